# Optimizing an MI355X kernel written in HIP

```python
import math
import jax, jax.numpy as jnp
from jax import lax
import numpy as np

D_MODEL = 1024
BATCH = 4
SEQ = 4096
DEPTH = 1

GRID_W = 64
CTX_LEN = 256
NORM_EPS = 1e-6
ATT_HEADS = 8
ATT_DK = 64
ATT_DV = 2 * ATT_DK
ATT_W = ATT_HEADS * ATT_DV
ROPE_BASE = 10000.0
Q_BLOCK = 128
SSM_GROUP = 16
SSM_W = D_MODEL // 2
SSM_GROUPS = SSM_W // SSM_GROUP
SSM_STATE = 64
DT_MIN = 1e-3
DT_MAX = 1e-1
PEER_HEADS = 8
PEER_NKEYS = 128
PEER_EXPERTS = PEER_NKEYS * PEER_NKEYS
PEER_TOPK = 16
PEER_DKEY = 128
PEER_BLOCK = 128
N_Q = 2 * ATT_HEADS * ATT_DK
N_K = 2 * ATT_HEADS * ATT_DK
N_V = ATT_W
N_IN_MIX = N_Q + N_K + N_V + SSM_W
N_IN = N_IN_MIX + 2 * D_MODEL

kernel_name = 'hybrid_diffattn_s5_peer_dit_block'


def _rmsnorm(h, g):
    hf = h.astype(jnp.float32)
    hf = hf * lax.rsqrt(jnp.mean(hf * hf, axis=-1, keepdims=True) + NORM_EPS)
    return (hf * g.astype(jnp.float32)).astype(h.dtype)


def _modulate(h, shift, scale):
    return h * (1 + scale) + shift


def _axial_angles(pos):
    n_freq = ATT_DK // 4
    inv = ROPE_BASE ** (-2.0 * jnp.arange(n_freq, dtype=jnp.float32) / (ATT_DK // 2))
    return pos.astype(jnp.float32)[:, None] * inv[None, :]


def _rope_1d(h, ang):
    f = ang.shape[-1]
    cos = jnp.cos(ang)[:, None, None, :]
    sin = jnp.sin(ang)[:, None, None, :]
    h1, h2 = h[..., :f], h[..., f:]
    return jnp.concatenate([h1 * cos - h2 * sin, h2 * cos + h1 * sin], axis=-1)


def _axial_rope(h, ang_r, ang_c):
    half = ATT_DK // 2
    hf = h.astype(jnp.float32)
    out = jnp.concatenate([_rope_1d(hf[..., :half], ang_r), _rope_1d(hf[..., half:], ang_c)], axis=-1)
    return out.astype(h.dtype)


def _diff_attend(q, k, v, lam):
    s = jnp.einsum('bqhmd,bkhmd->mbhqk', q, k, preferred_element_type=jnp.float32) * (ATT_DK ** -0.5)
    p = jax.nn.softmax(s, axis=-1)
    w = p[0] - lam * p[1]
    return jnp.einsum('bhqk,bkhe->bqhe', w.astype(v.dtype), v)


def _diff_attend_blocked(q, k, v, lam):
    b, l = q.shape[:2]
    nb = l // Q_BLOCK
    qb = jnp.moveaxis(q.reshape(b, nb, Q_BLOCK, ATT_HEADS, 2, ATT_DK), 1, 0)
    o = lax.map(lambda qblk: _diff_attend(qblk, k, v, lam), qb)
    return jnp.moveaxis(o, 0, 1).reshape(b, l, ATT_HEADS, ATT_DV)


def _diff_post(o, g, lam_init):
    b, l = o.shape[:2]
    return (_rmsnorm(o, g) * (1.0 - lam_init)).reshape(b, l, ATT_W)


def _s5_discretize(a_re, a_im, log_dt, b_re, b_im):
    ar = a_re.astype(jnp.float32)
    ai = a_im.astype(jnp.float32)
    dt = jnp.exp(log_dt.astype(jnp.float32))[:, None]
    mag = jnp.exp(ar * dt)
    abar_re = mag * jnp.cos(ai * dt)
    abar_im = mag * jnp.sin(ai * dt)
    den = ar * ar + ai * ai
    nr = abar_re - 1.0
    ni = abar_im
    fr = (nr * ar + ni * ai) / den
    fi = (ni * ar - nr * ai) / den
    br = b_re.astype(jnp.float32)
    bi = b_im.astype(jnp.float32)
    bbar_re = fr[..., None] * br - fi[..., None] * bi
    bbar_im = fr[..., None] * bi + fi[..., None] * br
    return abar_re, abar_im, bbar_re, bbar_im


def _cplx_combine(e1, e2):
    a1r, a1i, b1r, b1i = e1
    a2r, a2i, b2r, b2i = e2
    return (a2r * a1r - a2i * a1i,
            a2r * a1i + a2i * a1r,
            a2r * b1r - a2i * b1i + b2r,
            a2r * b1i + a2i * b1r + b2i)


def _s5_states(u, disc, h0, reverse):
    abar_re, abar_im, bbar_re, bbar_im = disc
    bu_re = jnp.einsum('gnp,blgp->blgn', bbar_re, u)
    bu_im = jnp.einsum('gnp,blgp->blgn', bbar_im, u)
    if h0 is not None:
        h0_re, h0_im = h0
        first = -1 if reverse else 0
        bu_re = bu_re.at[:, first].add(abar_re * h0_re - abar_im * h0_im)
        bu_im = bu_im.at[:, first].add(abar_re * h0_im + abar_im * h0_re)
    a_re = jnp.broadcast_to(abar_re, bu_re.shape)
    a_im = jnp.broadcast_to(abar_im, bu_im.shape)
    _, _, h_re, h_im = lax.associative_scan(_cplx_combine, (a_re, a_im, bu_re, bu_im), reverse=reverse, axis=1)
    return h_re, h_im


def _s5_readout(c_re, c_im, h):
    return (jnp.einsum('gpn,blgn->blgp', c_re.astype(jnp.float32), h[0])
            - jnp.einsum('gpn,blgn->blgp', c_im.astype(jnp.float32), h[1]))


def _s5_output(u, h_f, h_b, c_re, c_im, d_skip, w_glu, b_glu, dtype):
    b, l = u.shape[:2]
    y = (_s5_readout(c_re[0], c_im[0], h_f) + _s5_readout(c_re[1], c_im[1], h_b)
         + d_skip.astype(jnp.float32).reshape(SSM_GROUPS, SSM_GROUP) * u)
    y = jax.nn.gelu(y.reshape(b, l, SSM_W)).astype(dtype)
    return y * jax.nn.sigmoid(y @ w_glu + b_glu)


def _merge(attn, ssm, gates, w_attn_up, w_ssm_up, w_out):
    g_a, g_s = jnp.split(jax.nn.sigmoid(gates), 2, axis=-1)
    return (g_a * (attn @ w_attn_up) + g_s * (ssm @ w_ssm_up)) @ w_out


def _peer(h, w_query, sub_k1, sub_k2, table_u, table_v):
    b, l, d = h.shape
    half = PEER_DKEY // 2
    n_cand = PEER_TOPK * PEER_TOPK

    def block(tb):
        q = (tb @ w_query).reshape(PEER_BLOCK, PEER_HEADS, PEER_DKEY)
        s1 = jnp.einsum('thd,kd->thk', q[..., :half], sub_k1, preferred_element_type=jnp.float32)
        s2 = jnp.einsum('thd,kd->thk', q[..., half:], sub_k2, preferred_element_type=jnp.float32)
        v1, i1 = lax.top_k(s1, PEER_TOPK)
        v2, i2 = lax.top_k(s2, PEER_TOPK)
        cand_s = (v1[..., :, None] + v2[..., None, :]).reshape(PEER_BLOCK, PEER_HEADS, n_cand)
        cand_i = (i1[..., :, None] * PEER_NKEYS + i2[..., None, :]).reshape(PEER_BLOCK, PEER_HEADS, n_cand)
        top_s, top_j = lax.top_k(cand_s, PEER_TOPK)
        idx = jnp.take_along_axis(cand_i, top_j, axis=-1)
        gate = jax.nn.softmax(top_s, axis=-1)
        u_sel = jnp.take(table_u, idx, axis=0)
        act = jax.nn.gelu(jnp.einsum('thkd,td->thk', u_sel, tb, preferred_element_type=jnp.float32))
        v_sel = jnp.take(table_v, idx, axis=0)
        return jnp.einsum('thk,thkd->td', (gate * act).astype(tb.dtype), v_sel)

    out = lax.map(block, h.reshape(b * l // PEER_BLOCK, PEER_BLOCK, d))
    return out.reshape(b, l, d)


def setup_inputs(seed: int = 0) -> dict:
    key = jax.random.key(seed)
    keys = iter(jax.random.split(key, 48))

    def nrm(shape, scale):
        return jax.random.normal(next(keys), shape, jnp.float32) * scale

    D = D_MODEL
    G, N, P = SSM_GROUPS, SSM_STATE, SSM_GROUP
    half = PEER_DKEY // 2
    a_im_init = math.pi * jnp.arange(N, dtype=jnp.float32)
    return {
        'x': nrm((BATCH, SEQ, D), 1.0),
        'c': nrm((BATCH, D), 1.0),
        'ctx': nrm((BATCH, CTX_LEN, D), 1.0),
        'c_ctx': nrm((D,), 1.0),
        'ada_w': nrm((DEPTH, D, 6 * D), 0.5 * D ** -0.5),
        'ada_b': nrm((DEPTH, 6 * D), 0.02),
        'norm1_g': 1.0 + nrm((DEPTH, D), 0.02),
        'norm2_g': 1.0 + nrm((DEPTH, D), 0.02),
        'w_in': nrm((DEPTH, D, N_IN), D ** -0.5),
        'lambda_q1': nrm((DEPTH, ATT_DK), 0.1),
        'lambda_k1': nrm((DEPTH, ATT_DK), 0.1),
        'lambda_q2': nrm((DEPTH, ATT_DK), 0.1),
        'lambda_k2': nrm((DEPTH, ATT_DK), 0.1),
        'subln_g': 1.0 + nrm((DEPTH, ATT_DV), 0.02),
        'w_attn_up': nrm((DEPTH, ATT_W, D), ATT_W ** -0.5),
        'ssm_a_re': -0.5 + nrm((DEPTH, 2, G, N), 0.01),
        'ssm_a_im': a_im_init + nrm((DEPTH, 2, G, N), 0.01),
        'ssm_log_dt': jax.random.uniform(next(keys), (DEPTH, 2, G), jnp.float32, math.log(DT_MIN), math.log(DT_MAX)),
        'ssm_b_re': nrm((DEPTH, 2, G, N, P), (2 * P) ** -0.5),
        'ssm_b_im': nrm((DEPTH, 2, G, N, P), (2 * P) ** -0.5),
        'ssm_c_re': nrm((DEPTH, 2, G, P, N), (2 * N) ** -0.5),
        'ssm_c_im': nrm((DEPTH, 2, G, P, N), (2 * N) ** -0.5),
        'ssm_d': nrm((DEPTH, SSM_W), 1.0),
        'w_glu': nrm((DEPTH, SSM_W, SSM_W), SSM_W ** -0.5),
        'b_glu': nrm((DEPTH, SSM_W), 0.01),
        'w_ssm_up': nrm((DEPTH, SSM_W, D), SSM_W ** -0.5),
        'w_out': nrm((DEPTH, D, D), D ** -0.5),
        'peer_w_query': nrm((DEPTH, D, PEER_HEADS * PEER_DKEY), D ** -0.5),
        'peer_sub_k1': nrm((DEPTH, PEER_NKEYS, half), half ** -0.5),
        'peer_sub_k2': nrm((DEPTH, PEER_NKEYS, half), half ** -0.5),
        'peer_u': nrm((DEPTH, PEER_EXPERTS, D), D ** -0.5),
        'peer_v': nrm((DEPTH, PEER_EXPERTS, D), 1.0),
        'final_norm_g': 1.0 + nrm((D,), 0.02),
    }


def reference(x, c, ctx, c_ctx, ada_w, ada_b, norm1_g, norm2_g, w_in,
              lambda_q1, lambda_k1, lambda_q2, lambda_k2, subln_g, w_attn_up,
              ssm_a_re, ssm_a_im, ssm_log_dt, ssm_b_re, ssm_b_im, ssm_c_re, ssm_c_im,
              ssm_d, w_glu, b_glu, w_ssm_up, w_out,
              peer_w_query, peer_sub_k1, peer_sub_k2, peer_u, peer_v, final_norm_g):
    b, l, _ = x.shape
    n_ctx = ctx.shape[1]
    ROWS = l // GRID_W
    pos_row = jnp.repeat(jnp.arange(ROWS, dtype=jnp.int32), GRID_W)
    pos_col = jnp.tile(jnp.arange(GRID_W, dtype=jnp.int32), ROWS)
    ang_r = _axial_angles(pos_row)
    ang_c = _axial_angles(pos_col)
    c_act = jax.nn.silu(c)
    cc_act = jax.nn.silu(c_ctx)
    s_q, s_k, s_v = N_Q, N_Q + N_K, N_Q + N_K + N_V

    for i in range(DEPTH):
        ctx_out = i + 1 < DEPTH
        sh1, sc1, g1, sh2, sc2, g2 = jnp.split((c_act @ ada_w[i] + ada_b[i])[:, None, :], 6, axis=-1)
        sh1c, sc1c, g1c, sh2c, sc2c, g2c = jnp.split(cc_act @ ada_w[i] + ada_b[i], 6, axis=-1)
        lam_init = 0.8 - 0.6 * math.exp(-0.3 * i)
        lam = (jnp.exp(jnp.sum(lambda_q1[i].astype(jnp.float32) * lambda_k1[i].astype(jnp.float32)))
               - jnp.exp(jnp.sum(lambda_q2[i].astype(jnp.float32) * lambda_k2[i].astype(jnp.float32)))
               + lam_init)

        xn = _modulate(_rmsnorm(x, norm1_g[i]), sh1, sc1)
        cn = _modulate(_rmsnorm(ctx, norm1_g[i]), sh1c, sc1c)
        px = xn @ w_in[i]
        pc = cn @ w_in[i][:, s_q:N_IN_MIX]

        qx = _axial_rope(px[..., :s_q].reshape(b, l, ATT_HEADS, 2, ATT_DK), ang_r, ang_c)
        kx = _axial_rope(px[..., s_q:s_k].reshape(b, l, ATT_HEADS, 2, ATT_DK), ang_r, ang_c)
        vx = px[..., s_k:s_v].reshape(b, l, ATT_HEADS, ATT_DV)
        kc = pc[..., :N_K].reshape(b, n_ctx, ATT_HEADS, 2, ATT_DK)
        vc = pc[..., N_K:N_K + N_V].reshape(b, n_ctx, ATT_HEADS, ATT_DV)
        k_all = jnp.concatenate([kc, kx], axis=1)
        v_all = jnp.concatenate([vc, vx], axis=1)
        attn_x = _diff_post(_diff_attend_blocked(qx, k_all, v_all, lam), subln_g[i], lam_init)

        ux = px[..., s_v:N_IN_MIX].astype(jnp.float32).reshape(b, l, SSM_GROUPS, SSM_GROUP)
        uc = pc[..., N_K + N_V:].astype(jnp.float32).reshape(b, n_ctx, SSM_GROUPS, SSM_GROUP)
        disc_f = _s5_discretize(ssm_a_re[i, 0], ssm_a_im[i, 0], ssm_log_dt[i, 0], ssm_b_re[i, 0], ssm_b_im[i, 0])
        disc_b = _s5_discretize(ssm_a_re[i, 1], ssm_a_im[i, 1], ssm_log_dt[i, 1], ssm_b_re[i, 1], ssm_b_im[i, 1])
        hcf = _s5_states(uc, disc_f, None, False)
        hcb = _s5_states(uc, disc_b, None, True)
        hxf = _s5_states(ux, disc_f, (hcf[0][:, -1], hcf[1][:, -1]), False)
        hxb = _s5_states(ux, disc_b, (hcb[0][:, 0], hcb[1][:, 0]), True)
        ssm_x = _s5_output(ux, hxf, hxb, ssm_c_re[i], ssm_c_im[i], ssm_d[i], w_glu[i], b_glu[i], x.dtype)

        mix_x = _merge(attn_x, ssm_x, px[..., N_IN_MIX:], w_attn_up[i], w_ssm_up[i], w_out[i])

        if ctx_out:
            qc = (cn @ w_in[i][:, :s_q]).reshape(b, n_ctx, ATT_HEADS, 2, ATT_DK)
            attn_c = _diff_post(_diff_attend(qc, kc, vc, lam), subln_g[i], lam_init)
            ssm_cx = _s5_output(uc, hcf, hcb, ssm_c_re[i], ssm_c_im[i], ssm_d[i], w_glu[i], b_glu[i], ctx.dtype)
            mix_c = _merge(attn_c, ssm_cx, cn @ w_in[i][:, N_IN_MIX:], w_attn_up[i], w_ssm_up[i], w_out[i])

        x = x + g1 * mix_x

        xn2 = _modulate(_rmsnorm(x, norm2_g[i]), sh2, sc2)
        x = x + g2 * _peer(xn2, peer_w_query[i], peer_sub_k1[i], peer_sub_k2[i], peer_u[i], peer_v[i])

        if ctx_out:
            ctx = ctx + g1c * mix_c
            cn2 = _modulate(_rmsnorm(ctx, norm2_g[i]), sh2c, sc2c)
            ctx = ctx + g2c * _peer(cn2, peer_w_query[i], peer_sub_k1[i], peer_sub_k2[i], peer_u[i], peer_v[i])

    return _rmsnorm(x, final_norm_g)
```

```cpp
#include <hip/hip_runtime.h>
#include <hip/hip_cooperative_groups.h>
#include <cstdio>
#include <cstdint>
namespace cg = cooperative_groups;

typedef unsigned short bf16_t;
typedef float f32x4 __attribute__((ext_vector_type(4)));

constexpr int NT = 512;
constexpr int LDS_BYTES = 147456;
constexpr int Bn = 4, L = 4096, D = 1024, NCTX = 256, LA = L + NCTX;
constexpr int MX = Bn * L, MC = Bn * NCTX;
constexpr int N_IN = 5632;
constexpr size_t MiB = 1u << 20;
constexpr size_t WS_MOD = 0, WS_LAM = 128 * 1024, WS_ABRE = 192 * 1024, WS_ABIM = 224 * 1024, WS_BBRE = 256 * 1024, WS_BBIM = 512 * 1024;
constexpr size_t WS_XN = 2 * MiB, WS_Q = 36 * MiB, WS_K = 68 * MiB, WS_V = 102 * MiB, WS_U = 136 * MiB, WS_G = 153 * MiB;
constexpr size_t WS_IDX = 217 * MiB, WS_GATE = 225 * MiB, WS_SSMX = 233 * MiB;
constexpr size_t WS_ATT = WS_XN, WS_YS = WS_Q, WS_YG = WS_V, WS_M = 118 * MiB, WS_X1 = WS_Q, WS_XN2 = WS_XN, WS_QP = WS_G;


constexpr int PTR_OFF = LDS_BYTES - 1024;
__device__ __forceinline__ unsigned long long ldptr_(int k) {
  extern __shared__ __attribute__((aligned(16))) unsigned char lds_[];
  const unsigned long long v = ((const unsigned long long*)(lds_ + PTR_OFF))[k];
  const unsigned lo = __builtin_amdgcn_readfirstlane((unsigned)v), hi = __builtin_amdgcn_readfirstlane((unsigned)(v >> 32));
  return ((unsigned long long)hi << 32) | lo;
}
#define INP(k) ((const float*)ldptr_(k))
#define WSP(off) ((unsigned char*)ldptr_(34) + (off))
#define PHASE_LOCALS \
  int tid = threadIdx.x; asm volatile("" : "+v"(tid)); \
  const int lane = tid & 63, wid = tid >> 6; \
  const int gtid = blockIdx.x * NT + tid, gsz = gridDim.x * NT; \
  const int gw = blockIdx.x * (NT / 64) + wid, ngw = gridDim.x * (NT / 64); \
  float* fl = (float*)lds; (void)lane; (void)wid; (void)gtid; (void)gsz; (void)gw; (void)ngw; (void)fl;

struct Params {
  const float* in[33];
  float* out;
  unsigned char* ws;
  int pad0, pad1;
};

__device__ __forceinline__ float bf2f(bf16_t v) { return __uint_as_float(((unsigned)v) << 16); }
__device__ __forceinline__ bf16_t f2bf(float f) { unsigned u = __float_as_uint(f); return (bf16_t)((u + 0x7fffu + ((u >> 16) & 1u)) >> 16); }
__device__ __forceinline__ float wave_sum(float v) {
#pragma unroll
  for (int o = 32; o; o >>= 1) v += __shfl_xor(v, o);
  return v;
}
__device__ __forceinline__ float gelu_tanh(float x) { return 0.5f * x * (1.f + tanhf(0.7978845608028654f * (x + 0.044715f * x * x * x))); }
__device__ __forceinline__ float sigmoidf_(float x) { return 1.f / (1.f + __expf(-x)); }
__device__ __forceinline__ float siluf_(float x) { return x / (1.f + __expf(-x)); }

template <class Epi>
__device__ __forceinline__ void sgemm(const bf16_t* A, int lda, const float* Bm, int ldb, int M, int N, int K, float* lds, Epi epi) {
  constexpr int TM = 128, TN = 128, TK = 16, LDA_S = TM + 4, LDB_S = TN + 4;
  float* As = lds;
  float* Bs = lds + TK * LDA_S;
  const int tid = threadIdx.x, ty = tid >> 4, tx = tid & 15;
  const int ntm = M / TM, ntn = N / TN;
  for (int tile = blockIdx.x; tile < ntm * ntn; tile += gridDim.x) {
    const int tm = tile / ntn, tn = tile % ntn;
    float acc[4][8];
#pragma unroll
    for (int i = 0; i < 4; ++i)
#pragma unroll
      for (int j = 0; j < 8; ++j) acc[i][j] = 0.f;
    const int ar = tid >> 2, ak = (tid & 3) * 4;
    const int bk = tid >> 5, bn = (tid & 31) * 4;
    for (int k0 = 0; k0 < K; k0 += TK) {
      const bf16_t* ap = A + (size_t)(tm * TM + ar) * lda + k0 + ak;
      const unsigned long long av = *(const unsigned long long*)ap;
      const f32x4 bv = *(const f32x4*)(Bm + (size_t)(k0 + bk) * ldb + tn * TN + bn);
      __syncthreads();
      As[(ak + 0) * LDA_S + ar] = bf2f((bf16_t)(av & 0xffff));
      As[(ak + 1) * LDA_S + ar] = bf2f((bf16_t)((av >> 16) & 0xffff));
      As[(ak + 2) * LDA_S + ar] = bf2f((bf16_t)((av >> 32) & 0xffff));
      As[(ak + 3) * LDA_S + ar] = bf2f((bf16_t)((av >> 48) & 0xffff));
      *(f32x4*)(Bs + bk * LDB_S + bn) = bv;
      __syncthreads();
#pragma unroll
      for (int k = 0; k < TK; ++k) {
        const f32x4 a4 = *(const f32x4*)(As + k * LDA_S + ty * 4);
        const f32x4 b0 = *(const f32x4*)(Bs + k * LDB_S + tx * 8);
        const f32x4 b1 = *(const f32x4*)(Bs + k * LDB_S + tx * 8 + 4);
#pragma unroll
        for (int i = 0; i < 4; ++i) {
          acc[i][0] += a4[i] * b0[0]; acc[i][1] += a4[i] * b0[1]; acc[i][2] += a4[i] * b0[2]; acc[i][3] += a4[i] * b0[3];
          acc[i][4] += a4[i] * b1[0]; acc[i][5] += a4[i] * b1[1]; acc[i][6] += a4[i] * b1[2]; acc[i][7] += a4[i] * b1[3];
        }
      }
    }
#pragma unroll
    for (int i = 0; i < 4; ++i)
#pragma unroll
      for (int j = 0; j < 8; ++j) epi(tm * TM + ty * 4 + i, tn * TN + tx * 8 + j, acc[i][j]);
  }
  __syncthreads();
}

__device__ __forceinline__ void wave_argmax(float& v, int& i) {
#pragma unroll
  for (int o = 32; o; o >>= 1) {
    const float ov = __shfl_xor(v, o); const int oi = __shfl_xor(i, o);
    if (ov > v || (ov == v && oi < i)) { v = ov; i = oi; }
  }
}

__global__ void __launch_bounds__(NT) mega(Params p) {
  extern __shared__ __attribute__((aligned(16))) unsigned char lds[];
  cg::grid_group grid = cg::this_grid();
  if (threadIdx.x < 35) {
    unsigned long long v = threadIdx.x < 33 ? (unsigned long long)p.in[threadIdx.x] : (threadIdx.x == 33 ? (unsigned long long)p.out : (unsigned long long)p.ws);
    ((unsigned long long*)(lds + PTR_OFF))[threadIdx.x] = v;
  }
  __syncthreads();

  {
    PHASE_LOCALS
    float* MOD = (float*)WSP(WS_MOD); float* LAM = (float*)WSP(WS_LAM);
    float* ABRE = (float*)WSP(WS_ABRE); float* ABIM = (float*)WSP(WS_ABIM); float* BBRE = (float*)WSP(WS_BBRE); float* BBIM = (float*)WSP(WS_BBIM);
    const float* cin = INP(1); const float* c_ctx = INP(3); const float* ada_w = INP(4); const float* ada_b = INP(5);
    for (int it = gtid; it < 5 * 6144; it += gsz) {
      const int r = it / 6144, j = it % 6144;
      const float* cv = r < 4 ? cin + r * D : c_ctx;
      float a = 0.f;
      for (int k = 0; k < D; ++k) a += siluf_(cv[k]) * ada_w[(size_t)k * 6144 + j];
      MOD[it] = a + ada_b[j];
    }
    if (gtid == 0) {
      const float* q1 = INP(9); const float* k1 = INP(10); const float* q2 = INP(11); const float* k2 = INP(12);
      float s1 = 0.f, s2 = 0.f;
      for (int k = 0; k < 64; ++k) { s1 += q1[k] * k1[k]; s2 += q2[k] * k2[k]; }
      LAM[0] = expf(s1) - expf(s2) + 0.2f;
    }
    const float* a_re = INP(15); const float* a_im = INP(16); const float* ldt = INP(17); const float* b_re = INP(18); const float* b_im = INP(19);
    for (int it = gtid; it < 2 * 32 * 64; it += gsz) {
      const int dg = it >> 6;
      const float ar = a_re[it], ai = a_im[it], dt = expf(ldt[dg]);
      const float mag = expf(ar * dt), abr = mag * cosf(ai * dt), abi = mag * sinf(ai * dt);
      ABRE[it] = abr; ABIM[it] = abi;
      const float den = ar * ar + ai * ai, nr = abr - 1.f, ni = abi;
      const float fr = (nr * ar + ni * ai) / den, fi = (ni * ar - nr * ai) / den;
      for (int pp = 0; pp < 16; ++pp) {
        const float br = b_re[it * 16 + pp], bi = b_im[it * 16 + pp];
        BBRE[it * 16 + pp] = fr * br - fi * bi; BBIM[it * 16 + pp] = fr * bi + fi * br;
      }
    }
  }
  grid.sync();

  {
    PHASE_LOCALS
    const float* MOD = (const float*)WSP(WS_MOD); bf16_t* XN = (bf16_t*)WSP(WS_XN);
    const float* x = INP(0); const float* ctx = INP(2); const float* norm1_g = INP(6);
    for (int row = gw; row < MX + MC; row += ngw) {
      const float* src; const float* md;
      if (row < MX) { src = x + (size_t)row * D; md = MOD + (row / L) * 6144; } else { src = ctx + (size_t)(row - MX) * D; md = MOD + 4 * 6144; }
      f32x4 v[4]; float ss = 0.f;
#pragma unroll
      for (int j = 0; j < 4; ++j) { v[j] = *(const f32x4*)(src + lane * 4 + 256 * j); ss += v[j][0] * v[j][0] + v[j][1] * v[j][1] + v[j][2] * v[j][2] + v[j][3] * v[j][3]; }
      const float rstd = rsqrtf(wave_sum(ss) * (1.f / D) + 1e-6f);
#pragma unroll
      for (int j = 0; j < 4; ++j)
#pragma unroll
        for (int e = 0; e < 4; ++e) { const int col = lane * 4 + 256 * j + e; XN[(size_t)row * D + col] = f2bf(v[j][e] * rstd * norm1_g[col] * (1.f + md[1024 + col]) + md[col]); }
    }
  }
  grid.sync();

  {
    PHASE_LOCALS
    const bf16_t* XN = (const bf16_t*)WSP(WS_XN); bf16_t* Qb = (bf16_t*)WSP(WS_Q); bf16_t* Kb = (bf16_t*)WSP(WS_K); bf16_t* Vb = (bf16_t*)WSP(WS_V);
    bf16_t* Ub = (bf16_t*)WSP(WS_U); bf16_t* Gt = (bf16_t*)WSP(WS_G); const float* w_in = INP(8);
    sgemm(XN, D, w_in, N_IN, MX, N_IN, D, fl, [=](int row, int col, float v) {
      const int b = row / L, t = row % L; const size_t kr = (size_t)b * LA + NCTX + t;
      if (col < 1024) Qb[(size_t)row * 1024 + col] = f2bf(v);
      else if (col < 2048) Kb[kr * 1024 + col - 1024] = f2bf(v);
      else if (col < 3072) Vb[kr * 1024 + col - 2048] = f2bf(v);
      else if (col < 3584) Ub[kr * 512 + col - 3072] = f2bf(v);
      else Gt[(size_t)row * 2048 + col - 3584] = f2bf(sigmoidf_(v));
    });
    sgemm(XN + (size_t)MX * D, D, w_in + 1024, N_IN, MC, 2560, D, fl, [=](int row, int col, float v) {
      const int b = row / NCTX, t = row % NCTX; const size_t kr = (size_t)b * LA + t;
      if (col < 1024) Kb[kr * 1024 + col] = f2bf(v);
      else if (col < 2048) Vb[kr * 1024 + col - 1024] = f2bf(v);
      else Ub[kr * 512 + col - 2048] = f2bf(v);
    });
  }
  grid.sync();

  {
    PHASE_LOCALS
    bf16_t* Qb = (bf16_t*)WSP(WS_Q); bf16_t* Kb = (bf16_t*)WSP(WS_K);
    for (size_t it = gtid; it < (size_t)MX * 1024; it += gsz) {
      const int row = (int)(it >> 10), e = (int)(it & 1023), buf = e >> 9, pe = e & 511;
      const int blk = pe >> 5, within = pe & 31, half = within >> 4, f = within & 15;
      const int b = row / L, t = row % L;
      const int c1 = blk * 64 + half * 32 + f, c2 = c1 + 16;
      const float pos = (float)(half == 0 ? (t >> 6) : (t & 63));
      const float ang = pos * powf(10000.f, -(float)f / 16.f);
      const float cs = cosf(ang), sn = sinf(ang);
      bf16_t* base = buf == 0 ? Qb + (size_t)row * 1024 : Kb + ((size_t)b * LA + NCTX + t) * 1024;
      const float h1 = bf2f(base[c1]), h2 = bf2f(base[c2]);
      base[c1] = f2bf(h1 * cs - h2 * sn); base[c2] = f2bf(h2 * cs + h1 * sn);
    }
  }
  grid.sync();

  {
    PHASE_LOCALS
    const bf16_t* Qb = (const bf16_t*)WSP(WS_Q); const bf16_t* Kb = (const bf16_t*)WSP(WS_K); const bf16_t* Vb = (const bf16_t*)WSP(WS_V);
    bf16_t* ATT = (bf16_t*)WSP(WS_ATT); const float* subln = INP(13);
    const float lam = ((const float*)WSP(WS_LAM))[0];
    const int qi = tid & 127, mp = (tid >> 7) & 1, hv = tid >> 8;
    float* KV = fl;
    for (int unit = blockIdx.x; unit < Bn * 8 * (L / 128); unit += gridDim.x) {
      const int qb = unit % (L / 128), h = (unit / (L / 128)) % 8, b = unit / (8 * (L / 128));
      const int row = b * L + qb * 128 + qi;
      float q[64];
#pragma unroll
      for (int d = 0; d < 64; ++d) q[d] = bf2f(Qb[(size_t)row * 1024 + h * 128 + mp * 64 + d]) * 0.125f;
      float o[64];
#pragma unroll
      for (int e = 0; e < 64; ++e) o[e] = 0.f;
      float mrun = -1e30f, lrun = 0.f;
      for (int k0 = 0; k0 < LA; k0 += 8) {
        __syncthreads();
        {
          const int kk = tid >> 6, c4 = (tid & 63) * 4;
          const bf16_t* src = (c4 < 128 ? Kb + ((size_t)b * LA + k0 + kk) * 1024 + h * 128 + c4 : Vb + ((size_t)b * LA + k0 + kk) * 1024 + h * 128 + c4 - 128);
#pragma unroll
          for (int e = 0; e < 4; ++e) KV[kk * 256 + c4 + e] = bf2f(src[e]);
        }
        __syncthreads();
        float s[8]; float tmax = -1e30f;
#pragma unroll
        for (int j = 0; j < 8; ++j) {
          const float* kp = KV + j * 256 + mp * 64; float a = 0.f;
#pragma unroll
          for (int dc = 0; dc < 4; ++dc) {
#pragma unroll
            for (int d = 0; d < 16; ++d) a += q[dc * 16 + d] * kp[dc * 16 + d];
            __builtin_amdgcn_sched_barrier(0);
          }
          s[j] = a; tmax = fmaxf(tmax, a);
        }
        const float mnew = fmaxf(mrun, tmax), alpha = __expf(mrun - mnew);
        mrun = mnew; lrun *= alpha;
#pragma unroll
        for (int e = 0; e < 64; ++e) o[e] *= alpha;
#pragma unroll
        for (int j = 0; j < 8; ++j) {
          const float pj = __expf(s[j] - mnew); lrun += pj;
          const float* vp = KV + j * 256 + 128 + hv * 64;
#pragma unroll
          for (int ec = 0; ec < 4; ++ec) {
#pragma unroll
            for (int e = 0; e < 16; ++e) o[ec * 16 + e] += pj * vp[ec * 16 + e];
            __builtin_amdgcn_sched_barrier(0);
          }
        }
      }
      __syncthreads();
      float* EX = fl;
      const float il = 1.f / lrun;
#pragma unroll
      for (int e = 0; e < 64; ++e) EX[(mp * 128 + qi) * 129 + hv * 64 + e] = o[e] * il;
      __syncthreads();
      if (mp == 0) {
        float ss = 0.f;
        for (int e = 0; e < 128; ++e) { const float dv = EX[qi * 129 + e] - lam * EX[(128 + qi) * 129 + e]; ss += dv * dv; }
        const float rstd = rsqrtf(ss * (1.f / 128.f) + 1e-6f) * 0.8f;
        for (int e = 0; e < 64; ++e) {
          const int c = hv * 64 + e; const float dv = EX[qi * 129 + c] - lam * EX[(128 + qi) * 129 + c];
          ATT[(size_t)row * 1024 + h * 128 + c] = f2bf(dv * rstd * subln[c]);
        }
      }
    }
    __syncthreads();
  }
  grid.sync();

  {
    PHASE_LOCALS
    const float* ABRE = (const float*)WSP(WS_ABRE); const float* ABIM = (const float*)WSP(WS_ABIM);
    const float* BBRE = (const float*)WSP(WS_BBRE); const float* BBIM = (const float*)WSP(WS_BBIM);
    const bf16_t* Ub = (const bf16_t*)WSP(WS_U); float* YS = (float*)WSP(WS_YS);
    const float* c_re = INP(20); const float* c_im = INP(21);
    for (int it = gw; it < Bn * 32 * 2; it += ngw) {
      const int d = it & 1, g = (it >> 1) & 31, b = it >> 6;
      const int sidx = (d * 32 + g) * 64 + lane;
      const float abr = ABRE[sidx], abi = ABIM[sidx];
      float bre[16], bim[16], cre[16], cim[16];
#pragma unroll
      for (int pp = 0; pp < 16; ++pp) {
        bre[pp] = BBRE[sidx * 16 + pp]; bim[pp] = BBIM[sidx * 16 + pp];
        cre[pp] = c_re[((d * 32 + g) * 16 + pp) * 64 + lane]; cim[pp] = c_im[((d * 32 + g) * 16 + pp) * 64 + lane];
      }
      float hr = 0.f, hi = 0.f;
      float* ys = YS + (size_t)d * MX * 512;
      for (int s = 0; s < LA; ++s) {
        const bool isx = s >= NCTX;
        int tok;
        if (d == 0) tok = s;
        else tok = isx ? (NCTX + (L - 1) - (s - NCTX)) : (NCTX - 1 - s);
        const bf16_t* up = Ub + ((size_t)b * LA + tok) * 512 + g * 16;
        float bur = 0.f, bui = 0.f;
#pragma unroll
        for (int pp = 0; pp < 16; ++pp) { const float uv = bf2f(up[pp]); bur += bre[pp] * uv; bui += bim[pp] * uv; }
        const float nr = abr * hr - abi * hi + bur, ni = abr * hi + abi * hr + bui;
        hr = nr; hi = ni;
        if (isx) {
          float myv = 0.f;
#pragma unroll
          for (int pp = 0; pp < 16; ++pp) { const float yv = wave_sum(cre[pp] * hr - cim[pp] * hi); if (lane == pp) myv = yv; }
          if (lane < 16) ys[((size_t)b * L + (tok - NCTX)) * 512 + g * 16 + lane] = myv;
        }
      }
    }
  }
  grid.sync();

  {
    PHASE_LOCALS
    const bf16_t* Ub = (const bf16_t*)WSP(WS_U); const float* YS = (const float*)WSP(WS_YS); bf16_t* YG = (bf16_t*)WSP(WS_YG); const float* dsk = INP(22);
    for (size_t it = gtid; it < (size_t)MX * 512; it += gsz) {
      const int row = (int)(it >> 9), ch = (int)(it & 511), b = row / L, t = row % L;
      const float u = bf2f(Ub[((size_t)b * LA + NCTX + t) * 512 + ch]);
      const float y = YS[it] + YS[(size_t)MX * 512 + it] + dsk[ch] * u;
      YG[it] = f2bf(gelu_tanh(y));
    }
  }
  grid.sync();
  {
    PHASE_LOCALS
    const bf16_t* YG = (const bf16_t*)WSP(WS_YG); bf16_t* SSMX = (bf16_t*)WSP(WS_SSMX); const float* w_glu = INP(23); const float* b_glu = INP(24);
    sgemm(YG, 512, w_glu, 512, MX, 512, 512, fl, [=](int row, int col, float v) {
      SSMX[(size_t)row * 512 + col] = f2bf(bf2f(YG[(size_t)row * 512 + col]) * sigmoidf_(v + b_glu[col]));
    });
  }
  grid.sync();

  {
    PHASE_LOCALS
    const bf16_t* ATT = (const bf16_t*)WSP(WS_ATT); const bf16_t* Gt = (const bf16_t*)WSP(WS_G); bf16_t* Mb = (bf16_t*)WSP(WS_M); const float* w_au = INP(14);
    sgemm(ATT, 1024, w_au, 1024, MX, 1024, 1024, fl, [=](int row, int col, float v) {
      Mb[(size_t)row * 1024 + col] = f2bf(bf2f(Gt[(size_t)row * 2048 + col]) * v);
    });
  }
  grid.sync();
  {
    PHASE_LOCALS
    const bf16_t* SSMX = (const bf16_t*)WSP(WS_SSMX); const bf16_t* Gt = (const bf16_t*)WSP(WS_G); bf16_t* Mb = (bf16_t*)WSP(WS_M); const float* w_su = INP(25);
    sgemm(SSMX, 512, w_su, 1024, MX, 1024, 512, fl, [=](int row, int col, float v) {
      Mb[(size_t)row * 1024 + col] = f2bf(bf2f(Mb[(size_t)row * 1024 + col]) + bf2f(Gt[(size_t)row * 2048 + 1024 + col]) * v);
    });
  }
  grid.sync();
  {
    PHASE_LOCALS
    const bf16_t* Mb = (const bf16_t*)WSP(WS_M); float* X1 = (float*)WSP(WS_X1); const float* MOD = (const float*)WSP(WS_MOD); const float* x = INP(0); const float* w_out = INP(26);
    sgemm(Mb, 1024, w_out, 1024, MX, 1024, 1024, fl, [=](int row, int col, float v) {
      X1[(size_t)row * 1024 + col] = x[(size_t)row * 1024 + col] + MOD[(row / L) * 6144 + 2048 + col] * v;
    });
  }
  grid.sync();
  {
    PHASE_LOCALS
    const float* X1 = (const float*)WSP(WS_X1); const float* MOD = (const float*)WSP(WS_MOD); bf16_t* XN2 = (bf16_t*)WSP(WS_XN2); const float* norm2_g = INP(7);
    for (int row = gw; row < MX; row += ngw) {
      const float* src = X1 + (size_t)row * D; const float* md = MOD + (row / L) * 6144;
      f32x4 v[4]; float ss = 0.f;
#pragma unroll
      for (int j = 0; j < 4; ++j) { v[j] = *(const f32x4*)(src + lane * 4 + 256 * j); ss += v[j][0] * v[j][0] + v[j][1] * v[j][1] + v[j][2] * v[j][2] + v[j][3] * v[j][3]; }
      const float rstd = rsqrtf(wave_sum(ss) * (1.f / D) + 1e-6f);
#pragma unroll
      for (int j = 0; j < 4; ++j)
#pragma unroll
        for (int e = 0; e < 4; ++e) { const int col = lane * 4 + 256 * j + e; XN2[(size_t)row * D + col] = f2bf(v[j][e] * rstd * norm2_g[col] * (1.f + md[4096 + col]) + md[3072 + col]); }
    }
  }
  grid.sync();
  {
    PHASE_LOCALS
    const bf16_t* XN2 = (const bf16_t*)WSP(WS_XN2); float* QP = (float*)WSP(WS_QP); const float* w_q = INP(27);
    sgemm(XN2, 1024, w_q, 1024, MX, 1024, 1024, fl, [=](int row, int col, float v) { QP[(size_t)row * 1024 + col] = v; });
  }
  grid.sync();
  {
    PHASE_LOCALS
    const float* QP = (const float*)WSP(WS_QP); int* IDX = (int*)WSP(WS_IDX); float* GATE = (float*)WSP(WS_GATE);
    const float* sk1 = INP(28); const float* sk2 = INP(29);
    float* SK = fl;
    for (int i = tid; i < 128 * 64; i += NT) { SK[(i >> 6) * 65 + (i & 63)] = sk1[i]; SK[128 * 65 + (i >> 6) * 65 + (i & 63)] = sk2[i]; }
    __syncthreads();
    for (int it = gw; it < MX * 8; it += ngw) {
      const int t = it >> 3, h = it & 7;
      const float* qp = QP + (size_t)t * 1024 + h * 128;
      const float qa = qp[lane], qb2 = qp[64 + lane];
      float s1a = 0.f, s1b = 0.f, s2a = 0.f, s2b = 0.f;
      for (int dd = 0; dd < 64; ++dd) {
        const float q1 = __shfl(qa, dd), q2 = __shfl(qb2, dd);
        s1a += q1 * SK[lane * 65 + dd]; s1b += q1 * SK[(lane + 64) * 65 + dd];
        s2a += q2 * SK[128 * 65 + lane * 65 + dd]; s2b += q2 * SK[128 * 65 + (lane + 64) * 65 + dd];
      }
      float v1 = 0.f, v2 = 0.f; int i1 = 0, i2 = 0;
      for (int r = 0; r < 16; ++r) {
        float bv = s1a; int bi = lane; if (s1b > bv) { bv = s1b; bi = lane + 64; }
        wave_argmax(bv, bi);
        if (bi == lane) s1a = -3e38f;
        if (bi == lane + 64) s1b = -3e38f;
        if (lane == r) { v1 = bv; i1 = bi; }
        bv = s2a; bi = lane; if (s2b > bv) { bv = s2b; bi = lane + 64; }
        wave_argmax(bv, bi);
        if (bi == lane) s2a = -3e38f;
        if (bi == lane + 64) s2b = -3e38f;
        if (lane == r) { v2 = bv; i2 = bi; }
      }
      const float vb = __shfl(v2, lane & 15);
      float cs[4];
#pragma unroll
      for (int j = 0; j < 4; ++j) cs[j] = __shfl(v1, (lane >> 4) + 4 * j) + vb;
      float tv = 0.f; int tcand = 0;
      for (int r = 0; r < 16; ++r) {
        float bv = cs[0]; int bi = ((lane >> 4) + 0) * 16 + (lane & 15);
#pragma unroll
        for (int j = 1; j < 4; ++j) { const int ci = ((lane >> 4) + 4 * j) * 16 + (lane & 15); if (cs[j] > bv) { bv = cs[j]; bi = ci; } }
        wave_argmax(bv, bi);
#pragma unroll
        for (int j = 0; j < 4; ++j) { const int ci = ((lane >> 4) + 4 * j) * 16 + (lane & 15); if (ci == bi) cs[j] = -3e38f; }
        if (lane == r) { tv = bv; tcand = bi; }
      }
      const int e1 = __shfl(i1, tcand >> 4), e2 = __shfl(i2, tcand & 15);
      const float mx = __shfl(tv, 0);
      const float ex = lane < 16 ? __expf(tv - mx) : 0.f;
      const float den = wave_sum(ex);
      if (lane < 16) { IDX[(size_t)it * 16 + lane] = e1 * 128 + e2; GATE[(size_t)it * 16 + lane] = ex / den; }
    }
    __syncthreads();
  }
  grid.sync();
  {
    PHASE_LOCALS
    const float* X1 = (const float*)WSP(WS_X1); const float* MOD = (const float*)WSP(WS_MOD); const bf16_t* XN2 = (const bf16_t*)WSP(WS_XN2);
    const int* IDX = (const int*)WSP(WS_IDX); const float* GATE = (const float*)WSP(WS_GATE);
    const float* pu = INP(30); const float* pv = INP(31); const float* fng = INP(32); float* out = (float*)ldptr_(33);
    for (int row = gw; row < MX; row += ngw) {
      const float* md = MOD + (row / L) * 6144;
      float xv[16], acc[16];
#pragma unroll
      for (int j = 0; j < 4; ++j)
#pragma unroll
        for (int e = 0; e < 4; ++e) { xv[j * 4 + e] = bf2f(XN2[(size_t)row * D + lane * 4 + 256 * j + e]); acc[j * 4 + e] = 0.f; }
      for (int i = 0; i < 128; ++i) {
        const int ex = IDX[(size_t)row * 128 + i]; const float gt = GATE[(size_t)row * 128 + i];
        const float* ur = pu + (size_t)ex * D; const float* vr = pv + (size_t)ex * D;
        float dp = 0.f;
#pragma unroll
        for (int j = 0; j < 4; ++j) { const f32x4 uu = *(const f32x4*)(ur + lane * 4 + 256 * j); dp += uu[0] * xv[j * 4] + uu[1] * xv[j * 4 + 1] + uu[2] * xv[j * 4 + 2] + uu[3] * xv[j * 4 + 3]; }
        const float cf = gt * gelu_tanh(wave_sum(dp));
#pragma unroll
        for (int j = 0; j < 4; ++j) { const f32x4 vv = *(const f32x4*)(vr + lane * 4 + 256 * j); acc[j * 4] += cf * vv[0]; acc[j * 4 + 1] += cf * vv[1]; acc[j * 4 + 2] += cf * vv[2]; acc[j * 4 + 3] += cf * vv[3]; }
      }
      float ss = 0.f; float x2[16];
#pragma unroll
      for (int j = 0; j < 4; ++j)
#pragma unroll
        for (int e = 0; e < 4; ++e) { const int col = lane * 4 + 256 * j + e; const float v = X1[(size_t)row * D + col] + md[5120 + col] * acc[j * 4 + e]; x2[j * 4 + e] = v; ss += v * v; }
      const float rstd = rsqrtf(wave_sum(ss) * (1.f / D) + 1e-6f);
#pragma unroll
      for (int j = 0; j < 4; ++j) {
        f32x4 o4;
#pragma unroll
        for (int e = 0; e < 4; ++e) o4[e] = x2[j * 4 + e] * rstd * fng[lane * 4 + 256 * j + e];
        *(f32x4*)(out + (size_t)row * D + lane * 4 + 256 * j) = o4;
      }
    }
  }
}

extern "C" void kernel_launch(void* const* d_in, const int* in_sizes, int n_in, void* d_out, int out_size, void* d_ws, size_t ws_size, hipStream_t stream) {
  static int grid_blocks = 0;
  if (!grid_blocks) {
    int dev = 0, cus = 0, per_cu = 0;
    (void)hipGetDevice(&dev);
    (void)hipDeviceGetAttribute(&cus, hipDeviceAttributeMultiprocessorCount, dev);
    (void)hipFuncSetAttribute((const void*)mega, hipFuncAttributeMaxDynamicSharedMemorySize, LDS_BYTES);
    (void)hipOccupancyMaxActiveBlocksPerMultiprocessor(&per_cu, (const void*)mega, NT, LDS_BYTES);
    if (per_cu < 1) per_cu = 1;
    grid_blocks = cus * per_cu;
    if (n_in != 33 || ws_size < 249 * MiB) { fprintf(stderr, "kernel_launch: unexpected n_in %d / ws %zu\n", n_in, ws_size); }
  }
  Params p{};
  for (int i = 0; i < 33 && i < n_in; ++i) p.in[i] = (const float*)d_in[i];
  p.out = (float*)d_out; p.ws = (unsigned char*)d_ws;
  void* args[] = {&p};
  hipError_t e = hipLaunchCooperativeKernel((const void*)mega, dim3(grid_blocks), dim3(NT), args, LDS_BYTES, stream);
  if (e != hipSuccess) fprintf(stderr, "cooperative launch failed: %s (grid %d)\n", hipGetErrorString(e), grid_blocks);
}
```

```cpp
#include <hip/hip_runtime.h>
#include <hip/hip_cooperative_groups.h>
#include <cstdio>
#include <cstdint>
namespace cg = cooperative_groups;

typedef unsigned short bf16_t;
typedef float f32x4 __attribute__((ext_vector_type(4)));

constexpr int NT = 512;
constexpr int LDS_BYTES = 147456;
constexpr int Bn = 4, L = 4096, D = 1024, NCTX = 256, LA = L + NCTX;
constexpr int MX = Bn * L, MC = Bn * NCTX;
constexpr int N_IN = 5632;
constexpr size_t MiB = 1u << 20;
constexpr size_t WS_MOD = 0, WS_LAM = 128 * 1024, WS_ABRE = 192 * 1024, WS_ABIM = 224 * 1024, WS_BBRE = 256 * 1024, WS_BBIM = 512 * 1024;
constexpr size_t WS_XN = 2 * MiB, WS_Q = 36 * MiB, WS_K = 68 * MiB, WS_V = 102 * MiB, WS_U = 136 * MiB, WS_G = 153 * MiB;
constexpr size_t WS_IDX = 118 * MiB, WS_GATE = 126 * MiB, WS_SSMX = 236 * MiB;
constexpr size_t WS_ROPE = 136 * 1024;
constexpr size_t WS_WIN = 217 * MiB, WS_WAU = 228 * MiB, WS_WSU = 230 * MiB, WS_WOUT = 231 * MiB, WS_WQ = 233 * MiB, WS_WGLU = 235 * MiB;
constexpr size_t WS_ATT = WS_XN, WS_YS = WS_Q, WS_YG = WS_V, WS_M = 118 * MiB, WS_X1 = WS_Q, WS_XN2 = WS_XN, WS_QP = WS_G;


constexpr int PTR_OFF = LDS_BYTES - 1024;
__device__ __forceinline__ unsigned long long ldptr_(int k) {
  extern __shared__ __attribute__((aligned(16))) unsigned char lds_[];
  const unsigned long long v = ((const unsigned long long*)(lds_ + PTR_OFF))[k];
  const unsigned lo = __builtin_amdgcn_readfirstlane((unsigned)v), hi = __builtin_amdgcn_readfirstlane((unsigned)(v >> 32));
  return ((unsigned long long)hi << 32) | lo;
}
#define INP(k) ((const float*)ldptr_(k))
#define WSP(off) ((unsigned char*)ldptr_(34) + (off))
#define PHASE_LOCALS \
  int tid = threadIdx.x; asm volatile("" : "+v"(tid)); \
  const int lane = tid & 63, wid = tid >> 6; \
  const int gtid = blockIdx.x * NT + tid, gsz = gridDim.x * NT; \
  const int gw = blockIdx.x * (NT / 64) + wid, ngw = gridDim.x * (NT / 64); \
  float* fl = (float*)lds; (void)lane; (void)wid; (void)gtid; (void)gsz; (void)gw; (void)ngw; (void)fl;

struct Params {
  const float* in[33];
  float* out;
  unsigned char* ws;
  int pad0, pad1;
};

__device__ __forceinline__ float bf2f(bf16_t v) { return __uint_as_float(((unsigned)v) << 16); }
__device__ __forceinline__ bf16_t f2bf(float f) { unsigned u = __float_as_uint(f); return (bf16_t)((u + 0x7fffu + ((u >> 16) & 1u)) >> 16); }
__device__ __forceinline__ float wave_sum(float v) {
#pragma unroll
  for (int o = 32; o; o >>= 1) v += __shfl_xor(v, o);
  return v;
}
__device__ __forceinline__ float gelu_tanh(float x) { return 0.5f * x * (1.f + tanhf(0.7978845608028654f * (x + 0.044715f * x * x * x))); }
__device__ __forceinline__ float sigmoidf_(float x) { return 1.f / (1.f + __expf(-x)); }
__device__ __forceinline__ float siluf_(float x) { return x / (1.f + __expf(-x)); }

template <class Epi>
__device__ __forceinline__ void sgemm(const bf16_t* A, int lda, const float* Bm, int ldb, int M, int N, int K, float* lds, Epi epi) {
  constexpr int TM = 128, TN = 128, TK = 16, LDA_S = TM + 4, LDB_S = TN + 4;
  float* As = lds;
  float* Bs = lds + TK * LDA_S;
  const int tid = threadIdx.x, ty = tid >> 4, tx = tid & 15;
  const int ntm = M / TM, ntn = N / TN;
  for (int tile = blockIdx.x; tile < ntm * ntn; tile += gridDim.x) {
    const int tm = tile / ntn, tn = tile % ntn;
    float acc[4][8];
#pragma unroll
    for (int i = 0; i < 4; ++i)
#pragma unroll
      for (int j = 0; j < 8; ++j) acc[i][j] = 0.f;
    const int ar = tid >> 2, ak = (tid & 3) * 4;
    const int bk = tid >> 5, bn = (tid & 31) * 4;
    for (int k0 = 0; k0 < K; k0 += TK) {
      const bf16_t* ap = A + (size_t)(tm * TM + ar) * lda + k0 + ak;
      const unsigned long long av = *(const unsigned long long*)ap;
      const f32x4 bv = *(const f32x4*)(Bm + (size_t)(k0 + bk) * ldb + tn * TN + bn);
      __syncthreads();
      As[(ak + 0) * LDA_S + ar] = bf2f((bf16_t)(av & 0xffff));
      As[(ak + 1) * LDA_S + ar] = bf2f((bf16_t)((av >> 16) & 0xffff));
      As[(ak + 2) * LDA_S + ar] = bf2f((bf16_t)((av >> 32) & 0xffff));
      As[(ak + 3) * LDA_S + ar] = bf2f((bf16_t)((av >> 48) & 0xffff));
      *(f32x4*)(Bs + bk * LDB_S + bn) = bv;
      __syncthreads();
#pragma unroll
      for (int k = 0; k < TK; ++k) {
        const f32x4 a4 = *(const f32x4*)(As + k * LDA_S + ty * 4);
        const f32x4 b0 = *(const f32x4*)(Bs + k * LDB_S + tx * 8);
        const f32x4 b1 = *(const f32x4*)(Bs + k * LDB_S + tx * 8 + 4);
#pragma unroll
        for (int i = 0; i < 4; ++i) {
          acc[i][0] += a4[i] * b0[0]; acc[i][1] += a4[i] * b0[1]; acc[i][2] += a4[i] * b0[2]; acc[i][3] += a4[i] * b0[3];
          acc[i][4] += a4[i] * b1[0]; acc[i][5] += a4[i] * b1[1]; acc[i][6] += a4[i] * b1[2]; acc[i][7] += a4[i] * b1[3];
        }
      }
    }
#pragma unroll
    for (int i = 0; i < 4; ++i)
#pragma unroll
      for (int j = 0; j < 8; ++j) epi(tm * TM + ty * 4 + i, tn * TN + tx * 8 + j, acc[i][j]);
  }
  __syncthreads();
}

namespace pg8 {
#define PG8_LAS __attribute__((address_space(3)))
typedef unsigned short bf16_t;
typedef short bf16x8 __attribute__((ext_vector_type(8)));
typedef float f32x4 __attribute__((ext_vector_type(4)));
typedef unsigned u32x4 __attribute__((ext_vector_type(4)));
constexpr int BM = 256, BK = 64, HALF = 128, HTB = HALF * BK * 2  , STAGE_BYTES = 8 * HTB, NXCD = 8, WGM = 8;

__host__ __device__ __forceinline__ int lds_byte(int r, int c) { const int st = (r >> 4) * 2 + (c >> 5), rr = r & 15, cc = c & 31, ob = rr * 64 + cc * 2; return st * 1024 + (ob ^ (((ob >> 9) & 1) << 5)); }
__host__ __device__ __forceinline__ void stage_rc(int b, int& R, int& C) { const int st = b / 1024, sb = b % 1024, swz = sb ^ (((sb >> 9) & 1) << 5); R = (st >> 1) * 16 + swz / 64; C = (st & 1) * 32 + (swz % 64) / 2; }
__host__ __device__ __forceinline__ int perm32(int rho) { const int n = rho >> 4, i = rho & 15; return 8 * (i >> 2) + 4 * n + (i & 3); }

struct Unit { int pm, pn; };
struct Gemm { const bf16_t* A; const bf16_t* Bt; int M, N, K; };

struct StaticOrder {
    int nM, nN, nwg, G, c;
    __host__ __device__ void init(int M, int N, int G_, int c_) { nM = M / BM; nN = N / BM; nwg = nM * nN; G = G_; c = c_; }
    __host__ __device__ bool next(int i, Unit& u) const {
        const long L = (long)i * G + c; if (L >= nwg) return false;
        int wgid = (int)L; { const int q = nwg / NXCD, r = nwg % NXCD, xcd = wgid % NXCD, off = wgid / NXCD; wgid = (xcd < r ? xcd * (q + 1) : r * (q + 1) + (xcd - r) * q) + off; }
        const int nig = WGM * nN, gid = wgid / nig, fm = gid * WGM, gsz = (nM - fm) < WGM ? (nM - fm) : WGM;
        u.pm = fm + ((wgid % nig) % gsz); u.pn = (wgid % nig) / gsz; return true;
    }
    __device__ __forceinline__ void a_ready(const Unit&) const {}
    __device__ __forceinline__ void done(const Unit&) const {}
};

__device__ __forceinline__ unsigned cvt_pk_bf16(float lo, float hi) { unsigned r; asm volatile("v_cvt_pk_bf16_f32 %0, %1, %2" : "=v"(r) : "v"(lo), "v"(hi)); return r; }
template <class Epi, class Sched, bool ALIGN_EPI = false, bool SP2 = false>
__device__ __forceinline__ void gemm_phase(PG8_LAS unsigned char* lds, const Gemm g, const Sched& S, const Epi& E) {
    const int tid = threadIdx.x, wid = __builtin_amdgcn_readfirstlane(tid >> 6), lane = tid & 63, wr = wid >> 2, wc = wid & 3, fr = lane & 15, fq = lane >> 4;
    const int K = g.K, nt = K / BK;
    unsigned voffA[2], voffB[2];
#pragma unroll
    for (int i = 0; i < 2; ++i) { int R, C; stage_rc(tid * 16 + i * 8192, R, C); const int Rb = Epi::PERM ? ((R & ~31) + perm32(R & 31)) : R;
        voffA[i] = (unsigned)(R * K + C) * 2u; voffB[i] = (unsigned)(Rb * K + C) * 2u; }
    const size_t kstep = (size_t)(BK * 2);
    const size_t hstep = (size_t)HALF * K * 2;
    const size_t tstep = 2 * hstep;
    const unsigned ldsw = (unsigned)wid * 1024u;
    const int aoff = lds_byte(wr * 64 + fr, fq * 8), boff = lds_byte(wc * 32 + fr, fq * 8);
#define PG8_SA(b, h) (((b) * 2 + (h)) * HTB)
#define PG8_SB(b, h) ((4 + (b) * 2 + (h)) * HTB)
#define PG8_STAGE(bufoff, gbase, voff) do { _Pragma("unroll") for (int _i = 0; _i < 2; ++_i) \
        __builtin_amdgcn_global_load_lds((const unsigned*)((const char*)(gbase) + (voff)[_i]), (PG8_LAS unsigned*)(lds + (bufoff) + ldsw + _i * 8192), 16, 0, 0); } while (0)
#define PG8_LDA(dst, b, h) do { _Pragma("unroll") for (int m = 0; m < 4; ++m) _Pragma("unroll") for (int k = 0; k < 2; ++k) dst[m][k] = *(const PG8_LAS bf16x8*)(lds + PG8_SA(b, h) + aoff + m * 2048 + k * 1024); } while (0)
#define PG8_LDB(dst, b, h) do { _Pragma("unroll") for (int n = 0; n < 2; ++n) _Pragma("unroll") for (int k = 0; k < 2; ++k) dst[n][k] = *(const PG8_LAS bf16x8*)(lds + PG8_SB(b, h) + boff + n * 2048 + k * 1024); } while (0)
#define PG8_MMA(ai, bj, At, Bt) do { __builtin_amdgcn_s_setprio(1); _Pragma("unroll") for (int m = 0; m < 4; ++m) _Pragma("unroll") for (int n = 0; n < 2; ++n) _Pragma("unroll") for (int k = 0; k < 2; ++k) \
        acc[ai][bj][m][n] = __builtin_amdgcn_mfma_f32_16x16x32_bf16(Bt[n][k], At[m][k], acc[ai][bj][m][n], 0, 0, 0); __builtin_amdgcn_s_setprio(0); } while (0)
#define PG8_WAIT_V(n) asm volatile("s_waitcnt vmcnt(" #n ")" ::: "memory")
#define PG8_WAIT_L(n) asm volatile("s_waitcnt lgkmcnt(" #n ")" ::: "memory")
#define PG8_BAR __builtin_amdgcn_s_barrier()
#define PG8_SCHED __builtin_amdgcn_sched_barrier(0)
    Unit cur, nxt; int ui = 0;
    if (!S.next(0, cur)) return;
    f32x4 acc[2][2][4][2];
#pragma unroll
    for (int a = 0; a < 2; ++a)
#pragma unroll
        for (int b = 0; b < 2; ++b)
#pragma unroll
            for (int m = 0; m < 4; ++m)
#pragma unroll
                for (int n = 0; n < 2; ++n) acc[a][b][m][n] = (f32x4){0.f, 0.f, 0.f, 0.f};
    bf16x8 At[4][2], B0[2][2], B1[2][2];
    const char* cA = (const char*)g.A + (size_t)cur.pm * tstep; const char* cB = (const char*)g.Bt + (size_t)cur.pn * tstep;
    S.a_ready(cur);
    if constexpr (SP2) {
        PG8_STAGE(PG8_SB(0, 0), cB, voffB); PG8_STAGE(PG8_SB(0, 1), cB + hstep, voffB); PG8_STAGE(PG8_SA(0, 0), cA, voffA); PG8_STAGE(PG8_SA(0, 1), cA + hstep, voffA);
        if (wr == 1) PG8_BAR;
        PG8_WAIT_V(2); PG8_BAR;
        PG8_STAGE(PG8_SB(1, 0), cB + kstep, voffB); PG8_STAGE(PG8_SA(1, 0), cA + kstep, voffA); PG8_STAGE(PG8_SB(1, 1), cB + hstep + kstep, voffB);
        PG8_WAIT_V(6); PG8_BAR;
    } else {
        PG8_STAGE(PG8_SB(0, 0), cB, voffB); PG8_STAGE(PG8_SA(0, 0), cA, voffA); PG8_STAGE(PG8_SB(0, 1), cB + hstep, voffB); PG8_STAGE(PG8_SA(0, 1), cA + hstep, voffA);
        if (wr == 1) PG8_BAR;
        PG8_WAIT_V(4); PG8_BAR;
        PG8_STAGE(PG8_SB(1, 0), cB + kstep, voffB); PG8_STAGE(PG8_SA(1, 0), cA + kstep, voffA); PG8_STAGE(PG8_SB(1, 1), cB + hstep + kstep, voffB);
        PG8_WAIT_V(6); PG8_BAR;
    }
    for (;;) {
        const bool has_next = S.next(ui + 1, nxt);
        const char* nA = has_next ? (const char*)g.A + (size_t)nxt.pm * tstep : cA; const char* nB = has_next ? (const char*)g.Bt + (size_t)nxt.pn * tstep : cB;
        for (int t = 0; t < nt; t += 2) {
            const bool last = (t == nt - 2);
            const char* a1 = cA + (size_t)(t + 1) * kstep;
            const char* a2 = last ? nA : cA + (size_t)(t + 2) * kstep; const char* b2 = last ? nB : cB + (size_t)(t + 2) * kstep;
            const char* a3 = a2 + kstep; const char* b3 = b2 + kstep;
            if (last && has_next) S.a_ready(nxt);
            if constexpr (SP2) {
            PG8_LDB(B0, 0, 0); PG8_LDB(B1, 0, 1); PG8_SCHED; PG8_LDA(At, 0, 0); PG8_STAGE(PG8_SA(1, 1), a1 + hstep, voffA);
            PG8_WAIT_V(8); PG8_WAIT_L(0); PG8_BAR; PG8_MMA(0, 0, At, B0); PG8_MMA(0, 1, At, B1); PG8_BAR; PG8_SCHED;
            PG8_LDA(At, 0, 1); PG8_STAGE(PG8_SB(0, 0), b2, voffB); PG8_STAGE(PG8_SB(0, 1), b2 + hstep, voffB); PG8_STAGE(PG8_SA(0, 0), a2, voffA);
            PG8_WAIT_V(8); PG8_WAIT_L(0); PG8_BAR; PG8_MMA(1, 0, At, B0); PG8_MMA(1, 1, At, B1); PG8_BAR; PG8_SCHED;
            PG8_LDB(B0, 1, 0); PG8_LDB(B1, 1, 1); PG8_SCHED; PG8_LDA(At, 1, 0); PG8_STAGE(PG8_SA(0, 1), a2 + hstep, voffA);
            PG8_WAIT_V(8); PG8_WAIT_L(0); PG8_BAR; PG8_MMA(0, 0, At, B0); PG8_MMA(0, 1, At, B1); PG8_BAR; PG8_SCHED;
            PG8_LDA(At, 1, 1); PG8_STAGE(PG8_SB(1, 0), b3, voffB); PG8_STAGE(PG8_SB(1, 1), b3 + hstep, voffB); PG8_STAGE(PG8_SA(1, 0), a3, voffA);
            PG8_WAIT_V(8); PG8_WAIT_L(0); PG8_BAR; PG8_MMA(1, 0, At, B0); PG8_MMA(1, 1, At, B1); PG8_BAR; PG8_SCHED;
            } else {
            PG8_LDB(B0, 0, 0); PG8_SCHED; PG8_LDA(At, 0, 0); PG8_STAGE(PG8_SA(1, 1), a1 + hstep, voffA);
            PG8_WAIT_L(8); PG8_BAR; PG8_WAIT_L(0); PG8_MMA(0, 0, At, B0); PG8_BAR; PG8_SCHED;
            PG8_LDB(B1, 0, 1); PG8_STAGE(PG8_SB(0, 0), b2, voffB);
            PG8_BAR; PG8_WAIT_L(0); PG8_MMA(0, 1, At, B1); PG8_BAR;
            PG8_LDA(At, 0, 1); PG8_STAGE(PG8_SA(0, 0), a2, voffA);
            PG8_BAR; PG8_WAIT_L(0); PG8_MMA(1, 0, At, B0); PG8_BAR; PG8_SCHED;
            PG8_STAGE(PG8_SB(0, 1), b2 + hstep, voffB);
            PG8_WAIT_V(6); PG8_BAR; PG8_MMA(1, 1, At, B1); PG8_BAR;
            PG8_LDB(B0, 1, 0); PG8_SCHED; PG8_LDA(At, 1, 0); PG8_STAGE(PG8_SA(0, 1), a2 + hstep, voffA);
            PG8_WAIT_L(8); PG8_BAR; PG8_WAIT_L(0); PG8_MMA(0, 0, At, B0); PG8_BAR; PG8_SCHED;
            PG8_LDB(B1, 1, 1); PG8_STAGE(PG8_SB(1, 0), b3, voffB);
            PG8_BAR; PG8_WAIT_L(0); PG8_MMA(0, 1, At, B1); PG8_BAR;
            PG8_LDA(At, 1, 1); PG8_STAGE(PG8_SA(1, 0), a3, voffA);
            PG8_BAR; PG8_WAIT_L(0); PG8_MMA(1, 0, At, B0); PG8_BAR; PG8_SCHED;
            PG8_STAGE(PG8_SB(1, 1), b3 + hstep, voffB);
            PG8_WAIT_V(6); PG8_BAR; PG8_MMA(1, 1, At, B1); PG8_BAR;
            }
        }
        if constexpr (ALIGN_EPI) { if (wr == 0) PG8_BAR; }
        if constexpr (!Epi::AFTER_DRAIN) { E(acc, cur, wr, wc, fr, fq); S.done(cur); }
        if (!has_next) break;
#pragma unroll
        for (int a = 0; a < 2; ++a)
#pragma unroll
            for (int b = 0; b < 2; ++b)
#pragma unroll
                for (int m = 0; m < 4; ++m)
#pragma unroll
                    for (int n = 0; n < 2; ++n) acc[a][b][m][n] = (f32x4){0.f, 0.f, 0.f, 0.f};
        cur = nxt; cA = nA; cB = nB; ++ui;
        if constexpr (ALIGN_EPI) { if (wr == 1) PG8_BAR; }
    }
    PG8_WAIT_V(0);
    if constexpr (!ALIGN_EPI) { if (wr == 0) PG8_BAR; }
    PG8_BAR;
    if constexpr (Epi::AFTER_DRAIN) { E.fused(acc, cur, wr, wc, fr, fq, lds, wid, lane); S.done(cur); }
#undef PG8_SA
#undef PG8_SB
#undef PG8_STAGE
#undef PG8_LDA
#undef PG8_LDB
#undef PG8_MMA
#undef PG8_WAIT_V
#undef PG8_WAIT_L
#undef PG8_BAR
#undef PG8_SCHED
}
}


using pg8::Unit;
typedef unsigned u32x2 __attribute__((ext_vector_type(2)));
typedef unsigned u32x4 __attribute__((ext_vector_type(4)));
__device__ __forceinline__ float bflo(unsigned w) { return __uint_as_float(w << 16); }
__device__ __forceinline__ float bfhi(unsigned w) { return __uint_as_float(w & 0xffff0000u); }

struct InProjSched {
  pg8::StaticOrder so;
  __device__ __forceinline__ void init(int G, int c) { so.init(MX, N_IN, G, c); }
  __device__ __forceinline__ bool next(int i, Unit& u) const {
    const long Lx = (long)i * so.G + so.c;
    if (Lx < so.nwg) return so.next(i, u);
    const int j = (int)(Lx - so.nwg); if (j >= 40) return false;
    u.pm = 64 + (j & 3); u.pn = 4 + (j >> 2); return true;
  }
  __device__ __forceinline__ void a_ready(const Unit&) const {}
  __device__ __forceinline__ void done(const Unit&) const {}
};

struct EpiInProj {
  static constexpr bool PERM = false, AFTER_DRAIN = false;
  bf16_t *Q, *K, *V, *U, *G; const float* rope;
  __device__ __forceinline__ static void st4(bf16_t* p, const f32x4 v) { u32x2 w; w.x = pg8::cvt_pk_bf16(v[0], v[1]); w.y = pg8::cvt_pk_bf16(v[2], v[3]); *(u32x2*)p = w; }
  __device__ __forceinline__ void operator()(const f32x4 (&acc)[2][2][4][2], const Unit& u, int wr, int wc, int fr, int fq) const {
    const int row0 = u.pm * 256 + wr * 64 + fr;
    const int cg0 = u.pn * 256 + wc * 32 + fq * 4;
    if (u.pm < 64) {
      if (u.pn < 8) {
        const bool isq = u.pn < 4;
#pragma unroll
        for (int ai = 0; ai < 2; ++ai)
#pragma unroll
          for (int m = 0; m < 4; ++m) {
            const int row = row0 + ai * 128 + m * 16, b = row >> 12, t = row & 4095;
            const int pos = (wc & 1) ? (t & 63) : (t >> 6);
            const f32x4* rp = (const f32x4*)(rope + (pos * 16 + fq * 4) * 2);
            const f32x4 r0 = rp[0], r1 = rp[1];
            const f32x4 cs = {r0[0], r0[2], r1[0], r1[2]}, sn = {r0[1], r0[3], r1[1], r1[3]};
            bf16_t* dst = isq ? Q + (size_t)row * 1024 + cg0 : K + ((size_t)b * LA + NCTX + t) * 1024 + (cg0 - 1024);
#pragma unroll
            for (int bj = 0; bj < 2; ++bj) {
              const f32x4 h1 = acc[ai][bj][m][0], h2 = acc[ai][bj][m][1];
              st4(dst + bj * 128, h1 * cs - h2 * sn);
              st4(dst + bj * 128 + 16, h2 * cs + h1 * sn);
            }
          }
      } else {
#pragma unroll
        for (int ai = 0; ai < 2; ++ai)
#pragma unroll
          for (int m = 0; m < 4; ++m) {
            const int row = row0 + ai * 128 + m * 16, b = row >> 12, t = row & 4095;
            const size_t kr = (size_t)b * LA + NCTX + t;
            bf16_t* dst = u.pn < 12 ? V + kr * 1024 + (cg0 - 2048) : (u.pn < 14 ? U + kr * 512 + (cg0 - 3072) : G + (size_t)row * 2048 + (cg0 - 3584));
#pragma unroll
            for (int bj = 0; bj < 2; ++bj)
#pragma unroll
              for (int n = 0; n < 2; ++n) {
                f32x4 v = acc[ai][bj][m][n];
                if (u.pn >= 14) { v[0] = sigmoidf_(v[0]); v[1] = sigmoidf_(v[1]); v[2] = sigmoidf_(v[2]); v[3] = sigmoidf_(v[3]); }
                st4(dst + bj * 128 + n * 16, v);
              }
          }
      }
    } else {
#pragma unroll
      for (int ai = 0; ai < 2; ++ai)
#pragma unroll
        for (int m = 0; m < 4; ++m) {
          const int rc = row0 + ai * 128 + m * 16 - MX, b = rc >> 8, t = rc & 255;
          const size_t kr = (size_t)b * LA + t;
          bf16_t* dst = u.pn < 8 ? K + kr * 1024 + (cg0 - 1024) : (u.pn < 12 ? V + kr * 1024 + (cg0 - 2048) : U + kr * 512 + (cg0 - 3072));
#pragma unroll
          for (int bj = 0; bj < 2; ++bj)
#pragma unroll
            for (int n = 0; n < 2; ++n) st4(dst + bj * 128 + n * 16, acc[ai][bj][m][n]);
        }
    }
  }
};
template <int MODE>
struct EpiBf8 {
  static constexpr bool PERM = true, AFTER_DRAIN = false;
  bf16_t* O; int ldo; const bf16_t* X; int ldx; const float* bias;
  __device__ __forceinline__ void operator()(const f32x4 (&acc)[2][2][4][2], const Unit& u, int wr, int wc, int fr, int fq) const {
    const int row0 = u.pm * 256 + wr * 64 + fr, col0 = u.pn * 256 + wc * 32 + 8 * fq;
#pragma unroll
    for (int ai = 0; ai < 2; ++ai)
#pragma unroll
      for (int m = 0; m < 4; ++m) {
        const int row = row0 + ai * 128 + m * 16;
#pragma unroll
        for (int bj = 0; bj < 2; ++bj) {
          const int col = col0 + bj * 128;
          f32x4 v0 = acc[ai][bj][m][0], v1 = acc[ai][bj][m][1];
          const u32x4 xw = *(const u32x4*)(X + (size_t)row * ldx + col);
          const f32x4 x0 = {bflo(xw.x), bfhi(xw.x), bflo(xw.y), bfhi(xw.y)}, x1 = {bflo(xw.z), bfhi(xw.z), bflo(xw.w), bfhi(xw.w)};
          if (MODE == 0) {
            const f32x4 b0 = *(const f32x4*)(bias + col), b1 = *(const f32x4*)(bias + col + 4);
#pragma unroll
            for (int i = 0; i < 4; ++i) { v0[i] = x0[i] * sigmoidf_(v0[i] + b0[i]); v1[i] = x1[i] * sigmoidf_(v1[i] + b1[i]); }
          } else if (MODE == 1) { v0 = v0 * x0; v1 = v1 * x1; }
          else {
            const u32x4 ow = *(const u32x4*)(O + (size_t)row * ldo + col);
            const f32x4 o0 = {bflo(ow.x), bfhi(ow.x), bflo(ow.y), bfhi(ow.y)}, o1 = {bflo(ow.z), bfhi(ow.z), bflo(ow.w), bfhi(ow.w)};
            v0 = o0 + v0 * x0; v1 = o1 + v1 * x1;
          }
          u32x4 w; w.x = pg8::cvt_pk_bf16(v0[0], v0[1]); w.y = pg8::cvt_pk_bf16(v0[2], v0[3]); w.z = pg8::cvt_pk_bf16(v1[0], v1[1]); w.w = pg8::cvt_pk_bf16(v1[2], v1[3]);
          *(u32x4*)(O + (size_t)row * ldo + col) = w;
        }
      }
  }
};
template <int MODE>
struct EpiF32 {
  static constexpr bool PERM = false, AFTER_DRAIN = false;
  float* O; const float* xres; const float* mod;
  __device__ __forceinline__ void operator()(const f32x4 (&acc)[2][2][4][2], const Unit& u, int wr, int wc, int fr, int fq) const {
    const int row0 = u.pm * 256 + wr * 64 + fr, col0 = u.pn * 256 + wc * 32 + 4 * fq;
#pragma unroll
    for (int ai = 0; ai < 2; ++ai)
#pragma unroll
      for (int m = 0; m < 4; ++m) {
        const int row = row0 + ai * 128 + m * 16;
#pragma unroll
        for (int bj = 0; bj < 2; ++bj)
#pragma unroll
          for (int n = 0; n < 2; ++n) {
            const int col = col0 + bj * 128 + n * 16;
            f32x4 v = acc[ai][bj][m][n];
            if (MODE == 1) { const f32x4 xr = *(const f32x4*)(xres + (size_t)row * 1024 + col); const f32x4 g = *(const f32x4*)(mod + (row >> 12) * 6144 + 2048 + col); v = xr + g * v; }
            *(f32x4*)(O + (size_t)row * 1024 + col) = v;
          }
      }
  }
};

__device__ __forceinline__ void transpose_item(const float* W, int K, int N, bf16_t* WT, float* scr, int item, int lane) {
  const int nblk = N / 32, kb = item / nblk, nb = item % nblk, k0 = 64 * kb, n0 = 32 * nb;
#pragma unroll 8
  for (int i = 0; i < 32; ++i) { const int kk = 2 * i + (lane >> 5); scr[kk * 33 + (lane & 31)] = W[(size_t)(k0 + kk) * N + n0 + (lane & 31)]; }
  asm volatile("s_waitcnt lgkmcnt(0)" ::: "memory");
  const int c = lane & 7;
#pragma unroll
  for (int j = 0; j < 4; ++j) {
    const int n = (lane >> 3) + 8 * j; const float* s = scr + (8 * c) * 33 + n;
    u32x4 o; o.x = pg8::cvt_pk_bf16(s[0], s[33]); o.y = pg8::cvt_pk_bf16(s[66], s[99]); o.z = pg8::cvt_pk_bf16(s[132], s[165]); o.w = pg8::cvt_pk_bf16(s[198], s[231]);
    *(u32x4*)(WT + (size_t)(n0 + n) * K + k0 + 8 * c) = o;
  }
  asm volatile("s_waitcnt lgkmcnt(0)" ::: "memory");
}

namespace att {
using bf16 = unsigned short;
constexpr int   D = 128, NW = 8, QBLK = 32, KVBLK = 64, SDEPTH = 1;
constexpr float SCALE = 0.125f;
constexpr float THR = 8.f;
constexpr int LDQ = 1024, LDK = 1024, LDO = 1024;
constexpr size_t SHM_V = KVBLK * D * 2, SHM_K = KVBLK * D * 2, SHM_ATTN = 2 * SHM_V + 2 * SHM_K + NW * 64 * 4 + 4 * 4 * 16 * 64 * 4;
using bf16x8 = __attribute__((ext_vector_type(8))) short;
using s16x4  = __attribute__((ext_vector_type(4))) short;
using f32x16 = __attribute__((ext_vector_type(16))) float;
using f32x8  = __attribute__((ext_vector_type(8))) float;
using u32x4  = __attribute__((ext_vector_type(4))) unsigned;
#define KSWZ(row, colB) ((row) * 256 + ((colB) ^ (((row) & 7) << 4)))
#define SBAR() __builtin_amdgcn_sched_barrier(0)
__device__ __forceinline__ int crow(int r, int hi) { return (r & 3) + 8 * (r >> 2) + 4 * hi; }
__device__ __forceinline__ unsigned cvtpk(float lo, float hi) {
  unsigned r; asm volatile("v_cvt_pk_bf16_f32 %0, %1, %2" : "=v"(r) : "v"(lo), "v"(hi)); return r;
}
template <typename TIn> struct Stage;
template <> struct Stage<bf16>  { using T = bf16x8;
  __device__ static __forceinline__ T ld8(const bf16* p) { return *reinterpret_cast<const bf16x8*>(p); }
  __device__ static __forceinline__ bf16x8 tobf(T x) { return x; } };
__device__ __forceinline__ void partialSM(f32x16& p0, f32x16& p1, float& m_reg, float& mn, float& alpha) {
  constexpr float C = SCALE * 1.4426950408889634f;
  float pmax = p0[0]; for (int r = 1; r < 16; ++r) pmax = fmaxf(pmax, p0[r]); for (int r = 0; r < 16; ++r) pmax = fmaxf(pmax, p1[r]);
  { auto rr = __builtin_amdgcn_permlane32_swap(__float_as_uint(pmax), __float_as_uint(pmax), false, false);
    pmax = fmaxf(__uint_as_float(rr[0]), __uint_as_float(rr[1])); }
  if (__builtin_expect(__all(pmax - m_reg <= THR / SCALE), 1)) { mn = m_reg; alpha = 1.f; }
  else { mn = fmaxf(m_reg, pmax); alpha = __builtin_amdgcn_exp2f((m_reg - mn) * C); m_reg = mn; }
  float mnC = -mn * C;
  for (int r = 0; r < 16; ++r) p0[r] = fmaf(p0[r], C, mnC); for (int r = 0; r < 16; ++r) p1[r] = fmaf(p1[r], C, mnC);
  for (int r = 0; r < 16; ++r) p0[r] = __builtin_amdgcn_exp2f(p0[r]);
}
__device__ __forceinline__ void finishSM(f32x16& p0, f32x16& p1, float alpha, float& l_reg, bf16x8& pa0, bf16x8& pa1, bf16x8& pa2, bf16x8& pa3) {
  for (int r = 0; r < 16; ++r) p1[r] = __builtin_amdgcn_exp2f(p1[r]);
  float ps = 0; for (int r = 0; r < 16; ++r) ps += p0[r]; for (int r = 0; r < 16; ++r) ps += p1[r];
  { auto rr = __builtin_amdgcn_permlane32_swap(__float_as_uint(ps), __float_as_uint(ps), false, false);
    ps = __uint_as_float(rr[0]) + __uint_as_float(rr[1]); }
  l_reg = l_reg * alpha + ps;
#define PK4(P, BASE, OUT) do { unsigned a0 = cvtpk(P[BASE + 0], P[BASE + 1]), a1 = cvtpk(P[BASE + 2], P[BASE + 3]);   \
    unsigned b0 = cvtpk(P[BASE + 4], P[BASE + 5]), b1 = cvtpk(P[BASE + 6], P[BASE + 7]);                              \
    auto r0 = __builtin_amdgcn_permlane32_swap(a0, b0, false, false); auto r1 = __builtin_amdgcn_permlane32_swap(a1, b1, false, false); \
    u32x4 w = {r0[0], r1[0], r0[1], r1[1]}; OUT = *reinterpret_cast<bf16x8*>(&w); } while (0)
  PK4(p0, 0, pa0); PK4(p0, 8, pa1); PK4(p1, 0, pa2); PK4(p1, 8, pa3);
#undef PK4
}
__device__ __forceinline__ void qkt(f32x16& p0, f32x16& p1, const bf16* Ks, const bf16x8* qr, int r32, int hi, int mcolB) {
  p0 = f32x16{}; p1 = f32x16{};
#pragma unroll
  for (int d0 = 0; d0 < 4; ++d0) { int cb = mcolB + (d0 * 16 + hi * 8) * 2;
    bf16x8 b0 = *reinterpret_cast<const bf16x8*>((const char*)Ks + KSWZ(r32, cb));
    bf16x8 b1 = *reinterpret_cast<const bf16x8*>((const char*)Ks + KSWZ(32 + r32, cb));
    p0 = __builtin_amdgcn_mfma_f32_32x32x16_bf16(b0, qr[d0], p0, 0, 0, 0);
    p1 = __builtin_amdgcn_mfma_f32_32x32x16_bf16(b1, qr[d0], p1, 0, 0, 0); }
}
__device__ __forceinline__ int v_st(int k, int c) { const int kk = (k & ~0xC) | ((k & 4) << 1) | ((k & 8) >> 1); return ((kk >> 3) * 4 + (c >> 5)) * 512 + ((kk & 7) * 32 + (c & 31)) * 2; }
__device__ __forceinline__ int v_rd_base(int lane) { return ((lane & 3) << 3) | (((lane >> 2) & 3) << 6) | (((lane >> 4) & 1) << 5) | (((lane >> 5) & 1) << 8); }
constexpr int v_rd_off(int d0, int ks, int half) { return d0 * 512 + ks * 4096 + half * 2048; }
template <int OFF> __device__ __forceinline__ s16x4 tr_read(int vb) {
  s16x4 r; asm volatile("ds_read_b64_tr_b16 %0, %1 offset:%2" : "=&v"(r) : "v"(vb), "i"(OFF) : "memory"); return r;
}
template <int D0> __device__ __forceinline__ void pv_one(f32x16& od, int vb, bf16x8 pa0, bf16x8 pa1, bf16x8 pa2, bf16x8 pa3) {
  const s16x4 l0 = tr_read<v_rd_off(D0, 0, 0)>(vb), h0 = tr_read<v_rd_off(D0, 0, 1)>(vb), l1 = tr_read<v_rd_off(D0, 1, 0)>(vb), h1 = tr_read<v_rd_off(D0, 1, 1)>(vb);
  const s16x4 l2 = tr_read<v_rd_off(D0, 2, 0)>(vb), h2 = tr_read<v_rd_off(D0, 2, 1)>(vb), l3 = tr_read<v_rd_off(D0, 3, 0)>(vb), h3 = tr_read<v_rd_off(D0, 3, 1)>(vb);
  asm volatile("s_waitcnt lgkmcnt(0)" ::: "memory"); SBAR();
#define PK(L, H) (bf16x8){L[0], L[1], L[2], L[3], H[0], H[1], H[2], H[3]}
  od = __builtin_amdgcn_mfma_f32_32x32x16_bf16(pa0, PK(l0, h0), od, 0, 0, 0);
  od = __builtin_amdgcn_mfma_f32_32x32x16_bf16(pa1, PK(l1, h1), od, 0, 0, 0);
  od = __builtin_amdgcn_mfma_f32_32x32x16_bf16(pa2, PK(l2, h2), od, 0, 0, 0);
  od = __builtin_amdgcn_mfma_f32_32x32x16_bf16(pa3, PK(l3, h3), od, 0, 0, 0);
#undef PK
}
__device__ __forceinline__ void pv_d0(f32x16* o, int vb, bf16x8 pa0, bf16x8 pa1, bf16x8 pa2, bf16x8 pa3) {
  pv_one<0>(o[0], vb, pa0, pa1, pa2, pa3); pv_one<1>(o[1], vb, pa0, pa1, pa2, pa3); pv_one<2>(o[2], vb, pa0, pa1, pa2, pa3); pv_one<3>(o[3], vb, pa0, pa1, pa2, pa3);
}

__device__ __forceinline__ void diff_attn_unit(const bf16* __restrict__ Qb, const bf16* __restrict__ Kh, const bf16* __restrict__ Vh,
                                               bf16* __restrict__ Ob, int seq, float lam, const float* __restrict__ subln, char* lds) {
  using St = Stage<bf16>;
  const int tid = threadIdx.x, wid = tid >> 6, lane = tid & 63, r32 = lane & 31, hi = lane >> 5;
  bf16* V_lds = (bf16*)lds; bf16* K_lds = (bf16*)(lds + 2 * SHM_V);
  float* ws = (float*)(lds + 2 * SHM_V + 2 * SHM_K) + wid * 64; float* li_l = ws; float* al_l = ws + 32;
  float m_reg = -1e30f, l_reg = 0; f32x16 o[4] = {}; bf16x8 qr[4];
  const int mw = wid >> 2, wq = wid & 3, mcolB = mw * 128;
  const bf16* Qw = Qb + (long)(wq * QBLK + r32) * LDQ + mw * 64 + hi * 8;
#pragma unroll
  for (int d0 = 0; d0 < 4; ++d0) qr[d0] = St::ld8(Qw + d0 * 16);
  const int sr = tid >> 4, sc = (tid & 15) * 8, vst0 = v_st(sr, sc), vst1 = v_st(32 + sr, sc);
  const int vb0 = (int)(uintptr_t)V_lds + v_rd_base(lane);
  struct { typename St::T vs0, vs1, ks0, ks1; } sr_[SDEPTH];
#define SLOAD(i, k0) do { sr_[i].vs0 = St::ld8(&Vh[(long)((k0) + sr) * LDK + sc]); sr_[i].vs1 = St::ld8(&Vh[(long)((k0) + 32 + sr) * LDK + sc]); \
    sr_[i].ks0 = St::ld8(&Kh[(long)((k0) + sr) * LDK + sc]); sr_[i].ks1 = St::ld8(&Kh[(long)((k0) + 32 + sr) * LDK + sc]); } while (0)
#define SWRITE(b, i) do { *(bf16x8*)((char*)V_lds + (b) * SHM_V + vst0) = St::tobf(sr_[i].vs0);          \
    *(bf16x8*)((char*)V_lds + (b) * SHM_V + vst1) = St::tobf(sr_[i].vs1); int kc = sc * 2;               \
    *(bf16x8*)((char*)K_lds + (b) * SHM_K + KSWZ(sr, kc)) = St::tobf(sr_[i].ks0);                       \
    *(bf16x8*)((char*)K_lds + (b) * SHM_K + KSWZ(32 + sr, kc)) = St::tobf(sr_[i].ks1); } while (0)
#define SWAIT() do { if constexpr (SDEPTH == 2) asm volatile("s_waitcnt vmcnt(4)" ::: "memory"); else asm volatile("s_waitcnt vmcnt(0)" ::: "memory"); } while (0)
#define RESC(a) do { if (__any((a) < 1.f)) { if (hi == 0) al_l[r32] = (a); asm volatile("s_waitcnt lgkmcnt(0)" ::: "memory"); \
    for (int d = 0; d < 4; ++d) for (int r = 0; r < 16; ++r) o[d][r] *= al_l[crow(r, hi)]; } } while (0)
  f32x16 pA0, pA1, pB0, pB1; float mnA, mnB, alA, alB; bf16x8 pa0, pa1, pa2, pa3; const int NT = seq / KVBLK;
  constexpr int SE = 0, SO = SDEPTH - 1;
  SLOAD(SE, 0); asm volatile("s_waitcnt vmcnt(0)" ::: "memory"); SWRITE(0, SE); __syncthreads();
  qkt(pA0, pA1, K_lds, qr, r32, hi, mcolB); partialSM(pA0, pA1, m_reg, mnA, alA);
  SLOAD(SO, KVBLK); if constexpr (SDEPTH == 2) { if (2 < NT) SLOAD(SE, 2 * KVBLK); }
  SWAIT(); SWRITE(1, SO); __syncthreads();
  for (int j = 1; j + 1 < NT; j += 2) {
    SBAR(); qkt(pB0, pB1, (bf16*)((char*)K_lds + SHM_K), qr, r32, hi, mcolB);
    finishSM(pA0, pA1, alA, l_reg, pa0, pa1, pa2, pa3); SBAR();
    SLOAD(SO, (j + SDEPTH) * KVBLK); SBAR();
    pv_d0(o, vb0, pa0, pa1, pa2, pa3); partialSM(pB0, pB1, m_reg, mnB, alB);
    __syncthreads(); SWAIT(); SWRITE(0, SE);
    RESC(alB); __syncthreads();
    SBAR(); qkt(pA0, pA1, K_lds, qr, r32, hi, mcolB);
    finishSM(pB0, pB1, alB, l_reg, pa0, pa1, pa2, pa3); SBAR();
    if (SDEPTH == 1 || j + 3 < NT) SLOAD(SE, (j + 1 + SDEPTH) * KVBLK); SBAR();
    pv_d0(o, vb0 + (int)SHM_V, pa0, pa1, pa2, pa3); partialSM(pA0, pA1, m_reg, mnA, alA);
    __syncthreads(); SWAIT(); SWRITE(1, SO);
    RESC(alA); __syncthreads();
  }
  SBAR(); qkt(pB0, pB1, (bf16*)((char*)K_lds + SHM_K), qr, r32, hi, mcolB);
  finishSM(pA0, pA1, alA, l_reg, pa0, pa1, pa2, pa3); SBAR();
  pv_d0(o, vb0, pa0, pa1, pa2, pa3); partialSM(pB0, pB1, m_reg, mnB, alB);
  __syncthreads(); RESC(alB);
  finishSM(pB0, pB1, alB, l_reg, pa0, pa1, pa2, pa3); SBAR();
  pv_d0(o, vb0 + (int)SHM_V, pa0, pa1, pa2, pa3);
  if (hi == 0) li_l[r32] = l_reg; asm volatile("s_waitcnt lgkmcnt(0)" ::: "memory");
  float rli[16];
#pragma unroll
  for (int r = 0; r < 16; ++r) rli[r] = __builtin_amdgcn_rcpf(li_l[crow(r, hi)]);
  float* EXO = (float*)(lds + 2 * SHM_V + 2 * SHM_K + NW * 64 * 4) + wq * (4 * 16 * 64) + lane;
  if (mw == 1) {
#pragma unroll
    for (int d0 = 0; d0 < 4; ++d0)
#pragma unroll
      for (int r = 0; r < 16; ++r) EXO[(d0 * 16 + r) * 64] = o[d0][r] * rli[r];
  }
  __syncthreads();
  if (mw == 0) {
    float ssq[16];
#pragma unroll
    for (int r = 0; r < 16; ++r) ssq[r] = 0.f;
#pragma unroll
    for (int d0 = 0; d0 < 4; ++d0)
#pragma unroll
      for (int r = 0; r < 16; ++r) { const float dv = o[d0][r] * rli[r] - lam * EXO[(d0 * 16 + r) * 64]; o[d0][r] = dv; ssq[r] += dv * dv; }
#pragma unroll
    for (int r = 0; r < 16; ++r) {
#pragma unroll
      for (int sft = 1; sft < 32; sft <<= 1) ssq[r] += __shfl_xor(ssq[r], sft);
      ssq[r] = rsqrtf(ssq[r] * (1.f / 128.f) + 1e-6f) * 0.8f;
    }
    bf16* Ow = Ob + (long)(wq * QBLK) * LDO;
#pragma unroll
    for (int d0 = 0; d0 < 4; ++d0) { const float gg = subln[d0 * 32 + r32];
#pragma unroll
      for (int r = 0; r < 16; ++r) { const float val = o[d0][r] * ssq[r] * gg; Ow[(long)crow(r, hi) * LDO + d0 * 32 + r32] = (bf16)(pg8::cvt_pk_bf16(val, val) & 0xffffu); } }
  }
  __syncthreads();
#undef SLOAD
#undef SWRITE
#undef SWAIT
#undef RESC
}
}

__device__ __forceinline__ void wave_argmax(float& v, int& i) {
#pragma unroll
  for (int o = 32; o; o >>= 1) {
    const float ov = __shfl_xor(v, o); const int oi = __shfl_xor(i, o);
    if (ov > v || (ov == v && oi < i)) { v = ov; i = oi; }
  }
}

__global__ void __launch_bounds__(NT) mega(Params p) {
  extern __shared__ __attribute__((aligned(16))) unsigned char lds[];
  cg::grid_group grid = cg::this_grid();
  if (threadIdx.x < 35) {
    unsigned long long v = threadIdx.x < 33 ? (unsigned long long)p.in[threadIdx.x] : (threadIdx.x == 33 ? (unsigned long long)p.out : (unsigned long long)p.ws);
    ((unsigned long long*)(lds + PTR_OFF))[threadIdx.x] = v;
  }
  __syncthreads();

  {
    PHASE_LOCALS
    float* MOD = (float*)WSP(WS_MOD); float* LAM = (float*)WSP(WS_LAM);
    float* ABRE = (float*)WSP(WS_ABRE); float* ABIM = (float*)WSP(WS_ABIM); float* BBRE = (float*)WSP(WS_BBRE); float* BBIM = (float*)WSP(WS_BBIM);
    const float* cin = INP(1); const float* c_ctx = INP(3); const float* ada_w = INP(4); const float* ada_b = INP(5);
    for (int it = gtid; it < 5 * 6144; it += gsz) {
      const int r = it / 6144, j = it % 6144;
      const float* cv = r < 4 ? cin + r * D : c_ctx;
      float a = 0.f;
      for (int k = 0; k < D; ++k) a += siluf_(cv[k]) * ada_w[(size_t)k * 6144 + j];
      MOD[it] = a + ada_b[j];
    }
    if (gtid == 0) {
      const float* q1 = INP(9); const float* k1 = INP(10); const float* q2 = INP(11); const float* k2 = INP(12);
      float s1 = 0.f, s2 = 0.f;
      for (int k = 0; k < 64; ++k) { s1 += q1[k] * k1[k]; s2 += q2[k] * k2[k]; }
      LAM[0] = expf(s1) - expf(s2) + 0.2f;
    }
    const float* a_re = INP(15); const float* a_im = INP(16); const float* ldt = INP(17); const float* b_re = INP(18); const float* b_im = INP(19);
    for (int it = gtid; it < 2 * 32 * 64; it += gsz) {
      const int dg = it >> 6;
      const float ar = a_re[it], ai = a_im[it], dt = expf(ldt[dg]);
      const float mag = expf(ar * dt), abr = mag * cosf(ai * dt), abi = mag * sinf(ai * dt);
      ABRE[it] = abr; ABIM[it] = abi;
      const float den = ar * ar + ai * ai, nr = abr - 1.f, ni = abi;
      const float fr = (nr * ar + ni * ai) / den, fi = (ni * ar - nr * ai) / den;
      for (int pp = 0; pp < 16; ++pp) {
        const float br = b_re[it * 16 + pp], bi = b_im[it * 16 + pp];
        BBRE[it * 16 + pp] = fr * br - fi * bi; BBIM[it * 16 + pp] = fr * bi + fi * br;
      }
    }
    float* ROPE = (float*)WSP(WS_ROPE);
    for (int it = gtid; it < 64 * 16; it += gsz) {
      const float ang = (float)(it >> 4) * powf(10000.f, -(float)(it & 15) / 16.f);
      ROPE[it * 2] = cosf(ang); ROPE[it * 2 + 1] = sinf(ang);
    }
    {
      float* scr = fl + wid * (64 * 33);
      constexpr int I_IN = 16 * 176, I_AU = 16 * 32, I_SU = 8 * 32, I_OUT = 16 * 32, I_Q = 16 * 32, I_GLU = 8 * 16;
      for (int it = gw; it < I_IN + I_AU + I_SU + I_OUT + I_Q + I_GLU; it += ngw) {
        int r = it;
        if (r < I_IN) { transpose_item(INP(8), 1024, N_IN, (bf16_t*)WSP(WS_WIN), scr, r, lane); continue; } r -= I_IN;
        if (r < I_AU) { transpose_item(INP(14), 1024, 1024, (bf16_t*)WSP(WS_WAU), scr, r, lane); continue; } r -= I_AU;
        if (r < I_SU) { transpose_item(INP(25), 512, 1024, (bf16_t*)WSP(WS_WSU), scr, r, lane); continue; } r -= I_SU;
        if (r < I_OUT) { transpose_item(INP(26), 1024, 1024, (bf16_t*)WSP(WS_WOUT), scr, r, lane); continue; } r -= I_OUT;
        if (r < I_Q) { transpose_item(INP(27), 1024, 1024, (bf16_t*)WSP(WS_WQ), scr, r, lane); continue; } r -= I_Q;
        transpose_item(INP(23), 512, 512, (bf16_t*)WSP(WS_WGLU), scr, r, lane);
      }
    }
  }
  grid.sync();

  {
    PHASE_LOCALS
    const float* MOD = (const float*)WSP(WS_MOD); bf16_t* XN = (bf16_t*)WSP(WS_XN);
    const float* x = INP(0); const float* ctx = INP(2); const float* norm1_g = INP(6);
    for (int row = gw; row < MX + MC; row += ngw) {
      const float* src; const float* md;
      if (row < MX) { src = x + (size_t)row * D; md = MOD + (row / L) * 6144; } else { src = ctx + (size_t)(row - MX) * D; md = MOD + 4 * 6144; }
      f32x4 v[4]; float ss = 0.f;
#pragma unroll
      for (int j = 0; j < 4; ++j) { v[j] = *(const f32x4*)(src + lane * 4 + 256 * j); ss += v[j][0] * v[j][0] + v[j][1] * v[j][1] + v[j][2] * v[j][2] + v[j][3] * v[j][3]; }
      const float rstd = rsqrtf(wave_sum(ss) * (1.f / D) + 1e-6f);
#pragma unroll
      for (int j = 0; j < 4; ++j)
#pragma unroll
        for (int e = 0; e < 4; ++e) { const int col = lane * 4 + 256 * j + e; XN[(size_t)row * D + col] = f2bf(v[j][e] * rstd * norm1_g[col] * (1.f + md[1024 + col]) + md[col]); }
    }
  }
  grid.sync();

  {
    pg8::Gemm g{(const bf16_t*)WSP(WS_XN), (const bf16_t*)WSP(WS_WIN), MX + MC, N_IN, D};
    InProjSched S; S.init((int)gridDim.x, (int)blockIdx.x);
    EpiInProj E{(bf16_t*)WSP(WS_Q), (bf16_t*)WSP(WS_K), (bf16_t*)WSP(WS_V), (bf16_t*)WSP(WS_U), (bf16_t*)WSP(WS_G), (const float*)WSP(WS_ROPE)};
    pg8::gemm_phase<EpiInProj, InProjSched, true, true>((PG8_LAS unsigned char*)lds, g, S, E);
  }
  grid.sync();

  {
    const float lam = ((const float*)WSP(WS_LAM))[0];
    const bf16_t* Qb = (const bf16_t*)WSP(WS_Q); const bf16_t* Kb = (const bf16_t*)WSP(WS_K); const bf16_t* Vb = (const bf16_t*)WSP(WS_V);
    bf16_t* ATT = (bf16_t*)WSP(WS_ATT); const float* subln = INP(13);
    for (int unit = blockIdx.x; unit < Bn * 8 * (L / 128); unit += gridDim.x) {
      const int h = unit & 7, qb = (unit >> 3) & 31, b = unit >> 8;
      const size_t qoff = ((size_t)(b * L + qb * 128)) * 1024 + h * 128, koff = (size_t)b * LA * 1024 + h * 128;
      att::diff_attn_unit(Qb + qoff, Kb + koff, Vb + koff, ATT + qoff, LA, lam, subln, (char*)lds);
    }
  }
  grid.sync();

  {
    PHASE_LOCALS
    const float* ABRE = (const float*)WSP(WS_ABRE); const float* ABIM = (const float*)WSP(WS_ABIM);
    const float* BBRE = (const float*)WSP(WS_BBRE); const float* BBIM = (const float*)WSP(WS_BBIM);
    const bf16_t* Ub = (const bf16_t*)WSP(WS_U); float* YS = (float*)WSP(WS_YS);
    const float* c_re = INP(20); const float* c_im = INP(21);
    for (int it = gw; it < Bn * 32 * 2; it += ngw) {
      const int d = it & 1, g = (it >> 1) & 31, b = it >> 6;
      const int sidx = (d * 32 + g) * 64 + lane;
      const float abr = ABRE[sidx], abi = ABIM[sidx];
      float bre[16], bim[16], cre[16], cim[16];
#pragma unroll
      for (int pp = 0; pp < 16; ++pp) {
        bre[pp] = BBRE[sidx * 16 + pp]; bim[pp] = BBIM[sidx * 16 + pp];
        cre[pp] = c_re[((d * 32 + g) * 16 + pp) * 64 + lane]; cim[pp] = c_im[((d * 32 + g) * 16 + pp) * 64 + lane];
      }
      float hr = 0.f, hi = 0.f;
      float* ys = YS + (size_t)d * MX * 512;
      for (int s = 0; s < LA; ++s) {
        const bool isx = s >= NCTX;
        int tok;
        if (d == 0) tok = s;
        else tok = isx ? (NCTX + (L - 1) - (s - NCTX)) : (NCTX - 1 - s);
        const bf16_t* up = Ub + ((size_t)b * LA + tok) * 512 + g * 16;
        float bur = 0.f, bui = 0.f;
#pragma unroll
        for (int pp = 0; pp < 16; ++pp) { const float uv = bf2f(up[pp]); bur += bre[pp] * uv; bui += bim[pp] * uv; }
        const float nr = abr * hr - abi * hi + bur, ni = abr * hi + abi * hr + bui;
        hr = nr; hi = ni;
        if (isx) {
          float myv = 0.f;
#pragma unroll
          for (int pp = 0; pp < 16; ++pp) { const float yv = wave_sum(cre[pp] * hr - cim[pp] * hi); if (lane == pp) myv = yv; }
          if (lane < 16) ys[((size_t)b * L + (tok - NCTX)) * 512 + g * 16 + lane] = myv;
        }
      }
    }
  }
  grid.sync();

  {
    PHASE_LOCALS
    const bf16_t* Ub = (const bf16_t*)WSP(WS_U); const float* YS = (const float*)WSP(WS_YS); bf16_t* YG = (bf16_t*)WSP(WS_YG); const float* dsk = INP(22);
    for (size_t it = gtid; it < (size_t)MX * 512; it += gsz) {
      const int row = (int)(it >> 9), ch = (int)(it & 511), b = row / L, t = row % L;
      const float u = bf2f(Ub[((size_t)b * LA + NCTX + t) * 512 + ch]);
      const float y = YS[it] + YS[(size_t)MX * 512 + it] + dsk[ch] * u;
      YG[it] = f2bf(gelu_tanh(y));
    }
  }
  grid.sync();
  {
    pg8::Gemm g{(const bf16_t*)WSP(WS_YG), (const bf16_t*)WSP(WS_WGLU), MX, 512, 512};
    pg8::StaticOrder S; S.init(MX, 512, (int)gridDim.x, (int)blockIdx.x);
    EpiBf8<0> E{(bf16_t*)WSP(WS_SSMX), 512, (const bf16_t*)WSP(WS_YG), 512, INP(24)};
    pg8::gemm_phase<EpiBf8<0>, pg8::StaticOrder, true, true>((PG8_LAS unsigned char*)lds, g, S, E);
  }
  grid.sync();

  {
    pg8::Gemm g{(const bf16_t*)WSP(WS_ATT), (const bf16_t*)WSP(WS_WAU), MX, 1024, 1024};
    pg8::StaticOrder S; S.init(MX, 1024, (int)gridDim.x, (int)blockIdx.x);
    EpiBf8<1> E{(bf16_t*)WSP(WS_M), 1024, (const bf16_t*)WSP(WS_G), 2048, nullptr};
    pg8::gemm_phase<EpiBf8<1>, pg8::StaticOrder, true, true>((PG8_LAS unsigned char*)lds, g, S, E);
  }
  grid.sync();
  {
    pg8::Gemm g{(const bf16_t*)WSP(WS_SSMX), (const bf16_t*)WSP(WS_WSU), MX, 1024, 512};
    pg8::StaticOrder S; S.init(MX, 1024, (int)gridDim.x, (int)blockIdx.x);
    EpiBf8<2> E{(bf16_t*)WSP(WS_M), 1024, (const bf16_t*)WSP(WS_G) + 1024, 2048, nullptr};
    pg8::gemm_phase<EpiBf8<2>, pg8::StaticOrder, true, true>((PG8_LAS unsigned char*)lds, g, S, E);
  }
  grid.sync();
  {
    pg8::Gemm g{(const bf16_t*)WSP(WS_M), (const bf16_t*)WSP(WS_WOUT), MX, 1024, 1024};
    pg8::StaticOrder S; S.init(MX, 1024, (int)gridDim.x, (int)blockIdx.x);
    EpiF32<1> E{(float*)WSP(WS_X1), INP(0), (const float*)WSP(WS_MOD)};
    pg8::gemm_phase<EpiF32<1>, pg8::StaticOrder, true, true>((PG8_LAS unsigned char*)lds, g, S, E);
  }
  grid.sync();
  {
    PHASE_LOCALS
    const float* X1 = (const float*)WSP(WS_X1); const float* MOD = (const float*)WSP(WS_MOD); bf16_t* XN2 = (bf16_t*)WSP(WS_XN2); const float* norm2_g = INP(7);
    for (int row = gw; row < MX; row += ngw) {
      const float* src = X1 + (size_t)row * D; const float* md = MOD + (row / L) * 6144;
      f32x4 v[4]; float ss = 0.f;
#pragma unroll
      for (int j = 0; j < 4; ++j) { v[j] = *(const f32x4*)(src + lane * 4 + 256 * j); ss += v[j][0] * v[j][0] + v[j][1] * v[j][1] + v[j][2] * v[j][2] + v[j][3] * v[j][3]; }
      const float rstd = rsqrtf(wave_sum(ss) * (1.f / D) + 1e-6f);
#pragma unroll
      for (int j = 0; j < 4; ++j)
#pragma unroll
        for (int e = 0; e < 4; ++e) { const int col = lane * 4 + 256 * j + e; XN2[(size_t)row * D + col] = f2bf(v[j][e] * rstd * norm2_g[col] * (1.f + md[4096 + col]) + md[3072 + col]); }
    }
  }
  grid.sync();
  {
    pg8::Gemm g{(const bf16_t*)WSP(WS_XN2), (const bf16_t*)WSP(WS_WQ), MX, 1024, 1024};
    pg8::StaticOrder S; S.init(MX, 1024, (int)gridDim.x, (int)blockIdx.x);
    EpiF32<0> E{(float*)WSP(WS_QP), nullptr, nullptr};
    pg8::gemm_phase<EpiF32<0>, pg8::StaticOrder, true, true>((PG8_LAS unsigned char*)lds, g, S, E);
  }
  grid.sync();
  {
    PHASE_LOCALS
    const float* QP = (const float*)WSP(WS_QP); int* IDX = (int*)WSP(WS_IDX); float* GATE = (float*)WSP(WS_GATE);
    const float* sk1 = INP(28); const float* sk2 = INP(29);
    float* SK = fl;
    for (int i = tid; i < 128 * 64; i += NT) { SK[(i >> 6) * 65 + (i & 63)] = sk1[i]; SK[128 * 65 + (i >> 6) * 65 + (i & 63)] = sk2[i]; }
    __syncthreads();
    for (int it = gw; it < MX * 8; it += ngw) {
      const int t = it >> 3, h = it & 7;
      const float* qp = QP + (size_t)t * 1024 + h * 128;
      const float qa = qp[lane], qb2 = qp[64 + lane];
      float s1a = 0.f, s1b = 0.f, s2a = 0.f, s2b = 0.f;
      for (int dd = 0; dd < 64; ++dd) {
        const float q1 = __shfl(qa, dd), q2 = __shfl(qb2, dd);
        s1a += q1 * SK[lane * 65 + dd]; s1b += q1 * SK[(lane + 64) * 65 + dd];
        s2a += q2 * SK[128 * 65 + lane * 65 + dd]; s2b += q2 * SK[128 * 65 + (lane + 64) * 65 + dd];
      }
      float v1 = 0.f, v2 = 0.f; int i1 = 0, i2 = 0;
      for (int r = 0; r < 16; ++r) {
        float bv = s1a; int bi = lane; if (s1b > bv) { bv = s1b; bi = lane + 64; }
        wave_argmax(bv, bi);
        if (bi == lane) s1a = -3e38f;
        if (bi == lane + 64) s1b = -3e38f;
        if (lane == r) { v1 = bv; i1 = bi; }
        bv = s2a; bi = lane; if (s2b > bv) { bv = s2b; bi = lane + 64; }
        wave_argmax(bv, bi);
        if (bi == lane) s2a = -3e38f;
        if (bi == lane + 64) s2b = -3e38f;
        if (lane == r) { v2 = bv; i2 = bi; }
      }
      const float vb = __shfl(v2, lane & 15);
      float cs[4];
#pragma unroll
      for (int j = 0; j < 4; ++j) cs[j] = __shfl(v1, (lane >> 4) + 4 * j) + vb;
      float tv = 0.f; int tcand = 0;
      for (int r = 0; r < 16; ++r) {
        float bv = cs[0]; int bi = ((lane >> 4) + 0) * 16 + (lane & 15);
#pragma unroll
        for (int j = 1; j < 4; ++j) { const int ci = ((lane >> 4) + 4 * j) * 16 + (lane & 15); if (cs[j] > bv) { bv = cs[j]; bi = ci; } }
        wave_argmax(bv, bi);
#pragma unroll
        for (int j = 0; j < 4; ++j) { const int ci = ((lane >> 4) + 4 * j) * 16 + (lane & 15); if (ci == bi) cs[j] = -3e38f; }
        if (lane == r) { tv = bv; tcand = bi; }
      }
      const int e1 = __shfl(i1, tcand >> 4), e2 = __shfl(i2, tcand & 15);
      const float mx = __shfl(tv, 0);
      const float ex = lane < 16 ? __expf(tv - mx) : 0.f;
      const float den = wave_sum(ex);
      if (lane < 16) { IDX[(size_t)it * 16 + lane] = e1 * 128 + e2; GATE[(size_t)it * 16 + lane] = ex / den; }
    }
    __syncthreads();
  }
  grid.sync();
  {
    PHASE_LOCALS
    const float* X1 = (const float*)WSP(WS_X1); const float* MOD = (const float*)WSP(WS_MOD); const bf16_t* XN2 = (const bf16_t*)WSP(WS_XN2);
    const int* IDX = (const int*)WSP(WS_IDX); const float* GATE = (const float*)WSP(WS_GATE);
    const float* pu = INP(30); const float* pv = INP(31); const float* fng = INP(32); float* out = (float*)ldptr_(33);
    for (int row = gw; row < MX; row += ngw) {
      const float* md = MOD + (row / L) * 6144;
      float xv[16], acc[16];
#pragma unroll
      for (int j = 0; j < 4; ++j)
#pragma unroll
        for (int e = 0; e < 4; ++e) { xv[j * 4 + e] = bf2f(XN2[(size_t)row * D + lane * 4 + 256 * j + e]); acc[j * 4 + e] = 0.f; }
      for (int i = 0; i < 128; ++i) {
        const int ex = IDX[(size_t)row * 128 + i]; const float gt = GATE[(size_t)row * 128 + i];
        const float* ur = pu + (size_t)ex * D; const float* vr = pv + (size_t)ex * D;
        float dp = 0.f;
#pragma unroll
        for (int j = 0; j < 4; ++j) { const f32x4 uu = *(const f32x4*)(ur + lane * 4 + 256 * j); dp += uu[0] * xv[j * 4] + uu[1] * xv[j * 4 + 1] + uu[2] * xv[j * 4 + 2] + uu[3] * xv[j * 4 + 3]; }
        const float cf = gt * gelu_tanh(wave_sum(dp));
#pragma unroll
        for (int j = 0; j < 4; ++j) { const f32x4 vv = *(const f32x4*)(vr + lane * 4 + 256 * j); acc[j * 4] += cf * vv[0]; acc[j * 4 + 1] += cf * vv[1]; acc[j * 4 + 2] += cf * vv[2]; acc[j * 4 + 3] += cf * vv[3]; }
      }
      float ss = 0.f; float x2[16];
#pragma unroll
      for (int j = 0; j < 4; ++j)
#pragma unroll
        for (int e = 0; e < 4; ++e) { const int col = lane * 4 + 256 * j + e; const float v = X1[(size_t)row * D + col] + md[5120 + col] * acc[j * 4 + e]; x2[j * 4 + e] = v; ss += v * v; }
      const float rstd = rsqrtf(wave_sum(ss) * (1.f / D) + 1e-6f);
#pragma unroll
      for (int j = 0; j < 4; ++j) {
        f32x4 o4;
#pragma unroll
        for (int e = 0; e < 4; ++e) o4[e] = x2[j * 4 + e] * rstd * fng[lane * 4 + 256 * j + e];
        *(f32x4*)(out + (size_t)row * D + lane * 4 + 256 * j) = o4;
      }
    }
  }
}

extern "C" void kernel_launch(void* const* d_in, const int* in_sizes, int n_in, void* d_out, int out_size, void* d_ws, size_t ws_size, hipStream_t stream) {
  static int grid_blocks = 0;
  if (!grid_blocks) {
    int dev = 0, cus = 0, per_cu = 0;
    (void)hipGetDevice(&dev);
    (void)hipDeviceGetAttribute(&cus, hipDeviceAttributeMultiprocessorCount, dev);
    (void)hipFuncSetAttribute((const void*)mega, hipFuncAttributeMaxDynamicSharedMemorySize, LDS_BYTES);
    (void)hipOccupancyMaxActiveBlocksPerMultiprocessor(&per_cu, (const void*)mega, NT, LDS_BYTES);
    if (per_cu < 1) per_cu = 1;
    grid_blocks = cus * per_cu;
    if (n_in != 33 || ws_size < 249 * MiB) { fprintf(stderr, "kernel_launch: unexpected n_in %d / ws %zu\n", n_in, ws_size); }
  }
  Params p{};
  for (int i = 0; i < 33 && i < n_in; ++i) p.in[i] = (const float*)d_in[i];
  p.out = (float*)d_out; p.ws = (unsigned char*)d_ws;
  void* args[] = {&p};
  hipError_t e = hipLaunchCooperativeKernel((const void*)mega, dim3(grid_blocks), dim3(NT), args, LDS_BYTES, stream);
  if (e != hipSuccess) fprintf(stderr, "cooperative launch failed: %s (grid %d)\n", hipGetErrorString(e), grid_blocks);
}
```

```cpp
#include <hip/hip_runtime.h>
#include <hip/hip_cooperative_groups.h>
#include <cstdio>
#include <cstdint>
namespace cg = cooperative_groups;

typedef unsigned short bf16_t;
typedef float f32x4 __attribute__((ext_vector_type(4)));

constexpr int NT = 512;
constexpr int LDS_BYTES = 147456;
constexpr int Bn = 4, L = 4096, D = 1024, NCTX = 256, LA = L + NCTX;
constexpr int MX = Bn * L, MC = Bn * NCTX;
constexpr int N_IN = 5632;
constexpr size_t MiB = 1u << 20;
constexpr size_t WS_MOD = 0, WS_LAM = 128 * 1024, WS_ROPE = 136 * 1024, WS_ARDT = 144 * 1024, WS_AIDT = 160 * 1024;
constexpr size_t WS_ABRE = 192 * 1024, WS_ABIM = 224 * 1024, WS_BBRE = 256 * 1024, WS_BBIM = 512 * 1024;
constexpr size_t WS_KT = 2 * MiB;
constexpr size_t WS_XN = 4 * MiB, WS_Q = 38 * MiB, WS_K = 70 * MiB, WS_V = 104 * MiB, WS_SA = 138 * MiB, WS_G = 164 * MiB;
constexpr size_t WS_WIN = 228 * MiB, WS_WAU = 239 * MiB, WS_WSU = 241 * MiB, WS_WOUT = 242 * MiB, WS_WQ = 244 * MiB, WS_WGLU = 246 * MiB;
constexpr size_t WS_BTS = 247 * MiB;
constexpr size_t WS_BTY = 38 * MiB, WS_S = 62 * MiB, WS_YG = 79 * MiB, WS_SSMX = 95 * MiB, WS_M = 111 * MiB;
constexpr size_t WS_ATT = WS_XN, WS_X1 = 38 * MiB, WS_XN2 = WS_XN, WS_QP = WS_G, WS_IDX = 111 * MiB, WS_GATE = 119 * MiB;
constexpr int SA_ROWS = 544, SA_LD = 768;

constexpr int PTR_OFF = LDS_BYTES - 1024;
__device__ __forceinline__ unsigned long long ldptr_(int k) {
  extern __shared__ __attribute__((aligned(16))) unsigned char lds_[];
  const unsigned long long v = ((const unsigned long long*)(lds_ + PTR_OFF))[k];
  const unsigned lo = __builtin_amdgcn_readfirstlane((unsigned)v), hi = __builtin_amdgcn_readfirstlane((unsigned)(v >> 32));
  return ((unsigned long long)hi << 32) | lo;
}
#define INP(k) ((const float*)ldptr_(k))
#define WSP(off) ((unsigned char*)ldptr_(34) + (off))
#define PHASE_LOCALS \
  int tid = threadIdx.x; asm volatile("" : "+v"(tid)); \
  const int lane = tid & 63, wid = tid >> 6; \
  const int gtid = blockIdx.x * NT + tid, gsz = gridDim.x * NT; \
  const int gw = blockIdx.x * (NT / 64) + wid, ngw = gridDim.x * (NT / 64); \
  float* fl = (float*)lds; (void)lane; (void)wid; (void)gtid; (void)gsz; (void)gw; (void)ngw; (void)fl;

struct Params {
  const float* in[33];
  float* out;
  unsigned char* ws;
  int pad0, pad1;
};

__device__ __forceinline__ float bf2f(bf16_t v) { return __uint_as_float(((unsigned)v) << 16); }
__device__ __forceinline__ bf16_t f2bf(float f) { unsigned u = __float_as_uint(f); return (bf16_t)((u + 0x7fffu + ((u >> 16) & 1u)) >> 16); }
__device__ __forceinline__ float wave_sum(float v) {
#pragma unroll
  for (int o = 32; o; o >>= 1) v += __shfl_xor(v, o);
  return v;
}
__device__ __forceinline__ float gelu_tanh(float x) { return 0.5f * x * (1.f + tanhf(0.7978845608028654f * (x + 0.044715f * x * x * x))); }
__device__ __forceinline__ float sigmoidf_(float x) { return 1.f / (1.f + __expf(-x)); }
__device__ __forceinline__ float siluf_(float x) { return x / (1.f + __expf(-x)); }

template <class Epi>
__device__ __forceinline__ void sgemm(const bf16_t* A, int lda, const float* Bm, int ldb, int M, int N, int K, float* lds, Epi epi) {
  constexpr int TM = 128, TN = 128, TK = 16, LDA_S = TM + 4, LDB_S = TN + 4;
  float* As = lds;
  float* Bs = lds + TK * LDA_S;
  const int tid = threadIdx.x, ty = tid >> 4, tx = tid & 15;
  const int ntm = M / TM, ntn = N / TN;
  for (int tile = blockIdx.x; tile < ntm * ntn; tile += gridDim.x) {
    const int tm = tile / ntn, tn = tile % ntn;
    float acc[4][8];
#pragma unroll
    for (int i = 0; i < 4; ++i)
#pragma unroll
      for (int j = 0; j < 8; ++j) acc[i][j] = 0.f;
    const int ar = tid >> 2, ak = (tid & 3) * 4;
    const int bk = tid >> 5, bn = (tid & 31) * 4;
    for (int k0 = 0; k0 < K; k0 += TK) {
      const bf16_t* ap = A + (size_t)(tm * TM + ar) * lda + k0 + ak;
      const unsigned long long av = *(const unsigned long long*)ap;
      const f32x4 bv = *(const f32x4*)(Bm + (size_t)(k0 + bk) * ldb + tn * TN + bn);
      __syncthreads();
      As[(ak + 0) * LDA_S + ar] = bf2f((bf16_t)(av & 0xffff));
      As[(ak + 1) * LDA_S + ar] = bf2f((bf16_t)((av >> 16) & 0xffff));
      As[(ak + 2) * LDA_S + ar] = bf2f((bf16_t)((av >> 32) & 0xffff));
      As[(ak + 3) * LDA_S + ar] = bf2f((bf16_t)((av >> 48) & 0xffff));
      *(f32x4*)(Bs + bk * LDB_S + bn) = bv;
      __syncthreads();
#pragma unroll
      for (int k = 0; k < TK; ++k) {
        const f32x4 a4 = *(const f32x4*)(As + k * LDA_S + ty * 4);
        const f32x4 b0 = *(const f32x4*)(Bs + k * LDB_S + tx * 8);
        const f32x4 b1 = *(const f32x4*)(Bs + k * LDB_S + tx * 8 + 4);
#pragma unroll
        for (int i = 0; i < 4; ++i) {
          acc[i][0] += a4[i] * b0[0]; acc[i][1] += a4[i] * b0[1]; acc[i][2] += a4[i] * b0[2]; acc[i][3] += a4[i] * b0[3];
          acc[i][4] += a4[i] * b1[0]; acc[i][5] += a4[i] * b1[1]; acc[i][6] += a4[i] * b1[2]; acc[i][7] += a4[i] * b1[3];
        }
      }
    }
#pragma unroll
    for (int i = 0; i < 4; ++i)
#pragma unroll
      for (int j = 0; j < 8; ++j) epi(tm * TM + ty * 4 + i, tn * TN + tx * 8 + j, acc[i][j]);
  }
  __syncthreads();
}

namespace pg8 {
#define PG8_LAS __attribute__((address_space(3)))
typedef unsigned short bf16_t;
typedef short bf16x8 __attribute__((ext_vector_type(8)));
typedef float f32x4 __attribute__((ext_vector_type(4)));
typedef unsigned u32x4 __attribute__((ext_vector_type(4)));
constexpr int BM = 256, BK = 64, HALF = 128, HTB = HALF * BK * 2  , STAGE_BYTES = 8 * HTB, NXCD = 8, WGM = 8;

__host__ __device__ __forceinline__ int lds_byte(int r, int c) { const int st = (r >> 4) * 2 + (c >> 5), rr = r & 15, cc = c & 31, ob = rr * 64 + cc * 2; return st * 1024 + (ob ^ (((ob >> 9) & 1) << 5)); }
__host__ __device__ __forceinline__ void stage_rc(int b, int& R, int& C) { const int st = b / 1024, sb = b % 1024, swz = sb ^ (((sb >> 9) & 1) << 5); R = (st >> 1) * 16 + swz / 64; C = (st & 1) * 32 + (swz % 64) / 2; }
__host__ __device__ __forceinline__ int perm32(int rho) { const int n = rho >> 4, i = rho & 15; return 8 * (i >> 2) + 4 * n + (i & 3); }

struct Unit { int pm, pn, grp; long ao, bo; };
struct Gemm { const bf16_t* A; const bf16_t* Bt; int M, N, K, lda, ldb; };

struct StaticOrder {
    int nM, nN, nwg, G, c; long tsA, tsB;
    __host__ __device__ void init(int M, int N, int G_, int c_, int lda, int ldb) { nM = M / BM; nN = N / BM; nwg = nM * nN; G = G_; c = c_; tsA = (long)BM * lda * 2; tsB = (long)BM * ldb * 2; }
    __host__ __device__ bool next(int i, Unit& u) const {
        const long L = (long)i * G + c; if (L >= nwg) return false;
        int wgid = (int)L; { const int q = nwg / NXCD, r = nwg % NXCD, xcd = wgid % NXCD, off = wgid / NXCD; wgid = (xcd < r ? xcd * (q + 1) : r * (q + 1) + (xcd - r) * q) + off; }
        const int nig = WGM * nN, gid = wgid / nig, fm = gid * WGM, gsz = (nM - fm) < WGM ? (nM - fm) : WGM;
        u.pm = fm + ((wgid % nig) % gsz); u.pn = (wgid % nig) / gsz; u.grp = 0; u.ao = u.pm * tsA; u.bo = u.pn * tsB; return true;
    }
    __device__ __forceinline__ void a_ready(const Unit&) const {}
    __device__ __forceinline__ void done(const Unit&) const {}
};

__device__ __forceinline__ unsigned cvt_pk_bf16(float lo, float hi) { unsigned r; asm volatile("v_cvt_pk_bf16_f32 %0, %1, %2" : "=v"(r) : "v"(lo), "v"(hi)); return r; }
template <class Epi, class Sched, bool ALIGN_EPI = false, bool SP2 = false>
__device__ __forceinline__ void gemm_phase(PG8_LAS unsigned char* lds, const Gemm g, const Sched& S, const Epi& E) {
    const int tid = threadIdx.x, wid = __builtin_amdgcn_readfirstlane(tid >> 6), lane = tid & 63, wr = wid >> 2, wc = wid & 3, fr = lane & 15, fq = lane >> 4;
    const int K = g.K, nt = K / BK;
    unsigned voffA[2], voffB[2];
#pragma unroll
    for (int i = 0; i < 2; ++i) { int R, C; stage_rc(tid * 16 + i * 8192, R, C); const int Rb = Epi::PERM ? ((R & ~31) + perm32(R & 31)) : R;
        voffA[i] = (unsigned)(R * g.lda + C) * 2u; voffB[i] = (unsigned)(Rb * g.ldb + C) * 2u; }
    const size_t kstep = (size_t)(BK * 2);
    const size_t hstepA = (size_t)HALF * g.lda * 2, hstepB = (size_t)HALF * g.ldb * 2;
    const unsigned ldsw = (unsigned)wid * 1024u;
    const int aoff = lds_byte(wr * 64 + fr, fq * 8), boff = lds_byte(wc * 32 + fr, fq * 8);
#define PG8_SA(b, h) (((b) * 2 + (h)) * HTB)
#define PG8_SB(b, h) ((4 + (b) * 2 + (h)) * HTB)
#define PG8_STAGE(bufoff, gbase, voff) do { _Pragma("unroll") for (int _i = 0; _i < 2; ++_i) \
        __builtin_amdgcn_global_load_lds((const unsigned*)((const char*)(gbase) + (voff)[_i]), (PG8_LAS unsigned*)(lds + (bufoff) + ldsw + _i * 8192), 16, 0, 0); } while (0)
#define PG8_LDA(dst, b, h) do { _Pragma("unroll") for (int m = 0; m < 4; ++m) _Pragma("unroll") for (int k = 0; k < 2; ++k) dst[m][k] = *(const PG8_LAS bf16x8*)(lds + PG8_SA(b, h) + aoff + m * 2048 + k * 1024); } while (0)
#define PG8_LDB(dst, b, h) do { _Pragma("unroll") for (int n = 0; n < 2; ++n) _Pragma("unroll") for (int k = 0; k < 2; ++k) dst[n][k] = *(const PG8_LAS bf16x8*)(lds + PG8_SB(b, h) + boff + n * 2048 + k * 1024); } while (0)
#define PG8_MMA(ai, bj, At, Bt) do { __builtin_amdgcn_s_setprio(1); _Pragma("unroll") for (int m = 0; m < 4; ++m) _Pragma("unroll") for (int n = 0; n < 2; ++n) _Pragma("unroll") for (int k = 0; k < 2; ++k) \
        acc[ai][bj][m][n] = __builtin_amdgcn_mfma_f32_16x16x32_bf16(Bt[n][k], At[m][k], acc[ai][bj][m][n], 0, 0, 0); __builtin_amdgcn_s_setprio(0); } while (0)
#define PG8_WAIT_V(n) asm volatile("s_waitcnt vmcnt(" #n ")" ::: "memory")
#define PG8_WAIT_L(n) asm volatile("s_waitcnt lgkmcnt(" #n ")" ::: "memory")
#define PG8_BAR __builtin_amdgcn_s_barrier()
#define PG8_SCHED __builtin_amdgcn_sched_barrier(0)
    Unit cur, nxt; int ui = 0;
    if (!S.next(0, cur)) return;
    f32x4 acc[2][2][4][2];
#pragma unroll
    for (int a = 0; a < 2; ++a)
#pragma unroll
        for (int b = 0; b < 2; ++b)
#pragma unroll
            for (int m = 0; m < 4; ++m)
#pragma unroll
                for (int n = 0; n < 2; ++n) acc[a][b][m][n] = (f32x4){0.f, 0.f, 0.f, 0.f};
    bf16x8 At[4][2], B0[2][2], B1[2][2];
    const char* cA = (const char*)g.A + cur.ao; const char* cB = (const char*)g.Bt + cur.bo;
    S.a_ready(cur);
    if constexpr (SP2) {
        PG8_STAGE(PG8_SB(0, 0), cB, voffB); PG8_STAGE(PG8_SB(0, 1), cB + hstepB, voffB); PG8_STAGE(PG8_SA(0, 0), cA, voffA); PG8_STAGE(PG8_SA(0, 1), cA + hstepA, voffA);
        if (wr == 1) PG8_BAR;
        PG8_WAIT_V(2); PG8_BAR;
        PG8_STAGE(PG8_SB(1, 0), cB + kstep, voffB); PG8_STAGE(PG8_SA(1, 0), cA + kstep, voffA); PG8_STAGE(PG8_SB(1, 1), cB + hstepB + kstep, voffB);
        PG8_WAIT_V(6); PG8_BAR;
    } else {
        PG8_STAGE(PG8_SB(0, 0), cB, voffB); PG8_STAGE(PG8_SA(0, 0), cA, voffA); PG8_STAGE(PG8_SB(0, 1), cB + hstepB, voffB); PG8_STAGE(PG8_SA(0, 1), cA + hstepA, voffA);
        if (wr == 1) PG8_BAR;
        PG8_WAIT_V(4); PG8_BAR;
        PG8_STAGE(PG8_SB(1, 0), cB + kstep, voffB); PG8_STAGE(PG8_SA(1, 0), cA + kstep, voffA); PG8_STAGE(PG8_SB(1, 1), cB + hstepB + kstep, voffB);
        PG8_WAIT_V(6); PG8_BAR;
    }
    for (;;) {
        const bool has_next = S.next(ui + 1, nxt);
        const char* nA = has_next ? (const char*)g.A + nxt.ao : cA; const char* nB = has_next ? (const char*)g.Bt + nxt.bo : cB;
        for (int t = 0; t < nt; t += 2) {
            const bool last = (t == nt - 2);
            const char* a1 = cA + (size_t)(t + 1) * kstep;
            const char* a2 = last ? nA : cA + (size_t)(t + 2) * kstep; const char* b2 = last ? nB : cB + (size_t)(t + 2) * kstep;
            const char* a3 = a2 + kstep; const char* b3 = b2 + kstep;
            if (last && has_next) S.a_ready(nxt);
            if constexpr (SP2) {
            PG8_LDB(B0, 0, 0); PG8_LDB(B1, 0, 1); PG8_SCHED; PG8_LDA(At, 0, 0); PG8_STAGE(PG8_SA(1, 1), a1 + hstepA, voffA);
            PG8_WAIT_V(8); PG8_WAIT_L(0); PG8_BAR; PG8_MMA(0, 0, At, B0); PG8_MMA(0, 1, At, B1); PG8_BAR; PG8_SCHED;
            PG8_LDA(At, 0, 1); PG8_STAGE(PG8_SB(0, 0), b2, voffB); PG8_STAGE(PG8_SB(0, 1), b2 + hstepB, voffB); PG8_STAGE(PG8_SA(0, 0), a2, voffA);
            PG8_WAIT_V(8); PG8_WAIT_L(0); PG8_BAR; PG8_MMA(1, 0, At, B0); PG8_MMA(1, 1, At, B1); PG8_BAR; PG8_SCHED;
            PG8_LDB(B0, 1, 0); PG8_LDB(B1, 1, 1); PG8_SCHED; PG8_LDA(At, 1, 0); PG8_STAGE(PG8_SA(0, 1), a2 + hstepA, voffA);
            PG8_WAIT_V(8); PG8_WAIT_L(0); PG8_BAR; PG8_MMA(0, 0, At, B0); PG8_MMA(0, 1, At, B1); PG8_BAR; PG8_SCHED;
            PG8_LDA(At, 1, 1); PG8_STAGE(PG8_SB(1, 0), b3, voffB); PG8_STAGE(PG8_SB(1, 1), b3 + hstepB, voffB); PG8_STAGE(PG8_SA(1, 0), a3, voffA);
            PG8_WAIT_V(8); PG8_WAIT_L(0); PG8_BAR; PG8_MMA(1, 0, At, B0); PG8_MMA(1, 1, At, B1); PG8_BAR; PG8_SCHED;
            } else {
            PG8_LDB(B0, 0, 0); PG8_SCHED; PG8_LDA(At, 0, 0); PG8_STAGE(PG8_SA(1, 1), a1 + hstepA, voffA);
            PG8_WAIT_L(8); PG8_BAR; PG8_WAIT_L(0); PG8_MMA(0, 0, At, B0); PG8_BAR; PG8_SCHED;
            PG8_LDB(B1, 0, 1); PG8_STAGE(PG8_SB(0, 0), b2, voffB);
            PG8_BAR; PG8_WAIT_L(0); PG8_MMA(0, 1, At, B1); PG8_BAR;
            PG8_LDA(At, 0, 1); PG8_STAGE(PG8_SA(0, 0), a2, voffA);
            PG8_BAR; PG8_WAIT_L(0); PG8_MMA(1, 0, At, B0); PG8_BAR; PG8_SCHED;
            PG8_STAGE(PG8_SB(0, 1), b2 + hstepB, voffB);
            PG8_WAIT_V(6); PG8_BAR; PG8_MMA(1, 1, At, B1); PG8_BAR;
            PG8_LDB(B0, 1, 0); PG8_SCHED; PG8_LDA(At, 1, 0); PG8_STAGE(PG8_SA(0, 1), a2 + hstepA, voffA);
            PG8_WAIT_L(8); PG8_BAR; PG8_WAIT_L(0); PG8_MMA(0, 0, At, B0); PG8_BAR; PG8_SCHED;
            PG8_LDB(B1, 1, 1); PG8_STAGE(PG8_SB(1, 0), b3, voffB);
            PG8_BAR; PG8_WAIT_L(0); PG8_MMA(0, 1, At, B1); PG8_BAR;
            PG8_LDA(At, 1, 1); PG8_STAGE(PG8_SA(1, 0), a3, voffA);
            PG8_BAR; PG8_WAIT_L(0); PG8_MMA(1, 0, At, B0); PG8_BAR; PG8_SCHED;
            PG8_STAGE(PG8_SB(1, 1), b3 + hstepB, voffB);
            PG8_WAIT_V(6); PG8_BAR; PG8_MMA(1, 1, At, B1); PG8_BAR;
            }
        }
        if constexpr (ALIGN_EPI) { if (wr == 0) PG8_BAR; }
        if constexpr (!Epi::AFTER_DRAIN) { E(acc, cur, wr, wc, fr, fq); S.done(cur); }
        if (!has_next) break;
#pragma unroll
        for (int a = 0; a < 2; ++a)
#pragma unroll
            for (int b = 0; b < 2; ++b)
#pragma unroll
                for (int m = 0; m < 4; ++m)
#pragma unroll
                    for (int n = 0; n < 2; ++n) acc[a][b][m][n] = (f32x4){0.f, 0.f, 0.f, 0.f};
        cur = nxt; cA = nA; cB = nB; ++ui;
        if constexpr (ALIGN_EPI) { if (wr == 1) PG8_BAR; }
    }
    PG8_WAIT_V(0);
    if constexpr (!ALIGN_EPI) { if (wr == 0) PG8_BAR; }
    PG8_BAR;
    if constexpr (Epi::AFTER_DRAIN) { E.fused(acc, cur, wr, wc, fr, fq, lds, wid, lane); S.done(cur); }
#undef PG8_SA
#undef PG8_SB
#undef PG8_STAGE
#undef PG8_LDA
#undef PG8_LDB
#undef PG8_MMA
#undef PG8_WAIT_V
#undef PG8_WAIT_L
#undef PG8_BAR
#undef PG8_SCHED
}
}


using pg8::Unit;
typedef unsigned u32x2 __attribute__((ext_vector_type(2)));
typedef unsigned u32x4 __attribute__((ext_vector_type(4)));
__device__ __forceinline__ float bflo(unsigned w) { return __uint_as_float(w << 16); }
__device__ __forceinline__ float bfhi(unsigned w) { return __uint_as_float(w & 0xffff0000u); }

struct InProjSched {
  pg8::StaticOrder so;
  __device__ __forceinline__ void init(int G, int c) { so.init(MX, N_IN, G, c, D, D); }
  __device__ __forceinline__ bool next(int i, Unit& u) const {
    const long Lx = (long)i * so.G + so.c;
    if (Lx < so.nwg) return so.next(i, u);
    const int j = (int)(Lx - so.nwg); if (j >= 40) return false;
    u.pm = 64 + (j & 3); u.pn = 4 + (j >> 2); u.grp = 0; u.ao = u.pm * so.tsA; u.bo = u.pn * so.tsB; return true;
  }
  __device__ __forceinline__ void a_ready(const Unit&) const {}
  __device__ __forceinline__ void done(const Unit&) const {}
};

struct EpiInProj {
  static constexpr bool PERM = false, AFTER_DRAIN = false;
  bf16_t *Q, *K, *V, *SA, *G; const float* rope;
  __device__ __forceinline__ static void st4(bf16_t* p, const f32x4 v) { u32x2 w; w.x = pg8::cvt_pk_bf16(v[0], v[1]); w.y = pg8::cvt_pk_bf16(v[2], v[3]); *(u32x2*)p = w; }
  __device__ __forceinline__ void operator()(const f32x4 (&acc)[2][2][4][2], const Unit& u, int wr, int wc, int fr, int fq) const {
    const int row0 = u.pm * 256 + wr * 64 + fr;
    const int cg0 = u.pn * 256 + wc * 32 + fq * 4;
    if (u.pm < 64) {
      if (u.pn < 8) {
        const bool isq = u.pn < 4;
#pragma unroll
        for (int ai = 0; ai < 2; ++ai)
#pragma unroll
          for (int m = 0; m < 4; ++m) {
            const int row = row0 + ai * 128 + m * 16, b = row >> 12, t = row & 4095;
            const int pos = (wc & 1) ? (t & 63) : (t >> 6);
            const f32x4* rp = (const f32x4*)(rope + (pos * 16 + fq * 4) * 2);
            const f32x4 r0 = rp[0], r1 = rp[1];
            const f32x4 cs = {r0[0], r0[2], r1[0], r1[2]}, sn = {r0[1], r0[3], r1[1], r1[3]};
            bf16_t* dst = isq ? Q + (size_t)row * 1024 + cg0 : K + ((size_t)b * LA + NCTX + t) * 1024 + (cg0 - 1024);
#pragma unroll
            for (int bj = 0; bj < 2; ++bj) {
              const f32x4 h1 = acc[ai][bj][m][0], h2 = acc[ai][bj][m][1];
              st4(dst + bj * 128, h1 * cs - h2 * sn);
              st4(dst + bj * 128 + 16, h2 * cs + h1 * sn);
            }
          }
      } else {
#pragma unroll
        for (int ai = 0; ai < 2; ++ai)
#pragma unroll
          for (int m = 0; m < 4; ++m) {
            const int row = row0 + ai * 128 + m * 16, b = row >> 12, t = row & 4095;
            const size_t kr = (size_t)b * LA + NCTX + t;
            if (u.pn >= 12 && u.pn < 14) {
#pragma unroll
              for (int bj = 0; bj < 2; ++bj)
#pragma unroll
                for (int n = 0; n < 2; ++n) {
                  const int ch = cg0 + bj * 128 + n * 16 - 3072;
                  st4(SA + ((size_t)(ch >> 4) * SA_ROWS + b * 128 + (t >> 5)) * SA_LD + (t & 31) * 16 + (ch & 15), acc[ai][bj][m][n]);
                }
            } else {
              bf16_t* dst = u.pn < 12 ? V + kr * 1024 + (cg0 - 2048) : G + (size_t)row * 2048 + (cg0 - 3584);
#pragma unroll
              for (int bj = 0; bj < 2; ++bj)
#pragma unroll
                for (int n = 0; n < 2; ++n) {
                  f32x4 v = acc[ai][bj][m][n];
                  if (u.pn >= 14) { v[0] = sigmoidf_(v[0]); v[1] = sigmoidf_(v[1]); v[2] = sigmoidf_(v[2]); v[3] = sigmoidf_(v[3]); }
                  st4(dst + bj * 128 + n * 16, v);
                }
            }
          }
      }
    } else {
#pragma unroll
      for (int ai = 0; ai < 2; ++ai)
#pragma unroll
        for (int m = 0; m < 4; ++m) {
          const int rc = row0 + ai * 128 + m * 16 - MX, b = rc >> 8, t = rc & 255;
          const size_t kr = (size_t)b * LA + t;
          if (u.pn >= 12) {
#pragma unroll
            for (int bj = 0; bj < 2; ++bj)
#pragma unroll
              for (int n = 0; n < 2; ++n) {
                const int ch = cg0 + bj * 128 + n * 16 - 3072;
                st4(SA + ((size_t)(ch >> 4) * SA_ROWS + 512 + b * 8 + (t >> 5)) * SA_LD + (t & 31) * 16 + (ch & 15), acc[ai][bj][m][n]);
              }
          } else {
            bf16_t* dst = u.pn < 8 ? K + kr * 1024 + (cg0 - 1024) : V + kr * 1024 + (cg0 - 2048);
#pragma unroll
            for (int bj = 0; bj < 2; ++bj)
#pragma unroll
              for (int n = 0; n < 2; ++n) st4(dst + bj * 128 + n * 16, acc[ai][bj][m][n]);
          }
        }
    }
  }
};
template <int MODE>
struct EpiBf8 {
  static constexpr bool PERM = true, AFTER_DRAIN = false;
  bf16_t* O; int ldo; const bf16_t* X; int ldx; const float* bias;
  __device__ __forceinline__ void operator()(const f32x4 (&acc)[2][2][4][2], const Unit& u, int wr, int wc, int fr, int fq) const {
    const int row0 = u.pm * 256 + wr * 64 + fr, col0 = u.pn * 256 + wc * 32 + 8 * fq;
#pragma unroll
    for (int ai = 0; ai < 2; ++ai)
#pragma unroll
      for (int m = 0; m < 4; ++m) {
        const int row = row0 + ai * 128 + m * 16;
#pragma unroll
        for (int bj = 0; bj < 2; ++bj) {
          const int col = col0 + bj * 128;
          f32x4 v0 = acc[ai][bj][m][0], v1 = acc[ai][bj][m][1];
          const u32x4 xw = *(const u32x4*)(X + (size_t)row * ldx + col);
          const f32x4 x0 = {bflo(xw.x), bfhi(xw.x), bflo(xw.y), bfhi(xw.y)}, x1 = {bflo(xw.z), bfhi(xw.z), bflo(xw.w), bfhi(xw.w)};
          if (MODE == 0) {
            const f32x4 b0 = *(const f32x4*)(bias + col), b1 = *(const f32x4*)(bias + col + 4);
#pragma unroll
            for (int i = 0; i < 4; ++i) { v0[i] = x0[i] * sigmoidf_(v0[i] + b0[i]); v1[i] = x1[i] * sigmoidf_(v1[i] + b1[i]); }
          } else if (MODE == 1) { v0 = v0 * x0; v1 = v1 * x1; }
          else {
            const u32x4 ow = *(const u32x4*)(O + (size_t)row * ldo + col);
            const f32x4 o0 = {bflo(ow.x), bfhi(ow.x), bflo(ow.y), bfhi(ow.y)}, o1 = {bflo(ow.z), bfhi(ow.z), bflo(ow.w), bfhi(ow.w)};
            v0 = o0 + v0 * x0; v1 = o1 + v1 * x1;
          }
          u32x4 w; w.x = pg8::cvt_pk_bf16(v0[0], v0[1]); w.y = pg8::cvt_pk_bf16(v0[2], v0[3]); w.z = pg8::cvt_pk_bf16(v1[0], v1[1]); w.w = pg8::cvt_pk_bf16(v1[2], v1[3]);
          *(u32x4*)(O + (size_t)row * ldo + col) = w;
        }
      }
  }
};
template <int MODE>
struct EpiF32 {
  static constexpr bool PERM = false, AFTER_DRAIN = false;
  float* O; const float* xres; const float* mod;
  __device__ __forceinline__ void operator()(const f32x4 (&acc)[2][2][4][2], const Unit& u, int wr, int wc, int fr, int fq) const {
    const int row0 = u.pm * 256 + wr * 64 + fr, col0 = u.pn * 256 + wc * 32 + 4 * fq;
#pragma unroll
    for (int ai = 0; ai < 2; ++ai)
#pragma unroll
      for (int m = 0; m < 4; ++m) {
        const int row = row0 + ai * 128 + m * 16;
#pragma unroll
        for (int bj = 0; bj < 2; ++bj)
#pragma unroll
          for (int n = 0; n < 2; ++n) {
            const int col = col0 + bj * 128 + n * 16;
            f32x4 v = acc[ai][bj][m][n];
            if (MODE == 1) { const f32x4 xr = *(const f32x4*)(xres + (size_t)row * 1024 + col); const f32x4 g = *(const f32x4*)(mod + (row >> 12) * 6144 + 2048 + col); v = xr + g * v; }
            *(f32x4*)(O + (size_t)row * 1024 + col) = v;
          }
      }
  }
};


struct GroupSched {
  int npm, npn, nunits, G, c; long gsA, gsB, tsA, tsB;
  __device__ __forceinline__ void init(int ngrp, int npm_, int npn_, long gsA_, long tsA_, long gsB_, long tsB_, int G_, int c_) { npm = npm_; npn = npn_; nunits = ngrp * npm_ * npn_; gsA = gsA_; tsA = tsA_; gsB = gsB_; tsB = tsB_; G = G_; c = c_; }
  __device__ __forceinline__ bool next(int i, Unit& u) const {
    const long Lx = (long)i * G + c; if (Lx >= nunits) return false;
    const int per = npm * npn, grp = (int)Lx / per, r = (int)Lx % per;
    u.grp = grp; u.pm = r / npn; u.pn = r % npn; u.ao = grp * gsA + u.pm * tsA; u.bo = grp * gsB + u.pn * tsB; return true;
  }
  __device__ __forceinline__ void a_ready(const Unit&) const {}
  __device__ __forceinline__ void done(const Unit&) const {}
};
struct EpiS {
  static constexpr bool PERM = false, AFTER_DRAIN = false;
  float* S;
  __device__ __forceinline__ void operator()(const f32x4 (&acc)[2][2][4][2], const Unit& u, int wr, int wc, int fr, int fq) const {
    const int row0 = u.pm * 256 + wr * 64 + fr, col0 = wc * 32 + 4 * fq;
#pragma unroll
    for (int ai = 0; ai < 2; ++ai)
#pragma unroll
      for (int m = 0; m < 4; ++m) {
        const int row = row0 + ai * 128 + m * 16;
        if (row < SA_ROWS) {
#pragma unroll
          for (int bj = 0; bj < 2; ++bj)
#pragma unroll
            for (int n = 0; n < 2; ++n) *(f32x4*)(S + ((size_t)u.grp * SA_ROWS + row) * 256 + col0 + bj * 128 + n * 16) = acc[ai][bj][m][n];
        }
      }
  }
};
struct EpiY {
  static constexpr bool PERM = true, AFTER_DRAIN = false;
  bf16_t* YG;
  __device__ __forceinline__ void operator()(const f32x4 (&acc)[2][2][4][2], const Unit& u, int wr, int wc, int fr, int fq) const {
    const int row0 = u.pm * 256 + wr * 64 + fr, col0 = u.pn * 256 + wc * 32 + 8 * fq;
#pragma unroll
    for (int ai = 0; ai < 2; ++ai)
#pragma unroll
      for (int m = 0; m < 4; ++m) {
        const int row = row0 + ai * 128 + m * 16, b = row >> 7, cx = row & 127;
#pragma unroll
        for (int bj = 0; bj < 2; ++bj) {
          const int col = col0 + bj * 128, j = col >> 4, p0 = col & 15;
          const f32x4 v0 = acc[ai][bj][m][0], v1 = acc[ai][bj][m][1];
          u32x4 w; w.x = pg8::cvt_pk_bf16(gelu_tanh(v0[0]), gelu_tanh(v0[1])); w.y = pg8::cvt_pk_bf16(gelu_tanh(v0[2]), gelu_tanh(v0[3]));
          w.z = pg8::cvt_pk_bf16(gelu_tanh(v1[0]), gelu_tanh(v1[1])); w.w = pg8::cvt_pk_bf16(gelu_tanh(v1[2]), gelu_tanh(v1[3]));
          *(u32x4*)(YG + ((size_t)(b * L + cx * 32 + j)) * 512 + u.grp * 16 + p0) = w;
        }
      }
  }
};

__device__ __forceinline__ void transpose_item(const float* W, int K, int N, bf16_t* WT, float* scr, int item, int lane) {
  const int nblk = N / 32, kb = item / nblk, nb = item % nblk, k0 = 64 * kb, n0 = 32 * nb;
#pragma unroll 8
  for (int i = 0; i < 32; ++i) { const int kk = 2 * i + (lane >> 5); scr[kk * 33 + (lane & 31)] = W[(size_t)(k0 + kk) * N + n0 + (lane & 31)]; }
  asm volatile("s_waitcnt lgkmcnt(0)" ::: "memory");
  const int c = lane & 7;
#pragma unroll
  for (int j = 0; j < 4; ++j) {
    const int n = (lane >> 3) + 8 * j; const float* s = scr + (8 * c) * 33 + n;
    u32x4 o; o.x = pg8::cvt_pk_bf16(s[0], s[33]); o.y = pg8::cvt_pk_bf16(s[66], s[99]); o.z = pg8::cvt_pk_bf16(s[132], s[165]); o.w = pg8::cvt_pk_bf16(s[198], s[231]);
    *(u32x4*)(WT + (size_t)(n0 + n) * K + k0 + 8 * c) = o;
  }
  asm volatile("s_waitcnt lgkmcnt(0)" ::: "memory");
}

namespace att {
using bf16 = unsigned short;
constexpr int   D = 128, NW = 8, QBLK = 32, KVBLK = 64, SDEPTH = 1;
constexpr float SCALE = 0.125f;
constexpr float THR = 8.f;
constexpr int LDQ = 1024, LDK = 1024, LDO = 1024;
constexpr size_t SHM_V = KVBLK * D * 2, SHM_K = KVBLK * D * 2, SHM_ATTN = 2 * SHM_V + 2 * SHM_K + NW * 64 * 4 + 4 * 4 * 16 * 64 * 4;
using bf16x8 = __attribute__((ext_vector_type(8))) short;
using s16x4  = __attribute__((ext_vector_type(4))) short;
using f32x16 = __attribute__((ext_vector_type(16))) float;
using f32x8  = __attribute__((ext_vector_type(8))) float;
using u32x4  = __attribute__((ext_vector_type(4))) unsigned;
#define KSWZ(row, colB) ((row) * 256 + ((colB) ^ (((row) & 7) << 4)))
#define SBAR() __builtin_amdgcn_sched_barrier(0)
__device__ __forceinline__ int crow(int r, int hi) { return (r & 3) + 8 * (r >> 2) + 4 * hi; }
__device__ __forceinline__ unsigned cvtpk(float lo, float hi) {
  unsigned r; asm volatile("v_cvt_pk_bf16_f32 %0, %1, %2" : "=v"(r) : "v"(lo), "v"(hi)); return r;
}
template <typename TIn> struct Stage;
template <> struct Stage<bf16>  { using T = bf16x8;
  __device__ static __forceinline__ T ld8(const bf16* p) { return *reinterpret_cast<const bf16x8*>(p); }
  __device__ static __forceinline__ bf16x8 tobf(T x) { return x; } };
__device__ __forceinline__ void partialSM(f32x16& p0, f32x16& p1, float& m_reg, float& mn, float& alpha) {
  constexpr float C = SCALE * 1.4426950408889634f;
  float pmax = p0[0]; for (int r = 1; r < 16; ++r) pmax = fmaxf(pmax, p0[r]); for (int r = 0; r < 16; ++r) pmax = fmaxf(pmax, p1[r]);
  { auto rr = __builtin_amdgcn_permlane32_swap(__float_as_uint(pmax), __float_as_uint(pmax), false, false);
    pmax = fmaxf(__uint_as_float(rr[0]), __uint_as_float(rr[1])); }
  if (__builtin_expect(__all(pmax - m_reg <= THR / SCALE), 1)) { mn = m_reg; alpha = 1.f; }
  else { mn = fmaxf(m_reg, pmax); alpha = __builtin_amdgcn_exp2f((m_reg - mn) * C); m_reg = mn; }
  float mnC = -mn * C;
  for (int r = 0; r < 16; ++r) p0[r] = fmaf(p0[r], C, mnC); for (int r = 0; r < 16; ++r) p1[r] = fmaf(p1[r], C, mnC);
  for (int r = 0; r < 16; ++r) p0[r] = __builtin_amdgcn_exp2f(p0[r]);
}
__device__ __forceinline__ void finishSM(f32x16& p0, f32x16& p1, float alpha, float& l_reg, bf16x8& pa0, bf16x8& pa1, bf16x8& pa2, bf16x8& pa3) {
  for (int r = 0; r < 16; ++r) p1[r] = __builtin_amdgcn_exp2f(p1[r]);
  float ps = 0; for (int r = 0; r < 16; ++r) ps += p0[r]; for (int r = 0; r < 16; ++r) ps += p1[r];
  { auto rr = __builtin_amdgcn_permlane32_swap(__float_as_uint(ps), __float_as_uint(ps), false, false);
    ps = __uint_as_float(rr[0]) + __uint_as_float(rr[1]); }
  l_reg = l_reg * alpha + ps;
#define PK4(P, BASE, OUT) do { unsigned a0 = cvtpk(P[BASE + 0], P[BASE + 1]), a1 = cvtpk(P[BASE + 2], P[BASE + 3]);   \
    unsigned b0 = cvtpk(P[BASE + 4], P[BASE + 5]), b1 = cvtpk(P[BASE + 6], P[BASE + 7]);                              \
    auto r0 = __builtin_amdgcn_permlane32_swap(a0, b0, false, false); auto r1 = __builtin_amdgcn_permlane32_swap(a1, b1, false, false); \
    u32x4 w = {r0[0], r1[0], r0[1], r1[1]}; OUT = *reinterpret_cast<bf16x8*>(&w); } while (0)
  PK4(p0, 0, pa0); PK4(p0, 8, pa1); PK4(p1, 0, pa2); PK4(p1, 8, pa3);
#undef PK4
}
__device__ __forceinline__ void qkt(f32x16& p0, f32x16& p1, const bf16* Ks, const bf16x8* qr, int r32, int hi, int mcolB) {
  p0 = f32x16{}; p1 = f32x16{};
#pragma unroll
  for (int d0 = 0; d0 < 4; ++d0) { int cb = mcolB + (d0 * 16 + hi * 8) * 2;
    bf16x8 b0 = *reinterpret_cast<const bf16x8*>((const char*)Ks + KSWZ(r32, cb));
    bf16x8 b1 = *reinterpret_cast<const bf16x8*>((const char*)Ks + KSWZ(32 + r32, cb));
    p0 = __builtin_amdgcn_mfma_f32_32x32x16_bf16(b0, qr[d0], p0, 0, 0, 0);
    p1 = __builtin_amdgcn_mfma_f32_32x32x16_bf16(b1, qr[d0], p1, 0, 0, 0); }
}
__device__ __forceinline__ int v_st(int k, int c) { const int kk = (k & ~0xC) | ((k & 4) << 1) | ((k & 8) >> 1); return ((kk >> 3) * 4 + (c >> 5)) * 512 + ((kk & 7) * 32 + (c & 31)) * 2; }
__device__ __forceinline__ int v_rd_base(int lane) { return ((lane & 3) << 3) | (((lane >> 2) & 3) << 6) | (((lane >> 4) & 1) << 5) | (((lane >> 5) & 1) << 8); }
constexpr int v_rd_off(int d0, int ks, int half) { return d0 * 512 + ks * 4096 + half * 2048; }
template <int OFF> __device__ __forceinline__ s16x4 tr_read(int vb) {
  s16x4 r; asm volatile("ds_read_b64_tr_b16 %0, %1 offset:%2" : "=&v"(r) : "v"(vb), "i"(OFF) : "memory"); return r;
}
template <int D0> __device__ __forceinline__ void pv_one(f32x16& od, int vb, bf16x8 pa0, bf16x8 pa1, bf16x8 pa2, bf16x8 pa3) {
  const s16x4 l0 = tr_read<v_rd_off(D0, 0, 0)>(vb), h0 = tr_read<v_rd_off(D0, 0, 1)>(vb), l1 = tr_read<v_rd_off(D0, 1, 0)>(vb), h1 = tr_read<v_rd_off(D0, 1, 1)>(vb);
  const s16x4 l2 = tr_read<v_rd_off(D0, 2, 0)>(vb), h2 = tr_read<v_rd_off(D0, 2, 1)>(vb), l3 = tr_read<v_rd_off(D0, 3, 0)>(vb), h3 = tr_read<v_rd_off(D0, 3, 1)>(vb);
  asm volatile("s_waitcnt lgkmcnt(0)" ::: "memory"); SBAR();
#define PK(L, H) (bf16x8){L[0], L[1], L[2], L[3], H[0], H[1], H[2], H[3]}
  od = __builtin_amdgcn_mfma_f32_32x32x16_bf16(pa0, PK(l0, h0), od, 0, 0, 0);
  od = __builtin_amdgcn_mfma_f32_32x32x16_bf16(pa1, PK(l1, h1), od, 0, 0, 0);
  od = __builtin_amdgcn_mfma_f32_32x32x16_bf16(pa2, PK(l2, h2), od, 0, 0, 0);
  od = __builtin_amdgcn_mfma_f32_32x32x16_bf16(pa3, PK(l3, h3), od, 0, 0, 0);
#undef PK
}
__device__ __forceinline__ void pv_d0(f32x16* o, int vb, bf16x8 pa0, bf16x8 pa1, bf16x8 pa2, bf16x8 pa3) {
  pv_one<0>(o[0], vb, pa0, pa1, pa2, pa3); pv_one<1>(o[1], vb, pa0, pa1, pa2, pa3); pv_one<2>(o[2], vb, pa0, pa1, pa2, pa3); pv_one<3>(o[3], vb, pa0, pa1, pa2, pa3);
}

__device__ __forceinline__ void diff_attn_unit(const bf16* __restrict__ Qb, const bf16* __restrict__ Kh, const bf16* __restrict__ Vh,
                                               bf16* __restrict__ Ob, int seq, float lam, const float* __restrict__ subln, char* lds) {
  using St = Stage<bf16>;
  const int tid = threadIdx.x, wid = tid >> 6, lane = tid & 63, r32 = lane & 31, hi = lane >> 5;
  bf16* V_lds = (bf16*)lds; bf16* K_lds = (bf16*)(lds + 2 * SHM_V);
  float* ws = (float*)(lds + 2 * SHM_V + 2 * SHM_K) + wid * 64; float* li_l = ws; float* al_l = ws + 32;
  float m_reg = -1e30f, l_reg = 0; f32x16 o[4] = {}; bf16x8 qr[4];
  const int mw = wid >> 2, wq = wid & 3, mcolB = mw * 128;
  const bf16* Qw = Qb + (long)(wq * QBLK + r32) * LDQ + mw * 64 + hi * 8;
#pragma unroll
  for (int d0 = 0; d0 < 4; ++d0) qr[d0] = St::ld8(Qw + d0 * 16);
  const int sr = tid >> 4, sc = (tid & 15) * 8, vst0 = v_st(sr, sc), vst1 = v_st(32 + sr, sc);
  const int vb0 = (int)(uintptr_t)V_lds + v_rd_base(lane);
  struct { typename St::T vs0, vs1, ks0, ks1; } sr_[SDEPTH];
#define SLOAD(i, k0) do { sr_[i].vs0 = St::ld8(&Vh[(long)((k0) + sr) * LDK + sc]); sr_[i].vs1 = St::ld8(&Vh[(long)((k0) + 32 + sr) * LDK + sc]); \
    sr_[i].ks0 = St::ld8(&Kh[(long)((k0) + sr) * LDK + sc]); sr_[i].ks1 = St::ld8(&Kh[(long)((k0) + 32 + sr) * LDK + sc]); } while (0)
#define SWRITE(b, i) do { *(bf16x8*)((char*)V_lds + (b) * SHM_V + vst0) = St::tobf(sr_[i].vs0);          \
    *(bf16x8*)((char*)V_lds + (b) * SHM_V + vst1) = St::tobf(sr_[i].vs1); int kc = sc * 2;               \
    *(bf16x8*)((char*)K_lds + (b) * SHM_K + KSWZ(sr, kc)) = St::tobf(sr_[i].ks0);                       \
    *(bf16x8*)((char*)K_lds + (b) * SHM_K + KSWZ(32 + sr, kc)) = St::tobf(sr_[i].ks1); } while (0)
#define SWAIT() do { if constexpr (SDEPTH == 2) asm volatile("s_waitcnt vmcnt(4)" ::: "memory"); else asm volatile("s_waitcnt vmcnt(0)" ::: "memory"); } while (0)
#define RESC(a) do { if (__any((a) < 1.f)) { if (hi == 0) al_l[r32] = (a); asm volatile("s_waitcnt lgkmcnt(0)" ::: "memory"); \
    for (int d = 0; d < 4; ++d) for (int r = 0; r < 16; ++r) o[d][r] *= al_l[crow(r, hi)]; } } while (0)
  f32x16 pA0, pA1, pB0, pB1; float mnA, mnB, alA, alB; bf16x8 pa0, pa1, pa2, pa3; const int NT = seq / KVBLK;
  constexpr int SE = 0, SO = SDEPTH - 1;
  SLOAD(SE, 0); asm volatile("s_waitcnt vmcnt(0)" ::: "memory"); SWRITE(0, SE); __syncthreads();
  qkt(pA0, pA1, K_lds, qr, r32, hi, mcolB); partialSM(pA0, pA1, m_reg, mnA, alA);
  SLOAD(SO, KVBLK); if constexpr (SDEPTH == 2) { if (2 < NT) SLOAD(SE, 2 * KVBLK); }
  SWAIT(); SWRITE(1, SO); __syncthreads();
  for (int j = 1; j + 1 < NT; j += 2) {
    SBAR(); qkt(pB0, pB1, (bf16*)((char*)K_lds + SHM_K), qr, r32, hi, mcolB);
    finishSM(pA0, pA1, alA, l_reg, pa0, pa1, pa2, pa3); SBAR();
    SLOAD(SO, (j + SDEPTH) * KVBLK); SBAR();
    pv_d0(o, vb0, pa0, pa1, pa2, pa3); partialSM(pB0, pB1, m_reg, mnB, alB);
    __syncthreads(); SWAIT(); SWRITE(0, SE);
    RESC(alB); __syncthreads();
    SBAR(); qkt(pA0, pA1, K_lds, qr, r32, hi, mcolB);
    finishSM(pB0, pB1, alB, l_reg, pa0, pa1, pa2, pa3); SBAR();
    if (SDEPTH == 1 || j + 3 < NT) SLOAD(SE, (j + 1 + SDEPTH) * KVBLK); SBAR();
    pv_d0(o, vb0 + (int)SHM_V, pa0, pa1, pa2, pa3); partialSM(pA0, pA1, m_reg, mnA, alA);
    __syncthreads(); SWAIT(); SWRITE(1, SO);
    RESC(alA); __syncthreads();
  }
  SBAR(); qkt(pB0, pB1, (bf16*)((char*)K_lds + SHM_K), qr, r32, hi, mcolB);
  finishSM(pA0, pA1, alA, l_reg, pa0, pa1, pa2, pa3); SBAR();
  pv_d0(o, vb0, pa0, pa1, pa2, pa3); partialSM(pB0, pB1, m_reg, mnB, alB);
  __syncthreads(); RESC(alB);
  finishSM(pB0, pB1, alB, l_reg, pa0, pa1, pa2, pa3); SBAR();
  pv_d0(o, vb0 + (int)SHM_V, pa0, pa1, pa2, pa3);
  if (hi == 0) li_l[r32] = l_reg; asm volatile("s_waitcnt lgkmcnt(0)" ::: "memory");
  float rli[16];
#pragma unroll
  for (int r = 0; r < 16; ++r) rli[r] = __builtin_amdgcn_rcpf(li_l[crow(r, hi)]);
  float* EXO = (float*)(lds + 2 * SHM_V + 2 * SHM_K + NW * 64 * 4) + wq * (4 * 16 * 64) + lane;
  if (mw == 1) {
#pragma unroll
    for (int d0 = 0; d0 < 4; ++d0)
#pragma unroll
      for (int r = 0; r < 16; ++r) EXO[(d0 * 16 + r) * 64] = o[d0][r] * rli[r];
  }
  __syncthreads();
  if (mw == 0) {
    float ssq[16];
#pragma unroll
    for (int r = 0; r < 16; ++r) ssq[r] = 0.f;
#pragma unroll
    for (int d0 = 0; d0 < 4; ++d0)
#pragma unroll
      for (int r = 0; r < 16; ++r) { const float dv = o[d0][r] * rli[r] - lam * EXO[(d0 * 16 + r) * 64]; o[d0][r] = dv; ssq[r] += dv * dv; }
#pragma unroll
    for (int r = 0; r < 16; ++r) {
#pragma unroll
      for (int sft = 1; sft < 32; sft <<= 1) ssq[r] += __shfl_xor(ssq[r], sft);
      ssq[r] = rsqrtf(ssq[r] * (1.f / 128.f) + 1e-6f) * 0.8f;
    }
    bf16* Ow = Ob + (long)(wq * QBLK) * LDO;
#pragma unroll
    for (int d0 = 0; d0 < 4; ++d0) { const float gg = subln[d0 * 32 + r32];
#pragma unroll
      for (int r = 0; r < 16; ++r) { const float val = o[d0][r] * ssq[r] * gg; Ow[(long)crow(r, hi) * LDO + d0 * 32 + r32] = (bf16)(pg8::cvt_pk_bf16(val, val) & 0xffffu); } }
  }
  __syncthreads();
#undef SLOAD
#undef SWRITE
#undef SWAIT
#undef RESC
}
}

__device__ __forceinline__ void wave_argmax(float& v, int& i) {
#pragma unroll
  for (int o = 32; o; o >>= 1) {
    const float ov = __shfl_xor(v, o); const int oi = __shfl_xor(i, o);
    if (ov > v || (ov == v && oi < i)) { v = ov; i = oi; }
  }
}

__global__ void __launch_bounds__(NT) mega(Params p) {
  extern __shared__ __attribute__((aligned(16))) unsigned char lds[];
  cg::grid_group grid = cg::this_grid();
  if (threadIdx.x < 35) {
    unsigned long long v = threadIdx.x < 33 ? (unsigned long long)p.in[threadIdx.x] : (threadIdx.x == 33 ? (unsigned long long)p.out : (unsigned long long)p.ws);
    ((unsigned long long*)(lds + PTR_OFF))[threadIdx.x] = v;
  }
  __syncthreads();

  {
    PHASE_LOCALS
    float* MOD = (float*)WSP(WS_MOD); float* LAM = (float*)WSP(WS_LAM);
    float* ABRE = (float*)WSP(WS_ABRE); float* ABIM = (float*)WSP(WS_ABIM); float* BBRE = (float*)WSP(WS_BBRE); float* BBIM = (float*)WSP(WS_BBIM);
    const float* cin = INP(1); const float* c_ctx = INP(3); const float* ada_w = INP(4); const float* ada_b = INP(5);
    for (int it = gtid; it < 5 * 6144; it += gsz) {
      const int r = it / 6144, j = it % 6144;
      const float* cv = r < 4 ? cin + r * D : c_ctx;
      float a = 0.f;
      for (int k = 0; k < D; ++k) a += siluf_(cv[k]) * ada_w[(size_t)k * 6144 + j];
      MOD[it] = a + ada_b[j];
    }
    if (gtid == 0) {
      const float* q1 = INP(9); const float* k1 = INP(10); const float* q2 = INP(11); const float* k2 = INP(12);
      float s1 = 0.f, s2 = 0.f;
      for (int k = 0; k < 64; ++k) { s1 += q1[k] * k1[k]; s2 += q2[k] * k2[k]; }
      LAM[0] = expf(s1) - expf(s2) + 0.2f;
    }
    const float* a_re = INP(15); const float* a_im = INP(16); const float* ldt = INP(17); const float* b_re = INP(18); const float* b_im = INP(19);
    for (int it = gtid; it < 2 * 32 * 64; it += gsz) {
      const int dg = it >> 6;
      const float ar = a_re[it], ai = a_im[it], dt = expf(ldt[dg]);
      const float mag = expf(ar * dt), abr = mag * cosf(ai * dt), abi = mag * sinf(ai * dt);
      ABRE[it] = abr; ABIM[it] = abi; ((float*)WSP(WS_ARDT))[it] = ar * dt; ((float*)WSP(WS_AIDT))[it] = ai * dt;
      const float den = ar * ar + ai * ai, nr = abr - 1.f, ni = abi;
      const float fr = (nr * ar + ni * ai) / den, fi = (ni * ar - nr * ai) / den;
      for (int pp = 0; pp < 16; ++pp) {
        const float br = b_re[it * 16 + pp], bi = b_im[it * 16 + pp];
        BBRE[it * 16 + pp] = fr * br - fi * bi; BBIM[it * 16 + pp] = fr * bi + fi * br;
      }
    }
    float* ROPE = (float*)WSP(WS_ROPE);
    for (int it = gtid; it < 64 * 16; it += gsz) {
      const float ang = (float)(it >> 4) * powf(10000.f, -(float)(it & 15) / 16.f);
      ROPE[it * 2] = cosf(ang); ROPE[it * 2 + 1] = sinf(ang);
    }
    {
      float* scr = fl + wid * (64 * 33);
      constexpr int I_IN = 16 * 176, I_AU = 16 * 32, I_SU = 8 * 32, I_OUT = 16 * 32, I_Q = 16 * 32, I_GLU = 8 * 16;
      for (int it = gw; it < I_IN + I_AU + I_SU + I_OUT + I_Q + I_GLU; it += ngw) {
        int r = it;
        if (r < I_IN) { transpose_item(INP(8), 1024, N_IN, (bf16_t*)WSP(WS_WIN), scr, r, lane); continue; } r -= I_IN;
        if (r < I_AU) { transpose_item(INP(14), 1024, 1024, (bf16_t*)WSP(WS_WAU), scr, r, lane); continue; } r -= I_AU;
        if (r < I_SU) { transpose_item(INP(25), 512, 1024, (bf16_t*)WSP(WS_WSU), scr, r, lane); continue; } r -= I_SU;
        if (r < I_OUT) { transpose_item(INP(26), 1024, 1024, (bf16_t*)WSP(WS_WOUT), scr, r, lane); continue; } r -= I_OUT;
        if (r < I_Q) { transpose_item(INP(27), 1024, 1024, (bf16_t*)WSP(WS_WQ), scr, r, lane); continue; } r -= I_Q;
        transpose_item(INP(23), 512, 512, (bf16_t*)WSP(WS_WGLU), scr, r, lane);
      }
    }
  }
  grid.sync();

  {
    PHASE_LOCALS
    const float* MOD = (const float*)WSP(WS_MOD); bf16_t* XN = (bf16_t*)WSP(WS_XN);
    const float* x = INP(0); const float* ctx = INP(2); const float* norm1_g = INP(6);
    for (int row = gw; row < MX + MC; row += ngw) {
      const float* src; const float* md;
      if (row < MX) { src = x + (size_t)row * D; md = MOD + (row / L) * 6144; } else { src = ctx + (size_t)(row - MX) * D; md = MOD + 4 * 6144; }
      f32x4 v[4]; float ss = 0.f;
#pragma unroll
      for (int j = 0; j < 4; ++j) { v[j] = *(const f32x4*)(src + lane * 4 + 256 * j); ss += v[j][0] * v[j][0] + v[j][1] * v[j][1] + v[j][2] * v[j][2] + v[j][3] * v[j][3]; }
      const float rstd = rsqrtf(wave_sum(ss) * (1.f / D) + 1e-6f);
#pragma unroll
      for (int j = 0; j < 4; ++j)
#pragma unroll
        for (int e = 0; e < 4; ++e) { const int col = lane * 4 + 256 * j + e; XN[(size_t)row * D + col] = f2bf(v[j][e] * rstd * norm1_g[col] * (1.f + md[1024 + col]) + md[col]); }
    }
    const float* ARDT = (const float*)WSP(WS_ARDT); const float* AIDT = (const float*)WSP(WS_AIDT);
    const float* BBRE = (const float*)WSP(WS_BBRE); const float* BBIM = (const float*)WSP(WS_BBIM);
    {
      bf16_t* BTS = (bf16_t*)WSP(WS_BTS);
      for (int it = gtid; it < 32 * 256 * 32; it += gsz) {
        const int i = it & 31, r = (it >> 5) & 255, g = it >> 13;
        const int d = r >> 7, n = (r >> 1) & 63, ri = r & 1, sidx = (d * 32 + g) * 64 + n;
        const float e = (float)(d == 0 ? 31 - i : i);
        const float mag = expf(e * ARDT[sidx]), pr = mag * cosf(e * AIDT[sidx]), pi = mag * sinf(e * AIDT[sidx]);
        unsigned w[8];
#pragma unroll
        for (int q = 0; q < 8; ++q) {
          const float br0 = BBRE[sidx * 16 + 2 * q], bi0 = BBIM[sidx * 16 + 2 * q], br1 = BBRE[sidx * 16 + 2 * q + 1], bi1 = BBIM[sidx * 16 + 2 * q + 1];
          const float v0 = ri == 0 ? pr * br0 - pi * bi0 : pr * bi0 + pi * br0, v1 = ri == 0 ? pr * br1 - pi * bi1 : pr * bi1 + pi * br1;
          w[q] = pg8::cvt_pk_bf16(v0, v1);
        }
        u32x4* dst = (u32x4*)(BTS + ((size_t)g * 256 + r) * 512 + i * 16);
        dst[0] = (u32x4){w[0], w[1], w[2], w[3]}; dst[1] = (u32x4){w[4], w[5], w[6], w[7]};
      }
    }
    {
      float* KT = (float*)WSP(WS_KT); const float* c_re = INP(20); const float* c_im = INP(21);
      for (int it = gtid; it < 2 * 32 * 32 * 16; it += gsz) {
        const int pp = it & 15, m = (it >> 4) & 31, dg = it >> 9;
        float acc[16];
#pragma unroll
        for (int q = 0; q < 16; ++q) acc[q] = 0.f;
        for (int n = 0; n < 64; ++n) {
          const int sidx = dg * 64 + n;
          const float mag = expf((float)m * ARDT[sidx]), pr = mag * cosf((float)m * AIDT[sidx]), pi = mag * sinf((float)m * AIDT[sidx]);
          const float cr = c_re[(dg * 16 + pp) * 64 + n], ci = c_im[(dg * 16 + pp) * 64 + n];
          const float wr_ = cr * pr - ci * pi, wi_ = cr * pi + ci * pr;
#pragma unroll
          for (int q = 0; q < 16; ++q) acc[q] += wr_ * BBRE[sidx * 16 + q] - wi_ * BBIM[sidx * 16 + q];
        }
#pragma unroll
        for (int q = 0; q < 16; ++q) KT[((size_t)dg * 32 + m) * 256 + pp * 16 + q] = acc[q];
      }
    }
  }
  grid.sync();

  {
    pg8::Gemm g{(const bf16_t*)WSP(WS_XN), (const bf16_t*)WSP(WS_WIN), MX + MC, N_IN, D, D, D};
    InProjSched S; S.init((int)gridDim.x, (int)blockIdx.x);
    EpiInProj E{(bf16_t*)WSP(WS_Q), (bf16_t*)WSP(WS_K), (bf16_t*)WSP(WS_V), (bf16_t*)WSP(WS_SA), (bf16_t*)WSP(WS_G), (const float*)WSP(WS_ROPE)};
    pg8::gemm_phase<EpiInProj, InProjSched, true, true>((PG8_LAS unsigned char*)lds, g, S, E);
  }
  grid.sync();

  {
    const float lam = ((const float*)WSP(WS_LAM))[0];
    const bf16_t* Qb = (const bf16_t*)WSP(WS_Q); const bf16_t* Kb = (const bf16_t*)WSP(WS_K); const bf16_t* Vb = (const bf16_t*)WSP(WS_V);
    bf16_t* ATT = (bf16_t*)WSP(WS_ATT); const float* subln = INP(13);
    for (int unit = blockIdx.x; unit < Bn * 8 * (L / 128); unit += gridDim.x) {
      const int h = unit & 7, qb = (unit >> 3) & 31, b = unit >> 8;
      const size_t qoff = ((size_t)(b * L + qb * 128)) * 1024 + h * 128, koff = (size_t)b * LA * 1024 + h * 128;
      att::diff_attn_unit(Qb + qoff, Kb + koff, Vb + koff, ATT + qoff, LA, lam, subln, (char*)lds);
    }
  }
  grid.sync();

  {
    const bool gemm_blk = (blockIdx.x < 96) || (gridDim.x <= 96);
    if (gemm_blk) {
      pg8::Gemm g{(const bf16_t*)WSP(WS_SA), (const bf16_t*)WSP(WS_BTS), 0, 0, 512, SA_LD, 512};
      GroupSched S; S.init(32, 3, 1, (long)SA_ROWS * SA_LD * 2, (long)256 * SA_LD * 2, (long)256 * 512 * 2, 0, (int)(gridDim.x <= 96 ? gridDim.x : 96), (int)blockIdx.x);
      EpiS E{(float*)WSP(WS_S)};
      pg8::gemm_phase<EpiS, GroupSched, true, true>((PG8_LAS unsigned char*)lds, g, S, E);
    }
    if (!gemm_blk || gridDim.x <= 96) {
      PHASE_LOCALS
      const int wb = gridDim.x <= 96 ? (int)blockIdx.x : (int)blockIdx.x - 96, nwb = gridDim.x <= 96 ? (int)gridDim.x : (int)gridDim.x - 96;
      const float* KT = (const float*)WSP(WS_KT); const float* ARDT = (const float*)WSP(WS_ARDT); const float* AIDT = (const float*)WSP(WS_AIDT);
      const float* c_re = INP(20); const float* c_im = INP(21); const float* dsk = INP(22); bf16_t* BTY = (bf16_t*)WSP(WS_BTY);
      for (int it = wb * NT + tid; it < 32 * 512 * 96; it += nwb * NT) {
        const int cgp = it % 96, row = (it / 96) & 511, g = it / (96 * 512);
        const int j = row >> 4, pp = row & 15, col0 = cgp * 8;
        float v[8];
        if (col0 < 512) {
          const int i = col0 >> 4, q0 = col0 & 15;
#pragma unroll
          for (int e = 0; e < 8; ++e) v[e] = 0.f;
          if (i <= j) { const float* kp = KT + ((size_t)(0 * 32 + g) * 32 + (j - i)) * 256 + pp * 16 + q0;
#pragma unroll
            for (int e = 0; e < 8; ++e) v[e] += kp[e]; }
          if (i >= j) { const float* kp = KT + ((size_t)(1 * 32 + g) * 32 + (i - j)) * 256 + pp * 16 + q0;
#pragma unroll
            for (int e = 0; e < 8; ++e) v[e] += kp[e]; }
          if (i == j && pp >= q0 && pp < q0 + 8) {
#pragma unroll
            for (int e = 0; e < 8; ++e) if (q0 + e == pp) v[e] += dsk[g * 16 + pp];
          }
        } else {
          const int cc0 = col0 - 512, d = cc0 >> 7, n0 = (cc0 & 127) >> 1;
          const float ex = (float)(d == 0 ? j + 1 : 32 - j);
#pragma unroll
          for (int q = 0; q < 4; ++q) {
            const int n = n0 + q, sidx = (d * 32 + g) * 64 + n;
            const float mag = expf(ex * ARDT[sidx]), pr = mag * cosf(ex * AIDT[sidx]), pi = mag * sinf(ex * AIDT[sidx]);
            const float cr = c_re[((d * 32 + g) * 16 + pp) * 64 + n], ci = c_im[((d * 32 + g) * 16 + pp) * 64 + n];
            v[2 * q] = cr * pr - ci * pi; v[2 * q + 1] = -(cr * pi + ci * pr);
          }
        }
        u32x4 w; w.x = pg8::cvt_pk_bf16(v[0], v[1]); w.y = pg8::cvt_pk_bf16(v[2], v[3]); w.z = pg8::cvt_pk_bf16(v[4], v[5]); w.w = pg8::cvt_pk_bf16(v[6], v[7]);
        *(u32x4*)(BTY + ((size_t)g * 512 + row) * 768 + col0) = w;
      }
    }
  }
  grid.sync();

  {
    PHASE_LOCALS
    const float* ARDT = (const float*)WSP(WS_ARDT); const float* AIDT = (const float*)WSP(WS_AIDT);
    if (wid == 0) {
      for (int it = blockIdx.x; it < Bn * 32 * 2; it += gridDim.x) {
        const int d = it & 1, g = (it >> 1) & 31, b = it >> 6;
        const int sidx = (d * 32 + g) * 64 + lane;
        const float mag = expf(32.f * ARDT[sidx]), pr = mag * cosf(32.f * AIDT[sidx]), pi = mag * sinf(32.f * AIDT[sidx]);
        typedef float f32x2_ __attribute__((ext_vector_type(2)));
        const f32x2_* Sg = (const f32x2_*)((const float*)WSP(WS_S) + (size_t)g * SA_ROWS * 256) + d * 64 + lane;
        bf16_t* SAg = (bf16_t*)WSP(WS_SA) + (size_t)g * SA_ROWS * SA_LD + 512 + d * 128 + lane * 2;
        float hr = 0.f, hi = 0.f;
        f32x2_ sc[8];
#pragma unroll
        for (int k = 0; k < 8; ++k) { const int cc = d == 0 ? k : 7 - k; sc[k] = Sg[(size_t)(512 + b * 8 + cc) * 128]; }
#pragma unroll
        for (int k = 0; k < 8; ++k) { const float nr = pr * hr - pi * hi + sc[k][0], ni = pr * hi + pi * hr + sc[k][1]; hr = nr; hi = ni; }
        for (int k0 = 0; k0 < 128; k0 += 16) {
          f32x2_ sv[16];
#pragma unroll
          for (int k = 0; k < 16; ++k) { const int cx = d == 0 ? k0 + k : 127 - (k0 + k); sv[k] = Sg[(size_t)(b * 128 + cx) * 128]; }
#pragma unroll
          for (int k = 0; k < 16; ++k) {
            const int cx = d == 0 ? k0 + k : 127 - (k0 + k);
            *(unsigned*)(SAg + (size_t)(b * 128 + cx) * SA_LD) = pg8::cvt_pk_bf16(hr, hi);
            const float nr = pr * hr - pi * hi + sv[k][0], ni = pr * hi + pi * hr + sv[k][1]; hr = nr; hi = ni;
          }
        }
      }
    }
  }
  grid.sync();

  {
    pg8::Gemm g{(const bf16_t*)WSP(WS_SA), (const bf16_t*)WSP(WS_BTY), 0, 0, 768, SA_LD, 768};
    GroupSched S; S.init(32, 2, 2, (long)SA_ROWS * SA_LD * 2, (long)256 * SA_LD * 2, (long)512 * 768 * 2, (long)256 * 768 * 2, (int)gridDim.x, (int)blockIdx.x);
    EpiY E{(bf16_t*)WSP(WS_YG)};
    pg8::gemm_phase<EpiY, GroupSched, true, true>((PG8_LAS unsigned char*)lds, g, S, E);
  }
  grid.sync();

  {
    pg8::Gemm g{(const bf16_t*)WSP(WS_YG), (const bf16_t*)WSP(WS_WGLU), MX, 512, 512, 512, 512};
    pg8::StaticOrder S; S.init(MX, 512, (int)gridDim.x, (int)blockIdx.x, g.lda, g.ldb);
    EpiBf8<0> E{(bf16_t*)WSP(WS_SSMX), 512, (const bf16_t*)WSP(WS_YG), 512, INP(24)};
    pg8::gemm_phase<EpiBf8<0>, pg8::StaticOrder, true, true>((PG8_LAS unsigned char*)lds, g, S, E);
  }
  grid.sync();

  {
    pg8::Gemm g{(const bf16_t*)WSP(WS_ATT), (const bf16_t*)WSP(WS_WAU), MX, 1024, 1024, 1024, 1024};
    pg8::StaticOrder S; S.init(MX, 1024, (int)gridDim.x, (int)blockIdx.x, g.lda, g.ldb);
    EpiBf8<1> E{(bf16_t*)WSP(WS_M), 1024, (const bf16_t*)WSP(WS_G), 2048, nullptr};
    pg8::gemm_phase<EpiBf8<1>, pg8::StaticOrder, true, true>((PG8_LAS unsigned char*)lds, g, S, E);
  }
  grid.sync();
  {
    pg8::Gemm g{(const bf16_t*)WSP(WS_SSMX), (const bf16_t*)WSP(WS_WSU), MX, 1024, 512, 512, 512};
    pg8::StaticOrder S; S.init(MX, 1024, (int)gridDim.x, (int)blockIdx.x, g.lda, g.ldb);
    EpiBf8<2> E{(bf16_t*)WSP(WS_M), 1024, (const bf16_t*)WSP(WS_G) + 1024, 2048, nullptr};
    pg8::gemm_phase<EpiBf8<2>, pg8::StaticOrder, true, true>((PG8_LAS unsigned char*)lds, g, S, E);
  }
  grid.sync();
  {
    pg8::Gemm g{(const bf16_t*)WSP(WS_M), (const bf16_t*)WSP(WS_WOUT), MX, 1024, 1024, 1024, 1024};
    pg8::StaticOrder S; S.init(MX, 1024, (int)gridDim.x, (int)blockIdx.x, g.lda, g.ldb);
    EpiF32<1> E{(float*)WSP(WS_X1), INP(0), (const float*)WSP(WS_MOD)};
    pg8::gemm_phase<EpiF32<1>, pg8::StaticOrder, true, true>((PG8_LAS unsigned char*)lds, g, S, E);
  }
  grid.sync();
  {
    PHASE_LOCALS
    const float* X1 = (const float*)WSP(WS_X1); const float* MOD = (const float*)WSP(WS_MOD); bf16_t* XN2 = (bf16_t*)WSP(WS_XN2); const float* norm2_g = INP(7);
    for (int row = gw; row < MX; row += ngw) {
      const float* src = X1 + (size_t)row * D; const float* md = MOD + (row / L) * 6144;
      f32x4 v[4]; float ss = 0.f;
#pragma unroll
      for (int j = 0; j < 4; ++j) { v[j] = *(const f32x4*)(src + lane * 4 + 256 * j); ss += v[j][0] * v[j][0] + v[j][1] * v[j][1] + v[j][2] * v[j][2] + v[j][3] * v[j][3]; }
      const float rstd = rsqrtf(wave_sum(ss) * (1.f / D) + 1e-6f);
#pragma unroll
      for (int j = 0; j < 4; ++j)
#pragma unroll
        for (int e = 0; e < 4; ++e) { const int col = lane * 4 + 256 * j + e; XN2[(size_t)row * D + col] = f2bf(v[j][e] * rstd * norm2_g[col] * (1.f + md[4096 + col]) + md[3072 + col]); }
    }
  }
  grid.sync();
  {
    pg8::Gemm g{(const bf16_t*)WSP(WS_XN2), (const bf16_t*)WSP(WS_WQ), MX, 1024, 1024, 1024, 1024};
    pg8::StaticOrder S; S.init(MX, 1024, (int)gridDim.x, (int)blockIdx.x, g.lda, g.ldb);
    EpiF32<0> E{(float*)WSP(WS_QP), nullptr, nullptr};
    pg8::gemm_phase<EpiF32<0>, pg8::StaticOrder, true, true>((PG8_LAS unsigned char*)lds, g, S, E);
  }
  grid.sync();
  {
    PHASE_LOCALS
    const float* QP = (const float*)WSP(WS_QP); int* IDX = (int*)WSP(WS_IDX); float* GATE = (float*)WSP(WS_GATE);
    const float* sk1 = INP(28); const float* sk2 = INP(29);
    float* SK = fl;
    for (int i = tid; i < 128 * 64; i += NT) { SK[(i >> 6) * 65 + (i & 63)] = sk1[i]; SK[128 * 65 + (i >> 6) * 65 + (i & 63)] = sk2[i]; }
    __syncthreads();
    for (int it = gw; it < MX * 8; it += ngw) {
      const int t = it >> 3, h = it & 7;
      const float* qp = QP + (size_t)t * 1024 + h * 128;
      const float qa = qp[lane], qb2 = qp[64 + lane];
      float s1a = 0.f, s1b = 0.f, s2a = 0.f, s2b = 0.f;
      for (int dd = 0; dd < 64; ++dd) {
        const float q1 = __shfl(qa, dd), q2 = __shfl(qb2, dd);
        s1a += q1 * SK[lane * 65 + dd]; s1b += q1 * SK[(lane + 64) * 65 + dd];
        s2a += q2 * SK[128 * 65 + lane * 65 + dd]; s2b += q2 * SK[128 * 65 + (lane + 64) * 65 + dd];
      }
      float v1 = 0.f, v2 = 0.f; int i1 = 0, i2 = 0;
      for (int r = 0; r < 16; ++r) {
        float bv = s1a; int bi = lane; if (s1b > bv) { bv = s1b; bi = lane + 64; }
        wave_argmax(bv, bi);
        if (bi == lane) s1a = -3e38f;
        if (bi == lane + 64) s1b = -3e38f;
        if (lane == r) { v1 = bv; i1 = bi; }
        bv = s2a; bi = lane; if (s2b > bv) { bv = s2b; bi = lane + 64; }
        wave_argmax(bv, bi);
        if (bi == lane) s2a = -3e38f;
        if (bi == lane + 64) s2b = -3e38f;
        if (lane == r) { v2 = bv; i2 = bi; }
      }
      const float vb = __shfl(v2, lane & 15);
      float cs[4];
#pragma unroll
      for (int j = 0; j < 4; ++j) cs[j] = __shfl(v1, (lane >> 4) + 4 * j) + vb;
      float tv = 0.f; int tcand = 0;
      for (int r = 0; r < 16; ++r) {
        float bv = cs[0]; int bi = ((lane >> 4) + 0) * 16 + (lane & 15);
#pragma unroll
        for (int j = 1; j < 4; ++j) { const int ci = ((lane >> 4) + 4 * j) * 16 + (lane & 15); if (cs[j] > bv) { bv = cs[j]; bi = ci; } }
        wave_argmax(bv, bi);
#pragma unroll
        for (int j = 0; j < 4; ++j) { const int ci = ((lane >> 4) + 4 * j) * 16 + (lane & 15); if (ci == bi) cs[j] = -3e38f; }
        if (lane == r) { tv = bv; tcand = bi; }
      }
      const int e1 = __shfl(i1, tcand >> 4), e2 = __shfl(i2, tcand & 15);
      const float mx = __shfl(tv, 0);
      const float ex = lane < 16 ? __expf(tv - mx) : 0.f;
      const float den = wave_sum(ex);
      if (lane < 16) { IDX[(size_t)it * 16 + lane] = e1 * 128 + e2; GATE[(size_t)it * 16 + lane] = ex / den; }
    }
    __syncthreads();
  }
  grid.sync();
  {
    PHASE_LOCALS
    const float* X1 = (const float*)WSP(WS_X1); const float* MOD = (const float*)WSP(WS_MOD); const bf16_t* XN2 = (const bf16_t*)WSP(WS_XN2);
    const int* IDX = (const int*)WSP(WS_IDX); const float* GATE = (const float*)WSP(WS_GATE);
    const float* pu = INP(30); const float* pv = INP(31); const float* fng = INP(32); float* out = (float*)ldptr_(33);
    for (int row = gw; row < MX; row += ngw) {
      const float* md = MOD + (row / L) * 6144;
      float xv[16], acc[16];
#pragma unroll
      for (int j = 0; j < 4; ++j)
#pragma unroll
        for (int e = 0; e < 4; ++e) { xv[j * 4 + e] = bf2f(XN2[(size_t)row * D + lane * 4 + 256 * j + e]); acc[j * 4 + e] = 0.f; }
      for (int i = 0; i < 128; ++i) {
        const int ex = IDX[(size_t)row * 128 + i]; const float gt = GATE[(size_t)row * 128 + i];
        const float* ur = pu + (size_t)ex * D; const float* vr = pv + (size_t)ex * D;
        float dp = 0.f;
#pragma unroll
        for (int j = 0; j < 4; ++j) { const f32x4 uu = *(const f32x4*)(ur + lane * 4 + 256 * j); dp += uu[0] * xv[j * 4] + uu[1] * xv[j * 4 + 1] + uu[2] * xv[j * 4 + 2] + uu[3] * xv[j * 4 + 3]; }
        const float cf = gt * gelu_tanh(wave_sum(dp));
#pragma unroll
        for (int j = 0; j < 4; ++j) { const f32x4 vv = *(const f32x4*)(vr + lane * 4 + 256 * j); acc[j * 4] += cf * vv[0]; acc[j * 4 + 1] += cf * vv[1]; acc[j * 4 + 2] += cf * vv[2]; acc[j * 4 + 3] += cf * vv[3]; }
      }
      float ss = 0.f; float x2[16];
#pragma unroll
      for (int j = 0; j < 4; ++j)
#pragma unroll
        for (int e = 0; e < 4; ++e) { const int col = lane * 4 + 256 * j + e; const float v = X1[(size_t)row * D + col] + md[5120 + col] * acc[j * 4 + e]; x2[j * 4 + e] = v; ss += v * v; }
      const float rstd = rsqrtf(wave_sum(ss) * (1.f / D) + 1e-6f);
#pragma unroll
      for (int j = 0; j < 4; ++j) {
        f32x4 o4;
#pragma unroll
        for (int e = 0; e < 4; ++e) o4[e] = x2[j * 4 + e] * rstd * fng[lane * 4 + 256 * j + e];
        *(f32x4*)(out + (size_t)row * D + lane * 4 + 256 * j) = o4;
      }
    }
  }
}

extern "C" void kernel_launch(void* const* d_in, const int* in_sizes, int n_in, void* d_out, int out_size, void* d_ws, size_t ws_size, hipStream_t stream) {
  static int grid_blocks = 0;
  if (!grid_blocks) {
    int dev = 0, cus = 0, per_cu = 0;
    (void)hipGetDevice(&dev);
    (void)hipDeviceGetAttribute(&cus, hipDeviceAttributeMultiprocessorCount, dev);
    (void)hipFuncSetAttribute((const void*)mega, hipFuncAttributeMaxDynamicSharedMemorySize, LDS_BYTES);
    (void)hipOccupancyMaxActiveBlocksPerMultiprocessor(&per_cu, (const void*)mega, NT, LDS_BYTES);
    if (per_cu < 1) per_cu = 1;
    grid_blocks = cus * per_cu;
    if (n_in != 33 || ws_size < 255 * MiB) { fprintf(stderr, "kernel_launch: unexpected n_in %d / ws %zu\n", n_in, ws_size); }
  }
  Params p{};
  for (int i = 0; i < 33 && i < n_in; ++i) p.in[i] = (const float*)d_in[i];
  p.out = (float*)d_out; p.ws = (unsigned char*)d_ws;
  void* args[] = {&p};
  hipError_t e = hipLaunchCooperativeKernel((const void*)mega, dim3(grid_blocks), dim3(NT), args, LDS_BYTES, stream);
  if (e != hipSuccess) fprintf(stderr, "cooperative launch failed: %s (grid %d)\n", hipGetErrorString(e), grid_blocks);
}
```

```cpp
#include <hip/hip_runtime.h>
#include <hip/hip_cooperative_groups.h>
#include <cstdio>
#include <cstdint>
namespace cg = cooperative_groups;

typedef unsigned short bf16_t;
typedef float f32x4 __attribute__((ext_vector_type(4)));

constexpr int NT = 512;
constexpr int LDS_BYTES = 147456;
constexpr int Bn = 4, L = 4096, D = 1024, NCTX = 256, LA = L + NCTX;
constexpr int MX = Bn * L, MC = Bn * NCTX;
constexpr int N_IN = 5632;
constexpr size_t MiB = 1u << 20;
constexpr size_t WS_MOD = 0, WS_LAM = 128 * 1024, WS_ROPE = 136 * 1024, WS_ARDT = 144 * 1024, WS_AIDT = 160 * 1024;
constexpr size_t WS_ABRE = 192 * 1024, WS_ABIM = 224 * 1024, WS_BBRE = 256 * 1024, WS_BBIM = 512 * 1024;
constexpr size_t WS_KT = 2 * MiB;
constexpr size_t WS_XN = 4 * MiB, WS_Q = 38 * MiB, WS_K = 70 * MiB, WS_V = 104 * MiB, WS_SA = 138 * MiB, WS_G = 164 * MiB;
constexpr size_t WS_WIN = 228 * MiB, WS_WAU = 239 * MiB, WS_WSU = 241 * MiB, WS_WOUT = 242 * MiB, WS_WQ = 244 * MiB, WS_WGLU = 246 * MiB;
constexpr size_t WS_BTS = 247 * MiB;
constexpr size_t WS_BTY = 38 * MiB, WS_S = 62 * MiB, WS_YG = 79 * MiB, WS_SSMX = 95 * MiB, WS_M = 111 * MiB;
constexpr size_t WS_ATT = WS_XN, WS_X1 = 38 * MiB, WS_XN2 = WS_XN, WS_QP = WS_G;
constexpr size_t WS_IDX = 111 * MiB, WS_GATE = 115 * MiB, WS_SSQ = 123 * MiB;
constexpr size_t WS_U8 = 127 * MiB, WS_PD = 164 * MiB, WS_V8 = 196 * MiB;
constexpr int SA_ROWS = 544, SA_LD = 768;

constexpr int PTR_OFF = LDS_BYTES - 1024;
__device__ __forceinline__ unsigned long long ldptr_(int k) {
  extern __shared__ __attribute__((aligned(16))) unsigned char lds_[];
  const unsigned long long v = ((const unsigned long long*)(lds_ + PTR_OFF))[k];
  const unsigned lo = __builtin_amdgcn_readfirstlane((unsigned)v), hi = __builtin_amdgcn_readfirstlane((unsigned)(v >> 32));
  return ((unsigned long long)hi << 32) | lo;
}
#define INP(k) ((const float*)ldptr_(k))
#define WSP(off) ((unsigned char*)ldptr_(34) + (off))
#define PHASE_LOCALS \
  int tid = threadIdx.x; asm volatile("" : "+v"(tid)); \
  const int lane = tid & 63, wid = tid >> 6; \
  const int gtid = blockIdx.x * NT + tid, gsz = gridDim.x * NT; \
  const int gw = blockIdx.x * (NT / 64) + wid, ngw = gridDim.x * (NT / 64); \
  float* fl = (float*)lds; (void)lane; (void)wid; (void)gtid; (void)gsz; (void)gw; (void)ngw; (void)fl;

struct Params {
  const float* in[33];
  float* out;
  unsigned char* ws;
  int pad0, pad1;
};

__device__ __forceinline__ float bf2f(bf16_t v) { return __uint_as_float(((unsigned)v) << 16); }
__device__ __forceinline__ bf16_t f2bf(float f) { unsigned u = __float_as_uint(f); return (bf16_t)((u + 0x7fffu + ((u >> 16) & 1u)) >> 16); }
__device__ __forceinline__ float wave_sum(float v) {
#pragma unroll
  for (int o = 32; o; o >>= 1) v += __shfl_xor(v, o);
  return v;
}
__device__ __forceinline__ float gelu_tanh(float x) { return 0.5f * x * (1.f + tanhf(0.7978845608028654f * (x + 0.044715f * x * x * x))); }
__device__ __forceinline__ float sigmoidf_(float x) { return 1.f / (1.f + __expf(-x)); }
__device__ __forceinline__ float siluf_(float x) { return x / (1.f + __expf(-x)); }

template <class Epi>
__device__ __forceinline__ void sgemm(const bf16_t* A, int lda, const float* Bm, int ldb, int M, int N, int K, float* lds, Epi epi) {
  constexpr int TM = 128, TN = 128, TK = 16, LDA_S = TM + 4, LDB_S = TN + 4;
  float* As = lds;
  float* Bs = lds + TK * LDA_S;
  const int tid = threadIdx.x, ty = tid >> 4, tx = tid & 15;
  const int ntm = M / TM, ntn = N / TN;
  for (int tile = blockIdx.x; tile < ntm * ntn; tile += gridDim.x) {
    const int tm = tile / ntn, tn = tile % ntn;
    float acc[4][8];
#pragma unroll
    for (int i = 0; i < 4; ++i)
#pragma unroll
      for (int j = 0; j < 8; ++j) acc[i][j] = 0.f;
    const int ar = tid >> 2, ak = (tid & 3) * 4;
    const int bk = tid >> 5, bn = (tid & 31) * 4;
    for (int k0 = 0; k0 < K; k0 += TK) {
      const bf16_t* ap = A + (size_t)(tm * TM + ar) * lda + k0 + ak;
      const unsigned long long av = *(const unsigned long long*)ap;
      const f32x4 bv = *(const f32x4*)(Bm + (size_t)(k0 + bk) * ldb + tn * TN + bn);
      __syncthreads();
      As[(ak + 0) * LDA_S + ar] = bf2f((bf16_t)(av & 0xffff));
      As[(ak + 1) * LDA_S + ar] = bf2f((bf16_t)((av >> 16) & 0xffff));
      As[(ak + 2) * LDA_S + ar] = bf2f((bf16_t)((av >> 32) & 0xffff));
      As[(ak + 3) * LDA_S + ar] = bf2f((bf16_t)((av >> 48) & 0xffff));
      *(f32x4*)(Bs + bk * LDB_S + bn) = bv;
      __syncthreads();
#pragma unroll
      for (int k = 0; k < TK; ++k) {
        const f32x4 a4 = *(const f32x4*)(As + k * LDA_S + ty * 4);
        const f32x4 b0 = *(const f32x4*)(Bs + k * LDB_S + tx * 8);
        const f32x4 b1 = *(const f32x4*)(Bs + k * LDB_S + tx * 8 + 4);
#pragma unroll
        for (int i = 0; i < 4; ++i) {
          acc[i][0] += a4[i] * b0[0]; acc[i][1] += a4[i] * b0[1]; acc[i][2] += a4[i] * b0[2]; acc[i][3] += a4[i] * b0[3];
          acc[i][4] += a4[i] * b1[0]; acc[i][5] += a4[i] * b1[1]; acc[i][6] += a4[i] * b1[2]; acc[i][7] += a4[i] * b1[3];
        }
      }
    }
#pragma unroll
    for (int i = 0; i < 4; ++i)
#pragma unroll
      for (int j = 0; j < 8; ++j) epi(tm * TM + ty * 4 + i, tn * TN + tx * 8 + j, acc[i][j]);
  }
  __syncthreads();
}

namespace pg8 {
#define PG8_LAS __attribute__((address_space(3)))
typedef unsigned short bf16_t;
typedef short bf16x8 __attribute__((ext_vector_type(8)));
typedef float f32x4 __attribute__((ext_vector_type(4)));
typedef unsigned u32x4 __attribute__((ext_vector_type(4)));
constexpr int BM = 256, BK = 64, HALF = 128, HTB = HALF * BK * 2  , STAGE_BYTES = 8 * HTB, NXCD = 8, WGM = 8;

__host__ __device__ __forceinline__ int lds_byte(int r, int c) { const int st = (r >> 4) * 2 + (c >> 5), rr = r & 15, cc = c & 31, ob = rr * 64 + cc * 2; return st * 1024 + (ob ^ (((ob >> 9) & 1) << 5)); }
__host__ __device__ __forceinline__ void stage_rc(int b, int& R, int& C) { const int st = b / 1024, sb = b % 1024, swz = sb ^ (((sb >> 9) & 1) << 5); R = (st >> 1) * 16 + swz / 64; C = (st & 1) * 32 + (swz % 64) / 2; }
__host__ __device__ __forceinline__ int perm32(int rho) { const int n = rho >> 4, i = rho & 15; return 8 * (i >> 2) + 4 * n + (i & 3); }

struct Unit { int pm, pn, grp; long ao, bo; };
struct Gemm { const bf16_t* A; const bf16_t* Bt; int M, N, K, lda, ldb; };

struct StaticOrder {
    int nM, nN, nwg, G, c; long tsA, tsB;
    __host__ __device__ void init(int M, int N, int G_, int c_, int lda, int ldb) { nM = M / BM; nN = N / BM; nwg = nM * nN; G = G_; c = c_; tsA = (long)BM * lda * 2; tsB = (long)BM * ldb * 2; }
    __host__ __device__ bool next(int i, Unit& u) const {
        const long L = (long)i * G + c; if (L >= nwg) return false;
        int wgid = (int)L; { const int q = nwg / NXCD, r = nwg % NXCD, xcd = wgid % NXCD, off = wgid / NXCD; wgid = (xcd < r ? xcd * (q + 1) : r * (q + 1) + (xcd - r) * q) + off; }
        const int nig = WGM * nN, gid = wgid / nig, fm = gid * WGM, gsz = (nM - fm) < WGM ? (nM - fm) : WGM;
        u.pm = fm + ((wgid % nig) % gsz); u.pn = (wgid % nig) / gsz; u.grp = 0; u.ao = u.pm * tsA; u.bo = u.pn * tsB; return true;
    }
    __device__ __forceinline__ void a_ready(const Unit&) const {}
    __device__ __forceinline__ void done(const Unit&) const {}
};

__device__ __forceinline__ unsigned cvt_pk_bf16(float lo, float hi) { unsigned r; asm volatile("v_cvt_pk_bf16_f32 %0, %1, %2" : "=v"(r) : "v"(lo), "v"(hi)); return r; }
template <class Epi, class Sched, bool ALIGN_EPI = false, bool SP2 = false>
__device__ __forceinline__ void gemm_phase(PG8_LAS unsigned char* lds, const Gemm g, const Sched& S, const Epi& E) {
    const int tid = threadIdx.x, wid = __builtin_amdgcn_readfirstlane(tid >> 6), lane = tid & 63, wr = wid >> 2, wc = wid & 3, fr = lane & 15, fq = lane >> 4;
    const int K = g.K, nt = K / BK;
    unsigned voffA[2], voffB[2];
#pragma unroll
    for (int i = 0; i < 2; ++i) { int R, C; stage_rc(tid * 16 + i * 8192, R, C); const int Rb = Epi::PERM ? ((R & ~31) + perm32(R & 31)) : R;
        voffA[i] = (unsigned)(R * g.lda + C) * 2u; voffB[i] = (unsigned)(Rb * g.ldb + C) * 2u; }
    const size_t kstep = (size_t)(BK * 2);
    const size_t hstepA = (size_t)HALF * g.lda * 2, hstepB = (size_t)HALF * g.ldb * 2;
    const unsigned ldsw = (unsigned)wid * 1024u;
    const int aoff = lds_byte(wr * 64 + fr, fq * 8), boff = lds_byte(wc * 32 + fr, fq * 8);
#define PG8_SA(b, h) (((b) * 2 + (h)) * HTB)
#define PG8_SB(b, h) ((4 + (b) * 2 + (h)) * HTB)
#define PG8_STAGE(bufoff, gbase, voff) do { _Pragma("unroll") for (int _i = 0; _i < 2; ++_i) \
        __builtin_amdgcn_global_load_lds((const unsigned*)((const char*)(gbase) + (voff)[_i]), (PG8_LAS unsigned*)(lds + (bufoff) + ldsw + _i * 8192), 16, 0, 0); } while (0)
#define PG8_LDA(dst, b, h) do { _Pragma("unroll") for (int m = 0; m < 4; ++m) _Pragma("unroll") for (int k = 0; k < 2; ++k) dst[m][k] = *(const PG8_LAS bf16x8*)(lds + PG8_SA(b, h) + aoff + m * 2048 + k * 1024); } while (0)
#define PG8_LDB(dst, b, h) do { _Pragma("unroll") for (int n = 0; n < 2; ++n) _Pragma("unroll") for (int k = 0; k < 2; ++k) dst[n][k] = *(const PG8_LAS bf16x8*)(lds + PG8_SB(b, h) + boff + n * 2048 + k * 1024); } while (0)
#define PG8_MMA(ai, bj, At, Bt) do { __builtin_amdgcn_s_setprio(1); _Pragma("unroll") for (int m = 0; m < 4; ++m) _Pragma("unroll") for (int n = 0; n < 2; ++n) _Pragma("unroll") for (int k = 0; k < 2; ++k) \
        acc[ai][bj][m][n] = __builtin_amdgcn_mfma_f32_16x16x32_bf16(Bt[n][k], At[m][k], acc[ai][bj][m][n], 0, 0, 0); __builtin_amdgcn_s_setprio(0); } while (0)
#define PG8_WAIT_V(n) asm volatile("s_waitcnt vmcnt(" #n ")" ::: "memory")
#define PG8_WAIT_L(n) asm volatile("s_waitcnt lgkmcnt(" #n ")" ::: "memory")
#define PG8_BAR __builtin_amdgcn_s_barrier()
#define PG8_SCHED __builtin_amdgcn_sched_barrier(0)
    Unit cur, nxt; int ui = 0;
    if (!S.next(0, cur)) return;
    f32x4 acc[2][2][4][2];
#pragma unroll
    for (int a = 0; a < 2; ++a)
#pragma unroll
        for (int b = 0; b < 2; ++b)
#pragma unroll
            for (int m = 0; m < 4; ++m)
#pragma unroll
                for (int n = 0; n < 2; ++n) acc[a][b][m][n] = (f32x4){0.f, 0.f, 0.f, 0.f};
    bf16x8 At[4][2], B0[2][2], B1[2][2];
    const char* cA = (const char*)g.A + cur.ao; const char* cB = (const char*)g.Bt + cur.bo;
    S.a_ready(cur);
    if constexpr (SP2) {
        PG8_STAGE(PG8_SB(0, 0), cB, voffB); PG8_STAGE(PG8_SB(0, 1), cB + hstepB, voffB); PG8_STAGE(PG8_SA(0, 0), cA, voffA); PG8_STAGE(PG8_SA(0, 1), cA + hstepA, voffA);
        if (wr == 1) PG8_BAR;
        PG8_WAIT_V(2); PG8_BAR;
        PG8_STAGE(PG8_SB(1, 0), cB + kstep, voffB); PG8_STAGE(PG8_SA(1, 0), cA + kstep, voffA); PG8_STAGE(PG8_SB(1, 1), cB + hstepB + kstep, voffB);
        PG8_WAIT_V(6); PG8_BAR;
    } else {
        PG8_STAGE(PG8_SB(0, 0), cB, voffB); PG8_STAGE(PG8_SA(0, 0), cA, voffA); PG8_STAGE(PG8_SB(0, 1), cB + hstepB, voffB); PG8_STAGE(PG8_SA(0, 1), cA + hstepA, voffA);
        if (wr == 1) PG8_BAR;
        PG8_WAIT_V(4); PG8_BAR;
        PG8_STAGE(PG8_SB(1, 0), cB + kstep, voffB); PG8_STAGE(PG8_SA(1, 0), cA + kstep, voffA); PG8_STAGE(PG8_SB(1, 1), cB + hstepB + kstep, voffB);
        PG8_WAIT_V(6); PG8_BAR;
    }
    for (;;) {
        const bool has_next = S.next(ui + 1, nxt);
        const char* nA = has_next ? (const char*)g.A + nxt.ao : cA; const char* nB = has_next ? (const char*)g.Bt + nxt.bo : cB;
        for (int t = 0; t < nt; t += 2) {
            const bool last = (t == nt - 2);
            const char* a1 = cA + (size_t)(t + 1) * kstep;
            const char* a2 = last ? nA : cA + (size_t)(t + 2) * kstep; const char* b2 = last ? nB : cB + (size_t)(t + 2) * kstep;
            const char* a3 = a2 + kstep; const char* b3 = b2 + kstep;
            if (last && has_next) S.a_ready(nxt);
            if constexpr (SP2) {
            PG8_LDB(B0, 0, 0); PG8_LDB(B1, 0, 1); PG8_SCHED; PG8_LDA(At, 0, 0); PG8_STAGE(PG8_SA(1, 1), a1 + hstepA, voffA);
            PG8_WAIT_V(8); PG8_WAIT_L(0); PG8_BAR; PG8_MMA(0, 0, At, B0); PG8_MMA(0, 1, At, B1); PG8_BAR; PG8_SCHED;
            PG8_LDA(At, 0, 1); PG8_STAGE(PG8_SB(0, 0), b2, voffB); PG8_STAGE(PG8_SB(0, 1), b2 + hstepB, voffB); PG8_STAGE(PG8_SA(0, 0), a2, voffA);
            PG8_WAIT_V(8); PG8_WAIT_L(0); PG8_BAR; PG8_MMA(1, 0, At, B0); PG8_MMA(1, 1, At, B1); PG8_BAR; PG8_SCHED;
            PG8_LDB(B0, 1, 0); PG8_LDB(B1, 1, 1); PG8_SCHED; PG8_LDA(At, 1, 0); PG8_STAGE(PG8_SA(0, 1), a2 + hstepA, voffA);
            PG8_WAIT_V(8); PG8_WAIT_L(0); PG8_BAR; PG8_MMA(0, 0, At, B0); PG8_MMA(0, 1, At, B1); PG8_BAR; PG8_SCHED;
            PG8_LDA(At, 1, 1); PG8_STAGE(PG8_SB(1, 0), b3, voffB); PG8_STAGE(PG8_SB(1, 1), b3 + hstepB, voffB); PG8_STAGE(PG8_SA(1, 0), a3, voffA);
            PG8_WAIT_V(8); PG8_WAIT_L(0); PG8_BAR; PG8_MMA(1, 0, At, B0); PG8_MMA(1, 1, At, B1); PG8_BAR; PG8_SCHED;
            } else {
            PG8_LDB(B0, 0, 0); PG8_SCHED; PG8_LDA(At, 0, 0); PG8_STAGE(PG8_SA(1, 1), a1 + hstepA, voffA);
            PG8_WAIT_L(8); PG8_BAR; PG8_WAIT_L(0); PG8_MMA(0, 0, At, B0); PG8_BAR; PG8_SCHED;
            PG8_LDB(B1, 0, 1); PG8_STAGE(PG8_SB(0, 0), b2, voffB);
            PG8_BAR; PG8_WAIT_L(0); PG8_MMA(0, 1, At, B1); PG8_BAR;
            PG8_LDA(At, 0, 1); PG8_STAGE(PG8_SA(0, 0), a2, voffA);
            PG8_BAR; PG8_WAIT_L(0); PG8_MMA(1, 0, At, B0); PG8_BAR; PG8_SCHED;
            PG8_STAGE(PG8_SB(0, 1), b2 + hstepB, voffB);
            PG8_WAIT_V(6); PG8_BAR; PG8_MMA(1, 1, At, B1); PG8_BAR;
            PG8_LDB(B0, 1, 0); PG8_SCHED; PG8_LDA(At, 1, 0); PG8_STAGE(PG8_SA(0, 1), a2 + hstepA, voffA);
            PG8_WAIT_L(8); PG8_BAR; PG8_WAIT_L(0); PG8_MMA(0, 0, At, B0); PG8_BAR; PG8_SCHED;
            PG8_LDB(B1, 1, 1); PG8_STAGE(PG8_SB(1, 0), b3, voffB);
            PG8_BAR; PG8_WAIT_L(0); PG8_MMA(0, 1, At, B1); PG8_BAR;
            PG8_LDA(At, 1, 1); PG8_STAGE(PG8_SA(1, 0), a3, voffA);
            PG8_BAR; PG8_WAIT_L(0); PG8_MMA(1, 0, At, B0); PG8_BAR; PG8_SCHED;
            PG8_STAGE(PG8_SB(1, 1), b3 + hstepB, voffB);
            PG8_WAIT_V(6); PG8_BAR; PG8_MMA(1, 1, At, B1); PG8_BAR;
            }
        }
        if constexpr (ALIGN_EPI) { if (wr == 0) PG8_BAR; }
        if constexpr (!Epi::AFTER_DRAIN) { E(acc, cur, wr, wc, fr, fq); S.done(cur); }
        if (!has_next) break;
#pragma unroll
        for (int a = 0; a < 2; ++a)
#pragma unroll
            for (int b = 0; b < 2; ++b)
#pragma unroll
                for (int m = 0; m < 4; ++m)
#pragma unroll
                    for (int n = 0; n < 2; ++n) acc[a][b][m][n] = (f32x4){0.f, 0.f, 0.f, 0.f};
        cur = nxt; cA = nA; cB = nB; ++ui;
        if constexpr (ALIGN_EPI) { if (wr == 1) PG8_BAR; }
    }
    PG8_WAIT_V(0);
    if constexpr (!ALIGN_EPI) { if (wr == 0) PG8_BAR; }
    PG8_BAR;
    if constexpr (Epi::AFTER_DRAIN) { E.fused(acc, cur, wr, wc, fr, fq, lds, wid, lane); S.done(cur); }
#undef PG8_SA
#undef PG8_SB
#undef PG8_STAGE
#undef PG8_LDA
#undef PG8_LDB
#undef PG8_MMA
#undef PG8_WAIT_V
#undef PG8_WAIT_L
#undef PG8_BAR
#undef PG8_SCHED
}
}


using pg8::Unit;
typedef unsigned u32x2 __attribute__((ext_vector_type(2)));
typedef unsigned u32x4 __attribute__((ext_vector_type(4)));
__device__ __forceinline__ float bflo(unsigned w) { return __uint_as_float(w << 16); }
__device__ __forceinline__ float bfhi(unsigned w) { return __uint_as_float(w & 0xffff0000u); }

struct InProjSched {
  pg8::StaticOrder so;
  __device__ __forceinline__ void init(int G, int c) { so.init(MX, N_IN, G, c, D, D); }
  __device__ __forceinline__ bool next(int i, Unit& u) const {
    const long Lx = (long)i * so.G + so.c;
    if (Lx < so.nwg) return so.next(i, u);
    const int j = (int)(Lx - so.nwg); if (j >= 40) return false;
    u.pm = 64 + (j & 3); u.pn = 4 + (j >> 2); u.grp = 0; u.ao = u.pm * so.tsA; u.bo = u.pn * so.tsB; return true;
  }
  __device__ __forceinline__ void a_ready(const Unit&) const {}
  __device__ __forceinline__ void done(const Unit&) const {}
};

struct EpiInProj {
  static constexpr bool PERM = false, AFTER_DRAIN = false;
  bf16_t *Q, *K, *V, *SA, *G; const float* rope;
  __device__ __forceinline__ static void st4(bf16_t* p, const f32x4 v) { u32x2 w; w.x = pg8::cvt_pk_bf16(v[0], v[1]); w.y = pg8::cvt_pk_bf16(v[2], v[3]); *(u32x2*)p = w; }
  __device__ __forceinline__ void operator()(const f32x4 (&acc)[2][2][4][2], const Unit& u, int wr, int wc, int fr, int fq) const {
    const int row0 = u.pm * 256 + wr * 64 + fr;
    const int cg0 = u.pn * 256 + wc * 32 + fq * 4;
    if (u.pm < 64) {
      if (u.pn < 8) {
        const bool isq = u.pn < 4;
#pragma unroll
        for (int ai = 0; ai < 2; ++ai)
#pragma unroll
          for (int m = 0; m < 4; ++m) {
            const int row = row0 + ai * 128 + m * 16, b = row >> 12, t = row & 4095;
            const int pos = (wc & 1) ? (t & 63) : (t >> 6);
            const f32x4* rp = (const f32x4*)(rope + (pos * 16 + fq * 4) * 2);
            const f32x4 r0 = rp[0], r1 = rp[1];
            const f32x4 cs = {r0[0], r0[2], r1[0], r1[2]}, sn = {r0[1], r0[3], r1[1], r1[3]};
            bf16_t* dst = isq ? Q + (size_t)row * 1024 + cg0 : K + ((size_t)b * LA + NCTX + t) * 1024 + (cg0 - 1024);
#pragma unroll
            for (int bj = 0; bj < 2; ++bj) {
              const f32x4 h1 = acc[ai][bj][m][0], h2 = acc[ai][bj][m][1];
              st4(dst + bj * 128, h1 * cs - h2 * sn);
              st4(dst + bj * 128 + 16, h2 * cs + h1 * sn);
            }
          }
      } else {
#pragma unroll
        for (int ai = 0; ai < 2; ++ai)
#pragma unroll
          for (int m = 0; m < 4; ++m) {
            const int row = row0 + ai * 128 + m * 16, b = row >> 12, t = row & 4095;
            const size_t kr = (size_t)b * LA + NCTX + t;
            if (u.pn >= 12 && u.pn < 14) {
#pragma unroll
              for (int bj = 0; bj < 2; ++bj)
#pragma unroll
                for (int n = 0; n < 2; ++n) {
                  const int ch = cg0 + bj * 128 + n * 16 - 3072;
                  st4(SA + ((size_t)(ch >> 4) * SA_ROWS + b * 128 + (t >> 5)) * SA_LD + (t & 31) * 16 + (ch & 15), acc[ai][bj][m][n]);
                }
            } else {
              bf16_t* dst = u.pn < 12 ? V + kr * 1024 + (cg0 - 2048) : G + (size_t)row * 2048 + (cg0 - 3584);
#pragma unroll
              for (int bj = 0; bj < 2; ++bj)
#pragma unroll
                for (int n = 0; n < 2; ++n) {
                  f32x4 v = acc[ai][bj][m][n];
                  if (u.pn >= 14) { v[0] = sigmoidf_(v[0]); v[1] = sigmoidf_(v[1]); v[2] = sigmoidf_(v[2]); v[3] = sigmoidf_(v[3]); }
                  st4(dst + bj * 128 + n * 16, v);
                }
            }
          }
      }
    } else {
#pragma unroll
      for (int ai = 0; ai < 2; ++ai)
#pragma unroll
        for (int m = 0; m < 4; ++m) {
          const int rc = row0 + ai * 128 + m * 16 - MX, b = rc >> 8, t = rc & 255;
          const size_t kr = (size_t)b * LA + t;
          if (u.pn >= 12) {
#pragma unroll
            for (int bj = 0; bj < 2; ++bj)
#pragma unroll
              for (int n = 0; n < 2; ++n) {
                const int ch = cg0 + bj * 128 + n * 16 - 3072;
                st4(SA + ((size_t)(ch >> 4) * SA_ROWS + 512 + b * 8 + (t >> 5)) * SA_LD + (t & 31) * 16 + (ch & 15), acc[ai][bj][m][n]);
              }
          } else {
            bf16_t* dst = u.pn < 8 ? K + kr * 1024 + (cg0 - 1024) : V + kr * 1024 + (cg0 - 2048);
#pragma unroll
            for (int bj = 0; bj < 2; ++bj)
#pragma unroll
              for (int n = 0; n < 2; ++n) st4(dst + bj * 128 + n * 16, acc[ai][bj][m][n]);
          }
        }
    }
  }
};
template <int MODE>
struct EpiBf8 {
  static constexpr bool PERM = true, AFTER_DRAIN = false;
  bf16_t* O; int ldo; const bf16_t* X; int ldx; const float* bias;
  __device__ __forceinline__ void operator()(const f32x4 (&acc)[2][2][4][2], const Unit& u, int wr, int wc, int fr, int fq) const {
    const int row0 = u.pm * 256 + wr * 64 + fr, col0 = u.pn * 256 + wc * 32 + 8 * fq;
#pragma unroll
    for (int ai = 0; ai < 2; ++ai)
#pragma unroll
      for (int m = 0; m < 4; ++m) {
        const int row = row0 + ai * 128 + m * 16;
#pragma unroll
        for (int bj = 0; bj < 2; ++bj) {
          const int col = col0 + bj * 128;
          f32x4 v0 = acc[ai][bj][m][0], v1 = acc[ai][bj][m][1];
          const u32x4 xw = *(const u32x4*)(X + (size_t)row * ldx + col);
          const f32x4 x0 = {bflo(xw.x), bfhi(xw.x), bflo(xw.y), bfhi(xw.y)}, x1 = {bflo(xw.z), bfhi(xw.z), bflo(xw.w), bfhi(xw.w)};
          if (MODE == 0) {
            const f32x4 b0 = *(const f32x4*)(bias + col), b1 = *(const f32x4*)(bias + col + 4);
#pragma unroll
            for (int i = 0; i < 4; ++i) { v0[i] = x0[i] * sigmoidf_(v0[i] + b0[i]); v1[i] = x1[i] * sigmoidf_(v1[i] + b1[i]); }
          } else if (MODE == 1) { v0 = v0 * x0; v1 = v1 * x1; }
          else {
            const u32x4 ow = *(const u32x4*)(O + (size_t)row * ldo + col);
            const f32x4 o0 = {bflo(ow.x), bfhi(ow.x), bflo(ow.y), bfhi(ow.y)}, o1 = {bflo(ow.z), bfhi(ow.z), bflo(ow.w), bfhi(ow.w)};
            v0 = o0 + v0 * x0; v1 = o1 + v1 * x1;
          }
          u32x4 w; w.x = pg8::cvt_pk_bf16(v0[0], v0[1]); w.y = pg8::cvt_pk_bf16(v0[2], v0[3]); w.z = pg8::cvt_pk_bf16(v1[0], v1[1]); w.w = pg8::cvt_pk_bf16(v1[2], v1[3]);
          *(u32x4*)(O + (size_t)row * ldo + col) = w;
        }
      }
  }
};
template <int MODE>
struct EpiF32 {
  static constexpr bool PERM = false, AFTER_DRAIN = false;
  float* O; const float* xres; const float* mod;
  __device__ __forceinline__ void operator()(const f32x4 (&acc)[2][2][4][2], const Unit& u, int wr, int wc, int fr, int fq) const {
    const int row0 = u.pm * 256 + wr * 64 + fr, col0 = u.pn * 256 + wc * 32 + 4 * fq;
#pragma unroll
    for (int ai = 0; ai < 2; ++ai)
#pragma unroll
      for (int m = 0; m < 4; ++m) {
        const int row = row0 + ai * 128 + m * 16;
#pragma unroll
        for (int bj = 0; bj < 2; ++bj)
#pragma unroll
          for (int n = 0; n < 2; ++n) {
            const int col = col0 + bj * 128 + n * 16;
            f32x4 v = acc[ai][bj][m][n];
            if (MODE == 1) { const f32x4 xr = *(const f32x4*)(xres + (size_t)row * 1024 + col); const f32x4 g = *(const f32x4*)(mod + (row >> 12) * 6144 + 2048 + col); v = xr + g * v; }
            *(f32x4*)(O + (size_t)row * 1024 + col) = v;
          }
      }
  }
};


struct GroupSched {
  int npm, npn, nunits, G, c; long gsA, gsB, tsA, tsB;
  __device__ __forceinline__ void init(int ngrp, int npm_, int npn_, long gsA_, long tsA_, long gsB_, long tsB_, int G_, int c_) { npm = npm_; npn = npn_; nunits = ngrp * npm_ * npn_; gsA = gsA_; tsA = tsA_; gsB = gsB_; tsB = tsB_; G = G_; c = c_; }
  __device__ __forceinline__ bool next(int i, Unit& u) const {
    const long Lx = (long)i * G + c; if (Lx >= nunits) return false;
    const int per = npm * npn, grp = (int)Lx / per, r = (int)Lx % per;
    u.grp = grp; u.pm = r / npn; u.pn = r % npn; u.ao = grp * gsA + u.pm * tsA; u.bo = grp * gsB + u.pn * tsB; return true;
  }
  __device__ __forceinline__ void a_ready(const Unit&) const {}
  __device__ __forceinline__ void done(const Unit&) const {}
};
struct EpiS {
  static constexpr bool PERM = false, AFTER_DRAIN = false;
  float* S;
  __device__ __forceinline__ void operator()(const f32x4 (&acc)[2][2][4][2], const Unit& u, int wr, int wc, int fr, int fq) const {
    const int row0 = u.pm * 256 + wr * 64 + fr, col0 = wc * 32 + 4 * fq;
#pragma unroll
    for (int ai = 0; ai < 2; ++ai)
#pragma unroll
      for (int m = 0; m < 4; ++m) {
        const int row = row0 + ai * 128 + m * 16;
        if (row < SA_ROWS) {
#pragma unroll
          for (int bj = 0; bj < 2; ++bj)
#pragma unroll
            for (int n = 0; n < 2; ++n) *(f32x4*)(S + ((size_t)u.grp * SA_ROWS + row) * 256 + col0 + bj * 128 + n * 16) = acc[ai][bj][m][n];
        }
      }
  }
};
struct EpiY {
  static constexpr bool PERM = true, AFTER_DRAIN = false;
  bf16_t* YG;
  __device__ __forceinline__ void operator()(const f32x4 (&acc)[2][2][4][2], const Unit& u, int wr, int wc, int fr, int fq) const {
    const int row0 = u.pm * 256 + wr * 64 + fr, col0 = u.pn * 256 + wc * 32 + 8 * fq;
#pragma unroll
    for (int ai = 0; ai < 2; ++ai)
#pragma unroll
      for (int m = 0; m < 4; ++m) {
        const int row = row0 + ai * 128 + m * 16, b = row >> 7, cx = row & 127;
#pragma unroll
        for (int bj = 0; bj < 2; ++bj) {
          const int col = col0 + bj * 128, j = col >> 4, p0 = col & 15;
          const f32x4 v0 = acc[ai][bj][m][0], v1 = acc[ai][bj][m][1];
          u32x4 w; w.x = pg8::cvt_pk_bf16(gelu_tanh(v0[0]), gelu_tanh(v0[1])); w.y = pg8::cvt_pk_bf16(gelu_tanh(v0[2]), gelu_tanh(v0[3]));
          w.z = pg8::cvt_pk_bf16(gelu_tanh(v1[0]), gelu_tanh(v1[1])); w.w = pg8::cvt_pk_bf16(gelu_tanh(v1[2]), gelu_tanh(v1[3]));
          *(u32x4*)(YG + ((size_t)(b * L + cx * 32 + j)) * 512 + u.grp * 16 + p0) = w;
        }
      }
  }
};

__device__ __forceinline__ void transpose_item(const float* W, int K, int N, bf16_t* WT, float* scr, int item, int lane) {
  const int nblk = N / 32, kb = item / nblk, nb = item % nblk, k0 = 64 * kb, n0 = 32 * nb;
#pragma unroll 8
  for (int i = 0; i < 32; ++i) { const int kk = 2 * i + (lane >> 5); scr[kk * 33 + (lane & 31)] = W[(size_t)(k0 + kk) * N + n0 + (lane & 31)]; }
  asm volatile("s_waitcnt lgkmcnt(0)" ::: "memory");
  const int c = lane & 7;
#pragma unroll
  for (int j = 0; j < 4; ++j) {
    const int n = (lane >> 3) + 8 * j; const float* s = scr + (8 * c) * 33 + n;
    u32x4 o; o.x = pg8::cvt_pk_bf16(s[0], s[33]); o.y = pg8::cvt_pk_bf16(s[66], s[99]); o.z = pg8::cvt_pk_bf16(s[132], s[165]); o.w = pg8::cvt_pk_bf16(s[198], s[231]);
    *(u32x4*)(WT + (size_t)(n0 + n) * K + k0 + 8 * c) = o;
  }
  asm volatile("s_waitcnt lgkmcnt(0)" ::: "memory");
}

namespace att {
using bf16 = unsigned short;
constexpr int   D = 128, NW = 8, QBLK = 32, KVBLK = 64, SDEPTH = 1;
constexpr float SCALE = 0.125f;
constexpr float THR = 8.f;
constexpr int LDQ = 1024, LDK = 1024, LDO = 1024;
constexpr size_t SHM_V = KVBLK * D * 2, SHM_K = KVBLK * D * 2, SHM_ATTN = 2 * SHM_V + 2 * SHM_K + NW * 64 * 4 + 4 * 4 * 16 * 64 * 4;
using bf16x8 = __attribute__((ext_vector_type(8))) short;
using s16x4  = __attribute__((ext_vector_type(4))) short;
using f32x16 = __attribute__((ext_vector_type(16))) float;
using f32x8  = __attribute__((ext_vector_type(8))) float;
using u32x4  = __attribute__((ext_vector_type(4))) unsigned;
#define KSWZ(row, colB) ((row) * 256 + ((colB) ^ (((row) & 7) << 4)))
#define SBAR() __builtin_amdgcn_sched_barrier(0)
__device__ __forceinline__ int crow(int r, int hi) { return (r & 3) + 8 * (r >> 2) + 4 * hi; }
__device__ __forceinline__ unsigned cvtpk(float lo, float hi) {
  unsigned r; asm volatile("v_cvt_pk_bf16_f32 %0, %1, %2" : "=v"(r) : "v"(lo), "v"(hi)); return r;
}
template <typename TIn> struct Stage;
template <> struct Stage<bf16>  { using T = bf16x8;
  __device__ static __forceinline__ T ld8(const bf16* p) { return *reinterpret_cast<const bf16x8*>(p); }
  __device__ static __forceinline__ bf16x8 tobf(T x) { return x; } };
__device__ __forceinline__ void partialSM(f32x16& p0, f32x16& p1, float& m_reg, float& mn, float& alpha) {
  constexpr float C = SCALE * 1.4426950408889634f;
  float pmax = p0[0]; for (int r = 1; r < 16; ++r) pmax = fmaxf(pmax, p0[r]); for (int r = 0; r < 16; ++r) pmax = fmaxf(pmax, p1[r]);
  { auto rr = __builtin_amdgcn_permlane32_swap(__float_as_uint(pmax), __float_as_uint(pmax), false, false);
    pmax = fmaxf(__uint_as_float(rr[0]), __uint_as_float(rr[1])); }
  if (__builtin_expect(__all(pmax - m_reg <= THR / SCALE), 1)) { mn = m_reg; alpha = 1.f; }
  else { mn = fmaxf(m_reg, pmax); alpha = __builtin_amdgcn_exp2f((m_reg - mn) * C); m_reg = mn; }
  float mnC = -mn * C;
  for (int r = 0; r < 16; ++r) p0[r] = fmaf(p0[r], C, mnC); for (int r = 0; r < 16; ++r) p1[r] = fmaf(p1[r], C, mnC);
  for (int r = 0; r < 16; ++r) p0[r] = __builtin_amdgcn_exp2f(p0[r]);
}
__device__ __forceinline__ void finishSM(f32x16& p0, f32x16& p1, float alpha, float& l_reg, bf16x8& pa0, bf16x8& pa1, bf16x8& pa2, bf16x8& pa3) {
  for (int r = 0; r < 16; ++r) p1[r] = __builtin_amdgcn_exp2f(p1[r]);
  float ps = 0; for (int r = 0; r < 16; ++r) ps += p0[r]; for (int r = 0; r < 16; ++r) ps += p1[r];
  { auto rr = __builtin_amdgcn_permlane32_swap(__float_as_uint(ps), __float_as_uint(ps), false, false);
    ps = __uint_as_float(rr[0]) + __uint_as_float(rr[1]); }
  l_reg = l_reg * alpha + ps;
#define PK4(P, BASE, OUT) do { unsigned a0 = cvtpk(P[BASE + 0], P[BASE + 1]), a1 = cvtpk(P[BASE + 2], P[BASE + 3]);   \
    unsigned b0 = cvtpk(P[BASE + 4], P[BASE + 5]), b1 = cvtpk(P[BASE + 6], P[BASE + 7]);                              \
    auto r0 = __builtin_amdgcn_permlane32_swap(a0, b0, false, false); auto r1 = __builtin_amdgcn_permlane32_swap(a1, b1, false, false); \
    u32x4 w = {r0[0], r1[0], r0[1], r1[1]}; OUT = *reinterpret_cast<bf16x8*>(&w); } while (0)
  PK4(p0, 0, pa0); PK4(p0, 8, pa1); PK4(p1, 0, pa2); PK4(p1, 8, pa3);
#undef PK4
}
__device__ __forceinline__ void qkt(f32x16& p0, f32x16& p1, const bf16* Ks, const bf16x8* qr, int r32, int hi, int mcolB) {
  p0 = f32x16{}; p1 = f32x16{};
#pragma unroll
  for (int d0 = 0; d0 < 4; ++d0) { int cb = mcolB + (d0 * 16 + hi * 8) * 2;
    bf16x8 b0 = *reinterpret_cast<const bf16x8*>((const char*)Ks + KSWZ(r32, cb));
    bf16x8 b1 = *reinterpret_cast<const bf16x8*>((const char*)Ks + KSWZ(32 + r32, cb));
    p0 = __builtin_amdgcn_mfma_f32_32x32x16_bf16(b0, qr[d0], p0, 0, 0, 0);
    p1 = __builtin_amdgcn_mfma_f32_32x32x16_bf16(b1, qr[d0], p1, 0, 0, 0); }
}
__device__ __forceinline__ int v_st(int k, int c) { const int kk = (k & ~0xC) | ((k & 4) << 1) | ((k & 8) >> 1); return ((kk >> 3) * 4 + (c >> 5)) * 512 + ((kk & 7) * 32 + (c & 31)) * 2; }
__device__ __forceinline__ int v_rd_base(int lane) { return ((lane & 3) << 3) | (((lane >> 2) & 3) << 6) | (((lane >> 4) & 1) << 5) | (((lane >> 5) & 1) << 8); }
constexpr int v_rd_off(int d0, int ks, int half) { return d0 * 512 + ks * 4096 + half * 2048; }
template <int OFF> __device__ __forceinline__ s16x4 tr_read(int vb) {
  s16x4 r; asm volatile("ds_read_b64_tr_b16 %0, %1 offset:%2" : "=&v"(r) : "v"(vb), "i"(OFF) : "memory"); return r;
}
template <int D0> __device__ __forceinline__ void pv_one(f32x16& od, int vb, bf16x8 pa0, bf16x8 pa1, bf16x8 pa2, bf16x8 pa3) {
  const s16x4 l0 = tr_read<v_rd_off(D0, 0, 0)>(vb), h0 = tr_read<v_rd_off(D0, 0, 1)>(vb), l1 = tr_read<v_rd_off(D0, 1, 0)>(vb), h1 = tr_read<v_rd_off(D0, 1, 1)>(vb);
  const s16x4 l2 = tr_read<v_rd_off(D0, 2, 0)>(vb), h2 = tr_read<v_rd_off(D0, 2, 1)>(vb), l3 = tr_read<v_rd_off(D0, 3, 0)>(vb), h3 = tr_read<v_rd_off(D0, 3, 1)>(vb);
  asm volatile("s_waitcnt lgkmcnt(0)" ::: "memory"); SBAR();
#define PK(L, H) (bf16x8){L[0], L[1], L[2], L[3], H[0], H[1], H[2], H[3]}
  od = __builtin_amdgcn_mfma_f32_32x32x16_bf16(pa0, PK(l0, h0), od, 0, 0, 0);
  od = __builtin_amdgcn_mfma_f32_32x32x16_bf16(pa1, PK(l1, h1), od, 0, 0, 0);
  od = __builtin_amdgcn_mfma_f32_32x32x16_bf16(pa2, PK(l2, h2), od, 0, 0, 0);
  od = __builtin_amdgcn_mfma_f32_32x32x16_bf16(pa3, PK(l3, h3), od, 0, 0, 0);
#undef PK
}
__device__ __forceinline__ void pv_d0(f32x16* o, int vb, bf16x8 pa0, bf16x8 pa1, bf16x8 pa2, bf16x8 pa3) {
  pv_one<0>(o[0], vb, pa0, pa1, pa2, pa3); pv_one<1>(o[1], vb, pa0, pa1, pa2, pa3); pv_one<2>(o[2], vb, pa0, pa1, pa2, pa3); pv_one<3>(o[3], vb, pa0, pa1, pa2, pa3);
}

__device__ __forceinline__ void diff_attn_unit(const bf16* __restrict__ Qb, const bf16* __restrict__ Kh, const bf16* __restrict__ Vh,
                                               bf16* __restrict__ Ob, int seq, float lam, const float* __restrict__ subln, char* lds) {
  using St = Stage<bf16>;
  const int tid = threadIdx.x, wid = tid >> 6, lane = tid & 63, r32 = lane & 31, hi = lane >> 5;
  bf16* V_lds = (bf16*)lds; bf16* K_lds = (bf16*)(lds + 2 * SHM_V);
  float* ws = (float*)(lds + 2 * SHM_V + 2 * SHM_K) + wid * 64; float* li_l = ws; float* al_l = ws + 32;
  float m_reg = -1e30f, l_reg = 0; f32x16 o[4] = {}; bf16x8 qr[4];
  const int mw = wid >> 2, wq = wid & 3, mcolB = mw * 128;
  const bf16* Qw = Qb + (long)(wq * QBLK + r32) * LDQ + mw * 64 + hi * 8;
#pragma unroll
  for (int d0 = 0; d0 < 4; ++d0) qr[d0] = St::ld8(Qw + d0 * 16);
  const int sr = tid >> 4, sc = (tid & 15) * 8, vst0 = v_st(sr, sc), vst1 = v_st(32 + sr, sc);
  const int vb0 = (int)(uintptr_t)V_lds + v_rd_base(lane);
  struct { typename St::T vs0, vs1, ks0, ks1; } sr_[SDEPTH];
#define SLOAD(i, k0) do { sr_[i].vs0 = St::ld8(&Vh[(long)((k0) + sr) * LDK + sc]); sr_[i].vs1 = St::ld8(&Vh[(long)((k0) + 32 + sr) * LDK + sc]); \
    sr_[i].ks0 = St::ld8(&Kh[(long)((k0) + sr) * LDK + sc]); sr_[i].ks1 = St::ld8(&Kh[(long)((k0) + 32 + sr) * LDK + sc]); } while (0)
#define SWRITE(b, i) do { *(bf16x8*)((char*)V_lds + (b) * SHM_V + vst0) = St::tobf(sr_[i].vs0);          \
    *(bf16x8*)((char*)V_lds + (b) * SHM_V + vst1) = St::tobf(sr_[i].vs1); int kc = sc * 2;               \
    *(bf16x8*)((char*)K_lds + (b) * SHM_K + KSWZ(sr, kc)) = St::tobf(sr_[i].ks0);                       \
    *(bf16x8*)((char*)K_lds + (b) * SHM_K + KSWZ(32 + sr, kc)) = St::tobf(sr_[i].ks1); } while (0)
#define SWAIT() do { if constexpr (SDEPTH == 2) asm volatile("s_waitcnt vmcnt(4)" ::: "memory"); else asm volatile("s_waitcnt vmcnt(0)" ::: "memory"); } while (0)
#define RESC(a) do { if (__any((a) < 1.f)) { if (hi == 0) al_l[r32] = (a); asm volatile("s_waitcnt lgkmcnt(0)" ::: "memory"); \
    for (int d = 0; d < 4; ++d) for (int r = 0; r < 16; ++r) o[d][r] *= al_l[crow(r, hi)]; } } while (0)
  f32x16 pA0, pA1, pB0, pB1; float mnA, mnB, alA, alB; bf16x8 pa0, pa1, pa2, pa3; const int NT = seq / KVBLK;
  constexpr int SE = 0, SO = SDEPTH - 1;
  SLOAD(SE, 0); asm volatile("s_waitcnt vmcnt(0)" ::: "memory"); SWRITE(0, SE); __syncthreads();
  qkt(pA0, pA1, K_lds, qr, r32, hi, mcolB); partialSM(pA0, pA1, m_reg, mnA, alA);
  SLOAD(SO, KVBLK); if constexpr (SDEPTH == 2) { if (2 < NT) SLOAD(SE, 2 * KVBLK); }
  SWAIT(); SWRITE(1, SO); __syncthreads();
  for (int j = 1; j + 1 < NT; j += 2) {
    SBAR(); qkt(pB0, pB1, (bf16*)((char*)K_lds + SHM_K), qr, r32, hi, mcolB);
    finishSM(pA0, pA1, alA, l_reg, pa0, pa1, pa2, pa3); SBAR();
    SLOAD(SO, (j + SDEPTH) * KVBLK); SBAR();
    pv_d0(o, vb0, pa0, pa1, pa2, pa3); partialSM(pB0, pB1, m_reg, mnB, alB);
    __syncthreads(); SWAIT(); SWRITE(0, SE);
    RESC(alB); __syncthreads();
    SBAR(); qkt(pA0, pA1, K_lds, qr, r32, hi, mcolB);
    finishSM(pB0, pB1, alB, l_reg, pa0, pa1, pa2, pa3); SBAR();
    if (SDEPTH == 1 || j + 3 < NT) SLOAD(SE, (j + 1 + SDEPTH) * KVBLK); SBAR();
    pv_d0(o, vb0 + (int)SHM_V, pa0, pa1, pa2, pa3); partialSM(pA0, pA1, m_reg, mnA, alA);
    __syncthreads(); SWAIT(); SWRITE(1, SO);
    RESC(alA); __syncthreads();
  }
  SBAR(); qkt(pB0, pB1, (bf16*)((char*)K_lds + SHM_K), qr, r32, hi, mcolB);
  finishSM(pA0, pA1, alA, l_reg, pa0, pa1, pa2, pa3); SBAR();
  pv_d0(o, vb0, pa0, pa1, pa2, pa3); partialSM(pB0, pB1, m_reg, mnB, alB);
  __syncthreads(); RESC(alB);
  finishSM(pB0, pB1, alB, l_reg, pa0, pa1, pa2, pa3); SBAR();
  pv_d0(o, vb0 + (int)SHM_V, pa0, pa1, pa2, pa3);
  if (hi == 0) li_l[r32] = l_reg; asm volatile("s_waitcnt lgkmcnt(0)" ::: "memory");
  float rli[16];
#pragma unroll
  for (int r = 0; r < 16; ++r) rli[r] = __builtin_amdgcn_rcpf(li_l[crow(r, hi)]);
  float* EXO = (float*)(lds + 2 * SHM_V + 2 * SHM_K + NW * 64 * 4) + wq * (4 * 16 * 64) + lane;
  if (mw == 1) {
#pragma unroll
    for (int d0 = 0; d0 < 4; ++d0)
#pragma unroll
      for (int r = 0; r < 16; ++r) EXO[(d0 * 16 + r) * 64] = o[d0][r] * rli[r];
  }
  __syncthreads();
  if (mw == 0) {
    float ssq[16];
#pragma unroll
    for (int r = 0; r < 16; ++r) ssq[r] = 0.f;
#pragma unroll
    for (int d0 = 0; d0 < 4; ++d0)
#pragma unroll
      for (int r = 0; r < 16; ++r) { const float dv = o[d0][r] * rli[r] - lam * EXO[(d0 * 16 + r) * 64]; o[d0][r] = dv; ssq[r] += dv * dv; }
#pragma unroll
    for (int r = 0; r < 16; ++r) {
#pragma unroll
      for (int sft = 1; sft < 32; sft <<= 1) ssq[r] += __shfl_xor(ssq[r], sft);
      ssq[r] = rsqrtf(ssq[r] * (1.f / 128.f) + 1e-6f) * 0.8f;
    }
    bf16* Ow = Ob + (long)(wq * QBLK) * LDO;
#pragma unroll
    for (int d0 = 0; d0 < 4; ++d0) { const float gg = subln[d0 * 32 + r32];
#pragma unroll
      for (int r = 0; r < 16; ++r) { const float val = o[d0][r] * ssq[r] * gg; Ow[(long)crow(r, hi) * LDO + d0 * 32 + r32] = (bf16)(pg8::cvt_pk_bf16(val, val) & 0xffffu); } }
  }
  __syncthreads();
#undef SLOAD
#undef SWRITE
#undef SWAIT
#undef RESC
}
}


__device__ __forceinline__ void slice_table(const float* T, bf16_t* T8, int gtid, int gsz) {
  for (int it = gtid; it < 16384 * 128; it += gsz) {
    const int e = it >> 7, c8 = (it & 127) * 8, j = c8 >> 7, c = c8 & 127;
    const f32x4 a = *(const f32x4*)(T + (size_t)e * 1024 + c8), b = *(const f32x4*)(T + (size_t)e * 1024 + c8 + 4);
    u32x4 w; w.x = pg8::cvt_pk_bf16(a[0], a[1]); w.y = pg8::cvt_pk_bf16(a[2], a[3]); w.z = pg8::cvt_pk_bf16(b[0], b[1]); w.w = pg8::cvt_pk_bf16(b[2], b[3]);
    *(u32x4*)(T8 + ((size_t)j * 16384 + e) * 128 + c) = w;
  }
}

__device__ __forceinline__ void wave_argmax(float& v, int& i) {
#pragma unroll
  for (int o = 32; o; o >>= 1) {
    const float ov = __shfl_xor(v, o); const int oi = __shfl_xor(i, o);
    if (ov > v || (ov == v && oi < i)) { v = ov; i = oi; }
  }
}

__global__ void __launch_bounds__(NT) mega(Params p) {
  extern __shared__ __attribute__((aligned(16))) unsigned char lds[];
  cg::grid_group grid = cg::this_grid();
  if (threadIdx.x < 35) {
    unsigned long long v = threadIdx.x < 33 ? (unsigned long long)p.in[threadIdx.x] : (threadIdx.x == 33 ? (unsigned long long)p.out : (unsigned long long)p.ws);
    ((unsigned long long*)(lds + PTR_OFF))[threadIdx.x] = v;
  }
  __syncthreads();

  {
    PHASE_LOCALS
    float* MOD = (float*)WSP(WS_MOD); float* LAM = (float*)WSP(WS_LAM);
    float* ABRE = (float*)WSP(WS_ABRE); float* ABIM = (float*)WSP(WS_ABIM); float* BBRE = (float*)WSP(WS_BBRE); float* BBIM = (float*)WSP(WS_BBIM);
    const float* cin = INP(1); const float* c_ctx = INP(3); const float* ada_w = INP(4); const float* ada_b = INP(5);
    if (gridDim.x >= 192) {
      if (blockIdx.x < 192) {
        float* sil = fl; float* red = fl + 5 * 1024;
        for (int i = tid; i < 5 * 1024; i += NT) { const int r = i >> 10, k = i & 1023; sil[i] = siluf_(r < 4 ? cin[r * D + k] : c_ctx[k]); }
        __syncthreads();
        const int cl = tid & 31, kg = tid >> 5, col = blockIdx.x * 32 + cl;
        float a[5] = {0.f, 0.f, 0.f, 0.f, 0.f};
#pragma unroll 16
        for (int kk = 0; kk < 64; ++kk) {
          const int k = kg * 64 + kk; const float w = ada_w[(size_t)k * 6144 + col];
#pragma unroll
          for (int r = 0; r < 5; ++r) a[r] += sil[r * 1024 + k] * w;
        }
#pragma unroll
        for (int r = 0; r < 5; ++r) red[(kg * 5 + r) * 32 + cl] = a[r];
        __syncthreads();
        if (tid < 160) {
          const int r = tid >> 5; float s = 0.f;
#pragma unroll
          for (int q = 0; q < 16; ++q) s += red[(q * 5 + r) * 32 + cl];
          MOD[r * 6144 + col] = s + ada_b[col];
        }
        __syncthreads();
      }
    } else {
      for (int it = gtid; it < 5 * 6144; it += gsz) {
        const int r = it / 6144, j = it % 6144;
        const float* cv = r < 4 ? cin + r * D : c_ctx;
        float a = 0.f;
        for (int k = 0; k < D; ++k) a += siluf_(cv[k]) * ada_w[(size_t)k * 6144 + j];
        MOD[it] = a + ada_b[j];
      }
    }
    if (gtid == 0) {
      const float* q1 = INP(9); const float* k1 = INP(10); const float* q2 = INP(11); const float* k2 = INP(12);
      float s1 = 0.f, s2 = 0.f;
      for (int k = 0; k < 64; ++k) { s1 += q1[k] * k1[k]; s2 += q2[k] * k2[k]; }
      LAM[0] = expf(s1) - expf(s2) + 0.2f;
    }
    const float* a_re = INP(15); const float* a_im = INP(16); const float* ldt = INP(17); const float* b_re = INP(18); const float* b_im = INP(19);
    for (int it = gtid; it < 2 * 32 * 64; it += gsz) {
      const int dg = it >> 6;
      const float ar = a_re[it], ai = a_im[it], dt = expf(ldt[dg]);
      const float mag = expf(ar * dt), abr = mag * cosf(ai * dt), abi = mag * sinf(ai * dt);
      ABRE[it] = abr; ABIM[it] = abi; ((float*)WSP(WS_ARDT))[it] = ar * dt; ((float*)WSP(WS_AIDT))[it] = ai * dt;
      const float den = ar * ar + ai * ai, nr = abr - 1.f, ni = abi;
      const float fr = (nr * ar + ni * ai) / den, fi = (ni * ar - nr * ai) / den;
      for (int pp = 0; pp < 16; ++pp) {
        const float br = b_re[it * 16 + pp], bi = b_im[it * 16 + pp];
        BBRE[it * 16 + pp] = fr * br - fi * bi; BBIM[it * 16 + pp] = fr * bi + fi * br;
      }
    }
    float* ROPE = (float*)WSP(WS_ROPE);
    for (int it = gtid; it < 64 * 16; it += gsz) {
      const float ang = (float)(it >> 4) * powf(10000.f, -(float)(it & 15) / 16.f);
      ROPE[it * 2] = cosf(ang); ROPE[it * 2 + 1] = sinf(ang);
    }
    {
      float* scr = fl + wid * (64 * 33);
      constexpr int I_IN = 16 * 176, I_AU = 16 * 32, I_SU = 8 * 32, I_OUT = 16 * 32, I_Q = 16 * 32, I_GLU = 8 * 16;
      for (int it = gw; it < I_IN + I_AU + I_SU + I_OUT + I_Q + I_GLU; it += ngw) {
        int r = it;
        if (r < I_IN) { transpose_item(INP(8), 1024, N_IN, (bf16_t*)WSP(WS_WIN), scr, r, lane); continue; } r -= I_IN;
        if (r < I_AU) { transpose_item(INP(14), 1024, 1024, (bf16_t*)WSP(WS_WAU), scr, r, lane); continue; } r -= I_AU;
        if (r < I_SU) { transpose_item(INP(25), 512, 1024, (bf16_t*)WSP(WS_WSU), scr, r, lane); continue; } r -= I_SU;
        if (r < I_OUT) { transpose_item(INP(26), 1024, 1024, (bf16_t*)WSP(WS_WOUT), scr, r, lane); continue; } r -= I_OUT;
        if (r < I_Q) { transpose_item(INP(27), 1024, 1024, (bf16_t*)WSP(WS_WQ), scr, r, lane); continue; } r -= I_Q;
        transpose_item(INP(23), 512, 512, (bf16_t*)WSP(WS_WGLU), scr, r, lane);
      }
    }
  }
  grid.sync();

  {
    PHASE_LOCALS
    const float* MOD = (const float*)WSP(WS_MOD); bf16_t* XN = (bf16_t*)WSP(WS_XN);
    const float* x = INP(0); const float* ctx = INP(2); const float* norm1_g = INP(6);
    for (int row = gw; row < MX + MC; row += ngw) {
      const float* src; const float* md;
      if (row < MX) { src = x + (size_t)row * D; md = MOD + (row / L) * 6144; } else { src = ctx + (size_t)(row - MX) * D; md = MOD + 4 * 6144; }
      f32x4 v[4]; float ss = 0.f;
#pragma unroll
      for (int j = 0; j < 4; ++j) { v[j] = *(const f32x4*)(src + lane * 4 + 256 * j); ss += v[j][0] * v[j][0] + v[j][1] * v[j][1] + v[j][2] * v[j][2] + v[j][3] * v[j][3]; }
      const float rstd = rsqrtf(wave_sum(ss) * (1.f / D) + 1e-6f);
#pragma unroll
      for (int j = 0; j < 4; ++j)
#pragma unroll
        for (int e = 0; e < 4; ++e) { const int col = lane * 4 + 256 * j + e; XN[(size_t)row * D + col] = f2bf(v[j][e] * rstd * norm1_g[col] * (1.f + md[1024 + col]) + md[col]); }
    }
    const float* ARDT = (const float*)WSP(WS_ARDT); const float* AIDT = (const float*)WSP(WS_AIDT);
    const float* BBRE = (const float*)WSP(WS_BBRE); const float* BBIM = (const float*)WSP(WS_BBIM);
    {
      bf16_t* BTS = (bf16_t*)WSP(WS_BTS);
      for (int it = gtid; it < 32 * 256 * 32; it += gsz) {
        const int i = it & 31, r = (it >> 5) & 255, g = it >> 13;
        const int d = r >> 7, n = (r >> 1) & 63, ri = r & 1, sidx = (d * 32 + g) * 64 + n;
        const float e = (float)(d == 0 ? 31 - i : i);
        const float mag = expf(e * ARDT[sidx]), pr = mag * cosf(e * AIDT[sidx]), pi = mag * sinf(e * AIDT[sidx]);
        unsigned w[8];
#pragma unroll
        for (int q = 0; q < 8; ++q) {
          const float br0 = BBRE[sidx * 16 + 2 * q], bi0 = BBIM[sidx * 16 + 2 * q], br1 = BBRE[sidx * 16 + 2 * q + 1], bi1 = BBIM[sidx * 16 + 2 * q + 1];
          const float v0 = ri == 0 ? pr * br0 - pi * bi0 : pr * bi0 + pi * br0, v1 = ri == 0 ? pr * br1 - pi * bi1 : pr * bi1 + pi * br1;
          w[q] = pg8::cvt_pk_bf16(v0, v1);
        }
        u32x4* dst = (u32x4*)(BTS + ((size_t)g * 256 + r) * 512 + i * 16);
        dst[0] = (u32x4){w[0], w[1], w[2], w[3]}; dst[1] = (u32x4){w[4], w[5], w[6], w[7]};
      }
    }
    {
      float* KT = (float*)WSP(WS_KT); const float* c_re = INP(20); const float* c_im = INP(21);
      for (int it = gtid; it < 2 * 32 * 32 * 16; it += gsz) {
        const int pp = it & 15, m = (it >> 4) & 31, dg = it >> 9;
        float acc[16];
#pragma unroll
        for (int q = 0; q < 16; ++q) acc[q] = 0.f;
        for (int n = 0; n < 64; ++n) {
          const int sidx = dg * 64 + n;
          const float mag = expf((float)m * ARDT[sidx]), pr = mag * cosf((float)m * AIDT[sidx]), pi = mag * sinf((float)m * AIDT[sidx]);
          const float cr = c_re[(dg * 16 + pp) * 64 + n], ci = c_im[(dg * 16 + pp) * 64 + n];
          const float wr_ = cr * pr - ci * pi, wi_ = cr * pi + ci * pr;
#pragma unroll
          for (int q = 0; q < 16; ++q) acc[q] += wr_ * BBRE[sidx * 16 + q] - wi_ * BBIM[sidx * 16 + q];
        }
#pragma unroll
        for (int q = 0; q < 16; ++q) KT[((size_t)dg * 32 + m) * 256 + pp * 16 + q] = acc[q];
      }
    }
  }
  grid.sync();

  {
    pg8::Gemm g{(const bf16_t*)WSP(WS_XN), (const bf16_t*)WSP(WS_WIN), MX + MC, N_IN, D, D, D};
    InProjSched S; S.init((int)gridDim.x, (int)blockIdx.x);
    EpiInProj E{(bf16_t*)WSP(WS_Q), (bf16_t*)WSP(WS_K), (bf16_t*)WSP(WS_V), (bf16_t*)WSP(WS_SA), (bf16_t*)WSP(WS_G), (const float*)WSP(WS_ROPE)};
    pg8::gemm_phase<EpiInProj, InProjSched, true, true>((PG8_LAS unsigned char*)lds, g, S, E);
  }
  grid.sync();

  {
    const float lam = ((const float*)WSP(WS_LAM))[0];
    const bf16_t* Qb = (const bf16_t*)WSP(WS_Q); const bf16_t* Kb = (const bf16_t*)WSP(WS_K); const bf16_t* Vb = (const bf16_t*)WSP(WS_V);
    bf16_t* ATT = (bf16_t*)WSP(WS_ATT); const float* subln = INP(13);
    for (int unit = blockIdx.x; unit < Bn * 8 * (L / 128); unit += gridDim.x) {
      const int h = unit & 7, qb = (unit >> 3) & 31, b = unit >> 8;
      const size_t qoff = ((size_t)(b * L + qb * 128)) * 1024 + h * 128, koff = (size_t)b * LA * 1024 + h * 128;
      att::diff_attn_unit(Qb + qoff, Kb + koff, Vb + koff, ATT + qoff, LA, lam, subln, (char*)lds);
    }
  }
  grid.sync();

  {
    const bool gemm_blk = (blockIdx.x < 96) || (gridDim.x <= 96);
    if (gemm_blk) {
      pg8::Gemm g{(const bf16_t*)WSP(WS_SA), (const bf16_t*)WSP(WS_BTS), 0, 0, 512, SA_LD, 512};
      GroupSched S; S.init(32, 3, 1, (long)SA_ROWS * SA_LD * 2, (long)256 * SA_LD * 2, (long)256 * 512 * 2, 0, (int)(gridDim.x <= 96 ? gridDim.x : 96), (int)blockIdx.x);
      EpiS E{(float*)WSP(WS_S)};
      pg8::gemm_phase<EpiS, GroupSched, true, true>((PG8_LAS unsigned char*)lds, g, S, E);
    }
    if (!gemm_blk || gridDim.x <= 96) {
      PHASE_LOCALS
      const int wb = gridDim.x <= 96 ? (int)blockIdx.x : (int)blockIdx.x - 96, nwb = gridDim.x <= 96 ? (int)gridDim.x : (int)gridDim.x - 96;
      const float* KT = (const float*)WSP(WS_KT); const float* ARDT = (const float*)WSP(WS_ARDT); const float* AIDT = (const float*)WSP(WS_AIDT);
      const float* c_re = INP(20); const float* c_im = INP(21); const float* dsk = INP(22); bf16_t* BTY = (bf16_t*)WSP(WS_BTY);
      for (int it = wb * NT + tid; it < 32 * 512 * 96; it += nwb * NT) {
        const int cgp = it % 96, row = (it / 96) & 511, g = it / (96 * 512);
        const int j = row >> 4, pp = row & 15, col0 = cgp * 8;
        float v[8];
        if (col0 < 512) {
          const int i = col0 >> 4, q0 = col0 & 15;
#pragma unroll
          for (int e = 0; e < 8; ++e) v[e] = 0.f;
          if (i <= j) { const float* kp = KT + ((size_t)(0 * 32 + g) * 32 + (j - i)) * 256 + pp * 16 + q0;
#pragma unroll
            for (int e = 0; e < 8; ++e) v[e] += kp[e]; }
          if (i >= j) { const float* kp = KT + ((size_t)(1 * 32 + g) * 32 + (i - j)) * 256 + pp * 16 + q0;
#pragma unroll
            for (int e = 0; e < 8; ++e) v[e] += kp[e]; }
          if (i == j && pp >= q0 && pp < q0 + 8) {
#pragma unroll
            for (int e = 0; e < 8; ++e) if (q0 + e == pp) v[e] += dsk[g * 16 + pp];
          }
        } else {
          const int cc0 = col0 - 512, d = cc0 >> 7, n0 = (cc0 & 127) >> 1;
          const float ex = (float)(d == 0 ? j + 1 : 32 - j);
#pragma unroll
          for (int q = 0; q < 4; ++q) {
            const int n = n0 + q, sidx = (d * 32 + g) * 64 + n;
            const float mag = expf(ex * ARDT[sidx]), pr = mag * cosf(ex * AIDT[sidx]), pi = mag * sinf(ex * AIDT[sidx]);
            const float cr = c_re[((d * 32 + g) * 16 + pp) * 64 + n], ci = c_im[((d * 32 + g) * 16 + pp) * 64 + n];
            v[2 * q] = cr * pr - ci * pi; v[2 * q + 1] = -(cr * pi + ci * pr);
          }
        }
        u32x4 w; w.x = pg8::cvt_pk_bf16(v[0], v[1]); w.y = pg8::cvt_pk_bf16(v[2], v[3]); w.z = pg8::cvt_pk_bf16(v[4], v[5]); w.w = pg8::cvt_pk_bf16(v[6], v[7]);
        *(u32x4*)(BTY + ((size_t)g * 512 + row) * 768 + col0) = w;
      }
    }
  }
  grid.sync();

  {
    PHASE_LOCALS
    const float* ARDT = (const float*)WSP(WS_ARDT); const float* AIDT = (const float*)WSP(WS_AIDT);
    if (wid == 0) {
      for (int it = blockIdx.x; it < Bn * 32 * 2; it += gridDim.x) {
        const int d = it & 1, g = (it >> 1) & 31, b = it >> 6;
        const int sidx = (d * 32 + g) * 64 + lane;
        const float mag = expf(32.f * ARDT[sidx]), pr = mag * cosf(32.f * AIDT[sidx]), pi = mag * sinf(32.f * AIDT[sidx]);
        typedef float f32x2_ __attribute__((ext_vector_type(2)));
        const f32x2_* Sg = (const f32x2_*)((const float*)WSP(WS_S) + (size_t)g * SA_ROWS * 256) + d * 64 + lane;
        bf16_t* SAg = (bf16_t*)WSP(WS_SA) + (size_t)g * SA_ROWS * SA_LD + 512 + d * 128 + lane * 2;
        float hr = 0.f, hi = 0.f;
        f32x2_ sc[8];
#pragma unroll
        for (int k = 0; k < 8; ++k) { const int cc = d == 0 ? k : 7 - k; sc[k] = Sg[(size_t)(512 + b * 8 + cc) * 128]; }
#pragma unroll
        for (int k = 0; k < 8; ++k) { const float nr = pr * hr - pi * hi + sc[k][0], ni = pr * hi + pi * hr + sc[k][1]; hr = nr; hi = ni; }
        for (int k0 = 0; k0 < 128; k0 += 16) {
          f32x2_ sv[16];
#pragma unroll
          for (int k = 0; k < 16; ++k) { const int cx = d == 0 ? k0 + k : 127 - (k0 + k); sv[k] = Sg[(size_t)(b * 128 + cx) * 128]; }
#pragma unroll
          for (int k = 0; k < 16; ++k) {
            const int cx = d == 0 ? k0 + k : 127 - (k0 + k);
            *(unsigned*)(SAg + (size_t)(b * 128 + cx) * SA_LD) = pg8::cvt_pk_bf16(hr, hi);
            const float nr = pr * hr - pi * hi + sv[k][0], ni = pr * hi + pi * hr + sv[k][1]; hr = nr; hi = ni;
          }
        }
      }
    }
  }
  grid.sync();

  {
    pg8::Gemm g{(const bf16_t*)WSP(WS_SA), (const bf16_t*)WSP(WS_BTY), 0, 0, 768, SA_LD, 768};
    GroupSched S; S.init(32, 2, 2, (long)SA_ROWS * SA_LD * 2, (long)256 * SA_LD * 2, (long)512 * 768 * 2, (long)256 * 768 * 2, (int)gridDim.x, (int)blockIdx.x);
    EpiY E{(bf16_t*)WSP(WS_YG)};
    pg8::gemm_phase<EpiY, GroupSched, true, true>((PG8_LAS unsigned char*)lds, g, S, E);
  }
  grid.sync();

  {
    pg8::Gemm g{(const bf16_t*)WSP(WS_YG), (const bf16_t*)WSP(WS_WGLU), MX, 512, 512, 512, 512};
    pg8::StaticOrder S; S.init(MX, 512, (int)gridDim.x, (int)blockIdx.x, g.lda, g.ldb);
    EpiBf8<0> E{(bf16_t*)WSP(WS_SSMX), 512, (const bf16_t*)WSP(WS_YG), 512, INP(24)};
    pg8::gemm_phase<EpiBf8<0>, pg8::StaticOrder, true, true>((PG8_LAS unsigned char*)lds, g, S, E);
  }
  grid.sync();

  {
    pg8::Gemm g{(const bf16_t*)WSP(WS_ATT), (const bf16_t*)WSP(WS_WAU), MX, 1024, 1024, 1024, 1024};
    pg8::StaticOrder S; S.init(MX, 1024, (int)gridDim.x, (int)blockIdx.x, g.lda, g.ldb);
    EpiBf8<1> E{(bf16_t*)WSP(WS_M), 1024, (const bf16_t*)WSP(WS_G), 2048, nullptr};
    pg8::gemm_phase<EpiBf8<1>, pg8::StaticOrder, true, true>((PG8_LAS unsigned char*)lds, g, S, E);
  }
  grid.sync();
  {
    pg8::Gemm g{(const bf16_t*)WSP(WS_SSMX), (const bf16_t*)WSP(WS_WSU), MX, 1024, 512, 512, 512};
    pg8::StaticOrder S; S.init(MX, 1024, (int)gridDim.x, (int)blockIdx.x, g.lda, g.ldb);
    EpiBf8<2> E{(bf16_t*)WSP(WS_M), 1024, (const bf16_t*)WSP(WS_G) + 1024, 2048, nullptr};
    pg8::gemm_phase<EpiBf8<2>, pg8::StaticOrder, true, true>((PG8_LAS unsigned char*)lds, g, S, E);
  }
  grid.sync();
  {
    pg8::Gemm g{(const bf16_t*)WSP(WS_M), (const bf16_t*)WSP(WS_WOUT), MX, 1024, 1024, 1024, 1024};
    pg8::StaticOrder S; S.init(MX, 1024, (int)gridDim.x, (int)blockIdx.x, g.lda, g.ldb);
    EpiF32<1> E{(float*)WSP(WS_X1), INP(0), (const float*)WSP(WS_MOD)};
    pg8::gemm_phase<EpiF32<1>, pg8::StaticOrder, true, true>((PG8_LAS unsigned char*)lds, g, S, E);
  }
  grid.sync();
  {
    PHASE_LOCALS
    const float* X1 = (const float*)WSP(WS_X1); const float* MOD = (const float*)WSP(WS_MOD); bf16_t* XN2 = (bf16_t*)WSP(WS_XN2); const float* norm2_g = INP(7);
    for (int row = gw; row < MX; row += ngw) {
      const float* src = X1 + (size_t)row * D; const float* md = MOD + (row / L) * 6144;
      f32x4 v[4]; float ss = 0.f;
#pragma unroll
      for (int j = 0; j < 4; ++j) { v[j] = *(const f32x4*)(src + lane * 4 + 256 * j); ss += v[j][0] * v[j][0] + v[j][1] * v[j][1] + v[j][2] * v[j][2] + v[j][3] * v[j][3]; }
      const float rstd = rsqrtf(wave_sum(ss) * (1.f / D) + 1e-6f);
#pragma unroll
      for (int j = 0; j < 4; ++j)
#pragma unroll
        for (int e = 0; e < 4; ++e) { const int col = lane * 4 + 256 * j + e; XN2[(size_t)row * D + col] = f2bf(v[j][e] * rstd * norm2_g[col] * (1.f + md[4096 + col]) + md[3072 + col]); }
    }
    slice_table(INP(30), (bf16_t*)WSP(WS_U8), gtid, gsz);
  }
  grid.sync();
  {
    pg8::Gemm g{(const bf16_t*)WSP(WS_XN2), (const bf16_t*)WSP(WS_WQ), MX, 1024, 1024, 1024, 1024};
    pg8::StaticOrder S; S.init(MX, 1024, (int)gridDim.x, (int)blockIdx.x, g.lda, g.ldb);
    EpiF32<0> E{(float*)WSP(WS_QP), nullptr, nullptr};
    pg8::gemm_phase<EpiF32<0>, pg8::StaticOrder, true, true>((PG8_LAS unsigned char*)lds, g, S, E);
  }
  grid.sync();
  {
    PHASE_LOCALS
    const float* QP = (const float*)WSP(WS_QP); unsigned short* IDX = (unsigned short*)WSP(WS_IDX); float* GATE = (float*)WSP(WS_GATE);
    const float* sk1 = INP(28); const float* sk2 = INP(29);
    float* SK = fl;
    for (int i = tid; i < 128 * 64; i += NT) { SK[(i >> 6) * 65 + (i & 63)] = sk1[i]; SK[128 * 65 + (i >> 6) * 65 + (i & 63)] = sk2[i]; }
    __syncthreads();
    for (int it = gw; it < MX * 8; it += ngw) {
      const int t = it >> 3, h = it & 7;
      const float* qp = QP + (size_t)t * 1024 + h * 128;
      const float qa = qp[lane], qb2 = qp[64 + lane];
      float s1a = 0.f, s1b = 0.f, s2a = 0.f, s2b = 0.f;
      for (int dd = 0; dd < 64; ++dd) {
        const float q1 = __shfl(qa, dd), q2 = __shfl(qb2, dd);
        s1a += q1 * SK[lane * 65 + dd]; s1b += q1 * SK[(lane + 64) * 65 + dd];
        s2a += q2 * SK[128 * 65 + lane * 65 + dd]; s2b += q2 * SK[128 * 65 + (lane + 64) * 65 + dd];
      }
      float v1 = 0.f, v2 = 0.f; int i1 = 0, i2 = 0;
      for (int r = 0; r < 16; ++r) {
        float bv = s1a; int bi = lane; if (s1b > bv) { bv = s1b; bi = lane + 64; }
        wave_argmax(bv, bi);
        if (bi == lane) s1a = -3e38f;
        if (bi == lane + 64) s1b = -3e38f;
        if (lane == r) { v1 = bv; i1 = bi; }
        bv = s2a; bi = lane; if (s2b > bv) { bv = s2b; bi = lane + 64; }
        wave_argmax(bv, bi);
        if (bi == lane) s2a = -3e38f;
        if (bi == lane + 64) s2b = -3e38f;
        if (lane == r) { v2 = bv; i2 = bi; }
      }
      const float vb = __shfl(v2, lane & 15);
      float cs[4];
#pragma unroll
      for (int j = 0; j < 4; ++j) cs[j] = __shfl(v1, (lane >> 4) + 4 * j) + vb;
      float tv = 0.f; int tcand = 0;
      for (int r = 0; r < 16; ++r) {
        float bv = cs[0]; int bi = ((lane >> 4) + 0) * 16 + (lane & 15);
#pragma unroll
        for (int j = 1; j < 4; ++j) { const int ci = ((lane >> 4) + 4 * j) * 16 + (lane & 15); if (cs[j] > bv) { bv = cs[j]; bi = ci; } }
        wave_argmax(bv, bi);
#pragma unroll
        for (int j = 0; j < 4; ++j) { const int ci = ((lane >> 4) + 4 * j) * 16 + (lane & 15); if (ci == bi) cs[j] = -3e38f; }
        if (lane == r) { tv = bv; tcand = bi; }
      }
      const int e1 = __shfl(i1, tcand >> 4), e2 = __shfl(i2, tcand & 15);
      const float mx = __shfl(tv, 0);
      const float ex = lane < 16 ? __expf(tv - mx) : 0.f;
      const float den = wave_sum(ex);
      if (lane < 16) { IDX[(size_t)it * 16 + lane] = (unsigned short)(e1 * 128 + e2); GATE[(size_t)it * 16 + lane] = ex / den; }
    }
    __syncthreads();
  }
  grid.sync();
  {
    PHASE_LOCALS
    const bf16_t* XN2 = (const bf16_t*)WSP(WS_XN2); const unsigned short* IDX = (const unsigned short*)WSP(WS_IDX);
    bf16_t* PD = (bf16_t*)WSP(WS_PD);
    const bool sl = (gridDim.x & 7) == 0;
    const int j0 = sl ? (int)(blockIdx.x & 7) : 0, nj = sl ? 1 : 8;
    const int wk = sl ? (int)(blockIdx.x >> 3) * 8 + wid : gw, nwk = sl ? (int)(gridDim.x >> 3) * 8 : ngw;
    const int lg = lane >> 4, li = lane & 15;
    for (int jj = 0; jj < nj; ++jj) {
      const int j = j0 + jj;
      const bf16_t* U8j = (const bf16_t*)WSP(WS_U8) + (size_t)j * 16384 * 128 + li * 8;
      for (int t = wk; t < MX; t += nwk) {
        const u32x4 xw = *(const u32x4*)(XN2 + (size_t)t * 1024 + j * 128 + li * 8);
        const float x0 = bflo(xw.x), x1 = bfhi(xw.x), x2 = bflo(xw.y), x3 = bfhi(xw.y), x4 = bflo(xw.z), x5 = bfhi(xw.z), x6 = bflo(xw.w), x7 = bfhi(xw.w);
        const int i_lo = IDX[(size_t)t * 128 + lane], i_hi = IDX[(size_t)t * 128 + 64 + lane];
        float keep_lo = 0.f, keep_hi = 0.f;
#pragma unroll
        for (int itb = 0; itb < 32; itb += 8) {
          u32x4 uw[8];
#pragma unroll
          for (int k = 0; k < 8; ++k) {
            const int s = (itb + k) * 4 + lg;
            const int ex = itb < 16 ? __shfl(i_lo, s) : __shfl(i_hi, s - 64);
            uw[k] = *(const u32x4*)(U8j + (size_t)ex * 128);
          }
#pragma unroll
          for (int k = 0; k < 8; ++k) {
            float dp = bflo(uw[k].x) * x0 + bfhi(uw[k].x) * x1 + bflo(uw[k].y) * x2 + bfhi(uw[k].y) * x3 + bflo(uw[k].z) * x4 + bfhi(uw[k].z) * x5 + bflo(uw[k].w) * x6 + bfhi(uw[k].w) * x7;
            dp += __shfl_xor(dp, 1); dp += __shfl_xor(dp, 2); dp += __shfl_xor(dp, 4); dp += __shfl_xor(dp, 8);
            const int it = itb + k;
            if (li == (it & 15)) { if (itb < 16) keep_lo = dp; else keep_hi = dp; }
          }
        }
        bf16_t* pd = PD + ((size_t)t * 8 + j) * 128 + 4 * li + lg;
        pd[0] = f2bf(keep_lo); pd[64] = f2bf(keep_hi);
      }
    }
    slice_table(INP(31), (bf16_t*)WSP(WS_V8), gtid, gsz);
  }
  grid.sync();
  {
    PHASE_LOCALS
    const float* X1 = (const float*)WSP(WS_X1); const float* MOD = (const float*)WSP(WS_MOD);
    const unsigned short* IDX = (const unsigned short*)WSP(WS_IDX); const float* GATE = (const float*)WSP(WS_GATE);
    const bf16_t* PD = (const bf16_t*)WSP(WS_PD); float* SSQ = (float*)WSP(WS_SSQ); float* out = (float*)ldptr_(33);
    const bool sl = (gridDim.x & 7) == 0;
    const int j0 = sl ? (int)(blockIdx.x & 7) : 0, nj = sl ? 1 : 8;
    const int wk = sl ? (int)(blockIdx.x >> 3) * 8 + wid : gw, nwk = sl ? (int)(gridDim.x >> 3) * 8 : ngw;
    const int lg = lane >> 4, li = lane & 15;
    for (int jj = 0; jj < nj; ++jj) {
      const int j = j0 + jj;
      const bf16_t* V8j = (const bf16_t*)WSP(WS_V8) + (size_t)j * 16384 * 128 + li * 8;
      for (int t = wk; t < MX; t += nwk) {
        const int i_lo = IDX[(size_t)t * 128 + lane], i_hi = IDX[(size_t)t * 128 + 64 + lane];
        float p_lo = 0.f, p_hi = 0.f;
#pragma unroll
        for (int q = 0; q < 8; ++q) { p_lo += bf2f(PD[((size_t)t * 8 + q) * 128 + lane]); p_hi += bf2f(PD[((size_t)t * 8 + q) * 128 + 64 + lane]); }
        const float c_lo = GATE[(size_t)t * 128 + lane] * gelu_tanh(p_lo), c_hi = GATE[(size_t)t * 128 + 64 + lane] * gelu_tanh(p_hi);
        float acc[8];
#pragma unroll
        for (int i = 0; i < 8; ++i) acc[i] = 0.f;
#pragma unroll
        for (int itb = 0; itb < 32; itb += 8) {
          u32x4 vw[8]; float cf[8];
#pragma unroll
          for (int k = 0; k < 8; ++k) {
            const int s = (itb + k) * 4 + lg;
            const int ex = itb < 16 ? __shfl(i_lo, s) : __shfl(i_hi, s - 64);
            cf[k] = itb < 16 ? __shfl(c_lo, s) : __shfl(c_hi, s - 64);
            vw[k] = *(const u32x4*)(V8j + (size_t)ex * 128);
          }
#pragma unroll
          for (int k = 0; k < 8; ++k) {
            acc[0] += cf[k] * bflo(vw[k].x); acc[1] += cf[k] * bfhi(vw[k].x); acc[2] += cf[k] * bflo(vw[k].y); acc[3] += cf[k] * bfhi(vw[k].y);
            acc[4] += cf[k] * bflo(vw[k].z); acc[5] += cf[k] * bfhi(vw[k].z); acc[6] += cf[k] * bflo(vw[k].w); acc[7] += cf[k] * bfhi(vw[k].w);
          }
        }
#pragma unroll
        for (int i = 0; i < 8; ++i) { acc[i] += __shfl_xor(acc[i], 16); acc[i] += __shfl_xor(acc[i], 32); }
        const int col = j * 128 + li * 8;
        const float* md = MOD + (t >> 12) * 6144 + 5120 + col;
        const f32x4 xa = *(const f32x4*)(X1 + (size_t)t * 1024 + col), xb = *(const f32x4*)(X1 + (size_t)t * 1024 + col + 4);
        const f32x4 ga = *(const f32x4*)md, gb = *(const f32x4*)(md + 4);
        f32x4 oa, ob; float ss = 0.f;
#pragma unroll
        for (int i = 0; i < 4; ++i) { oa[i] = xa[i] + ga[i] * acc[i]; ob[i] = xb[i] + gb[i] * acc[4 + i]; ss += oa[i] * oa[i] + ob[i] * ob[i]; }
        ss += __shfl_xor(ss, 1); ss += __shfl_xor(ss, 2); ss += __shfl_xor(ss, 4); ss += __shfl_xor(ss, 8);
        if (lg == 0) { *(f32x4*)(out + (size_t)t * 1024 + col) = oa; *(f32x4*)(out + (size_t)t * 1024 + col + 4) = ob; }
        if (lane == 0) SSQ[(size_t)t * 8 + j] = ss;
      }
    }
  }
  grid.sync();
  {
    PHASE_LOCALS
    const float* SSQ = (const float*)WSP(WS_SSQ); const float* fng = INP(32); float* out = (float*)ldptr_(33);
    for (int row = gw; row < MX; row += ngw) {
      const f32x4 sa = *(const f32x4*)(SSQ + (size_t)row * 8), sb = *(const f32x4*)(SSQ + (size_t)row * 8 + 4);
      const float rstd = rsqrtf(((sa[0] + sa[1]) + (sa[2] + sa[3]) + (sb[0] + sb[1]) + (sb[2] + sb[3])) * (1.f / D) + 1e-6f);
#pragma unroll
      for (int jq = 0; jq < 4; ++jq) {
        float* op = out + (size_t)row * D + lane * 4 + 256 * jq;
        const f32x4 v = *(const f32x4*)op, g4 = *(const f32x4*)(fng + lane * 4 + 256 * jq);
        *(f32x4*)op = v * rstd * g4;
      }
    }
  }
}

extern "C" void kernel_launch(void* const* d_in, const int* in_sizes, int n_in, void* d_out, int out_size, void* d_ws, size_t ws_size, hipStream_t stream) {
  static int grid_blocks = 0;
  if (!grid_blocks) {
    int dev = 0, cus = 0, per_cu = 0;
    (void)hipGetDevice(&dev);
    (void)hipDeviceGetAttribute(&cus, hipDeviceAttributeMultiprocessorCount, dev);
    (void)hipFuncSetAttribute((const void*)mega, hipFuncAttributeMaxDynamicSharedMemorySize, LDS_BYTES);
    (void)hipOccupancyMaxActiveBlocksPerMultiprocessor(&per_cu, (const void*)mega, NT, LDS_BYTES);
    if (per_cu < 1) per_cu = 1;
    grid_blocks = cus * per_cu;
    if (n_in != 33 || ws_size < 255 * MiB) { fprintf(stderr, "kernel_launch: unexpected n_in %d / ws %zu\n", n_in, ws_size); }
  }
  Params p{};
  for (int i = 0; i < 33 && i < n_in; ++i) p.in[i] = (const float*)d_in[i];
  p.out = (float*)d_out; p.ws = (unsigned char*)d_ws;
  void* args[] = {&p};
  hipError_t e = hipLaunchCooperativeKernel((const void*)mega, dim3(grid_blocks), dim3(NT), args, LDS_BYTES, stream);
  if (e != hipSuccess) fprintf(stderr, "cooperative launch failed: %s (grid %d)\n", hipGetErrorString(e), grid_blocks);
}
```

```cpp
#include <hip/hip_runtime.h>
#include <hip/hip_cooperative_groups.h>
#include <cstdio>
#include <cstdint>
namespace cg = cooperative_groups;

typedef unsigned short bf16_t;
typedef float f32x4 __attribute__((ext_vector_type(4)));

constexpr int NT = 512;
constexpr int LDS_BYTES = 147456;
constexpr int Bn = 4, L = 4096, D = 1024, NCTX = 256, LA = L + NCTX;
constexpr int MX = Bn * L, MC = Bn * NCTX;
constexpr int N_IN = 5632;
constexpr size_t MiB = 1u << 20;
constexpr size_t WS_MOD = 0, WS_LAM = 128 * 1024, WS_ROPE = 136 * 1024, WS_ARDT = 144 * 1024, WS_AIDT = 160 * 1024;
constexpr size_t WS_ABRE = 192 * 1024, WS_ABIM = 224 * 1024, WS_BBRE = 256 * 1024, WS_BBIM = 512 * 1024;
constexpr size_t WS_KT = 2 * MiB;
constexpr size_t WS_XN = 4 * MiB, WS_Q = 38 * MiB, WS_K = 70 * MiB, WS_V = 104 * MiB, WS_SA = 138 * MiB, WS_G = 164 * MiB;
constexpr size_t WS_WIN = 228 * MiB, WS_WAU = 239 * MiB, WS_WSU = 241 * MiB, WS_WOUT = 242 * MiB, WS_WQ = 244 * MiB, WS_WGLU = 246 * MiB;
constexpr size_t WS_BTS = 247 * MiB;
constexpr size_t WS_BTY = 38 * MiB, WS_S = 62 * MiB, WS_YG = 79 * MiB, WS_SSMX = 95 * MiB, WS_M = 111 * MiB;
constexpr size_t WS_ATT = WS_XN, WS_X1 = 38 * MiB, WS_XN2 = WS_XN, WS_QP = WS_G;
constexpr size_t WS_IDX = 111 * MiB, WS_GATE = 115 * MiB, WS_SSQ = 123 * MiB;
constexpr size_t WS_U8 = 127 * MiB, WS_PD = 164 * MiB, WS_V8 = 196 * MiB, WS_WC = 160 * MiB;
constexpr int SA_ROWS = 544, SA_LD = 768;

constexpr int PTR_OFF = LDS_BYTES - 1024;
__device__ __forceinline__ unsigned long long ldptr_(int k) {
  extern __shared__ __attribute__((aligned(16))) unsigned char lds_[];
  const unsigned long long v = ((const unsigned long long*)(lds_ + PTR_OFF))[k];
  const unsigned lo = __builtin_amdgcn_readfirstlane((unsigned)v), hi = __builtin_amdgcn_readfirstlane((unsigned)(v >> 32));
  return ((unsigned long long)hi << 32) | lo;
}
#define INP(k) ((const float*)ldptr_(k))
#define WSP(off) ((unsigned char*)ldptr_(34) + (off))
#define PHASE_LOCALS \
  int tid = threadIdx.x; asm volatile("" : "+v"(tid)); \
  const int lane = tid & 63, wid = tid >> 6; \
  const int gtid = blockIdx.x * NT + tid, gsz = gridDim.x * NT; \
  const int gw = blockIdx.x * (NT / 64) + wid, ngw = gridDim.x * (NT / 64); \
  float* fl = (float*)lds; (void)lane; (void)wid; (void)gtid; (void)gsz; (void)gw; (void)ngw; (void)fl;

struct Params {
  const float* in[33];
  float* out;
  unsigned char* ws;
  int pad0, pad1;
};

__device__ __forceinline__ float bf2f(bf16_t v) { return __uint_as_float(((unsigned)v) << 16); }
__device__ __forceinline__ bf16_t f2bf(float f) { unsigned u = __float_as_uint(f); return (bf16_t)((u + 0x7fffu + ((u >> 16) & 1u)) >> 16); }
__device__ __forceinline__ float wave_sum(float v) {
#pragma unroll
  for (int o = 32; o; o >>= 1) v += __shfl_xor(v, o);
  return v;
}
__device__ __forceinline__ float gelu_tanh(float x) { return 0.5f * x * (1.f + tanhf(0.7978845608028654f * (x + 0.044715f * x * x * x))); }
__device__ __forceinline__ float sigmoidf_(float x) { return 1.f / (1.f + __expf(-x)); }
__device__ __forceinline__ float siluf_(float x) { return x / (1.f + __expf(-x)); }

template <class Epi>
__device__ __forceinline__ void sgemm(const bf16_t* A, int lda, const float* Bm, int ldb, int M, int N, int K, float* lds, Epi epi) {
  constexpr int TM = 128, TN = 128, TK = 16, LDA_S = TM + 4, LDB_S = TN + 4;
  float* As = lds;
  float* Bs = lds + TK * LDA_S;
  const int tid = threadIdx.x, ty = tid >> 4, tx = tid & 15;
  const int ntm = M / TM, ntn = N / TN;
  for (int tile = blockIdx.x; tile < ntm * ntn; tile += gridDim.x) {
    const int tm = tile / ntn, tn = tile % ntn;
    float acc[4][8];
#pragma unroll
    for (int i = 0; i < 4; ++i)
#pragma unroll
      for (int j = 0; j < 8; ++j) acc[i][j] = 0.f;
    const int ar = tid >> 2, ak = (tid & 3) * 4;
    const int bk = tid >> 5, bn = (tid & 31) * 4;
    for (int k0 = 0; k0 < K; k0 += TK) {
      const bf16_t* ap = A + (size_t)(tm * TM + ar) * lda + k0 + ak;
      const unsigned long long av = *(const unsigned long long*)ap;
      const f32x4 bv = *(const f32x4*)(Bm + (size_t)(k0 + bk) * ldb + tn * TN + bn);
      __syncthreads();
      As[(ak + 0) * LDA_S + ar] = bf2f((bf16_t)(av & 0xffff));
      As[(ak + 1) * LDA_S + ar] = bf2f((bf16_t)((av >> 16) & 0xffff));
      As[(ak + 2) * LDA_S + ar] = bf2f((bf16_t)((av >> 32) & 0xffff));
      As[(ak + 3) * LDA_S + ar] = bf2f((bf16_t)((av >> 48) & 0xffff));
      *(f32x4*)(Bs + bk * LDB_S + bn) = bv;
      __syncthreads();
#pragma unroll
      for (int k = 0; k < TK; ++k) {
        const f32x4 a4 = *(const f32x4*)(As + k * LDA_S + ty * 4);
        const f32x4 b0 = *(const f32x4*)(Bs + k * LDB_S + tx * 8);
        const f32x4 b1 = *(const f32x4*)(Bs + k * LDB_S + tx * 8 + 4);
#pragma unroll
        for (int i = 0; i < 4; ++i) {
          acc[i][0] += a4[i] * b0[0]; acc[i][1] += a4[i] * b0[1]; acc[i][2] += a4[i] * b0[2]; acc[i][3] += a4[i] * b0[3];
          acc[i][4] += a4[i] * b1[0]; acc[i][5] += a4[i] * b1[1]; acc[i][6] += a4[i] * b1[2]; acc[i][7] += a4[i] * b1[3];
        }
      }
    }
#pragma unroll
    for (int i = 0; i < 4; ++i)
#pragma unroll
      for (int j = 0; j < 8; ++j) epi(tm * TM + ty * 4 + i, tn * TN + tx * 8 + j, acc[i][j]);
  }
  __syncthreads();
}

namespace pg8 {
#define PG8_LAS __attribute__((address_space(3)))
typedef unsigned short bf16_t;
typedef short bf16x8 __attribute__((ext_vector_type(8)));
typedef float f32x4 __attribute__((ext_vector_type(4)));
typedef unsigned u32x4 __attribute__((ext_vector_type(4)));
constexpr int BM = 256, BK = 64, HALF = 128, HTB = HALF * BK * 2  , STAGE_BYTES = 8 * HTB, NXCD = 8, WGM = 8;

__host__ __device__ __forceinline__ int lds_byte(int r, int c) { const int st = (r >> 4) * 2 + (c >> 5), rr = r & 15, cc = c & 31, ob = rr * 64 + cc * 2; return st * 1024 + (ob ^ (((ob >> 9) & 1) << 5)); }
__host__ __device__ __forceinline__ void stage_rc(int b, int& R, int& C) { const int st = b / 1024, sb = b % 1024, swz = sb ^ (((sb >> 9) & 1) << 5); R = (st >> 1) * 16 + swz / 64; C = (st & 1) * 32 + (swz % 64) / 2; }
__host__ __device__ __forceinline__ int perm32(int rho) { const int n = rho >> 4, i = rho & 15; return 8 * (i >> 2) + 4 * n + (i & 3); }

struct Unit { int pm, pn, grp; long ao, bo; };
struct Gemm { const bf16_t* A; const bf16_t* Bt; int M, N, K, lda, ldb; };

struct StaticOrder {
    int nM, nN, nwg, G, c; long tsA, tsB;
    __host__ __device__ void init(int M, int N, int G_, int c_, int lda, int ldb) { nM = M / BM; nN = N / BM; nwg = nM * nN; G = G_; c = c_; tsA = (long)BM * lda * 2; tsB = (long)BM * ldb * 2; }
    __host__ __device__ bool next(int i, Unit& u) const {
        const long L = (long)i * G + c; if (L >= nwg) return false;
        int wgid = (int)L; { const int q = nwg / NXCD, r = nwg % NXCD, xcd = wgid % NXCD, off = wgid / NXCD; wgid = (xcd < r ? xcd * (q + 1) : r * (q + 1) + (xcd - r) * q) + off; }
        const int nig = WGM * nN, gid = wgid / nig, fm = gid * WGM, gsz = (nM - fm) < WGM ? (nM - fm) : WGM;
        u.pm = fm + ((wgid % nig) % gsz); u.pn = (wgid % nig) / gsz; u.grp = 0; u.ao = u.pm * tsA; u.bo = u.pn * tsB; return true;
    }
    __device__ __forceinline__ void a_ready(const Unit&) const {}
    __device__ __forceinline__ void done(const Unit&) const {}
};

__device__ __forceinline__ unsigned cvt_pk_bf16(float lo, float hi) { unsigned r; asm volatile("v_cvt_pk_bf16_f32 %0, %1, %2" : "=v"(r) : "v"(lo), "v"(hi)); return r; }
template <class Epi, class Sched, bool ALIGN_EPI = false, bool SP2 = false>
__device__ __forceinline__ void gemm_phase(PG8_LAS unsigned char* lds, const Gemm g, const Sched& S, const Epi& E) {
    const int tid = threadIdx.x, wid = __builtin_amdgcn_readfirstlane(tid >> 6), lane = tid & 63, wr = wid >> 2, wc = wid & 3, fr = lane & 15, fq = lane >> 4;
    const int K = g.K, nt = K / BK;
    unsigned voffA[2], voffB[2];
#pragma unroll
    for (int i = 0; i < 2; ++i) { int R, C; stage_rc(tid * 16 + i * 8192, R, C); const int Rb = Epi::PERM ? ((R & ~31) + perm32(R & 31)) : R;
        voffA[i] = (unsigned)(R * g.lda + C) * 2u; voffB[i] = (unsigned)(Rb * g.ldb + C) * 2u; }
    const size_t kstep = (size_t)(BK * 2);
    const size_t hstepA = (size_t)HALF * g.lda * 2, hstepB = (size_t)HALF * g.ldb * 2;
    const unsigned ldsw = (unsigned)wid * 1024u;
    const int aoff = lds_byte(wr * 64 + fr, fq * 8), boff = lds_byte(wc * 32 + fr, fq * 8);
#define PG8_SA(b, h) (((b) * 2 + (h)) * HTB)
#define PG8_SB(b, h) ((4 + (b) * 2 + (h)) * HTB)
#define PG8_STAGE(bufoff, gbase, voff) do { _Pragma("unroll") for (int _i = 0; _i < 2; ++_i) \
        __builtin_amdgcn_global_load_lds((const unsigned*)((const char*)(gbase) + (voff)[_i]), (PG8_LAS unsigned*)(lds + (bufoff) + ldsw + _i * 8192), 16, 0, 0); } while (0)
#define PG8_LDA(dst, b, h) do { _Pragma("unroll") for (int m = 0; m < 4; ++m) _Pragma("unroll") for (int k = 0; k < 2; ++k) dst[m][k] = *(const PG8_LAS bf16x8*)(lds + PG8_SA(b, h) + aoff + m * 2048 + k * 1024); } while (0)
#define PG8_LDB(dst, b, h) do { _Pragma("unroll") for (int n = 0; n < 2; ++n) _Pragma("unroll") for (int k = 0; k < 2; ++k) dst[n][k] = *(const PG8_LAS bf16x8*)(lds + PG8_SB(b, h) + boff + n * 2048 + k * 1024); } while (0)
#define PG8_MMA(ai, bj, At, Bt) do { __builtin_amdgcn_s_setprio(1); _Pragma("unroll") for (int m = 0; m < 4; ++m) _Pragma("unroll") for (int n = 0; n < 2; ++n) _Pragma("unroll") for (int k = 0; k < 2; ++k) \
        acc[ai][bj][m][n] = __builtin_amdgcn_mfma_f32_16x16x32_bf16(Bt[n][k], At[m][k], acc[ai][bj][m][n], 0, 0, 0); __builtin_amdgcn_s_setprio(0); } while (0)
#define PG8_WAIT_V(n) asm volatile("s_waitcnt vmcnt(" #n ")" ::: "memory")
#define PG8_WAIT_L(n) asm volatile("s_waitcnt lgkmcnt(" #n ")" ::: "memory")
#define PG8_BAR __builtin_amdgcn_s_barrier()
#define PG8_SCHED __builtin_amdgcn_sched_barrier(0)
    Unit cur, nxt; int ui = 0;
    if (!S.next(0, cur)) return;
    f32x4 acc[2][2][4][2];
#pragma unroll
    for (int a = 0; a < 2; ++a)
#pragma unroll
        for (int b = 0; b < 2; ++b)
#pragma unroll
            for (int m = 0; m < 4; ++m)
#pragma unroll
                for (int n = 0; n < 2; ++n) acc[a][b][m][n] = (f32x4){0.f, 0.f, 0.f, 0.f};
    bf16x8 At[4][2], B0[2][2], B1[2][2];
    const char* cA = (const char*)g.A + cur.ao; const char* cB = (const char*)g.Bt + cur.bo;
    S.a_ready(cur);
    if constexpr (SP2) {
        PG8_STAGE(PG8_SB(0, 0), cB, voffB); PG8_STAGE(PG8_SB(0, 1), cB + hstepB, voffB); PG8_STAGE(PG8_SA(0, 0), cA, voffA); PG8_STAGE(PG8_SA(0, 1), cA + hstepA, voffA);
        if (wr == 1) PG8_BAR;
        PG8_WAIT_V(2); PG8_BAR;
        PG8_STAGE(PG8_SB(1, 0), cB + kstep, voffB); PG8_STAGE(PG8_SA(1, 0), cA + kstep, voffA); PG8_STAGE(PG8_SB(1, 1), cB + hstepB + kstep, voffB);
        PG8_WAIT_V(6); PG8_BAR;
    } else {
        PG8_STAGE(PG8_SB(0, 0), cB, voffB); PG8_STAGE(PG8_SA(0, 0), cA, voffA); PG8_STAGE(PG8_SB(0, 1), cB + hstepB, voffB); PG8_STAGE(PG8_SA(0, 1), cA + hstepA, voffA);
        if (wr == 1) PG8_BAR;
        PG8_WAIT_V(4); PG8_BAR;
        PG8_STAGE(PG8_SB(1, 0), cB + kstep, voffB); PG8_STAGE(PG8_SA(1, 0), cA + kstep, voffA); PG8_STAGE(PG8_SB(1, 1), cB + hstepB + kstep, voffB);
        PG8_WAIT_V(6); PG8_BAR;
    }
    for (;;) {
        const bool has_next = S.next(ui + 1, nxt);
        const char* nA = has_next ? (const char*)g.A + nxt.ao : cA; const char* nB = has_next ? (const char*)g.Bt + nxt.bo : cB;
        for (int t = 0; t < nt; t += 2) {
            const bool last = (t == nt - 2);
            const char* a1 = cA + (size_t)(t + 1) * kstep;
            const char* a2 = last ? nA : cA + (size_t)(t + 2) * kstep; const char* b2 = last ? nB : cB + (size_t)(t + 2) * kstep;
            const char* a3 = a2 + kstep; const char* b3 = b2 + kstep;
            if (last && has_next) S.a_ready(nxt);
            if constexpr (SP2) {
            PG8_LDB(B0, 0, 0); PG8_LDB(B1, 0, 1); PG8_SCHED; PG8_LDA(At, 0, 0); PG8_STAGE(PG8_SA(1, 1), a1 + hstepA, voffA);
            PG8_WAIT_V(8); PG8_WAIT_L(0); PG8_BAR; PG8_MMA(0, 0, At, B0); PG8_MMA(0, 1, At, B1); PG8_BAR; PG8_SCHED;
            PG8_LDA(At, 0, 1); PG8_STAGE(PG8_SB(0, 0), b2, voffB); PG8_STAGE(PG8_SB(0, 1), b2 + hstepB, voffB); PG8_STAGE(PG8_SA(0, 0), a2, voffA);
            PG8_WAIT_V(8); PG8_WAIT_L(0); PG8_BAR; PG8_MMA(1, 0, At, B0); PG8_MMA(1, 1, At, B1); PG8_BAR; PG8_SCHED;
            PG8_LDB(B0, 1, 0); PG8_LDB(B1, 1, 1); PG8_SCHED; PG8_LDA(At, 1, 0); PG8_STAGE(PG8_SA(0, 1), a2 + hstepA, voffA);
            PG8_WAIT_V(8); PG8_WAIT_L(0); PG8_BAR; PG8_MMA(0, 0, At, B0); PG8_MMA(0, 1, At, B1); PG8_BAR; PG8_SCHED;
            PG8_LDA(At, 1, 1); PG8_STAGE(PG8_SB(1, 0), b3, voffB); PG8_STAGE(PG8_SB(1, 1), b3 + hstepB, voffB); PG8_STAGE(PG8_SA(1, 0), a3, voffA);
            PG8_WAIT_V(8); PG8_WAIT_L(0); PG8_BAR; PG8_MMA(1, 0, At, B0); PG8_MMA(1, 1, At, B1); PG8_BAR; PG8_SCHED;
            } else {
            PG8_LDB(B0, 0, 0); PG8_SCHED; PG8_LDA(At, 0, 0); PG8_STAGE(PG8_SA(1, 1), a1 + hstepA, voffA);
            PG8_WAIT_L(8); PG8_BAR; PG8_WAIT_L(0); PG8_MMA(0, 0, At, B0); PG8_BAR; PG8_SCHED;
            PG8_LDB(B1, 0, 1); PG8_STAGE(PG8_SB(0, 0), b2, voffB);
            PG8_BAR; PG8_WAIT_L(0); PG8_MMA(0, 1, At, B1); PG8_BAR;
            PG8_LDA(At, 0, 1); PG8_STAGE(PG8_SA(0, 0), a2, voffA);
            PG8_BAR; PG8_WAIT_L(0); PG8_MMA(1, 0, At, B0); PG8_BAR; PG8_SCHED;
            PG8_STAGE(PG8_SB(0, 1), b2 + hstepB, voffB);
            PG8_WAIT_V(6); PG8_BAR; PG8_MMA(1, 1, At, B1); PG8_BAR;
            PG8_LDB(B0, 1, 0); PG8_SCHED; PG8_LDA(At, 1, 0); PG8_STAGE(PG8_SA(0, 1), a2 + hstepA, voffA);
            PG8_WAIT_L(8); PG8_BAR; PG8_WAIT_L(0); PG8_MMA(0, 0, At, B0); PG8_BAR; PG8_SCHED;
            PG8_LDB(B1, 1, 1); PG8_STAGE(PG8_SB(1, 0), b3, voffB);
            PG8_BAR; PG8_WAIT_L(0); PG8_MMA(0, 1, At, B1); PG8_BAR;
            PG8_LDA(At, 1, 1); PG8_STAGE(PG8_SA(1, 0), a3, voffA);
            PG8_BAR; PG8_WAIT_L(0); PG8_MMA(1, 0, At, B0); PG8_BAR; PG8_SCHED;
            PG8_STAGE(PG8_SB(1, 1), b3 + hstepB, voffB);
            PG8_WAIT_V(6); PG8_BAR; PG8_MMA(1, 1, At, B1); PG8_BAR;
            }
        }
        if constexpr (ALIGN_EPI) { if (wr == 0) PG8_BAR; }
        if constexpr (!Epi::AFTER_DRAIN) { E(acc, cur, wr, wc, fr, fq); S.done(cur); }
        if (!has_next) break;
#pragma unroll
        for (int a = 0; a < 2; ++a)
#pragma unroll
            for (int b = 0; b < 2; ++b)
#pragma unroll
                for (int m = 0; m < 4; ++m)
#pragma unroll
                    for (int n = 0; n < 2; ++n) acc[a][b][m][n] = (f32x4){0.f, 0.f, 0.f, 0.f};
        cur = nxt; cA = nA; cB = nB; ++ui;
        if constexpr (ALIGN_EPI) { if (wr == 1) PG8_BAR; }
    }
    PG8_WAIT_V(0);
    if constexpr (!ALIGN_EPI) { if (wr == 0) PG8_BAR; }
    PG8_BAR;
    if constexpr (Epi::AFTER_DRAIN) { E.fused(acc, cur, wr, wc, fr, fq, lds, wid, lane); S.done(cur); }
#undef PG8_SA
#undef PG8_SB
#undef PG8_STAGE
#undef PG8_LDA
#undef PG8_LDB
#undef PG8_MMA
#undef PG8_WAIT_V
#undef PG8_WAIT_L
#undef PG8_BAR
#undef PG8_SCHED
}
}


using pg8::Unit;
typedef unsigned u32x2 __attribute__((ext_vector_type(2)));
typedef unsigned u32x4 __attribute__((ext_vector_type(4)));
__device__ __forceinline__ float bflo(unsigned w) { return __uint_as_float(w << 16); }
__device__ __forceinline__ float bfhi(unsigned w) { return __uint_as_float(w & 0xffff0000u); }

struct InProjSched {
  pg8::StaticOrder so;
  __device__ __forceinline__ void init(int G, int c) { so.init(MX, N_IN, G, c, D, D); }
  __device__ __forceinline__ bool next(int i, Unit& u) const {
    const long Lx = (long)i * so.G + so.c;
    if (Lx < so.nwg) return so.next(i, u);
    const int j = (int)(Lx - so.nwg); if (j >= 40) return false;
    u.pm = 64 + (j & 3); u.pn = 4 + (j >> 2); u.grp = 0; u.ao = u.pm * so.tsA; u.bo = u.pn * so.tsB; return true;
  }
  __device__ __forceinline__ void a_ready(const Unit&) const {}
  __device__ __forceinline__ void done(const Unit&) const {}
};

struct EpiInProj {
  static constexpr bool PERM = false, AFTER_DRAIN = false;
  bf16_t *Q, *K, *V, *SA, *G; const float* rope;
  __device__ __forceinline__ static void st4(bf16_t* p, const f32x4 v) { u32x2 w; w.x = pg8::cvt_pk_bf16(v[0], v[1]); w.y = pg8::cvt_pk_bf16(v[2], v[3]); *(u32x2*)p = w; }
  __device__ __forceinline__ void operator()(const f32x4 (&acc)[2][2][4][2], const Unit& u, int wr, int wc, int fr, int fq) const {
    const int row0 = u.pm * 256 + wr * 64 + fr;
    const int cg0 = u.pn * 256 + wc * 32 + fq * 4;
    if (u.pm < 64) {
      if (u.pn < 8) {
        const bool isq = u.pn < 4;
#pragma unroll
        for (int ai = 0; ai < 2; ++ai)
#pragma unroll
          for (int m = 0; m < 4; ++m) {
            const int row = row0 + ai * 128 + m * 16, b = row >> 12, t = row & 4095;
            const int pos = (wc & 1) ? (t & 63) : (t >> 6);
            const f32x4* rp = (const f32x4*)(rope + (pos * 16 + fq * 4) * 2);
            const f32x4 r0 = rp[0], r1 = rp[1];
            const f32x4 cs = {r0[0], r0[2], r1[0], r1[2]}, sn = {r0[1], r0[3], r1[1], r1[3]};
            bf16_t* dst = isq ? Q + (size_t)row * 1024 + cg0 : K + ((size_t)b * LA + NCTX + t) * 1024 + (cg0 - 1024);
#pragma unroll
            for (int bj = 0; bj < 2; ++bj) {
              const f32x4 h1 = acc[ai][bj][m][0], h2 = acc[ai][bj][m][1];
              st4(dst + bj * 128, h1 * cs - h2 * sn);
              st4(dst + bj * 128 + 16, h2 * cs + h1 * sn);
            }
          }
      } else {
#pragma unroll
        for (int ai = 0; ai < 2; ++ai)
#pragma unroll
          for (int m = 0; m < 4; ++m) {
            const int row = row0 + ai * 128 + m * 16, b = row >> 12, t = row & 4095;
            const size_t kr = (size_t)b * LA + NCTX + t;
            if (u.pn >= 12 && u.pn < 14) {
#pragma unroll
              for (int bj = 0; bj < 2; ++bj)
#pragma unroll
                for (int n = 0; n < 2; ++n) {
                  const int ch = cg0 + bj * 128 + n * 16 - 3072;
                  st4(SA + ((size_t)(ch >> 4) * SA_ROWS + b * 128 + (t >> 5)) * SA_LD + (t & 31) * 16 + (ch & 15), acc[ai][bj][m][n]);
                }
            } else {
              bf16_t* dst = u.pn < 12 ? V + kr * 1024 + (cg0 - 2048) : G + (size_t)row * 2048 + (cg0 - 3584);
#pragma unroll
              for (int bj = 0; bj < 2; ++bj)
#pragma unroll
                for (int n = 0; n < 2; ++n) {
                  f32x4 v = acc[ai][bj][m][n];
                  if (u.pn >= 14) { v[0] = sigmoidf_(v[0]); v[1] = sigmoidf_(v[1]); v[2] = sigmoidf_(v[2]); v[3] = sigmoidf_(v[3]); }
                  st4(dst + bj * 128 + n * 16, v);
                }
            }
          }
      }
    } else {
#pragma unroll
      for (int ai = 0; ai < 2; ++ai)
#pragma unroll
        for (int m = 0; m < 4; ++m) {
          const int rc = row0 + ai * 128 + m * 16 - MX, b = rc >> 8, t = rc & 255;
          const size_t kr = (size_t)b * LA + t;
          if (u.pn >= 12) {
#pragma unroll
            for (int bj = 0; bj < 2; ++bj)
#pragma unroll
              for (int n = 0; n < 2; ++n) {
                const int ch = cg0 + bj * 128 + n * 16 - 3072;
                st4(SA + ((size_t)(ch >> 4) * SA_ROWS + 512 + b * 8 + (t >> 5)) * SA_LD + (t & 31) * 16 + (ch & 15), acc[ai][bj][m][n]);
              }
          } else {
            bf16_t* dst = u.pn < 8 ? K + kr * 1024 + (cg0 - 1024) : V + kr * 1024 + (cg0 - 2048);
#pragma unroll
            for (int bj = 0; bj < 2; ++bj)
#pragma unroll
              for (int n = 0; n < 2; ++n) st4(dst + bj * 128 + n * 16, acc[ai][bj][m][n]);
          }
        }
    }
  }
};
template <int MODE>
struct EpiBf8 {
  static constexpr bool PERM = true, AFTER_DRAIN = false;
  bf16_t* O; int ldo; const bf16_t* X; int ldx; const float* bias;
  __device__ __forceinline__ void operator()(const f32x4 (&acc)[2][2][4][2], const Unit& u, int wr, int wc, int fr, int fq) const {
    const int row0 = u.pm * 256 + wr * 64 + fr, col0 = u.pn * 256 + wc * 32 + 8 * fq;
#pragma unroll
    for (int ai = 0; ai < 2; ++ai)
#pragma unroll
      for (int m = 0; m < 4; ++m) {
        const int row = row0 + ai * 128 + m * 16;
#pragma unroll
        for (int bj = 0; bj < 2; ++bj) {
          const int col = col0 + bj * 128;
          f32x4 v0 = acc[ai][bj][m][0], v1 = acc[ai][bj][m][1];
          const u32x4 xw = *(const u32x4*)(X + (size_t)row * ldx + col);
          const f32x4 x0 = {bflo(xw.x), bfhi(xw.x), bflo(xw.y), bfhi(xw.y)}, x1 = {bflo(xw.z), bfhi(xw.z), bflo(xw.w), bfhi(xw.w)};
          if (MODE == 0) {
            const f32x4 b0 = *(const f32x4*)(bias + col), b1 = *(const f32x4*)(bias + col + 4);
#pragma unroll
            for (int i = 0; i < 4; ++i) { v0[i] = x0[i] * sigmoidf_(v0[i] + b0[i]); v1[i] = x1[i] * sigmoidf_(v1[i] + b1[i]); }
          } else if (MODE == 1) { v0 = v0 * x0; v1 = v1 * x1; }
          else {
            const u32x4 ow = *(const u32x4*)(O + (size_t)row * ldo + col);
            const f32x4 o0 = {bflo(ow.x), bfhi(ow.x), bflo(ow.y), bfhi(ow.y)}, o1 = {bflo(ow.z), bfhi(ow.z), bflo(ow.w), bfhi(ow.w)};
            v0 = o0 + v0 * x0; v1 = o1 + v1 * x1;
          }
          u32x4 w; w.x = pg8::cvt_pk_bf16(v0[0], v0[1]); w.y = pg8::cvt_pk_bf16(v0[2], v0[3]); w.z = pg8::cvt_pk_bf16(v1[0], v1[1]); w.w = pg8::cvt_pk_bf16(v1[2], v1[3]);
          *(u32x4*)(O + (size_t)row * ldo + col) = w;
        }
      }
  }
};
template <int MODE>
struct EpiF32 {
  static constexpr bool PERM = false, AFTER_DRAIN = false;
  float* O; const float* xres; const float* mod;
  __device__ __forceinline__ void operator()(const f32x4 (&acc)[2][2][4][2], const Unit& u, int wr, int wc, int fr, int fq) const {
    const int row0 = u.pm * 256 + wr * 64 + fr, col0 = u.pn * 256 + wc * 32 + 4 * fq;
#pragma unroll
    for (int ai = 0; ai < 2; ++ai)
#pragma unroll
      for (int m = 0; m < 4; ++m) {
        const int row = row0 + ai * 128 + m * 16;
#pragma unroll
        for (int bj = 0; bj < 2; ++bj)
#pragma unroll
          for (int n = 0; n < 2; ++n) {
            const int col = col0 + bj * 128 + n * 16;
            f32x4 v = acc[ai][bj][m][n];
            if (MODE == 1) { const f32x4 xr = *(const f32x4*)(xres + (size_t)row * 1024 + col); const f32x4 g = *(const f32x4*)(mod + (row >> 12) * 6144 + 2048 + col); v = xr + g * v; }
            *(f32x4*)(O + (size_t)row * 1024 + col) = v;
          }
      }
  }
};


struct GroupSched {
  int npm, npn, nunits, G, c; long gsA, gsB, tsA, tsB;
  __device__ __forceinline__ void init(int ngrp, int npm_, int npn_, long gsA_, long tsA_, long gsB_, long tsB_, int G_, int c_) { npm = npm_; npn = npn_; nunits = ngrp * npm_ * npn_; gsA = gsA_; tsA = tsA_; gsB = gsB_; tsB = tsB_; G = G_; c = c_; }
  __device__ __forceinline__ bool next(int i, Unit& u) const {
    const long Lx = (long)i * G + c; if (Lx >= nunits) return false;
    const int per = npm * npn, grp = (int)Lx / per, r = (int)Lx % per;
    u.grp = grp; u.pm = r / npn; u.pn = r % npn; u.ao = grp * gsA + u.pm * tsA; u.bo = grp * gsB + u.pn * tsB; return true;
  }
  __device__ __forceinline__ void a_ready(const Unit&) const {}
  __device__ __forceinline__ void done(const Unit&) const {}
};
struct EpiS {
  static constexpr bool PERM = false, AFTER_DRAIN = false;
  float* S;
  __device__ __forceinline__ void operator()(const f32x4 (&acc)[2][2][4][2], const Unit& u, int wr, int wc, int fr, int fq) const {
    const int row0 = u.pm * 256 + wr * 64 + fr, col0 = wc * 32 + 4 * fq;
#pragma unroll
    for (int ai = 0; ai < 2; ++ai)
#pragma unroll
      for (int m = 0; m < 4; ++m) {
        const int row = row0 + ai * 128 + m * 16;
        if (row < SA_ROWS) {
#pragma unroll
          for (int bj = 0; bj < 2; ++bj)
#pragma unroll
            for (int n = 0; n < 2; ++n) *(f32x4*)(S + ((size_t)u.grp * SA_ROWS + row) * 256 + col0 + bj * 128 + n * 16) = acc[ai][bj][m][n];
        }
      }
  }
};
struct EpiY {
  static constexpr bool PERM = true, AFTER_DRAIN = false;
  bf16_t* YG;
  __device__ __forceinline__ void operator()(const f32x4 (&acc)[2][2][4][2], const Unit& u, int wr, int wc, int fr, int fq) const {
    const int row0 = u.pm * 256 + wr * 64 + fr, col0 = u.pn * 256 + wc * 32 + 8 * fq;
#pragma unroll
    for (int ai = 0; ai < 2; ++ai)
#pragma unroll
      for (int m = 0; m < 4; ++m) {
        const int row = row0 + ai * 128 + m * 16, b = row >> 7, cx = row & 127;
#pragma unroll
        for (int bj = 0; bj < 2; ++bj) {
          const int col = col0 + bj * 128, j = col >> 4, p0 = col & 15;
          const f32x4 v0 = acc[ai][bj][m][0], v1 = acc[ai][bj][m][1];
          u32x4 w; w.x = pg8::cvt_pk_bf16(gelu_tanh(v0[0]), gelu_tanh(v0[1])); w.y = pg8::cvt_pk_bf16(gelu_tanh(v0[2]), gelu_tanh(v0[3]));
          w.z = pg8::cvt_pk_bf16(gelu_tanh(v1[0]), gelu_tanh(v1[1])); w.w = pg8::cvt_pk_bf16(gelu_tanh(v1[2]), gelu_tanh(v1[3]));
          *(u32x4*)(YG + ((size_t)(b * L + cx * 32 + j)) * 512 + u.grp * 16 + p0) = w;
        }
      }
  }
};


__device__ __forceinline__ unsigned f2key(float s) { const unsigned u = __float_as_uint(s); return u ^ ((u & 0x80000000u) ? 0xFFFFFFFFu : 0x80000000u); }
__device__ __forceinline__ float key2f(unsigned k) { return __uint_as_float(k ^ ((k & 0x80000000u) ? 0x80000000u : 0xFFFFFFFFu)); }
#define TK_INSERT(L, cv) do { _Pragma("unroll") for (int k_ = 0; k_ < 16; ++k_) { const unsigned hi_ = L[k_] > cv ? L[k_] : cv, lo_ = L[k_] > cv ? cv : L[k_]; L[k_] = hi_; cv = lo_; } } while (0)
struct EpiTopK {
  static constexpr bool PERM = false, AFTER_DRAIN = true;
  unsigned short* IDX; float* GATE;
  __device__ __forceinline__ void fused(f32x4 (&acc)[2][2][4][2], const Unit& u, int wr, int wc, int fr, int fq, PG8_LAS unsigned char* lds, int wid, int lane) const {
    PG8_LAS float* SC = (PG8_LAS float*)lds;
    const int tid = wid * 64 + lane;
#pragma unroll
    for (int ai = 0; ai < 2; ++ai) {
#pragma unroll
      for (int m = 0; m < 4; ++m)
#pragma unroll
        for (int bj = 0; bj < 2; ++bj)
#pragma unroll
          for (int n = 0; n < 2; ++n)
#pragma unroll
            for (int i = 0; i < 4; ++i) SC[(64 * wr + 16 * m + fr) * 257 + 128 * bj + 32 * wc + 16 * n + 4 * fq + i] = acc[ai][bj][m][n][i];
      asm volatile("s_waitcnt lgkmcnt(0)" ::: "memory"); __builtin_amdgcn_s_barrier(); asm volatile("" ::: "memory");
      if (tid < 256) {
        PG8_LAS float* rowp = SC + (tid & 127) * 257 + (tid >> 7) * 128;
        unsigned Lk[16];
#pragma unroll
        for (int k = 0; k < 16; ++k) Lk[k] = 0u;
        for (int k = 0; k < 128; ++k) { unsigned cv = (f2key(rowp[k]) & ~0x7Fu) | (unsigned)(127 - k); TK_INSERT(Lk, cv); }
#pragma unroll
        for (int k = 0; k < 16; ++k) rowp[k] = __uint_as_float(Lk[k]);
      }
      asm volatile("s_waitcnt lgkmcnt(0)" ::: "memory"); __builtin_amdgcn_s_barrier(); asm volatile("" ::: "memory");
      if (tid < 128) {
        PG8_LAS float* rowp = SC + tid * 257;
        float v1[16], v2[16];
#pragma unroll
        for (int k = 0; k < 16; ++k) { v1[k] = key2f(__float_as_uint(rowp[k]) & ~0x7Fu); v2[k] = key2f(__float_as_uint(rowp[128 + k]) & ~0x7Fu); }
        unsigned Lc[16];
#pragma unroll
        for (int k = 0; k < 16; ++k) Lc[k] = 0u;
#pragma unroll
        for (int a = 0; a < 16; ++a)
#pragma unroll
          for (int b = 0; b < 16; ++b)
            if ((a + 1) * (b + 1) <= 16) { unsigned cv = (f2key(v1[a] + v2[b]) & ~0xFFu) | (unsigned)(255 - (a * 16 + b)); TK_INSERT(Lc, cv); }
        float ev[16]; float den = 0.f; const float mx = key2f(Lc[0] & ~0xFFu);
#pragma unroll
        for (int k = 0; k < 16; ++k) { ev[k] = __expf(key2f(Lc[k] & ~0xFFu) - mx); den += ev[k]; }
        const float inv = 1.f / den;
        const size_t o = ((size_t)(u.pm * 256 + ai * 128 + tid) * 8 + u.pn) * 16;
        unsigned iw[8];
#pragma unroll
        for (int k = 0; k < 16; ++k) {
          const int code = 255 - (int)(Lc[k] & 0xFFu), a = code >> 4, b = code & 15;
          const unsigned e1 = 127u - (__float_as_uint(rowp[a]) & 0x7Fu), e2 = 127u - (__float_as_uint(rowp[128 + b]) & 0x7Fu);
          const unsigned ex = e1 * 128u + e2;
          if (k & 1) iw[k >> 1] |= ex << 16; else iw[k >> 1] = ex;
        }
        *(u32x4*)(IDX + o) = (u32x4){iw[0], iw[1], iw[2], iw[3]}; *(u32x4*)(IDX + o + 8) = (u32x4){iw[4], iw[5], iw[6], iw[7]};
#pragma unroll
        for (int k = 0; k < 16; k += 4) *(f32x4*)(GATE + o + k) = (f32x4){ev[k] * inv, ev[k + 1] * inv, ev[k + 2] * inv, ev[k + 3] * inv};
      }
      asm volatile("s_waitcnt lgkmcnt(0)" ::: "memory"); __builtin_amdgcn_s_barrier(); asm volatile("" ::: "memory");
    }
  }
};
struct OneUnitSched {
  int nM, nN, G, c, round; long tsA, tsB;
  __device__ __forceinline__ bool next(int i, Unit& u) const {
    if (i > 0) return false;
    const long Lx = (long)round * G + c; if (Lx >= (long)nM * nN) return false;
    u.pm = (int)(Lx % nM); u.pn = (int)(Lx / nM); u.grp = 0; u.ao = u.pm * tsA; u.bo = u.pn * tsB; return true;
  }
  __device__ __forceinline__ void a_ready(const Unit&) const {}
  __device__ __forceinline__ void done(const Unit&) const {}
};

__device__ __forceinline__ void transpose_item(const float* W, int K, int N, bf16_t* WT, float* scr, int item, int lane) {
  const int nblk = N / 32, kb = item / nblk, nb = item % nblk, k0 = 64 * kb, n0 = 32 * nb;
#pragma unroll 8
  for (int i = 0; i < 32; ++i) { const int kk = 2 * i + (lane >> 5); scr[kk * 33 + (lane & 31)] = W[(size_t)(k0 + kk) * N + n0 + (lane & 31)]; }
  asm volatile("s_waitcnt lgkmcnt(0)" ::: "memory");
  const int c = lane & 7;
#pragma unroll
  for (int j = 0; j < 4; ++j) {
    const int n = (lane >> 3) + 8 * j; const float* s = scr + (8 * c) * 33 + n;
    u32x4 o; o.x = pg8::cvt_pk_bf16(s[0], s[33]); o.y = pg8::cvt_pk_bf16(s[66], s[99]); o.z = pg8::cvt_pk_bf16(s[132], s[165]); o.w = pg8::cvt_pk_bf16(s[198], s[231]);
    *(u32x4*)(WT + (size_t)(n0 + n) * K + k0 + 8 * c) = o;
  }
  asm volatile("s_waitcnt lgkmcnt(0)" ::: "memory");
}

namespace att {
using bf16 = unsigned short;
constexpr int   D = 128, NW = 8, QBLK = 32, KVBLK = 64, SDEPTH = 1;
constexpr float SCALE = 0.125f;
constexpr float THR = 8.f;
constexpr int LDQ = 1024, LDK = 1024, LDO = 1024;
constexpr size_t SHM_V = KVBLK * D * 2, SHM_K = KVBLK * D * 2, SHM_ATTN = 2 * SHM_V + 2 * SHM_K + NW * 64 * 4 + 4 * 4 * 16 * 64 * 4;
using bf16x8 = __attribute__((ext_vector_type(8))) short;
using s16x4  = __attribute__((ext_vector_type(4))) short;
using f32x16 = __attribute__((ext_vector_type(16))) float;
using f32x8  = __attribute__((ext_vector_type(8))) float;
using u32x4  = __attribute__((ext_vector_type(4))) unsigned;
#define KSWZ(row, colB) ((row) * 256 + ((colB) ^ (((row) & 7) << 4)))
#define SBAR() __builtin_amdgcn_sched_barrier(0)
__device__ __forceinline__ int crow(int r, int hi) { return (r & 3) + 8 * (r >> 2) + 4 * hi; }
__device__ __forceinline__ unsigned cvtpk(float lo, float hi) {
  unsigned r; asm volatile("v_cvt_pk_bf16_f32 %0, %1, %2" : "=v"(r) : "v"(lo), "v"(hi)); return r;
}
template <typename TIn> struct Stage;
template <> struct Stage<bf16>  { using T = bf16x8;
  __device__ static __forceinline__ T ld8(const bf16* p) { return *reinterpret_cast<const bf16x8*>(p); }
  __device__ static __forceinline__ bf16x8 tobf(T x) { return x; } };
__device__ __forceinline__ void partialSM(f32x16& p0, f32x16& p1, float& m_reg, float& mn, float& alpha) {
  constexpr float C = SCALE * 1.4426950408889634f;
  float pmax = p0[0]; for (int r = 1; r < 16; ++r) pmax = fmaxf(pmax, p0[r]); for (int r = 0; r < 16; ++r) pmax = fmaxf(pmax, p1[r]);
  { auto rr = __builtin_amdgcn_permlane32_swap(__float_as_uint(pmax), __float_as_uint(pmax), false, false);
    pmax = fmaxf(__uint_as_float(rr[0]), __uint_as_float(rr[1])); }
  if (__builtin_expect(__all(pmax - m_reg <= THR / SCALE), 1)) { mn = m_reg; alpha = 1.f; }
  else { mn = fmaxf(m_reg, pmax); alpha = __builtin_amdgcn_exp2f((m_reg - mn) * C); m_reg = mn; }
  float mnC = -mn * C;
  for (int r = 0; r < 16; ++r) p0[r] = fmaf(p0[r], C, mnC); for (int r = 0; r < 16; ++r) p1[r] = fmaf(p1[r], C, mnC);
  for (int r = 0; r < 16; ++r) p0[r] = __builtin_amdgcn_exp2f(p0[r]);
}
__device__ __forceinline__ void finishSM(f32x16& p0, f32x16& p1, float alpha, float& l_reg, bf16x8& pa0, bf16x8& pa1, bf16x8& pa2, bf16x8& pa3) {
  for (int r = 0; r < 16; ++r) p1[r] = __builtin_amdgcn_exp2f(p1[r]);
  float ps = 0; for (int r = 0; r < 16; ++r) ps += p0[r]; for (int r = 0; r < 16; ++r) ps += p1[r];
  { auto rr = __builtin_amdgcn_permlane32_swap(__float_as_uint(ps), __float_as_uint(ps), false, false);
    ps = __uint_as_float(rr[0]) + __uint_as_float(rr[1]); }
  l_reg = l_reg * alpha + ps;
#define PK4(P, BASE, OUT) do { unsigned a0 = cvtpk(P[BASE + 0], P[BASE + 1]), a1 = cvtpk(P[BASE + 2], P[BASE + 3]);   \
    unsigned b0 = cvtpk(P[BASE + 4], P[BASE + 5]), b1 = cvtpk(P[BASE + 6], P[BASE + 7]);                              \
    auto r0 = __builtin_amdgcn_permlane32_swap(a0, b0, false, false); auto r1 = __builtin_amdgcn_permlane32_swap(a1, b1, false, false); \
    u32x4 w = {r0[0], r1[0], r0[1], r1[1]}; OUT = *reinterpret_cast<bf16x8*>(&w); } while (0)
  PK4(p0, 0, pa0); PK4(p0, 8, pa1); PK4(p1, 0, pa2); PK4(p1, 8, pa3);
#undef PK4
}
__device__ __forceinline__ void qkt(f32x16& p0, f32x16& p1, const bf16* Ks, const bf16x8* qr, int r32, int hi, int mcolB) {
  p0 = f32x16{}; p1 = f32x16{};
#pragma unroll
  for (int d0 = 0; d0 < 4; ++d0) { int cb = mcolB + (d0 * 16 + hi * 8) * 2;
    bf16x8 b0 = *reinterpret_cast<const bf16x8*>((const char*)Ks + KSWZ(r32, cb));
    bf16x8 b1 = *reinterpret_cast<const bf16x8*>((const char*)Ks + KSWZ(32 + r32, cb));
    p0 = __builtin_amdgcn_mfma_f32_32x32x16_bf16(b0, qr[d0], p0, 0, 0, 0);
    p1 = __builtin_amdgcn_mfma_f32_32x32x16_bf16(b1, qr[d0], p1, 0, 0, 0); }
}
__device__ __forceinline__ int v_st(int k, int c) { const int kk = (k & ~0xC) | ((k & 4) << 1) | ((k & 8) >> 1); return ((kk >> 3) * 4 + (c >> 5)) * 512 + ((kk & 7) * 32 + (c & 31)) * 2; }
__device__ __forceinline__ int v_rd_base(int lane) { return ((lane & 3) << 3) | (((lane >> 2) & 3) << 6) | (((lane >> 4) & 1) << 5) | (((lane >> 5) & 1) << 8); }
constexpr int v_rd_off(int d0, int ks, int half) { return d0 * 512 + ks * 4096 + half * 2048; }
template <int OFF> __device__ __forceinline__ s16x4 tr_read(int vb) {
  s16x4 r; asm volatile("ds_read_b64_tr_b16 %0, %1 offset:%2" : "=&v"(r) : "v"(vb), "i"(OFF) : "memory"); return r;
}
template <int D0> __device__ __forceinline__ void pv_one(f32x16& od, int vb, bf16x8 pa0, bf16x8 pa1, bf16x8 pa2, bf16x8 pa3) {
  const s16x4 l0 = tr_read<v_rd_off(D0, 0, 0)>(vb), h0 = tr_read<v_rd_off(D0, 0, 1)>(vb), l1 = tr_read<v_rd_off(D0, 1, 0)>(vb), h1 = tr_read<v_rd_off(D0, 1, 1)>(vb);
  const s16x4 l2 = tr_read<v_rd_off(D0, 2, 0)>(vb), h2 = tr_read<v_rd_off(D0, 2, 1)>(vb), l3 = tr_read<v_rd_off(D0, 3, 0)>(vb), h3 = tr_read<v_rd_off(D0, 3, 1)>(vb);
  asm volatile("s_waitcnt lgkmcnt(0)" ::: "memory"); SBAR();
#define PK(L, H) (bf16x8){L[0], L[1], L[2], L[3], H[0], H[1], H[2], H[3]}
  od = __builtin_amdgcn_mfma_f32_32x32x16_bf16(pa0, PK(l0, h0), od, 0, 0, 0);
  od = __builtin_amdgcn_mfma_f32_32x32x16_bf16(pa1, PK(l1, h1), od, 0, 0, 0);
  od = __builtin_amdgcn_mfma_f32_32x32x16_bf16(pa2, PK(l2, h2), od, 0, 0, 0);
  od = __builtin_amdgcn_mfma_f32_32x32x16_bf16(pa3, PK(l3, h3), od, 0, 0, 0);
#undef PK
}
__device__ __forceinline__ void pv_d0(f32x16* o, int vb, bf16x8 pa0, bf16x8 pa1, bf16x8 pa2, bf16x8 pa3) {
  pv_one<0>(o[0], vb, pa0, pa1, pa2, pa3); pv_one<1>(o[1], vb, pa0, pa1, pa2, pa3); pv_one<2>(o[2], vb, pa0, pa1, pa2, pa3); pv_one<3>(o[3], vb, pa0, pa1, pa2, pa3);
}

__device__ __forceinline__ void diff_attn_unit(const bf16* __restrict__ Qb, const bf16* __restrict__ Kh, const bf16* __restrict__ Vh,
                                               bf16* __restrict__ Ob, int seq, float lam, const float* __restrict__ subln, char* lds) {
  using St = Stage<bf16>;
  const int tid = threadIdx.x, wid = tid >> 6, lane = tid & 63, r32 = lane & 31, hi = lane >> 5;
  bf16* V_lds = (bf16*)lds; bf16* K_lds = (bf16*)(lds + 2 * SHM_V);
  float* ws = (float*)(lds + 2 * SHM_V + 2 * SHM_K) + wid * 64; float* li_l = ws; float* al_l = ws + 32;
  float m_reg = -1e30f, l_reg = 0; f32x16 o[4] = {}; bf16x8 qr[4];
  const int mw = wid >> 2, wq = wid & 3, mcolB = mw * 128;
  const bf16* Qw = Qb + (long)(wq * QBLK + r32) * LDQ + mw * 64 + hi * 8;
#pragma unroll
  for (int d0 = 0; d0 < 4; ++d0) qr[d0] = St::ld8(Qw + d0 * 16);
  const int sr = tid >> 4, sc = (tid & 15) * 8, vst0 = v_st(sr, sc), vst1 = v_st(32 + sr, sc);
  const int vb0 = (int)(uintptr_t)V_lds + v_rd_base(lane);
  struct { typename St::T vs0, vs1, ks0, ks1; } sr_[SDEPTH];
#define SLOAD(i, k0) do { sr_[i].vs0 = St::ld8(&Vh[(long)((k0) + sr) * LDK + sc]); sr_[i].vs1 = St::ld8(&Vh[(long)((k0) + 32 + sr) * LDK + sc]); \
    sr_[i].ks0 = St::ld8(&Kh[(long)((k0) + sr) * LDK + sc]); sr_[i].ks1 = St::ld8(&Kh[(long)((k0) + 32 + sr) * LDK + sc]); } while (0)
#define SWRITE(b, i) do { *(bf16x8*)((char*)V_lds + (b) * SHM_V + vst0) = St::tobf(sr_[i].vs0);          \
    *(bf16x8*)((char*)V_lds + (b) * SHM_V + vst1) = St::tobf(sr_[i].vs1); int kc = sc * 2;               \
    *(bf16x8*)((char*)K_lds + (b) * SHM_K + KSWZ(sr, kc)) = St::tobf(sr_[i].ks0);                       \
    *(bf16x8*)((char*)K_lds + (b) * SHM_K + KSWZ(32 + sr, kc)) = St::tobf(sr_[i].ks1); } while (0)
#define SWAIT() do { if constexpr (SDEPTH == 2) asm volatile("s_waitcnt vmcnt(4)" ::: "memory"); else asm volatile("s_waitcnt vmcnt(0)" ::: "memory"); } while (0)
#define RESC(a) do { if (__any((a) < 1.f)) { if (hi == 0) al_l[r32] = (a); asm volatile("s_waitcnt lgkmcnt(0)" ::: "memory"); \
    for (int d = 0; d < 4; ++d) for (int r = 0; r < 16; ++r) o[d][r] *= al_l[crow(r, hi)]; } } while (0)
  f32x16 pA0, pA1, pB0, pB1; float mnA, mnB, alA, alB; bf16x8 pa0, pa1, pa2, pa3; const int NT = seq / KVBLK;
  constexpr int SE = 0, SO = SDEPTH - 1;
  SLOAD(SE, 0); asm volatile("s_waitcnt vmcnt(0)" ::: "memory"); SWRITE(0, SE); __syncthreads();
  qkt(pA0, pA1, K_lds, qr, r32, hi, mcolB); partialSM(pA0, pA1, m_reg, mnA, alA);
  SLOAD(SO, KVBLK); if constexpr (SDEPTH == 2) { if (2 < NT) SLOAD(SE, 2 * KVBLK); }
  SWAIT(); SWRITE(1, SO); __syncthreads();
  for (int j = 1; j + 1 < NT; j += 2) {
    SBAR(); qkt(pB0, pB1, (bf16*)((char*)K_lds + SHM_K), qr, r32, hi, mcolB);
    finishSM(pA0, pA1, alA, l_reg, pa0, pa1, pa2, pa3); SBAR();
    SLOAD(SO, (j + SDEPTH) * KVBLK); SBAR();
    pv_d0(o, vb0, pa0, pa1, pa2, pa3); partialSM(pB0, pB1, m_reg, mnB, alB);
    __syncthreads(); SWAIT(); SWRITE(0, SE);
    RESC(alB); __syncthreads();
    SBAR(); qkt(pA0, pA1, K_lds, qr, r32, hi, mcolB);
    finishSM(pB0, pB1, alB, l_reg, pa0, pa1, pa2, pa3); SBAR();
    if (SDEPTH == 1 || j + 3 < NT) SLOAD(SE, (j + 1 + SDEPTH) * KVBLK); SBAR();
    pv_d0(o, vb0 + (int)SHM_V, pa0, pa1, pa2, pa3); partialSM(pA0, pA1, m_reg, mnA, alA);
    __syncthreads(); SWAIT(); SWRITE(1, SO);
    RESC(alA); __syncthreads();
  }
  SBAR(); qkt(pB0, pB1, (bf16*)((char*)K_lds + SHM_K), qr, r32, hi, mcolB);
  finishSM(pA0, pA1, alA, l_reg, pa0, pa1, pa2, pa3); SBAR();
  pv_d0(o, vb0, pa0, pa1, pa2, pa3); partialSM(pB0, pB1, m_reg, mnB, alB);
  __syncthreads(); RESC(alB);
  finishSM(pB0, pB1, alB, l_reg, pa0, pa1, pa2, pa3); SBAR();
  pv_d0(o, vb0 + (int)SHM_V, pa0, pa1, pa2, pa3);
  if (hi == 0) li_l[r32] = l_reg; asm volatile("s_waitcnt lgkmcnt(0)" ::: "memory");
  float rli[16];
#pragma unroll
  for (int r = 0; r < 16; ++r) rli[r] = __builtin_amdgcn_rcpf(li_l[crow(r, hi)]);
  float* EXO = (float*)(lds + 2 * SHM_V + 2 * SHM_K + NW * 64 * 4) + wq * (4 * 16 * 64) + lane;
  if (mw == 1) {
#pragma unroll
    for (int d0 = 0; d0 < 4; ++d0)
#pragma unroll
      for (int r = 0; r < 16; ++r) EXO[(d0 * 16 + r) * 64] = o[d0][r] * rli[r];
  }
  __syncthreads();
  if (mw == 0) {
    float ssq[16];
#pragma unroll
    for (int r = 0; r < 16; ++r) ssq[r] = 0.f;
#pragma unroll
    for (int d0 = 0; d0 < 4; ++d0)
#pragma unroll
      for (int r = 0; r < 16; ++r) { const float dv = o[d0][r] * rli[r] - lam * EXO[(d0 * 16 + r) * 64]; o[d0][r] = dv; ssq[r] += dv * dv; }
#pragma unroll
    for (int r = 0; r < 16; ++r) {
#pragma unroll
      for (int sft = 1; sft < 32; sft <<= 1) ssq[r] += __shfl_xor(ssq[r], sft);
      ssq[r] = rsqrtf(ssq[r] * (1.f / 128.f) + 1e-6f) * 0.8f;
    }
    bf16* Ow = Ob + (long)(wq * QBLK) * LDO;
#pragma unroll
    for (int d0 = 0; d0 < 4; ++d0) { const float gg = subln[d0 * 32 + r32];
#pragma unroll
      for (int r = 0; r < 16; ++r) { const float val = o[d0][r] * ssq[r] * gg; Ow[(long)crow(r, hi) * LDO + d0 * 32 + r32] = (bf16)(pg8::cvt_pk_bf16(val, val) & 0xffffu); } }
  }
  __syncthreads();
#undef SLOAD
#undef SWRITE
#undef SWAIT
#undef RESC
}
}


__device__ __forceinline__ void slice_table(const float* T, bf16_t* T8, int gtid, int gsz) {
  for (int it = gtid; it < 16384 * 128; it += gsz) {
    const int e = it >> 7, c8 = (it & 127) * 8, j = c8 >> 7, c = c8 & 127;
    const f32x4 a = *(const f32x4*)(T + (size_t)e * 1024 + c8), b = *(const f32x4*)(T + (size_t)e * 1024 + c8 + 4);
    u32x4 w; w.x = pg8::cvt_pk_bf16(a[0], a[1]); w.y = pg8::cvt_pk_bf16(a[2], a[3]); w.z = pg8::cvt_pk_bf16(b[0], b[1]); w.w = pg8::cvt_pk_bf16(b[2], b[3]);
    *(u32x4*)(T8 + ((size_t)j * 16384 + e) * 128 + c) = w;
  }
}

__device__ __forceinline__ void wave_argmax(float& v, int& i) {
#pragma unroll
  for (int o = 32; o; o >>= 1) {
    const float ov = __shfl_xor(v, o); const int oi = __shfl_xor(i, o);
    if (ov > v || (ov == v && oi < i)) { v = ov; i = oi; }
  }
}

__global__ void __launch_bounds__(NT) mega(Params p) {
  extern __shared__ __attribute__((aligned(16))) unsigned char lds[];
  cg::grid_group grid = cg::this_grid();
  if (threadIdx.x < 35) {
    unsigned long long v = threadIdx.x < 33 ? (unsigned long long)p.in[threadIdx.x] : (threadIdx.x == 33 ? (unsigned long long)p.out : (unsigned long long)p.ws);
    ((unsigned long long*)(lds + PTR_OFF))[threadIdx.x] = v;
  }
  __syncthreads();

  {
    PHASE_LOCALS
    float* MOD = (float*)WSP(WS_MOD); float* LAM = (float*)WSP(WS_LAM);
    float* ABRE = (float*)WSP(WS_ABRE); float* ABIM = (float*)WSP(WS_ABIM); float* BBRE = (float*)WSP(WS_BBRE); float* BBIM = (float*)WSP(WS_BBIM);
    const float* cin = INP(1); const float* c_ctx = INP(3); const float* ada_w = INP(4); const float* ada_b = INP(5);
    if (gridDim.x >= 192) {
      if (blockIdx.x < 192) {
        float* sil = fl; float* red = fl + 5 * 1024;
        for (int i = tid; i < 5 * 1024; i += NT) { const int r = i >> 10, k = i & 1023; sil[i] = siluf_(r < 4 ? cin[r * D + k] : c_ctx[k]); }
        __syncthreads();
        const int cl = tid & 31, kg = tid >> 5, col = blockIdx.x * 32 + cl;
        float a[5] = {0.f, 0.f, 0.f, 0.f, 0.f};
#pragma unroll 16
        for (int kk = 0; kk < 64; ++kk) {
          const int k = kg * 64 + kk; const float w = ada_w[(size_t)k * 6144 + col];
#pragma unroll
          for (int r = 0; r < 5; ++r) a[r] += sil[r * 1024 + k] * w;
        }
#pragma unroll
        for (int r = 0; r < 5; ++r) red[(kg * 5 + r) * 32 + cl] = a[r];
        __syncthreads();
        if (tid < 160) {
          const int r = tid >> 5; float s = 0.f;
#pragma unroll
          for (int q = 0; q < 16; ++q) s += red[(q * 5 + r) * 32 + cl];
          MOD[r * 6144 + col] = s + ada_b[col];
        }
        __syncthreads();
      }
    } else {
      for (int it = gtid; it < 5 * 6144; it += gsz) {
        const int r = it / 6144, j = it % 6144;
        const float* cv = r < 4 ? cin + r * D : c_ctx;
        float a = 0.f;
        for (int k = 0; k < D; ++k) a += siluf_(cv[k]) * ada_w[(size_t)k * 6144 + j];
        MOD[it] = a + ada_b[j];
      }
    }
    if (gtid == 0) {
      const float* q1 = INP(9); const float* k1 = INP(10); const float* q2 = INP(11); const float* k2 = INP(12);
      float s1 = 0.f, s2 = 0.f;
      for (int k = 0; k < 64; ++k) { s1 += q1[k] * k1[k]; s2 += q2[k] * k2[k]; }
      LAM[0] = expf(s1) - expf(s2) + 0.2f;
    }
    const float* a_re = INP(15); const float* a_im = INP(16); const float* ldt = INP(17); const float* b_re = INP(18); const float* b_im = INP(19);
    for (int it = gtid; it < 2 * 32 * 64; it += gsz) {
      const int dg = it >> 6;
      const float ar = a_re[it], ai = a_im[it], dt = expf(ldt[dg]);
      const float mag = expf(ar * dt), abr = mag * cosf(ai * dt), abi = mag * sinf(ai * dt);
      ABRE[it] = abr; ABIM[it] = abi; ((float*)WSP(WS_ARDT))[it] = ar * dt; ((float*)WSP(WS_AIDT))[it] = ai * dt;
      const float den = ar * ar + ai * ai, nr = abr - 1.f, ni = abi;
      const float fr = (nr * ar + ni * ai) / den, fi = (ni * ar - nr * ai) / den;
      for (int pp = 0; pp < 16; ++pp) {
        const float br = b_re[it * 16 + pp], bi = b_im[it * 16 + pp];
        BBRE[it * 16 + pp] = fr * br - fi * bi; BBIM[it * 16 + pp] = fr * bi + fi * br;
      }
    }
    float* ROPE = (float*)WSP(WS_ROPE);
    for (int it = gtid; it < 64 * 16; it += gsz) {
      const float ang = (float)(it >> 4) * powf(10000.f, -(float)(it & 15) / 16.f);
      ROPE[it * 2] = cosf(ang); ROPE[it * 2 + 1] = sinf(ang);
    }
    {
      float* scr = fl + wid * (64 * 33);
      constexpr int I_IN = 16 * 176, I_AU = 16 * 32, I_SU = 8 * 32, I_OUT = 16 * 32, I_Q = 16 * 32, I_GLU = 8 * 16;
      for (int it = gw; it < I_IN + I_AU + I_SU + I_OUT + I_GLU; it += ngw) {
        int r = it;
        if (r < I_IN) { transpose_item(INP(8), 1024, N_IN, (bf16_t*)WSP(WS_WIN), scr, r, lane); continue; } r -= I_IN;
        if (r < I_AU) { transpose_item(INP(14), 1024, 1024, (bf16_t*)WSP(WS_WAU), scr, r, lane); continue; } r -= I_AU;
        if (r < I_SU) { transpose_item(INP(25), 512, 1024, (bf16_t*)WSP(WS_WSU), scr, r, lane); continue; } r -= I_SU;
        if (r < I_OUT) { transpose_item(INP(26), 1024, 1024, (bf16_t*)WSP(WS_WOUT), scr, r, lane); continue; } r -= I_OUT;
        transpose_item(INP(23), 512, 512, (bf16_t*)WSP(WS_WGLU), scr, r, lane);
      }
    }
  }
  grid.sync();

  {
    PHASE_LOCALS
    const float* MOD = (const float*)WSP(WS_MOD); bf16_t* XN = (bf16_t*)WSP(WS_XN);
    const float* x = INP(0); const float* ctx = INP(2); const float* norm1_g = INP(6);
    for (int row = gw; row < MX + MC; row += ngw) {
      const float* src; const float* md;
      if (row < MX) { src = x + (size_t)row * D; md = MOD + (row / L) * 6144; } else { src = ctx + (size_t)(row - MX) * D; md = MOD + 4 * 6144; }
      f32x4 v[4]; float ss = 0.f;
#pragma unroll
      for (int j = 0; j < 4; ++j) { v[j] = *(const f32x4*)(src + lane * 4 + 256 * j); ss += v[j][0] * v[j][0] + v[j][1] * v[j][1] + v[j][2] * v[j][2] + v[j][3] * v[j][3]; }
      const float rstd = rsqrtf(wave_sum(ss) * (1.f / D) + 1e-6f);
#pragma unroll
      for (int j = 0; j < 4; ++j)
#pragma unroll
        for (int e = 0; e < 4; ++e) { const int col = lane * 4 + 256 * j + e; XN[(size_t)row * D + col] = f2bf(v[j][e] * rstd * norm1_g[col] * (1.f + md[1024 + col]) + md[col]); }
    }
    const float* ARDT = (const float*)WSP(WS_ARDT); const float* AIDT = (const float*)WSP(WS_AIDT);
    const float* BBRE = (const float*)WSP(WS_BBRE); const float* BBIM = (const float*)WSP(WS_BBIM);
    {
      bf16_t* BTS = (bf16_t*)WSP(WS_BTS);
      for (int it = gtid; it < 32 * 256 * 32; it += gsz) {
        const int i = it & 31, r = (it >> 5) & 255, g = it >> 13;
        const int d = r >> 7, n = (r >> 1) & 63, ri = r & 1, sidx = (d * 32 + g) * 64 + n;
        const float e = (float)(d == 0 ? 31 - i : i);
        const float mag = expf(e * ARDT[sidx]), pr = mag * cosf(e * AIDT[sidx]), pi = mag * sinf(e * AIDT[sidx]);
        unsigned w[8];
#pragma unroll
        for (int q = 0; q < 8; ++q) {
          const float br0 = BBRE[sidx * 16 + 2 * q], bi0 = BBIM[sidx * 16 + 2 * q], br1 = BBRE[sidx * 16 + 2 * q + 1], bi1 = BBIM[sidx * 16 + 2 * q + 1];
          const float v0 = ri == 0 ? pr * br0 - pi * bi0 : pr * bi0 + pi * br0, v1 = ri == 0 ? pr * br1 - pi * bi1 : pr * bi1 + pi * br1;
          w[q] = pg8::cvt_pk_bf16(v0, v1);
        }
        u32x4* dst = (u32x4*)(BTS + ((size_t)g * 256 + r) * 512 + i * 16);
        dst[0] = (u32x4){w[0], w[1], w[2], w[3]}; dst[1] = (u32x4){w[4], w[5], w[6], w[7]};
      }
    }
    {
      float* KT = (float*)WSP(WS_KT); const float* c_re = INP(20); const float* c_im = INP(21);
      for (int it = gtid; it < 2 * 32 * 32 * 16; it += gsz) {
        const int pp = it & 15, m = (it >> 4) & 31, dg = it >> 9;
        float acc[16];
#pragma unroll
        for (int q = 0; q < 16; ++q) acc[q] = 0.f;
        for (int n = 0; n < 64; ++n) {
          const int sidx = dg * 64 + n;
          const float mag = expf((float)m * ARDT[sidx]), pr = mag * cosf((float)m * AIDT[sidx]), pi = mag * sinf((float)m * AIDT[sidx]);
          const float cr = c_re[(dg * 16 + pp) * 64 + n], ci = c_im[(dg * 16 + pp) * 64 + n];
          const float wr_ = cr * pr - ci * pi, wi_ = cr * pi + ci * pr;
#pragma unroll
          for (int q = 0; q < 16; ++q) acc[q] += wr_ * BBRE[sidx * 16 + q] - wi_ * BBIM[sidx * 16 + q];
        }
#pragma unroll
        for (int q = 0; q < 16; ++q) KT[((size_t)dg * 32 + m) * 256 + pp * 16 + q] = acc[q];
      }
    }
  }
  grid.sync();

  {
    pg8::Gemm g{(const bf16_t*)WSP(WS_XN), (const bf16_t*)WSP(WS_WIN), MX + MC, N_IN, D, D, D};
    InProjSched S; S.init((int)gridDim.x, (int)blockIdx.x);
    EpiInProj E{(bf16_t*)WSP(WS_Q), (bf16_t*)WSP(WS_K), (bf16_t*)WSP(WS_V), (bf16_t*)WSP(WS_SA), (bf16_t*)WSP(WS_G), (const float*)WSP(WS_ROPE)};
    pg8::gemm_phase<EpiInProj, InProjSched, true, true>((PG8_LAS unsigned char*)lds, g, S, E);
  }
  grid.sync();

  {
    const float lam = ((const float*)WSP(WS_LAM))[0];
    const bf16_t* Qb = (const bf16_t*)WSP(WS_Q); const bf16_t* Kb = (const bf16_t*)WSP(WS_K); const bf16_t* Vb = (const bf16_t*)WSP(WS_V);
    bf16_t* ATT = (bf16_t*)WSP(WS_ATT); const float* subln = INP(13);
    for (int unit = blockIdx.x; unit < Bn * 8 * (L / 128); unit += gridDim.x) {
      const int h = unit & 7, qb = (unit >> 3) & 31, b = unit >> 8;
      const size_t qoff = ((size_t)(b * L + qb * 128)) * 1024 + h * 128, koff = (size_t)b * LA * 1024 + h * 128;
      att::diff_attn_unit(Qb + qoff, Kb + koff, Vb + koff, ATT + qoff, LA, lam, subln, (char*)lds);
    }
  }
  grid.sync();

  {
    const bool gemm_blk = (blockIdx.x < 96) || (gridDim.x <= 96);
    if (gemm_blk) {
      pg8::Gemm g{(const bf16_t*)WSP(WS_SA), (const bf16_t*)WSP(WS_BTS), 0, 0, 512, SA_LD, 512};
      GroupSched S; S.init(32, 3, 1, (long)SA_ROWS * SA_LD * 2, (long)256 * SA_LD * 2, (long)256 * 512 * 2, 0, (int)(gridDim.x <= 96 ? gridDim.x : 96), (int)blockIdx.x);
      EpiS E{(float*)WSP(WS_S)};
      pg8::gemm_phase<EpiS, GroupSched, true, true>((PG8_LAS unsigned char*)lds, g, S, E);
    }
    if (!gemm_blk || gridDim.x <= 96) {
      PHASE_LOCALS
      const int wb = gridDim.x <= 96 ? (int)blockIdx.x : (int)blockIdx.x - 96, nwb = gridDim.x <= 96 ? (int)gridDim.x : (int)gridDim.x - 96;
      const float* KT = (const float*)WSP(WS_KT); const float* ARDT = (const float*)WSP(WS_ARDT); const float* AIDT = (const float*)WSP(WS_AIDT);
      const float* c_re = INP(20); const float* c_im = INP(21); const float* dsk = INP(22); bf16_t* BTY = (bf16_t*)WSP(WS_BTY);
      for (int it = wb * NT + tid; it < 32 * 512 * 96; it += nwb * NT) {
        const int cgp = it % 96, row = (it / 96) & 511, g = it / (96 * 512);
        const int j = row >> 4, pp = row & 15, col0 = cgp * 8;
        float v[8];
        if (col0 < 512) {
          const int i = col0 >> 4, q0 = col0 & 15;
#pragma unroll
          for (int e = 0; e < 8; ++e) v[e] = 0.f;
          if (i <= j) { const float* kp = KT + ((size_t)(0 * 32 + g) * 32 + (j - i)) * 256 + pp * 16 + q0;
#pragma unroll
            for (int e = 0; e < 8; ++e) v[e] += kp[e]; }
          if (i >= j) { const float* kp = KT + ((size_t)(1 * 32 + g) * 32 + (i - j)) * 256 + pp * 16 + q0;
#pragma unroll
            for (int e = 0; e < 8; ++e) v[e] += kp[e]; }
          if (i == j && pp >= q0 && pp < q0 + 8) {
#pragma unroll
            for (int e = 0; e < 8; ++e) if (q0 + e == pp) v[e] += dsk[g * 16 + pp];
          }
        } else {
          const int cc0 = col0 - 512, d = cc0 >> 7, n0 = (cc0 & 127) >> 1;
          const float ex = (float)(d == 0 ? j + 1 : 32 - j);
#pragma unroll
          for (int q = 0; q < 4; ++q) {
            const int n = n0 + q, sidx = (d * 32 + g) * 64 + n;
            const float mag = expf(ex * ARDT[sidx]), pr = mag * cosf(ex * AIDT[sidx]), pi = mag * sinf(ex * AIDT[sidx]);
            const float cr = c_re[((d * 32 + g) * 16 + pp) * 64 + n], ci = c_im[((d * 32 + g) * 16 + pp) * 64 + n];
            v[2 * q] = cr * pr - ci * pi; v[2 * q + 1] = -(cr * pi + ci * pr);
          }
        }
        u32x4 w; w.x = pg8::cvt_pk_bf16(v[0], v[1]); w.y = pg8::cvt_pk_bf16(v[2], v[3]); w.z = pg8::cvt_pk_bf16(v[4], v[5]); w.w = pg8::cvt_pk_bf16(v[6], v[7]);
        *(u32x4*)(BTY + ((size_t)g * 512 + row) * 768 + col0) = w;
      }
    }
  }
  grid.sync();

  {
    PHASE_LOCALS
    const float* ARDT = (const float*)WSP(WS_ARDT); const float* AIDT = (const float*)WSP(WS_AIDT);
    if (wid == 0) {
      for (int it = blockIdx.x; it < Bn * 32 * 2; it += gridDim.x) {
        const int d = it & 1, g = (it >> 1) & 31, b = it >> 6;
        const int sidx = (d * 32 + g) * 64 + lane;
        const float mag = expf(32.f * ARDT[sidx]), pr = mag * cosf(32.f * AIDT[sidx]), pi = mag * sinf(32.f * AIDT[sidx]);
        typedef float f32x2_ __attribute__((ext_vector_type(2)));
        const f32x2_* Sg = (const f32x2_*)((const float*)WSP(WS_S) + (size_t)g * SA_ROWS * 256) + d * 64 + lane;
        bf16_t* SAg = (bf16_t*)WSP(WS_SA) + (size_t)g * SA_ROWS * SA_LD + 512 + d * 128 + lane * 2;
        float hr = 0.f, hi = 0.f;
        f32x2_ sc[8];
#pragma unroll
        for (int k = 0; k < 8; ++k) { const int cc = d == 0 ? k : 7 - k; sc[k] = Sg[(size_t)(512 + b * 8 + cc) * 128]; }
#pragma unroll
        for (int k = 0; k < 8; ++k) { const float nr = pr * hr - pi * hi + sc[k][0], ni = pr * hi + pi * hr + sc[k][1]; hr = nr; hi = ni; }
        for (int k0 = 0; k0 < 128; k0 += 16) {
          f32x2_ sv[16];
#pragma unroll
          for (int k = 0; k < 16; ++k) { const int cx = d == 0 ? k0 + k : 127 - (k0 + k); sv[k] = Sg[(size_t)(b * 128 + cx) * 128]; }
#pragma unroll
          for (int k = 0; k < 16; ++k) {
            const int cx = d == 0 ? k0 + k : 127 - (k0 + k);
            *(unsigned*)(SAg + (size_t)(b * 128 + cx) * SA_LD) = pg8::cvt_pk_bf16(hr, hi);
            const float nr = pr * hr - pi * hi + sv[k][0], ni = pr * hi + pi * hr + sv[k][1]; hr = nr; hi = ni;
          }
        }
      }
    }
  }
  grid.sync();

  {
    pg8::Gemm g{(const bf16_t*)WSP(WS_SA), (const bf16_t*)WSP(WS_BTY), 0, 0, 768, SA_LD, 768};
    GroupSched S; S.init(32, 2, 2, (long)SA_ROWS * SA_LD * 2, (long)256 * SA_LD * 2, (long)512 * 768 * 2, (long)256 * 768 * 2, (int)gridDim.x, (int)blockIdx.x);
    EpiY E{(bf16_t*)WSP(WS_YG)};
    pg8::gemm_phase<EpiY, GroupSched, true, true>((PG8_LAS unsigned char*)lds, g, S, E);
  }
  grid.sync();

  {
    pg8::Gemm g{(const bf16_t*)WSP(WS_YG), (const bf16_t*)WSP(WS_WGLU), MX, 512, 512, 512, 512};
    pg8::StaticOrder S; S.init(MX, 512, (int)gridDim.x, (int)blockIdx.x, g.lda, g.ldb);
    EpiBf8<0> E{(bf16_t*)WSP(WS_SSMX), 512, (const bf16_t*)WSP(WS_YG), 512, INP(24)};
    pg8::gemm_phase<EpiBf8<0>, pg8::StaticOrder, true, true>((PG8_LAS unsigned char*)lds, g, S, E);
  }
  grid.sync();

  {
    pg8::Gemm g{(const bf16_t*)WSP(WS_ATT), (const bf16_t*)WSP(WS_WAU), MX, 1024, 1024, 1024, 1024};
    pg8::StaticOrder S; S.init(MX, 1024, (int)gridDim.x, (int)blockIdx.x, g.lda, g.ldb);
    EpiBf8<1> E{(bf16_t*)WSP(WS_M), 1024, (const bf16_t*)WSP(WS_G), 2048, nullptr};
    pg8::gemm_phase<EpiBf8<1>, pg8::StaticOrder, true, true>((PG8_LAS unsigned char*)lds, g, S, E);
  }
  grid.sync();
  {
    pg8::Gemm g{(const bf16_t*)WSP(WS_SSMX), (const bf16_t*)WSP(WS_WSU), MX, 1024, 512, 512, 512};
    pg8::StaticOrder S; S.init(MX, 1024, (int)gridDim.x, (int)blockIdx.x, g.lda, g.ldb);
    EpiBf8<2> E{(bf16_t*)WSP(WS_M), 1024, (const bf16_t*)WSP(WS_G) + 1024, 2048, nullptr};
    pg8::gemm_phase<EpiBf8<2>, pg8::StaticOrder, true, true>((PG8_LAS unsigned char*)lds, g, S, E);
  }
  grid.sync();
  {
    pg8::Gemm g{(const bf16_t*)WSP(WS_M), (const bf16_t*)WSP(WS_WOUT), MX, 1024, 1024, 1024, 1024};
    pg8::StaticOrder S; S.init(MX, 1024, (int)gridDim.x, (int)blockIdx.x, g.lda, g.ldb);
    EpiF32<1> E{(float*)WSP(WS_X1), INP(0), (const float*)WSP(WS_MOD)};
    pg8::gemm_phase<EpiF32<1>, pg8::StaticOrder, true, true>((PG8_LAS unsigned char*)lds, g, S, E);
  }
  grid.sync();
  {
    PHASE_LOCALS
    const float* X1 = (const float*)WSP(WS_X1); const float* MOD = (const float*)WSP(WS_MOD); bf16_t* XN2 = (bf16_t*)WSP(WS_XN2); const float* norm2_g = INP(7);
    for (int row = gw; row < MX; row += ngw) {
      const float* src = X1 + (size_t)row * D; const float* md = MOD + (row / L) * 6144;
      f32x4 v[4]; float ss = 0.f;
#pragma unroll
      for (int j = 0; j < 4; ++j) { v[j] = *(const f32x4*)(src + lane * 4 + 256 * j); ss += v[j][0] * v[j][0] + v[j][1] * v[j][1] + v[j][2] * v[j][2] + v[j][3] * v[j][3]; }
      const float rstd = rsqrtf(wave_sum(ss) * (1.f / D) + 1e-6f);
#pragma unroll
      for (int j = 0; j < 4; ++j)
#pragma unroll
        for (int e = 0; e < 4; ++e) { const int col = lane * 4 + 256 * j + e; XN2[(size_t)row * D + col] = f2bf(v[j][e] * rstd * norm2_g[col] * (1.f + md[4096 + col]) + md[3072 + col]); }
    }
    slice_table(INP(30), (bf16_t*)WSP(WS_U8), gtid, gsz);
    {
      const float* wq = INP(27); const float* sk1 = INP(28); const float* sk2 = INP(29); bf16_t* WC = (bf16_t*)WSP(WS_WC);
      for (int it = gtid; it < 2048 * 128; it += gsz) {
        const int d0 = (it & 127) * 8, n = it >> 7, k = n & 127, s = (n >> 7) & 1, h = n >> 8;
        const float* skr = (s ? sk2 : sk1) + k * 64; const float* wr0 = wq + (size_t)d0 * 1024 + h * 128 + s * 64;
        float a[8];
#pragma unroll
        for (int q = 0; q < 8; ++q) a[q] = 0.f;
        for (int e4 = 0; e4 < 64; e4 += 4) {
          const f32x4 sv = *(const f32x4*)(skr + e4);
#pragma unroll
          for (int q = 0; q < 8; ++q) { const f32x4 wv = *(const f32x4*)(wr0 + (size_t)q * 1024 + e4); a[q] += sv[0] * wv[0] + sv[1] * wv[1] + sv[2] * wv[2] + sv[3] * wv[3]; }
        }
        u32x4 w; w.x = pg8::cvt_pk_bf16(a[0], a[1]); w.y = pg8::cvt_pk_bf16(a[2], a[3]); w.z = pg8::cvt_pk_bf16(a[4], a[5]); w.w = pg8::cvt_pk_bf16(a[6], a[7]);
        *(u32x4*)(WC + (size_t)n * 1024 + d0) = w;
      }
    }
  }
  grid.sync();
  {
    pg8::Gemm g{(const bf16_t*)WSP(WS_XN2), (const bf16_t*)WSP(WS_WC), MX, 2048, 1024, 1024, 1024};
    EpiTopK E{(unsigned short*)WSP(WS_IDX), (float*)WSP(WS_GATE)};
    const int nrounds = (64 * 8 + (int)gridDim.x - 1) / (int)gridDim.x;
    for (int rd = 0; rd < nrounds; ++rd) {
      OneUnitSched S; S.nM = 64; S.nN = 8; S.G = (int)gridDim.x; S.c = (int)blockIdx.x; S.round = rd; S.tsA = (long)256 * 1024 * 2; S.tsB = (long)256 * 1024 * 2;
      pg8::gemm_phase<EpiTopK, OneUnitSched, false, true>((PG8_LAS unsigned char*)lds, g, S, E);
    }
  }
  grid.sync();
  {
    PHASE_LOCALS
    const bf16_t* XN2 = (const bf16_t*)WSP(WS_XN2); const unsigned short* IDX = (const unsigned short*)WSP(WS_IDX);
    bf16_t* PD = (bf16_t*)WSP(WS_PD);
    const bool sl = (gridDim.x & 7) == 0;
    const int j0 = sl ? (int)(blockIdx.x & 7) : 0, nj = sl ? 1 : 8;
    const int wk = sl ? (int)(blockIdx.x >> 3) * 8 + wid : gw, nwk = sl ? (int)(gridDim.x >> 3) * 8 : ngw;
    const int lg = lane >> 4, li = lane & 15;
    for (int jj = 0; jj < nj; ++jj) {
      const int j = j0 + jj;
      const bf16_t* U8j = (const bf16_t*)WSP(WS_U8) + (size_t)j * 16384 * 128 + li * 8;
      for (int t = wk; t < MX; t += nwk) {
        const u32x4 xw = *(const u32x4*)(XN2 + (size_t)t * 1024 + j * 128 + li * 8);
        const float x0 = bflo(xw.x), x1 = bfhi(xw.x), x2 = bflo(xw.y), x3 = bfhi(xw.y), x4 = bflo(xw.z), x5 = bfhi(xw.z), x6 = bflo(xw.w), x7 = bfhi(xw.w);
        const int i_lo = IDX[(size_t)t * 128 + lane], i_hi = IDX[(size_t)t * 128 + 64 + lane];
        float keep_lo = 0.f, keep_hi = 0.f;
#pragma unroll
        for (int itb = 0; itb < 32; itb += 8) {
          u32x4 uw[8];
#pragma unroll
          for (int k = 0; k < 8; ++k) {
            const int s = (itb + k) * 4 + lg;
            const int ex = itb < 16 ? __shfl(i_lo, s) : __shfl(i_hi, s - 64);
            uw[k] = *(const u32x4*)(U8j + (size_t)ex * 128);
          }
#pragma unroll
          for (int k = 0; k < 8; ++k) {
            float dp = bflo(uw[k].x) * x0 + bfhi(uw[k].x) * x1 + bflo(uw[k].y) * x2 + bfhi(uw[k].y) * x3 + bflo(uw[k].z) * x4 + bfhi(uw[k].z) * x5 + bflo(uw[k].w) * x6 + bfhi(uw[k].w) * x7;
            dp += __shfl_xor(dp, 1); dp += __shfl_xor(dp, 2); dp += __shfl_xor(dp, 4); dp += __shfl_xor(dp, 8);
            const int it = itb + k;
            if (li == (it & 15)) { if (itb < 16) keep_lo = dp; else keep_hi = dp; }
          }
        }
        bf16_t* pd = PD + ((size_t)t * 8 + j) * 128 + 4 * li + lg;
        pd[0] = f2bf(keep_lo); pd[64] = f2bf(keep_hi);
      }
    }
    slice_table(INP(31), (bf16_t*)WSP(WS_V8), gtid, gsz);
  }
  grid.sync();
  {
    PHASE_LOCALS
    const float* X1 = (const float*)WSP(WS_X1); const float* MOD = (const float*)WSP(WS_MOD);
    const unsigned short* IDX = (const unsigned short*)WSP(WS_IDX); const float* GATE = (const float*)WSP(WS_GATE);
    const bf16_t* PD = (const bf16_t*)WSP(WS_PD); float* SSQ = (float*)WSP(WS_SSQ); float* out = (float*)ldptr_(33);
    const bool sl = (gridDim.x & 7) == 0;
    const int j0 = sl ? (int)(blockIdx.x & 7) : 0, nj = sl ? 1 : 8;
    const int wk = sl ? (int)(blockIdx.x >> 3) * 8 + wid : gw, nwk = sl ? (int)(gridDim.x >> 3) * 8 : ngw;
    const int lg = lane >> 4, li = lane & 15;
    for (int jj = 0; jj < nj; ++jj) {
      const int j = j0 + jj;
      const bf16_t* V8j = (const bf16_t*)WSP(WS_V8) + (size_t)j * 16384 * 128 + li * 8;
      for (int t = wk; t < MX; t += nwk) {
        const int i_lo = IDX[(size_t)t * 128 + lane], i_hi = IDX[(size_t)t * 128 + 64 + lane];
        float p_lo = 0.f, p_hi = 0.f;
#pragma unroll
        for (int q = 0; q < 8; ++q) { p_lo += bf2f(PD[((size_t)t * 8 + q) * 128 + lane]); p_hi += bf2f(PD[((size_t)t * 8 + q) * 128 + 64 + lane]); }
        const float c_lo = GATE[(size_t)t * 128 + lane] * gelu_tanh(p_lo), c_hi = GATE[(size_t)t * 128 + 64 + lane] * gelu_tanh(p_hi);
        float acc[8];
#pragma unroll
        for (int i = 0; i < 8; ++i) acc[i] = 0.f;
#pragma unroll
        for (int itb = 0; itb < 32; itb += 8) {
          u32x4 vw[8]; float cf[8];
#pragma unroll
          for (int k = 0; k < 8; ++k) {
            const int s = (itb + k) * 4 + lg;
            const int ex = itb < 16 ? __shfl(i_lo, s) : __shfl(i_hi, s - 64);
            cf[k] = itb < 16 ? __shfl(c_lo, s) : __shfl(c_hi, s - 64);
            vw[k] = *(const u32x4*)(V8j + (size_t)ex * 128);
          }
#pragma unroll
          for (int k = 0; k < 8; ++k) {
            acc[0] += cf[k] * bflo(vw[k].x); acc[1] += cf[k] * bfhi(vw[k].x); acc[2] += cf[k] * bflo(vw[k].y); acc[3] += cf[k] * bfhi(vw[k].y);
            acc[4] += cf[k] * bflo(vw[k].z); acc[5] += cf[k] * bfhi(vw[k].z); acc[6] += cf[k] * bflo(vw[k].w); acc[7] += cf[k] * bfhi(vw[k].w);
          }
        }
#pragma unroll
        for (int i = 0; i < 8; ++i) { acc[i] += __shfl_xor(acc[i], 16); acc[i] += __shfl_xor(acc[i], 32); }
        const int col = j * 128 + li * 8;
        const float* md = MOD + (t >> 12) * 6144 + 5120 + col;
        const f32x4 xa = *(const f32x4*)(X1 + (size_t)t * 1024 + col), xb = *(const f32x4*)(X1 + (size_t)t * 1024 + col + 4);
        const f32x4 ga = *(const f32x4*)md, gb = *(const f32x4*)(md + 4);
        f32x4 oa, ob; float ss = 0.f;
#pragma unroll
        for (int i = 0; i < 4; ++i) { oa[i] = xa[i] + ga[i] * acc[i]; ob[i] = xb[i] + gb[i] * acc[4 + i]; ss += oa[i] * oa[i] + ob[i] * ob[i]; }
        ss += __shfl_xor(ss, 1); ss += __shfl_xor(ss, 2); ss += __shfl_xor(ss, 4); ss += __shfl_xor(ss, 8);
        if (lg == 0) { *(f32x4*)(out + (size_t)t * 1024 + col) = oa; *(f32x4*)(out + (size_t)t * 1024 + col + 4) = ob; }
        if (lane == 0) SSQ[(size_t)t * 8 + j] = ss;
      }
    }
  }
  grid.sync();
  {
    PHASE_LOCALS
    const float* SSQ = (const float*)WSP(WS_SSQ); const float* fng = INP(32); float* out = (float*)ldptr_(33);
    for (int row = gw; row < MX; row += ngw) {
      const f32x4 sa = *(const f32x4*)(SSQ + (size_t)row * 8), sb = *(const f32x4*)(SSQ + (size_t)row * 8 + 4);
      const float rstd = rsqrtf(((sa[0] + sa[1]) + (sa[2] + sa[3]) + (sb[0] + sb[1]) + (sb[2] + sb[3])) * (1.f / D) + 1e-6f);
#pragma unroll
      for (int jq = 0; jq < 4; ++jq) {
        float* op = out + (size_t)row * D + lane * 4 + 256 * jq;
        const f32x4 v = *(const f32x4*)op, g4 = *(const f32x4*)(fng + lane * 4 + 256 * jq);
        *(f32x4*)op = v * rstd * g4;
      }
    }
  }
}

extern "C" void kernel_launch(void* const* d_in, const int* in_sizes, int n_in, void* d_out, int out_size, void* d_ws, size_t ws_size, hipStream_t stream) {
  static int grid_blocks = 0;
  if (!grid_blocks) {
    int dev = 0, cus = 0, per_cu = 0;
    (void)hipGetDevice(&dev);
    (void)hipDeviceGetAttribute(&cus, hipDeviceAttributeMultiprocessorCount, dev);
    (void)hipFuncSetAttribute((const void*)mega, hipFuncAttributeMaxDynamicSharedMemorySize, LDS_BYTES);
    (void)hipOccupancyMaxActiveBlocksPerMultiprocessor(&per_cu, (const void*)mega, NT, LDS_BYTES);
    if (per_cu < 1) per_cu = 1;
    grid_blocks = cus * per_cu;
    if (n_in != 33 || ws_size < 255 * MiB) { fprintf(stderr, "kernel_launch: unexpected n_in %d / ws %zu\n", n_in, ws_size); }
  }
  Params p{};
  for (int i = 0; i < 33 && i < n_in; ++i) p.in[i] = (const float*)d_in[i];
  p.out = (float*)d_out; p.ws = (unsigned char*)d_ws;
  void* args[] = {&p};
  hipError_t e = hipLaunchCooperativeKernel((const void*)mega, dim3(grid_blocks), dim3(NT), args, LDS_BYTES, stream);
  if (e != hipSuccess) fprintf(stderr, "cooperative launch failed: %s (grid %d)\n", hipGetErrorString(e), grid_blocks);
}
```

```cpp
#include <hip/hip_runtime.h>
#include <hip/hip_cooperative_groups.h>
#include <cstdio>
#include <cstdint>
namespace cg = cooperative_groups;

typedef unsigned short bf16_t;
typedef float f32x4 __attribute__((ext_vector_type(4)));

constexpr int NT = 512;
constexpr int LDS_BYTES = 147456;
constexpr int Bn = 4, L = 4096, D = 1024, NCTX = 256, LA = L + NCTX;
constexpr int MX = Bn * L, MC = Bn * NCTX;
constexpr int N_IN = 5632;
constexpr size_t MiB = 1u << 20;
constexpr size_t WS_MOD = 0, WS_LAM = 128 * 1024, WS_ROPE = 136 * 1024, WS_ARDT = 144 * 1024, WS_AIDT = 160 * 1024;
constexpr size_t WS_ABRE = 192 * 1024, WS_ABIM = 224 * 1024, WS_BBRE = 256 * 1024, WS_BBIM = 512 * 1024;
constexpr size_t WS_KT = 2 * MiB;
constexpr size_t WS_XN = 4 * MiB, WS_Q = 38 * MiB, WS_K = 70 * MiB, WS_V = 104 * MiB, WS_SA = 138 * MiB, WS_G = 164 * MiB;
constexpr size_t WS_WIN = 228 * MiB, WS_WAU = 239 * MiB, WS_WSU = 241 * MiB, WS_WOUT = 242 * MiB, WS_WQ = 244 * MiB, WS_WGLU = 246 * MiB;
constexpr size_t WS_BTS = 247 * MiB;
constexpr size_t WS_BTY = 38 * MiB, WS_S = 62 * MiB, WS_YG = 79 * MiB, WS_SSMX = 95 * MiB, WS_M = 111 * MiB;
constexpr size_t WS_ATT = WS_XN, WS_X1 = 38 * MiB, WS_XN2 = WS_XN, WS_QP = WS_G;
constexpr size_t WS_IDX = 111 * MiB, WS_GATE = 115 * MiB, WS_SSQ = 123 * MiB;
constexpr size_t WS_U8 = 127 * MiB, WS_PD = 164 * MiB, WS_V8 = 196 * MiB, WS_WC = 160 * MiB;
constexpr int SA_ROWS = 544, SA_LD = 768;

constexpr int PTR_OFF = LDS_BYTES - 1024;
__device__ __forceinline__ unsigned long long ldptr_(int k) {
  extern __shared__ __attribute__((aligned(16))) unsigned char lds_[];
  const unsigned long long v = ((const unsigned long long*)(lds_ + PTR_OFF))[k];
  const unsigned lo = __builtin_amdgcn_readfirstlane((unsigned)v), hi = __builtin_amdgcn_readfirstlane((unsigned)(v >> 32));
  return ((unsigned long long)hi << 32) | lo;
}
#define GPTR(T, v) ((T*)(__attribute__((address_space(1))) T*)(v))
#define INP(k) GPTR(const float, ldptr_(k))
#define WSP(off) GPTR(unsigned char, ldptr_(34) + (off))
#define PHASE_LOCALS \
  int tid = threadIdx.x; asm volatile("" : "+v"(tid)); \
  const int lane = tid & 63, wid = tid >> 6; \
  const int gtid = blockIdx.x * NT + tid, gsz = gridDim.x * NT; \
  const int gw = blockIdx.x * (NT / 64) + wid, ngw = gridDim.x * (NT / 64); \
  float* fl = (float*)lds; (void)lane; (void)wid; (void)gtid; (void)gsz; (void)gw; (void)ngw; (void)fl;

struct Params {
  const float* in[33];
  float* out;
  unsigned char* ws;
  int pad0, pad1;
};

__device__ __forceinline__ float bf2f(bf16_t v) { return __uint_as_float(((unsigned)v) << 16); }
__device__ __forceinline__ bf16_t f2bf(float f) { unsigned u = __float_as_uint(f); return (bf16_t)((u + 0x7fffu + ((u >> 16) & 1u)) >> 16); }
__device__ __forceinline__ float wave_sum(float v) {
#pragma unroll
  for (int o = 32; o; o >>= 1) v += __shfl_xor(v, o);
  return v;
}
__device__ __forceinline__ float gelu_tanh(float x) { return 0.5f * x * (1.f + tanhf(0.7978845608028654f * (x + 0.044715f * x * x * x))); }
__device__ __forceinline__ float sigmoidf_(float x) { return 1.f / (1.f + __expf(-x)); }
__device__ __forceinline__ float siluf_(float x) { return x / (1.f + __expf(-x)); }

template <class Epi>
__device__ __forceinline__ void sgemm(const bf16_t* A, int lda, const float* Bm, int ldb, int M, int N, int K, float* lds, Epi epi) {
  constexpr int TM = 128, TN = 128, TK = 16, LDA_S = TM + 4, LDB_S = TN + 4;
  float* As = lds;
  float* Bs = lds + TK * LDA_S;
  const int tid = threadIdx.x, ty = tid >> 4, tx = tid & 15;
  const int ntm = M / TM, ntn = N / TN;
  for (int tile = blockIdx.x; tile < ntm * ntn; tile += gridDim.x) {
    const int tm = tile / ntn, tn = tile % ntn;
    float acc[4][8];
#pragma unroll
    for (int i = 0; i < 4; ++i)
#pragma unroll
      for (int j = 0; j < 8; ++j) acc[i][j] = 0.f;
    const int ar = tid >> 2, ak = (tid & 3) * 4;
    const int bk = tid >> 5, bn = (tid & 31) * 4;
    for (int k0 = 0; k0 < K; k0 += TK) {
      const bf16_t* ap = A + (size_t)(tm * TM + ar) * lda + k0 + ak;
      const unsigned long long av = *(const unsigned long long*)ap;
      const f32x4 bv = *(const f32x4*)(Bm + (size_t)(k0 + bk) * ldb + tn * TN + bn);
      __syncthreads();
      As[(ak + 0) * LDA_S + ar] = bf2f((bf16_t)(av & 0xffff));
      As[(ak + 1) * LDA_S + ar] = bf2f((bf16_t)((av >> 16) & 0xffff));
      As[(ak + 2) * LDA_S + ar] = bf2f((bf16_t)((av >> 32) & 0xffff));
      As[(ak + 3) * LDA_S + ar] = bf2f((bf16_t)((av >> 48) & 0xffff));
      *(f32x4*)(Bs + bk * LDB_S + bn) = bv;
      __syncthreads();
#pragma unroll
      for (int k = 0; k < TK; ++k) {
        const f32x4 a4 = *(const f32x4*)(As + k * LDA_S + ty * 4);
        const f32x4 b0 = *(const f32x4*)(Bs + k * LDB_S + tx * 8);
        const f32x4 b1 = *(const f32x4*)(Bs + k * LDB_S + tx * 8 + 4);
#pragma unroll
        for (int i = 0; i < 4; ++i) {
          acc[i][0] += a4[i] * b0[0]; acc[i][1] += a4[i] * b0[1]; acc[i][2] += a4[i] * b0[2]; acc[i][3] += a4[i] * b0[3];
          acc[i][4] += a4[i] * b1[0]; acc[i][5] += a4[i] * b1[1]; acc[i][6] += a4[i] * b1[2]; acc[i][7] += a4[i] * b1[3];
        }
      }
    }
#pragma unroll
    for (int i = 0; i < 4; ++i)
#pragma unroll
      for (int j = 0; j < 8; ++j) epi(tm * TM + ty * 4 + i, tn * TN + tx * 8 + j, acc[i][j]);
  }
  __syncthreads();
}

namespace pg8 {
#define PG8_LAS __attribute__((address_space(3)))
typedef unsigned short bf16_t;
typedef short bf16x8 __attribute__((ext_vector_type(8)));
typedef float f32x4 __attribute__((ext_vector_type(4)));
typedef unsigned u32x4 __attribute__((ext_vector_type(4)));
constexpr int BM = 256, BK = 64, HALF = 128, HTB = HALF * BK * 2  , STAGE_BYTES = 8 * HTB, NXCD = 8, WGM = 8;

__host__ __device__ __forceinline__ int lds_byte(int r, int c) { const int st = (r >> 4) * 2 + (c >> 5), rr = r & 15, cc = c & 31, ob = rr * 64 + cc * 2; return st * 1024 + (ob ^ (((ob >> 9) & 1) << 5)); }
__host__ __device__ __forceinline__ void stage_rc(int b, int& R, int& C) { const int st = b / 1024, sb = b % 1024, swz = sb ^ (((sb >> 9) & 1) << 5); R = (st >> 1) * 16 + swz / 64; C = (st & 1) * 32 + (swz % 64) / 2; }
__host__ __device__ __forceinline__ int perm32(int rho) { const int n = rho >> 4, i = rho & 15; return 8 * (i >> 2) + 4 * n + (i & 3); }

struct Unit { int pm, pn, grp; long ao, bo; };
struct Gemm { const bf16_t* A; const bf16_t* Bt; int M, N, K, lda, ldb; };

struct StaticOrder {
    int nM, nN, nwg, G, c; long tsA, tsB;
    __host__ __device__ void init(int M, int N, int G_, int c_, int lda, int ldb) { nM = M / BM; nN = N / BM; nwg = nM * nN; G = G_; c = c_; tsA = (long)BM * lda * 2; tsB = (long)BM * ldb * 2; }
    __host__ __device__ bool next(int i, Unit& u) const {
        const long L = (long)i * G + c; if (L >= nwg) return false;
        int wgid = (int)L; { const int q = nwg / NXCD, r = nwg % NXCD, xcd = wgid % NXCD, off = wgid / NXCD; wgid = (xcd < r ? xcd * (q + 1) : r * (q + 1) + (xcd - r) * q) + off; }
        const int nig = WGM * nN, gid = wgid / nig, fm = gid * WGM, gsz = (nM - fm) < WGM ? (nM - fm) : WGM;
        u.pm = fm + ((wgid % nig) % gsz); u.pn = (wgid % nig) / gsz; u.grp = 0; u.ao = u.pm * tsA; u.bo = u.pn * tsB; return true;
    }
    __device__ __forceinline__ void a_ready(const Unit&) const {}
    __device__ __forceinline__ void done(const Unit&) const {}
};

__device__ __forceinline__ unsigned cvt_pk_bf16(float lo, float hi) { unsigned r; asm volatile("v_cvt_pk_bf16_f32 %0, %1, %2" : "=v"(r) : "v"(lo), "v"(hi)); return r; }
template <class Epi, class Sched, bool ALIGN_EPI = false, bool SP2 = false>
__device__ __forceinline__ void gemm_phase(PG8_LAS unsigned char* lds, const Gemm g, const Sched& S, const Epi& E) {
    int tid_ = threadIdx.x; asm volatile("" : "+v"(tid_));
    const int tid = tid_, wid = __builtin_amdgcn_readfirstlane(tid >> 6), lane = tid & 63, wr = wid >> 2, wc = wid & 3, fr = lane & 15, fq = lane >> 4;
    const int K = g.K, nt = K / BK;
    unsigned voffA[2], voffB[2];
#pragma unroll
    for (int i = 0; i < 2; ++i) { int R, C; stage_rc(tid * 16 + i * 8192, R, C); const int Rb = Epi::PERM ? ((R & ~31) + perm32(R & 31)) : R;
        voffA[i] = (unsigned)(R * g.lda + C) * 2u; voffB[i] = (unsigned)(Rb * g.ldb + C) * 2u; }
    const size_t kstep = (size_t)(BK * 2);
    const size_t hstepA = (size_t)HALF * g.lda * 2, hstepB = (size_t)HALF * g.ldb * 2;
    const unsigned ldsw = (unsigned)wid * 1024u;
    const int aoff = lds_byte(wr * 64 + fr, fq * 8), boff = lds_byte(wc * 32 + fr, fq * 8);
#define PG8_SA(b, h) (((b) * 2 + (h)) * HTB)
#define PG8_SB(b, h) ((4 + (b) * 2 + (h)) * HTB)
#define PG8_STAGE(bufoff, gbase, voff) do { _Pragma("unroll") for (int _i = 0; _i < 2; ++_i) \
        __builtin_amdgcn_global_load_lds((const unsigned*)((const char*)(gbase) + (voff)[_i]), (PG8_LAS unsigned*)(lds + (bufoff) + ldsw + _i * 8192), 16, 0, 0); } while (0)
#define PG8_LDA(dst, b, h) do { _Pragma("unroll") for (int m = 0; m < 4; ++m) _Pragma("unroll") for (int k = 0; k < 2; ++k) dst[m][k] = *(const PG8_LAS bf16x8*)(lds + PG8_SA(b, h) + aoff + m * 2048 + k * 1024); } while (0)
#define PG8_LDB(dst, b, h) do { _Pragma("unroll") for (int n = 0; n < 2; ++n) _Pragma("unroll") for (int k = 0; k < 2; ++k) dst[n][k] = *(const PG8_LAS bf16x8*)(lds + PG8_SB(b, h) + boff + n * 2048 + k * 1024); } while (0)
#define PG8_MMA(ai, bj, At, Bt) do { __builtin_amdgcn_s_setprio(1); _Pragma("unroll") for (int m = 0; m < 4; ++m) _Pragma("unroll") for (int n = 0; n < 2; ++n) _Pragma("unroll") for (int k = 0; k < 2; ++k) \
        acc[ai][bj][m][n] = __builtin_amdgcn_mfma_f32_16x16x32_bf16(Bt[n][k], At[m][k], acc[ai][bj][m][n], 0, 0, 0); __builtin_amdgcn_s_setprio(0); } while (0)
#define PG8_WAIT_V(n) asm volatile("s_waitcnt vmcnt(" #n ")" ::: "memory")
#define PG8_WAIT_L(n) asm volatile("s_waitcnt lgkmcnt(" #n ")" ::: "memory")
#define PG8_BAR __builtin_amdgcn_s_barrier()
#define PG8_SCHED __builtin_amdgcn_sched_barrier(0)
    Unit cur, nxt; int ui = 0;
    if (!S.next(0, cur)) return;
    f32x4 acc[2][2][4][2];
#pragma unroll
    for (int a = 0; a < 2; ++a)
#pragma unroll
        for (int b = 0; b < 2; ++b)
#pragma unroll
            for (int m = 0; m < 4; ++m)
#pragma unroll
                for (int n = 0; n < 2; ++n) acc[a][b][m][n] = (f32x4){0.f, 0.f, 0.f, 0.f};
    bf16x8 At[4][2], B0[2][2], B1[2][2];
    const char* cA = (const char*)g.A + cur.ao; const char* cB = (const char*)g.Bt + cur.bo;
    S.a_ready(cur);
    if constexpr (SP2) {
        PG8_STAGE(PG8_SB(0, 0), cB, voffB); PG8_STAGE(PG8_SB(0, 1), cB + hstepB, voffB); PG8_STAGE(PG8_SA(0, 0), cA, voffA); PG8_STAGE(PG8_SA(0, 1), cA + hstepA, voffA);
        if (wr == 1) PG8_BAR;
        PG8_WAIT_V(2); PG8_BAR;
        PG8_STAGE(PG8_SB(1, 0), cB + kstep, voffB); PG8_STAGE(PG8_SA(1, 0), cA + kstep, voffA); PG8_STAGE(PG8_SB(1, 1), cB + hstepB + kstep, voffB);
        PG8_WAIT_V(6); PG8_BAR;
    } else {
        PG8_STAGE(PG8_SB(0, 0), cB, voffB); PG8_STAGE(PG8_SA(0, 0), cA, voffA); PG8_STAGE(PG8_SB(0, 1), cB + hstepB, voffB); PG8_STAGE(PG8_SA(0, 1), cA + hstepA, voffA);
        if (wr == 1) PG8_BAR;
        PG8_WAIT_V(4); PG8_BAR;
        PG8_STAGE(PG8_SB(1, 0), cB + kstep, voffB); PG8_STAGE(PG8_SA(1, 0), cA + kstep, voffA); PG8_STAGE(PG8_SB(1, 1), cB + hstepB + kstep, voffB);
        PG8_WAIT_V(6); PG8_BAR;
    }
    for (;;) {
        const bool has_next = S.next(ui + 1, nxt);
        const char* nA = has_next ? (const char*)g.A + nxt.ao : cA; const char* nB = has_next ? (const char*)g.Bt + nxt.bo : cB;
        for (int t = 0; t < nt; t += 2) {
            const bool last = (t == nt - 2);
            const char* a1 = cA + (size_t)(t + 1) * kstep;
            const char* a2 = last ? nA : cA + (size_t)(t + 2) * kstep; const char* b2 = last ? nB : cB + (size_t)(t + 2) * kstep;
            const char* a3 = a2 + kstep; const char* b3 = b2 + kstep;
            if (last && has_next) S.a_ready(nxt);
            if constexpr (SP2) {
            PG8_LDB(B0, 0, 0); PG8_LDB(B1, 0, 1); PG8_SCHED; PG8_LDA(At, 0, 0); PG8_STAGE(PG8_SA(1, 1), a1 + hstepA, voffA);
            PG8_WAIT_V(8); PG8_WAIT_L(0); PG8_BAR; PG8_MMA(0, 0, At, B0); PG8_MMA(0, 1, At, B1); PG8_BAR; PG8_SCHED;
            PG8_LDA(At, 0, 1); PG8_STAGE(PG8_SB(0, 0), b2, voffB); PG8_STAGE(PG8_SB(0, 1), b2 + hstepB, voffB); PG8_STAGE(PG8_SA(0, 0), a2, voffA);
            PG8_WAIT_V(8); PG8_WAIT_L(0); PG8_BAR; PG8_MMA(1, 0, At, B0); PG8_MMA(1, 1, At, B1); PG8_BAR; PG8_SCHED;
            PG8_LDB(B0, 1, 0); PG8_LDB(B1, 1, 1); PG8_SCHED; PG8_LDA(At, 1, 0); PG8_STAGE(PG8_SA(0, 1), a2 + hstepA, voffA);
            PG8_WAIT_V(8); PG8_WAIT_L(0); PG8_BAR; PG8_MMA(0, 0, At, B0); PG8_MMA(0, 1, At, B1); PG8_BAR; PG8_SCHED;
            PG8_LDA(At, 1, 1); PG8_STAGE(PG8_SB(1, 0), b3, voffB); PG8_STAGE(PG8_SB(1, 1), b3 + hstepB, voffB); PG8_STAGE(PG8_SA(1, 0), a3, voffA);
            PG8_WAIT_V(8); PG8_WAIT_L(0); PG8_BAR; PG8_MMA(1, 0, At, B0); PG8_MMA(1, 1, At, B1); PG8_BAR; PG8_SCHED;
            } else {
            PG8_LDB(B0, 0, 0); PG8_SCHED; PG8_LDA(At, 0, 0); PG8_STAGE(PG8_SA(1, 1), a1 + hstepA, voffA);
            PG8_WAIT_L(8); PG8_BAR; PG8_WAIT_L(0); PG8_MMA(0, 0, At, B0); PG8_BAR; PG8_SCHED;
            PG8_LDB(B1, 0, 1); PG8_STAGE(PG8_SB(0, 0), b2, voffB);
            PG8_BAR; PG8_WAIT_L(0); PG8_MMA(0, 1, At, B1); PG8_BAR;
            PG8_LDA(At, 0, 1); PG8_STAGE(PG8_SA(0, 0), a2, voffA);
            PG8_BAR; PG8_WAIT_L(0); PG8_MMA(1, 0, At, B0); PG8_BAR; PG8_SCHED;
            PG8_STAGE(PG8_SB(0, 1), b2 + hstepB, voffB);
            PG8_WAIT_V(6); PG8_BAR; PG8_MMA(1, 1, At, B1); PG8_BAR;
            PG8_LDB(B0, 1, 0); PG8_SCHED; PG8_LDA(At, 1, 0); PG8_STAGE(PG8_SA(0, 1), a2 + hstepA, voffA);
            PG8_WAIT_L(8); PG8_BAR; PG8_WAIT_L(0); PG8_MMA(0, 0, At, B0); PG8_BAR; PG8_SCHED;
            PG8_LDB(B1, 1, 1); PG8_STAGE(PG8_SB(1, 0), b3, voffB);
            PG8_BAR; PG8_WAIT_L(0); PG8_MMA(0, 1, At, B1); PG8_BAR;
            PG8_LDA(At, 1, 1); PG8_STAGE(PG8_SA(1, 0), a3, voffA);
            PG8_BAR; PG8_WAIT_L(0); PG8_MMA(1, 0, At, B0); PG8_BAR; PG8_SCHED;
            PG8_STAGE(PG8_SB(1, 1), b3 + hstepB, voffB);
            PG8_WAIT_V(6); PG8_BAR; PG8_MMA(1, 1, At, B1); PG8_BAR;
            }
        }
        if constexpr (ALIGN_EPI) { if (wr == 0) PG8_BAR; }
        if constexpr (!Epi::AFTER_DRAIN) { int fr_ = fr, fq_ = fq; asm volatile("" : "+v"(fr_), "+v"(fq_));
            E(acc, cur, wr, wc, fr_, fq_); S.done(cur); }
        if (!has_next) break;
#pragma unroll
        for (int a = 0; a < 2; ++a)
#pragma unroll
            for (int b = 0; b < 2; ++b)
#pragma unroll
                for (int m = 0; m < 4; ++m)
#pragma unroll
                    for (int n = 0; n < 2; ++n) acc[a][b][m][n] = (f32x4){0.f, 0.f, 0.f, 0.f};
        cur = nxt; cA = nA; cB = nB; ++ui;
        if constexpr (ALIGN_EPI) { if (wr == 1) PG8_BAR; }
    }
    PG8_WAIT_V(0);
    if constexpr (!ALIGN_EPI) { if (wr == 0) PG8_BAR; }
    PG8_BAR;
    if constexpr (Epi::AFTER_DRAIN) { int fr_ = fr, fq_ = fq, lane_ = lane; asm volatile("" : "+v"(fr_), "+v"(fq_), "+v"(lane_)); E.fused(acc, cur, wr, wc, fr_, fq_, lds, wid, lane_); S.done(cur); }
#undef PG8_SA
#undef PG8_SB
#undef PG8_STAGE
#undef PG8_LDA
#undef PG8_LDB
#undef PG8_MMA
#undef PG8_WAIT_V
#undef PG8_WAIT_L
#undef PG8_BAR
#undef PG8_SCHED
}
}


using pg8::Unit;
typedef unsigned u32x2 __attribute__((ext_vector_type(2)));
typedef unsigned u32x4 __attribute__((ext_vector_type(4)));
__device__ __forceinline__ float bflo(unsigned w) { return __uint_as_float(w << 16); }
__device__ __forceinline__ float bfhi(unsigned w) { return __uint_as_float(w & 0xffff0000u); }

struct InProjSched {
  pg8::StaticOrder so;
  __device__ __forceinline__ void init(int G, int c) { so.init(MX, N_IN, G, c, D, D); }
  __device__ __forceinline__ bool next(int i, Unit& u) const {
    const long Lx = (long)i * so.G + so.c;
    if (Lx < so.nwg) return so.next(i, u);
    const int j = (int)(Lx - so.nwg); if (j >= 40) return false;
    u.pm = 64 + (j & 3); u.pn = 4 + (j >> 2); u.grp = 0; u.ao = u.pm * so.tsA; u.bo = u.pn * so.tsB; return true;
  }
  __device__ __forceinline__ void a_ready(const Unit&) const {}
  __device__ __forceinline__ void done(const Unit&) const {}
};

struct EpiInProj {
  static constexpr bool PERM = false, AFTER_DRAIN = false;
  bf16_t *Q, *K, *V, *SA, *G; const float* rope;
  __device__ __forceinline__ static void st4(bf16_t* p, const f32x4 v) { u32x2 w; w.x = pg8::cvt_pk_bf16(v[0], v[1]); w.y = pg8::cvt_pk_bf16(v[2], v[3]); *(u32x2*)p = w; }
  __device__ __forceinline__ void operator()(const f32x4 (&acc)[2][2][4][2], const Unit& u, int wr, int wc, int fr, int fq) const {
    const int row0 = u.pm * 256 + wr * 64 + fr;
    const int cg0 = u.pn * 256 + wc * 32 + fq * 4;
    if (u.pm < 64) {
      if (u.pn < 8) {
        const bool isq = u.pn < 4;
#pragma unroll
        for (int ai = 0; ai < 2; ++ai)
#pragma unroll
          for (int m = 0; m < 4; ++m) {
            const int row = row0 + ai * 128 + m * 16, b = row >> 12, t = row & 4095;
            const int pos = (wc & 1) ? (t & 63) : (t >> 6);
            const f32x4* rp = (const f32x4*)(rope + (pos * 16 + fq * 4) * 2);
            const f32x4 r0 = rp[0], r1 = rp[1];
            const f32x4 cs = {r0[0], r0[2], r1[0], r1[2]}, sn = {r0[1], r0[3], r1[1], r1[3]};
            bf16_t* dst = isq ? Q + (size_t)row * 1024 + cg0 : K + ((size_t)b * LA + NCTX + t) * 1024 + (cg0 - 1024);
#pragma unroll
            for (int bj = 0; bj < 2; ++bj) {
              const f32x4 h1 = acc[ai][bj][m][0], h2 = acc[ai][bj][m][1];
              st4(dst + bj * 128, h1 * cs - h2 * sn);
              st4(dst + bj * 128 + 16, h2 * cs + h1 * sn);
            }
          }
      } else {
#pragma unroll
        for (int ai = 0; ai < 2; ++ai)
#pragma unroll
          for (int m = 0; m < 4; ++m) {
            const int row = row0 + ai * 128 + m * 16, b = row >> 12, t = row & 4095;
            const size_t kr = (size_t)b * LA + NCTX + t;
            if (u.pn >= 12 && u.pn < 14) {
#pragma unroll
              for (int bj = 0; bj < 2; ++bj)
#pragma unroll
                for (int n = 0; n < 2; ++n) {
                  const int ch = cg0 + bj * 128 + n * 16 - 3072;
                  st4(SA + ((size_t)(ch >> 4) * SA_ROWS + b * 128 + (t >> 5)) * SA_LD + (t & 31) * 16 + (ch & 15), acc[ai][bj][m][n]);
                }
            } else {
              bf16_t* dst = u.pn < 12 ? V + kr * 1024 + (cg0 - 2048) : G + (size_t)row * 2048 + (cg0 - 3584);
#pragma unroll
              for (int bj = 0; bj < 2; ++bj)
#pragma unroll
                for (int n = 0; n < 2; ++n) {
                  f32x4 v = acc[ai][bj][m][n];
                  if (u.pn >= 14) { v[0] = sigmoidf_(v[0]); v[1] = sigmoidf_(v[1]); v[2] = sigmoidf_(v[2]); v[3] = sigmoidf_(v[3]); }
                  st4(dst + bj * 128 + n * 16, v);
                }
            }
          }
      }
    } else {
#pragma unroll
      for (int ai = 0; ai < 2; ++ai)
#pragma unroll
        for (int m = 0; m < 4; ++m) {
          const int rc = row0 + ai * 128 + m * 16 - MX, b = rc >> 8, t = rc & 255;
          const size_t kr = (size_t)b * LA + t;
          if (u.pn >= 12) {
#pragma unroll
            for (int bj = 0; bj < 2; ++bj)
#pragma unroll
              for (int n = 0; n < 2; ++n) {
                const int ch = cg0 + bj * 128 + n * 16 - 3072;
                st4(SA + ((size_t)(ch >> 4) * SA_ROWS + 512 + b * 8 + (t >> 5)) * SA_LD + (t & 31) * 16 + (ch & 15), acc[ai][bj][m][n]);
              }
          } else {
            bf16_t* dst = u.pn < 8 ? K + kr * 1024 + (cg0 - 1024) : V + kr * 1024 + (cg0 - 2048);
#pragma unroll
            for (int bj = 0; bj < 2; ++bj)
#pragma unroll
              for (int n = 0; n < 2; ++n) st4(dst + bj * 128 + n * 16, acc[ai][bj][m][n]);
          }
        }
    }
  }
};
template <int MODE>
struct EpiBf8 {
  static constexpr bool PERM = true, AFTER_DRAIN = false;
  bf16_t* O; int ldo; const bf16_t* X; int ldx; const float* bias;
  __device__ __forceinline__ void operator()(const f32x4 (&acc)[2][2][4][2], const Unit& u, int wr, int wc, int fr, int fq) const {
    const int row0 = u.pm * 256 + wr * 64 + fr, col0 = u.pn * 256 + wc * 32 + 8 * fq;
#pragma unroll
    for (int ai = 0; ai < 2; ++ai)
#pragma unroll
      for (int m = 0; m < 4; ++m) {
        const int row = row0 + ai * 128 + m * 16;
#pragma unroll
        for (int bj = 0; bj < 2; ++bj) {
          const int col = col0 + bj * 128;
          f32x4 v0 = acc[ai][bj][m][0], v1 = acc[ai][bj][m][1];
          const u32x4 xw = *(const u32x4*)(X + (size_t)row * ldx + col);
          const f32x4 x0 = {bflo(xw.x), bfhi(xw.x), bflo(xw.y), bfhi(xw.y)}, x1 = {bflo(xw.z), bfhi(xw.z), bflo(xw.w), bfhi(xw.w)};
          if (MODE == 0) {
            const f32x4 b0 = *(const f32x4*)(bias + col), b1 = *(const f32x4*)(bias + col + 4);
#pragma unroll
            for (int i = 0; i < 4; ++i) { v0[i] = x0[i] * sigmoidf_(v0[i] + b0[i]); v1[i] = x1[i] * sigmoidf_(v1[i] + b1[i]); }
          } else if (MODE == 1) { v0 = v0 * x0; v1 = v1 * x1; }
          else {
            const u32x4 ow = *(const u32x4*)(O + (size_t)row * ldo + col);
            const f32x4 o0 = {bflo(ow.x), bfhi(ow.x), bflo(ow.y), bfhi(ow.y)}, o1 = {bflo(ow.z), bfhi(ow.z), bflo(ow.w), bfhi(ow.w)};
            v0 = o0 + v0 * x0; v1 = o1 + v1 * x1;
          }
          u32x4 w; w.x = pg8::cvt_pk_bf16(v0[0], v0[1]); w.y = pg8::cvt_pk_bf16(v0[2], v0[3]); w.z = pg8::cvt_pk_bf16(v1[0], v1[1]); w.w = pg8::cvt_pk_bf16(v1[2], v1[3]);
          *(u32x4*)(O + (size_t)row * ldo + col) = w;
        }
      }
  }
};
template <int MODE>
struct EpiF32 {
  static constexpr bool PERM = false, AFTER_DRAIN = false;
  float* O; const float* xres; const float* mod;
  __device__ __forceinline__ void operator()(const f32x4 (&acc)[2][2][4][2], const Unit& u, int wr, int wc, int fr, int fq) const {
    const int row0 = u.pm * 256 + wr * 64 + fr, col0 = u.pn * 256 + wc * 32 + 4 * fq;
#pragma unroll
    for (int ai = 0; ai < 2; ++ai)
#pragma unroll
      for (int m = 0; m < 4; ++m) {
        const int row = row0 + ai * 128 + m * 16;
#pragma unroll
        for (int bj = 0; bj < 2; ++bj)
#pragma unroll
          for (int n = 0; n < 2; ++n) {
            const int col = col0 + bj * 128 + n * 16;
            f32x4 v = acc[ai][bj][m][n];
            if (MODE == 1) { const f32x4 xr = *(const f32x4*)(xres + (size_t)row * 1024 + col); const f32x4 g = *(const f32x4*)(mod + (row >> 12) * 6144 + 2048 + col); v = xr + g * v; }
            *(f32x4*)(O + (size_t)row * 1024 + col) = v;
          }
      }
  }
};


struct GroupSched {
  int npm, npn, nunits, G, c; long gsA, gsB, tsA, tsB;
  __device__ __forceinline__ void init(int ngrp, int npm_, int npn_, long gsA_, long tsA_, long gsB_, long tsB_, int G_, int c_) { npm = npm_; npn = npn_; nunits = ngrp * npm_ * npn_; gsA = gsA_; tsA = tsA_; gsB = gsB_; tsB = tsB_; G = G_; c = c_; }
  __device__ __forceinline__ bool next(int i, Unit& u) const {
    const long Lx = (long)i * G + c; if (Lx >= nunits) return false;
    const int per = npm * npn, grp = (int)Lx / per, r = (int)Lx % per;
    u.grp = grp; u.pm = r / npn; u.pn = r % npn; u.ao = grp * gsA + u.pm * tsA; u.bo = grp * gsB + u.pn * tsB; return true;
  }
  __device__ __forceinline__ void a_ready(const Unit&) const {}
  __device__ __forceinline__ void done(const Unit&) const {}
};
struct EpiS {
  static constexpr bool PERM = false, AFTER_DRAIN = false;
  float* S;
  __device__ __forceinline__ void operator()(const f32x4 (&acc)[2][2][4][2], const Unit& u, int wr, int wc, int fr, int fq) const {
    const int row0 = u.pm * 256 + wr * 64 + fr, col0 = wc * 32 + 4 * fq;
#pragma unroll
    for (int ai = 0; ai < 2; ++ai)
#pragma unroll
      for (int m = 0; m < 4; ++m) {
        const int row = row0 + ai * 128 + m * 16;
        if (row < SA_ROWS) {
#pragma unroll
          for (int bj = 0; bj < 2; ++bj)
#pragma unroll
            for (int n = 0; n < 2; ++n) *(f32x4*)(S + ((size_t)u.grp * SA_ROWS + row) * 256 + col0 + bj * 128 + n * 16) = acc[ai][bj][m][n];
        }
      }
  }
};
struct EpiY {
  static constexpr bool PERM = true, AFTER_DRAIN = false;
  bf16_t* YG;
  __device__ __forceinline__ void operator()(const f32x4 (&acc)[2][2][4][2], const Unit& u, int wr, int wc, int fr, int fq) const {
    const int row0 = u.pm * 256 + wr * 64 + fr, col0 = u.pn * 256 + wc * 32 + 8 * fq;
#pragma unroll
    for (int ai = 0; ai < 2; ++ai)
#pragma unroll
      for (int m = 0; m < 4; ++m) {
        const int row = row0 + ai * 128 + m * 16, b = row >> 7, cx = row & 127;
#pragma unroll
        for (int bj = 0; bj < 2; ++bj) {
          const int col = col0 + bj * 128, j = col >> 4, p0 = col & 15;
          const f32x4 v0 = acc[ai][bj][m][0], v1 = acc[ai][bj][m][1];
          u32x4 w; w.x = pg8::cvt_pk_bf16(gelu_tanh(v0[0]), gelu_tanh(v0[1])); w.y = pg8::cvt_pk_bf16(gelu_tanh(v0[2]), gelu_tanh(v0[3]));
          w.z = pg8::cvt_pk_bf16(gelu_tanh(v1[0]), gelu_tanh(v1[1])); w.w = pg8::cvt_pk_bf16(gelu_tanh(v1[2]), gelu_tanh(v1[3]));
          *(u32x4*)(YG + ((size_t)(b * L + cx * 32 + j)) * 512 + u.grp * 16 + p0) = w;
        }
      }
  }
};


__device__ __forceinline__ unsigned f2key(float s) { const unsigned u = __float_as_uint(s); return u ^ ((u & 0x80000000u) ? 0xFFFFFFFFu : 0x80000000u); }
__device__ __forceinline__ float key2f(unsigned k) { return __uint_as_float(k ^ ((k & 0x80000000u) ? 0x80000000u : 0xFFFFFFFFu)); }
#define TK_INSERT(L, cv) do { _Pragma("unroll") for (int k_ = 0; k_ < 16; ++k_) { const unsigned hi_ = L[k_] > cv ? L[k_] : cv, lo_ = L[k_] > cv ? cv : L[k_]; L[k_] = hi_; cv = lo_; } } while (0)
struct EpiTopK {
  static constexpr bool PERM = false, AFTER_DRAIN = true;
  unsigned short* IDX; float* GATE;
  __device__ __forceinline__ void fused(f32x4 (&acc)[2][2][4][2], const Unit& u, int wr, int wc, int fr, int fq, PG8_LAS unsigned char* lds, int wid, int lane) const {
    PG8_LAS float* SC = (PG8_LAS float*)lds;
    const int tid = wid * 64 + lane;
#pragma unroll
    for (int ai = 0; ai < 2; ++ai) {
#pragma unroll
      for (int m = 0; m < 4; ++m)
#pragma unroll
        for (int bj = 0; bj < 2; ++bj)
#pragma unroll
          for (int n = 0; n < 2; ++n)
#pragma unroll
            for (int i = 0; i < 4; ++i) SC[(64 * wr + 16 * m + fr) * 257 + 128 * bj + 32 * wc + 16 * n + 4 * fq + i] = acc[ai][bj][m][n][i];
      asm volatile("s_waitcnt lgkmcnt(0)" ::: "memory"); __builtin_amdgcn_s_barrier(); asm volatile("" ::: "memory");
      if (tid < 256) {
        PG8_LAS float* rowp = SC + (tid & 127) * 257 + (tid >> 7) * 128;
        unsigned Lk[16];
#pragma unroll
        for (int k = 0; k < 16; ++k) Lk[k] = 0u;
        for (int k = 0; k < 128; ++k) { unsigned cv = (f2key(rowp[k]) & ~0x7Fu) | (unsigned)(127 - k); TK_INSERT(Lk, cv); }
#pragma unroll
        for (int k = 0; k < 16; ++k) rowp[k] = __uint_as_float(Lk[k]);
      }
      asm volatile("s_waitcnt lgkmcnt(0)" ::: "memory"); __builtin_amdgcn_s_barrier(); asm volatile("" ::: "memory");
      if (tid < 128) {
        PG8_LAS float* rowp = SC + tid * 257;
        float v1[16], v2[16];
#pragma unroll
        for (int k = 0; k < 16; ++k) { v1[k] = key2f(__float_as_uint(rowp[k]) & ~0x7Fu); v2[k] = key2f(__float_as_uint(rowp[128 + k]) & ~0x7Fu); }
        unsigned Lc[16];
#pragma unroll
        for (int k = 0; k < 16; ++k) Lc[k] = 0u;
#pragma unroll
        for (int a = 0; a < 16; ++a)
#pragma unroll
          for (int b = 0; b < 16; ++b)
            if ((a + 1) * (b + 1) <= 16) { unsigned cv = (f2key(v1[a] + v2[b]) & ~0xFFu) | (unsigned)(255 - (a * 16 + b)); TK_INSERT(Lc, cv); }
        float ev[16]; float den = 0.f; const float mx = key2f(Lc[0] & ~0xFFu);
#pragma unroll
        for (int k = 0; k < 16; ++k) { ev[k] = __expf(key2f(Lc[k] & ~0xFFu) - mx); den += ev[k]; }
        const float inv = 1.f / den;
        const size_t o = ((size_t)(u.pm * 256 + ai * 128 + tid) * 8 + u.pn) * 16;
        unsigned iw[8];
#pragma unroll
        for (int k = 0; k < 16; ++k) {
          const int code = 255 - (int)(Lc[k] & 0xFFu), a = code >> 4, b = code & 15;
          const unsigned e1 = 127u - (__float_as_uint(rowp[a]) & 0x7Fu), e2 = 127u - (__float_as_uint(rowp[128 + b]) & 0x7Fu);
          const unsigned ex = e1 * 128u + e2;
          if (k & 1) iw[k >> 1] |= ex << 16; else iw[k >> 1] = ex;
        }
        *(u32x4*)(IDX + o) = (u32x4){iw[0], iw[1], iw[2], iw[3]}; *(u32x4*)(IDX + o + 8) = (u32x4){iw[4], iw[5], iw[6], iw[7]};
#pragma unroll
        for (int k = 0; k < 16; k += 4) *(f32x4*)(GATE + o + k) = (f32x4){ev[k] * inv, ev[k + 1] * inv, ev[k + 2] * inv, ev[k + 3] * inv};
      }
      asm volatile("s_waitcnt lgkmcnt(0)" ::: "memory"); __builtin_amdgcn_s_barrier(); asm volatile("" ::: "memory");
    }
  }
};
struct OneUnitSched {
  int nM, nN, G, c, round; long tsA, tsB;
  __device__ __forceinline__ bool next(int i, Unit& u) const {
    if (i > 0) return false;
    const long Lx = (long)round * G + c; if (Lx >= (long)nM * nN) return false;
    u.pm = (int)(Lx % nM); u.pn = (int)(Lx / nM); u.grp = 0; u.ao = u.pm * tsA; u.bo = u.pn * tsB; return true;
  }
  __device__ __forceinline__ void a_ready(const Unit&) const {}
  __device__ __forceinline__ void done(const Unit&) const {}
};

__device__ __forceinline__ void transpose_item(const float* W, int K, int N, bf16_t* WT, float* scr, int item, int lane) {
  const int nblk = N / 32, kb = item / nblk, nb = item % nblk, k0 = 64 * kb, n0 = 32 * nb;
#pragma unroll 8
  for (int i = 0; i < 32; ++i) { const int kk = 2 * i + (lane >> 5); scr[kk * 33 + (lane & 31)] = W[(size_t)(k0 + kk) * N + n0 + (lane & 31)]; }
  asm volatile("s_waitcnt lgkmcnt(0)" ::: "memory");
  const int c = lane & 7;
#pragma unroll
  for (int j = 0; j < 4; ++j) {
    const int n = (lane >> 3) + 8 * j; const float* s = scr + (8 * c) * 33 + n;
    u32x4 o; o.x = pg8::cvt_pk_bf16(s[0], s[33]); o.y = pg8::cvt_pk_bf16(s[66], s[99]); o.z = pg8::cvt_pk_bf16(s[132], s[165]); o.w = pg8::cvt_pk_bf16(s[198], s[231]);
    *(u32x4*)(WT + (size_t)(n0 + n) * K + k0 + 8 * c) = o;
  }
  asm volatile("s_waitcnt lgkmcnt(0)" ::: "memory");
}

namespace att {
using bf16 = unsigned short;
constexpr int   D = 128, NW = 8, QBLK = 32, KVBLK = 64, SDEPTH = 2;
constexpr float SCALE = 0.125f;
constexpr float THR = 8.f;
constexpr int LDQ = 1024, LDK = 1024, LDO = 1024;
constexpr size_t SHM_V = KVBLK * D * 2, SHM_K = KVBLK * D * 2, SHM_ATTN = 2 * SHM_V + 2 * SHM_K + NW * 64 * 4 + 4 * 4 * 16 * 64 * 4;
using bf16x8 = __attribute__((ext_vector_type(8))) short;
using s16x4  = __attribute__((ext_vector_type(4))) short;
using f32x16 = __attribute__((ext_vector_type(16))) float;
using f32x8  = __attribute__((ext_vector_type(8))) float;
using u32x4  = __attribute__((ext_vector_type(4))) unsigned;
#define KSWZ(row, colB) ((row) * 256 + ((colB) ^ (((row) & 7) << 4)))
#define SBAR() __builtin_amdgcn_sched_barrier(0)
__device__ __forceinline__ int crow(int r, int hi) { return (r & 3) + 8 * (r >> 2) + 4 * hi; }
__device__ __forceinline__ unsigned cvtpk(float lo, float hi) {
  unsigned r; asm volatile("v_cvt_pk_bf16_f32 %0, %1, %2" : "=v"(r) : "v"(lo), "v"(hi)); return r;
}
template <typename TIn> struct Stage;
template <> struct Stage<bf16>  { using T = bf16x8;
  __device__ static __forceinline__ T ld8(const bf16* p) { return *reinterpret_cast<const bf16x8*>(p); }
  __device__ static __forceinline__ bf16x8 tobf(T x) { return x; } };
__device__ __forceinline__ void partialSM(f32x16& p0, f32x16& p1, float& m_reg, float& mn, float& alpha) {
  constexpr float C = SCALE * 1.4426950408889634f;
  float pmax = p0[0]; for (int r = 1; r < 16; ++r) pmax = fmaxf(pmax, p0[r]); for (int r = 0; r < 16; ++r) pmax = fmaxf(pmax, p1[r]);
  { auto rr = __builtin_amdgcn_permlane32_swap(__float_as_uint(pmax), __float_as_uint(pmax), false, false);
    pmax = fmaxf(__uint_as_float(rr[0]), __uint_as_float(rr[1])); }
  if (__builtin_expect(__all(pmax - m_reg <= THR / SCALE), 1)) { mn = m_reg; alpha = 1.f; }
  else { mn = fmaxf(m_reg, pmax); alpha = __builtin_amdgcn_exp2f((m_reg - mn) * C); m_reg = mn; }
  float mnC = -mn * C;
  for (int r = 0; r < 16; ++r) p0[r] = fmaf(p0[r], C, mnC); for (int r = 0; r < 16; ++r) p1[r] = fmaf(p1[r], C, mnC);
  for (int r = 0; r < 16; ++r) p0[r] = __builtin_amdgcn_exp2f(p0[r]);
}
__device__ __forceinline__ void finishSM(f32x16& p0, f32x16& p1, float alpha, float& l_reg, bf16x8& pa0, bf16x8& pa1, bf16x8& pa2, bf16x8& pa3) {
  for (int r = 0; r < 16; ++r) p1[r] = __builtin_amdgcn_exp2f(p1[r]);
  float ps = 0; for (int r = 0; r < 16; ++r) ps += p0[r]; for (int r = 0; r < 16; ++r) ps += p1[r];
  { auto rr = __builtin_amdgcn_permlane32_swap(__float_as_uint(ps), __float_as_uint(ps), false, false);
    ps = __uint_as_float(rr[0]) + __uint_as_float(rr[1]); }
  l_reg = l_reg * alpha + ps;
#define PK4(P, BASE, OUT) do { unsigned a0 = cvtpk(P[BASE + 0], P[BASE + 1]), a1 = cvtpk(P[BASE + 2], P[BASE + 3]);   \
    unsigned b0 = cvtpk(P[BASE + 4], P[BASE + 5]), b1 = cvtpk(P[BASE + 6], P[BASE + 7]);                              \
    auto r0 = __builtin_amdgcn_permlane32_swap(a0, b0, false, false); auto r1 = __builtin_amdgcn_permlane32_swap(a1, b1, false, false); \
    u32x4 w = {r0[0], r1[0], r0[1], r1[1]}; OUT = *reinterpret_cast<bf16x8*>(&w); } while (0)
  PK4(p0, 0, pa0); PK4(p0, 8, pa1); PK4(p1, 0, pa2); PK4(p1, 8, pa3);
#undef PK4
}
__device__ __forceinline__ void qkt(f32x16& p0, f32x16& p1, const bf16* Ks, const char* qfl, int r32, int hi, int mcolB) {
  p0 = f32x16{}; p1 = f32x16{};
  asm volatile("" : "+v"(qfl));
  bf16x8 qr[4];
#pragma unroll
  for (int d0 = 0; d0 < 4; ++d0) qr[d0] = *reinterpret_cast<const bf16x8*>(qfl + d0 * 1024);
#pragma unroll
  for (int d0 = 0; d0 < 4; ++d0) { int cb = mcolB + (d0 * 16 + hi * 8) * 2;
    bf16x8 b0 = *reinterpret_cast<const bf16x8*>((const char*)Ks + KSWZ(r32, cb));
    bf16x8 b1 = *reinterpret_cast<const bf16x8*>((const char*)Ks + KSWZ(32 + r32, cb));
    p0 = __builtin_amdgcn_mfma_f32_32x32x16_bf16(b0, qr[d0], p0, 0, 0, 0);
    p1 = __builtin_amdgcn_mfma_f32_32x32x16_bf16(b1, qr[d0], p1, 0, 0, 0); }
}
__device__ __forceinline__ int v_st(int k, int c) { const int kk = (k & ~0xC) | ((k & 4) << 1) | ((k & 8) >> 1); return ((kk >> 3) * 4 + (c >> 5)) * 512 + ((kk & 7) * 32 + (c & 31)) * 2; }
__device__ __forceinline__ int v_rd_base(int lane) { return ((lane & 3) << 3) | (((lane >> 2) & 3) << 6) | (((lane >> 4) & 1) << 5) | (((lane >> 5) & 1) << 8); }
constexpr int v_rd_off(int d0, int ks, int half) { return d0 * 512 + ks * 4096 + half * 2048; }
template <int OFF> __device__ __forceinline__ s16x4 tr_read(int vb) {
  s16x4 r; asm volatile("ds_read_b64_tr_b16 %0, %1 offset:%2" : "=&v"(r) : "v"(vb), "i"(OFF) : "memory"); return r;
}
template <int D0> __device__ __forceinline__ void pv_one(f32x16& od, int vb, bf16x8 pa0, bf16x8 pa1, bf16x8 pa2, bf16x8 pa3) {
  const s16x4 l0 = tr_read<v_rd_off(D0, 0, 0)>(vb), h0 = tr_read<v_rd_off(D0, 0, 1)>(vb), l1 = tr_read<v_rd_off(D0, 1, 0)>(vb), h1 = tr_read<v_rd_off(D0, 1, 1)>(vb);
  const s16x4 l2 = tr_read<v_rd_off(D0, 2, 0)>(vb), h2 = tr_read<v_rd_off(D0, 2, 1)>(vb), l3 = tr_read<v_rd_off(D0, 3, 0)>(vb), h3 = tr_read<v_rd_off(D0, 3, 1)>(vb);
  asm volatile("s_waitcnt lgkmcnt(0)" ::: "memory"); SBAR();
#define PK(L, H) (bf16x8){L[0], L[1], L[2], L[3], H[0], H[1], H[2], H[3]}
  od = __builtin_amdgcn_mfma_f32_32x32x16_bf16(pa0, PK(l0, h0), od, 0, 0, 0);
  od = __builtin_amdgcn_mfma_f32_32x32x16_bf16(pa1, PK(l1, h1), od, 0, 0, 0);
  od = __builtin_amdgcn_mfma_f32_32x32x16_bf16(pa2, PK(l2, h2), od, 0, 0, 0);
  od = __builtin_amdgcn_mfma_f32_32x32x16_bf16(pa3, PK(l3, h3), od, 0, 0, 0);
#undef PK
}
__device__ __forceinline__ void pv_d0(f32x16* o, int vb, bf16x8 pa0, bf16x8 pa1, bf16x8 pa2, bf16x8 pa3) {
  pv_one<0>(o[0], vb, pa0, pa1, pa2, pa3); pv_one<1>(o[1], vb, pa0, pa1, pa2, pa3); pv_one<2>(o[2], vb, pa0, pa1, pa2, pa3); pv_one<3>(o[3], vb, pa0, pa1, pa2, pa3);
}

__device__ __forceinline__ void diff_attn_unit(const bf16* __restrict__ Qb, const bf16* __restrict__ Kh, const bf16* __restrict__ Vh,
                                               bf16* __restrict__ Ob, int seq, float lam, const float* __restrict__ subln, char* lds) {
  using St = Stage<bf16>;
  int tid_ = threadIdx.x; asm volatile("" : "+v"(tid_));
  const int tid = tid_, wid = tid >> 6, lane = tid & 63, r32 = lane & 31, hi = lane >> 5;
  bf16* V_lds = (bf16*)lds; bf16* K_lds = (bf16*)(lds + 2 * SHM_V);
  float* ws = (float*)(lds + 2 * SHM_V + 2 * SHM_K) + wid * 64; float* li_l = ws; float* al_l = ws + 32;
  float m_reg = -1e30f, l_reg = 0; f32x16 o[4] = {};
  const int mw = wid >> 2, wq = wid & 3, mcolB = mw * 128;
  const bf16* Qw = Qb + (long)(wq * QBLK + r32) * LDQ + mw * 64 + hi * 8;
  char* qr = lds + 2 * SHM_V + 2 * SHM_K + NW * 64 * 4 + wid * 4096 + lane * 16;
#pragma unroll
  for (int d0 = 0; d0 < 4; ++d0) *reinterpret_cast<bf16x8*>(qr + d0 * 1024) = St::ld8(Qw + d0 * 16);
  const int sr = tid >> 4, sc = (tid & 15) * 8, vst0 = v_st(sr, sc), vst1 = v_st(32 + sr, sc);
  const int vb0 = (int)(uintptr_t)V_lds + v_rd_base(lane);
  struct { typename St::T vs0, vs1, ks0, ks1; } sr_[SDEPTH];
#define SLOAD(i, k0) do { sr_[i].vs0 = St::ld8(&Vh[(long)((k0) + sr) * LDK + sc]); sr_[i].vs1 = St::ld8(&Vh[(long)((k0) + 32 + sr) * LDK + sc]); \
    sr_[i].ks0 = St::ld8(&Kh[(long)((k0) + sr) * LDK + sc]); sr_[i].ks1 = St::ld8(&Kh[(long)((k0) + 32 + sr) * LDK + sc]); } while (0)
#define SWRITE(b, i) do { *(bf16x8*)((char*)V_lds + (b) * SHM_V + vst0) = St::tobf(sr_[i].vs0);          \
    *(bf16x8*)((char*)V_lds + (b) * SHM_V + vst1) = St::tobf(sr_[i].vs1); int kc = sc * 2;               \
    *(bf16x8*)((char*)K_lds + (b) * SHM_K + KSWZ(sr, kc)) = St::tobf(sr_[i].ks0);                       \
    *(bf16x8*)((char*)K_lds + (b) * SHM_K + KSWZ(32 + sr, kc)) = St::tobf(sr_[i].ks1); } while (0)
#define SWAIT() do { if constexpr (SDEPTH == 2) asm volatile("s_waitcnt vmcnt(4)" ::: "memory"); else asm volatile("s_waitcnt vmcnt(0)" ::: "memory"); } while (0)
#define RESC(a) do { if (__any((a) < 1.f)) { if (hi == 0) al_l[r32] = (a); asm volatile("s_waitcnt lgkmcnt(0)" ::: "memory"); \
    for (int d = 0; d < 4; ++d) for (int r = 0; r < 16; ++r) o[d][r] *= al_l[crow(r, hi)]; } } while (0)
  f32x16 pA0, pA1, pB0, pB1; float mnA, mnB, alA, alB; bf16x8 pa0, pa1, pa2, pa3; const int NT = seq / KVBLK;
  constexpr int SE = 0, SO = SDEPTH - 1;
  SLOAD(SE, 0); asm volatile("s_waitcnt vmcnt(0)" ::: "memory"); SWRITE(0, SE); __syncthreads();
  qkt(pA0, pA1, K_lds, qr, r32, hi, mcolB); partialSM(pA0, pA1, m_reg, mnA, alA);
  SLOAD(SO, KVBLK); if constexpr (SDEPTH == 2) { if (2 < NT) SLOAD(SE, 2 * KVBLK); }
  SWAIT(); SWRITE(1, SO); __syncthreads();
  for (int j = 1; j + 1 < NT; j += 2) {
    SBAR(); qkt(pB0, pB1, (bf16*)((char*)K_lds + SHM_K), qr, r32, hi, mcolB);
    finishSM(pA0, pA1, alA, l_reg, pa0, pa1, pa2, pa3); SBAR();
    SLOAD(SO, (j + SDEPTH) * KVBLK); SBAR();
    pv_d0(o, vb0, pa0, pa1, pa2, pa3); partialSM(pB0, pB1, m_reg, mnB, alB);
    __syncthreads(); SWAIT(); SWRITE(0, SE);
    RESC(alB); __syncthreads();
    SBAR(); qkt(pA0, pA1, K_lds, qr, r32, hi, mcolB);
    finishSM(pB0, pB1, alB, l_reg, pa0, pa1, pa2, pa3); SBAR();
    if (SDEPTH == 1 || j + 3 < NT) SLOAD(SE, (j + 1 + SDEPTH) * KVBLK); SBAR();
    pv_d0(o, vb0 + (int)SHM_V, pa0, pa1, pa2, pa3); partialSM(pA0, pA1, m_reg, mnA, alA);
    __syncthreads(); SWAIT(); SWRITE(1, SO);
    RESC(alA); __syncthreads();
  }
  SBAR(); qkt(pB0, pB1, (bf16*)((char*)K_lds + SHM_K), qr, r32, hi, mcolB);
  finishSM(pA0, pA1, alA, l_reg, pa0, pa1, pa2, pa3); SBAR();
  pv_d0(o, vb0, pa0, pa1, pa2, pa3); partialSM(pB0, pB1, m_reg, mnB, alB);
  __syncthreads(); RESC(alB);
  finishSM(pB0, pB1, alB, l_reg, pa0, pa1, pa2, pa3); SBAR();
  pv_d0(o, vb0 + (int)SHM_V, pa0, pa1, pa2, pa3);
  if (hi == 0) li_l[r32] = l_reg; asm volatile("s_waitcnt lgkmcnt(0)" ::: "memory");
  float rli[16];
#pragma unroll
  for (int r = 0; r < 16; ++r) rli[r] = __builtin_amdgcn_rcpf(li_l[crow(r, hi)]);
  float* EXO = (float*)(lds + 2 * SHM_V + 2 * SHM_K + NW * 64 * 4) + wq * (4 * 16 * 64) + lane;
  if (mw == 1) {
#pragma unroll
    for (int d0 = 0; d0 < 4; ++d0)
#pragma unroll
      for (int r = 0; r < 16; ++r) EXO[(d0 * 16 + r) * 64] = o[d0][r] * rli[r];
  }
  __syncthreads();
  if (mw == 0) {
    float ssq[16];
#pragma unroll
    for (int r = 0; r < 16; ++r) ssq[r] = 0.f;
#pragma unroll
    for (int d0 = 0; d0 < 4; ++d0)
#pragma unroll
      for (int r = 0; r < 16; ++r) { const float dv = o[d0][r] * rli[r] - lam * EXO[(d0 * 16 + r) * 64]; o[d0][r] = dv; ssq[r] += dv * dv; }
#pragma unroll
    for (int r = 0; r < 16; ++r) {
#pragma unroll
      for (int sft = 1; sft < 32; sft <<= 1) ssq[r] += __shfl_xor(ssq[r], sft);
      ssq[r] = rsqrtf(ssq[r] * (1.f / 128.f) + 1e-6f) * 0.8f;
    }
    bf16* Ow = Ob + (long)(wq * QBLK) * LDO;
#pragma unroll
    for (int d0 = 0; d0 < 4; ++d0) { const float gg = subln[d0 * 32 + r32];
#pragma unroll
      for (int r = 0; r < 16; ++r) { const float val = o[d0][r] * ssq[r] * gg; Ow[(long)crow(r, hi) * LDO + d0 * 32 + r32] = (bf16)(pg8::cvt_pk_bf16(val, val) & 0xffffu); } }
  }
  __syncthreads();
#undef SLOAD
#undef SWRITE
#undef SWAIT
#undef RESC
}
}


typedef __bf16 bf16x2_t __attribute__((ext_vector_type(2)));
__device__ __forceinline__ float dot2bf(unsigned a, unsigned b, float acc) { return __builtin_amdgcn_fdot2_f32_bf16(__builtin_bit_cast(bf16x2_t, a), __builtin_bit_cast(bf16x2_t, b), acc, false); }
template <int CTRL> __device__ __forceinline__ float dpp_add(float v) { return v + __builtin_bit_cast(float, __builtin_amdgcn_update_dpp(0, __builtin_bit_cast(int, v), CTRL, 0xf, 0xf, true)); }
__device__ __forceinline__ float row16_sum(float v) {
  v = dpp_add<0xB1>(v); v = dpp_add<0x4E>(v); v = dpp_add<0x141>(v); v = dpp_add<0x140>(v); return v;
}

__device__ __forceinline__ void slice_table(const float* T, bf16_t* T8, int gtid, int gsz) {
  for (int it = gtid; it < 16384 * 128; it += gsz) {
    const int e = it >> 7, c8 = (it & 127) * 8, j = c8 >> 7, c = c8 & 127;
    const f32x4 a = *(const f32x4*)(T + (size_t)e * 1024 + c8), b = *(const f32x4*)(T + (size_t)e * 1024 + c8 + 4);
    u32x4 w; w.x = pg8::cvt_pk_bf16(a[0], a[1]); w.y = pg8::cvt_pk_bf16(a[2], a[3]); w.z = pg8::cvt_pk_bf16(b[0], b[1]); w.w = pg8::cvt_pk_bf16(b[2], b[3]);
    *(u32x4*)(T8 + ((size_t)j * 16384 + e) * 128 + c) = w;
  }
}

__device__ __forceinline__ void wave_argmax(float& v, int& i) {
#pragma unroll
  for (int o = 32; o; o >>= 1) {
    const float ov = __shfl_xor(v, o); const int oi = __shfl_xor(i, o);
    if (ov > v || (ov == v && oi < i)) { v = ov; i = oi; }
  }
}

__global__ void __launch_bounds__(NT) mega(Params p) {
  extern __shared__ __attribute__((aligned(16))) unsigned char lds[];
  cg::grid_group grid = cg::this_grid();
  if (threadIdx.x < 35) {
    unsigned long long v = threadIdx.x < 33 ? (unsigned long long)p.in[threadIdx.x] : (threadIdx.x == 33 ? (unsigned long long)p.out : (unsigned long long)p.ws);
    ((unsigned long long*)(lds + PTR_OFF))[threadIdx.x] = v;
  }
  __syncthreads();

  {
    PHASE_LOCALS
    float* MOD = (float*)WSP(WS_MOD); float* LAM = (float*)WSP(WS_LAM);
    float* ABRE = (float*)WSP(WS_ABRE); float* ABIM = (float*)WSP(WS_ABIM); float* BBRE = (float*)WSP(WS_BBRE); float* BBIM = (float*)WSP(WS_BBIM);
    const float* cin = INP(1); const float* c_ctx = INP(3); const float* ada_w = INP(4); const float* ada_b = INP(5);
    if (gridDim.x >= 192) {
      if (blockIdx.x < 192) {
        float* sil = fl; float* red = fl + 5 * 1024;
        for (int i = tid; i < 5 * 1024; i += NT) { const int r = i >> 10, k = i & 1023; sil[i] = siluf_(r < 4 ? cin[r * D + k] : c_ctx[k]); }
        __syncthreads();
        const int cl = tid & 31, kg = tid >> 5, col = blockIdx.x * 32 + cl;
        float a[5] = {0.f, 0.f, 0.f, 0.f, 0.f};
#pragma unroll 16
        for (int kk = 0; kk < 64; ++kk) {
          const int k = kg * 64 + kk; const float w = ada_w[(size_t)k * 6144 + col];
#pragma unroll
          for (int r = 0; r < 5; ++r) a[r] += sil[r * 1024 + k] * w;
        }
#pragma unroll
        for (int r = 0; r < 5; ++r) red[(kg * 5 + r) * 32 + cl] = a[r];
        __syncthreads();
        if (tid < 160) {
          const int r = tid >> 5; float s = 0.f;
#pragma unroll
          for (int q = 0; q < 16; ++q) s += red[(q * 5 + r) * 32 + cl];
          MOD[r * 6144 + col] = s + ada_b[col];
        }
        __syncthreads();
      }
    } else {
      for (int it = gtid; it < 5 * 6144; it += gsz) {
        const int r = it / 6144, j = it % 6144;
        const float* cv = r < 4 ? cin + r * D : c_ctx;
        float a = 0.f;
        for (int k = 0; k < D; ++k) a += siluf_(cv[k]) * ada_w[(size_t)k * 6144 + j];
        MOD[it] = a + ada_b[j];
      }
    }
    if (gtid == 0) {
      const float* q1 = INP(9); const float* k1 = INP(10); const float* q2 = INP(11); const float* k2 = INP(12);
      float s1 = 0.f, s2 = 0.f;
      for (int k = 0; k < 64; ++k) { s1 += q1[k] * k1[k]; s2 += q2[k] * k2[k]; }
      LAM[0] = expf(s1) - expf(s2) + 0.2f;
    }
    const float* a_re = INP(15); const float* a_im = INP(16); const float* ldt = INP(17); const float* b_re = INP(18); const float* b_im = INP(19);
    for (int it = gtid; it < 2 * 32 * 64; it += gsz) {
      const int dg = it >> 6;
      const float ar = a_re[it], ai = a_im[it], dt = expf(ldt[dg]);
      const float mag = expf(ar * dt), abr = mag * cosf(ai * dt), abi = mag * sinf(ai * dt);
      ABRE[it] = abr; ABIM[it] = abi; ((float*)WSP(WS_ARDT))[it] = ar * dt; ((float*)WSP(WS_AIDT))[it] = ai * dt;
      const float den = ar * ar + ai * ai, nr = abr - 1.f, ni = abi;
      const float fr = (nr * ar + ni * ai) / den, fi = (ni * ar - nr * ai) / den;
      for (int pp = 0; pp < 16; ++pp) {
        const float br = b_re[it * 16 + pp], bi = b_im[it * 16 + pp];
        BBRE[it * 16 + pp] = fr * br - fi * bi; BBIM[it * 16 + pp] = fr * bi + fi * br;
      }
    }
    float* ROPE = (float*)WSP(WS_ROPE);
    for (int it = gtid; it < 64 * 16; it += gsz) {
      const float ang = (float)(it >> 4) * powf(10000.f, -(float)(it & 15) / 16.f);
      ROPE[it * 2] = cosf(ang); ROPE[it * 2 + 1] = sinf(ang);
    }
    {
      float* scr = fl + wid * (64 * 33);
      constexpr int I_IN = 16 * 176, I_AU = 16 * 32, I_SU = 8 * 32, I_OUT = 16 * 32, I_Q = 16 * 32, I_GLU = 8 * 16;
      for (int it = gw; it < I_IN + I_AU + I_SU + I_OUT + I_GLU; it += ngw) {
        int r = it;
        if (r < I_IN) { transpose_item(INP(8), 1024, N_IN, (bf16_t*)WSP(WS_WIN), scr, r, lane); continue; } r -= I_IN;
        if (r < I_AU) { transpose_item(INP(14), 1024, 1024, (bf16_t*)WSP(WS_WAU), scr, r, lane); continue; } r -= I_AU;
        if (r < I_SU) { transpose_item(INP(25), 512, 1024, (bf16_t*)WSP(WS_WSU), scr, r, lane); continue; } r -= I_SU;
        if (r < I_OUT) { transpose_item(INP(26), 1024, 1024, (bf16_t*)WSP(WS_WOUT), scr, r, lane); continue; } r -= I_OUT;
        transpose_item(INP(23), 512, 512, (bf16_t*)WSP(WS_WGLU), scr, r, lane);
      }
    }
  }
  grid.sync();

  {
    PHASE_LOCALS
    const float* MOD = (const float*)WSP(WS_MOD); bf16_t* XN = (bf16_t*)WSP(WS_XN);
    const float* x = INP(0); const float* ctx = INP(2); const float* norm1_g = INP(6);
    for (int row = gw; row < MX + MC; row += ngw) {
      const float* src; const float* md;
      if (row < MX) { src = x + (size_t)row * D; md = MOD + (row / L) * 6144; } else { src = ctx + (size_t)(row - MX) * D; md = MOD + 4 * 6144; }
      f32x4 v[4]; float ss = 0.f;
#pragma unroll
      for (int j = 0; j < 4; ++j) { v[j] = *(const f32x4*)(src + lane * 4 + 256 * j); ss += v[j][0] * v[j][0] + v[j][1] * v[j][1] + v[j][2] * v[j][2] + v[j][3] * v[j][3]; }
      const float rstd = rsqrtf(wave_sum(ss) * (1.f / D) + 1e-6f);
#pragma unroll
      for (int j = 0; j < 4; ++j)
#pragma unroll
        for (int e = 0; e < 4; ++e) { const int col = lane * 4 + 256 * j + e; XN[(size_t)row * D + col] = f2bf(v[j][e] * rstd * norm1_g[col] * (1.f + md[1024 + col]) + md[col]); }
    }
    const float* ARDT = (const float*)WSP(WS_ARDT); const float* AIDT = (const float*)WSP(WS_AIDT);
    const float* BBRE = (const float*)WSP(WS_BBRE); const float* BBIM = (const float*)WSP(WS_BBIM);
    {
      bf16_t* BTS = (bf16_t*)WSP(WS_BTS);
      for (int it = gtid; it < 32 * 256 * 32; it += gsz) {
        const int i = it & 31, r = (it >> 5) & 255, g = it >> 13;
        const int d = r >> 7, n = (r >> 1) & 63, ri = r & 1, sidx = (d * 32 + g) * 64 + n;
        const float e = (float)(d == 0 ? 31 - i : i);
        const float mag = expf(e * ARDT[sidx]), pr = mag * cosf(e * AIDT[sidx]), pi = mag * sinf(e * AIDT[sidx]);
        unsigned w[8];
#pragma unroll
        for (int q = 0; q < 8; ++q) {
          const float br0 = BBRE[sidx * 16 + 2 * q], bi0 = BBIM[sidx * 16 + 2 * q], br1 = BBRE[sidx * 16 + 2 * q + 1], bi1 = BBIM[sidx * 16 + 2 * q + 1];
          const float v0 = ri == 0 ? pr * br0 - pi * bi0 : pr * bi0 + pi * br0, v1 = ri == 0 ? pr * br1 - pi * bi1 : pr * bi1 + pi * br1;
          w[q] = pg8::cvt_pk_bf16(v0, v1);
        }
        u32x4* dst = (u32x4*)(BTS + ((size_t)g * 256 + r) * 512 + i * 16);
        dst[0] = (u32x4){w[0], w[1], w[2], w[3]}; dst[1] = (u32x4){w[4], w[5], w[6], w[7]};
      }
    }
    {
      float* KT = (float*)WSP(WS_KT); const float* c_re = INP(20); const float* c_im = INP(21);
      for (int it = gtid; it < 2 * 32 * 32 * 16; it += gsz) {
        const int pp = it & 15, m = (it >> 4) & 31, dg = it >> 9;
        float acc[16];
#pragma unroll
        for (int q = 0; q < 16; ++q) acc[q] = 0.f;
        for (int n = 0; n < 64; ++n) {
          const int sidx = dg * 64 + n;
          const float mag = expf((float)m * ARDT[sidx]), pr = mag * cosf((float)m * AIDT[sidx]), pi = mag * sinf((float)m * AIDT[sidx]);
          const float cr = c_re[(dg * 16 + pp) * 64 + n], ci = c_im[(dg * 16 + pp) * 64 + n];
          const float wr_ = cr * pr - ci * pi, wi_ = cr * pi + ci * pr;
#pragma unroll
          for (int q = 0; q < 16; ++q) acc[q] += wr_ * BBRE[sidx * 16 + q] - wi_ * BBIM[sidx * 16 + q];
        }
#pragma unroll
        for (int q = 0; q < 16; ++q) KT[((size_t)dg * 32 + m) * 256 + pp * 16 + q] = acc[q];
      }
    }
  }
  grid.sync();

  {
    pg8::Gemm g{(const bf16_t*)WSP(WS_XN), (const bf16_t*)WSP(WS_WIN), MX + MC, N_IN, D, D, D};
    InProjSched S; S.init((int)gridDim.x, (int)blockIdx.x);
    EpiInProj E{(bf16_t*)WSP(WS_Q), (bf16_t*)WSP(WS_K), (bf16_t*)WSP(WS_V), (bf16_t*)WSP(WS_SA), (bf16_t*)WSP(WS_G), (const float*)WSP(WS_ROPE)};
    pg8::gemm_phase<EpiInProj, InProjSched, true, true>((PG8_LAS unsigned char*)lds, g, S, E);
  }
  grid.sync();

  {
    const float lam = ((const float*)WSP(WS_LAM))[0];
    const bf16_t* Qb = (const bf16_t*)WSP(WS_Q); const bf16_t* Kb = (const bf16_t*)WSP(WS_K); const bf16_t* Vb = (const bf16_t*)WSP(WS_V);
    bf16_t* ATT = (bf16_t*)WSP(WS_ATT); const float* subln = INP(13);
    for (int unit = blockIdx.x; unit < Bn * 8 * (L / 128); unit += gridDim.x) {
      const int h = unit & 7, qb = (unit >> 3) & 31, b = unit >> 8;
      const size_t qoff = ((size_t)(b * L + qb * 128)) * 1024 + h * 128, koff = (size_t)b * LA * 1024 + h * 128;
      att::diff_attn_unit(Qb + qoff, Kb + koff, Vb + koff, ATT + qoff, LA, lam, subln, (char*)lds);
    }
  }
  grid.sync();

  {
    const bool gemm_blk = (blockIdx.x < 96) || (gridDim.x <= 96);
    if (gemm_blk) {
      pg8::Gemm g{(const bf16_t*)WSP(WS_SA), (const bf16_t*)WSP(WS_BTS), 0, 0, 512, SA_LD, 512};
      GroupSched S; S.init(32, 3, 1, (long)SA_ROWS * SA_LD * 2, (long)256 * SA_LD * 2, (long)256 * 512 * 2, 0, (int)(gridDim.x <= 96 ? gridDim.x : 96), (int)blockIdx.x);
      EpiS E{(float*)WSP(WS_S)};
      pg8::gemm_phase<EpiS, GroupSched, true, true>((PG8_LAS unsigned char*)lds, g, S, E);
    }
    if (!gemm_blk || gridDim.x <= 96) {
      PHASE_LOCALS
      const int wb = gridDim.x <= 96 ? (int)blockIdx.x : (int)blockIdx.x - 96, nwb = gridDim.x <= 96 ? (int)gridDim.x : (int)gridDim.x - 96;
      const float* KT = (const float*)WSP(WS_KT); const float* ARDT = (const float*)WSP(WS_ARDT); const float* AIDT = (const float*)WSP(WS_AIDT);
      const float* c_re = INP(20); const float* c_im = INP(21); const float* dsk = INP(22); bf16_t* BTY = (bf16_t*)WSP(WS_BTY);
      for (int it = wb * NT + tid; it < 32 * 512 * 96; it += nwb * NT) {
        const int cgp = it % 96, row = (it / 96) & 511, g = it / (96 * 512);
        const int j = row >> 4, pp = row & 15, col0 = cgp * 8;
        float v[8];
        if (col0 < 512) {
          const int i = col0 >> 4, q0 = col0 & 15;
#pragma unroll
          for (int e = 0; e < 8; ++e) v[e] = 0.f;
          if (i <= j) { const float* kp = KT + ((size_t)(0 * 32 + g) * 32 + (j - i)) * 256 + pp * 16 + q0;
#pragma unroll
            for (int e = 0; e < 8; ++e) v[e] += kp[e]; }
          if (i >= j) { const float* kp = KT + ((size_t)(1 * 32 + g) * 32 + (i - j)) * 256 + pp * 16 + q0;
#pragma unroll
            for (int e = 0; e < 8; ++e) v[e] += kp[e]; }
          if (i == j && pp >= q0 && pp < q0 + 8) {
#pragma unroll
            for (int e = 0; e < 8; ++e) if (q0 + e == pp) v[e] += dsk[g * 16 + pp];
          }
        } else {
          const int cc0 = col0 - 512, d = cc0 >> 7, n0 = (cc0 & 127) >> 1;
          const float ex = (float)(d == 0 ? j + 1 : 32 - j);
#pragma unroll
          for (int q = 0; q < 4; ++q) {
            const int n = n0 + q, sidx = (d * 32 + g) * 64 + n;
            const float mag = expf(ex * ARDT[sidx]), pr = mag * cosf(ex * AIDT[sidx]), pi = mag * sinf(ex * AIDT[sidx]);
            const float cr = c_re[((d * 32 + g) * 16 + pp) * 64 + n], ci = c_im[((d * 32 + g) * 16 + pp) * 64 + n];
            v[2 * q] = cr * pr - ci * pi; v[2 * q + 1] = -(cr * pi + ci * pr);
          }
        }
        u32x4 w; w.x = pg8::cvt_pk_bf16(v[0], v[1]); w.y = pg8::cvt_pk_bf16(v[2], v[3]); w.z = pg8::cvt_pk_bf16(v[4], v[5]); w.w = pg8::cvt_pk_bf16(v[6], v[7]);
        *(u32x4*)(BTY + ((size_t)g * 512 + row) * 768 + col0) = w;
      }
    }
  }
  grid.sync();

  {
    PHASE_LOCALS
    const float* ARDT = (const float*)WSP(WS_ARDT); const float* AIDT = (const float*)WSP(WS_AIDT);
    if (wid == 0) {
      for (int it = blockIdx.x; it < Bn * 32 * 2; it += gridDim.x) {
        const int d = it & 1, g = (it >> 1) & 31, b = it >> 6;
        const int sidx = (d * 32 + g) * 64 + lane;
        const float mag = expf(32.f * ARDT[sidx]), pr = mag * cosf(32.f * AIDT[sidx]), pi = mag * sinf(32.f * AIDT[sidx]);
        typedef float f32x2_ __attribute__((ext_vector_type(2)));
        const f32x2_* Sg = (const f32x2_*)((const float*)WSP(WS_S) + (size_t)g * SA_ROWS * 256) + d * 64 + lane;
        bf16_t* SAg = (bf16_t*)WSP(WS_SA) + (size_t)g * SA_ROWS * SA_LD + 512 + d * 128 + lane * 2;
        float hr = 0.f, hi = 0.f;
        f32x2_ sc[8];
#pragma unroll
        for (int k = 0; k < 8; ++k) { const int cc = d == 0 ? k : 7 - k; sc[k] = Sg[(size_t)(512 + b * 8 + cc) * 128]; }
#pragma unroll
        for (int k = 0; k < 8; ++k) { const float nr = pr * hr - pi * hi + sc[k][0], ni = pr * hi + pi * hr + sc[k][1]; hr = nr; hi = ni; }
        for (int k0 = 0; k0 < 128; k0 += 16) {
          f32x2_ sv[16];
#pragma unroll
          for (int k = 0; k < 16; ++k) { const int cx = d == 0 ? k0 + k : 127 - (k0 + k); sv[k] = Sg[(size_t)(b * 128 + cx) * 128]; }
#pragma unroll
          for (int k = 0; k < 16; ++k) {
            const int cx = d == 0 ? k0 + k : 127 - (k0 + k);
            *(unsigned*)(SAg + (size_t)(b * 128 + cx) * SA_LD) = pg8::cvt_pk_bf16(hr, hi);
            const float nr = pr * hr - pi * hi + sv[k][0], ni = pr * hi + pi * hr + sv[k][1]; hr = nr; hi = ni;
          }
        }
      }
    }
  }
  grid.sync();

  {
    pg8::Gemm g{(const bf16_t*)WSP(WS_SA), (const bf16_t*)WSP(WS_BTY), 0, 0, 768, SA_LD, 768};
    GroupSched S; S.init(32, 2, 2, (long)SA_ROWS * SA_LD * 2, (long)256 * SA_LD * 2, (long)512 * 768 * 2, (long)256 * 768 * 2, (int)gridDim.x, (int)blockIdx.x);
    EpiY E{(bf16_t*)WSP(WS_YG)};
    pg8::gemm_phase<EpiY, GroupSched, true, true>((PG8_LAS unsigned char*)lds, g, S, E);
  }
  grid.sync();

  {
    pg8::Gemm g{(const bf16_t*)WSP(WS_YG), (const bf16_t*)WSP(WS_WGLU), MX, 512, 512, 512, 512};
    pg8::StaticOrder S; S.init(MX, 512, (int)gridDim.x, (int)blockIdx.x, g.lda, g.ldb);
    EpiBf8<0> E{(bf16_t*)WSP(WS_SSMX), 512, (const bf16_t*)WSP(WS_YG), 512, INP(24)};
    pg8::gemm_phase<EpiBf8<0>, pg8::StaticOrder, true, true>((PG8_LAS unsigned char*)lds, g, S, E);
  }
  grid.sync();

  {
    pg8::Gemm g{(const bf16_t*)WSP(WS_ATT), (const bf16_t*)WSP(WS_WAU), MX, 1024, 1024, 1024, 1024};
    pg8::StaticOrder S; S.init(MX, 1024, (int)gridDim.x, (int)blockIdx.x, g.lda, g.ldb);
    EpiBf8<1> E{(bf16_t*)WSP(WS_M), 1024, (const bf16_t*)WSP(WS_G), 2048, nullptr};
    pg8::gemm_phase<EpiBf8<1>, pg8::StaticOrder, true, true>((PG8_LAS unsigned char*)lds, g, S, E);
  }
  grid.sync();
  {
    pg8::Gemm g{(const bf16_t*)WSP(WS_SSMX), (const bf16_t*)WSP(WS_WSU), MX, 1024, 512, 512, 512};
    pg8::StaticOrder S; S.init(MX, 1024, (int)gridDim.x, (int)blockIdx.x, g.lda, g.ldb);
    EpiBf8<2> E{(bf16_t*)WSP(WS_M), 1024, (const bf16_t*)WSP(WS_G) + 1024, 2048, nullptr};
    pg8::gemm_phase<EpiBf8<2>, pg8::StaticOrder, true, true>((PG8_LAS unsigned char*)lds, g, S, E);
  }
  grid.sync();
  {
    pg8::Gemm g{(const bf16_t*)WSP(WS_M), (const bf16_t*)WSP(WS_WOUT), MX, 1024, 1024, 1024, 1024};
    pg8::StaticOrder S; S.init(MX, 1024, (int)gridDim.x, (int)blockIdx.x, g.lda, g.ldb);
    EpiF32<1> E{(float*)WSP(WS_X1), INP(0), (const float*)WSP(WS_MOD)};
    pg8::gemm_phase<EpiF32<1>, pg8::StaticOrder, true, true>((PG8_LAS unsigned char*)lds, g, S, E);
  }
  grid.sync();
  {
    PHASE_LOCALS
    const float* X1 = (const float*)WSP(WS_X1); const float* MOD = (const float*)WSP(WS_MOD); bf16_t* XN2 = (bf16_t*)WSP(WS_XN2); const float* norm2_g = INP(7);
    for (int row = gw; row < MX; row += ngw) {
      const float* src = X1 + (size_t)row * D; const float* md = MOD + (row / L) * 6144;
      f32x4 v[4]; float ss = 0.f;
#pragma unroll
      for (int j = 0; j < 4; ++j) { v[j] = *(const f32x4*)(src + lane * 4 + 256 * j); ss += v[j][0] * v[j][0] + v[j][1] * v[j][1] + v[j][2] * v[j][2] + v[j][3] * v[j][3]; }
      const float rstd = rsqrtf(wave_sum(ss) * (1.f / D) + 1e-6f);
#pragma unroll
      for (int j = 0; j < 4; ++j)
#pragma unroll
        for (int e = 0; e < 4; ++e) { const int col = lane * 4 + 256 * j + e; XN2[(size_t)row * D + col] = f2bf(v[j][e] * rstd * norm2_g[col] * (1.f + md[4096 + col]) + md[3072 + col]); }
    }
    slice_table(INP(30), (bf16_t*)WSP(WS_U8), gtid, gsz);
    {
      const float* wq = INP(27); const float* sk1 = INP(28); const float* sk2 = INP(29); bf16_t* WC = (bf16_t*)WSP(WS_WC);
      for (int it = gtid; it < 2048 * 128; it += gsz) {
        const int d0 = (it & 127) * 8, n = it >> 7, k = n & 127, s = (n >> 7) & 1, h = n >> 8;
        const float* skr = (s ? sk2 : sk1) + k * 64; const float* wr0 = wq + (size_t)d0 * 1024 + h * 128 + s * 64;
        float a[8];
#pragma unroll
        for (int q = 0; q < 8; ++q) a[q] = 0.f;
        for (int e4 = 0; e4 < 64; e4 += 4) {
          const f32x4 sv = *(const f32x4*)(skr + e4);
#pragma unroll
          for (int q = 0; q < 8; ++q) { const f32x4 wv = *(const f32x4*)(wr0 + (size_t)q * 1024 + e4); a[q] += sv[0] * wv[0] + sv[1] * wv[1] + sv[2] * wv[2] + sv[3] * wv[3]; }
        }
        u32x4 w; w.x = pg8::cvt_pk_bf16(a[0], a[1]); w.y = pg8::cvt_pk_bf16(a[2], a[3]); w.z = pg8::cvt_pk_bf16(a[4], a[5]); w.w = pg8::cvt_pk_bf16(a[6], a[7]);
        *(u32x4*)(WC + (size_t)n * 1024 + d0) = w;
      }
    }
  }
  grid.sync();
  {
    pg8::Gemm g{(const bf16_t*)WSP(WS_XN2), (const bf16_t*)WSP(WS_WC), MX, 2048, 1024, 1024, 1024};
    EpiTopK E{(unsigned short*)WSP(WS_IDX), (float*)WSP(WS_GATE)};
    const int nrounds = (64 * 8 + (int)gridDim.x - 1) / (int)gridDim.x;
    for (int rd = 0; rd < nrounds; ++rd) {
      OneUnitSched S; S.nM = 64; S.nN = 8; S.G = (int)gridDim.x; S.c = (int)blockIdx.x; S.round = rd; S.tsA = (long)256 * 1024 * 2; S.tsB = (long)256 * 1024 * 2;
      pg8::gemm_phase<EpiTopK, OneUnitSched, false, true>((PG8_LAS unsigned char*)lds, g, S, E);
    }
  }
  grid.sync();
  {
    PHASE_LOCALS
    const bf16_t* XN2 = (const bf16_t*)WSP(WS_XN2); const unsigned short* IDX = (const unsigned short*)WSP(WS_IDX);
    bf16_t* PD = (bf16_t*)WSP(WS_PD);
    const bool sl = (gridDim.x & 7) == 0;
    const int j0 = sl ? (int)(blockIdx.x & 7) : 0, nj = sl ? 1 : 8;
    const int wk = sl ? (int)(blockIdx.x >> 3) * 8 + wid : gw, nwk = sl ? (int)(gridDim.x >> 3) * 8 : ngw;
    const int lg = lane >> 4, li = lane & 15;
    unsigned* wl = (unsigned*)lds + wid * 256;
    for (int jj = 0; jj < nj; ++jj) {
      const int j = j0 + jj;
      const bf16_t* U8j = (const bf16_t*)WSP(WS_U8) + (size_t)j * 16384 * 128 + li * 8;
      for (int t = wk; t < MX; t += nwk) {
        const u32x4 xw = *(const u32x4*)(XN2 + (size_t)t * 1024 + j * 128 + li * 8);
        wl[(lane & 3) * 32 + (lane >> 2)] = IDX[(size_t)t * 128 + lane]; wl[(lane & 3) * 32 + 16 + (lane >> 2)] = IDX[(size_t)t * 128 + 64 + lane];
        asm volatile("s_waitcnt lgkmcnt(0)" ::: "memory");
        unsigned ex[32];
#pragma unroll
        for (int q = 0; q < 8; ++q) { const u32x4 v = *(const u32x4*)(wl + lg * 32 + q * 4); ex[q * 4] = v.x; ex[q * 4 + 1] = v.y; ex[q * 4 + 2] = v.z; ex[q * 4 + 3] = v.w; }
        asm volatile("s_waitcnt lgkmcnt(0)" ::: "memory");
        float keep_lo = 0.f, keep_hi = 0.f;
#pragma unroll
        for (int hf = 0; hf < 2; ++hf) {
          u32x4 uw[16];
#pragma unroll
          for (int k = 0; k < 16; ++k) uw[k] = *(const u32x4*)(U8j + (size_t)ex[hf * 16 + k] * 128);
#pragma unroll
          for (int k = 0; k < 16; ++k) {
            float dp = dot2bf(uw[k].x, xw.x, 0.f); dp = dot2bf(uw[k].y, xw.y, dp); dp = dot2bf(uw[k].z, xw.z, dp); dp = dot2bf(uw[k].w, xw.w, dp);
            dp = row16_sum(dp);
            if (li == k) { if (hf == 0) keep_lo = dp; else keep_hi = dp; }
          }
        }
        bf16_t* pd = PD + ((size_t)t * 128 + 4 * li + lg) * 8 + j;
        pd[0] = f2bf(keep_lo); pd[64 * 8] = f2bf(keep_hi);
      }
    }
    slice_table(INP(31), (bf16_t*)WSP(WS_V8), gtid, gsz);
  }
  grid.sync();
  {
    PHASE_LOCALS
    const float* X1 = (const float*)WSP(WS_X1); const float* MOD = (const float*)WSP(WS_MOD);
    const unsigned short* IDX = (const unsigned short*)WSP(WS_IDX); const float* GATE = (const float*)WSP(WS_GATE);
    const bf16_t* PD = (const bf16_t*)WSP(WS_PD); float* SSQ = (float*)WSP(WS_SSQ); float* out = GPTR(float, ldptr_(33));
    const bool sl = (gridDim.x & 7) == 0;
    const int j0 = sl ? (int)(blockIdx.x & 7) : 0, nj = sl ? 1 : 8;
    const int wk = sl ? (int)(blockIdx.x >> 3) * 8 + wid : gw, nwk = sl ? (int)(gridDim.x >> 3) * 8 : ngw;
    const int lg = lane >> 4, li = lane & 15;
    unsigned* wl = (unsigned*)lds + wid * 256;
    for (int jj = 0; jj < nj; ++jj) {
      const int j = j0 + jj;
      const bf16_t* V8j = (const bf16_t*)WSP(WS_V8) + (size_t)j * 16384 * 128 + li * 8;
      for (int t = wk; t < MX; t += nwk) {
        const u32x4 pa = *(const u32x4*)(PD + ((size_t)t * 128 + lane) * 8), pb = *(const u32x4*)(PD + ((size_t)t * 128 + 64 + lane) * 8);
        const float p_lo = ((bflo(pa.x) + bfhi(pa.x)) + (bflo(pa.y) + bfhi(pa.y))) + ((bflo(pa.z) + bfhi(pa.z)) + (bflo(pa.w) + bfhi(pa.w)));
        const float p_hi = ((bflo(pb.x) + bfhi(pb.x)) + (bflo(pb.y) + bfhi(pb.y))) + ((bflo(pb.z) + bfhi(pb.z)) + (bflo(pb.w) + bfhi(pb.w)));
        const float c_lo = GATE[(size_t)t * 128 + lane] * gelu_tanh(p_lo), c_hi = GATE[(size_t)t * 128 + 64 + lane] * gelu_tanh(p_hi);
        const int tp = (lane & 3) * 32 + (lane >> 2);
        wl[tp] = IDX[(size_t)t * 128 + lane]; wl[tp + 16] = IDX[(size_t)t * 128 + 64 + lane];
        wl[128 + tp] = __float_as_uint(c_lo); wl[128 + tp + 16] = __float_as_uint(c_hi);
        asm volatile("s_waitcnt lgkmcnt(0)" ::: "memory");
        unsigned ex[32], cfp[16];
#pragma unroll
        for (int q = 0; q < 8; ++q) {
          const u32x4 v = *(const u32x4*)(wl + lg * 32 + q * 4); ex[q * 4] = v.x; ex[q * 4 + 1] = v.y; ex[q * 4 + 2] = v.z; ex[q * 4 + 3] = v.w;
          const u32x4 c = *(const u32x4*)(wl + 128 + lg * 32 + q * 4);
          cfp[q * 2] = pg8::cvt_pk_bf16(__uint_as_float(c.x), __uint_as_float(c.y)); cfp[q * 2 + 1] = pg8::cvt_pk_bf16(__uint_as_float(c.z), __uint_as_float(c.w));
        }
        asm volatile("s_waitcnt lgkmcnt(0)" ::: "memory");
        float acc[8];
#pragma unroll
        for (int i = 0; i < 8; ++i) acc[i] = 0.f;
#pragma unroll
        for (int hf = 0; hf < 2; ++hf) {
          u32x4 vw[16];
#pragma unroll
          for (int k = 0; k < 16; ++k) vw[k] = *(const u32x4*)(V8j + (size_t)ex[hf * 16 + k] * 128);
#pragma unroll
          for (int kk = 0; kk < 8; ++kk) {
            const u32x4 A = vw[2 * kk], B = vw[2 * kk + 1]; const unsigned cf2 = cfp[hf * 8 + kk];
            acc[0] = dot2bf(__builtin_amdgcn_perm(B.x, A.x, 0x05040100u), cf2, acc[0]); acc[1] = dot2bf(__builtin_amdgcn_perm(B.x, A.x, 0x07060302u), cf2, acc[1]);
            acc[2] = dot2bf(__builtin_amdgcn_perm(B.y, A.y, 0x05040100u), cf2, acc[2]); acc[3] = dot2bf(__builtin_amdgcn_perm(B.y, A.y, 0x07060302u), cf2, acc[3]);
            acc[4] = dot2bf(__builtin_amdgcn_perm(B.z, A.z, 0x05040100u), cf2, acc[4]); acc[5] = dot2bf(__builtin_amdgcn_perm(B.z, A.z, 0x07060302u), cf2, acc[5]);
            acc[6] = dot2bf(__builtin_amdgcn_perm(B.w, A.w, 0x05040100u), cf2, acc[6]); acc[7] = dot2bf(__builtin_amdgcn_perm(B.w, A.w, 0x07060302u), cf2, acc[7]);
          }
        }
#pragma unroll
        for (int i = 0; i < 8; ++i) { acc[i] += __shfl_xor(acc[i], 16); acc[i] += __shfl_xor(acc[i], 32); }
        const int col = j * 128 + li * 8;
        const float* md = MOD + (t >> 12) * 6144 + 5120 + col;
        const f32x4 xa = *(const f32x4*)(X1 + (size_t)t * 1024 + col), xb = *(const f32x4*)(X1 + (size_t)t * 1024 + col + 4);
        const f32x4 ga = *(const f32x4*)md, gb = *(const f32x4*)(md + 4);
        f32x4 oa, ob; float ss = 0.f;
#pragma unroll
        for (int i = 0; i < 4; ++i) { oa[i] = xa[i] + ga[i] * acc[i]; ob[i] = xb[i] + gb[i] * acc[4 + i]; ss += oa[i] * oa[i] + ob[i] * ob[i]; }
        ss = row16_sum(ss);
        if (lg == 0) { *(f32x4*)(out + (size_t)t * 1024 + col) = oa; *(f32x4*)(out + (size_t)t * 1024 + col + 4) = ob; }
        if (lane == 0) SSQ[(size_t)t * 8 + j] = ss;
      }
    }
  }
  grid.sync();
  {
    PHASE_LOCALS
    const float* SSQ = (const float*)WSP(WS_SSQ); const float* fng = INP(32); float* out = GPTR(float, ldptr_(33));
    for (int row = gw; row < MX; row += ngw) {
      const f32x4 sa = *(const f32x4*)(SSQ + (size_t)row * 8), sb = *(const f32x4*)(SSQ + (size_t)row * 8 + 4);
      const float rstd = rsqrtf(((sa[0] + sa[1]) + (sa[2] + sa[3]) + (sb[0] + sb[1]) + (sb[2] + sb[3])) * (1.f / D) + 1e-6f);
#pragma unroll
      for (int jq = 0; jq < 4; ++jq) {
        float* op = out + (size_t)row * D + lane * 4 + 256 * jq;
        const f32x4 v = *(const f32x4*)op, g4 = *(const f32x4*)(fng + lane * 4 + 256 * jq);
        *(f32x4*)op = v * rstd * g4;
      }
    }
  }
}

extern "C" void kernel_launch(void* const* d_in, const int* in_sizes, int n_in, void* d_out, int out_size, void* d_ws, size_t ws_size, hipStream_t stream) {
  static int grid_blocks = 0;
  if (!grid_blocks) {
    int dev = 0, cus = 0, per_cu = 0;
    (void)hipGetDevice(&dev);
    (void)hipDeviceGetAttribute(&cus, hipDeviceAttributeMultiprocessorCount, dev);
    (void)hipFuncSetAttribute((const void*)mega, hipFuncAttributeMaxDynamicSharedMemorySize, LDS_BYTES);
    (void)hipOccupancyMaxActiveBlocksPerMultiprocessor(&per_cu, (const void*)mega, NT, LDS_BYTES);
    if (per_cu < 1) per_cu = 1;
    grid_blocks = cus * per_cu;
    if (n_in != 33 || ws_size < 255 * MiB) { fprintf(stderr, "kernel_launch: unexpected n_in %d / ws %zu\n", n_in, ws_size); }
  }
  Params p{};
  for (int i = 0; i < 33 && i < n_in; ++i) p.in[i] = (const float*)d_in[i];
  p.out = (float*)d_out; p.ws = (unsigned char*)d_ws;
  void* args[] = {&p};
  hipError_t e = hipLaunchCooperativeKernel((const void*)mega, dim3(grid_blocks), dim3(NT), args, LDS_BYTES, stream);
  if (e != hipSuccess) fprintf(stderr, "cooperative launch failed: %s (grid %d)\n", hipGetErrorString(e), grid_blocks);
}
```

```cpp
#include <hip/hip_runtime.h>
#include <hip/hip_cooperative_groups.h>
#include <cstdio>
#include <cstdint>
namespace cg = cooperative_groups;

typedef unsigned short bf16_t;
typedef float f32x4 __attribute__((ext_vector_type(4)));

constexpr int NT = 512;
constexpr int LDS_BYTES = 147456;
constexpr int Bn = 4, L = 4096, D = 1024, NCTX = 256, LA = L + NCTX;
constexpr int MX = Bn * L, MC = Bn * NCTX;
constexpr int N_IN = 5632;
constexpr size_t MiB = 1u << 20;
constexpr size_t WS_MOD = 0, WS_LAM = 128 * 1024, WS_ROPE = 136 * 1024, WS_ARDT = 144 * 1024, WS_AIDT = 160 * 1024;
constexpr size_t WS_ABRE = 192 * 1024, WS_ABIM = 224 * 1024, WS_BBRE = 256 * 1024, WS_BBIM = 512 * 1024;
constexpr size_t WS_KT = 2 * MiB;
constexpr size_t WS_XN = 4 * MiB, WS_Q = 38 * MiB, WS_K = 70 * MiB, WS_V = 104 * MiB, WS_SA = 138 * MiB, WS_G = 164 * MiB;
constexpr size_t WS_WIN = 228 * MiB, WS_WAU = 239 * MiB, WS_WSU = 241 * MiB, WS_WOUT = 242 * MiB, WS_WQ = 244 * MiB, WS_WGLU = 246 * MiB;
constexpr size_t WS_BTS = 247 * MiB;
constexpr size_t WS_BTY = 38 * MiB, WS_S = 62 * MiB, WS_YG = 79 * MiB, WS_SSMX = 95 * MiB, WS_M = 111 * MiB;
constexpr size_t WS_ATT = WS_XN, WS_X1 = 38 * MiB, WS_XN2 = WS_XN, WS_QP = WS_G;
constexpr size_t WS_IDX = 111 * MiB, WS_GATE = 115 * MiB, WS_SSQ = 123 * MiB;
constexpr size_t WS_U8 = 127 * MiB, WS_PD = 164 * MiB, WS_V8 = 196 * MiB, WS_WC = 160 * MiB;
constexpr int SA_ROWS = 544, SA_LD = 768;

constexpr int PTR_OFF = LDS_BYTES - 1024;
__device__ __forceinline__ unsigned long long ldptr_(int k) {
  extern __shared__ __attribute__((aligned(16))) unsigned char lds_[];
  const unsigned long long v = ((const unsigned long long*)(lds_ + PTR_OFF))[k];
  const unsigned lo = __builtin_amdgcn_readfirstlane((unsigned)v), hi = __builtin_amdgcn_readfirstlane((unsigned)(v >> 32));
  return ((unsigned long long)hi << 32) | lo;
}
#define GPTR(T, v) ((T*)(__attribute__((address_space(1))) T*)(v))
#define INP(k) GPTR(const float, ldptr_(k))
#define WSP(off) GPTR(unsigned char, ldptr_(34) + (off))
#define PHASE_LOCALS \
  int tid = threadIdx.x; asm volatile("" : "+v"(tid)); \
  const int lane = tid & 63, wid = tid >> 6; \
  const int gtid = blockIdx.x * NT + tid, gsz = gridDim.x * NT; \
  const int gw = blockIdx.x * (NT / 64) + wid, ngw = gridDim.x * (NT / 64); \
  float* fl = (float*)lds; (void)lane; (void)wid; (void)gtid; (void)gsz; (void)gw; (void)ngw; (void)fl;

struct Params {
  const float* in[33];
  float* out;
  unsigned char* ws;
  int pad0, pad1;
};

__device__ __forceinline__ float bf2f(bf16_t v) { return __uint_as_float(((unsigned)v) << 16); }
__device__ __forceinline__ bf16_t f2bf(float f) { unsigned u = __float_as_uint(f); return (bf16_t)((u + 0x7fffu + ((u >> 16) & 1u)) >> 16); }
__device__ __forceinline__ float wave_sum(float v) {
#pragma unroll
  for (int o = 32; o; o >>= 1) v += __shfl_xor(v, o);
  return v;
}
__device__ __forceinline__ float gelu_tanh(float x) { return 0.5f * x * (1.f + tanhf(0.7978845608028654f * (x + 0.044715f * x * x * x))); }
__device__ __forceinline__ float sigmoidf_(float x) { return 1.f / (1.f + __expf(-x)); }
__device__ __forceinline__ float siluf_(float x) { return x / (1.f + __expf(-x)); }

template <class Epi>
__device__ __forceinline__ void sgemm(const bf16_t* A, int lda, const float* Bm, int ldb, int M, int N, int K, float* lds, Epi epi) {
  constexpr int TM = 128, TN = 128, TK = 16, LDA_S = TM + 4, LDB_S = TN + 4;
  float* As = lds;
  float* Bs = lds + TK * LDA_S;
  const int tid = threadIdx.x, ty = tid >> 4, tx = tid & 15;
  const int ntm = M / TM, ntn = N / TN;
  for (int tile = blockIdx.x; tile < ntm * ntn; tile += gridDim.x) {
    const int tm = tile / ntn, tn = tile % ntn;
    float acc[4][8];
#pragma unroll
    for (int i = 0; i < 4; ++i)
#pragma unroll
      for (int j = 0; j < 8; ++j) acc[i][j] = 0.f;
    const int ar = tid >> 2, ak = (tid & 3) * 4;
    const int bk = tid >> 5, bn = (tid & 31) * 4;
    for (int k0 = 0; k0 < K; k0 += TK) {
      const bf16_t* ap = A + (size_t)(tm * TM + ar) * lda + k0 + ak;
      const unsigned long long av = *(const unsigned long long*)ap;
      const f32x4 bv = *(const f32x4*)(Bm + (size_t)(k0 + bk) * ldb + tn * TN + bn);
      __syncthreads();
      As[(ak + 0) * LDA_S + ar] = bf2f((bf16_t)(av & 0xffff));
      As[(ak + 1) * LDA_S + ar] = bf2f((bf16_t)((av >> 16) & 0xffff));
      As[(ak + 2) * LDA_S + ar] = bf2f((bf16_t)((av >> 32) & 0xffff));
      As[(ak + 3) * LDA_S + ar] = bf2f((bf16_t)((av >> 48) & 0xffff));
      *(f32x4*)(Bs + bk * LDB_S + bn) = bv;
      __syncthreads();
#pragma unroll
      for (int k = 0; k < TK; ++k) {
        const f32x4 a4 = *(const f32x4*)(As + k * LDA_S + ty * 4);
        const f32x4 b0 = *(const f32x4*)(Bs + k * LDB_S + tx * 8);
        const f32x4 b1 = *(const f32x4*)(Bs + k * LDB_S + tx * 8 + 4);
#pragma unroll
        for (int i = 0; i < 4; ++i) {
          acc[i][0] += a4[i] * b0[0]; acc[i][1] += a4[i] * b0[1]; acc[i][2] += a4[i] * b0[2]; acc[i][3] += a4[i] * b0[3];
          acc[i][4] += a4[i] * b1[0]; acc[i][5] += a4[i] * b1[1]; acc[i][6] += a4[i] * b1[2]; acc[i][7] += a4[i] * b1[3];
        }
      }
    }
#pragma unroll
    for (int i = 0; i < 4; ++i)
#pragma unroll
      for (int j = 0; j < 8; ++j) epi(tm * TM + ty * 4 + i, tn * TN + tx * 8 + j, acc[i][j]);
  }
  __syncthreads();
}

namespace pg8 {
#define PG8_LAS __attribute__((address_space(3)))
typedef unsigned short bf16_t;
typedef short bf16x8 __attribute__((ext_vector_type(8)));
typedef float f32x4 __attribute__((ext_vector_type(4)));
typedef unsigned u32x4 __attribute__((ext_vector_type(4)));
constexpr int BM = 256, BK = 64, HALF = 128, HTB = HALF * BK * 2  , STAGE_BYTES = 8 * HTB, NXCD = 8, WGM = 8;

__host__ __device__ __forceinline__ int lds_byte(int r, int c) { const int st = (r >> 4) * 2 + (c >> 5), rr = r & 15, cc = c & 31, ob = rr * 64 + cc * 2; return st * 1024 + (ob ^ (((ob >> 9) & 1) << 5)); }
__host__ __device__ __forceinline__ void stage_rc(int b, int& R, int& C) { const int st = b / 1024, sb = b % 1024, swz = sb ^ (((sb >> 9) & 1) << 5); R = (st >> 1) * 16 + swz / 64; C = (st & 1) * 32 + (swz % 64) / 2; }
__host__ __device__ __forceinline__ int perm32(int rho) { const int n = rho >> 4, i = rho & 15; return 8 * (i >> 2) + 4 * n + (i & 3); }

struct Unit { int pm, pn, grp; long ao, bo; };
struct Gemm { const bf16_t* A; const bf16_t* Bt; int M, N, K, lda, ldb; };

struct StaticOrder {
    int nM, nN, nwg, G, c; long tsA, tsB;
    __host__ __device__ void init(int M, int N, int G_, int c_, int lda, int ldb) { nM = M / BM; nN = N / BM; nwg = nM * nN; G = G_; c = c_; tsA = (long)BM * lda * 2; tsB = (long)BM * ldb * 2; }
    __host__ __device__ bool next(int i, Unit& u) const {
        const long L = (long)i * G + c; if (L >= nwg) return false;
        int wgid = (int)L; { const int q = nwg / NXCD, r = nwg % NXCD, xcd = wgid % NXCD, off = wgid / NXCD; wgid = (xcd < r ? xcd * (q + 1) : r * (q + 1) + (xcd - r) * q) + off; }
        const int nig = WGM * nN, gid = wgid / nig, fm = gid * WGM, gsz = (nM - fm) < WGM ? (nM - fm) : WGM;
        u.pm = fm + ((wgid % nig) % gsz); u.pn = (wgid % nig) / gsz; u.grp = 0; u.ao = u.pm * tsA; u.bo = u.pn * tsB; return true;
    }
    __device__ __forceinline__ void a_ready(const Unit&) const {}
    __device__ __forceinline__ void done(const Unit&) const {}
};

__device__ __forceinline__ unsigned cvt_pk_bf16(float lo, float hi) { unsigned r; asm volatile("v_cvt_pk_bf16_f32 %0, %1, %2" : "=v"(r) : "v"(lo), "v"(hi)); return r; }
template <class Epi, class Sched, bool ALIGN_EPI = false, bool SP2 = false>
__device__ __forceinline__ void gemm_phase(PG8_LAS unsigned char* lds, const Gemm g, const Sched& S, const Epi& E) {
    int tid_ = threadIdx.x; asm volatile("" : "+v"(tid_));
    const int tid = tid_, wid = __builtin_amdgcn_readfirstlane(tid >> 6), lane = tid & 63, wr = wid >> 2, wc = wid & 3, fr = lane & 15, fq = lane >> 4;
    const int K = g.K, nt = K / BK;
    unsigned voffA[2], voffB[2];
#pragma unroll
    for (int i = 0; i < 2; ++i) { int R, C; stage_rc(tid * 16 + i * 8192, R, C); const int Rb = Epi::PERM ? ((R & ~31) + perm32(R & 31)) : R;
        voffA[i] = (unsigned)(R * g.lda + C) * 2u; voffB[i] = (unsigned)(Rb * g.ldb + C) * 2u; }
    const size_t kstep = (size_t)(BK * 2);
    const size_t hstepA = (size_t)HALF * g.lda * 2, hstepB = (size_t)HALF * g.ldb * 2;
    const unsigned ldsw = (unsigned)wid * 1024u;
    const int aoff = lds_byte(wr * 64 + fr, fq * 8), boff = lds_byte(wc * 32 + fr, fq * 8);
#define PG8_SA(b, h) (((b) * 2 + (h)) * HTB)
#define PG8_SB(b, h) ((4 + (b) * 2 + (h)) * HTB)
#define PG8_STAGE(bufoff, gbase, voff) do { _Pragma("unroll") for (int _i = 0; _i < 2; ++_i) \
        __builtin_amdgcn_global_load_lds((const unsigned*)((const char*)(gbase) + (voff)[_i]), (PG8_LAS unsigned*)(lds + (bufoff) + ldsw + _i * 8192), 16, 0, 0); } while (0)
#define PG8_LDA(dst, b, h) do { _Pragma("unroll") for (int m = 0; m < 4; ++m) _Pragma("unroll") for (int k = 0; k < 2; ++k) dst[m][k] = *(const PG8_LAS bf16x8*)(lds + PG8_SA(b, h) + aoff + m * 2048 + k * 1024); } while (0)
#define PG8_LDB(dst, b, h) do { _Pragma("unroll") for (int n = 0; n < 2; ++n) _Pragma("unroll") for (int k = 0; k < 2; ++k) dst[n][k] = *(const PG8_LAS bf16x8*)(lds + PG8_SB(b, h) + boff + n * 2048 + k * 1024); } while (0)
#define PG8_MMA(ai, bj, At, Bt) do { __builtin_amdgcn_s_setprio(1); _Pragma("unroll") for (int m = 0; m < 4; ++m) _Pragma("unroll") for (int n = 0; n < 2; ++n) _Pragma("unroll") for (int k = 0; k < 2; ++k) \
        acc[ai][bj][m][n] = __builtin_amdgcn_mfma_f32_16x16x32_bf16(Bt[n][k], At[m][k], acc[ai][bj][m][n], 0, 0, 0); __builtin_amdgcn_s_setprio(0); } while (0)
#define PG8_WAIT_V(n) asm volatile("s_waitcnt vmcnt(" #n ")" ::: "memory")
#define PG8_WAIT_L(n) asm volatile("s_waitcnt lgkmcnt(" #n ")" ::: "memory")
#define PG8_BAR __builtin_amdgcn_s_barrier()
#define PG8_SCHED __builtin_amdgcn_sched_barrier(0)
    Unit cur, nxt; int ui = 0;
    if (!S.next(0, cur)) return;
    f32x4 acc[2][2][4][2];
#pragma unroll
    for (int a = 0; a < 2; ++a)
#pragma unroll
        for (int b = 0; b < 2; ++b)
#pragma unroll
            for (int m = 0; m < 4; ++m)
#pragma unroll
                for (int n = 0; n < 2; ++n) acc[a][b][m][n] = (f32x4){0.f, 0.f, 0.f, 0.f};
    bf16x8 At[4][2], B0[2][2], B1[2][2];
    const char* cA = (const char*)g.A + cur.ao; const char* cB = (const char*)g.Bt + cur.bo;
    S.a_ready(cur);
    if constexpr (SP2) {
        PG8_STAGE(PG8_SB(0, 0), cB, voffB); PG8_STAGE(PG8_SB(0, 1), cB + hstepB, voffB); PG8_STAGE(PG8_SA(0, 0), cA, voffA); PG8_STAGE(PG8_SA(0, 1), cA + hstepA, voffA);
        if (wr == 1) PG8_BAR;
        PG8_WAIT_V(2); PG8_BAR;
        PG8_STAGE(PG8_SB(1, 0), cB + kstep, voffB); PG8_STAGE(PG8_SA(1, 0), cA + kstep, voffA); PG8_STAGE(PG8_SB(1, 1), cB + hstepB + kstep, voffB);
        PG8_WAIT_V(6); PG8_BAR;
    } else {
        PG8_STAGE(PG8_SB(0, 0), cB, voffB); PG8_STAGE(PG8_SA(0, 0), cA, voffA); PG8_STAGE(PG8_SB(0, 1), cB + hstepB, voffB); PG8_STAGE(PG8_SA(0, 1), cA + hstepA, voffA);
        if (wr == 1) PG8_BAR;
        PG8_WAIT_V(4); PG8_BAR;
        PG8_STAGE(PG8_SB(1, 0), cB + kstep, voffB); PG8_STAGE(PG8_SA(1, 0), cA + kstep, voffA); PG8_STAGE(PG8_SB(1, 1), cB + hstepB + kstep, voffB);
        PG8_WAIT_V(6); PG8_BAR;
    }
    for (;;) {
        const bool has_next = S.next(ui + 1, nxt);
        const char* nA = has_next ? (const char*)g.A + nxt.ao : cA; const char* nB = has_next ? (const char*)g.Bt + nxt.bo : cB;
        for (int t = 0; t < nt; t += 2) {
            const bool last = (t == nt - 2);
            const char* a1 = cA + (size_t)(t + 1) * kstep;
            const char* a2 = last ? nA : cA + (size_t)(t + 2) * kstep; const char* b2 = last ? nB : cB + (size_t)(t + 2) * kstep;
            const char* a3 = a2 + kstep; const char* b3 = b2 + kstep;
            if (last && has_next) S.a_ready(nxt);
            if constexpr (SP2) {
            PG8_LDB(B0, 0, 0); PG8_LDB(B1, 0, 1); PG8_SCHED; PG8_LDA(At, 0, 0); PG8_STAGE(PG8_SA(1, 1), a1 + hstepA, voffA);
            PG8_WAIT_V(8); PG8_WAIT_L(0); PG8_BAR; PG8_MMA(0, 0, At, B0); PG8_MMA(0, 1, At, B1); PG8_BAR; PG8_SCHED;
            PG8_LDA(At, 0, 1); PG8_STAGE(PG8_SB(0, 0), b2, voffB); PG8_STAGE(PG8_SB(0, 1), b2 + hstepB, voffB); PG8_STAGE(PG8_SA(0, 0), a2, voffA);
            PG8_WAIT_V(8); PG8_WAIT_L(0); PG8_BAR; PG8_MMA(1, 0, At, B0); PG8_MMA(1, 1, At, B1); PG8_BAR; PG8_SCHED;
            PG8_LDB(B0, 1, 0); PG8_LDB(B1, 1, 1); PG8_SCHED; PG8_LDA(At, 1, 0); PG8_STAGE(PG8_SA(0, 1), a2 + hstepA, voffA);
            PG8_WAIT_V(8); PG8_WAIT_L(0); PG8_BAR; PG8_MMA(0, 0, At, B0); PG8_MMA(0, 1, At, B1); PG8_BAR; PG8_SCHED;
            PG8_LDA(At, 1, 1); PG8_STAGE(PG8_SB(1, 0), b3, voffB); PG8_STAGE(PG8_SB(1, 1), b3 + hstepB, voffB); PG8_STAGE(PG8_SA(1, 0), a3, voffA);
            PG8_WAIT_V(8); PG8_WAIT_L(0); PG8_BAR; PG8_MMA(1, 0, At, B0); PG8_MMA(1, 1, At, B1); PG8_BAR; PG8_SCHED;
            } else {
            PG8_LDB(B0, 0, 0); PG8_SCHED; PG8_LDA(At, 0, 0); PG8_STAGE(PG8_SA(1, 1), a1 + hstepA, voffA);
            PG8_WAIT_L(8); PG8_BAR; PG8_WAIT_L(0); PG8_MMA(0, 0, At, B0); PG8_BAR; PG8_SCHED;
            PG8_LDB(B1, 0, 1); PG8_STAGE(PG8_SB(0, 0), b2, voffB);
            PG8_BAR; PG8_WAIT_L(0); PG8_MMA(0, 1, At, B1); PG8_BAR;
            PG8_LDA(At, 0, 1); PG8_STAGE(PG8_SA(0, 0), a2, voffA);
            PG8_BAR; PG8_WAIT_L(0); PG8_MMA(1, 0, At, B0); PG8_BAR; PG8_SCHED;
            PG8_STAGE(PG8_SB(0, 1), b2 + hstepB, voffB);
            PG8_WAIT_V(6); PG8_BAR; PG8_MMA(1, 1, At, B1); PG8_BAR;
            PG8_LDB(B0, 1, 0); PG8_SCHED; PG8_LDA(At, 1, 0); PG8_STAGE(PG8_SA(0, 1), a2 + hstepA, voffA);
            PG8_WAIT_L(8); PG8_BAR; PG8_WAIT_L(0); PG8_MMA(0, 0, At, B0); PG8_BAR; PG8_SCHED;
            PG8_LDB(B1, 1, 1); PG8_STAGE(PG8_SB(1, 0), b3, voffB);
            PG8_BAR; PG8_WAIT_L(0); PG8_MMA(0, 1, At, B1); PG8_BAR;
            PG8_LDA(At, 1, 1); PG8_STAGE(PG8_SA(1, 0), a3, voffA);
            PG8_BAR; PG8_WAIT_L(0); PG8_MMA(1, 0, At, B0); PG8_BAR; PG8_SCHED;
            PG8_STAGE(PG8_SB(1, 1), b3 + hstepB, voffB);
            PG8_WAIT_V(6); PG8_BAR; PG8_MMA(1, 1, At, B1); PG8_BAR;
            }
        }
        if constexpr (ALIGN_EPI) { if (wr == 0) PG8_BAR; }
        if constexpr (!Epi::AFTER_DRAIN) { int fr_ = fr, fq_ = fq; asm volatile("" : "+v"(fr_), "+v"(fq_));
            E(acc, cur, wr, wc, fr_, fq_); S.done(cur); }
        if (!has_next) break;
#pragma unroll
        for (int a = 0; a < 2; ++a)
#pragma unroll
            for (int b = 0; b < 2; ++b)
#pragma unroll
                for (int m = 0; m < 4; ++m)
#pragma unroll
                    for (int n = 0; n < 2; ++n) acc[a][b][m][n] = (f32x4){0.f, 0.f, 0.f, 0.f};
        cur = nxt; cA = nA; cB = nB; ++ui;
        if constexpr (ALIGN_EPI) { if (wr == 1) PG8_BAR; }
    }
    PG8_WAIT_V(0);
    if constexpr (!ALIGN_EPI) { if (wr == 0) PG8_BAR; }
    PG8_BAR;
    if constexpr (Epi::AFTER_DRAIN) { int fr_ = fr, fq_ = fq, lane_ = lane; asm volatile("" : "+v"(fr_), "+v"(fq_), "+v"(lane_)); E.fused(acc, cur, wr, wc, fr_, fq_, lds, wid, lane_); S.done(cur); }
#undef PG8_SA
#undef PG8_SB
#undef PG8_STAGE
#undef PG8_LDA
#undef PG8_LDB
#undef PG8_MMA
#undef PG8_WAIT_V
#undef PG8_WAIT_L
#undef PG8_BAR
#undef PG8_SCHED
}
}


using pg8::Unit;
typedef unsigned u32x2 __attribute__((ext_vector_type(2)));
typedef unsigned u32x4 __attribute__((ext_vector_type(4)));
__device__ __forceinline__ float bflo(unsigned w) { return __uint_as_float(w << 16); }
__device__ __forceinline__ float bfhi(unsigned w) { return __uint_as_float(w & 0xffff0000u); }

struct InProjSched {
  pg8::StaticOrder so;
  __device__ __forceinline__ void init(int G, int c) { so.init(MX, N_IN, G, c, D, D); }
  __device__ __forceinline__ bool next(int i, Unit& u) const {
    const long Lx = (long)i * so.G + so.c;
    if (Lx < so.nwg) return so.next(i, u);
    const int j = (int)(Lx - so.nwg); if (j >= 40) return false;
    u.pm = 64 + (j & 3); u.pn = 4 + (j >> 2); u.grp = 0; u.ao = u.pm * so.tsA; u.bo = u.pn * so.tsB; return true;
  }
  __device__ __forceinline__ void a_ready(const Unit&) const {}
  __device__ __forceinline__ void done(const Unit&) const {}
};

struct EpiInProj {
  static constexpr bool PERM = false, AFTER_DRAIN = false;
  bf16_t *Q, *K, *V, *SA, *G; const float* rope;
  __device__ __forceinline__ static void st4(bf16_t* p, const f32x4 v) { u32x2 w; w.x = pg8::cvt_pk_bf16(v[0], v[1]); w.y = pg8::cvt_pk_bf16(v[2], v[3]); *(u32x2*)p = w; }
  __device__ __forceinline__ void operator()(const f32x4 (&acc)[2][2][4][2], const Unit& u, int wr, int wc, int fr, int fq) const {
    const int row0 = u.pm * 256 + wr * 64 + fr;
    const int cg0 = u.pn * 256 + wc * 32 + fq * 4;
    if (u.pm < 64) {
      if (u.pn < 8) {
        const bool isq = u.pn < 4;
#pragma unroll
        for (int ai = 0; ai < 2; ++ai)
#pragma unroll
          for (int m = 0; m < 4; ++m) {
            const int row = row0 + ai * 128 + m * 16, b = row >> 12, t = row & 4095;
            const int pos = (wc & 1) ? (t & 63) : (t >> 6);
            const f32x4* rp = (const f32x4*)(rope + (pos * 16 + fq * 4) * 2);
            const f32x4 r0 = rp[0], r1 = rp[1];
            const f32x4 cs = {r0[0], r0[2], r1[0], r1[2]}, sn = {r0[1], r0[3], r1[1], r1[3]};
            bf16_t* dst = isq ? Q + (size_t)row * 1024 + cg0 : K + ((size_t)b * LA + NCTX + t) * 1024 + (cg0 - 1024);
#pragma unroll
            for (int bj = 0; bj < 2; ++bj) {
              const f32x4 h1 = acc[ai][bj][m][0], h2 = acc[ai][bj][m][1];
              st4(dst + bj * 128, h1 * cs - h2 * sn);
              st4(dst + bj * 128 + 16, h2 * cs + h1 * sn);
            }
          }
      } else {
#pragma unroll
        for (int ai = 0; ai < 2; ++ai)
#pragma unroll
          for (int m = 0; m < 4; ++m) {
            const int row = row0 + ai * 128 + m * 16, b = row >> 12, t = row & 4095;
            const size_t kr = (size_t)b * LA + NCTX + t;
            if (u.pn >= 12 && u.pn < 14) {
#pragma unroll
              for (int bj = 0; bj < 2; ++bj)
#pragma unroll
                for (int n = 0; n < 2; ++n) {
                  const int ch = cg0 + bj * 128 + n * 16 - 3072;
                  st4(SA + ((size_t)(ch >> 4) * SA_ROWS + b * 128 + (t >> 5)) * SA_LD + (t & 31) * 16 + (ch & 15), acc[ai][bj][m][n]);
                }
            } else {
              bf16_t* dst = u.pn < 12 ? V + kr * 1024 + (cg0 - 2048) : G + (size_t)row * 2048 + (cg0 - 3584);
#pragma unroll
              for (int bj = 0; bj < 2; ++bj)
#pragma unroll
                for (int n = 0; n < 2; ++n) {
                  f32x4 v = acc[ai][bj][m][n];
                  if (u.pn >= 14) { v[0] = sigmoidf_(v[0]); v[1] = sigmoidf_(v[1]); v[2] = sigmoidf_(v[2]); v[3] = sigmoidf_(v[3]); }
                  st4(dst + bj * 128 + n * 16, v);
                }
            }
          }
      }
    } else {
#pragma unroll
      for (int ai = 0; ai < 2; ++ai)
#pragma unroll
        for (int m = 0; m < 4; ++m) {
          const int rc = row0 + ai * 128 + m * 16 - MX, b = rc >> 8, t = rc & 255;
          const size_t kr = (size_t)b * LA + t;
          if (u.pn >= 12) {
#pragma unroll
            for (int bj = 0; bj < 2; ++bj)
#pragma unroll
              for (int n = 0; n < 2; ++n) {
                const int ch = cg0 + bj * 128 + n * 16 - 3072;
                st4(SA + ((size_t)(ch >> 4) * SA_ROWS + 512 + b * 8 + (t >> 5)) * SA_LD + (t & 31) * 16 + (ch & 15), acc[ai][bj][m][n]);
              }
          } else {
            bf16_t* dst = u.pn < 8 ? K + kr * 1024 + (cg0 - 1024) : V + kr * 1024 + (cg0 - 2048);
#pragma unroll
            for (int bj = 0; bj < 2; ++bj)
#pragma unroll
              for (int n = 0; n < 2; ++n) st4(dst + bj * 128 + n * 16, acc[ai][bj][m][n]);
          }
        }
    }
  }
};
template <int MODE>
struct EpiBf8 {
  static constexpr bool PERM = true, AFTER_DRAIN = false;
  bf16_t* O; int ldo; const bf16_t* X; int ldx; const float* bias;
  __device__ __forceinline__ void operator()(const f32x4 (&acc)[2][2][4][2], const Unit& u, int wr, int wc, int fr, int fq) const {
    const int row0 = u.pm * 256 + wr * 64 + fr, col0 = u.pn * 256 + wc * 32 + 8 * fq;
#pragma unroll
    for (int ai = 0; ai < 2; ++ai)
#pragma unroll
      for (int m = 0; m < 4; ++m) {
        const int row = row0 + ai * 128 + m * 16;
#pragma unroll
        for (int bj = 0; bj < 2; ++bj) {
          const int col = col0 + bj * 128;
          f32x4 v0 = acc[ai][bj][m][0], v1 = acc[ai][bj][m][1];
          const u32x4 xw = *(const u32x4*)(X + (size_t)row * ldx + col);
          const f32x4 x0 = {bflo(xw.x), bfhi(xw.x), bflo(xw.y), bfhi(xw.y)}, x1 = {bflo(xw.z), bfhi(xw.z), bflo(xw.w), bfhi(xw.w)};
          if (MODE == 0) {
            const f32x4 b0 = *(const f32x4*)(bias + col), b1 = *(const f32x4*)(bias + col + 4);
#pragma unroll
            for (int i = 0; i < 4; ++i) { v0[i] = x0[i] * sigmoidf_(v0[i] + b0[i]); v1[i] = x1[i] * sigmoidf_(v1[i] + b1[i]); }
          } else if (MODE == 1) { v0 = v0 * x0; v1 = v1 * x1; }
          else {
            const u32x4 ow = *(const u32x4*)(O + (size_t)row * ldo + col);
            const f32x4 o0 = {bflo(ow.x), bfhi(ow.x), bflo(ow.y), bfhi(ow.y)}, o1 = {bflo(ow.z), bfhi(ow.z), bflo(ow.w), bfhi(ow.w)};
            v0 = o0 + v0 * x0; v1 = o1 + v1 * x1;
          }
          u32x4 w; w.x = pg8::cvt_pk_bf16(v0[0], v0[1]); w.y = pg8::cvt_pk_bf16(v0[2], v0[3]); w.z = pg8::cvt_pk_bf16(v1[0], v1[1]); w.w = pg8::cvt_pk_bf16(v1[2], v1[3]);
          *(u32x4*)(O + (size_t)row * ldo + col) = w;
        }
      }
  }
};
template <int MODE>
struct EpiF32 {
  static constexpr bool PERM = false, AFTER_DRAIN = false;
  float* O; const float* xres; const float* mod;
  __device__ __forceinline__ void operator()(const f32x4 (&acc)[2][2][4][2], const Unit& u, int wr, int wc, int fr, int fq) const {
    const int row0 = u.pm * 256 + wr * 64 + fr, col0 = u.pn * 256 + wc * 32 + 4 * fq;
#pragma unroll
    for (int ai = 0; ai < 2; ++ai)
#pragma unroll
      for (int m = 0; m < 4; ++m) {
        const int row = row0 + ai * 128 + m * 16;
#pragma unroll
        for (int bj = 0; bj < 2; ++bj)
#pragma unroll
          for (int n = 0; n < 2; ++n) {
            const int col = col0 + bj * 128 + n * 16;
            f32x4 v = acc[ai][bj][m][n];
            if (MODE == 1) { const f32x4 xr = *(const f32x4*)(xres + (size_t)row * 1024 + col); const f32x4 g = *(const f32x4*)(mod + (row >> 12) * 6144 + 2048 + col); v = xr + g * v; }
            *(f32x4*)(O + (size_t)row * 1024 + col) = v;
          }
      }
  }
};


struct GroupSched {
  int npm, npn, nunits, G, c; long gsA, gsB, tsA, tsB;
  __device__ __forceinline__ void init(int ngrp, int npm_, int npn_, long gsA_, long tsA_, long gsB_, long tsB_, int G_, int c_) { npm = npm_; npn = npn_; nunits = ngrp * npm_ * npn_; gsA = gsA_; tsA = tsA_; gsB = gsB_; tsB = tsB_; G = G_; c = c_; }
  __device__ __forceinline__ bool next(int i, Unit& u) const {
    const long Lx = (long)i * G + c; if (Lx >= nunits) return false;
    const int per = npm * npn, grp = (int)Lx / per, r = (int)Lx % per;
    u.grp = grp; u.pm = r / npn; u.pn = r % npn; u.ao = grp * gsA + u.pm * tsA; u.bo = grp * gsB + u.pn * tsB; return true;
  }
  __device__ __forceinline__ void a_ready(const Unit&) const {}
  __device__ __forceinline__ void done(const Unit&) const {}
};
struct EpiS {
  static constexpr bool PERM = false, AFTER_DRAIN = false;
  float* S;
  __device__ __forceinline__ void operator()(const f32x4 (&acc)[2][2][4][2], const Unit& u, int wr, int wc, int fr, int fq) const {
    const int row0 = u.pm * 256 + wr * 64 + fr, col0 = wc * 32 + 4 * fq;
#pragma unroll
    for (int ai = 0; ai < 2; ++ai)
#pragma unroll
      for (int m = 0; m < 4; ++m) {
        const int row = row0 + ai * 128 + m * 16;
        if (row < SA_ROWS) {
#pragma unroll
          for (int bj = 0; bj < 2; ++bj)
#pragma unroll
            for (int n = 0; n < 2; ++n) *(f32x4*)(S + ((size_t)u.grp * SA_ROWS + row) * 256 + col0 + bj * 128 + n * 16) = acc[ai][bj][m][n];
        }
      }
  }
};
struct EpiY {
  static constexpr bool PERM = true, AFTER_DRAIN = false;
  bf16_t* YG;
  __device__ __forceinline__ void operator()(const f32x4 (&acc)[2][2][4][2], const Unit& u, int wr, int wc, int fr, int fq) const {
    const int row0 = u.pm * 256 + wr * 64 + fr, col0 = u.pn * 256 + wc * 32 + 8 * fq;
#pragma unroll
    for (int ai = 0; ai < 2; ++ai)
#pragma unroll
      for (int m = 0; m < 4; ++m) {
        const int row = row0 + ai * 128 + m * 16, b = row >> 7, cx = row & 127;
#pragma unroll
        for (int bj = 0; bj < 2; ++bj) {
          const int col = col0 + bj * 128, j = col >> 4, p0 = col & 15;
          const f32x4 v0 = acc[ai][bj][m][0], v1 = acc[ai][bj][m][1];
          u32x4 w; w.x = pg8::cvt_pk_bf16(gelu_tanh(v0[0]), gelu_tanh(v0[1])); w.y = pg8::cvt_pk_bf16(gelu_tanh(v0[2]), gelu_tanh(v0[3]));
          w.z = pg8::cvt_pk_bf16(gelu_tanh(v1[0]), gelu_tanh(v1[1])); w.w = pg8::cvt_pk_bf16(gelu_tanh(v1[2]), gelu_tanh(v1[3]));
          *(u32x4*)(YG + ((size_t)(b * L + cx * 32 + j)) * 512 + u.grp * 16 + p0) = w;
        }
      }
  }
};


__device__ __forceinline__ unsigned f2key(float s) { const unsigned u = __float_as_uint(s); return u ^ ((u & 0x80000000u) ? 0xFFFFFFFFu : 0x80000000u); }
__device__ __forceinline__ float key2f(unsigned k) { return __uint_as_float(k ^ ((k & 0x80000000u) ? 0x80000000u : 0xFFFFFFFFu)); }
#define TK_INSERT(L, cv) do { _Pragma("unroll") for (int k_ = 0; k_ < 16; ++k_) { const unsigned hi_ = L[k_] > cv ? L[k_] : cv, lo_ = L[k_] > cv ? cv : L[k_]; L[k_] = hi_; cv = lo_; } } while (0)
struct EpiTopK {
  static constexpr bool PERM = false, AFTER_DRAIN = true;
  unsigned short* IDX; float* GATE;
  __device__ __forceinline__ void fused(f32x4 (&acc)[2][2][4][2], const Unit& u, int wr, int wc, int fr, int fq, PG8_LAS unsigned char* lds, int wid, int lane) const {
    PG8_LAS float* SC = (PG8_LAS float*)lds;
    const int tid = wid * 64 + lane;
#pragma unroll
    for (int ai = 0; ai < 2; ++ai) {
#pragma unroll
      for (int m = 0; m < 4; ++m)
#pragma unroll
        for (int bj = 0; bj < 2; ++bj)
#pragma unroll
          for (int n = 0; n < 2; ++n)
#pragma unroll
            for (int i = 0; i < 4; ++i) SC[(64 * wr + 16 * m + fr) * 257 + 128 * bj + 32 * wc + 16 * n + 4 * fq + i] = acc[ai][bj][m][n][i];
      asm volatile("s_waitcnt lgkmcnt(0)" ::: "memory"); __builtin_amdgcn_s_barrier(); asm volatile("" ::: "memory");
      if (tid < 256) {
        PG8_LAS float* rowp = SC + (tid & 127) * 257 + (tid >> 7) * 128;
        unsigned Lk[16];
#pragma unroll
        for (int k = 0; k < 16; ++k) Lk[k] = 0u;
        for (int k = 0; k < 128; ++k) { unsigned cv = (f2key(rowp[k]) & ~0x7Fu) | (unsigned)(127 - k); TK_INSERT(Lk, cv); }
#pragma unroll
        for (int k = 0; k < 16; ++k) rowp[k] = __uint_as_float(Lk[k]);
      }
      asm volatile("s_waitcnt lgkmcnt(0)" ::: "memory"); __builtin_amdgcn_s_barrier(); asm volatile("" ::: "memory");
      if (tid < 128) {
        PG8_LAS float* rowp = SC + tid * 257;
        float v1[16], v2[16];
#pragma unroll
        for (int k = 0; k < 16; ++k) { v1[k] = key2f(__float_as_uint(rowp[k]) & ~0x7Fu); v2[k] = key2f(__float_as_uint(rowp[128 + k]) & ~0x7Fu); }
        unsigned Lc[16];
#pragma unroll
        for (int k = 0; k < 16; ++k) Lc[k] = 0u;
#pragma unroll
        for (int a = 0; a < 16; ++a)
#pragma unroll
          for (int b = 0; b < 16; ++b)
            if ((a + 1) * (b + 1) <= 16) { unsigned cv = (f2key(v1[a] + v2[b]) & ~0xFFu) | (unsigned)(255 - (a * 16 + b)); TK_INSERT(Lc, cv); }
        float ev[16]; float den = 0.f; const float mx = key2f(Lc[0] & ~0xFFu);
#pragma unroll
        for (int k = 0; k < 16; ++k) { ev[k] = __expf(key2f(Lc[k] & ~0xFFu) - mx); den += ev[k]; }
        const float inv = 1.f / den;
        const size_t o = ((size_t)(u.pm * 256 + ai * 128 + tid) * 8 + u.pn) * 16;
        unsigned iw[8];
#pragma unroll
        for (int k = 0; k < 16; ++k) {
          const int code = 255 - (int)(Lc[k] & 0xFFu), a = code >> 4, b = code & 15;
          const unsigned e1 = 127u - (__float_as_uint(rowp[a]) & 0x7Fu), e2 = 127u - (__float_as_uint(rowp[128 + b]) & 0x7Fu);
          const unsigned ex = e1 * 128u + e2;
          if (k & 1) iw[k >> 1] |= ex << 16; else iw[k >> 1] = ex;
        }
        *(u32x4*)(IDX + o) = (u32x4){iw[0], iw[1], iw[2], iw[3]}; *(u32x4*)(IDX + o + 8) = (u32x4){iw[4], iw[5], iw[6], iw[7]};
#pragma unroll
        for (int k = 0; k < 16; k += 4) *(f32x4*)(GATE + o + k) = (f32x4){ev[k] * inv, ev[k + 1] * inv, ev[k + 2] * inv, ev[k + 3] * inv};
      }
      asm volatile("s_waitcnt lgkmcnt(0)" ::: "memory"); __builtin_amdgcn_s_barrier(); asm volatile("" ::: "memory");
    }
  }
};
struct OneUnitSched {
  int nM, nN, G, c, round; long tsA, tsB;
  __device__ __forceinline__ bool next(int i, Unit& u) const {
    if (i > 0) return false;
    const long Lx = (long)round * G + c; if (Lx >= (long)nM * nN) return false;
    u.pm = (int)(Lx % nM); u.pn = (int)(Lx / nM); u.grp = 0; u.ao = u.pm * tsA; u.bo = u.pn * tsB; return true;
  }
  __device__ __forceinline__ void a_ready(const Unit&) const {}
  __device__ __forceinline__ void done(const Unit&) const {}
};

__device__ __forceinline__ void transpose_item(const float* W, int K, int N, bf16_t* WT, float* scr, int item, int lane) {
  const int nblk = N / 32, kb = item / nblk, nb = item % nblk, k0 = 64 * kb, n0 = 32 * nb;
#pragma unroll 8
  for (int i = 0; i < 32; ++i) { const int kk = 2 * i + (lane >> 5); scr[kk * 33 + (lane & 31)] = W[(size_t)(k0 + kk) * N + n0 + (lane & 31)]; }
  asm volatile("s_waitcnt lgkmcnt(0)" ::: "memory");
  const int c = lane & 7;
#pragma unroll
  for (int j = 0; j < 4; ++j) {
    const int n = (lane >> 3) + 8 * j; const float* s = scr + (8 * c) * 33 + n;
    u32x4 o; o.x = pg8::cvt_pk_bf16(s[0], s[33]); o.y = pg8::cvt_pk_bf16(s[66], s[99]); o.z = pg8::cvt_pk_bf16(s[132], s[165]); o.w = pg8::cvt_pk_bf16(s[198], s[231]);
    *(u32x4*)(WT + (size_t)(n0 + n) * K + k0 + 8 * c) = o;
  }
  asm volatile("s_waitcnt lgkmcnt(0)" ::: "memory");
}

namespace att {
using bf16 = unsigned short;
constexpr int   D = 128, NW = 8, QBLK = 32, KVBLK = 64, SDEPTH = 2;
constexpr float SCALE = 0.125f;
constexpr float THR = 8.f;
constexpr int LDQ = 1024, LDK = 1024, LDO = 1024;
constexpr size_t SHM_V = KVBLK * D * 2, SHM_K = KVBLK * D * 2, SHM_ATTN = 2 * SHM_V + 2 * SHM_K + NW * 64 * 4 + 4 * 4 * 16 * 64 * 4;
using bf16x8 = __attribute__((ext_vector_type(8))) short;
using s16x4  = __attribute__((ext_vector_type(4))) short;
using f32x16 = __attribute__((ext_vector_type(16))) float;
using f32x8  = __attribute__((ext_vector_type(8))) float;
using u32x4  = __attribute__((ext_vector_type(4))) unsigned;
#define KSWZ(row, colB) ((row) * 256 + ((colB) ^ (((row) & 7) << 4)))
#define SBAR() __builtin_amdgcn_sched_barrier(0)
__device__ __forceinline__ int crow(int r, int hi) { return (r & 3) + 8 * (r >> 2) + 4 * hi; }
__device__ __forceinline__ unsigned cvtpk(float lo, float hi) {
  unsigned r; asm volatile("v_cvt_pk_bf16_f32 %0, %1, %2" : "=v"(r) : "v"(lo), "v"(hi)); return r;
}
template <typename TIn> struct Stage;
template <> struct Stage<bf16>  { using T = bf16x8;
  __device__ static __forceinline__ T ld8(const bf16* p) { return *reinterpret_cast<const bf16x8*>(p); }
  __device__ static __forceinline__ bf16x8 tobf(T x) { return x; } };
__device__ __forceinline__ void partialSM(f32x16& p0, f32x16& p1, float& m_reg, float& mn, float& alpha) {
  constexpr float C = SCALE * 1.4426950408889634f;
  float pmax = p0[0]; for (int r = 1; r < 16; ++r) pmax = fmaxf(pmax, p0[r]); for (int r = 0; r < 16; ++r) pmax = fmaxf(pmax, p1[r]);
  { auto rr = __builtin_amdgcn_permlane32_swap(__float_as_uint(pmax), __float_as_uint(pmax), false, false);
    pmax = fmaxf(__uint_as_float(rr[0]), __uint_as_float(rr[1])); }
  if (__builtin_expect(__all(pmax - m_reg <= THR / SCALE), 1)) { mn = m_reg; alpha = 1.f; }
  else { mn = fmaxf(m_reg, pmax); alpha = __builtin_amdgcn_exp2f((m_reg - mn) * C); m_reg = mn; }
  float mnC = -mn * C;
  for (int r = 0; r < 16; ++r) p0[r] = fmaf(p0[r], C, mnC); for (int r = 0; r < 16; ++r) p1[r] = fmaf(p1[r], C, mnC);
  for (int r = 0; r < 16; ++r) p0[r] = __builtin_amdgcn_exp2f(p0[r]);
}
__device__ __forceinline__ void finishSM(f32x16& p0, f32x16& p1, float alpha, float& l_reg, bf16x8& pa0, bf16x8& pa1, bf16x8& pa2, bf16x8& pa3) {
  for (int r = 0; r < 16; ++r) p1[r] = __builtin_amdgcn_exp2f(p1[r]);
  float ps = 0; for (int r = 0; r < 16; ++r) ps += p0[r]; for (int r = 0; r < 16; ++r) ps += p1[r];
  { auto rr = __builtin_amdgcn_permlane32_swap(__float_as_uint(ps), __float_as_uint(ps), false, false);
    ps = __uint_as_float(rr[0]) + __uint_as_float(rr[1]); }
  l_reg = l_reg * alpha + ps;
#define PK4(P, BASE, OUT) do { unsigned a0 = cvtpk(P[BASE + 0], P[BASE + 1]), a1 = cvtpk(P[BASE + 2], P[BASE + 3]);   \
    unsigned b0 = cvtpk(P[BASE + 4], P[BASE + 5]), b1 = cvtpk(P[BASE + 6], P[BASE + 7]);                              \
    auto r0 = __builtin_amdgcn_permlane32_swap(a0, b0, false, false); auto r1 = __builtin_amdgcn_permlane32_swap(a1, b1, false, false); \
    u32x4 w = {r0[0], r1[0], r0[1], r1[1]}; OUT = *reinterpret_cast<bf16x8*>(&w); } while (0)
  PK4(p0, 0, pa0); PK4(p0, 8, pa1); PK4(p1, 0, pa2); PK4(p1, 8, pa3);
#undef PK4
}
__device__ __forceinline__ void qkt(f32x16& p0, f32x16& p1, const bf16* Ks, const char* qfl, int r32, int hi, int mcolB) {
  p0 = f32x16{}; p1 = f32x16{};
  asm volatile("" : "+v"(qfl));
  bf16x8 qr[4];
#pragma unroll
  for (int d0 = 0; d0 < 4; ++d0) qr[d0] = *reinterpret_cast<const bf16x8*>(qfl + d0 * 1024);
#pragma unroll
  for (int d0 = 0; d0 < 4; ++d0) { int cb = mcolB + (d0 * 16 + hi * 8) * 2;
    bf16x8 b0 = *reinterpret_cast<const bf16x8*>((const char*)Ks + KSWZ(r32, cb));
    bf16x8 b1 = *reinterpret_cast<const bf16x8*>((const char*)Ks + KSWZ(32 + r32, cb));
    p0 = __builtin_amdgcn_mfma_f32_32x32x16_bf16(b0, qr[d0], p0, 0, 0, 0);
    p1 = __builtin_amdgcn_mfma_f32_32x32x16_bf16(b1, qr[d0], p1, 0, 0, 0); }
}
__device__ __forceinline__ int v_st(int k, int c) { const int kk = (k & ~0xC) | ((k & 4) << 1) | ((k & 8) >> 1); return ((kk >> 3) * 4 + (c >> 5)) * 512 + ((kk & 7) * 32 + (c & 31)) * 2; }
__device__ __forceinline__ int v_rd_base(int lane) { return ((lane & 3) << 3) | (((lane >> 2) & 3) << 6) | (((lane >> 4) & 1) << 5) | (((lane >> 5) & 1) << 8); }
constexpr int v_rd_off(int d0, int ks, int half) { return d0 * 512 + ks * 4096 + half * 2048; }
template <int OFF> __device__ __forceinline__ s16x4 tr_read(int vb) {
  s16x4 r; asm volatile("ds_read_b64_tr_b16 %0, %1 offset:%2" : "=&v"(r) : "v"(vb), "i"(OFF) : "memory"); return r;
}
template <int D0> __device__ __forceinline__ void pv_one(f32x16& od, int vb, bf16x8 pa0, bf16x8 pa1, bf16x8 pa2, bf16x8 pa3) {
  const s16x4 l0 = tr_read<v_rd_off(D0, 0, 0)>(vb), h0 = tr_read<v_rd_off(D0, 0, 1)>(vb), l1 = tr_read<v_rd_off(D0, 1, 0)>(vb), h1 = tr_read<v_rd_off(D0, 1, 1)>(vb);
  const s16x4 l2 = tr_read<v_rd_off(D0, 2, 0)>(vb), h2 = tr_read<v_rd_off(D0, 2, 1)>(vb), l3 = tr_read<v_rd_off(D0, 3, 0)>(vb), h3 = tr_read<v_rd_off(D0, 3, 1)>(vb);
  asm volatile("s_waitcnt lgkmcnt(0)" ::: "memory"); SBAR();
#define PK(L, H) (bf16x8){L[0], L[1], L[2], L[3], H[0], H[1], H[2], H[3]}
  od = __builtin_amdgcn_mfma_f32_32x32x16_bf16(pa0, PK(l0, h0), od, 0, 0, 0);
  od = __builtin_amdgcn_mfma_f32_32x32x16_bf16(pa1, PK(l1, h1), od, 0, 0, 0);
  od = __builtin_amdgcn_mfma_f32_32x32x16_bf16(pa2, PK(l2, h2), od, 0, 0, 0);
  od = __builtin_amdgcn_mfma_f32_32x32x16_bf16(pa3, PK(l3, h3), od, 0, 0, 0);
#undef PK
}
__device__ __forceinline__ void pv_d0(f32x16* o, int vb, bf16x8 pa0, bf16x8 pa1, bf16x8 pa2, bf16x8 pa3) {
  pv_one<0>(o[0], vb, pa0, pa1, pa2, pa3); pv_one<1>(o[1], vb, pa0, pa1, pa2, pa3); pv_one<2>(o[2], vb, pa0, pa1, pa2, pa3); pv_one<3>(o[3], vb, pa0, pa1, pa2, pa3);
}

__device__ __forceinline__ void diff_attn_unit(const bf16* __restrict__ Qb, const bf16* __restrict__ Kh, const bf16* __restrict__ Vh,
                                               bf16* __restrict__ Ob, int seq, float lam, const float* __restrict__ subln, char* lds) {
  using St = Stage<bf16>;
  int tid_ = threadIdx.x; asm volatile("" : "+v"(tid_));
  const int tid = tid_, wid = tid >> 6, lane = tid & 63, r32 = lane & 31, hi = lane >> 5;
  bf16* V_lds = (bf16*)lds; bf16* K_lds = (bf16*)(lds + 2 * SHM_V);
  float* ws = (float*)(lds + 2 * SHM_V + 2 * SHM_K) + wid * 64; float* li_l = ws; float* al_l = ws + 32;
  float m_reg = -1e30f, l_reg = 0; f32x16 o[4] = {};
  const int mw = wid >> 2, wq = wid & 3, mcolB = mw * 128;
  const bf16* Qw = Qb + (long)(wq * QBLK + r32) * LDQ + mw * 64 + hi * 8;
  char* qr = lds + 2 * SHM_V + 2 * SHM_K + NW * 64 * 4 + wid * 4096 + lane * 16;
#pragma unroll
  for (int d0 = 0; d0 < 4; ++d0) *reinterpret_cast<bf16x8*>(qr + d0 * 1024) = St::ld8(Qw + d0 * 16);
  const int sr = tid >> 4, sc = (tid & 15) * 8, vst0 = v_st(sr, sc), vst1 = v_st(32 + sr, sc);
  const int vb0 = (int)(uintptr_t)V_lds + v_rd_base(lane);
  struct { typename St::T vs0, vs1, ks0, ks1; } sr_[SDEPTH];
#define SLOAD(i, k0) do { sr_[i].vs0 = St::ld8(&Vh[(long)((k0) + sr) * LDK + sc]); sr_[i].vs1 = St::ld8(&Vh[(long)((k0) + 32 + sr) * LDK + sc]); \
    sr_[i].ks0 = St::ld8(&Kh[(long)((k0) + sr) * LDK + sc]); sr_[i].ks1 = St::ld8(&Kh[(long)((k0) + 32 + sr) * LDK + sc]); } while (0)
#define SWRITE(b, i) do { *(bf16x8*)((char*)V_lds + (b) * SHM_V + vst0) = St::tobf(sr_[i].vs0);          \
    *(bf16x8*)((char*)V_lds + (b) * SHM_V + vst1) = St::tobf(sr_[i].vs1); int kc = sc * 2;               \
    *(bf16x8*)((char*)K_lds + (b) * SHM_K + KSWZ(sr, kc)) = St::tobf(sr_[i].ks0);                       \
    *(bf16x8*)((char*)K_lds + (b) * SHM_K + KSWZ(32 + sr, kc)) = St::tobf(sr_[i].ks1); } while (0)
#define SWAIT() do { if constexpr (SDEPTH == 2) asm volatile("s_waitcnt vmcnt(4)" ::: "memory"); else asm volatile("s_waitcnt vmcnt(0)" ::: "memory"); } while (0)
#define RESC(a) do { if (__any((a) < 1.f)) { if (hi == 0) al_l[r32] = (a); asm volatile("s_waitcnt lgkmcnt(0)" ::: "memory"); \
    for (int d = 0; d < 4; ++d) for (int r = 0; r < 16; ++r) o[d][r] *= al_l[crow(r, hi)]; } } while (0)
  f32x16 pA0, pA1, pB0, pB1; float mnA, mnB, alA, alB; bf16x8 pa0, pa1, pa2, pa3; const int NT = seq / KVBLK;
  constexpr int SE = 0, SO = SDEPTH - 1;
  SLOAD(SE, 0); asm volatile("s_waitcnt vmcnt(0)" ::: "memory"); SWRITE(0, SE); __syncthreads();
  qkt(pA0, pA1, K_lds, qr, r32, hi, mcolB); partialSM(pA0, pA1, m_reg, mnA, alA);
  SLOAD(SO, KVBLK); if constexpr (SDEPTH == 2) { if (2 < NT) SLOAD(SE, 2 * KVBLK); }
  SWAIT(); SWRITE(1, SO); __syncthreads();
  for (int j = 1; j + 1 < NT; j += 2) {
    SBAR(); qkt(pB0, pB1, (bf16*)((char*)K_lds + SHM_K), qr, r32, hi, mcolB);
    finishSM(pA0, pA1, alA, l_reg, pa0, pa1, pa2, pa3); SBAR();
    SLOAD(SO, (j + SDEPTH) * KVBLK); SBAR();
    pv_d0(o, vb0, pa0, pa1, pa2, pa3); partialSM(pB0, pB1, m_reg, mnB, alB);
    __syncthreads(); SWAIT(); SWRITE(0, SE);
    RESC(alB); __syncthreads();
    SBAR(); qkt(pA0, pA1, K_lds, qr, r32, hi, mcolB);
    finishSM(pB0, pB1, alB, l_reg, pa0, pa1, pa2, pa3); SBAR();
    if (SDEPTH == 1 || j + 3 < NT) SLOAD(SE, (j + 1 + SDEPTH) * KVBLK); SBAR();
    pv_d0(o, vb0 + (int)SHM_V, pa0, pa1, pa2, pa3); partialSM(pA0, pA1, m_reg, mnA, alA);
    __syncthreads(); SWAIT(); SWRITE(1, SO);
    RESC(alA); __syncthreads();
  }
  SBAR(); qkt(pB0, pB1, (bf16*)((char*)K_lds + SHM_K), qr, r32, hi, mcolB);
  finishSM(pA0, pA1, alA, l_reg, pa0, pa1, pa2, pa3); SBAR();
  pv_d0(o, vb0, pa0, pa1, pa2, pa3); partialSM(pB0, pB1, m_reg, mnB, alB);
  __syncthreads(); RESC(alB);
  finishSM(pB0, pB1, alB, l_reg, pa0, pa1, pa2, pa3); SBAR();
  pv_d0(o, vb0 + (int)SHM_V, pa0, pa1, pa2, pa3);
  if (hi == 0) li_l[r32] = l_reg; asm volatile("s_waitcnt lgkmcnt(0)" ::: "memory");
  float rli[16];
#pragma unroll
  for (int r = 0; r < 16; ++r) rli[r] = __builtin_amdgcn_rcpf(li_l[crow(r, hi)]);
  float* EXO = (float*)(lds + 2 * SHM_V + 2 * SHM_K + NW * 64 * 4) + wq * (4 * 16 * 64) + lane;
  if (mw == 1) {
#pragma unroll
    for (int d0 = 0; d0 < 4; ++d0)
#pragma unroll
      for (int r = 0; r < 16; ++r) EXO[(d0 * 16 + r) * 64] = o[d0][r] * rli[r];
  }
  __syncthreads();
  if (mw == 0) {
    float ssq[16];
#pragma unroll
    for (int r = 0; r < 16; ++r) ssq[r] = 0.f;
#pragma unroll
    for (int d0 = 0; d0 < 4; ++d0)
#pragma unroll
      for (int r = 0; r < 16; ++r) { const float dv = o[d0][r] * rli[r] - lam * EXO[(d0 * 16 + r) * 64]; o[d0][r] = dv; ssq[r] += dv * dv; }
#pragma unroll
    for (int r = 0; r < 16; ++r) {
#pragma unroll
      for (int sft = 1; sft < 32; sft <<= 1) ssq[r] += __shfl_xor(ssq[r], sft);
      ssq[r] = rsqrtf(ssq[r] * (1.f / 128.f) + 1e-6f) * 0.8f;
    }
    bf16* Ow = Ob + (long)(wq * QBLK) * LDO;
#pragma unroll
    for (int d0 = 0; d0 < 4; ++d0) { const float gg = subln[d0 * 32 + r32];
#pragma unroll
      for (int r = 0; r < 16; ++r) { const float val = o[d0][r] * ssq[r] * gg; Ow[(long)crow(r, hi) * LDO + d0 * 32 + r32] = (bf16)(pg8::cvt_pk_bf16(val, val) & 0xffffu); } }
  }
  __syncthreads();
#undef SLOAD
#undef SWRITE
#undef SWAIT
#undef RESC
}
}


typedef __bf16 bf16x2_t __attribute__((ext_vector_type(2)));
__device__ __forceinline__ float dot2bf(unsigned a, unsigned b, float acc) { return __builtin_amdgcn_fdot2_f32_bf16(__builtin_bit_cast(bf16x2_t, a), __builtin_bit_cast(bf16x2_t, b), acc, false); }
template <int CTRL> __device__ __forceinline__ float dpp_add(float v) { return v + __builtin_bit_cast(float, __builtin_amdgcn_update_dpp(0, __builtin_bit_cast(int, v), CTRL, 0xf, 0xf, true)); }
__device__ __forceinline__ float row16_sum(float v) {
  v = dpp_add<0xB1>(v); v = dpp_add<0x4E>(v); v = dpp_add<0x141>(v); v = dpp_add<0x140>(v); return v;
}

__device__ __forceinline__ void slice_table(const float* T, bf16_t* T8, int gtid, int gsz) {
  for (int it = gtid; it < 16384 * 128; it += gsz) {
    const int e = it >> 7, c8 = (it & 127) * 8, j = c8 >> 7, c = c8 & 127;
    const f32x4 a = *(const f32x4*)(T + (size_t)e * 1024 + c8), b = *(const f32x4*)(T + (size_t)e * 1024 + c8 + 4);
    u32x4 w; w.x = pg8::cvt_pk_bf16(a[0], a[1]); w.y = pg8::cvt_pk_bf16(a[2], a[3]); w.z = pg8::cvt_pk_bf16(b[0], b[1]); w.w = pg8::cvt_pk_bf16(b[2], b[3]);
    *(u32x4*)(T8 + ((size_t)j * 16384 + e) * 128 + c) = w;
  }
}

__device__ __forceinline__ void wave_argmax(float& v, int& i) {
#pragma unroll
  for (int o = 32; o; o >>= 1) {
    const float ov = __shfl_xor(v, o); const int oi = __shfl_xor(i, o);
    if (ov > v || (ov == v && oi < i)) { v = ov; i = oi; }
  }
}

__global__ void __launch_bounds__(NT) mega(Params p) {
  extern __shared__ __attribute__((aligned(16))) unsigned char lds[];
  cg::grid_group grid = cg::this_grid();
  if (threadIdx.x < 35) {
    unsigned long long v = threadIdx.x < 33 ? (unsigned long long)p.in[threadIdx.x] : (threadIdx.x == 33 ? (unsigned long long)p.out : (unsigned long long)p.ws);
    ((unsigned long long*)(lds + PTR_OFF))[threadIdx.x] = v;
  }
  __syncthreads();

  {
    PHASE_LOCALS
    float* MOD = (float*)WSP(WS_MOD); float* LAM = (float*)WSP(WS_LAM);
    float* ABRE = (float*)WSP(WS_ABRE); float* ABIM = (float*)WSP(WS_ABIM); float* BBRE = (float*)WSP(WS_BBRE); float* BBIM = (float*)WSP(WS_BBIM);
    const float* cin = INP(1); const float* c_ctx = INP(3); const float* ada_w = INP(4); const float* ada_b = INP(5);
    if (gridDim.x >= 192) {
      if (blockIdx.x < 192) {
        float* sil = fl; float* red = fl + 5 * 1024;
        for (int i = tid; i < 5 * 1024; i += NT) { const int r = i >> 10, k = i & 1023; sil[i] = siluf_(r < 4 ? cin[r * D + k] : c_ctx[k]); }
        __syncthreads();
        const int cl = tid & 31, kg = tid >> 5, col = blockIdx.x * 32 + cl;
        float a[5] = {0.f, 0.f, 0.f, 0.f, 0.f};
#pragma unroll 16
        for (int kk = 0; kk < 64; ++kk) {
          const int k = kg * 64 + kk; const float w = ada_w[(size_t)k * 6144 + col];
#pragma unroll
          for (int r = 0; r < 5; ++r) a[r] += sil[r * 1024 + k] * w;
        }
#pragma unroll
        for (int r = 0; r < 5; ++r) red[(kg * 5 + r) * 32 + cl] = a[r];
        __syncthreads();
        if (tid < 160) {
          const int r = tid >> 5; float s = 0.f;
#pragma unroll
          for (int q = 0; q < 16; ++q) s += red[(q * 5 + r) * 32 + cl];
          MOD[r * 6144 + col] = s + ada_b[col];
        }
        __syncthreads();
      }
    } else {
      for (int it = gtid; it < 5 * 6144; it += gsz) {
        const int r = it / 6144, j = it % 6144;
        const float* cv = r < 4 ? cin + r * D : c_ctx;
        float a = 0.f;
        for (int k = 0; k < D; ++k) a += siluf_(cv[k]) * ada_w[(size_t)k * 6144 + j];
        MOD[it] = a + ada_b[j];
      }
    }
    if (gtid == 0) {
      const float* q1 = INP(9); const float* k1 = INP(10); const float* q2 = INP(11); const float* k2 = INP(12);
      float s1 = 0.f, s2 = 0.f;
      for (int k = 0; k < 64; ++k) { s1 += q1[k] * k1[k]; s2 += q2[k] * k2[k]; }
      LAM[0] = expf(s1) - expf(s2) + 0.2f;
    }
    const float* a_re = INP(15); const float* a_im = INP(16); const float* ldt = INP(17); const float* b_re = INP(18); const float* b_im = INP(19);
    for (int it = gtid; it < 2 * 32 * 64; it += gsz) {
      const int dg = it >> 6;
      const float ar = a_re[it], ai = a_im[it], dt = expf(ldt[dg]);
      const float mag = expf(ar * dt), abr = mag * cosf(ai * dt), abi = mag * sinf(ai * dt);
      ABRE[it] = abr; ABIM[it] = abi; ((float*)WSP(WS_ARDT))[it] = ar * dt; ((float*)WSP(WS_AIDT))[it] = ai * dt;
      const float den = ar * ar + ai * ai, nr = abr - 1.f, ni = abi;
      const float fr = (nr * ar + ni * ai) / den, fi = (ni * ar - nr * ai) / den;
      for (int pp = 0; pp < 16; ++pp) {
        const float br = b_re[it * 16 + pp], bi = b_im[it * 16 + pp];
        BBRE[it * 16 + pp] = fr * br - fi * bi; BBIM[it * 16 + pp] = fr * bi + fi * br;
      }
    }
    {
      struct BB { float fr, fi, ardt, aidt; };
      auto disc1 = [&](int sidx) -> BB {
        const float ar = a_re[sidx], ai = a_im[sidx], dt = expf(ldt[sidx >> 6]);
        const float mag = expf(ar * dt), abr = mag * cosf(ai * dt), abi = mag * sinf(ai * dt);
        const float den = ar * ar + ai * ai, nr = abr - 1.f, ni = abi;
        return BB{(nr * ar + ni * ai) / den, (ni * ar - nr * ai) / den, ar * dt, ai * dt};
      };
      {
        bf16_t* BTS = (bf16_t*)WSP(WS_BTS);
        for (int it = gtid; it < 32 * 256 * 32; it += gsz) {
          const int i = it & 31, r = (it >> 5) & 255, g = it >> 13;
          const int d = r >> 7, n = (r >> 1) & 63, ri = r & 1, sidx = (d * 32 + g) * 64 + n;
          const BB bb = disc1(sidx);
          const float e = (float)(d == 0 ? 31 - i : i);
          const float mag = __expf(e * bb.ardt), pr0 = mag * __cosf(e * bb.aidt), pi0 = mag * __sinf(e * bb.aidt);
          const float pr = pr0 * bb.fr - pi0 * bb.fi, pi = pr0 * bb.fi + pi0 * bb.fr;
          unsigned w[8];
#pragma unroll
          for (int q = 0; q < 8; ++q) {
            const float br0 = b_re[sidx * 16 + 2 * q], bi0 = b_im[sidx * 16 + 2 * q], br1 = b_re[sidx * 16 + 2 * q + 1], bi1 = b_im[sidx * 16 + 2 * q + 1];
            const float v0 = ri == 0 ? pr * br0 - pi * bi0 : pr * bi0 + pi * br0, v1 = ri == 0 ? pr * br1 - pi * bi1 : pr * bi1 + pi * br1;
            w[q] = pg8::cvt_pk_bf16(v0, v1);
          }
          u32x4* dst = (u32x4*)(BTS + ((size_t)g * 256 + r) * 512 + i * 16);
          dst[0] = (u32x4){w[0], w[1], w[2], w[3]}; dst[1] = (u32x4){w[4], w[5], w[6], w[7]};
        }
      }
      {
        float* KT = (float*)WSP(WS_KT); const float* c_re = INP(20); const float* c_im = INP(21);
        if (gridDim.x >= 256) {
          if (blockIdx.x >= 192) {
            const int dg = (int)blockIdx.x - 192; float* dsc = fl;
            if (tid < 64) { const BB bb = disc1(dg * 64 + tid); dsc[tid * 4] = bb.fr; dsc[tid * 4 + 1] = bb.fi; dsc[tid * 4 + 2] = bb.ardt; dsc[tid * 4 + 3] = bb.aidt; }
            __syncthreads();
            const int pp = tid & 15, m = tid >> 4;
            float acc[16];
#pragma unroll
            for (int q = 0; q < 16; ++q) acc[q] = 0.f;
            for (int n = 0; n < 64; ++n) {
              const int sidx = dg * 64 + n;
              const float fr = dsc[n * 4], fi = dsc[n * 4 + 1], ardt = dsc[n * 4 + 2], aidt = dsc[n * 4 + 3];
              const float mag = __expf((float)m * ardt), pr0 = mag * __cosf((float)m * aidt), pi0 = mag * __sinf((float)m * aidt);
              const float pr = pr0 * fr - pi0 * fi, pi = pr0 * fi + pi0 * fr;
              const float cr = c_re[(dg * 16 + pp) * 64 + n], ci = c_im[(dg * 16 + pp) * 64 + n];
              const float wr_ = cr * pr - ci * pi, wi_ = cr * pi + ci * pr;
#pragma unroll
              for (int q = 0; q < 16; ++q) acc[q] += wr_ * b_re[sidx * 16 + q] - wi_ * b_im[sidx * 16 + q];
            }
#pragma unroll
            for (int q = 0; q < 16; ++q) KT[((size_t)dg * 32 + m) * 256 + pp * 16 + q] = acc[q];
            __syncthreads();
          }
        } else {
          for (int it = gtid; it < 2 * 32 * 32 * 16; it += gsz) {
            const int pp = it & 15, m = (it >> 4) & 31, dg = it >> 9;
            float acc[16];
#pragma unroll
            for (int q = 0; q < 16; ++q) acc[q] = 0.f;
            for (int n = 0; n < 64; ++n) {
              const int sidx = dg * 64 + n;
              const BB bb = disc1(sidx);
              const float mag = __expf((float)m * bb.ardt), pr0 = mag * __cosf((float)m * bb.aidt), pi0 = mag * __sinf((float)m * bb.aidt);
              const float pr = pr0 * bb.fr - pi0 * bb.fi, pi = pr0 * bb.fi + pi0 * bb.fr;
              const float cr = c_re[(dg * 16 + pp) * 64 + n], ci = c_im[(dg * 16 + pp) * 64 + n];
              const float wr_ = cr * pr - ci * pi, wi_ = cr * pi + ci * pr;
#pragma unroll
              for (int q = 0; q < 16; ++q) acc[q] += wr_ * b_re[sidx * 16 + q] - wi_ * b_im[sidx * 16 + q];
            }
#pragma unroll
            for (int q = 0; q < 16; ++q) KT[((size_t)dg * 32 + m) * 256 + pp * 16 + q] = acc[q];
          }
        }
      }
    }
    float* ROPE = (float*)WSP(WS_ROPE);
    for (int it = gtid; it < 64 * 16; it += gsz) {
      const float ang = (float)(it >> 4) * powf(10000.f, -(float)(it & 15) / 16.f);
      ROPE[it * 2] = cosf(ang); ROPE[it * 2 + 1] = sinf(ang);
    }
    {
      float* scr = fl + wid * (64 * 33);
      constexpr int I_IN = 16 * 176, I_AU = 16 * 32, I_SU = 8 * 32, I_OUT = 16 * 32, I_Q = 16 * 32, I_GLU = 8 * 16;
      for (int it = gw; it < I_IN + I_AU + I_SU + I_OUT + I_GLU; it += ngw) {
        int r = it;
        if (r < I_IN) { transpose_item(INP(8), 1024, N_IN, (bf16_t*)WSP(WS_WIN), scr, r, lane); continue; } r -= I_IN;
        if (r < I_AU) { transpose_item(INP(14), 1024, 1024, (bf16_t*)WSP(WS_WAU), scr, r, lane); continue; } r -= I_AU;
        if (r < I_SU) { transpose_item(INP(25), 512, 1024, (bf16_t*)WSP(WS_WSU), scr, r, lane); continue; } r -= I_SU;
        if (r < I_OUT) { transpose_item(INP(26), 1024, 1024, (bf16_t*)WSP(WS_WOUT), scr, r, lane); continue; } r -= I_OUT;
        transpose_item(INP(23), 512, 512, (bf16_t*)WSP(WS_WGLU), scr, r, lane);
      }
    }
  }
  grid.sync();

  {
    PHASE_LOCALS
    const float* MOD = (const float*)WSP(WS_MOD); bf16_t* XN = (bf16_t*)WSP(WS_XN);
    const float* x = INP(0); const float* ctx = INP(2); const float* norm1_g = INP(6);
    for (int row = gw; row < MX + MC; row += ngw) {
      const float* src; const float* md;
      if (row < MX) { src = x + (size_t)row * D; md = MOD + (row / L) * 6144; } else { src = ctx + (size_t)(row - MX) * D; md = MOD + 4 * 6144; }
      f32x4 v[4]; float ss = 0.f;
#pragma unroll
      for (int j = 0; j < 4; ++j) { v[j] = *(const f32x4*)(src + lane * 4 + 256 * j); ss += v[j][0] * v[j][0] + v[j][1] * v[j][1] + v[j][2] * v[j][2] + v[j][3] * v[j][3]; }
      const float rstd = rsqrtf(wave_sum(ss) * (1.f / D) + 1e-6f);
#pragma unroll
      for (int j = 0; j < 4; ++j)
#pragma unroll
        for (int e = 0; e < 4; ++e) { const int col = lane * 4 + 256 * j + e; XN[(size_t)row * D + col] = f2bf(v[j][e] * rstd * norm1_g[col] * (1.f + md[1024 + col]) + md[col]); }
    }
  }
  grid.sync();

  {
    pg8::Gemm g{(const bf16_t*)WSP(WS_XN), (const bf16_t*)WSP(WS_WIN), MX + MC, N_IN, D, D, D};
    InProjSched S; S.init((int)gridDim.x, (int)blockIdx.x);
    EpiInProj E{(bf16_t*)WSP(WS_Q), (bf16_t*)WSP(WS_K), (bf16_t*)WSP(WS_V), (bf16_t*)WSP(WS_SA), (bf16_t*)WSP(WS_G), (const float*)WSP(WS_ROPE)};
    pg8::gemm_phase<EpiInProj, InProjSched, true, true>((PG8_LAS unsigned char*)lds, g, S, E);
  }
  grid.sync();

  {
    const float lam = ((const float*)WSP(WS_LAM))[0];
    const bf16_t* Qb = (const bf16_t*)WSP(WS_Q); const bf16_t* Kb = (const bf16_t*)WSP(WS_K); const bf16_t* Vb = (const bf16_t*)WSP(WS_V);
    bf16_t* ATT = (bf16_t*)WSP(WS_ATT); const float* subln = INP(13);
    for (int unit = blockIdx.x; unit < Bn * 8 * (L / 128); unit += gridDim.x) {
      const int h = unit & 7, qb = (unit >> 3) & 31, b = unit >> 8;
      const size_t qoff = ((size_t)(b * L + qb * 128)) * 1024 + h * 128, koff = (size_t)b * LA * 1024 + h * 128;
      att::diff_attn_unit(Qb + qoff, Kb + koff, Vb + koff, ATT + qoff, LA, lam, subln, (char*)lds);
    }
  }
  grid.sync();

  {
    const bool gemm_blk = (blockIdx.x < 96) || (gridDim.x <= 96);
    if (gemm_blk) {
      pg8::Gemm g{(const bf16_t*)WSP(WS_SA), (const bf16_t*)WSP(WS_BTS), 0, 0, 512, SA_LD, 512};
      GroupSched S; S.init(32, 3, 1, (long)SA_ROWS * SA_LD * 2, (long)256 * SA_LD * 2, (long)256 * 512 * 2, 0, (int)(gridDim.x <= 96 ? gridDim.x : 96), (int)blockIdx.x);
      EpiS E{(float*)WSP(WS_S)};
      pg8::gemm_phase<EpiS, GroupSched, true, true>((PG8_LAS unsigned char*)lds, g, S, E);
    }
    if (!gemm_blk || gridDim.x <= 96) {
      PHASE_LOCALS
      const int wb = gridDim.x <= 96 ? (int)blockIdx.x : (int)blockIdx.x - 96, nwb = gridDim.x <= 96 ? (int)gridDim.x : (int)gridDim.x - 96;
      const float* KT = (const float*)WSP(WS_KT); const float* ARDT = (const float*)WSP(WS_ARDT); const float* AIDT = (const float*)WSP(WS_AIDT);
      const float* c_re = INP(20); const float* c_im = INP(21); const float* dsk = INP(22); bf16_t* BTY = (bf16_t*)WSP(WS_BTY);
      for (int it = wb * NT + tid; it < 32 * 512 * 96; it += nwb * NT) {
        const int cgp = it % 96, row = (it / 96) & 511, g = it / (96 * 512);
        const int j = row >> 4, pp = row & 15, col0 = cgp * 8;
        float v[8];
        if (col0 < 512) {
          const int i = col0 >> 4, q0 = col0 & 15;
#pragma unroll
          for (int e = 0; e < 8; ++e) v[e] = 0.f;
          if (i <= j) { const float* kp = KT + ((size_t)(0 * 32 + g) * 32 + (j - i)) * 256 + pp * 16 + q0;
#pragma unroll
            for (int e = 0; e < 8; ++e) v[e] += kp[e]; }
          if (i >= j) { const float* kp = KT + ((size_t)(1 * 32 + g) * 32 + (i - j)) * 256 + pp * 16 + q0;
#pragma unroll
            for (int e = 0; e < 8; ++e) v[e] += kp[e]; }
          if (i == j && pp >= q0 && pp < q0 + 8) {
#pragma unroll
            for (int e = 0; e < 8; ++e) if (q0 + e == pp) v[e] += dsk[g * 16 + pp];
          }
        } else {
          const int cc0 = col0 - 512, d = cc0 >> 7, n0 = (cc0 & 127) >> 1;
          const float ex = (float)(d == 0 ? j + 1 : 32 - j);
#pragma unroll
          for (int q = 0; q < 4; ++q) {
            const int n = n0 + q, sidx = (d * 32 + g) * 64 + n;
            const float mag = __expf(ex * ARDT[sidx]), pr = mag * __cosf(ex * AIDT[sidx]), pi = mag * __sinf(ex * AIDT[sidx]);
            const float cr = c_re[((d * 32 + g) * 16 + pp) * 64 + n], ci = c_im[((d * 32 + g) * 16 + pp) * 64 + n];
            v[2 * q] = cr * pr - ci * pi; v[2 * q + 1] = -(cr * pi + ci * pr);
          }
        }
        u32x4 w; w.x = pg8::cvt_pk_bf16(v[0], v[1]); w.y = pg8::cvt_pk_bf16(v[2], v[3]); w.z = pg8::cvt_pk_bf16(v[4], v[5]); w.w = pg8::cvt_pk_bf16(v[6], v[7]);
        *(u32x4*)(BTY + ((size_t)g * 512 + row) * 768 + col0) = w;
      }
    }
  }
  grid.sync();

  {
    PHASE_LOCALS
    const float* ARDT = (const float*)WSP(WS_ARDT); const float* AIDT = (const float*)WSP(WS_AIDT);
    if (wid == 0) {
      for (int it = blockIdx.x; it < Bn * 32 * 2; it += gridDim.x) {
        const int d = it & 1, g = (it >> 1) & 31, b = it >> 6;
        const int sidx = (d * 32 + g) * 64 + lane;
        const float mag = expf(32.f * ARDT[sidx]), pr = mag * cosf(32.f * AIDT[sidx]), pi = mag * sinf(32.f * AIDT[sidx]);
        typedef float f32x2_ __attribute__((ext_vector_type(2)));
        const f32x2_* Sg = (const f32x2_*)((const float*)WSP(WS_S) + (size_t)g * SA_ROWS * 256) + d * 64 + lane;
        bf16_t* SAg = (bf16_t*)WSP(WS_SA) + (size_t)g * SA_ROWS * SA_LD + 512 + d * 128 + lane * 2;
        float hr = 0.f, hi = 0.f;
        f32x2_ sc[8];
#pragma unroll
        for (int k = 0; k < 8; ++k) { const int cc = d == 0 ? k : 7 - k; sc[k] = Sg[(size_t)(512 + b * 8 + cc) * 128]; }
#pragma unroll
        for (int k = 0; k < 8; ++k) { const float nr = pr * hr - pi * hi + sc[k][0], ni = pr * hi + pi * hr + sc[k][1]; hr = nr; hi = ni; }
        for (int k0 = 0; k0 < 128; k0 += 16) {
          f32x2_ sv[16];
#pragma unroll
          for (int k = 0; k < 16; ++k) { const int cx = d == 0 ? k0 + k : 127 - (k0 + k); sv[k] = Sg[(size_t)(b * 128 + cx) * 128]; }
#pragma unroll
          for (int k = 0; k < 16; ++k) {
            const int cx = d == 0 ? k0 + k : 127 - (k0 + k);
            *(unsigned*)(SAg + (size_t)(b * 128 + cx) * SA_LD) = pg8::cvt_pk_bf16(hr, hi);
            const float nr = pr * hr - pi * hi + sv[k][0], ni = pr * hi + pi * hr + sv[k][1]; hr = nr; hi = ni;
          }
        }
      }
    }
  }
  grid.sync();

  {
    pg8::Gemm g{(const bf16_t*)WSP(WS_SA), (const bf16_t*)WSP(WS_BTY), 0, 0, 768, SA_LD, 768};
    GroupSched S; S.init(32, 2, 2, (long)SA_ROWS * SA_LD * 2, (long)256 * SA_LD * 2, (long)512 * 768 * 2, (long)256 * 768 * 2, (int)gridDim.x, (int)blockIdx.x);
    EpiY E{(bf16_t*)WSP(WS_YG)};
    pg8::gemm_phase<EpiY, GroupSched, true, true>((PG8_LAS unsigned char*)lds, g, S, E);
  }
  grid.sync();

  {
    pg8::Gemm g{(const bf16_t*)WSP(WS_YG), (const bf16_t*)WSP(WS_WGLU), MX, 512, 512, 512, 512};
    pg8::StaticOrder S; S.init(MX, 512, (int)gridDim.x, (int)blockIdx.x, g.lda, g.ldb);
    EpiBf8<0> E{(bf16_t*)WSP(WS_SSMX), 512, (const bf16_t*)WSP(WS_YG), 512, INP(24)};
    pg8::gemm_phase<EpiBf8<0>, pg8::StaticOrder, true, true>((PG8_LAS unsigned char*)lds, g, S, E);
  }
  grid.sync();

  {
    pg8::Gemm g{(const bf16_t*)WSP(WS_ATT), (const bf16_t*)WSP(WS_WAU), MX, 1024, 1024, 1024, 1024};
    pg8::StaticOrder S; S.init(MX, 1024, (int)gridDim.x, (int)blockIdx.x, g.lda, g.ldb);
    EpiBf8<1> E{(bf16_t*)WSP(WS_M), 1024, (const bf16_t*)WSP(WS_G), 2048, nullptr};
    pg8::gemm_phase<EpiBf8<1>, pg8::StaticOrder, true, true>((PG8_LAS unsigned char*)lds, g, S, E);
  }
  grid.sync();
  {
    pg8::Gemm g{(const bf16_t*)WSP(WS_SSMX), (const bf16_t*)WSP(WS_WSU), MX, 1024, 512, 512, 512};
    pg8::StaticOrder S; S.init(MX, 1024, (int)gridDim.x, (int)blockIdx.x, g.lda, g.ldb);
    EpiBf8<2> E{(bf16_t*)WSP(WS_M), 1024, (const bf16_t*)WSP(WS_G) + 1024, 2048, nullptr};
    pg8::gemm_phase<EpiBf8<2>, pg8::StaticOrder, true, true>((PG8_LAS unsigned char*)lds, g, S, E);
  }
  grid.sync();
  {
    pg8::Gemm g{(const bf16_t*)WSP(WS_M), (const bf16_t*)WSP(WS_WOUT), MX, 1024, 1024, 1024, 1024};
    pg8::StaticOrder S; S.init(MX, 1024, (int)gridDim.x, (int)blockIdx.x, g.lda, g.ldb);
    EpiF32<1> E{(float*)WSP(WS_X1), INP(0), (const float*)WSP(WS_MOD)};
    pg8::gemm_phase<EpiF32<1>, pg8::StaticOrder, true, true>((PG8_LAS unsigned char*)lds, g, S, E);
  }
  grid.sync();
  {
    PHASE_LOCALS
    const float* X1 = (const float*)WSP(WS_X1); const float* MOD = (const float*)WSP(WS_MOD); bf16_t* XN2 = (bf16_t*)WSP(WS_XN2); const float* norm2_g = INP(7);
    for (int row = gw; row < MX; row += ngw) {
      const float* src = X1 + (size_t)row * D; const float* md = MOD + (row / L) * 6144;
      f32x4 v[4]; float ss = 0.f;
#pragma unroll
      for (int j = 0; j < 4; ++j) { v[j] = *(const f32x4*)(src + lane * 4 + 256 * j); ss += v[j][0] * v[j][0] + v[j][1] * v[j][1] + v[j][2] * v[j][2] + v[j][3] * v[j][3]; }
      const float rstd = rsqrtf(wave_sum(ss) * (1.f / D) + 1e-6f);
#pragma unroll
      for (int j = 0; j < 4; ++j)
#pragma unroll
        for (int e = 0; e < 4; ++e) { const int col = lane * 4 + 256 * j + e; XN2[(size_t)row * D + col] = f2bf(v[j][e] * rstd * norm2_g[col] * (1.f + md[4096 + col]) + md[3072 + col]); }
    }
    slice_table(INP(30), (bf16_t*)WSP(WS_U8), gtid, gsz);
    {
      const float* wq = INP(27); const float* sk1 = INP(28); const float* sk2 = INP(29); bf16_t* WC = (bf16_t*)WSP(WS_WC);
      float* skl = fl; float* wql = fl + 128 * 65;
      for (int tile = blockIdx.x; tile < 16 * 16; tile += gridDim.x) {
        const int hs = tile >> 4, d0 = (tile & 15) * 64, h = hs >> 1, s = hs & 1;
        __syncthreads();
        const float* skp = s ? sk2 : sk1;
        for (int i = tid; i < 128 * 16; i += NT) { const int k = i >> 4, e4 = (i & 15) * 4; const f32x4 v = *(const f32x4*)(skp + k * 64 + e4); skl[k * 65 + e4] = v[0]; skl[k * 65 + e4 + 1] = v[1]; skl[k * 65 + e4 + 2] = v[2]; skl[k * 65 + e4 + 3] = v[3]; }
        for (int i = tid; i < 64 * 16; i += NT) { const int dd = i >> 4, e4 = (i & 15) * 4; const f32x4 v = *(const f32x4*)(wq + (size_t)(d0 + dd) * 1024 + h * 128 + s * 64 + e4); wql[dd * 65 + e4] = v[0]; wql[dd * 65 + e4 + 1] = v[1]; wql[dd * 65 + e4 + 2] = v[2]; wql[dd * 65 + e4 + 3] = v[3]; }
        __syncthreads();
        const int k = tid & 127, dgp = tid >> 7;
        float a[16];
#pragma unroll
        for (int q = 0; q < 16; ++q) a[q] = 0.f;
        for (int e = 0; e < 64; ++e) {
          const float sv = skl[k * 65 + e];
#pragma unroll
          for (int q = 0; q < 16; ++q) a[q] += sv * wql[(dgp * 16 + q) * 65 + e];
        }
        u32x4 w0, w1;
        w0.x = pg8::cvt_pk_bf16(a[0], a[1]); w0.y = pg8::cvt_pk_bf16(a[2], a[3]); w0.z = pg8::cvt_pk_bf16(a[4], a[5]); w0.w = pg8::cvt_pk_bf16(a[6], a[7]);
        w1.x = pg8::cvt_pk_bf16(a[8], a[9]); w1.y = pg8::cvt_pk_bf16(a[10], a[11]); w1.z = pg8::cvt_pk_bf16(a[12], a[13]); w1.w = pg8::cvt_pk_bf16(a[14], a[15]);
        bf16_t* dst = WC + (size_t)(h * 256 + s * 128 + k) * 1024 + d0 + dgp * 16;
        *(u32x4*)dst = w0; *(u32x4*)(dst + 8) = w1;
      }
      __syncthreads();
    }
  }
  grid.sync();
  {
    pg8::Gemm g{(const bf16_t*)WSP(WS_XN2), (const bf16_t*)WSP(WS_WC), MX, 2048, 1024, 1024, 1024};
    EpiTopK E{(unsigned short*)WSP(WS_IDX), (float*)WSP(WS_GATE)};
    const int nrounds = (64 * 8 + (int)gridDim.x - 1) / (int)gridDim.x;
    for (int rd = 0; rd < nrounds; ++rd) {
      OneUnitSched S; S.nM = 64; S.nN = 8; S.G = (int)gridDim.x; S.c = (int)blockIdx.x; S.round = rd; S.tsA = (long)256 * 1024 * 2; S.tsB = (long)256 * 1024 * 2;
      pg8::gemm_phase<EpiTopK, OneUnitSched, false, true>((PG8_LAS unsigned char*)lds, g, S, E);
    }
  }
  grid.sync();
  {
    PHASE_LOCALS
    const bf16_t* XN2 = (const bf16_t*)WSP(WS_XN2); const unsigned short* IDX = (const unsigned short*)WSP(WS_IDX);
    bf16_t* PD = (bf16_t*)WSP(WS_PD);
    const bool sl = (gridDim.x & 7) == 0;
    const int j0 = sl ? (int)(blockIdx.x & 7) : 0, nj = sl ? 1 : 8;
    const int wk = sl ? (int)(blockIdx.x >> 3) * 8 + wid : gw, nwk = sl ? (int)(gridDim.x >> 3) * 8 : ngw;
    const int lg = lane >> 4, li = lane & 15;
    unsigned* wl = (unsigned*)lds + wid * 256;
    for (int jj = 0; jj < nj; ++jj) {
      const int j = j0 + jj;
      const bf16_t* U8j = (const bf16_t*)WSP(WS_U8) + (size_t)j * 16384 * 128 + li * 8;
      for (int t = wk; t < MX; t += nwk) {
        const u32x4 xw = *(const u32x4*)(XN2 + (size_t)t * 1024 + j * 128 + li * 8);
        wl[(lane & 3) * 32 + (lane >> 2)] = IDX[(size_t)t * 128 + lane]; wl[(lane & 3) * 32 + 16 + (lane >> 2)] = IDX[(size_t)t * 128 + 64 + lane];
        asm volatile("s_waitcnt lgkmcnt(0)" ::: "memory");
        unsigned ex[32];
#pragma unroll
        for (int q = 0; q < 8; ++q) { const u32x4 v = *(const u32x4*)(wl + lg * 32 + q * 4); ex[q * 4] = v.x; ex[q * 4 + 1] = v.y; ex[q * 4 + 2] = v.z; ex[q * 4 + 3] = v.w; }
        asm volatile("s_waitcnt lgkmcnt(0)" ::: "memory");
        float keep_lo = 0.f, keep_hi = 0.f;
#pragma unroll
        for (int hf = 0; hf < 2; ++hf) {
          u32x4 uw[16];
#pragma unroll
          for (int k = 0; k < 16; ++k) uw[k] = *(const u32x4*)(U8j + (size_t)ex[hf * 16 + k] * 128);
#pragma unroll
          for (int k = 0; k < 16; ++k) {
            float dp = dot2bf(uw[k].x, xw.x, 0.f); dp = dot2bf(uw[k].y, xw.y, dp); dp = dot2bf(uw[k].z, xw.z, dp); dp = dot2bf(uw[k].w, xw.w, dp);
            dp = row16_sum(dp);
            if (li == k) { if (hf == 0) keep_lo = dp; else keep_hi = dp; }
          }
        }
        bf16_t* pd = PD + ((size_t)t * 128 + 4 * li + lg) * 8 + j;
        pd[0] = f2bf(keep_lo); pd[64 * 8] = f2bf(keep_hi);
      }
    }
    slice_table(INP(31), (bf16_t*)WSP(WS_V8), gtid, gsz);
  }
  grid.sync();
  {
    PHASE_LOCALS
    const float* X1 = (const float*)WSP(WS_X1); const float* MOD = (const float*)WSP(WS_MOD);
    const unsigned short* IDX = (const unsigned short*)WSP(WS_IDX); const float* GATE = (const float*)WSP(WS_GATE);
    const bf16_t* PD = (const bf16_t*)WSP(WS_PD); float* SSQ = (float*)WSP(WS_SSQ); float* out = GPTR(float, ldptr_(33));
    const bool sl = (gridDim.x & 7) == 0;
    const int j0 = sl ? (int)(blockIdx.x & 7) : 0, nj = sl ? 1 : 8;
    const int wk = sl ? (int)(blockIdx.x >> 3) * 8 + wid : gw, nwk = sl ? (int)(gridDim.x >> 3) * 8 : ngw;
    const int lg = lane >> 4, li = lane & 15;
    unsigned* wl = (unsigned*)lds + wid * 256;
    for (int jj = 0; jj < nj; ++jj) {
      const int j = j0 + jj;
      const bf16_t* V8j = (const bf16_t*)WSP(WS_V8) + (size_t)j * 16384 * 128 + li * 8;
      for (int t = wk; t < MX; t += nwk) {
        const u32x4 pa = *(const u32x4*)(PD + ((size_t)t * 128 + lane) * 8), pb = *(const u32x4*)(PD + ((size_t)t * 128 + 64 + lane) * 8);
        const float p_lo = ((bflo(pa.x) + bfhi(pa.x)) + (bflo(pa.y) + bfhi(pa.y))) + ((bflo(pa.z) + bfhi(pa.z)) + (bflo(pa.w) + bfhi(pa.w)));
        const float p_hi = ((bflo(pb.x) + bfhi(pb.x)) + (bflo(pb.y) + bfhi(pb.y))) + ((bflo(pb.z) + bfhi(pb.z)) + (bflo(pb.w) + bfhi(pb.w)));
        const float c_lo = GATE[(size_t)t * 128 + lane] * gelu_tanh(p_lo), c_hi = GATE[(size_t)t * 128 + 64 + lane] * gelu_tanh(p_hi);
        const int tp = (lane & 3) * 32 + (lane >> 2);
        wl[tp] = IDX[(size_t)t * 128 + lane]; wl[tp + 16] = IDX[(size_t)t * 128 + 64 + lane];
        wl[128 + tp] = __float_as_uint(c_lo); wl[128 + tp + 16] = __float_as_uint(c_hi);
        asm volatile("s_waitcnt lgkmcnt(0)" ::: "memory");
        unsigned ex[32], cfp[16];
#pragma unroll
        for (int q = 0; q < 8; ++q) {
          const u32x4 v = *(const u32x4*)(wl + lg * 32 + q * 4); ex[q * 4] = v.x; ex[q * 4 + 1] = v.y; ex[q * 4 + 2] = v.z; ex[q * 4 + 3] = v.w;
          const u32x4 c = *(const u32x4*)(wl + 128 + lg * 32 + q * 4);
          cfp[q * 2] = pg8::cvt_pk_bf16(__uint_as_float(c.x), __uint_as_float(c.y)); cfp[q * 2 + 1] = pg8::cvt_pk_bf16(__uint_as_float(c.z), __uint_as_float(c.w));
        }
        asm volatile("s_waitcnt lgkmcnt(0)" ::: "memory");
        float acc[8];
#pragma unroll
        for (int i = 0; i < 8; ++i) acc[i] = 0.f;
#pragma unroll
        for (int hf = 0; hf < 2; ++hf) {
          u32x4 vw[16];
#pragma unroll
          for (int k = 0; k < 16; ++k) vw[k] = *(const u32x4*)(V8j + (size_t)ex[hf * 16 + k] * 128);
#pragma unroll
          for (int kk = 0; kk < 8; ++kk) {
            const u32x4 A = vw[2 * kk], B = vw[2 * kk + 1]; const unsigned cf2 = cfp[hf * 8 + kk];
            acc[0] = dot2bf(__builtin_amdgcn_perm(B.x, A.x, 0x05040100u), cf2, acc[0]); acc[1] = dot2bf(__builtin_amdgcn_perm(B.x, A.x, 0x07060302u), cf2, acc[1]);
            acc[2] = dot2bf(__builtin_amdgcn_perm(B.y, A.y, 0x05040100u), cf2, acc[2]); acc[3] = dot2bf(__builtin_amdgcn_perm(B.y, A.y, 0x07060302u), cf2, acc[3]);
            acc[4] = dot2bf(__builtin_amdgcn_perm(B.z, A.z, 0x05040100u), cf2, acc[4]); acc[5] = dot2bf(__builtin_amdgcn_perm(B.z, A.z, 0x07060302u), cf2, acc[5]);
            acc[6] = dot2bf(__builtin_amdgcn_perm(B.w, A.w, 0x05040100u), cf2, acc[6]); acc[7] = dot2bf(__builtin_amdgcn_perm(B.w, A.w, 0x07060302u), cf2, acc[7]);
          }
        }
#pragma unroll
        for (int i = 0; i < 8; ++i) { acc[i] += __shfl_xor(acc[i], 16); acc[i] += __shfl_xor(acc[i], 32); }
        const int col = j * 128 + li * 8;
        const float* md = MOD + (t >> 12) * 6144 + 5120 + col;
        const f32x4 xa = *(const f32x4*)(X1 + (size_t)t * 1024 + col), xb = *(const f32x4*)(X1 + (size_t)t * 1024 + col + 4);
        const f32x4 ga = *(const f32x4*)md, gb = *(const f32x4*)(md + 4);
        f32x4 oa, ob; float ss = 0.f;
#pragma unroll
        for (int i = 0; i < 4; ++i) { oa[i] = xa[i] + ga[i] * acc[i]; ob[i] = xb[i] + gb[i] * acc[4 + i]; ss += oa[i] * oa[i] + ob[i] * ob[i]; }
        ss = row16_sum(ss);
        if (lg == 0) { *(f32x4*)(out + (size_t)t * 1024 + col) = oa; *(f32x4*)(out + (size_t)t * 1024 + col + 4) = ob; }
        if (lane == 0) SSQ[(size_t)t * 8 + j] = ss;
      }
    }
  }
  grid.sync();
  {
    PHASE_LOCALS
    const float* SSQ = (const float*)WSP(WS_SSQ); const float* fng = INP(32); float* out = GPTR(float, ldptr_(33));
    for (int row = gw; row < MX; row += ngw) {
      const f32x4 sa = *(const f32x4*)(SSQ + (size_t)row * 8), sb = *(const f32x4*)(SSQ + (size_t)row * 8 + 4);
      const float rstd = rsqrtf(((sa[0] + sa[1]) + (sa[2] + sa[3]) + (sb[0] + sb[1]) + (sb[2] + sb[3])) * (1.f / D) + 1e-6f);
#pragma unroll
      for (int jq = 0; jq < 4; ++jq) {
        float* op = out + (size_t)row * D + lane * 4 + 256 * jq;
        const f32x4 v = *(const f32x4*)op, g4 = *(const f32x4*)(fng + lane * 4 + 256 * jq);
        *(f32x4*)op = v * rstd * g4;
      }
    }
  }
}

extern "C" void kernel_launch(void* const* d_in, const int* in_sizes, int n_in, void* d_out, int out_size, void* d_ws, size_t ws_size, hipStream_t stream) {
  static int grid_blocks = 0;
  if (!grid_blocks) {
    int dev = 0, cus = 0, per_cu = 0;
    (void)hipGetDevice(&dev);
    (void)hipDeviceGetAttribute(&cus, hipDeviceAttributeMultiprocessorCount, dev);
    (void)hipFuncSetAttribute((const void*)mega, hipFuncAttributeMaxDynamicSharedMemorySize, LDS_BYTES);
    (void)hipOccupancyMaxActiveBlocksPerMultiprocessor(&per_cu, (const void*)mega, NT, LDS_BYTES);
    if (per_cu < 1) per_cu = 1;
    grid_blocks = cus * per_cu;
    if (n_in != 33 || ws_size < 255 * MiB) { fprintf(stderr, "kernel_launch: unexpected n_in %d / ws %zu\n", n_in, ws_size); }
  }
  Params p{};
  for (int i = 0; i < 33 && i < n_in; ++i) p.in[i] = (const float*)d_in[i];
  p.out = (float*)d_out; p.ws = (unsigned char*)d_ws;
  void* args[] = {&p};
  hipError_t e = hipLaunchCooperativeKernel((const void*)mega, dim3(grid_blocks), dim3(NT), args, LDS_BYTES, stream);
  if (e != hipSuccess) fprintf(stderr, "cooperative launch failed: %s (grid %d)\n", hipGetErrorString(e), grid_blocks);
}
```

```cpp
#include <hip/hip_runtime.h>
#include <hip/hip_cooperative_groups.h>
#include <cstdio>
#include <cstdint>
namespace cg = cooperative_groups;

typedef unsigned short bf16_t;
typedef float f32x4 __attribute__((ext_vector_type(4)));

constexpr int NT = 512;
constexpr int LDS_BYTES = 147456;
constexpr int Bn = 4, L = 4096, D = 1024, NCTX = 256, LA = L + NCTX;
constexpr int MX = Bn * L, MC = Bn * NCTX;
constexpr int N_IN = 5632;
constexpr size_t MiB = 1u << 20;
constexpr size_t WS_MOD = 0, WS_LAM = 128 * 1024, WS_ROPE = 136 * 1024, WS_ARDT = 144 * 1024, WS_AIDT = 160 * 1024;
constexpr size_t WS_ABRE = 192 * 1024, WS_ABIM = 224 * 1024, WS_BBRE = 256 * 1024, WS_BBIM = 512 * 1024;
constexpr size_t WS_KT = 2 * MiB;
constexpr size_t WS_XN = 4 * MiB, WS_Q = 38 * MiB, WS_K = 70 * MiB, WS_V = 104 * MiB, WS_SA = 138 * MiB, WS_G = 164 * MiB;
constexpr size_t WS_WIN = 228 * MiB, WS_WAU = 239 * MiB, WS_WSU = 241 * MiB, WS_WOUT = 242 * MiB, WS_WQ = 244 * MiB, WS_WGLU = 246 * MiB;
constexpr size_t WS_BTS = 247 * MiB;
constexpr size_t WS_BTY = 38 * MiB, WS_S = 62 * MiB, WS_YG = 79 * MiB, WS_SSMX = 95 * MiB, WS_M = 111 * MiB;
constexpr size_t WS_ATT = WS_XN, WS_X1 = 38 * MiB, WS_XN2 = WS_XN, WS_QP = WS_G;
constexpr size_t WS_IDX = 111 * MiB, WS_GATE = 115 * MiB, WS_SSQ = 123 * MiB;
constexpr size_t WS_U8 = 127 * MiB, WS_PD = 164 * MiB, WS_V8 = 196 * MiB, WS_WC = 160 * MiB, WS_CFP = 160 * MiB;
constexpr int SA_ROWS = 544, SA_LD = 768;

constexpr int PTR_OFF = LDS_BYTES - 1024;
__device__ __forceinline__ unsigned long long ldptr_(int k) {
  extern __shared__ __attribute__((aligned(16))) unsigned char lds_[];
  const unsigned long long v = ((const unsigned long long*)(lds_ + PTR_OFF))[k];
  const unsigned lo = __builtin_amdgcn_readfirstlane((unsigned)v), hi = __builtin_amdgcn_readfirstlane((unsigned)(v >> 32));
  return ((unsigned long long)hi << 32) | lo;
}
#define GPTR(T, v) ((T*)(__attribute__((address_space(1))) T*)(v))
#define INP(k) GPTR(const float, ldptr_(k))
#define WSP(off) GPTR(unsigned char, ldptr_(34) + (off))
#define PHASE_LOCALS \
  int tid = threadIdx.x; asm volatile("" : "+v"(tid)); \
  const int lane = tid & 63, wid = tid >> 6; \
  const int gtid = blockIdx.x * NT + tid, gsz = gridDim.x * NT; \
  const int gw = blockIdx.x * (NT / 64) + wid, ngw = gridDim.x * (NT / 64); \
  float* fl = (float*)lds; (void)lane; (void)wid; (void)gtid; (void)gsz; (void)gw; (void)ngw; (void)fl;

struct Params {
  const float* in[33];
  float* out;
  unsigned char* ws;
  int pad0, pad1;
};

__device__ __forceinline__ float bf2f(bf16_t v) { return __uint_as_float(((unsigned)v) << 16); }
__device__ __forceinline__ bf16_t f2bf(float f) { unsigned u = __float_as_uint(f); return (bf16_t)((u + 0x7fffu + ((u >> 16) & 1u)) >> 16); }
__device__ __forceinline__ float wave_sum(float v) {
#pragma unroll
  for (int o = 32; o; o >>= 1) v += __shfl_xor(v, o);
  return v;
}
__device__ __forceinline__ float gelu_tanh(float x) { return 0.5f * x * (1.f + tanhf(0.7978845608028654f * (x + 0.044715f * x * x * x))); }
__device__ __forceinline__ float sigmoidf_(float x) { return 1.f / (1.f + __expf(-x)); }
__device__ __forceinline__ float siluf_(float x) { return x / (1.f + __expf(-x)); }

template <class Epi>
__device__ __forceinline__ void sgemm(const bf16_t* A, int lda, const float* Bm, int ldb, int M, int N, int K, float* lds, Epi epi) {
  constexpr int TM = 128, TN = 128, TK = 16, LDA_S = TM + 4, LDB_S = TN + 4;
  float* As = lds;
  float* Bs = lds + TK * LDA_S;
  const int tid = threadIdx.x, ty = tid >> 4, tx = tid & 15;
  const int ntm = M / TM, ntn = N / TN;
  for (int tile = blockIdx.x; tile < ntm * ntn; tile += gridDim.x) {
    const int tm = tile / ntn, tn = tile % ntn;
    float acc[4][8];
#pragma unroll
    for (int i = 0; i < 4; ++i)
#pragma unroll
      for (int j = 0; j < 8; ++j) acc[i][j] = 0.f;
    const int ar = tid >> 2, ak = (tid & 3) * 4;
    const int bk = tid >> 5, bn = (tid & 31) * 4;
    for (int k0 = 0; k0 < K; k0 += TK) {
      const bf16_t* ap = A + (size_t)(tm * TM + ar) * lda + k0 + ak;
      const unsigned long long av = *(const unsigned long long*)ap;
      const f32x4 bv = *(const f32x4*)(Bm + (size_t)(k0 + bk) * ldb + tn * TN + bn);
      __syncthreads();
      As[(ak + 0) * LDA_S + ar] = bf2f((bf16_t)(av & 0xffff));
      As[(ak + 1) * LDA_S + ar] = bf2f((bf16_t)((av >> 16) & 0xffff));
      As[(ak + 2) * LDA_S + ar] = bf2f((bf16_t)((av >> 32) & 0xffff));
      As[(ak + 3) * LDA_S + ar] = bf2f((bf16_t)((av >> 48) & 0xffff));
      *(f32x4*)(Bs + bk * LDB_S + bn) = bv;
      __syncthreads();
#pragma unroll
      for (int k = 0; k < TK; ++k) {
        const f32x4 a4 = *(const f32x4*)(As + k * LDA_S + ty * 4);
        const f32x4 b0 = *(const f32x4*)(Bs + k * LDB_S + tx * 8);
        const f32x4 b1 = *(const f32x4*)(Bs + k * LDB_S + tx * 8 + 4);
#pragma unroll
        for (int i = 0; i < 4; ++i) {
          acc[i][0] += a4[i] * b0[0]; acc[i][1] += a4[i] * b0[1]; acc[i][2] += a4[i] * b0[2]; acc[i][3] += a4[i] * b0[3];
          acc[i][4] += a4[i] * b1[0]; acc[i][5] += a4[i] * b1[1]; acc[i][6] += a4[i] * b1[2]; acc[i][7] += a4[i] * b1[3];
        }
      }
    }
#pragma unroll
    for (int i = 0; i < 4; ++i)
#pragma unroll
      for (int j = 0; j < 8; ++j) epi(tm * TM + ty * 4 + i, tn * TN + tx * 8 + j, acc[i][j]);
  }
  __syncthreads();
}

namespace pg8 {
#define PG8_LAS __attribute__((address_space(3)))
typedef unsigned short bf16_t;
typedef short bf16x8 __attribute__((ext_vector_type(8)));
typedef float f32x4 __attribute__((ext_vector_type(4)));
typedef unsigned u32x4 __attribute__((ext_vector_type(4)));
constexpr int BM = 256, BK = 64, HALF = 128, HTB = HALF * BK * 2  , STAGE_BYTES = 8 * HTB, NXCD = 8, WGM = 8;

__host__ __device__ __forceinline__ int lds_byte(int r, int c) { const int st = (r >> 4) * 2 + (c >> 5), rr = r & 15, cc = c & 31, ob = rr * 64 + cc * 2; return st * 1024 + (ob ^ (((ob >> 9) & 1) << 5)); }
__host__ __device__ __forceinline__ void stage_rc(int b, int& R, int& C) { const int st = b / 1024, sb = b % 1024, swz = sb ^ (((sb >> 9) & 1) << 5); R = (st >> 1) * 16 + swz / 64; C = (st & 1) * 32 + (swz % 64) / 2; }
__host__ __device__ __forceinline__ int perm32(int rho) { const int n = rho >> 4, i = rho & 15; return 8 * (i >> 2) + 4 * n + (i & 3); }

struct Unit { int pm, pn, grp; long ao, bo; };
struct Gemm { const bf16_t* A; const bf16_t* Bt; int M, N, K, lda, ldb; };

struct StaticOrder {
    int nM, nN, nwg, G, c; long tsA, tsB;
    __host__ __device__ void init(int M, int N, int G_, int c_, int lda, int ldb) { nM = M / BM; nN = N / BM; nwg = nM * nN; G = G_; c = c_; tsA = (long)BM * lda * 2; tsB = (long)BM * ldb * 2; }
    __host__ __device__ bool next(int i, Unit& u) const {
        const long L = (long)i * G + c; if (L >= nwg) return false;
        int wgid = (int)L; { const int q = nwg / NXCD, r = nwg % NXCD, xcd = wgid % NXCD, off = wgid / NXCD; wgid = (xcd < r ? xcd * (q + 1) : r * (q + 1) + (xcd - r) * q) + off; }
        const int nig = WGM * nN, gid = wgid / nig, fm = gid * WGM, gsz = (nM - fm) < WGM ? (nM - fm) : WGM;
        u.pm = fm + ((wgid % nig) % gsz); u.pn = (wgid % nig) / gsz; u.grp = 0; u.ao = u.pm * tsA; u.bo = u.pn * tsB; return true;
    }
    __device__ __forceinline__ void a_ready(const Unit&) const {}
    __device__ __forceinline__ void done(const Unit&) const {}
};

__device__ __forceinline__ unsigned cvt_pk_bf16(float lo, float hi) { unsigned r; asm volatile("v_cvt_pk_bf16_f32 %0, %1, %2" : "=v"(r) : "v"(lo), "v"(hi)); return r; }
template <class Epi, class Sched, bool ALIGN_EPI = false, bool SP2 = false>
__device__ __forceinline__ void gemm_phase(PG8_LAS unsigned char* lds, const Gemm g, const Sched& S, const Epi& E) {
    int tid_ = threadIdx.x; asm volatile("" : "+v"(tid_));
    const int tid = tid_, wid = __builtin_amdgcn_readfirstlane(tid >> 6), lane = tid & 63, wr = wid >> 2, wc = wid & 3, fr = lane & 15, fq = lane >> 4;
    const int K = g.K, nt = K / BK;
    unsigned voffA[2], voffB[2];
#pragma unroll
    for (int i = 0; i < 2; ++i) { int R, C; stage_rc(tid * 16 + i * 8192, R, C); const int Rb = Epi::PERM ? ((R & ~31) + perm32(R & 31)) : R;
        voffA[i] = (unsigned)(R * g.lda + C) * 2u; voffB[i] = (unsigned)(Rb * g.ldb + C) * 2u; }
    const size_t kstep = (size_t)(BK * 2);
    const size_t hstepA = (size_t)HALF * g.lda * 2, hstepB = (size_t)HALF * g.ldb * 2;
    const unsigned ldsw = (unsigned)wid * 1024u;
    const int aoff = lds_byte(wr * 64 + fr, fq * 8), boff = lds_byte(wc * 32 + fr, fq * 8);
#define PG8_SA(b, h) (((b) * 2 + (h)) * HTB)
#define PG8_SB(b, h) ((4 + (b) * 2 + (h)) * HTB)
#define PG8_STAGE(bufoff, gbase, voff) do { _Pragma("unroll") for (int _i = 0; _i < 2; ++_i) \
        __builtin_amdgcn_global_load_lds((const unsigned*)((const char*)(gbase) + (voff)[_i]), (PG8_LAS unsigned*)(lds + (bufoff) + ldsw + _i * 8192), 16, 0, 0); } while (0)
#define PG8_LDA(dst, b, h) do { _Pragma("unroll") for (int m = 0; m < 4; ++m) _Pragma("unroll") for (int k = 0; k < 2; ++k) dst[m][k] = *(const PG8_LAS bf16x8*)(lds + PG8_SA(b, h) + aoff + m * 2048 + k * 1024); } while (0)
#define PG8_LDB(dst, b, h) do { _Pragma("unroll") for (int n = 0; n < 2; ++n) _Pragma("unroll") for (int k = 0; k < 2; ++k) dst[n][k] = *(const PG8_LAS bf16x8*)(lds + PG8_SB(b, h) + boff + n * 2048 + k * 1024); } while (0)
#define PG8_MMA(ai, bj, At, Bt) do { __builtin_amdgcn_s_setprio(1); _Pragma("unroll") for (int m = 0; m < 4; ++m) _Pragma("unroll") for (int n = 0; n < 2; ++n) _Pragma("unroll") for (int k = 0; k < 2; ++k) \
        acc[ai][bj][m][n] = __builtin_amdgcn_mfma_f32_16x16x32_bf16(Bt[n][k], At[m][k], acc[ai][bj][m][n], 0, 0, 0); __builtin_amdgcn_s_setprio(0); } while (0)
#define PG8_WAIT_V(n) asm volatile("s_waitcnt vmcnt(" #n ")" ::: "memory")
#define PG8_WAIT_L(n) asm volatile("s_waitcnt lgkmcnt(" #n ")" ::: "memory")
#define PG8_BAR __builtin_amdgcn_s_barrier()
#define PG8_SCHED __builtin_amdgcn_sched_barrier(0)
    Unit cur, nxt; int ui = 0;
    if (!S.next(0, cur)) return;
    f32x4 acc[2][2][4][2];
#pragma unroll
    for (int a = 0; a < 2; ++a)
#pragma unroll
        for (int b = 0; b < 2; ++b)
#pragma unroll
            for (int m = 0; m < 4; ++m)
#pragma unroll
                for (int n = 0; n < 2; ++n) acc[a][b][m][n] = (f32x4){0.f, 0.f, 0.f, 0.f};
    bf16x8 At[4][2], B0[2][2], B1[2][2];
    const char* cA = (const char*)g.A + cur.ao; const char* cB = (const char*)g.Bt + cur.bo;
    S.a_ready(cur);
    if constexpr (SP2) {
        PG8_STAGE(PG8_SB(0, 0), cB, voffB); PG8_STAGE(PG8_SB(0, 1), cB + hstepB, voffB); PG8_STAGE(PG8_SA(0, 0), cA, voffA); PG8_STAGE(PG8_SA(0, 1), cA + hstepA, voffA);
        if (wr == 1) PG8_BAR;
        PG8_WAIT_V(2); PG8_BAR;
        PG8_STAGE(PG8_SB(1, 0), cB + kstep, voffB); PG8_STAGE(PG8_SA(1, 0), cA + kstep, voffA); PG8_STAGE(PG8_SB(1, 1), cB + hstepB + kstep, voffB);
        PG8_WAIT_V(6); PG8_BAR;
    } else {
        PG8_STAGE(PG8_SB(0, 0), cB, voffB); PG8_STAGE(PG8_SA(0, 0), cA, voffA); PG8_STAGE(PG8_SB(0, 1), cB + hstepB, voffB); PG8_STAGE(PG8_SA(0, 1), cA + hstepA, voffA);
        if (wr == 1) PG8_BAR;
        PG8_WAIT_V(4); PG8_BAR;
        PG8_STAGE(PG8_SB(1, 0), cB + kstep, voffB); PG8_STAGE(PG8_SA(1, 0), cA + kstep, voffA); PG8_STAGE(PG8_SB(1, 1), cB + hstepB + kstep, voffB);
        PG8_WAIT_V(6); PG8_BAR;
    }
    for (;;) {
        const bool has_next = S.next(ui + 1, nxt);
        const char* nA = has_next ? (const char*)g.A + nxt.ao : cA; const char* nB = has_next ? (const char*)g.Bt + nxt.bo : cB;
        for (int t = 0; t < nt; t += 2) {
            const bool last = (t == nt - 2);
            const char* a1 = cA + (size_t)(t + 1) * kstep;
            const char* a2 = last ? nA : cA + (size_t)(t + 2) * kstep; const char* b2 = last ? nB : cB + (size_t)(t + 2) * kstep;
            const char* a3 = a2 + kstep; const char* b3 = b2 + kstep;
            if (last && has_next) S.a_ready(nxt);
            if constexpr (SP2) {
            PG8_LDB(B0, 0, 0); PG8_LDB(B1, 0, 1); PG8_SCHED; PG8_LDA(At, 0, 0); PG8_STAGE(PG8_SA(1, 1), a1 + hstepA, voffA);
            PG8_WAIT_V(8); PG8_WAIT_L(0); PG8_BAR; PG8_MMA(0, 0, At, B0); PG8_MMA(0, 1, At, B1); PG8_BAR; PG8_SCHED;
            PG8_LDA(At, 0, 1); PG8_STAGE(PG8_SB(0, 0), b2, voffB); PG8_STAGE(PG8_SB(0, 1), b2 + hstepB, voffB); PG8_STAGE(PG8_SA(0, 0), a2, voffA);
            PG8_WAIT_V(8); PG8_WAIT_L(0); PG8_BAR; PG8_MMA(1, 0, At, B0); PG8_MMA(1, 1, At, B1); PG8_BAR; PG8_SCHED;
            PG8_LDB(B0, 1, 0); PG8_LDB(B1, 1, 1); PG8_SCHED; PG8_LDA(At, 1, 0); PG8_STAGE(PG8_SA(0, 1), a2 + hstepA, voffA);
            PG8_WAIT_V(8); PG8_WAIT_L(0); PG8_BAR; PG8_MMA(0, 0, At, B0); PG8_MMA(0, 1, At, B1); PG8_BAR; PG8_SCHED;
            PG8_LDA(At, 1, 1); PG8_STAGE(PG8_SB(1, 0), b3, voffB); PG8_STAGE(PG8_SB(1, 1), b3 + hstepB, voffB); PG8_STAGE(PG8_SA(1, 0), a3, voffA);
            PG8_WAIT_V(8); PG8_WAIT_L(0); PG8_BAR; PG8_MMA(1, 0, At, B0); PG8_MMA(1, 1, At, B1); PG8_BAR; PG8_SCHED;
            } else {
            PG8_LDB(B0, 0, 0); PG8_SCHED; PG8_LDA(At, 0, 0); PG8_STAGE(PG8_SA(1, 1), a1 + hstepA, voffA);
            PG8_WAIT_L(8); PG8_BAR; PG8_WAIT_L(0); PG8_MMA(0, 0, At, B0); PG8_BAR; PG8_SCHED;
            PG8_LDB(B1, 0, 1); PG8_STAGE(PG8_SB(0, 0), b2, voffB);
            PG8_BAR; PG8_WAIT_L(0); PG8_MMA(0, 1, At, B1); PG8_BAR;
            PG8_LDA(At, 0, 1); PG8_STAGE(PG8_SA(0, 0), a2, voffA);
            PG8_BAR; PG8_WAIT_L(0); PG8_MMA(1, 0, At, B0); PG8_BAR; PG8_SCHED;
            PG8_STAGE(PG8_SB(0, 1), b2 + hstepB, voffB);
            PG8_WAIT_V(6); PG8_BAR; PG8_MMA(1, 1, At, B1); PG8_BAR;
            PG8_LDB(B0, 1, 0); PG8_SCHED; PG8_LDA(At, 1, 0); PG8_STAGE(PG8_SA(0, 1), a2 + hstepA, voffA);
            PG8_WAIT_L(8); PG8_BAR; PG8_WAIT_L(0); PG8_MMA(0, 0, At, B0); PG8_BAR; PG8_SCHED;
            PG8_LDB(B1, 1, 1); PG8_STAGE(PG8_SB(1, 0), b3, voffB);
            PG8_BAR; PG8_WAIT_L(0); PG8_MMA(0, 1, At, B1); PG8_BAR;
            PG8_LDA(At, 1, 1); PG8_STAGE(PG8_SA(1, 0), a3, voffA);
            PG8_BAR; PG8_WAIT_L(0); PG8_MMA(1, 0, At, B0); PG8_BAR; PG8_SCHED;
            PG8_STAGE(PG8_SB(1, 1), b3 + hstepB, voffB);
            PG8_WAIT_V(6); PG8_BAR; PG8_MMA(1, 1, At, B1); PG8_BAR;
            }
        }
        if constexpr (ALIGN_EPI) { if (wr == 0) PG8_BAR; }
        if constexpr (!Epi::AFTER_DRAIN) { int fr_ = fr, fq_ = fq; asm volatile("" : "+v"(fr_), "+v"(fq_));
            E(acc, cur, wr, wc, fr_, fq_); S.done(cur); }
        if (!has_next) break;
#pragma unroll
        for (int a = 0; a < 2; ++a)
#pragma unroll
            for (int b = 0; b < 2; ++b)
#pragma unroll
                for (int m = 0; m < 4; ++m)
#pragma unroll
                    for (int n = 0; n < 2; ++n) acc[a][b][m][n] = (f32x4){0.f, 0.f, 0.f, 0.f};
        cur = nxt; cA = nA; cB = nB; ++ui;
        if constexpr (ALIGN_EPI) { if (wr == 1) PG8_BAR; }
    }
    PG8_WAIT_V(0);
    if constexpr (!ALIGN_EPI) { if (wr == 0) PG8_BAR; }
    PG8_BAR;
    if constexpr (Epi::AFTER_DRAIN) { int fr_ = fr, fq_ = fq, lane_ = lane; asm volatile("" : "+v"(fr_), "+v"(fq_), "+v"(lane_)); E.fused(acc, cur, wr, wc, fr_, fq_, lds, wid, lane_); S.done(cur); }
#undef PG8_SA
#undef PG8_SB
#undef PG8_STAGE
#undef PG8_LDA
#undef PG8_LDB
#undef PG8_MMA
#undef PG8_WAIT_V
#undef PG8_WAIT_L
#undef PG8_BAR
#undef PG8_SCHED
}
}


using pg8::Unit;
typedef unsigned u32x2 __attribute__((ext_vector_type(2)));
typedef unsigned u32x4 __attribute__((ext_vector_type(4)));
__device__ __forceinline__ float bflo(unsigned w) { return __uint_as_float(w << 16); }
__device__ __forceinline__ float bfhi(unsigned w) { return __uint_as_float(w & 0xffff0000u); }

struct InProjSched {
  pg8::StaticOrder so;
  __device__ __forceinline__ void init(int G, int c) { so.init(MX, N_IN, G, c, D, D); }
  __device__ __forceinline__ bool next(int i, Unit& u) const {
    const long Lx = (long)i * so.G + so.c;
    if (Lx < so.nwg) return so.next(i, u);
    const int j = (int)(Lx - so.nwg); if (j >= 40) return false;
    u.pm = 64 + (j & 3); u.pn = 4 + (j >> 2); u.grp = 0; u.ao = u.pm * so.tsA; u.bo = u.pn * so.tsB; return true;
  }
  __device__ __forceinline__ void a_ready(const Unit&) const {}
  __device__ __forceinline__ void done(const Unit&) const {}
};

struct EpiInProj {
  static constexpr bool PERM = false, AFTER_DRAIN = false;
  bf16_t *Q, *K, *V, *SA, *G; const float* rope;
  __device__ __forceinline__ static void st4(bf16_t* p, const f32x4 v) { u32x2 w; w.x = pg8::cvt_pk_bf16(v[0], v[1]); w.y = pg8::cvt_pk_bf16(v[2], v[3]); *(u32x2*)p = w; }
  __device__ __forceinline__ void operator()(const f32x4 (&acc)[2][2][4][2], const Unit& u, int wr, int wc, int fr, int fq) const {
    const int row0 = u.pm * 256 + wr * 64 + fr;
    const int cg0 = u.pn * 256 + wc * 32 + fq * 4;
    if (u.pm < 64) {
      if (u.pn < 8) {
        const bool isq = u.pn < 4;
#pragma unroll
        for (int ai = 0; ai < 2; ++ai)
#pragma unroll
          for (int m = 0; m < 4; ++m) {
            const int row = row0 + ai * 128 + m * 16, b = row >> 12, t = row & 4095;
            const int pos = (wc & 1) ? (t & 63) : (t >> 6);
            const f32x4* rp = (const f32x4*)(rope + (pos * 16 + fq * 4) * 2);
            const f32x4 r0 = rp[0], r1 = rp[1];
            const f32x4 cs = {r0[0], r0[2], r1[0], r1[2]}, sn = {r0[1], r0[3], r1[1], r1[3]};
            bf16_t* dst = isq ? Q + (size_t)row * 1024 + cg0 : K + ((size_t)b * LA + NCTX + t) * 1024 + (cg0 - 1024);
#pragma unroll
            for (int bj = 0; bj < 2; ++bj) {
              const f32x4 h1 = acc[ai][bj][m][0], h2 = acc[ai][bj][m][1];
              st4(dst + bj * 128, h1 * cs - h2 * sn);
              st4(dst + bj * 128 + 16, h2 * cs + h1 * sn);
            }
          }
      } else {
#pragma unroll
        for (int ai = 0; ai < 2; ++ai)
#pragma unroll
          for (int m = 0; m < 4; ++m) {
            const int row = row0 + ai * 128 + m * 16, b = row >> 12, t = row & 4095;
            const size_t kr = (size_t)b * LA + NCTX + t;
            if (u.pn >= 12 && u.pn < 14) {
#pragma unroll
              for (int bj = 0; bj < 2; ++bj)
#pragma unroll
                for (int n = 0; n < 2; ++n) {
                  const int ch = cg0 + bj * 128 + n * 16 - 3072;
                  st4(SA + ((size_t)(ch >> 4) * SA_ROWS + b * 128 + (t >> 5)) * SA_LD + (t & 31) * 16 + (ch & 15), acc[ai][bj][m][n]);
                }
            } else {
              bf16_t* dst = u.pn < 12 ? V + kr * 1024 + (cg0 - 2048) : G + (size_t)row * 2048 + (cg0 - 3584);
#pragma unroll
              for (int bj = 0; bj < 2; ++bj)
#pragma unroll
                for (int n = 0; n < 2; ++n) {
                  f32x4 v = acc[ai][bj][m][n];
                  if (u.pn >= 14) { v[0] = sigmoidf_(v[0]); v[1] = sigmoidf_(v[1]); v[2] = sigmoidf_(v[2]); v[3] = sigmoidf_(v[3]); }
                  st4(dst + bj * 128 + n * 16, v);
                }
            }
          }
      }
    } else {
#pragma unroll
      for (int ai = 0; ai < 2; ++ai)
#pragma unroll
        for (int m = 0; m < 4; ++m) {
          const int rc = row0 + ai * 128 + m * 16 - MX, b = rc >> 8, t = rc & 255;
          const size_t kr = (size_t)b * LA + t;
          if (u.pn >= 12) {
#pragma unroll
            for (int bj = 0; bj < 2; ++bj)
#pragma unroll
              for (int n = 0; n < 2; ++n) {
                const int ch = cg0 + bj * 128 + n * 16 - 3072;
                st4(SA + ((size_t)(ch >> 4) * SA_ROWS + 512 + b * 8 + (t >> 5)) * SA_LD + (t & 31) * 16 + (ch & 15), acc[ai][bj][m][n]);
              }
          } else {
            bf16_t* dst = u.pn < 8 ? K + kr * 1024 + (cg0 - 1024) : V + kr * 1024 + (cg0 - 2048);
#pragma unroll
            for (int bj = 0; bj < 2; ++bj)
#pragma unroll
              for (int n = 0; n < 2; ++n) st4(dst + bj * 128 + n * 16, acc[ai][bj][m][n]);
          }
        }
    }
  }
};
template <int MODE>
struct EpiBf8 {
  static constexpr bool PERM = true, AFTER_DRAIN = false;
  bf16_t* O; int ldo; const bf16_t* X; int ldx; const float* bias;
  __device__ __forceinline__ void operator()(const f32x4 (&acc)[2][2][4][2], const Unit& u, int wr, int wc, int fr, int fq) const {
    const int row0 = u.pm * 256 + wr * 64 + fr, col0 = u.pn * 256 + wc * 32 + 8 * fq;
#pragma unroll
    for (int ai = 0; ai < 2; ++ai)
#pragma unroll
      for (int m = 0; m < 4; ++m) {
        const int row = row0 + ai * 128 + m * 16;
#pragma unroll
        for (int bj = 0; bj < 2; ++bj) {
          const int col = col0 + bj * 128;
          f32x4 v0 = acc[ai][bj][m][0], v1 = acc[ai][bj][m][1];
          const u32x4 xw = *(const u32x4*)(X + (size_t)row * ldx + col);
          const f32x4 x0 = {bflo(xw.x), bfhi(xw.x), bflo(xw.y), bfhi(xw.y)}, x1 = {bflo(xw.z), bfhi(xw.z), bflo(xw.w), bfhi(xw.w)};
          if (MODE == 0) {
            const f32x4 b0 = *(const f32x4*)(bias + col), b1 = *(const f32x4*)(bias + col + 4);
#pragma unroll
            for (int i = 0; i < 4; ++i) { v0[i] = x0[i] * sigmoidf_(v0[i] + b0[i]); v1[i] = x1[i] * sigmoidf_(v1[i] + b1[i]); }
          } else if (MODE == 1) { v0 = v0 * x0; v1 = v1 * x1; }
          else {
            const u32x4 ow = *(const u32x4*)(O + (size_t)row * ldo + col);
            const f32x4 o0 = {bflo(ow.x), bfhi(ow.x), bflo(ow.y), bfhi(ow.y)}, o1 = {bflo(ow.z), bfhi(ow.z), bflo(ow.w), bfhi(ow.w)};
            v0 = o0 + v0 * x0; v1 = o1 + v1 * x1;
          }
          u32x4 w; w.x = pg8::cvt_pk_bf16(v0[0], v0[1]); w.y = pg8::cvt_pk_bf16(v0[2], v0[3]); w.z = pg8::cvt_pk_bf16(v1[0], v1[1]); w.w = pg8::cvt_pk_bf16(v1[2], v1[3]);
          *(u32x4*)(O + (size_t)row * ldo + col) = w;
        }
      }
  }
};
template <int MODE>
struct EpiF32 {
  static constexpr bool PERM = false, AFTER_DRAIN = false;
  float* O; const float* xres; const float* mod;
  __device__ __forceinline__ void operator()(const f32x4 (&acc)[2][2][4][2], const Unit& u, int wr, int wc, int fr, int fq) const {
    const int row0 = u.pm * 256 + wr * 64 + fr, col0 = u.pn * 256 + wc * 32 + 4 * fq;
#pragma unroll
    for (int ai = 0; ai < 2; ++ai)
#pragma unroll
      for (int m = 0; m < 4; ++m) {
        const int row = row0 + ai * 128 + m * 16;
#pragma unroll
        for (int bj = 0; bj < 2; ++bj)
#pragma unroll
          for (int n = 0; n < 2; ++n) {
            const int col = col0 + bj * 128 + n * 16;
            f32x4 v = acc[ai][bj][m][n];
            if (MODE == 1) { const f32x4 xr = *(const f32x4*)(xres + (size_t)row * 1024 + col); const f32x4 g = *(const f32x4*)(mod + (row >> 12) * 6144 + 2048 + col); v = xr + g * v; }
            *(f32x4*)(O + (size_t)row * 1024 + col) = v;
          }
      }
  }
};


struct GroupSched {
  int npm, npn, nunits, G, c; long gsA, gsB, tsA, tsB;
  __device__ __forceinline__ void init(int ngrp, int npm_, int npn_, long gsA_, long tsA_, long gsB_, long tsB_, int G_, int c_) { npm = npm_; npn = npn_; nunits = ngrp * npm_ * npn_; gsA = gsA_; tsA = tsA_; gsB = gsB_; tsB = tsB_; G = G_; c = c_; }
  __device__ __forceinline__ bool next(int i, Unit& u) const {
    const long Lx = (long)i * G + c; if (Lx >= nunits) return false;
    const int per = npm * npn, grp = (int)Lx / per, r = (int)Lx % per;
    u.grp = grp; u.pm = r / npn; u.pn = r % npn; u.ao = grp * gsA + u.pm * tsA; u.bo = grp * gsB + u.pn * tsB; return true;
  }
  __device__ __forceinline__ void a_ready(const Unit&) const {}
  __device__ __forceinline__ void done(const Unit&) const {}
};
struct EpiS {
  static constexpr bool PERM = false, AFTER_DRAIN = false;
  float* S;
  __device__ __forceinline__ void operator()(const f32x4 (&acc)[2][2][4][2], const Unit& u, int wr, int wc, int fr, int fq) const {
    const int row0 = u.pm * 256 + wr * 64 + fr, col0 = wc * 32 + 4 * fq;
#pragma unroll
    for (int ai = 0; ai < 2; ++ai)
#pragma unroll
      for (int m = 0; m < 4; ++m) {
        const int row = row0 + ai * 128 + m * 16;
        if (row < SA_ROWS) {
#pragma unroll
          for (int bj = 0; bj < 2; ++bj)
#pragma unroll
            for (int n = 0; n < 2; ++n) *(f32x4*)(S + ((size_t)u.grp * SA_ROWS + row) * 256 + col0 + bj * 128 + n * 16) = acc[ai][bj][m][n];
        }
      }
  }
};
struct EpiY {
  static constexpr bool PERM = true, AFTER_DRAIN = false;
  bf16_t* YG;
  __device__ __forceinline__ void operator()(const f32x4 (&acc)[2][2][4][2], const Unit& u, int wr, int wc, int fr, int fq) const {
    const int row0 = u.pm * 256 + wr * 64 + fr, col0 = u.pn * 256 + wc * 32 + 8 * fq;
#pragma unroll
    for (int ai = 0; ai < 2; ++ai)
#pragma unroll
      for (int m = 0; m < 4; ++m) {
        const int row = row0 + ai * 128 + m * 16, b = row >> 7, cx = row & 127;
#pragma unroll
        for (int bj = 0; bj < 2; ++bj) {
          const int col = col0 + bj * 128, j = col >> 4, p0 = col & 15;
          const f32x4 v0 = acc[ai][bj][m][0], v1 = acc[ai][bj][m][1];
          u32x4 w; w.x = pg8::cvt_pk_bf16(gelu_tanh(v0[0]), gelu_tanh(v0[1])); w.y = pg8::cvt_pk_bf16(gelu_tanh(v0[2]), gelu_tanh(v0[3]));
          w.z = pg8::cvt_pk_bf16(gelu_tanh(v1[0]), gelu_tanh(v1[1])); w.w = pg8::cvt_pk_bf16(gelu_tanh(v1[2]), gelu_tanh(v1[3]));
          *(u32x4*)(YG + ((size_t)(b * L + cx * 32 + j)) * 512 + u.grp * 16 + p0) = w;
        }
      }
  }
};


__device__ __forceinline__ unsigned f2key(float s) { const unsigned u = __float_as_uint(s); return u ^ ((u & 0x80000000u) ? 0xFFFFFFFFu : 0x80000000u); }
__device__ __forceinline__ float key2f(unsigned k) { return __uint_as_float(k ^ ((k & 0x80000000u) ? 0x80000000u : 0xFFFFFFFFu)); }
#define TK_INSERT(L, cv) do { _Pragma("unroll") for (int k_ = 0; k_ < 16; ++k_) { const unsigned hi_ = L[k_] > cv ? L[k_] : cv, lo_ = L[k_] > cv ? cv : L[k_]; L[k_] = hi_; cv = lo_; } } while (0)
struct EpiTopK {
  static constexpr bool PERM = false, AFTER_DRAIN = true;
  unsigned short* IDX; float* GATE;
  __device__ __forceinline__ void fused(f32x4 (&acc)[2][2][4][2], const Unit& u, int wr, int wc, int fr, int fq, PG8_LAS unsigned char* lds, int wid, int lane) const {
    PG8_LAS float* SC = (PG8_LAS float*)lds;
    const int tid = wid * 64 + lane;
#pragma unroll
    for (int ai = 0; ai < 2; ++ai) {
#pragma unroll
      for (int m = 0; m < 4; ++m)
#pragma unroll
        for (int bj = 0; bj < 2; ++bj)
#pragma unroll
          for (int n = 0; n < 2; ++n)
#pragma unroll
            for (int i = 0; i < 4; ++i) SC[(64 * wr + 16 * m + fr) * 257 + 128 * bj + 32 * wc + 16 * n + 4 * fq + i] = acc[ai][bj][m][n][i];
      asm volatile("s_waitcnt lgkmcnt(0)" ::: "memory"); __builtin_amdgcn_s_barrier(); asm volatile("" ::: "memory");
      if (tid < 256) {
        PG8_LAS float* rowp = SC + (tid & 127) * 257 + (tid >> 7) * 128;
        unsigned Lk[16];
#pragma unroll
        for (int k = 0; k < 16; ++k) Lk[k] = 0u;
        for (int k = 0; k < 128; ++k) { unsigned cv = (f2key(rowp[k]) & ~0x7Fu) | (unsigned)(127 - k); TK_INSERT(Lk, cv); }
#pragma unroll
        for (int k = 0; k < 16; ++k) rowp[k] = __uint_as_float(Lk[k]);
      }
      asm volatile("s_waitcnt lgkmcnt(0)" ::: "memory"); __builtin_amdgcn_s_barrier(); asm volatile("" ::: "memory");
      if (tid < 128) {
        PG8_LAS float* rowp = SC + tid * 257;
        float v1[16], v2[16];
#pragma unroll
        for (int k = 0; k < 16; ++k) { v1[k] = key2f(__float_as_uint(rowp[k]) & ~0x7Fu); v2[k] = key2f(__float_as_uint(rowp[128 + k]) & ~0x7Fu); }
        unsigned Lc[16];
#pragma unroll
        for (int k = 0; k < 16; ++k) Lc[k] = 0u;
#pragma unroll
        for (int a = 0; a < 16; ++a)
#pragma unroll
          for (int b = 0; b < 16; ++b)
            if ((a + 1) * (b + 1) <= 16) { unsigned cv = (f2key(v1[a] + v2[b]) & ~0xFFu) | (unsigned)(255 - (a * 16 + b)); TK_INSERT(Lc, cv); }
        float ev[16]; float den = 0.f; const float mx = key2f(Lc[0] & ~0xFFu);
#pragma unroll
        for (int k = 0; k < 16; ++k) { ev[k] = __expf(key2f(Lc[k] & ~0xFFu) - mx); den += ev[k]; }
        const float inv = 1.f / den;
        const size_t o = ((size_t)(u.pm * 256 + ai * 128 + tid) * 8 + u.pn) * 16;
        unsigned iw[8];
#pragma unroll
        for (int k = 0; k < 16; ++k) {
          const int code = 255 - (int)(Lc[k] & 0xFFu), a = code >> 4, b = code & 15;
          const unsigned e1 = 127u - (__float_as_uint(rowp[a]) & 0x7Fu), e2 = 127u - (__float_as_uint(rowp[128 + b]) & 0x7Fu);
          const unsigned ex = e1 * 128u + e2;
          if (k & 1) iw[k >> 1] |= ex << 16; else iw[k >> 1] = ex;
        }
        *(u32x4*)(IDX + o) = (u32x4){iw[0], iw[1], iw[2], iw[3]}; *(u32x4*)(IDX + o + 8) = (u32x4){iw[4], iw[5], iw[6], iw[7]};
#pragma unroll
        for (int k = 0; k < 16; k += 4) *(f32x4*)(GATE + o + k) = (f32x4){ev[k] * inv, ev[k + 1] * inv, ev[k + 2] * inv, ev[k + 3] * inv};
      }
      asm volatile("s_waitcnt lgkmcnt(0)" ::: "memory"); __builtin_amdgcn_s_barrier(); asm volatile("" ::: "memory");
    }
  }
};
struct OneUnitSched {
  int nM, nN, G, c, round; long tsA, tsB;
  __device__ __forceinline__ bool next(int i, Unit& u) const {
    if (i > 0) return false;
    const long Lx = (long)round * G + c; if (Lx >= (long)nM * nN) return false;
    u.pm = (int)(Lx % nM); u.pn = (int)(Lx / nM); u.grp = 0; u.ao = u.pm * tsA; u.bo = u.pn * tsB; return true;
  }
  __device__ __forceinline__ void a_ready(const Unit&) const {}
  __device__ __forceinline__ void done(const Unit&) const {}
};

__device__ __forceinline__ void transpose_item(const float* W, int K, int N, bf16_t* WT, float* scr, int item, int lane) {
  const int nblk = N / 32, kb = item / nblk, nb = item % nblk, k0 = 64 * kb, n0 = 32 * nb;
#pragma unroll 8
  for (int i = 0; i < 32; ++i) { const int kk = 2 * i + (lane >> 5); scr[kk * 33 + (lane & 31)] = W[(size_t)(k0 + kk) * N + n0 + (lane & 31)]; }
  asm volatile("s_waitcnt lgkmcnt(0)" ::: "memory");
  const int c = lane & 7;
#pragma unroll
  for (int j = 0; j < 4; ++j) {
    const int n = (lane >> 3) + 8 * j; const float* s = scr + (8 * c) * 33 + n;
    u32x4 o; o.x = pg8::cvt_pk_bf16(s[0], s[33]); o.y = pg8::cvt_pk_bf16(s[66], s[99]); o.z = pg8::cvt_pk_bf16(s[132], s[165]); o.w = pg8::cvt_pk_bf16(s[198], s[231]);
    *(u32x4*)(WT + (size_t)(n0 + n) * K + k0 + 8 * c) = o;
  }
  asm volatile("s_waitcnt lgkmcnt(0)" ::: "memory");
}

namespace att {
using bf16 = unsigned short;
constexpr int   D = 128, NW = 8, QBLK = 32, KVBLK = 64, SDEPTH = 2;
constexpr float SCALE = 0.125f;
constexpr float THR = 8.f;
constexpr int LDQ = 1024, LDK = 1024, LDO = 1024;
constexpr size_t SHM_V = KVBLK * D * 2, SHM_K = KVBLK * D * 2, SHM_ATTN = 2 * SHM_V + 2 * SHM_K + NW * 64 * 4 + 4 * 4 * 16 * 64 * 4;
using bf16x8 = __attribute__((ext_vector_type(8))) short;
using s16x4  = __attribute__((ext_vector_type(4))) short;
using f32x16 = __attribute__((ext_vector_type(16))) float;
using f32x8  = __attribute__((ext_vector_type(8))) float;
using u32x4  = __attribute__((ext_vector_type(4))) unsigned;
#define KSWZ(row, colB) ((row) * 256 + ((colB) ^ (((row) & 7) << 4)))
#define SBAR() __builtin_amdgcn_sched_barrier(0)
__device__ __forceinline__ int crow(int r, int hi) { return (r & 3) + 8 * (r >> 2) + 4 * hi; }
__device__ __forceinline__ unsigned cvtpk(float lo, float hi) {
  unsigned r; asm volatile("v_cvt_pk_bf16_f32 %0, %1, %2" : "=v"(r) : "v"(lo), "v"(hi)); return r;
}
template <typename TIn> struct Stage;
template <> struct Stage<bf16>  { using T = bf16x8;
  __device__ static __forceinline__ T ld8(const bf16* p) { return *(const __attribute__((address_space(1))) bf16x8*)(p); }
  __device__ static __forceinline__ bf16x8 tobf(T x) { return x; } };
__device__ __forceinline__ void partialSM(f32x16& p0, f32x16& p1, float& m_reg, float& mn, float& alpha) {
  constexpr float C = SCALE * 1.4426950408889634f;
  float pmax = p0[0]; for (int r = 1; r < 16; ++r) pmax = fmaxf(pmax, p0[r]); for (int r = 0; r < 16; ++r) pmax = fmaxf(pmax, p1[r]);
  { auto rr = __builtin_amdgcn_permlane32_swap(__float_as_uint(pmax), __float_as_uint(pmax), false, false);
    pmax = fmaxf(__uint_as_float(rr[0]), __uint_as_float(rr[1])); }
  if (__builtin_expect(__all(pmax - m_reg <= THR / SCALE), 1)) { mn = m_reg; alpha = 1.f; }
  else { mn = fmaxf(m_reg, pmax); alpha = __builtin_amdgcn_exp2f((m_reg - mn) * C); m_reg = mn; }
  float mnC = -mn * C;
  for (int r = 0; r < 16; ++r) p0[r] = fmaf(p0[r], C, mnC); for (int r = 0; r < 16; ++r) p1[r] = fmaf(p1[r], C, mnC);
  for (int r = 0; r < 16; ++r) p0[r] = __builtin_amdgcn_exp2f(p0[r]);
}
__device__ __forceinline__ void finishSM(f32x16& p0, f32x16& p1, float alpha, float& l_reg, bf16x8& pa0, bf16x8& pa1, bf16x8& pa2, bf16x8& pa3) {
  for (int r = 0; r < 16; ++r) p1[r] = __builtin_amdgcn_exp2f(p1[r]);
  float ps = 0; for (int r = 0; r < 16; ++r) ps += p0[r]; for (int r = 0; r < 16; ++r) ps += p1[r];
  { auto rr = __builtin_amdgcn_permlane32_swap(__float_as_uint(ps), __float_as_uint(ps), false, false);
    ps = __uint_as_float(rr[0]) + __uint_as_float(rr[1]); }
  l_reg = l_reg * alpha + ps;
#define PK4(P, BASE, OUT) do { unsigned a0 = cvtpk(P[BASE + 0], P[BASE + 1]), a1 = cvtpk(P[BASE + 2], P[BASE + 3]);   \
    unsigned b0 = cvtpk(P[BASE + 4], P[BASE + 5]), b1 = cvtpk(P[BASE + 6], P[BASE + 7]);                              \
    auto r0 = __builtin_amdgcn_permlane32_swap(a0, b0, false, false); auto r1 = __builtin_amdgcn_permlane32_swap(a1, b1, false, false); \
    u32x4 w = {r0[0], r1[0], r0[1], r1[1]}; OUT = *reinterpret_cast<bf16x8*>(&w); } while (0)
  PK4(p0, 0, pa0); PK4(p0, 8, pa1); PK4(p1, 0, pa2); PK4(p1, 8, pa3);
#undef PK4
}
typedef __attribute__((address_space(3))) const char* lds_cptr_t;
__device__ __forceinline__ void qkt(f32x16& p0, f32x16& p1, const bf16* Ks, const char* qfl_, int r32, int hi, int mcolB) {
  p0 = f32x16{}; p1 = f32x16{};
  unsigned qoff = (unsigned)(uintptr_t)qfl_;
  asm volatile("" : "+v"(qoff));
  const lds_cptr_t qfl = (lds_cptr_t)qoff;
  bf16x8 qr[4];
#pragma unroll
  for (int d0 = 0; d0 < 4; ++d0) qr[d0] = *(const __attribute__((address_space(3))) bf16x8*)(qfl + d0 * 1024);
#pragma unroll
  for (int d0 = 0; d0 < 4; ++d0) { int cb = mcolB + (d0 * 16 + hi * 8) * 2;
    bf16x8 b0 = *reinterpret_cast<const bf16x8*>((const char*)Ks + KSWZ(r32, cb));
    bf16x8 b1 = *reinterpret_cast<const bf16x8*>((const char*)Ks + KSWZ(32 + r32, cb));
    p0 = __builtin_amdgcn_mfma_f32_32x32x16_bf16(b0, qr[d0], p0, 0, 0, 0);
    p1 = __builtin_amdgcn_mfma_f32_32x32x16_bf16(b1, qr[d0], p1, 0, 0, 0); }
}
__device__ __forceinline__ int v_st(int k, int c) { const int kk = (k & ~0xC) | ((k & 4) << 1) | ((k & 8) >> 1); return ((kk >> 3) * 4 + (c >> 5)) * 512 + ((kk & 7) * 32 + (c & 31)) * 2; }
__device__ __forceinline__ int v_rd_base(int lane) { return ((lane & 3) << 3) | (((lane >> 2) & 3) << 6) | (((lane >> 4) & 1) << 5) | (((lane >> 5) & 1) << 8); }
constexpr int v_rd_off(int d0, int ks, int half) { return d0 * 512 + ks * 4096 + half * 2048; }
template <int OFF> __device__ __forceinline__ s16x4 tr_read(int vb) {
  s16x4 r; asm volatile("ds_read_b64_tr_b16 %0, %1 offset:%2" : "=&v"(r) : "v"(vb), "i"(OFF) : "memory"); return r;
}
template <int D0> __device__ __forceinline__ void pv_one(f32x16& od, int vb, bf16x8 pa0, bf16x8 pa1, bf16x8 pa2, bf16x8 pa3) {
  const s16x4 l0 = tr_read<v_rd_off(D0, 0, 0)>(vb), h0 = tr_read<v_rd_off(D0, 0, 1)>(vb), l1 = tr_read<v_rd_off(D0, 1, 0)>(vb), h1 = tr_read<v_rd_off(D0, 1, 1)>(vb);
  const s16x4 l2 = tr_read<v_rd_off(D0, 2, 0)>(vb), h2 = tr_read<v_rd_off(D0, 2, 1)>(vb), l3 = tr_read<v_rd_off(D0, 3, 0)>(vb), h3 = tr_read<v_rd_off(D0, 3, 1)>(vb);
  asm volatile("s_waitcnt lgkmcnt(0)" ::: "memory"); SBAR();
#define PK(L, H) (bf16x8){L[0], L[1], L[2], L[3], H[0], H[1], H[2], H[3]}
  od = __builtin_amdgcn_mfma_f32_32x32x16_bf16(pa0, PK(l0, h0), od, 0, 0, 0);
  od = __builtin_amdgcn_mfma_f32_32x32x16_bf16(pa1, PK(l1, h1), od, 0, 0, 0);
  od = __builtin_amdgcn_mfma_f32_32x32x16_bf16(pa2, PK(l2, h2), od, 0, 0, 0);
  od = __builtin_amdgcn_mfma_f32_32x32x16_bf16(pa3, PK(l3, h3), od, 0, 0, 0);
#undef PK
}
__device__ __forceinline__ void pv_d0(f32x16* o, int vb, bf16x8 pa0, bf16x8 pa1, bf16x8 pa2, bf16x8 pa3) {
  pv_one<0>(o[0], vb, pa0, pa1, pa2, pa3); pv_one<1>(o[1], vb, pa0, pa1, pa2, pa3); pv_one<2>(o[2], vb, pa0, pa1, pa2, pa3); pv_one<3>(o[3], vb, pa0, pa1, pa2, pa3);
}

__device__ __forceinline__ void diff_attn_unit(const bf16* __restrict__ Qb, const bf16* __restrict__ Kh, const bf16* __restrict__ Vh,
                                               bf16* __restrict__ Ob, int seq, float lam, const float* __restrict__ subln, char* lds) {
  using St = Stage<bf16>;
  int tid_ = threadIdx.x; asm volatile("" : "+v"(tid_));
  const int tid = tid_, wid = tid >> 6, lane = tid & 63, r32 = lane & 31, hi = lane >> 5;
  bf16* V_lds = (bf16*)lds; bf16* K_lds = (bf16*)(lds + 2 * SHM_V);
  float* ws = (float*)(lds + 2 * SHM_V + 2 * SHM_K) + wid * 64; float* li_l = ws; float* al_l = ws + 32;
  float m_reg = -1e30f, l_reg = 0; f32x16 o[4] = {};
  const int mw = wid >> 2, wq = wid & 3, mcolB = mw * 128;
  const bf16* Qw = Qb + (long)(wq * QBLK + r32) * LDQ + mw * 64 + hi * 8;
  char* qr = lds + 2 * SHM_V + 2 * SHM_K + NW * 64 * 4 + wid * 4096 + lane * 16;
#pragma unroll
  for (int d0 = 0; d0 < 4; ++d0) *reinterpret_cast<bf16x8*>(qr + d0 * 1024) = St::ld8(Qw + d0 * 16);
  const int sr = tid >> 4, sc = (tid & 15) * 8, vst0 = v_st(sr, sc), vst1 = v_st(32 + sr, sc);
  const int vb0 = (int)(uintptr_t)V_lds + v_rd_base(lane);
  struct { typename St::T vs0, vs1, ks0, ks1; } sr_[SDEPTH];
#define SLOAD(i, k0) do { sr_[i].vs0 = St::ld8(&Vh[(long)((k0) + sr) * LDK + sc]); sr_[i].vs1 = St::ld8(&Vh[(long)((k0) + 32 + sr) * LDK + sc]); \
    sr_[i].ks0 = St::ld8(&Kh[(long)((k0) + sr) * LDK + sc]); sr_[i].ks1 = St::ld8(&Kh[(long)((k0) + 32 + sr) * LDK + sc]); } while (0)
#define SWRITE(b, i) do { *(bf16x8*)((char*)V_lds + (b) * SHM_V + vst0) = St::tobf(sr_[i].vs0);          \
    *(bf16x8*)((char*)V_lds + (b) * SHM_V + vst1) = St::tobf(sr_[i].vs1); int kc = sc * 2;               \
    *(bf16x8*)((char*)K_lds + (b) * SHM_K + KSWZ(sr, kc)) = St::tobf(sr_[i].ks0);                       \
    *(bf16x8*)((char*)K_lds + (b) * SHM_K + KSWZ(32 + sr, kc)) = St::tobf(sr_[i].ks1); } while (0)
#define SWAIT() do { if constexpr (SDEPTH == 2) asm volatile("s_waitcnt vmcnt(4)" ::: "memory"); else asm volatile("s_waitcnt vmcnt(0)" ::: "memory"); } while (0)
#define RESC(a) do { if (__any((a) < 1.f)) { if (hi == 0) al_l[r32] = (a); asm volatile("s_waitcnt lgkmcnt(0)" ::: "memory"); \
    for (int d = 0; d < 4; ++d) for (int r = 0; r < 16; ++r) o[d][r] *= al_l[crow(r, hi)]; } } while (0)
  f32x16 pA0, pA1, pB0, pB1; float mnA, mnB, alA, alB; bf16x8 pa0, pa1, pa2, pa3; const int NT = seq / KVBLK;
  constexpr int SE = 0, SO = SDEPTH - 1;
  SLOAD(SE, 0); asm volatile("s_waitcnt vmcnt(0)" ::: "memory"); SWRITE(0, SE); __syncthreads();
  qkt(pA0, pA1, K_lds, qr, r32, hi, mcolB); partialSM(pA0, pA1, m_reg, mnA, alA);
  SLOAD(SO, KVBLK); if constexpr (SDEPTH == 2) { if (2 < NT) SLOAD(SE, 2 * KVBLK); }
  SWAIT(); SWRITE(1, SO); __syncthreads();
  for (int j = 1; j + 1 < NT; j += 2) {
    SBAR(); qkt(pB0, pB1, (bf16*)((char*)K_lds + SHM_K), qr, r32, hi, mcolB);
    finishSM(pA0, pA1, alA, l_reg, pa0, pa1, pa2, pa3); SBAR();
    SLOAD(SO, (j + SDEPTH) * KVBLK); SBAR();
    pv_d0(o, vb0, pa0, pa1, pa2, pa3); partialSM(pB0, pB1, m_reg, mnB, alB);
    __syncthreads(); SWAIT(); SWRITE(0, SE);
    RESC(alB); __syncthreads();
    SBAR(); qkt(pA0, pA1, K_lds, qr, r32, hi, mcolB);
    finishSM(pB0, pB1, alB, l_reg, pa0, pa1, pa2, pa3); SBAR();
    if (SDEPTH == 1 || j + 3 < NT) SLOAD(SE, (j + 1 + SDEPTH) * KVBLK); SBAR();
    pv_d0(o, vb0 + (int)SHM_V, pa0, pa1, pa2, pa3); partialSM(pA0, pA1, m_reg, mnA, alA);
    __syncthreads(); SWAIT(); SWRITE(1, SO);
    RESC(alA); __syncthreads();
  }
  SBAR(); qkt(pB0, pB1, (bf16*)((char*)K_lds + SHM_K), qr, r32, hi, mcolB);
  finishSM(pA0, pA1, alA, l_reg, pa0, pa1, pa2, pa3); SBAR();
  pv_d0(o, vb0, pa0, pa1, pa2, pa3); partialSM(pB0, pB1, m_reg, mnB, alB);
  __syncthreads(); RESC(alB);
  finishSM(pB0, pB1, alB, l_reg, pa0, pa1, pa2, pa3); SBAR();
  pv_d0(o, vb0 + (int)SHM_V, pa0, pa1, pa2, pa3);
  if (hi == 0) li_l[r32] = l_reg; asm volatile("s_waitcnt lgkmcnt(0)" ::: "memory");
  float rli[16];
#pragma unroll
  for (int r = 0; r < 16; ++r) rli[r] = __builtin_amdgcn_rcpf(li_l[crow(r, hi)]);
  float* EXO = (float*)(lds + 2 * SHM_V + 2 * SHM_K + NW * 64 * 4) + wq * (4 * 16 * 64) + lane;
  if (mw == 1) {
#pragma unroll
    for (int d0 = 0; d0 < 4; ++d0)
#pragma unroll
      for (int r = 0; r < 16; ++r) EXO[(d0 * 16 + r) * 64] = o[d0][r] * rli[r];
  }
  __syncthreads();
  if (mw == 0) {
    float ssq[16];
#pragma unroll
    for (int r = 0; r < 16; ++r) ssq[r] = 0.f;
#pragma unroll
    for (int d0 = 0; d0 < 4; ++d0)
#pragma unroll
      for (int r = 0; r < 16; ++r) { const float dv = o[d0][r] * rli[r] - lam * EXO[(d0 * 16 + r) * 64]; o[d0][r] = dv; ssq[r] += dv * dv; }
#pragma unroll
    for (int r = 0; r < 16; ++r) {
#pragma unroll
      for (int sft = 1; sft < 32; sft <<= 1) ssq[r] += __shfl_xor(ssq[r], sft);
      ssq[r] = rsqrtf(ssq[r] * (1.f / 128.f) + 1e-6f) * 0.8f;
    }
    bf16* Ow = Ob + (long)(wq * QBLK) * LDO;
#pragma unroll
    for (int d0 = 0; d0 < 4; ++d0) { const float gg = subln[d0 * 32 + r32];
#pragma unroll
      for (int r = 0; r < 16; ++r) { const float val = o[d0][r] * ssq[r] * gg; Ow[(long)crow(r, hi) * LDO + d0 * 32 + r32] = (bf16)(pg8::cvt_pk_bf16(val, val) & 0xffffu); } }
  }
  __syncthreads();
#undef SLOAD
#undef SWRITE
#undef SWAIT
#undef RESC
}
}


typedef __bf16 bf16x2_t __attribute__((ext_vector_type(2)));
__device__ __forceinline__ float dot2bf(unsigned a, unsigned b, float acc) { return __builtin_amdgcn_fdot2_f32_bf16(__builtin_bit_cast(bf16x2_t, a), __builtin_bit_cast(bf16x2_t, b), acc, false); }
template <int CTRL> __device__ __forceinline__ float dpp_add(float v) { return v + __builtin_bit_cast(float, __builtin_amdgcn_update_dpp(0, __builtin_bit_cast(int, v), CTRL, 0xf, 0xf, true)); }
__device__ __forceinline__ float row16_sum(float v) {
  v = dpp_add<0xB1>(v); v = dpp_add<0x4E>(v); v = dpp_add<0x141>(v); v = dpp_add<0x140>(v); return v;
}

typedef unsigned u32x2_t __attribute__((ext_vector_type(2)));
typedef float f32x2_t __attribute__((ext_vector_type(2)));
__device__ __forceinline__ void slice_table_fp8(const float* T, unsigned char* T8, float scale, int gtid, int gsz) {
  for (int it = gtid; it < 16384 * 128; it += gsz) {
    const int e = it >> 7, c8 = (it & 127) * 8, j = c8 >> 7, c = c8 & 127;
    const f32x4 a = *(const f32x4*)(T + (size_t)e * 1024 + c8) * scale, b = *(const f32x4*)(T + (size_t)e * 1024 + c8 + 4) * scale;
    int w0 = __builtin_amdgcn_cvt_pk_fp8_f32(a[0], a[1], 0, false); w0 = __builtin_amdgcn_cvt_pk_fp8_f32(a[2], a[3], w0, true);
    int w1 = __builtin_amdgcn_cvt_pk_fp8_f32(b[0], b[1], 0, false); w1 = __builtin_amdgcn_cvt_pk_fp8_f32(b[2], b[3], w1, true);
    *(u32x2_t*)(T8 + ((size_t)j * 16384 + e) * 128 + c) = (u32x2_t){(unsigned)w0, (unsigned)w1};
  }
}
__device__ __forceinline__ void slice_table(const float* T, bf16_t* T8, int gtid, int gsz) {
  for (int it = gtid; it < 16384 * 128; it += gsz) {
    const int e = it >> 7, c8 = (it & 127) * 8, j = c8 >> 7, c = c8 & 127;
    const f32x4 a = *(const f32x4*)(T + (size_t)e * 1024 + c8), b = *(const f32x4*)(T + (size_t)e * 1024 + c8 + 4);
    u32x4 w; w.x = pg8::cvt_pk_bf16(a[0], a[1]); w.y = pg8::cvt_pk_bf16(a[2], a[3]); w.z = pg8::cvt_pk_bf16(b[0], b[1]); w.w = pg8::cvt_pk_bf16(b[2], b[3]);
    *(u32x4*)(T8 + ((size_t)j * 16384 + e) * 128 + c) = w;
  }
}

__device__ __forceinline__ void wave_argmax(float& v, int& i) {
#pragma unroll
  for (int o = 32; o; o >>= 1) {
    const float ov = __shfl_xor(v, o); const int oi = __shfl_xor(i, o);
    if (ov > v || (ov == v && oi < i)) { v = ov; i = oi; }
  }
}

__global__ void __launch_bounds__(NT) mega(Params p) {
  extern __shared__ __attribute__((aligned(16))) unsigned char lds[];
  cg::grid_group grid = cg::this_grid();
  if (threadIdx.x < 35) {
    unsigned long long v = threadIdx.x < 33 ? (unsigned long long)p.in[threadIdx.x] : (threadIdx.x == 33 ? (unsigned long long)p.out : (unsigned long long)p.ws);
    ((unsigned long long*)(lds + PTR_OFF))[threadIdx.x] = v;
  }
  __syncthreads();

  {
    PHASE_LOCALS
    float* MOD = (float*)WSP(WS_MOD); float* LAM = (float*)WSP(WS_LAM);
    float* ABRE = (float*)WSP(WS_ABRE); float* ABIM = (float*)WSP(WS_ABIM); float* BBRE = (float*)WSP(WS_BBRE); float* BBIM = (float*)WSP(WS_BBIM);
    const float* cin = INP(1); const float* c_ctx = INP(3); const float* ada_w = INP(4); const float* ada_b = INP(5);
    if (gridDim.x >= 192) {
      if (blockIdx.x < 192) {
        float* sil = fl; float* red = fl + 5 * 1024;
        for (int i = tid; i < 5 * 1024; i += NT) { const int r = i >> 10, k = i & 1023; sil[i] = siluf_(r < 4 ? cin[r * D + k] : c_ctx[k]); }
        __syncthreads();
        const int cl = tid & 31, kg = tid >> 5, col = blockIdx.x * 32 + cl;
        float a[5] = {0.f, 0.f, 0.f, 0.f, 0.f};
#pragma unroll 16
        for (int kk = 0; kk < 64; ++kk) {
          const int k = kg * 64 + kk; const float w = ada_w[(size_t)k * 6144 + col];
#pragma unroll
          for (int r = 0; r < 5; ++r) a[r] += sil[r * 1024 + k] * w;
        }
#pragma unroll
        for (int r = 0; r < 5; ++r) red[(kg * 5 + r) * 32 + cl] = a[r];
        __syncthreads();
        if (tid < 160) {
          const int r = tid >> 5; float s = 0.f;
#pragma unroll
          for (int q = 0; q < 16; ++q) s += red[(q * 5 + r) * 32 + cl];
          MOD[r * 6144 + col] = s + ada_b[col];
        }
        __syncthreads();
      }
    } else {
      for (int it = gtid; it < 5 * 6144; it += gsz) {
        const int r = it / 6144, j = it % 6144;
        const float* cv = r < 4 ? cin + r * D : c_ctx;
        float a = 0.f;
        for (int k = 0; k < D; ++k) a += siluf_(cv[k]) * ada_w[(size_t)k * 6144 + j];
        MOD[it] = a + ada_b[j];
      }
    }
    if (gtid == 0) {
      const float* q1 = INP(9); const float* k1 = INP(10); const float* q2 = INP(11); const float* k2 = INP(12);
      float s1 = 0.f, s2 = 0.f;
      for (int k = 0; k < 64; ++k) { s1 += q1[k] * k1[k]; s2 += q2[k] * k2[k]; }
      LAM[0] = expf(s1) - expf(s2) + 0.2f;
    }
    const float* a_re = INP(15); const float* a_im = INP(16); const float* ldt = INP(17); const float* b_re = INP(18); const float* b_im = INP(19);
    for (int it = gtid; it < 2 * 32 * 64; it += gsz) {
      const int dg = it >> 6;
      const float ar = a_re[it], ai = a_im[it], dt = expf(ldt[dg]);
      const float mag = expf(ar * dt), abr = mag * cosf(ai * dt), abi = mag * sinf(ai * dt);
      ABRE[it] = abr; ABIM[it] = abi; ((float*)WSP(WS_ARDT))[it] = ar * dt; ((float*)WSP(WS_AIDT))[it] = ai * dt;
      const float den = ar * ar + ai * ai, nr = abr - 1.f, ni = abi;
      const float fr = (nr * ar + ni * ai) / den, fi = (ni * ar - nr * ai) / den;
      for (int pp = 0; pp < 16; ++pp) {
        const float br = b_re[it * 16 + pp], bi = b_im[it * 16 + pp];
        BBRE[it * 16 + pp] = fr * br - fi * bi; BBIM[it * 16 + pp] = fr * bi + fi * br;
      }
    }
    {
      struct BB { float fr, fi, ardt, aidt; };
      auto disc1 = [&](int sidx) -> BB {
        const float ar = a_re[sidx], ai = a_im[sidx], dt = expf(ldt[sidx >> 6]);
        const float mag = expf(ar * dt), abr = mag * cosf(ai * dt), abi = mag * sinf(ai * dt);
        const float den = ar * ar + ai * ai, nr = abr - 1.f, ni = abi;
        return BB{(nr * ar + ni * ai) / den, (ni * ar - nr * ai) / den, ar * dt, ai * dt};
      };
      {
        bf16_t* BTS = (bf16_t*)WSP(WS_BTS);
        for (int it = gtid; it < 32 * 256 * 32; it += gsz) {
          const int i = it & 31, r = (it >> 5) & 255, g = it >> 13;
          const int d = r >> 7, n = (r >> 1) & 63, ri = r & 1, sidx = (d * 32 + g) * 64 + n;
          const BB bb = disc1(sidx);
          const float e = (float)(d == 0 ? 31 - i : i);
          const float mag = __expf(e * bb.ardt), pr0 = mag * __cosf(e * bb.aidt), pi0 = mag * __sinf(e * bb.aidt);
          const float pr = pr0 * bb.fr - pi0 * bb.fi, pi = pr0 * bb.fi + pi0 * bb.fr;
          unsigned w[8];
#pragma unroll
          for (int q = 0; q < 8; ++q) {
            const float br0 = b_re[sidx * 16 + 2 * q], bi0 = b_im[sidx * 16 + 2 * q], br1 = b_re[sidx * 16 + 2 * q + 1], bi1 = b_im[sidx * 16 + 2 * q + 1];
            const float v0 = ri == 0 ? pr * br0 - pi * bi0 : pr * bi0 + pi * br0, v1 = ri == 0 ? pr * br1 - pi * bi1 : pr * bi1 + pi * br1;
            w[q] = pg8::cvt_pk_bf16(v0, v1);
          }
          u32x4* dst = (u32x4*)(BTS + ((size_t)g * 256 + r) * 512 + i * 16);
          dst[0] = (u32x4){w[0], w[1], w[2], w[3]}; dst[1] = (u32x4){w[4], w[5], w[6], w[7]};
        }
      }
      {
        float* KT = (float*)WSP(WS_KT); const float* c_re = INP(20); const float* c_im = INP(21);
        if (gridDim.x >= 256) {
          if (blockIdx.x >= 192) {
            const int dg = (int)blockIdx.x - 192; float* dsc = fl;
            if (tid < 64) { const BB bb = disc1(dg * 64 + tid); dsc[tid * 4] = bb.fr; dsc[tid * 4 + 1] = bb.fi; dsc[tid * 4 + 2] = bb.ardt; dsc[tid * 4 + 3] = bb.aidt; }
            __syncthreads();
            const int pp = tid & 15, m = tid >> 4;
            float acc[16];
#pragma unroll
            for (int q = 0; q < 16; ++q) acc[q] = 0.f;
            for (int n = 0; n < 64; ++n) {
              const int sidx = dg * 64 + n;
              const float fr = dsc[n * 4], fi = dsc[n * 4 + 1], ardt = dsc[n * 4 + 2], aidt = dsc[n * 4 + 3];
              const float mag = __expf((float)m * ardt), pr0 = mag * __cosf((float)m * aidt), pi0 = mag * __sinf((float)m * aidt);
              const float pr = pr0 * fr - pi0 * fi, pi = pr0 * fi + pi0 * fr;
              const float cr = c_re[(dg * 16 + pp) * 64 + n], ci = c_im[(dg * 16 + pp) * 64 + n];
              const float wr_ = cr * pr - ci * pi, wi_ = cr * pi + ci * pr;
#pragma unroll
              for (int q = 0; q < 16; ++q) acc[q] += wr_ * b_re[sidx * 16 + q] - wi_ * b_im[sidx * 16 + q];
            }
#pragma unroll
            for (int q = 0; q < 16; ++q) KT[((size_t)dg * 32 + m) * 256 + pp * 16 + q] = acc[q];
            __syncthreads();
          }
        } else {
          for (int it = gtid; it < 2 * 32 * 32 * 16; it += gsz) {
            const int pp = it & 15, m = (it >> 4) & 31, dg = it >> 9;
            float acc[16];
#pragma unroll
            for (int q = 0; q < 16; ++q) acc[q] = 0.f;
            for (int n = 0; n < 64; ++n) {
              const int sidx = dg * 64 + n;
              const BB bb = disc1(sidx);
              const float mag = __expf((float)m * bb.ardt), pr0 = mag * __cosf((float)m * bb.aidt), pi0 = mag * __sinf((float)m * bb.aidt);
              const float pr = pr0 * bb.fr - pi0 * bb.fi, pi = pr0 * bb.fi + pi0 * bb.fr;
              const float cr = c_re[(dg * 16 + pp) * 64 + n], ci = c_im[(dg * 16 + pp) * 64 + n];
              const float wr_ = cr * pr - ci * pi, wi_ = cr * pi + ci * pr;
#pragma unroll
              for (int q = 0; q < 16; ++q) acc[q] += wr_ * b_re[sidx * 16 + q] - wi_ * b_im[sidx * 16 + q];
            }
#pragma unroll
            for (int q = 0; q < 16; ++q) KT[((size_t)dg * 32 + m) * 256 + pp * 16 + q] = acc[q];
          }
        }
      }
    }
    float* ROPE = (float*)WSP(WS_ROPE);
    for (int it = gtid; it < 64 * 16; it += gsz) {
      const float ang = (float)(it >> 4) * powf(10000.f, -(float)(it & 15) / 16.f);
      ROPE[it * 2] = cosf(ang); ROPE[it * 2 + 1] = sinf(ang);
    }
    {
      float* scr = fl + wid * (64 * 33);
      constexpr int I_IN = 16 * 176, I_AU = 16 * 32, I_SU = 8 * 32, I_OUT = 16 * 32, I_Q = 16 * 32, I_GLU = 8 * 16;
      for (int it = gw; it < I_IN + I_AU + I_SU + I_OUT + I_GLU; it += ngw) {
        int r = it;
        if (r < I_IN) { transpose_item(INP(8), 1024, N_IN, (bf16_t*)WSP(WS_WIN), scr, r, lane); continue; } r -= I_IN;
        if (r < I_AU) { transpose_item(INP(14), 1024, 1024, (bf16_t*)WSP(WS_WAU), scr, r, lane); continue; } r -= I_AU;
        if (r < I_SU) { transpose_item(INP(25), 512, 1024, (bf16_t*)WSP(WS_WSU), scr, r, lane); continue; } r -= I_SU;
        if (r < I_OUT) { transpose_item(INP(26), 1024, 1024, (bf16_t*)WSP(WS_WOUT), scr, r, lane); continue; } r -= I_OUT;
        transpose_item(INP(23), 512, 512, (bf16_t*)WSP(WS_WGLU), scr, r, lane);
      }
    }
  }
  grid.sync();

  {
    PHASE_LOCALS
    const float* MOD = (const float*)WSP(WS_MOD); bf16_t* XN = (bf16_t*)WSP(WS_XN);
    const float* x = INP(0); const float* ctx = INP(2); const float* norm1_g = INP(6);
    for (int row = gw; row < MX + MC; row += ngw) {
      const float* src; const float* md;
      if (row < MX) { src = x + (size_t)row * D; md = MOD + (row / L) * 6144; } else { src = ctx + (size_t)(row - MX) * D; md = MOD + 4 * 6144; }
      f32x4 v[4]; float ss = 0.f;
#pragma unroll
      for (int j = 0; j < 4; ++j) { v[j] = *(const f32x4*)(src + lane * 4 + 256 * j); ss += v[j][0] * v[j][0] + v[j][1] * v[j][1] + v[j][2] * v[j][2] + v[j][3] * v[j][3]; }
      const float rstd = rsqrtf(wave_sum(ss) * (1.f / D) + 1e-6f);
#pragma unroll
      for (int j = 0; j < 4; ++j)
#pragma unroll
        for (int e = 0; e < 4; ++e) { const int col = lane * 4 + 256 * j + e; XN[(size_t)row * D + col] = f2bf(v[j][e] * rstd * norm1_g[col] * (1.f + md[1024 + col]) + md[col]); }
    }
  }
  grid.sync();

  {
    pg8::Gemm g{(const bf16_t*)WSP(WS_XN), (const bf16_t*)WSP(WS_WIN), MX + MC, N_IN, D, D, D};
    InProjSched S; S.init((int)gridDim.x, (int)blockIdx.x);
    EpiInProj E{(bf16_t*)WSP(WS_Q), (bf16_t*)WSP(WS_K), (bf16_t*)WSP(WS_V), (bf16_t*)WSP(WS_SA), (bf16_t*)WSP(WS_G), (const float*)WSP(WS_ROPE)};
    pg8::gemm_phase<EpiInProj, InProjSched, true, true>((PG8_LAS unsigned char*)lds, g, S, E);
  }
  grid.sync();

  {
    const float lam = ((const float*)WSP(WS_LAM))[0];
    const bf16_t* Qb = (const bf16_t*)WSP(WS_Q); const bf16_t* Kb = (const bf16_t*)WSP(WS_K); const bf16_t* Vb = (const bf16_t*)WSP(WS_V);
    bf16_t* ATT = (bf16_t*)WSP(WS_ATT); const float* subln = INP(13);
    for (int unit = blockIdx.x; unit < Bn * 8 * (L / 128); unit += gridDim.x) {
      const int h = unit & 7, qb = (unit >> 3) & 31, b = unit >> 8;
      const size_t qoff = ((size_t)(b * L + qb * 128)) * 1024 + h * 128, koff = (size_t)b * LA * 1024 + h * 128;
      att::diff_attn_unit(Qb + qoff, Kb + koff, Vb + koff, ATT + qoff, LA, lam, subln, (char*)lds);
    }
  }
  grid.sync();

  {
    const bool gemm_blk = (blockIdx.x < 96) || (gridDim.x <= 96);
    if (gemm_blk) {
      pg8::Gemm g{(const bf16_t*)WSP(WS_SA), (const bf16_t*)WSP(WS_BTS), 0, 0, 512, SA_LD, 512};
      GroupSched S; S.init(32, 3, 1, (long)SA_ROWS * SA_LD * 2, (long)256 * SA_LD * 2, (long)256 * 512 * 2, 0, (int)(gridDim.x <= 96 ? gridDim.x : 96), (int)blockIdx.x);
      EpiS E{(float*)WSP(WS_S)};
      pg8::gemm_phase<EpiS, GroupSched, true, true>((PG8_LAS unsigned char*)lds, g, S, E);
    }
    if (!gemm_blk || gridDim.x <= 96) {
      PHASE_LOCALS
      const int wb = gridDim.x <= 96 ? (int)blockIdx.x : (int)blockIdx.x - 96, nwb = gridDim.x <= 96 ? (int)gridDim.x : (int)gridDim.x - 96;
      const float* KT = (const float*)WSP(WS_KT); const float* ARDT = (const float*)WSP(WS_ARDT); const float* AIDT = (const float*)WSP(WS_AIDT);
      const float* c_re = INP(20); const float* c_im = INP(21); const float* dsk = INP(22); bf16_t* BTY = (bf16_t*)WSP(WS_BTY);
      for (int it = wb * NT + tid; it < 32 * 512 * 96; it += nwb * NT) {
        const int cgp = it % 96, row = (it / 96) & 511, g = it / (96 * 512);
        const int j = row >> 4, pp = row & 15, col0 = cgp * 8;
        float v[8];
        if (col0 < 512) {
          const int i = col0 >> 4, q0 = col0 & 15;
#pragma unroll
          for (int e = 0; e < 8; ++e) v[e] = 0.f;
          if (i <= j) { const float* kp = KT + ((size_t)(0 * 32 + g) * 32 + (j - i)) * 256 + pp * 16 + q0;
#pragma unroll
            for (int e = 0; e < 8; ++e) v[e] += kp[e]; }
          if (i >= j) { const float* kp = KT + ((size_t)(1 * 32 + g) * 32 + (i - j)) * 256 + pp * 16 + q0;
#pragma unroll
            for (int e = 0; e < 8; ++e) v[e] += kp[e]; }
          if (i == j && pp >= q0 && pp < q0 + 8) {
#pragma unroll
            for (int e = 0; e < 8; ++e) if (q0 + e == pp) v[e] += dsk[g * 16 + pp];
          }
        } else {
          const int cc0 = col0 - 512, d = cc0 >> 7, n0 = (cc0 & 127) >> 1;
          const float ex = (float)(d == 0 ? j + 1 : 32 - j);
#pragma unroll
          for (int q = 0; q < 4; ++q) {
            const int n = n0 + q, sidx = (d * 32 + g) * 64 + n;
            const float mag = __expf(ex * ARDT[sidx]), pr = mag * __cosf(ex * AIDT[sidx]), pi = mag * __sinf(ex * AIDT[sidx]);
            const float cr = c_re[((d * 32 + g) * 16 + pp) * 64 + n], ci = c_im[((d * 32 + g) * 16 + pp) * 64 + n];
            v[2 * q] = cr * pr - ci * pi; v[2 * q + 1] = -(cr * pi + ci * pr);
          }
        }
        u32x4 w; w.x = pg8::cvt_pk_bf16(v[0], v[1]); w.y = pg8::cvt_pk_bf16(v[2], v[3]); w.z = pg8::cvt_pk_bf16(v[4], v[5]); w.w = pg8::cvt_pk_bf16(v[6], v[7]);
        *(u32x4*)(BTY + ((size_t)g * 512 + row) * 768 + col0) = w;
      }
    }
  }
  grid.sync();

  {
    PHASE_LOCALS
    const float* ARDT = (const float*)WSP(WS_ARDT); const float* AIDT = (const float*)WSP(WS_AIDT);
    if (wid == 0) {
      for (int it = blockIdx.x; it < Bn * 32 * 2; it += gridDim.x) {
        const int d = it & 1, g = (it >> 1) & 31, b = it >> 6;
        const int sidx = (d * 32 + g) * 64 + lane;
        const float mag = expf(32.f * ARDT[sidx]), pr = mag * cosf(32.f * AIDT[sidx]), pi = mag * sinf(32.f * AIDT[sidx]);
        typedef float f32x2_ __attribute__((ext_vector_type(2)));
        const f32x2_* Sg = (const f32x2_*)((const float*)WSP(WS_S) + (size_t)g * SA_ROWS * 256) + d * 64 + lane;
        bf16_t* SAg = (bf16_t*)WSP(WS_SA) + (size_t)g * SA_ROWS * SA_LD + 512 + d * 128 + lane * 2;
        float hr = 0.f, hi = 0.f;
        f32x2_ sc[8];
#pragma unroll
        for (int k = 0; k < 8; ++k) { const int cc = d == 0 ? k : 7 - k; sc[k] = Sg[(size_t)(512 + b * 8 + cc) * 128]; }
#pragma unroll
        for (int k = 0; k < 8; ++k) { const float nr = pr * hr - pi * hi + sc[k][0], ni = pr * hi + pi * hr + sc[k][1]; hr = nr; hi = ni; }
        for (int k0 = 0; k0 < 128; k0 += 16) {
          f32x2_ sv[16];
#pragma unroll
          for (int k = 0; k < 16; ++k) { const int cx = d == 0 ? k0 + k : 127 - (k0 + k); sv[k] = Sg[(size_t)(b * 128 + cx) * 128]; }
#pragma unroll
          for (int k = 0; k < 16; ++k) {
            const int cx = d == 0 ? k0 + k : 127 - (k0 + k);
            *(unsigned*)(SAg + (size_t)(b * 128 + cx) * SA_LD) = pg8::cvt_pk_bf16(hr, hi);
            const float nr = pr * hr - pi * hi + sv[k][0], ni = pr * hi + pi * hr + sv[k][1]; hr = nr; hi = ni;
          }
        }
      }
    }
  }
  grid.sync();

  {
    pg8::Gemm g{(const bf16_t*)WSP(WS_SA), (const bf16_t*)WSP(WS_BTY), 0, 0, 768, SA_LD, 768};
    GroupSched S; S.init(32, 2, 2, (long)SA_ROWS * SA_LD * 2, (long)256 * SA_LD * 2, (long)512 * 768 * 2, (long)256 * 768 * 2, (int)gridDim.x, (int)blockIdx.x);
    EpiY E{(bf16_t*)WSP(WS_YG)};
    pg8::gemm_phase<EpiY, GroupSched, true, true>((PG8_LAS unsigned char*)lds, g, S, E);
  }
  grid.sync();

  {
    pg8::Gemm g{(const bf16_t*)WSP(WS_YG), (const bf16_t*)WSP(WS_WGLU), MX, 512, 512, 512, 512};
    pg8::StaticOrder S; S.init(MX, 512, (int)gridDim.x, (int)blockIdx.x, g.lda, g.ldb);
    EpiBf8<0> E{(bf16_t*)WSP(WS_SSMX), 512, (const bf16_t*)WSP(WS_YG), 512, INP(24)};
    pg8::gemm_phase<EpiBf8<0>, pg8::StaticOrder, true, true>((PG8_LAS unsigned char*)lds, g, S, E);
  }
  grid.sync();

  {
    pg8::Gemm g{(const bf16_t*)WSP(WS_ATT), (const bf16_t*)WSP(WS_WAU), MX, 1024, 1024, 1024, 1024};
    pg8::StaticOrder S; S.init(MX, 1024, (int)gridDim.x, (int)blockIdx.x, g.lda, g.ldb);
    EpiBf8<1> E{(bf16_t*)WSP(WS_M), 1024, (const bf16_t*)WSP(WS_G), 2048, nullptr};
    pg8::gemm_phase<EpiBf8<1>, pg8::StaticOrder, true, true>((PG8_LAS unsigned char*)lds, g, S, E);
  }
  grid.sync();
  {
    pg8::Gemm g{(const bf16_t*)WSP(WS_SSMX), (const bf16_t*)WSP(WS_WSU), MX, 1024, 512, 512, 512};
    pg8::StaticOrder S; S.init(MX, 1024, (int)gridDim.x, (int)blockIdx.x, g.lda, g.ldb);
    EpiBf8<2> E{(bf16_t*)WSP(WS_M), 1024, (const bf16_t*)WSP(WS_G) + 1024, 2048, nullptr};
    pg8::gemm_phase<EpiBf8<2>, pg8::StaticOrder, true, true>((PG8_LAS unsigned char*)lds, g, S, E);
  }
  grid.sync();
  {
    pg8::Gemm g{(const bf16_t*)WSP(WS_M), (const bf16_t*)WSP(WS_WOUT), MX, 1024, 1024, 1024, 1024};
    pg8::StaticOrder S; S.init(MX, 1024, (int)gridDim.x, (int)blockIdx.x, g.lda, g.ldb);
    EpiF32<1> E{(float*)WSP(WS_X1), INP(0), (const float*)WSP(WS_MOD)};
    pg8::gemm_phase<EpiF32<1>, pg8::StaticOrder, true, true>((PG8_LAS unsigned char*)lds, g, S, E);
  }
  grid.sync();
  {
    PHASE_LOCALS
    const float* X1 = (const float*)WSP(WS_X1); const float* MOD = (const float*)WSP(WS_MOD); bf16_t* XN2 = (bf16_t*)WSP(WS_XN2); const float* norm2_g = INP(7);
    for (int row = gw; row < MX; row += ngw) {
      const float* src = X1 + (size_t)row * D; const float* md = MOD + (row / L) * 6144;
      f32x4 v[4]; float ss = 0.f;
#pragma unroll
      for (int j = 0; j < 4; ++j) { v[j] = *(const f32x4*)(src + lane * 4 + 256 * j); ss += v[j][0] * v[j][0] + v[j][1] * v[j][1] + v[j][2] * v[j][2] + v[j][3] * v[j][3]; }
      const float rstd = rsqrtf(wave_sum(ss) * (1.f / D) + 1e-6f);
#pragma unroll
      for (int j = 0; j < 4; ++j)
#pragma unroll
        for (int e = 0; e < 4; ++e) { const int col = lane * 4 + 256 * j + e; XN2[(size_t)row * D + col] = f2bf(v[j][e] * rstd * norm2_g[col] * (1.f + md[4096 + col]) + md[3072 + col]); }
    }
    slice_table_fp8(INP(30), (unsigned char*)WSP(WS_U8), 32.f, gtid, gsz);
    {
      const float* wq = INP(27); const float* sk1 = INP(28); const float* sk2 = INP(29); bf16_t* WC = (bf16_t*)WSP(WS_WC);
      float* skl = fl; float* wql = fl + 128 * 65;
      for (int tile = blockIdx.x; tile < 16 * 16; tile += gridDim.x) {
        const int hs = tile >> 4, d0 = (tile & 15) * 64, h = hs >> 1, s = hs & 1;
        __syncthreads();
        const float* skp = s ? sk2 : sk1;
        for (int i = tid; i < 128 * 16; i += NT) { const int k = i >> 4, e4 = (i & 15) * 4; const f32x4 v = *(const f32x4*)(skp + k * 64 + e4); skl[k * 65 + e4] = v[0]; skl[k * 65 + e4 + 1] = v[1]; skl[k * 65 + e4 + 2] = v[2]; skl[k * 65 + e4 + 3] = v[3]; }
        for (int i = tid; i < 64 * 16; i += NT) { const int dd = i >> 4, e4 = (i & 15) * 4; const f32x4 v = *(const f32x4*)(wq + (size_t)(d0 + dd) * 1024 + h * 128 + s * 64 + e4); wql[dd * 65 + e4] = v[0]; wql[dd * 65 + e4 + 1] = v[1]; wql[dd * 65 + e4 + 2] = v[2]; wql[dd * 65 + e4 + 3] = v[3]; }
        __syncthreads();
        const int k = tid & 127, dgp = tid >> 7;
        float a[16];
#pragma unroll
        for (int q = 0; q < 16; ++q) a[q] = 0.f;
        for (int e = 0; e < 64; ++e) {
          const float sv = skl[k * 65 + e];
#pragma unroll
          for (int q = 0; q < 16; ++q) a[q] += sv * wql[(dgp * 16 + q) * 65 + e];
        }
        u32x4 w0, w1;
        w0.x = pg8::cvt_pk_bf16(a[0], a[1]); w0.y = pg8::cvt_pk_bf16(a[2], a[3]); w0.z = pg8::cvt_pk_bf16(a[4], a[5]); w0.w = pg8::cvt_pk_bf16(a[6], a[7]);
        w1.x = pg8::cvt_pk_bf16(a[8], a[9]); w1.y = pg8::cvt_pk_bf16(a[10], a[11]); w1.z = pg8::cvt_pk_bf16(a[12], a[13]); w1.w = pg8::cvt_pk_bf16(a[14], a[15]);
        bf16_t* dst = WC + (size_t)(h * 256 + s * 128 + k) * 1024 + d0 + dgp * 16;
        *(u32x4*)dst = w0; *(u32x4*)(dst + 8) = w1;
      }
      __syncthreads();
    }
  }
  grid.sync();
  {
    pg8::Gemm g{(const bf16_t*)WSP(WS_XN2), (const bf16_t*)WSP(WS_WC), MX, 2048, 1024, 1024, 1024};
    EpiTopK E{(unsigned short*)WSP(WS_IDX), (float*)WSP(WS_GATE)};
    const int nrounds = (64 * 8 + (int)gridDim.x - 1) / (int)gridDim.x;
    for (int rd = 0; rd < nrounds; ++rd) {
      OneUnitSched S; S.nM = 64; S.nN = 8; S.G = (int)gridDim.x; S.c = (int)blockIdx.x; S.round = rd; S.tsA = (long)256 * 1024 * 2; S.tsB = (long)256 * 1024 * 2;
      pg8::gemm_phase<EpiTopK, OneUnitSched, false, true>((PG8_LAS unsigned char*)lds, g, S, E);
    }
  }
  grid.sync();
  {
    PHASE_LOCALS
    const bf16_t* XN2 = (const bf16_t*)WSP(WS_XN2); const unsigned short* EXT = (const unsigned short*)WSP(WS_IDX);
    bf16_t* PD = (bf16_t*)WSP(WS_PD);
    const bool sl = (gridDim.x & 7) == 0;
    const int widu = __builtin_amdgcn_readfirstlane(wid);
    const int j0 = sl ? (int)(blockIdx.x & 7) : 0, nj = sl ? 1 : 8;
    const int wk = sl ? (int)(blockIdx.x >> 3) * 8 + widu : (int)blockIdx.x * (NT / 64) + widu, nwk = sl ? (int)(gridDim.x >> 3) * 8 : ngw;
    const int eg = lane >> 3, li = lane & 7;
    for (int jj = 0; jj < nj; ++jj) {
      const int j = j0 + jj;
      const unsigned char* U8j = (const unsigned char*)WSP(WS_U8) + (size_t)j * 16384 * 128 + li * 16;
      for (int t = wk; t < MX; t += nwk) {
        const u32x4* xp = (const u32x4*)(XN2 + (size_t)t * 1024 + j * 128 + li * 16);
        const u32x4 xa = xp[0], xb = xp[1];
        const u32x4* ep = (const u32x4*)(EXT + (size_t)t * 128 + eg * 16);
        const u32x4 e0 = ep[0], e1 = ep[1];
        const unsigned ew[8] = {e0.x, e0.y, e0.z, e0.w, e1.x, e1.y, e1.z, e1.w};
        u32x4 uw[16];
#pragma unroll
        for (int k = 0; k < 16; ++k) { const unsigned ex = (k & 1) ? (ew[k >> 1] >> 16) : (ew[k >> 1] & 0xffffu); uw[k] = *(const u32x4*)(U8j + ex * 128u); }
        const unsigned xwd[8] = {xa.x, xa.y, xa.z, xa.w, xb.x, xb.y, xb.z, xb.w};
        f32x2_t xf[8];
#pragma unroll
        for (int q = 0; q < 8; ++q) xf[q] = (f32x2_t){bflo(xwd[q]), bfhi(xwd[q])};
        float keep_lo = 0.f, keep_hi = 0.f;
#pragma unroll
        for (int k = 0; k < 16; ++k) {
          const unsigned uu[4] = {uw[k].x, uw[k].y, uw[k].z, uw[k].w};
          f32x2_t s2 = {0.f, 0.f};
#pragma unroll
          for (int q = 0; q < 4; ++q) { s2 += __builtin_amdgcn_cvt_pk_f32_fp8((int)uu[q], false) * xf[2 * q]; s2 += __builtin_amdgcn_cvt_pk_f32_fp8((int)uu[q], true) * xf[2 * q + 1]; }
          float dp = s2.x + s2.y;
          dp = dpp_add<0xB1>(dp); dp = dpp_add<0x4E>(dp); dp = dpp_add<0x141>(dp);
          if (li == (k & 7)) { if (k < 8) keep_lo = dp; else keep_hi = dp; }
        }
        bf16_t* pd = PD + ((size_t)t * 128 + eg * 16 + li) * 8 + j;
        pd[0] = f2bf(keep_lo * (1.f / 32.f)); pd[8 * 8] = f2bf(keep_hi * (1.f / 32.f));
      }
    }
    slice_table_fp8(INP(31), (unsigned char*)WSP(WS_V8), 1.f, gtid, gsz);
  }
  grid.sync();
  {
    PHASE_LOCALS
    const bf16_t* PD = (const bf16_t*)WSP(WS_PD); const float* GATE = (const float*)WSP(WS_GATE); unsigned* CFP = (unsigned*)WSP(WS_CFP);
    for (int t = gw; t < MX; t += ngw) {
      const u32x4* pp = (const u32x4*)(PD + ((size_t)t * 128 + 2 * lane) * 8);
      const u32x4 pa = pp[0], pb = pp[1];
      const f32x2_t g2 = *(const f32x2_t*)(GATE + (size_t)t * 128 + 2 * lane);
      const float p0 = ((bflo(pa.x) + bfhi(pa.x)) + (bflo(pa.y) + bfhi(pa.y))) + ((bflo(pa.z) + bfhi(pa.z)) + (bflo(pa.w) + bfhi(pa.w)));
      const float p1 = ((bflo(pb.x) + bfhi(pb.x)) + (bflo(pb.y) + bfhi(pb.y))) + ((bflo(pb.z) + bfhi(pb.z)) + (bflo(pb.w) + bfhi(pb.w)));
      CFP[(size_t)t * 64 + lane] = pg8::cvt_pk_bf16(g2.x * gelu_tanh(p0), g2.y * gelu_tanh(p1));
    }
  }
  grid.sync();
  {
    PHASE_LOCALS
    const float* X1 = (const float*)WSP(WS_X1); const float* MOD = (const float*)WSP(WS_MOD);
    const unsigned short* EXT = (const unsigned short*)WSP(WS_IDX); const unsigned* CFP = (const unsigned*)WSP(WS_CFP);
    float* SSQ = (float*)WSP(WS_SSQ); float* out = GPTR(float, ldptr_(33));
    const bool sl = (gridDim.x & 7) == 0;
    const int widu = __builtin_amdgcn_readfirstlane(wid);
    const int j0 = sl ? (int)(blockIdx.x & 7) : 0, nj = sl ? 1 : 8;
    const int wk = sl ? (int)(blockIdx.x >> 3) * 8 + widu : (int)blockIdx.x * (NT / 64) + widu, nwk = sl ? (int)(gridDim.x >> 3) * 8 : ngw;
    const int eg = lane >> 3, li = lane & 7;
    float* red = fl + widu * 1024;
    for (int jj = 0; jj < nj; ++jj) {
      const int j = j0 + jj;
      const unsigned char* V8j = (const unsigned char*)WSP(WS_V8) + (size_t)j * 16384 * 128 + li * 16;
      for (int t = wk; t < MX; t += nwk) {
        const u32x4* ep = (const u32x4*)(EXT + (size_t)t * 128 + eg * 16);
        const u32x4 e0 = ep[0], e1 = ep[1];
        const u32x4* cp = (const u32x4*)(CFP + (size_t)t * 64 + eg * 8);
        const u32x4 c0 = cp[0], c1 = cp[1];
        const int col = j * 128 + 2 * lane;
        const f32x2_t xr = *(const f32x2_t*)(X1 + (size_t)t * 1024 + col);
        const f32x2_t gr = *(const f32x2_t*)(MOD + (t >> 12) * 6144 + 5120 + col);
        const unsigned ew[8] = {e0.x, e0.y, e0.z, e0.w, e1.x, e1.y, e1.z, e1.w};
        const unsigned cfp[8] = {c0.x, c0.y, c0.z, c0.w, c1.x, c1.y, c1.z, c1.w};
        u32x4 vw[16];
#pragma unroll
        for (int k = 0; k < 16; ++k) { const unsigned ex = (k & 1) ? (ew[k >> 1] >> 16) : (ew[k >> 1] & 0xffffu); vw[k] = *(const u32x4*)(V8j + ex * 128u); }
        f32x2_t a[8];
#pragma unroll
        for (int q = 0; q < 8; ++q) a[q] = (f32x2_t){0.f, 0.f};
#pragma unroll
        for (int k = 0; k < 16; ++k) {
          const unsigned cf2 = cfp[k >> 1]; const float cf = (k & 1) ? bfhi(cf2) : bflo(cf2);
          const unsigned vv[4] = {vw[k].x, vw[k].y, vw[k].z, vw[k].w};
#pragma unroll
          for (int q = 0; q < 4; ++q) { a[2 * q] += __builtin_amdgcn_cvt_pk_f32_fp8((int)vv[q], false) * cf; a[2 * q + 1] += __builtin_amdgcn_cvt_pk_f32_fp8((int)vv[q], true) * cf; }
        }
#pragma unroll
        for (int q = 0; q < 4; ++q) *(f32x4*)(red + eg * 128 + li * 16 + q * 4) = (f32x4){a[2 * q].x, a[2 * q].y, a[2 * q + 1].x, a[2 * q + 1].y};
        asm volatile("s_waitcnt lgkmcnt(0)" ::: "memory");
        f32x2_t acc = {0.f, 0.f};
#pragma unroll
        for (int g = 0; g < 8; ++g) acc += *(const f32x2_t*)(red + g * 128 + 2 * lane);
        asm volatile("s_waitcnt lgkmcnt(0)" ::: "memory");
        const f32x2_t o2 = xr + gr * acc;
        float ss = o2.x * o2.x + o2.y * o2.y;
        ss = wave_sum(ss);
        *(f32x2_t*)(out + (size_t)t * 1024 + col) = o2;
        if (lane == 0) SSQ[(size_t)t * 8 + j] = ss;
      }
    }
  }
  grid.sync();
  {
    PHASE_LOCALS
    const float* SSQ = (const float*)WSP(WS_SSQ); const float* fng = INP(32); float* out = GPTR(float, ldptr_(33));
    for (int row = gw; row < MX; row += ngw) {
      const f32x4 sa = *(const f32x4*)(SSQ + (size_t)row * 8), sb = *(const f32x4*)(SSQ + (size_t)row * 8 + 4);
      const float rstd = rsqrtf(((sa[0] + sa[1]) + (sa[2] + sa[3]) + (sb[0] + sb[1]) + (sb[2] + sb[3])) * (1.f / D) + 1e-6f);
#pragma unroll
      for (int jq = 0; jq < 4; ++jq) {
        float* op = out + (size_t)row * D + lane * 4 + 256 * jq;
        const f32x4 v = *(const f32x4*)op, g4 = *(const f32x4*)(fng + lane * 4 + 256 * jq);
        *(f32x4*)op = v * rstd * g4;
      }
    }
  }
}

extern "C" void kernel_launch(void* const* d_in, const int* in_sizes, int n_in, void* d_out, int out_size, void* d_ws, size_t ws_size, hipStream_t stream) {
  static int grid_blocks = 0;
  if (!grid_blocks) {
    int dev = 0, cus = 0, per_cu = 0;
    (void)hipGetDevice(&dev);
    (void)hipDeviceGetAttribute(&cus, hipDeviceAttributeMultiprocessorCount, dev);
    (void)hipFuncSetAttribute((const void*)mega, hipFuncAttributeMaxDynamicSharedMemorySize, LDS_BYTES);
    (void)hipOccupancyMaxActiveBlocksPerMultiprocessor(&per_cu, (const void*)mega, NT, LDS_BYTES);
    if (per_cu < 1) per_cu = 1;
    grid_blocks = cus * per_cu;
    if (n_in != 33 || ws_size < 255 * MiB) { fprintf(stderr, "kernel_launch: unexpected n_in %d / ws %zu\n", n_in, ws_size); }
  }
  Params p{};
  for (int i = 0; i < 33 && i < n_in; ++i) p.in[i] = (const float*)d_in[i];
  p.out = (float*)d_out; p.ws = (unsigned char*)d_ws;
  void* args[] = {&p};
  hipError_t e = hipLaunchCooperativeKernel((const void*)mega, dim3(grid_blocks), dim3(NT), args, LDS_BYTES, stream);
  if (e != hipSuccess) fprintf(stderr, "cooperative launch failed: %s (grid %d)\n", hipGetErrorString(e), grid_blocks);
}
```

```cpp
#include <hip/hip_runtime.h>
#include <hip/hip_cooperative_groups.h>
#include <cstdio>
#include <cstdint>
namespace cg = cooperative_groups;

typedef unsigned short bf16_t;
typedef float f32x4 __attribute__((ext_vector_type(4)));

constexpr int NT = 512;
constexpr int LDS_BYTES = 147456;
constexpr int Bn = 4, L = 4096, D = 1024, NCTX = 256, LA = L + NCTX;
constexpr int MX = Bn * L, MC = Bn * NCTX;
constexpr int N_IN = 5632;
constexpr size_t MiB = 1u << 20;
constexpr size_t WS_MOD = 0, WS_LAM = 128 * 1024, WS_ROPE = 136 * 1024, WS_ARDT = 144 * 1024, WS_AIDT = 160 * 1024;
constexpr size_t WS_ABRE = 192 * 1024, WS_ABIM = 224 * 1024, WS_BBRE = 256 * 1024, WS_BBIM = 512 * 1024;
constexpr size_t WS_BAR = 1 * MiB;
constexpr size_t WS_KT = 2 * MiB;
constexpr size_t WS_XN = 4 * MiB, WS_Q = 38 * MiB, WS_K = 70 * MiB, WS_V = 104 * MiB, WS_SA = 138 * MiB, WS_G = 164 * MiB;
constexpr size_t WS_WIN = 228 * MiB, WS_WAU = 239 * MiB, WS_WSU = 241 * MiB, WS_WOUT = 242 * MiB, WS_WQ = 244 * MiB, WS_WGLU = 246 * MiB;
constexpr size_t WS_BTS = 247 * MiB;
constexpr size_t WS_BTY = 38 * MiB, WS_S = 62 * MiB, WS_YG = 79 * MiB, WS_SSMX = 95 * MiB, WS_M = 111 * MiB;
constexpr size_t WS_ATT = WS_XN, WS_X1 = 38 * MiB, WS_XN2 = WS_XN, WS_QP = WS_G;
constexpr size_t WS_IDX = 111 * MiB, WS_GATE = 115 * MiB, WS_SSQ = 123 * MiB;
constexpr size_t WS_U8 = 127 * MiB, WS_PD = 164 * MiB, WS_V8 = 196 * MiB, WS_WC = 160 * MiB, WS_CFP = 160 * MiB;
constexpr int SA_ROWS = 544, SA_LD = 768;

constexpr int PTR_OFF = LDS_BYTES - 1024;
__device__ __forceinline__ unsigned long long ldptr_(int k) {
  extern __shared__ __attribute__((aligned(16))) unsigned char lds_[];
  const unsigned long long v = ((const unsigned long long*)(lds_ + PTR_OFF))[k];
  const unsigned lo = __builtin_amdgcn_readfirstlane((unsigned)v), hi = __builtin_amdgcn_readfirstlane((unsigned)(v >> 32));
  return ((unsigned long long)hi << 32) | lo;
}
#define GPTR(T, v) ((T*)(__attribute__((address_space(1))) T*)(v))
#define INP(k) GPTR(const float, ldptr_(k))
#define WSP(off) GPTR(unsigned char, ldptr_(34) + (off))
#define PHASE_LOCALS \
  int tid = threadIdx.x; asm volatile("" : "+v"(tid)); \
  const int lane = tid & 63, wid = tid >> 6; \
  const int gtid = blockIdx.x * NT + tid, gsz = gridDim.x * NT; \
  const int gw = blockIdx.x * (NT / 64) + wid, ngw = gridDim.x * (NT / 64); \
  float* fl = (float*)lds; (void)lane; (void)wid; (void)gtid; (void)gsz; (void)gw; (void)ngw; (void)fl;

struct Params {
  const float* in[33];
  float* out;
  unsigned char* ws;
  int pad0, pad1;
};

__device__ __forceinline__ float bf2f(bf16_t v) { return __uint_as_float(((unsigned)v) << 16); }
__device__ __forceinline__ bf16_t f2bf(float f) { unsigned u = __float_as_uint(f); return (bf16_t)((u + 0x7fffu + ((u >> 16) & 1u)) >> 16); }
__device__ __forceinline__ float wave_sum(float v) {
#pragma unroll
  for (int o = 32; o; o >>= 1) v += __shfl_xor(v, o);
  return v;
}
__device__ __forceinline__ float gelu_tanh(float x) { return 0.5f * x * (1.f + tanhf(0.7978845608028654f * (x + 0.044715f * x * x * x))); }
__device__ __forceinline__ float sigmoidf_(float x) { return 1.f / (1.f + __expf(-x)); }
__device__ __forceinline__ float siluf_(float x) { return x / (1.f + __expf(-x)); }

template <class Epi>
__device__ __forceinline__ void sgemm(const bf16_t* A, int lda, const float* Bm, int ldb, int M, int N, int K, float* lds, Epi epi) {
  constexpr int TM = 128, TN = 128, TK = 16, LDA_S = TM + 4, LDB_S = TN + 4;
  float* As = lds;
  float* Bs = lds + TK * LDA_S;
  const int tid = threadIdx.x, ty = tid >> 4, tx = tid & 15;
  const int ntm = M / TM, ntn = N / TN;
  for (int tile = blockIdx.x; tile < ntm * ntn; tile += gridDim.x) {
    const int tm = tile / ntn, tn = tile % ntn;
    float acc[4][8];
#pragma unroll
    for (int i = 0; i < 4; ++i)
#pragma unroll
      for (int j = 0; j < 8; ++j) acc[i][j] = 0.f;
    const int ar = tid >> 2, ak = (tid & 3) * 4;
    const int bk = tid >> 5, bn = (tid & 31) * 4;
    for (int k0 = 0; k0 < K; k0 += TK) {
      const bf16_t* ap = A + (size_t)(tm * TM + ar) * lda + k0 + ak;
      const unsigned long long av = *(const unsigned long long*)ap;
      const f32x4 bv = *(const f32x4*)(Bm + (size_t)(k0 + bk) * ldb + tn * TN + bn);
      __syncthreads();
      As[(ak + 0) * LDA_S + ar] = bf2f((bf16_t)(av & 0xffff));
      As[(ak + 1) * LDA_S + ar] = bf2f((bf16_t)((av >> 16) & 0xffff));
      As[(ak + 2) * LDA_S + ar] = bf2f((bf16_t)((av >> 32) & 0xffff));
      As[(ak + 3) * LDA_S + ar] = bf2f((bf16_t)((av >> 48) & 0xffff));
      *(f32x4*)(Bs + bk * LDB_S + bn) = bv;
      __syncthreads();
#pragma unroll
      for (int k = 0; k < TK; ++k) {
        const f32x4 a4 = *(const f32x4*)(As + k * LDA_S + ty * 4);
        const f32x4 b0 = *(const f32x4*)(Bs + k * LDB_S + tx * 8);
        const f32x4 b1 = *(const f32x4*)(Bs + k * LDB_S + tx * 8 + 4);
#pragma unroll
        for (int i = 0; i < 4; ++i) {
          acc[i][0] += a4[i] * b0[0]; acc[i][1] += a4[i] * b0[1]; acc[i][2] += a4[i] * b0[2]; acc[i][3] += a4[i] * b0[3];
          acc[i][4] += a4[i] * b1[0]; acc[i][5] += a4[i] * b1[1]; acc[i][6] += a4[i] * b1[2]; acc[i][7] += a4[i] * b1[3];
        }
      }
    }
#pragma unroll
    for (int i = 0; i < 4; ++i)
#pragma unroll
      for (int j = 0; j < 8; ++j) epi(tm * TM + ty * 4 + i, tn * TN + tx * 8 + j, acc[i][j]);
  }
  __syncthreads();
}

namespace pg8 {
#define PG8_LAS __attribute__((address_space(3)))
typedef unsigned short bf16_t;
typedef short bf16x8 __attribute__((ext_vector_type(8)));
typedef float f32x4 __attribute__((ext_vector_type(4)));
typedef unsigned u32x4 __attribute__((ext_vector_type(4)));
constexpr int BM = 256, BK = 64, HALF = 128, HTB = HALF * BK * 2  , STAGE_BYTES = 8 * HTB, NXCD = 8, WGM = 8;

__host__ __device__ __forceinline__ int lds_byte(int r, int c) { const int st = (r >> 4) * 2 + (c >> 5), rr = r & 15, cc = c & 31, ob = rr * 64 + cc * 2; return st * 1024 + (ob ^ (((ob >> 9) & 1) << 5)); }
__host__ __device__ __forceinline__ void stage_rc(int b, int& R, int& C) { const int st = b / 1024, sb = b % 1024, swz = sb ^ (((sb >> 9) & 1) << 5); R = (st >> 1) * 16 + swz / 64; C = (st & 1) * 32 + (swz % 64) / 2; }
__host__ __device__ __forceinline__ int perm32(int rho) { const int n = rho >> 4, i = rho & 15; return 8 * (i >> 2) + 4 * n + (i & 3); }

struct Unit { int pm, pn, grp; long ao, bo; };
struct Gemm { const bf16_t* A; const bf16_t* Bt; int M, N, K, lda, ldb; };

struct StaticOrder {
    int nM, nN, nwg, G, c; long tsA, tsB;
    __host__ __device__ void init(int M, int N, int G_, int c_, int lda, int ldb) { nM = M / BM; nN = N / BM; nwg = nM * nN; G = G_; c = c_; tsA = (long)BM * lda * 2; tsB = (long)BM * ldb * 2; }
    __host__ __device__ bool next(int i, Unit& u) const {
        const long L = (long)i * G + c; if (L >= nwg) return false;
        int wgid = (int)L; { const int q = nwg / NXCD, r = nwg % NXCD, xcd = wgid % NXCD, off = wgid / NXCD; wgid = (xcd < r ? xcd * (q + 1) : r * (q + 1) + (xcd - r) * q) + off; }
        const int nig = WGM * nN, gid = wgid / nig, fm = gid * WGM, gsz = (nM - fm) < WGM ? (nM - fm) : WGM;
        u.pm = fm + ((wgid % nig) % gsz); u.pn = (wgid % nig) / gsz; u.grp = 0; u.ao = u.pm * tsA; u.bo = u.pn * tsB; return true;
    }
    __device__ __forceinline__ void a_ready(const Unit&) const {}
    __device__ __forceinline__ void done(const Unit&) const {}
};

__device__ __forceinline__ unsigned cvt_pk_bf16(float lo, float hi) { unsigned r; asm volatile("v_cvt_pk_bf16_f32 %0, %1, %2" : "=v"(r) : "v"(lo), "v"(hi)); return r; }
template <class Epi, class Sched, bool ALIGN_EPI = false, bool SP2 = false>
__device__ __forceinline__ void gemm_phase(PG8_LAS unsigned char* lds, const Gemm g, const Sched& S, const Epi& E) {
    int tid_ = threadIdx.x; asm volatile("" : "+v"(tid_));
    const int tid = tid_, wid = __builtin_amdgcn_readfirstlane(tid >> 6), lane = tid & 63, wr = wid >> 2, wc = wid & 3, fr = lane & 15, fq = lane >> 4;
    const int K = g.K, nt = K / BK;
    unsigned voffA[2], voffB[2];
#pragma unroll
    for (int i = 0; i < 2; ++i) { int R, C; stage_rc(tid * 16 + i * 8192, R, C); const int Rb = Epi::PERM ? ((R & ~31) + perm32(R & 31)) : R;
        voffA[i] = (unsigned)(R * g.lda + C) * 2u; voffB[i] = (unsigned)(Rb * g.ldb + C) * 2u; }
    const size_t kstep = (size_t)(BK * 2);
    const size_t hstepA = (size_t)HALF * g.lda * 2, hstepB = (size_t)HALF * g.ldb * 2;
    const unsigned ldsw = (unsigned)wid * 1024u;
    const int aoff = lds_byte(wr * 64 + fr, fq * 8), boff = lds_byte(wc * 32 + fr, fq * 8);
#define PG8_SA(b, h) (((b) * 2 + (h)) * HTB)
#define PG8_SB(b, h) ((4 + (b) * 2 + (h)) * HTB)
#define PG8_STAGE(bufoff, gbase, voff) do { _Pragma("unroll") for (int _i = 0; _i < 2; ++_i) \
        __builtin_amdgcn_global_load_lds((const unsigned*)((const char*)(gbase) + (voff)[_i]), (PG8_LAS unsigned*)(lds + (bufoff) + ldsw + _i * 8192), 16, 0, 0); } while (0)
#define PG8_LDA(dst, b, h) do { _Pragma("unroll") for (int m = 0; m < 4; ++m) _Pragma("unroll") for (int k = 0; k < 2; ++k) dst[m][k] = *(const PG8_LAS bf16x8*)(lds + PG8_SA(b, h) + aoff + m * 2048 + k * 1024); } while (0)
#define PG8_LDB(dst, b, h) do { _Pragma("unroll") for (int n = 0; n < 2; ++n) _Pragma("unroll") for (int k = 0; k < 2; ++k) dst[n][k] = *(const PG8_LAS bf16x8*)(lds + PG8_SB(b, h) + boff + n * 2048 + k * 1024); } while (0)
#define PG8_MMA(ai, bj, At, Bt) do { __builtin_amdgcn_s_setprio(1); _Pragma("unroll") for (int m = 0; m < 4; ++m) _Pragma("unroll") for (int n = 0; n < 2; ++n) _Pragma("unroll") for (int k = 0; k < 2; ++k) \
        acc[ai][bj][m][n] = __builtin_amdgcn_mfma_f32_16x16x32_bf16(Bt[n][k], At[m][k], acc[ai][bj][m][n], 0, 0, 0); __builtin_amdgcn_s_setprio(0); } while (0)
#define PG8_WAIT_V(n) asm volatile("s_waitcnt vmcnt(" #n ")" ::: "memory")
#define PG8_WAIT_L(n) asm volatile("s_waitcnt lgkmcnt(" #n ")" ::: "memory")
#define PG8_BAR __builtin_amdgcn_s_barrier()
#define PG8_SCHED __builtin_amdgcn_sched_barrier(0)
    Unit cur, nxt; int ui = 0;
    if (!S.next(0, cur)) return;
    f32x4 acc[2][2][4][2];
#pragma unroll
    for (int a = 0; a < 2; ++a)
#pragma unroll
        for (int b = 0; b < 2; ++b)
#pragma unroll
            for (int m = 0; m < 4; ++m)
#pragma unroll
                for (int n = 0; n < 2; ++n) acc[a][b][m][n] = (f32x4){0.f, 0.f, 0.f, 0.f};
    bf16x8 At[4][2], B0[2][2], B1[2][2];
    const char* cA = (const char*)g.A + cur.ao; const char* cB = (const char*)g.Bt + cur.bo;
    S.a_ready(cur);
    if constexpr (SP2) {
        PG8_STAGE(PG8_SB(0, 0), cB, voffB); PG8_STAGE(PG8_SB(0, 1), cB + hstepB, voffB); PG8_STAGE(PG8_SA(0, 0), cA, voffA); PG8_STAGE(PG8_SA(0, 1), cA + hstepA, voffA);
        if (wr == 1) PG8_BAR;
        PG8_WAIT_V(2); PG8_BAR;
        PG8_STAGE(PG8_SB(1, 0), cB + kstep, voffB); PG8_STAGE(PG8_SA(1, 0), cA + kstep, voffA); PG8_STAGE(PG8_SB(1, 1), cB + hstepB + kstep, voffB);
        PG8_WAIT_V(6); PG8_BAR;
    } else {
        PG8_STAGE(PG8_SB(0, 0), cB, voffB); PG8_STAGE(PG8_SA(0, 0), cA, voffA); PG8_STAGE(PG8_SB(0, 1), cB + hstepB, voffB); PG8_STAGE(PG8_SA(0, 1), cA + hstepA, voffA);
        if (wr == 1) PG8_BAR;
        PG8_WAIT_V(4); PG8_BAR;
        PG8_STAGE(PG8_SB(1, 0), cB + kstep, voffB); PG8_STAGE(PG8_SA(1, 0), cA + kstep, voffA); PG8_STAGE(PG8_SB(1, 1), cB + hstepB + kstep, voffB);
        PG8_WAIT_V(6); PG8_BAR;
    }
    for (;;) {
        const bool has_next = S.next(ui + 1, nxt);
        const char* nA = has_next ? (const char*)g.A + nxt.ao : cA; const char* nB = has_next ? (const char*)g.Bt + nxt.bo : cB;
        for (int t = 0; t < nt; t += 2) {
            const bool last = (t == nt - 2);
            const char* a1 = cA + (size_t)(t + 1) * kstep;
            const char* a2 = last ? nA : cA + (size_t)(t + 2) * kstep; const char* b2 = last ? nB : cB + (size_t)(t + 2) * kstep;
            const char* a3 = a2 + kstep; const char* b3 = b2 + kstep;
            if (last && has_next) S.a_ready(nxt);
            if constexpr (SP2) {
            PG8_LDB(B0, 0, 0); PG8_LDB(B1, 0, 1); PG8_SCHED; PG8_LDA(At, 0, 0); PG8_STAGE(PG8_SA(1, 1), a1 + hstepA, voffA);
            PG8_WAIT_V(8); PG8_WAIT_L(0); PG8_BAR; PG8_MMA(0, 0, At, B0); PG8_MMA(0, 1, At, B1); PG8_BAR; PG8_SCHED;
            PG8_LDA(At, 0, 1); PG8_STAGE(PG8_SB(0, 0), b2, voffB); PG8_STAGE(PG8_SB(0, 1), b2 + hstepB, voffB); PG8_STAGE(PG8_SA(0, 0), a2, voffA);
            PG8_WAIT_V(8); PG8_WAIT_L(0); PG8_BAR; PG8_MMA(1, 0, At, B0); PG8_MMA(1, 1, At, B1); PG8_BAR; PG8_SCHED;
            PG8_LDB(B0, 1, 0); PG8_LDB(B1, 1, 1); PG8_SCHED; PG8_LDA(At, 1, 0); PG8_STAGE(PG8_SA(0, 1), a2 + hstepA, voffA);
            PG8_WAIT_V(8); PG8_WAIT_L(0); PG8_BAR; PG8_MMA(0, 0, At, B0); PG8_MMA(0, 1, At, B1); PG8_BAR; PG8_SCHED;
            PG8_LDA(At, 1, 1); PG8_STAGE(PG8_SB(1, 0), b3, voffB); PG8_STAGE(PG8_SB(1, 1), b3 + hstepB, voffB); PG8_STAGE(PG8_SA(1, 0), a3, voffA);
            PG8_WAIT_V(8); PG8_WAIT_L(0); PG8_BAR; PG8_MMA(1, 0, At, B0); PG8_MMA(1, 1, At, B1); PG8_BAR; PG8_SCHED;
            } else {
            PG8_LDB(B0, 0, 0); PG8_SCHED; PG8_LDA(At, 0, 0); PG8_STAGE(PG8_SA(1, 1), a1 + hstepA, voffA);
            PG8_WAIT_L(8); PG8_BAR; PG8_WAIT_L(0); PG8_MMA(0, 0, At, B0); PG8_BAR; PG8_SCHED;
            PG8_LDB(B1, 0, 1); PG8_STAGE(PG8_SB(0, 0), b2, voffB);
            PG8_BAR; PG8_WAIT_L(0); PG8_MMA(0, 1, At, B1); PG8_BAR;
            PG8_LDA(At, 0, 1); PG8_STAGE(PG8_SA(0, 0), a2, voffA);
            PG8_BAR; PG8_WAIT_L(0); PG8_MMA(1, 0, At, B0); PG8_BAR; PG8_SCHED;
            PG8_STAGE(PG8_SB(0, 1), b2 + hstepB, voffB);
            PG8_WAIT_V(6); PG8_BAR; PG8_MMA(1, 1, At, B1); PG8_BAR;
            PG8_LDB(B0, 1, 0); PG8_SCHED; PG8_LDA(At, 1, 0); PG8_STAGE(PG8_SA(0, 1), a2 + hstepA, voffA);
            PG8_WAIT_L(8); PG8_BAR; PG8_WAIT_L(0); PG8_MMA(0, 0, At, B0); PG8_BAR; PG8_SCHED;
            PG8_LDB(B1, 1, 1); PG8_STAGE(PG8_SB(1, 0), b3, voffB);
            PG8_BAR; PG8_WAIT_L(0); PG8_MMA(0, 1, At, B1); PG8_BAR;
            PG8_LDA(At, 1, 1); PG8_STAGE(PG8_SA(1, 0), a3, voffA);
            PG8_BAR; PG8_WAIT_L(0); PG8_MMA(1, 0, At, B0); PG8_BAR; PG8_SCHED;
            PG8_STAGE(PG8_SB(1, 1), b3 + hstepB, voffB);
            PG8_WAIT_V(6); PG8_BAR; PG8_MMA(1, 1, At, B1); PG8_BAR;
            }
        }
        if constexpr (ALIGN_EPI) { if (wr == 0) PG8_BAR; }
        if constexpr (!Epi::AFTER_DRAIN) { int fr_ = fr, fq_ = fq; asm volatile("" : "+v"(fr_), "+v"(fq_));
            E(acc, cur, wr, wc, fr_, fq_); S.done(cur); }
        if (!has_next) break;
#pragma unroll
        for (int a = 0; a < 2; ++a)
#pragma unroll
            for (int b = 0; b < 2; ++b)
#pragma unroll
                for (int m = 0; m < 4; ++m)
#pragma unroll
                    for (int n = 0; n < 2; ++n) acc[a][b][m][n] = (f32x4){0.f, 0.f, 0.f, 0.f};
        cur = nxt; cA = nA; cB = nB; ++ui;
        if constexpr (ALIGN_EPI) { if (wr == 1) PG8_BAR; }
    }
    PG8_WAIT_V(0);
    if constexpr (!ALIGN_EPI) { if (wr == 0) PG8_BAR; }
    PG8_BAR;
    if constexpr (Epi::AFTER_DRAIN) { int fr_ = fr, fq_ = fq, lane_ = lane; asm volatile("" : "+v"(fr_), "+v"(fq_), "+v"(lane_)); E.fused(acc, cur, wr, wc, fr_, fq_, lds, wid, lane_); S.done(cur); }
#undef PG8_SA
#undef PG8_SB
#undef PG8_STAGE
#undef PG8_LDA
#undef PG8_LDB
#undef PG8_MMA
#undef PG8_WAIT_V
#undef PG8_WAIT_L
#undef PG8_BAR
#undef PG8_SCHED
}
}


using pg8::Unit;
typedef unsigned u32x2 __attribute__((ext_vector_type(2)));
typedef unsigned u32x4 __attribute__((ext_vector_type(4)));
__device__ __forceinline__ float bflo(unsigned w) { return __uint_as_float(w << 16); }
__device__ __forceinline__ float bfhi(unsigned w) { return __uint_as_float(w & 0xffff0000u); }

struct InProjSched {
  pg8::StaticOrder so;
  __device__ __forceinline__ void init(int G, int c) { so.init(MX, N_IN, G, c, D, D); }
  __device__ __forceinline__ bool next(int i, Unit& u) const {
    const long Lx = (long)i * so.G + so.c;
    if (Lx < so.nwg) return so.next(i, u);
    const int j = (int)(Lx - so.nwg); if (j >= 40) return false;
    u.pm = 64 + (j & 3); u.pn = 4 + (j >> 2); u.grp = 0; u.ao = u.pm * so.tsA; u.bo = u.pn * so.tsB; return true;
  }
  __device__ __forceinline__ void a_ready(const Unit&) const {}
  __device__ __forceinline__ void done(const Unit&) const {}
};

struct EpiInProj {
  static constexpr bool PERM = false, AFTER_DRAIN = false;
  bf16_t *Q, *K, *V, *SA, *G; const float* rope;
  __device__ __forceinline__ static void st4(bf16_t* p, const f32x4 v) { u32x2 w; w.x = pg8::cvt_pk_bf16(v[0], v[1]); w.y = pg8::cvt_pk_bf16(v[2], v[3]); *(u32x2*)p = w; }
  __device__ __forceinline__ void operator()(const f32x4 (&acc)[2][2][4][2], const Unit& u, int wr, int wc, int fr, int fq) const {
    const int row0 = u.pm * 256 + wr * 64 + fr;
    const int cg0 = u.pn * 256 + wc * 32 + fq * 4;
    if (u.pm < 64) {
      if (u.pn < 8) {
        const bool isq = u.pn < 4;
#pragma unroll
        for (int ai = 0; ai < 2; ++ai)
#pragma unroll
          for (int m = 0; m < 4; ++m) {
            const int row = row0 + ai * 128 + m * 16, b = row >> 12, t = row & 4095;
            const int pos = (wc & 1) ? (t & 63) : (t >> 6);
            const f32x4* rp = (const f32x4*)(rope + (pos * 16 + fq * 4) * 2);
            const f32x4 r0 = rp[0], r1 = rp[1];
            const f32x4 cs = {r0[0], r0[2], r1[0], r1[2]}, sn = {r0[1], r0[3], r1[1], r1[3]};
            bf16_t* dst = isq ? Q + (size_t)row * 1024 + cg0 : K + ((size_t)b * LA + NCTX + t) * 1024 + (cg0 - 1024);
#pragma unroll
            for (int bj = 0; bj < 2; ++bj) {
              const f32x4 h1 = acc[ai][bj][m][0], h2 = acc[ai][bj][m][1];
              st4(dst + bj * 128, h1 * cs - h2 * sn);
              st4(dst + bj * 128 + 16, h2 * cs + h1 * sn);
            }
          }
      } else {
#pragma unroll
        for (int ai = 0; ai < 2; ++ai)
#pragma unroll
          for (int m = 0; m < 4; ++m) {
            const int row = row0 + ai * 128 + m * 16, b = row >> 12, t = row & 4095;
            const size_t kr = (size_t)b * LA + NCTX + t;
            if (u.pn >= 12 && u.pn < 14) {
#pragma unroll
              for (int bj = 0; bj < 2; ++bj)
#pragma unroll
                for (int n = 0; n < 2; ++n) {
                  const int ch = cg0 + bj * 128 + n * 16 - 3072;
                  st4(SA + ((size_t)(ch >> 4) * SA_ROWS + b * 128 + (t >> 5)) * SA_LD + (t & 31) * 16 + (ch & 15), acc[ai][bj][m][n]);
                }
            } else {
              bf16_t* dst = u.pn < 12 ? V + kr * 1024 + (cg0 - 2048) : G + (size_t)row * 2048 + (cg0 - 3584);
#pragma unroll
              for (int bj = 0; bj < 2; ++bj)
#pragma unroll
                for (int n = 0; n < 2; ++n) {
                  f32x4 v = acc[ai][bj][m][n];
                  if (u.pn >= 14) { v[0] = sigmoidf_(v[0]); v[1] = sigmoidf_(v[1]); v[2] = sigmoidf_(v[2]); v[3] = sigmoidf_(v[3]); }
                  st4(dst + bj * 128 + n * 16, v);
                }
            }
          }
      }
    } else {
#pragma unroll
      for (int ai = 0; ai < 2; ++ai)
#pragma unroll
        for (int m = 0; m < 4; ++m) {
          const int rc = row0 + ai * 128 + m * 16 - MX, b = rc >> 8, t = rc & 255;
          const size_t kr = (size_t)b * LA + t;
          if (u.pn >= 12) {
#pragma unroll
            for (int bj = 0; bj < 2; ++bj)
#pragma unroll
              for (int n = 0; n < 2; ++n) {
                const int ch = cg0 + bj * 128 + n * 16 - 3072;
                st4(SA + ((size_t)(ch >> 4) * SA_ROWS + 512 + b * 8 + (t >> 5)) * SA_LD + (t & 31) * 16 + (ch & 15), acc[ai][bj][m][n]);
              }
          } else {
            bf16_t* dst = u.pn < 8 ? K + kr * 1024 + (cg0 - 1024) : V + kr * 1024 + (cg0 - 2048);
#pragma unroll
            for (int bj = 0; bj < 2; ++bj)
#pragma unroll
              for (int n = 0; n < 2; ++n) st4(dst + bj * 128 + n * 16, acc[ai][bj][m][n]);
          }
        }
    }
  }
};
template <int MODE>
struct EpiBf8 {
  static constexpr bool PERM = true, AFTER_DRAIN = false;
  bf16_t* O; int ldo; const bf16_t* X; int ldx; const float* bias;
  __device__ __forceinline__ void operator()(const f32x4 (&acc)[2][2][4][2], const Unit& u, int wr, int wc, int fr, int fq) const {
    const int row0 = u.pm * 256 + wr * 64 + fr, col0 = u.pn * 256 + wc * 32 + 8 * fq;
#pragma unroll
    for (int ai = 0; ai < 2; ++ai)
#pragma unroll
      for (int m = 0; m < 4; ++m) {
        const int row = row0 + ai * 128 + m * 16;
#pragma unroll
        for (int bj = 0; bj < 2; ++bj) {
          const int col = col0 + bj * 128;
          f32x4 v0 = acc[ai][bj][m][0], v1 = acc[ai][bj][m][1];
          const u32x4 xw = *(const u32x4*)(X + (size_t)row * ldx + col);
          const f32x4 x0 = {bflo(xw.x), bfhi(xw.x), bflo(xw.y), bfhi(xw.y)}, x1 = {bflo(xw.z), bfhi(xw.z), bflo(xw.w), bfhi(xw.w)};
          if (MODE == 0) {
            const f32x4 b0 = *(const f32x4*)(bias + col), b1 = *(const f32x4*)(bias + col + 4);
#pragma unroll
            for (int i = 0; i < 4; ++i) { v0[i] = x0[i] * sigmoidf_(v0[i] + b0[i]); v1[i] = x1[i] * sigmoidf_(v1[i] + b1[i]); }
          } else if (MODE == 1) { v0 = v0 * x0; v1 = v1 * x1; }
          else {
            const u32x4 ow = *(const u32x4*)(O + (size_t)row * ldo + col);
            const f32x4 o0 = {bflo(ow.x), bfhi(ow.x), bflo(ow.y), bfhi(ow.y)}, o1 = {bflo(ow.z), bfhi(ow.z), bflo(ow.w), bfhi(ow.w)};
            v0 = o0 + v0 * x0; v1 = o1 + v1 * x1;
          }
          u32x4 w; w.x = pg8::cvt_pk_bf16(v0[0], v0[1]); w.y = pg8::cvt_pk_bf16(v0[2], v0[3]); w.z = pg8::cvt_pk_bf16(v1[0], v1[1]); w.w = pg8::cvt_pk_bf16(v1[2], v1[3]);
          *(u32x4*)(O + (size_t)row * ldo + col) = w;
        }
      }
  }
};
template <int MODE>
struct EpiF32 {
  static constexpr bool PERM = false, AFTER_DRAIN = false;
  float* O; const float* xres; const float* mod;
  __device__ __forceinline__ void operator()(const f32x4 (&acc)[2][2][4][2], const Unit& u, int wr, int wc, int fr, int fq) const {
    const int row0 = u.pm * 256 + wr * 64 + fr, col0 = u.pn * 256 + wc * 32 + 4 * fq;
#pragma unroll
    for (int ai = 0; ai < 2; ++ai)
#pragma unroll
      for (int m = 0; m < 4; ++m) {
        const int row = row0 + ai * 128 + m * 16;
#pragma unroll
        for (int bj = 0; bj < 2; ++bj)
#pragma unroll
          for (int n = 0; n < 2; ++n) {
            const int col = col0 + bj * 128 + n * 16;
            f32x4 v = acc[ai][bj][m][n];
            if (MODE == 1) { const f32x4 xr = *(const f32x4*)(xres + (size_t)row * 1024 + col); const f32x4 g = *(const f32x4*)(mod + (row >> 12) * 6144 + 2048 + col); v = xr + g * v; }
            *(f32x4*)(O + (size_t)row * 1024 + col) = v;
          }
      }
  }
};


struct GroupSched {
  int npm, npn, nunits, G, c; long gsA, gsB, tsA, tsB;
  __device__ __forceinline__ void init(int ngrp, int npm_, int npn_, long gsA_, long tsA_, long gsB_, long tsB_, int G_, int c_) { npm = npm_; npn = npn_; nunits = ngrp * npm_ * npn_; gsA = gsA_; tsA = tsA_; gsB = gsB_; tsB = tsB_; G = G_; c = c_; }
  __device__ __forceinline__ bool next(int i, Unit& u) const {
    const long Lx = (long)i * G + c; if (Lx >= nunits) return false;
    const int per = npm * npn, grp = (int)Lx / per, r = (int)Lx % per;
    u.grp = grp; u.pm = r / npn; u.pn = r % npn; u.ao = grp * gsA + u.pm * tsA; u.bo = grp * gsB + u.pn * tsB; return true;
  }
  __device__ __forceinline__ void a_ready(const Unit&) const {}
  __device__ __forceinline__ void done(const Unit&) const {}
};
struct EpiS {
  static constexpr bool PERM = false, AFTER_DRAIN = false;
  float* S;
  __device__ __forceinline__ void operator()(const f32x4 (&acc)[2][2][4][2], const Unit& u, int wr, int wc, int fr, int fq) const {
    const int row0 = u.pm * 256 + wr * 64 + fr, col0 = wc * 32 + 4 * fq;
#pragma unroll
    for (int ai = 0; ai < 2; ++ai)
#pragma unroll
      for (int m = 0; m < 4; ++m) {
        const int row = row0 + ai * 128 + m * 16;
        if (row < SA_ROWS) {
#pragma unroll
          for (int bj = 0; bj < 2; ++bj)
#pragma unroll
            for (int n = 0; n < 2; ++n) *(f32x4*)(S + ((size_t)u.grp * SA_ROWS + row) * 256 + col0 + bj * 128 + n * 16) = acc[ai][bj][m][n];
        }
      }
  }
};
struct EpiY {
  static constexpr bool PERM = true, AFTER_DRAIN = false;
  bf16_t* YG;
  __device__ __forceinline__ void operator()(const f32x4 (&acc)[2][2][4][2], const Unit& u, int wr, int wc, int fr, int fq) const {
    const int row0 = u.pm * 256 + wr * 64 + fr, col0 = u.pn * 256 + wc * 32 + 8 * fq;
#pragma unroll
    for (int ai = 0; ai < 2; ++ai)
#pragma unroll
      for (int m = 0; m < 4; ++m) {
        const int row = row0 + ai * 128 + m * 16, b = row >> 7, cx = row & 127;
#pragma unroll
        for (int bj = 0; bj < 2; ++bj) {
          const int col = col0 + bj * 128, j = col >> 4, p0 = col & 15;
          const f32x4 v0 = acc[ai][bj][m][0], v1 = acc[ai][bj][m][1];
          u32x4 w; w.x = pg8::cvt_pk_bf16(gelu_tanh(v0[0]), gelu_tanh(v0[1])); w.y = pg8::cvt_pk_bf16(gelu_tanh(v0[2]), gelu_tanh(v0[3]));
          w.z = pg8::cvt_pk_bf16(gelu_tanh(v1[0]), gelu_tanh(v1[1])); w.w = pg8::cvt_pk_bf16(gelu_tanh(v1[2]), gelu_tanh(v1[3]));
          *(u32x4*)(YG + ((size_t)(b * L + cx * 32 + j)) * 512 + u.grp * 16 + p0) = w;
        }
      }
  }
};


__device__ __forceinline__ unsigned f2key(float s) { const unsigned u = __float_as_uint(s); return u ^ ((u & 0x80000000u) ? 0xFFFFFFFFu : 0x80000000u); }
__device__ __forceinline__ float key2f(unsigned k) { return __uint_as_float(k ^ ((k & 0x80000000u) ? 0x80000000u : 0xFFFFFFFFu)); }
#define TK_INSERT(L, cv) do { _Pragma("unroll") for (int k_ = 0; k_ < 16; ++k_) { const unsigned hi_ = L[k_] > cv ? L[k_] : cv, lo_ = L[k_] > cv ? cv : L[k_]; L[k_] = hi_; cv = lo_; } } while (0)
struct EpiTopK {
  static constexpr bool PERM = false, AFTER_DRAIN = true;
  unsigned short* IDX; float* GATE;
  __device__ __forceinline__ void fused(f32x4 (&acc)[2][2][4][2], const Unit& u, int wr, int wc, int fr, int fq, PG8_LAS unsigned char* lds, int wid, int lane) const {
    PG8_LAS float* SC = (PG8_LAS float*)lds;
    const int tid = wid * 64 + lane;
#pragma unroll
    for (int ai = 0; ai < 2; ++ai) {
#pragma unroll
      for (int m = 0; m < 4; ++m)
#pragma unroll
        for (int bj = 0; bj < 2; ++bj)
#pragma unroll
          for (int n = 0; n < 2; ++n)
#pragma unroll
            for (int i = 0; i < 4; ++i) SC[(64 * wr + 16 * m + fr) * 257 + 128 * bj + 32 * wc + 16 * n + 4 * fq + i] = acc[ai][bj][m][n][i];
      asm volatile("s_waitcnt lgkmcnt(0)" ::: "memory"); __builtin_amdgcn_s_barrier(); asm volatile("" ::: "memory");
      if (tid < 256) {
        PG8_LAS float* rowp = SC + (tid & 127) * 257 + (tid >> 7) * 128;
        unsigned Lk[16];
#pragma unroll
        for (int k = 0; k < 16; ++k) Lk[k] = 0u;
        for (int k = 0; k < 128; ++k) { unsigned cv = (f2key(rowp[k]) & ~0x7Fu) | (unsigned)(127 - k); TK_INSERT(Lk, cv); }
#pragma unroll
        for (int k = 0; k < 16; ++k) rowp[k] = __uint_as_float(Lk[k]);
      }
      asm volatile("s_waitcnt lgkmcnt(0)" ::: "memory"); __builtin_amdgcn_s_barrier(); asm volatile("" ::: "memory");
      if (tid < 128) {
        PG8_LAS float* rowp = SC + tid * 257;
        float v1[16], v2[16];
#pragma unroll
        for (int k = 0; k < 16; ++k) { v1[k] = key2f(__float_as_uint(rowp[k]) & ~0x7Fu); v2[k] = key2f(__float_as_uint(rowp[128 + k]) & ~0x7Fu); }
        unsigned Lc[16];
#pragma unroll
        for (int k = 0; k < 16; ++k) Lc[k] = 0u;
#pragma unroll
        for (int a = 0; a < 16; ++a)
#pragma unroll
          for (int b = 0; b < 16; ++b)
            if ((a + 1) * (b + 1) <= 16) { unsigned cv = (f2key(v1[a] + v2[b]) & ~0xFFu) | (unsigned)(255 - (a * 16 + b)); TK_INSERT(Lc, cv); }
        float ev[16]; float den = 0.f; const float mx = key2f(Lc[0] & ~0xFFu);
#pragma unroll
        for (int k = 0; k < 16; ++k) { ev[k] = __expf(key2f(Lc[k] & ~0xFFu) - mx); den += ev[k]; }
        const float inv = 1.f / den;
        const size_t o = ((size_t)(u.pm * 256 + ai * 128 + tid) * 8 + u.pn) * 16;
        unsigned iw[8];
#pragma unroll
        for (int k = 0; k < 16; ++k) {
          const int code = 255 - (int)(Lc[k] & 0xFFu), a = code >> 4, b = code & 15;
          const unsigned e1 = 127u - (__float_as_uint(rowp[a]) & 0x7Fu), e2 = 127u - (__float_as_uint(rowp[128 + b]) & 0x7Fu);
          const unsigned ex = e1 * 128u + e2;
          if (k & 1) iw[k >> 1] |= ex << 16; else iw[k >> 1] = ex;
        }
        *(u32x4*)(IDX + o) = (u32x4){iw[0], iw[1], iw[2], iw[3]}; *(u32x4*)(IDX + o + 8) = (u32x4){iw[4], iw[5], iw[6], iw[7]};
#pragma unroll
        for (int k = 0; k < 16; k += 4) *(f32x4*)(GATE + o + k) = (f32x4){ev[k] * inv, ev[k + 1] * inv, ev[k + 2] * inv, ev[k + 3] * inv};
      }
      asm volatile("s_waitcnt lgkmcnt(0)" ::: "memory"); __builtin_amdgcn_s_barrier(); asm volatile("" ::: "memory");
    }
  }
};
struct OneUnitSched {
  int nM, nN, G, c, round; long tsA, tsB;
  __device__ __forceinline__ bool next(int i, Unit& u) const {
    if (i > 0) return false;
    const long Lx = (long)round * G + c; if (Lx >= (long)nM * nN) return false;
    u.pm = (int)(Lx % nM); u.pn = (int)(Lx / nM); u.grp = 0; u.ao = u.pm * tsA; u.bo = u.pn * tsB; return true;
  }
  __device__ __forceinline__ void a_ready(const Unit&) const {}
  __device__ __forceinline__ void done(const Unit&) const {}
};

__device__ __forceinline__ void transpose_item(const float* W, int K, int N, bf16_t* WT, float* scr, int item, int lane) {
  const int nblk = N / 32, kb = item / nblk, nb = item % nblk, k0 = 64 * kb, n0 = 32 * nb;
#pragma unroll 8
  for (int i = 0; i < 32; ++i) { const int kk = 2 * i + (lane >> 5); scr[kk * 33 + (lane & 31)] = W[(size_t)(k0 + kk) * N + n0 + (lane & 31)]; }
  asm volatile("s_waitcnt lgkmcnt(0)" ::: "memory");
  const int c = lane & 7;
#pragma unroll
  for (int j = 0; j < 4; ++j) {
    const int n = (lane >> 3) + 8 * j; const float* s = scr + (8 * c) * 33 + n;
    u32x4 o; o.x = pg8::cvt_pk_bf16(s[0], s[33]); o.y = pg8::cvt_pk_bf16(s[66], s[99]); o.z = pg8::cvt_pk_bf16(s[132], s[165]); o.w = pg8::cvt_pk_bf16(s[198], s[231]);
    *(u32x4*)(WT + (size_t)(n0 + n) * K + k0 + 8 * c) = o;
  }
  asm volatile("s_waitcnt lgkmcnt(0)" ::: "memory");
}

namespace att {
using bf16 = unsigned short;
constexpr int   D = 128, NW = 8, QBLK = 32, KVBLK = 64, SDEPTH = 2;
constexpr float SCALE = 0.125f;
constexpr float THR = 8.f;
constexpr int LDQ = 1024, LDK = 1024, LDO = 1024;
constexpr size_t SHM_V = KVBLK * D * 2, SHM_K = KVBLK * D * 2, SHM_ATTN = 2 * SHM_V + 2 * SHM_K + NW * 64 * 4 + 4 * 4 * 16 * 64 * 4;
using bf16x8 = __attribute__((ext_vector_type(8))) short;
using s16x4  = __attribute__((ext_vector_type(4))) short;
using f32x16 = __attribute__((ext_vector_type(16))) float;
using f32x8  = __attribute__((ext_vector_type(8))) float;
using u32x4  = __attribute__((ext_vector_type(4))) unsigned;
#define KSWZ(row, colB) ((row) * 256 + ((colB) ^ (((row) & 7) << 4)))
#define SBAR() __builtin_amdgcn_sched_barrier(0)
__device__ __forceinline__ int crow(int r, int hi) { return (r & 3) + 8 * (r >> 2) + 4 * hi; }
__device__ __forceinline__ unsigned cvtpk(float lo, float hi) {
  unsigned r; asm volatile("v_cvt_pk_bf16_f32 %0, %1, %2" : "=v"(r) : "v"(lo), "v"(hi)); return r;
}
template <typename TIn> struct Stage;
template <> struct Stage<bf16>  { using T = bf16x8;
  __device__ static __forceinline__ T ld8(const bf16* p) { return *(const __attribute__((address_space(1))) bf16x8*)(p); }
  __device__ static __forceinline__ bf16x8 tobf(T x) { return x; } };
__device__ __forceinline__ void partialSM(f32x16& p0, f32x16& p1, float& m_reg, float& mn, float& alpha) {
  constexpr float C = SCALE * 1.4426950408889634f;
  float pmax = p0[0]; for (int r = 1; r < 16; ++r) pmax = fmaxf(pmax, p0[r]); for (int r = 0; r < 16; ++r) pmax = fmaxf(pmax, p1[r]);
  { auto rr = __builtin_amdgcn_permlane32_swap(__float_as_uint(pmax), __float_as_uint(pmax), false, false);
    pmax = fmaxf(__uint_as_float(rr[0]), __uint_as_float(rr[1])); }
  if (__builtin_expect(__all(pmax - m_reg <= THR / SCALE), 1)) { mn = m_reg; alpha = 1.f; }
  else { mn = fmaxf(m_reg, pmax); alpha = __builtin_amdgcn_exp2f((m_reg - mn) * C); m_reg = mn; }
  float mnC = -mn * C;
  for (int r = 0; r < 16; ++r) p0[r] = fmaf(p0[r], C, mnC); for (int r = 0; r < 16; ++r) p1[r] = fmaf(p1[r], C, mnC);
  for (int r = 0; r < 16; ++r) p0[r] = __builtin_amdgcn_exp2f(p0[r]);
}
__device__ __forceinline__ void finishSM(f32x16& p0, f32x16& p1, float alpha, float& l_reg, bf16x8& pa0, bf16x8& pa1, bf16x8& pa2, bf16x8& pa3) {
  for (int r = 0; r < 16; ++r) p1[r] = __builtin_amdgcn_exp2f(p1[r]);
  float ps = 0; for (int r = 0; r < 16; ++r) ps += p0[r]; for (int r = 0; r < 16; ++r) ps += p1[r];
  { auto rr = __builtin_amdgcn_permlane32_swap(__float_as_uint(ps), __float_as_uint(ps), false, false);
    ps = __uint_as_float(rr[0]) + __uint_as_float(rr[1]); }
  l_reg = l_reg * alpha + ps;
#define PK4(P, BASE, OUT) do { unsigned a0 = cvtpk(P[BASE + 0], P[BASE + 1]), a1 = cvtpk(P[BASE + 2], P[BASE + 3]);   \
    unsigned b0 = cvtpk(P[BASE + 4], P[BASE + 5]), b1 = cvtpk(P[BASE + 6], P[BASE + 7]);                              \
    auto r0 = __builtin_amdgcn_permlane32_swap(a0, b0, false, false); auto r1 = __builtin_amdgcn_permlane32_swap(a1, b1, false, false); \
    u32x4 w = {r0[0], r1[0], r0[1], r1[1]}; OUT = *reinterpret_cast<bf16x8*>(&w); } while (0)
  PK4(p0, 0, pa0); PK4(p0, 8, pa1); PK4(p1, 0, pa2); PK4(p1, 8, pa3);
#undef PK4
}
typedef __attribute__((address_space(3))) const char* lds_cptr_t;
__device__ __forceinline__ void qkt(f32x16& p0, f32x16& p1, const bf16* Ks, const char* qfl_, int r32, int hi, int mcolB) {
  p0 = f32x16{}; p1 = f32x16{};
  unsigned qoff = (unsigned)(uintptr_t)qfl_;
  asm volatile("" : "+v"(qoff));
  const lds_cptr_t qfl = (lds_cptr_t)qoff;
  bf16x8 qr[4];
#pragma unroll
  for (int d0 = 0; d0 < 4; ++d0) qr[d0] = *(const __attribute__((address_space(3))) bf16x8*)(qfl + d0 * 1024);
#pragma unroll
  for (int d0 = 0; d0 < 4; ++d0) { int cb = mcolB + (d0 * 16 + hi * 8) * 2;
    bf16x8 b0 = *reinterpret_cast<const bf16x8*>((const char*)Ks + KSWZ(r32, cb));
    bf16x8 b1 = *reinterpret_cast<const bf16x8*>((const char*)Ks + KSWZ(32 + r32, cb));
    p0 = __builtin_amdgcn_mfma_f32_32x32x16_bf16(b0, qr[d0], p0, 0, 0, 0);
    p1 = __builtin_amdgcn_mfma_f32_32x32x16_bf16(b1, qr[d0], p1, 0, 0, 0); }
}
__device__ __forceinline__ int v_st(int k, int c) { const int kk = (k & ~0xC) | ((k & 4) << 1) | ((k & 8) >> 1); return ((kk >> 3) * 4 + (c >> 5)) * 512 + ((kk & 7) * 32 + (c & 31)) * 2; }
__device__ __forceinline__ int v_rd_base(int lane) { return ((lane & 3) << 3) | (((lane >> 2) & 3) << 6) | (((lane >> 4) & 1) << 5) | (((lane >> 5) & 1) << 8); }
constexpr int v_rd_off(int d0, int ks, int half) { return d0 * 512 + ks * 4096 + half * 2048; }
template <int OFF> __device__ __forceinline__ s16x4 tr_read(int vb) {
  s16x4 r; asm volatile("ds_read_b64_tr_b16 %0, %1 offset:%2" : "=&v"(r) : "v"(vb), "i"(OFF) : "memory"); return r;
}
template <int D0> __device__ __forceinline__ void pv_one(f32x16& od, int vb, bf16x8 pa0, bf16x8 pa1, bf16x8 pa2, bf16x8 pa3) {
  const s16x4 l0 = tr_read<v_rd_off(D0, 0, 0)>(vb), h0 = tr_read<v_rd_off(D0, 0, 1)>(vb), l1 = tr_read<v_rd_off(D0, 1, 0)>(vb), h1 = tr_read<v_rd_off(D0, 1, 1)>(vb);
  const s16x4 l2 = tr_read<v_rd_off(D0, 2, 0)>(vb), h2 = tr_read<v_rd_off(D0, 2, 1)>(vb), l3 = tr_read<v_rd_off(D0, 3, 0)>(vb), h3 = tr_read<v_rd_off(D0, 3, 1)>(vb);
  asm volatile("s_waitcnt lgkmcnt(0)" ::: "memory"); SBAR();
#define PK(L, H) (bf16x8){L[0], L[1], L[2], L[3], H[0], H[1], H[2], H[3]}
  od = __builtin_amdgcn_mfma_f32_32x32x16_bf16(pa0, PK(l0, h0), od, 0, 0, 0);
  od = __builtin_amdgcn_mfma_f32_32x32x16_bf16(pa1, PK(l1, h1), od, 0, 0, 0);
  od = __builtin_amdgcn_mfma_f32_32x32x16_bf16(pa2, PK(l2, h2), od, 0, 0, 0);
  od = __builtin_amdgcn_mfma_f32_32x32x16_bf16(pa3, PK(l3, h3), od, 0, 0, 0);
#undef PK
}
__device__ __forceinline__ void pv_d0(f32x16* o, int vb, bf16x8 pa0, bf16x8 pa1, bf16x8 pa2, bf16x8 pa3) {
  pv_one<0>(o[0], vb, pa0, pa1, pa2, pa3); pv_one<1>(o[1], vb, pa0, pa1, pa2, pa3); pv_one<2>(o[2], vb, pa0, pa1, pa2, pa3); pv_one<3>(o[3], vb, pa0, pa1, pa2, pa3);
}

__device__ __forceinline__ void diff_attn_unit(const bf16* __restrict__ Qb, const bf16* __restrict__ Kh, const bf16* __restrict__ Vh,
                                               bf16* __restrict__ Ob, int seq, float lam, const float* __restrict__ subln, char* lds) {
  using St = Stage<bf16>;
  int tid_ = threadIdx.x; asm volatile("" : "+v"(tid_));
  const int tid = tid_, wid = tid >> 6, lane = tid & 63, r32 = lane & 31, hi = lane >> 5;
  bf16* V_lds = (bf16*)lds; bf16* K_lds = (bf16*)(lds + 2 * SHM_V);
  float* ws = (float*)(lds + 2 * SHM_V + 2 * SHM_K) + wid * 64; float* li_l = ws; float* al_l = ws + 32;
  float m_reg = -1e30f, l_reg = 0; f32x16 o[4] = {};
  const int mw = wid >> 2, wq = wid & 3, mcolB = mw * 128;
  const bf16* Qw = Qb + (long)(wq * QBLK + r32) * LDQ + mw * 64 + hi * 8;
  char* qr = lds + 2 * SHM_V + 2 * SHM_K + NW * 64 * 4 + wid * 4096 + lane * 16;
#pragma unroll
  for (int d0 = 0; d0 < 4; ++d0) *reinterpret_cast<bf16x8*>(qr + d0 * 1024) = St::ld8(Qw + d0 * 16);
  const int sr = tid >> 4, sc = (tid & 15) * 8, vst0 = v_st(sr, sc), vst1 = v_st(32 + sr, sc);
  const int vb0 = (int)(uintptr_t)V_lds + v_rd_base(lane);
  struct { typename St::T vs0, vs1, ks0, ks1; } sr_[SDEPTH];
#define SLOAD(i, k0) do { sr_[i].vs0 = St::ld8(&Vh[(long)((k0) + sr) * LDK + sc]); sr_[i].vs1 = St::ld8(&Vh[(long)((k0) + 32 + sr) * LDK + sc]); \
    sr_[i].ks0 = St::ld8(&Kh[(long)((k0) + sr) * LDK + sc]); sr_[i].ks1 = St::ld8(&Kh[(long)((k0) + 32 + sr) * LDK + sc]); } while (0)
#define SWRITE(b, i) do { *(bf16x8*)((char*)V_lds + (b) * SHM_V + vst0) = St::tobf(sr_[i].vs0);          \
    *(bf16x8*)((char*)V_lds + (b) * SHM_V + vst1) = St::tobf(sr_[i].vs1); int kc = sc * 2;               \
    *(bf16x8*)((char*)K_lds + (b) * SHM_K + KSWZ(sr, kc)) = St::tobf(sr_[i].ks0);                       \
    *(bf16x8*)((char*)K_lds + (b) * SHM_K + KSWZ(32 + sr, kc)) = St::tobf(sr_[i].ks1); } while (0)
#define SWAIT() do { if constexpr (SDEPTH == 2) asm volatile("s_waitcnt vmcnt(4)" ::: "memory"); else asm volatile("s_waitcnt vmcnt(0)" ::: "memory"); } while (0)
#define RESC(a) do { if (__any((a) < 1.f)) { if (hi == 0) al_l[r32] = (a); asm volatile("s_waitcnt lgkmcnt(0)" ::: "memory"); \
    for (int d = 0; d < 4; ++d) for (int r = 0; r < 16; ++r) o[d][r] *= al_l[crow(r, hi)]; } } while (0)
  f32x16 pA0, pA1, pB0, pB1; float mnA, mnB, alA, alB; bf16x8 pa0, pa1, pa2, pa3; const int NT = seq / KVBLK;
  constexpr int SE = 0, SO = SDEPTH - 1;
  SLOAD(SE, 0); asm volatile("s_waitcnt vmcnt(0)" ::: "memory"); SWRITE(0, SE); __syncthreads();
  qkt(pA0, pA1, K_lds, qr, r32, hi, mcolB); partialSM(pA0, pA1, m_reg, mnA, alA);
  SLOAD(SO, KVBLK); if constexpr (SDEPTH == 2) { if (2 < NT) SLOAD(SE, 2 * KVBLK); }
  SWAIT(); SWRITE(1, SO); __syncthreads();
  for (int j = 1; j + 1 < NT; j += 2) {
    SBAR(); qkt(pB0, pB1, (bf16*)((char*)K_lds + SHM_K), qr, r32, hi, mcolB);
    finishSM(pA0, pA1, alA, l_reg, pa0, pa1, pa2, pa3); SBAR();
    SLOAD(SO, (j + SDEPTH) * KVBLK); SBAR();
    pv_d0(o, vb0, pa0, pa1, pa2, pa3); partialSM(pB0, pB1, m_reg, mnB, alB);
    __syncthreads(); SWAIT(); SWRITE(0, SE);
    RESC(alB); __syncthreads();
    SBAR(); qkt(pA0, pA1, K_lds, qr, r32, hi, mcolB);
    finishSM(pB0, pB1, alB, l_reg, pa0, pa1, pa2, pa3); SBAR();
    if (SDEPTH == 1 || j + 3 < NT) SLOAD(SE, (j + 1 + SDEPTH) * KVBLK); SBAR();
    pv_d0(o, vb0 + (int)SHM_V, pa0, pa1, pa2, pa3); partialSM(pA0, pA1, m_reg, mnA, alA);
    __syncthreads(); SWAIT(); SWRITE(1, SO);
    RESC(alA); __syncthreads();
  }
  SBAR(); qkt(pB0, pB1, (bf16*)((char*)K_lds + SHM_K), qr, r32, hi, mcolB);
  finishSM(pA0, pA1, alA, l_reg, pa0, pa1, pa2, pa3); SBAR();
  pv_d0(o, vb0, pa0, pa1, pa2, pa3); partialSM(pB0, pB1, m_reg, mnB, alB);
  __syncthreads(); RESC(alB);
  finishSM(pB0, pB1, alB, l_reg, pa0, pa1, pa2, pa3); SBAR();
  pv_d0(o, vb0 + (int)SHM_V, pa0, pa1, pa2, pa3);
  if (hi == 0) li_l[r32] = l_reg; asm volatile("s_waitcnt lgkmcnt(0)" ::: "memory");
  float rli[16];
#pragma unroll
  for (int r = 0; r < 16; ++r) rli[r] = __builtin_amdgcn_rcpf(li_l[crow(r, hi)]);
  float* EXO = (float*)(lds + 2 * SHM_V + 2 * SHM_K + NW * 64 * 4) + wq * (4 * 16 * 64) + lane;
  if (mw == 1) {
#pragma unroll
    for (int d0 = 0; d0 < 4; ++d0)
#pragma unroll
      for (int r = 0; r < 16; ++r) EXO[(d0 * 16 + r) * 64] = o[d0][r] * rli[r];
  }
  __syncthreads();
  if (mw == 0) {
    float ssq[16];
#pragma unroll
    for (int r = 0; r < 16; ++r) ssq[r] = 0.f;
#pragma unroll
    for (int d0 = 0; d0 < 4; ++d0)
#pragma unroll
      for (int r = 0; r < 16; ++r) { const float dv = o[d0][r] * rli[r] - lam * EXO[(d0 * 16 + r) * 64]; o[d0][r] = dv; ssq[r] += dv * dv; }
#pragma unroll
    for (int r = 0; r < 16; ++r) {
#pragma unroll
      for (int sft = 1; sft < 32; sft <<= 1) ssq[r] += __shfl_xor(ssq[r], sft);
      ssq[r] = rsqrtf(ssq[r] * (1.f / 128.f) + 1e-6f) * 0.8f;
    }
    bf16* Ow = Ob + (long)(wq * QBLK) * LDO;
#pragma unroll
    for (int d0 = 0; d0 < 4; ++d0) { const float gg = subln[d0 * 32 + r32];
#pragma unroll
      for (int r = 0; r < 16; ++r) { const float val = o[d0][r] * ssq[r] * gg; Ow[(long)crow(r, hi) * LDO + d0 * 32 + r32] = (bf16)(pg8::cvt_pk_bf16(val, val) & 0xffffu); } }
  }
  __syncthreads();
#undef SLOAD
#undef SWRITE
#undef SWAIT
#undef RESC
}
}


typedef __bf16 bf16x2_t __attribute__((ext_vector_type(2)));
__device__ __forceinline__ float dot2bf(unsigned a, unsigned b, float acc) { return __builtin_amdgcn_fdot2_f32_bf16(__builtin_bit_cast(bf16x2_t, a), __builtin_bit_cast(bf16x2_t, b), acc, false); }
template <int CTRL> __device__ __forceinline__ float dpp_add(float v) { return v + __builtin_bit_cast(float, __builtin_amdgcn_update_dpp(0, __builtin_bit_cast(int, v), CTRL, 0xf, 0xf, true)); }
__device__ __forceinline__ float row16_sum(float v) {
  v = dpp_add<0xB1>(v); v = dpp_add<0x4E>(v); v = dpp_add<0x141>(v); v = dpp_add<0x140>(v); return v;
}

typedef unsigned u32x2_t __attribute__((ext_vector_type(2)));
typedef float f32x2_t __attribute__((ext_vector_type(2)));
__device__ __forceinline__ void slice_table_fp8(const float* T, unsigned char* T8, float scale, int gtid, int gsz) {
  for (int it0 = gtid; it0 < 16384 * 128; it0 += 4 * gsz) {
    f32x4 a[4], b[4];
#pragma unroll
    for (int q = 0; q < 4; ++q) { const int it = it0 + q * gsz; if (it < 16384 * 128) { const int e = it >> 7, c8 = (it & 127) * 8; a[q] = *(const f32x4*)(T + (size_t)e * 1024 + c8); b[q] = *(const f32x4*)(T + (size_t)e * 1024 + c8 + 4); } }
#pragma unroll
    for (int q = 0; q < 4; ++q) { const int it = it0 + q * gsz; if (it < 16384 * 128) {
      const int e = it >> 7, c8 = (it & 127) * 8, j = c8 >> 7, c = c8 & 127; const f32x4 as = a[q] * scale, bs = b[q] * scale;
      int w0 = __builtin_amdgcn_cvt_pk_fp8_f32(as[0], as[1], 0, false); w0 = __builtin_amdgcn_cvt_pk_fp8_f32(as[2], as[3], w0, true);
      int w1 = __builtin_amdgcn_cvt_pk_fp8_f32(bs[0], bs[1], 0, false); w1 = __builtin_amdgcn_cvt_pk_fp8_f32(bs[2], bs[3], w1, true);
      *(u32x2_t*)(T8 + ((size_t)j * 16384 + e) * 128 + c) = (u32x2_t){(unsigned)w0, (unsigned)w1}; } }
  }
}
__device__ __forceinline__ void slice_table(const float* T, bf16_t* T8, int gtid, int gsz) {
  for (int it = gtid; it < 16384 * 128; it += gsz) {
    const int e = it >> 7, c8 = (it & 127) * 8, j = c8 >> 7, c = c8 & 127;
    const f32x4 a = *(const f32x4*)(T + (size_t)e * 1024 + c8), b = *(const f32x4*)(T + (size_t)e * 1024 + c8 + 4);
    u32x4 w; w.x = pg8::cvt_pk_bf16(a[0], a[1]); w.y = pg8::cvt_pk_bf16(a[2], a[3]); w.z = pg8::cvt_pk_bf16(b[0], b[1]); w.w = pg8::cvt_pk_bf16(b[2], b[3]);
    *(u32x4*)(T8 + ((size_t)j * 16384 + e) * 128 + c) = w;
  }
}

#define LAS __attribute__((address_space(3)))
#define XB_TMO      128
#define XB_XCNT(j)  (256  + 64 * (j))
#define XB_XSUB(j)  (1280 + 64 * (j))
#define XB_XGEN(j)  (2304 + 64 * (j))
#define XB_TOP      3328
#define XB_TOPGEN   3392
#define XCD_BAR_WORDS 3456
#define XB_SPIN_CAP (1u << 18)

__device__ __forceinline__ unsigned xb_ld(unsigned* p)              { return __hip_atomic_load(p, __ATOMIC_RELAXED, __HIP_MEMORY_SCOPE_AGENT); }
__device__ __forceinline__ unsigned xb_add(unsigned* p, unsigned v) { return __hip_atomic_fetch_add(p, v, __ATOMIC_RELAXED, __HIP_MEMORY_SCOPE_AGENT); }
__device__ __forceinline__ unsigned xb_xcc_id() { return (unsigned)__builtin_amdgcn_s_getreg((3 << 11) | 20) & 0xFu; }
#define XB_SPIN(cond, bar) do { unsigned _sp = 0; while (cond) { __builtin_amdgcn_s_sleep(1); \
    if ((++_sp & 255u) == 0u) { if (xb_ld(&(bar)[XB_TMO])) break; if (_sp > XB_SPIN_CAP) { atomicAdd(&(bar)[XB_TMO], 1u); break; } } } } while (0)

struct XcdBarrier {
    unsigned* bar; unsigned x;
    volatile LAS unsigned* st;
};

__device__ __forceinline__ XcdBarrier xcd_barrier_post(unsigned* bar, volatile LAS unsigned* st) {
    XcdBarrier b; b.bar = bar; b.x = xb_xcc_id(); b.st = st;
    if (threadIdx.x == 0) (void)xb_add(&bar[XB_XCNT(b.x)], 1u);
    return b;
}
__device__ __forceinline__ void xcd_barrier_complete(unsigned* bar, unsigned x, unsigned& nloc, unsigned& nx) {
    const unsigned G = gridDim.x * gridDim.y * gridDim.z;
    unsigned sum, cnt, mine, sp = 0u;
    for (;;) {
        sum = 0u; cnt = 0u; mine = 0u;
#pragma unroll
        for (unsigned j = 0; j < 16; ++j) { const unsigned c = xb_ld(&bar[XB_XCNT(j)]); sum += c; cnt += (c > 0u) ? 1u : 0u; mine = (j == x) ? c : mine; }
        if (sum == G) break;
        __builtin_amdgcn_s_sleep(1);
        if ((++sp & 255u) == 0u) { if (xb_ld(&bar[XB_TMO])) break; if (sp > XB_SPIN_CAP) { atomicAdd(&bar[XB_TMO], 1u); break; } }
    }
    nloc = mine > 0u ? mine : 1u; nx = cnt > 0u ? cnt : 1u;
}

__device__ __forceinline__ void xcd_barrier(const XcdBarrier& b) {
    asm volatile("s_waitcnt vmcnt(0)" ::: "memory");
    __syncthreads();
    if (threadIdx.x == 0) {
        unsigned* bar = b.bar;
        __builtin_amdgcn_s_waitcnt(0);
        unsigned nloc = b.st[0], nx = b.st[1];
        if (nloc == 0u) { xcd_barrier_complete(bar, b.x, nloc, nx); b.st[0] = nloc; b.st[1] = nx; }
        const unsigned old = xb_add(&bar[XB_XSUB(b.x)], 1u);
        const unsigned gen = old / nloc;
        if (old + 1u == (gen + 1u) * nloc) {
            __builtin_amdgcn_fence(__ATOMIC_RELEASE, "agent");
            asm volatile("s_waitcnt vmcnt(0)" ::: "memory");
            const unsigned og = xb_add(&bar[XB_TOP], 1u);
            const unsigned tg = og / nx;
            if (og + 1u == (tg + 1u) * nx) xb_add(&bar[XB_TOPGEN], 1u);
            else XB_SPIN(xb_ld(&bar[XB_TOPGEN]) == tg, bar);
            __builtin_amdgcn_fence(__ATOMIC_ACQUIRE, "agent");
            xb_add(&bar[XB_XGEN(b.x)], 1u);
            asm volatile("s_waitcnt vmcnt(0)" ::: "memory");
        } else {
            XB_SPIN(xb_ld(&bar[XB_XGEN(b.x)]) == gen, bar);
            __builtin_amdgcn_fence(__ATOMIC_ACQUIRE, "agent");
            asm volatile("s_waitcnt vmcnt(0)" ::: "memory");
        }
    }
    __syncthreads();
}


__device__ __forceinline__ void wave_argmax(float& v, int& i) {
#pragma unroll
  for (int o = 32; o; o >>= 1) {
    const float ov = __shfl_xor(v, o); const int oi = __shfl_xor(i, o);
    if (ov > v || (ov == v && oi < i)) { v = ov; i = oi; }
  }
}

__global__ void __launch_bounds__(NT) mega(Params p) {
  extern __shared__ __attribute__((aligned(16))) unsigned char lds[];
  cg::grid_group grid = cg::this_grid();
  if (threadIdx.x < 35) {
    unsigned long long v = threadIdx.x < 33 ? (unsigned long long)p.in[threadIdx.x] : (threadIdx.x == 33 ? (unsigned long long)p.out : (unsigned long long)p.ws);
    ((unsigned long long*)(lds + PTR_OFF))[threadIdx.x] = v;
  }
  if (threadIdx.x < 2) ((volatile unsigned*)(lds + PTR_OFF + 800))[threadIdx.x] = 0u;
  __syncthreads();
  if (blockIdx.x == 0) for (int i = threadIdx.x; i < XCD_BAR_WORDS; i += NT) ((unsigned*)WSP(WS_BAR))[i] = 0u;

  {
    PHASE_LOCALS
    float* MOD = (float*)WSP(WS_MOD); float* LAM = (float*)WSP(WS_LAM);
    float* ABRE = (float*)WSP(WS_ABRE); float* ABIM = (float*)WSP(WS_ABIM); float* BBRE = (float*)WSP(WS_BBRE); float* BBIM = (float*)WSP(WS_BBIM);
    const float* cin = INP(1); const float* c_ctx = INP(3); const float* ada_w = INP(4); const float* ada_b = INP(5);
    if (gridDim.x >= 192) {
      if (blockIdx.x < 192) {
        float* sil = fl; float* red = fl + 5 * 1024;
        for (int i = tid; i < 5 * 1024; i += NT) { const int r = i >> 10, k = i & 1023; sil[i] = siluf_(r < 4 ? cin[r * D + k] : c_ctx[k]); }
        __syncthreads();
        const int cl = tid & 31, kg = tid >> 5, col = blockIdx.x * 32 + cl;
        float a[5] = {0.f, 0.f, 0.f, 0.f, 0.f};
#pragma unroll
        for (int kk = 0; kk < 64; ++kk) {
          const int k = kg * 64 + kk; const float w = ada_w[(size_t)k * 6144 + col];
#pragma unroll
          for (int r = 0; r < 5; ++r) a[r] += sil[r * 1024 + k] * w;
        }
#pragma unroll
        for (int r = 0; r < 5; ++r) red[(kg * 5 + r) * 32 + cl] = a[r];
        __syncthreads();
        if (tid < 160) {
          const int r = tid >> 5; float s = 0.f;
#pragma unroll
          for (int q = 0; q < 16; ++q) s += red[(q * 5 + r) * 32 + cl];
          MOD[r * 6144 + col] = s + ada_b[col];
        }
        __syncthreads();
      }
    } else {
      for (int it = gtid; it < 5 * 6144; it += gsz) {
        const int r = it / 6144, j = it % 6144;
        const float* cv = r < 4 ? cin + r * D : c_ctx;
        float a = 0.f;
        for (int k = 0; k < D; ++k) a += siluf_(cv[k]) * ada_w[(size_t)k * 6144 + j];
        MOD[it] = a + ada_b[j];
      }
    }
    if (gtid == 0) {
      const float* q1 = INP(9); const float* k1 = INP(10); const float* q2 = INP(11); const float* k2 = INP(12);
      float s1 = 0.f, s2 = 0.f;
      for (int k = 0; k < 64; ++k) { s1 += q1[k] * k1[k]; s2 += q2[k] * k2[k]; }
      LAM[0] = expf(s1) - expf(s2) + 0.2f;
    }
    const float* a_re = INP(15); const float* a_im = INP(16); const float* ldt = INP(17); const float* b_re = INP(18); const float* b_im = INP(19);
    for (int it = gtid; it < 2 * 32 * 64; it += gsz) {
      const int dg = it >> 6;
      const float ar = a_re[it], ai = a_im[it], dt = expf(ldt[dg]);
      const float mag = expf(ar * dt), abr = mag * cosf(ai * dt), abi = mag * sinf(ai * dt);
      ABRE[it] = abr; ABIM[it] = abi; ((float*)WSP(WS_ARDT))[it] = ar * dt; ((float*)WSP(WS_AIDT))[it] = ai * dt;
      const float den = ar * ar + ai * ai, nr = abr - 1.f, ni = abi;
      const float fr = (nr * ar + ni * ai) / den, fi = (ni * ar - nr * ai) / den;
      for (int pp = 0; pp < 16; ++pp) {
        const float br = b_re[it * 16 + pp], bi = b_im[it * 16 + pp];
        BBRE[it * 16 + pp] = fr * br - fi * bi; BBIM[it * 16 + pp] = fr * bi + fi * br;
      }
    }
    {
      struct BB { float fr, fi, ardt, aidt; };
      auto disc1 = [&](int sidx) -> BB {
        const float ar = a_re[sidx], ai = a_im[sidx], dt = expf(ldt[sidx >> 6]);
        const float mag = expf(ar * dt), abr = mag * cosf(ai * dt), abi = mag * sinf(ai * dt);
        const float den = ar * ar + ai * ai, nr = abr - 1.f, ni = abi;
        return BB{(nr * ar + ni * ai) / den, (ni * ar - nr * ai) / den, ar * dt, ai * dt};
      };
      {
        bf16_t* BTS = (bf16_t*)WSP(WS_BTS);
        for (int it = gtid; it < 32 * 256 * 32; it += gsz) {
          const int i = it & 31, r = (it >> 5) & 255, g = it >> 13;
          const int d = r >> 7, n = (r >> 1) & 63, ri = r & 1, sidx = (d * 32 + g) * 64 + n;
          const BB bb = disc1(sidx);
          const float e = (float)(d == 0 ? 31 - i : i);
          const float mag = __expf(e * bb.ardt), pr0 = mag * __cosf(e * bb.aidt), pi0 = mag * __sinf(e * bb.aidt);
          const float pr = pr0 * bb.fr - pi0 * bb.fi, pi = pr0 * bb.fi + pi0 * bb.fr;
          unsigned w[8];
#pragma unroll
          for (int q = 0; q < 8; ++q) {
            const float br0 = b_re[sidx * 16 + 2 * q], bi0 = b_im[sidx * 16 + 2 * q], br1 = b_re[sidx * 16 + 2 * q + 1], bi1 = b_im[sidx * 16 + 2 * q + 1];
            const float v0 = ri == 0 ? pr * br0 - pi * bi0 : pr * bi0 + pi * br0, v1 = ri == 0 ? pr * br1 - pi * bi1 : pr * bi1 + pi * br1;
            w[q] = pg8::cvt_pk_bf16(v0, v1);
          }
          u32x4* dst = (u32x4*)(BTS + ((size_t)g * 256 + r) * 512 + i * 16);
          dst[0] = (u32x4){w[0], w[1], w[2], w[3]}; dst[1] = (u32x4){w[4], w[5], w[6], w[7]};
        }
      }
      {
        float* KT = (float*)WSP(WS_KT); const float* c_re = INP(20); const float* c_im = INP(21);
        if (gridDim.x >= 256) {
          if (blockIdx.x >= 192) {
            const int dg = (int)blockIdx.x - 192; float* dsc = fl;
            if (tid < 64) { const BB bb = disc1(dg * 64 + tid); dsc[tid * 4] = bb.fr; dsc[tid * 4 + 1] = bb.fi; dsc[tid * 4 + 2] = bb.ardt; dsc[tid * 4 + 3] = bb.aidt; }
            __syncthreads();
            const int pp = tid & 15, m = tid >> 4;
            float acc[16];
#pragma unroll
            for (int q = 0; q < 16; ++q) acc[q] = 0.f;
            for (int n = 0; n < 64; ++n) {
              const int sidx = dg * 64 + n;
              const float fr = dsc[n * 4], fi = dsc[n * 4 + 1], ardt = dsc[n * 4 + 2], aidt = dsc[n * 4 + 3];
              const float mag = __expf((float)m * ardt), pr0 = mag * __cosf((float)m * aidt), pi0 = mag * __sinf((float)m * aidt);
              const float pr = pr0 * fr - pi0 * fi, pi = pr0 * fi + pi0 * fr;
              const float cr = c_re[(dg * 16 + pp) * 64 + n], ci = c_im[(dg * 16 + pp) * 64 + n];
              const float wr_ = cr * pr - ci * pi, wi_ = cr * pi + ci * pr;
#pragma unroll
              for (int q = 0; q < 16; ++q) acc[q] += wr_ * b_re[sidx * 16 + q] - wi_ * b_im[sidx * 16 + q];
            }
#pragma unroll
            for (int q = 0; q < 16; ++q) KT[((size_t)dg * 32 + m) * 256 + pp * 16 + q] = acc[q];
            __syncthreads();
          }
        } else {
          for (int it = gtid; it < 2 * 32 * 32 * 16; it += gsz) {
            const int pp = it & 15, m = (it >> 4) & 31, dg = it >> 9;
            float acc[16];
#pragma unroll
            for (int q = 0; q < 16; ++q) acc[q] = 0.f;
            for (int n = 0; n < 64; ++n) {
              const int sidx = dg * 64 + n;
              const BB bb = disc1(sidx);
              const float mag = __expf((float)m * bb.ardt), pr0 = mag * __cosf((float)m * bb.aidt), pi0 = mag * __sinf((float)m * bb.aidt);
              const float pr = pr0 * bb.fr - pi0 * bb.fi, pi = pr0 * bb.fi + pi0 * bb.fr;
              const float cr = c_re[(dg * 16 + pp) * 64 + n], ci = c_im[(dg * 16 + pp) * 64 + n];
              const float wr_ = cr * pr - ci * pi, wi_ = cr * pi + ci * pr;
#pragma unroll
              for (int q = 0; q < 16; ++q) acc[q] += wr_ * b_re[sidx * 16 + q] - wi_ * b_im[sidx * 16 + q];
            }
#pragma unroll
            for (int q = 0; q < 16; ++q) KT[((size_t)dg * 32 + m) * 256 + pp * 16 + q] = acc[q];
          }
        }
      }
    }
    float* ROPE = (float*)WSP(WS_ROPE);
    for (int it = gtid; it < 64 * 16; it += gsz) {
      const float ang = (float)(it >> 4) * powf(10000.f, -(float)(it & 15) / 16.f);
      ROPE[it * 2] = cosf(ang); ROPE[it * 2 + 1] = sinf(ang);
    }
    {
      float* scr = fl + wid * (64 * 33);
      constexpr int I_IN = 16 * 176, I_AU = 16 * 32, I_SU = 8 * 32, I_OUT = 16 * 32, I_Q = 16 * 32, I_GLU = 8 * 16;
      for (int it = gw; it < I_IN + I_AU + I_SU + I_OUT + I_GLU; it += ngw) {
        int r = it;
        if (r < I_IN) { transpose_item(INP(8), 1024, N_IN, (bf16_t*)WSP(WS_WIN), scr, r, lane); continue; } r -= I_IN;
        if (r < I_AU) { transpose_item(INP(14), 1024, 1024, (bf16_t*)WSP(WS_WAU), scr, r, lane); continue; } r -= I_AU;
        if (r < I_SU) { transpose_item(INP(25), 512, 1024, (bf16_t*)WSP(WS_WSU), scr, r, lane); continue; } r -= I_SU;
        if (r < I_OUT) { transpose_item(INP(26), 1024, 1024, (bf16_t*)WSP(WS_WOUT), scr, r, lane); continue; } r -= I_OUT;
        transpose_item(INP(23), 512, 512, (bf16_t*)WSP(WS_WGLU), scr, r, lane);
      }
    }
  }
  grid.sync();
  const XcdBarrier xbar = xcd_barrier_post((unsigned*)WSP(WS_BAR), (volatile LAS unsigned*)(lds + PTR_OFF + 800));

  {
    PHASE_LOCALS
    const float* MOD = (const float*)WSP(WS_MOD); bf16_t* XN = (bf16_t*)WSP(WS_XN);
    const float* x = INP(0); const float* ctx = INP(2); const float* norm1_g = INP(6);
    for (int row = gw; row < MX + MC; row += ngw) {
      const float* src; const float* md;
      if (row < MX) { src = x + (size_t)row * D; md = MOD + (row / L) * 6144; } else { src = ctx + (size_t)(row - MX) * D; md = MOD + 4 * 6144; }
      f32x4 v[4]; float ss = 0.f;
#pragma unroll
      for (int j = 0; j < 4; ++j) { v[j] = *(const f32x4*)(src + lane * 4 + 256 * j); ss += v[j][0] * v[j][0] + v[j][1] * v[j][1] + v[j][2] * v[j][2] + v[j][3] * v[j][3]; }
      const float rstd = rsqrtf(wave_sum(ss) * (1.f / D) + 1e-6f);
#pragma unroll
      for (int j = 0; j < 4; ++j)
#pragma unroll
        for (int e = 0; e < 4; ++e) { const int col = lane * 4 + 256 * j + e; XN[(size_t)row * D + col] = f2bf(v[j][e] * rstd * norm1_g[col] * (1.f + md[1024 + col]) + md[col]); }
    }
  }
  xcd_barrier(xbar);

  {
    pg8::Gemm g{(const bf16_t*)WSP(WS_XN), (const bf16_t*)WSP(WS_WIN), MX + MC, N_IN, D, D, D};
    InProjSched S; S.init((int)gridDim.x, (int)blockIdx.x);
    EpiInProj E{(bf16_t*)WSP(WS_Q), (bf16_t*)WSP(WS_K), (bf16_t*)WSP(WS_V), (bf16_t*)WSP(WS_SA), (bf16_t*)WSP(WS_G), (const float*)WSP(WS_ROPE)};
    pg8::gemm_phase<EpiInProj, InProjSched, true, true>((PG8_LAS unsigned char*)lds, g, S, E);
  }
  xcd_barrier(xbar);

  {
    const float lam = ((const float*)WSP(WS_LAM))[0];
    const bf16_t* Qb = (const bf16_t*)WSP(WS_Q); const bf16_t* Kb = (const bf16_t*)WSP(WS_K); const bf16_t* Vb = (const bf16_t*)WSP(WS_V);
    bf16_t* ATT = (bf16_t*)WSP(WS_ATT); const float* subln = INP(13);
    for (int unit = blockIdx.x; unit < Bn * 8 * (L / 128); unit += gridDim.x) {
      const int h = unit & 7, qb = (unit >> 3) & 31, b = unit >> 8;
      const size_t qoff = ((size_t)(b * L + qb * 128)) * 1024 + h * 128, koff = (size_t)b * LA * 1024 + h * 128;
      att::diff_attn_unit(Qb + qoff, Kb + koff, Vb + koff, ATT + qoff, LA, lam, subln, (char*)lds);
    }
  }
  xcd_barrier(xbar);

  {
    const bool gemm_blk = (blockIdx.x < 96) || (gridDim.x <= 96);
    if (gemm_blk) {
      pg8::Gemm g{(const bf16_t*)WSP(WS_SA), (const bf16_t*)WSP(WS_BTS), 0, 0, 512, SA_LD, 512};
      GroupSched S; S.init(32, 3, 1, (long)SA_ROWS * SA_LD * 2, (long)256 * SA_LD * 2, (long)256 * 512 * 2, 0, (int)(gridDim.x <= 96 ? gridDim.x : 96), (int)blockIdx.x);
      EpiS E{(float*)WSP(WS_S)};
      pg8::gemm_phase<EpiS, GroupSched, true, true>((PG8_LAS unsigned char*)lds, g, S, E);
    }
    {
      PHASE_LOCALS
      const bool big = gridDim.x > 96;
      const int vslots = big ? (gemm_blk ? 3 : 5) : 1, vbase = big ? (gemm_blk ? (int)blockIdx.x * 3 : 96 * 3 + ((int)blockIdx.x - 96) * 5) : (int)blockIdx.x;
      const int vtot = big ? 96 * 3 + ((int)gridDim.x - 96) * 5 : (int)gridDim.x;
      const float* KT = (const float*)WSP(WS_KT); const float* ARDT = (const float*)WSP(WS_ARDT); const float* AIDT = (const float*)WSP(WS_AIDT);
      const float* c_re = INP(20); const float* c_im = INP(21); const float* dsk = INP(22); bf16_t* BTY = (bf16_t*)WSP(WS_BTY);
      for (int cb = vbase; cb < 32 * 512 * 96 / NT; cb += vtot) for (int vs = 0; vs < vslots; ++vs) {
        const int ch = cb + vs; if (ch >= 32 * 512 * 96 / NT) break;
        const int it = ch * NT + tid;
        const int cgp = it % 96, row = (it / 96) & 511, g = it / (96 * 512);
        const int j = row >> 4, pp = row & 15, col0 = cgp * 8;
        float v[8];
        if (col0 < 512) {
          const int i = col0 >> 4, q0 = col0 & 15;
#pragma unroll
          for (int e = 0; e < 8; ++e) v[e] = 0.f;
          if (i <= j) { const float* kp = KT + ((size_t)(0 * 32 + g) * 32 + (j - i)) * 256 + pp * 16 + q0;
#pragma unroll
            for (int e = 0; e < 8; ++e) v[e] += kp[e]; }
          if (i >= j) { const float* kp = KT + ((size_t)(1 * 32 + g) * 32 + (i - j)) * 256 + pp * 16 + q0;
#pragma unroll
            for (int e = 0; e < 8; ++e) v[e] += kp[e]; }
          if (i == j && pp >= q0 && pp < q0 + 8) {
#pragma unroll
            for (int e = 0; e < 8; ++e) if (q0 + e == pp) v[e] += dsk[g * 16 + pp];
          }
        } else {
          const int cc0 = col0 - 512, d = cc0 >> 7, n0 = (cc0 & 127) >> 1;
          const float ex = (float)(d == 0 ? j + 1 : 32 - j);
#pragma unroll
          for (int q = 0; q < 4; ++q) {
            const int n = n0 + q, sidx = (d * 32 + g) * 64 + n;
            const float mag = __expf(ex * ARDT[sidx]), pr = mag * __cosf(ex * AIDT[sidx]), pi = mag * __sinf(ex * AIDT[sidx]);
            const float cr = c_re[((d * 32 + g) * 16 + pp) * 64 + n], ci = c_im[((d * 32 + g) * 16 + pp) * 64 + n];
            v[2 * q] = cr * pr - ci * pi; v[2 * q + 1] = -(cr * pi + ci * pr);
          }
        }
        u32x4 w; w.x = pg8::cvt_pk_bf16(v[0], v[1]); w.y = pg8::cvt_pk_bf16(v[2], v[3]); w.z = pg8::cvt_pk_bf16(v[4], v[5]); w.w = pg8::cvt_pk_bf16(v[6], v[7]);
        *(u32x4*)(BTY + ((size_t)g * 512 + row) * 768 + col0) = w;
      }
    }
  }
  xcd_barrier(xbar);

  {
    PHASE_LOCALS
    const float* ARDT = (const float*)WSP(WS_ARDT); const float* AIDT = (const float*)WSP(WS_AIDT);
    if (wid == 0) {
      for (int it = blockIdx.x; it < Bn * 32 * 2; it += gridDim.x) {
        const int d = it & 1, g = (it >> 1) & 31, b = it >> 6;
        const int sidx = (d * 32 + g) * 64 + lane;
        const float mag = expf(32.f * ARDT[sidx]), pr = mag * cosf(32.f * AIDT[sidx]), pi = mag * sinf(32.f * AIDT[sidx]);
        typedef float f32x2_ __attribute__((ext_vector_type(2)));
        const f32x2_* Sg = (const f32x2_*)((const float*)WSP(WS_S) + (size_t)g * SA_ROWS * 256) + d * 64 + lane;
        bf16_t* SAg = (bf16_t*)WSP(WS_SA) + (size_t)g * SA_ROWS * SA_LD + 512 + d * 128 + lane * 2;
        float hr = 0.f, hi = 0.f;
        f32x2_ sc[8];
#pragma unroll
        for (int k = 0; k < 8; ++k) { const int cc = d == 0 ? k : 7 - k; sc[k] = Sg[(size_t)(512 + b * 8 + cc) * 128]; }
#pragma unroll
        for (int k = 0; k < 8; ++k) { const float nr = pr * hr - pi * hi + sc[k][0], ni = pr * hi + pi * hr + sc[k][1]; hr = nr; hi = ni; }
        for (int k0 = 0; k0 < 128; k0 += 16) {
          f32x2_ sv[16];
#pragma unroll
          for (int k = 0; k < 16; ++k) { const int cx = d == 0 ? k0 + k : 127 - (k0 + k); sv[k] = Sg[(size_t)(b * 128 + cx) * 128]; }
#pragma unroll
          for (int k = 0; k < 16; ++k) {
            const int cx = d == 0 ? k0 + k : 127 - (k0 + k);
            *(unsigned*)(SAg + (size_t)(b * 128 + cx) * SA_LD) = pg8::cvt_pk_bf16(hr, hi);
            const float nr = pr * hr - pi * hi + sv[k][0], ni = pr * hi + pi * hr + sv[k][1]; hr = nr; hi = ni;
          }
        }
      }
    }
  }
  xcd_barrier(xbar);

  {
    pg8::Gemm g{(const bf16_t*)WSP(WS_SA), (const bf16_t*)WSP(WS_BTY), 0, 0, 768, SA_LD, 768};
    GroupSched S; S.init(32, 2, 2, (long)SA_ROWS * SA_LD * 2, (long)256 * SA_LD * 2, (long)512 * 768 * 2, (long)256 * 768 * 2, (int)gridDim.x, (int)blockIdx.x);
    EpiY E{(bf16_t*)WSP(WS_YG)};
    pg8::gemm_phase<EpiY, GroupSched, true, true>((PG8_LAS unsigned char*)lds, g, S, E);
  }
  xcd_barrier(xbar);

  {
    pg8::Gemm g{(const bf16_t*)WSP(WS_YG), (const bf16_t*)WSP(WS_WGLU), MX, 512, 512, 512, 512};
    pg8::StaticOrder S; S.init(MX, 512, (int)gridDim.x, (int)blockIdx.x, g.lda, g.ldb);
    EpiBf8<0> E{(bf16_t*)WSP(WS_SSMX), 512, (const bf16_t*)WSP(WS_YG), 512, INP(24)};
    pg8::gemm_phase<EpiBf8<0>, pg8::StaticOrder, true, true>((PG8_LAS unsigned char*)lds, g, S, E);
  }

  {
    pg8::Gemm g{(const bf16_t*)WSP(WS_ATT), (const bf16_t*)WSP(WS_WAU), MX, 1024, 1024, 1024, 1024};
    pg8::StaticOrder S; S.init(MX, 1024, (int)gridDim.x, (int)blockIdx.x, g.lda, g.ldb);
    EpiBf8<1> E{(bf16_t*)WSP(WS_M), 1024, (const bf16_t*)WSP(WS_G), 2048, nullptr};
    pg8::gemm_phase<EpiBf8<1>, pg8::StaticOrder, true, true>((PG8_LAS unsigned char*)lds, g, S, E);
  }
  xcd_barrier(xbar);
  {
    pg8::Gemm g{(const bf16_t*)WSP(WS_SSMX), (const bf16_t*)WSP(WS_WSU), MX, 1024, 512, 512, 512};
    pg8::StaticOrder S; S.init(MX, 1024, (int)gridDim.x, (int)blockIdx.x, g.lda, g.ldb);
    EpiBf8<2> E{(bf16_t*)WSP(WS_M), 1024, (const bf16_t*)WSP(WS_G) + 1024, 2048, nullptr};
    pg8::gemm_phase<EpiBf8<2>, pg8::StaticOrder, true, true>((PG8_LAS unsigned char*)lds, g, S, E);
  }
  xcd_barrier(xbar);
  {
    pg8::Gemm g{(const bf16_t*)WSP(WS_M), (const bf16_t*)WSP(WS_WOUT), MX, 1024, 1024, 1024, 1024};
    pg8::StaticOrder S; S.init(MX, 1024, (int)gridDim.x, (int)blockIdx.x, g.lda, g.ldb);
    EpiF32<1> E{(float*)WSP(WS_X1), INP(0), (const float*)WSP(WS_MOD)};
    pg8::gemm_phase<EpiF32<1>, pg8::StaticOrder, true, true>((PG8_LAS unsigned char*)lds, g, S, E);
  }
  xcd_barrier(xbar);
  {
    PHASE_LOCALS
    const float* X1 = (const float*)WSP(WS_X1); const float* MOD = (const float*)WSP(WS_MOD); bf16_t* XN2 = (bf16_t*)WSP(WS_XN2); const float* norm2_g = INP(7);
    for (int row = gw; row < MX; row += ngw) {
      const float* src = X1 + (size_t)row * D; const float* md = MOD + (row / L) * 6144;
      f32x4 v[4]; float ss = 0.f;
#pragma unroll
      for (int j = 0; j < 4; ++j) { v[j] = *(const f32x4*)(src + lane * 4 + 256 * j); ss += v[j][0] * v[j][0] + v[j][1] * v[j][1] + v[j][2] * v[j][2] + v[j][3] * v[j][3]; }
      const float rstd = rsqrtf(wave_sum(ss) * (1.f / D) + 1e-6f);
#pragma unroll
      for (int j = 0; j < 4; ++j)
#pragma unroll
        for (int e = 0; e < 4; ++e) { const int col = lane * 4 + 256 * j + e; XN2[(size_t)row * D + col] = f2bf(v[j][e] * rstd * norm2_g[col] * (1.f + md[4096 + col]) + md[3072 + col]); }
    }
    slice_table_fp8(INP(30), (unsigned char*)WSP(WS_U8), 32.f, gtid, gsz);
    {
      const float* wq = INP(27); const float* sk1 = INP(28); const float* sk2 = INP(29); bf16_t* WC = (bf16_t*)WSP(WS_WC);
      float* skl = fl; float* wql = fl + 128 * 65;
      for (int tile = blockIdx.x; tile < 16 * 16; tile += gridDim.x) {
        const int hs = tile >> 4, d0 = (tile & 15) * 64, h = hs >> 1, s = hs & 1;
        __syncthreads();
        const float* skp = s ? sk2 : sk1;
        for (int i = tid; i < 128 * 16; i += NT) { const int k = i >> 4, e4 = (i & 15) * 4; const f32x4 v = *(const f32x4*)(skp + k * 64 + e4); skl[k * 65 + e4] = v[0]; skl[k * 65 + e4 + 1] = v[1]; skl[k * 65 + e4 + 2] = v[2]; skl[k * 65 + e4 + 3] = v[3]; }
        for (int i = tid; i < 64 * 16; i += NT) { const int dd = i >> 4, e4 = (i & 15) * 4; const f32x4 v = *(const f32x4*)(wq + (size_t)(d0 + dd) * 1024 + h * 128 + s * 64 + e4); wql[dd * 65 + e4] = v[0]; wql[dd * 65 + e4 + 1] = v[1]; wql[dd * 65 + e4 + 2] = v[2]; wql[dd * 65 + e4 + 3] = v[3]; }
        __syncthreads();
        const int k = tid & 127, dgp = tid >> 7;
        float a[16];
#pragma unroll
        for (int q = 0; q < 16; ++q) a[q] = 0.f;
        for (int e = 0; e < 64; ++e) {
          const float sv = skl[k * 65 + e];
#pragma unroll
          for (int q = 0; q < 16; ++q) a[q] += sv * wql[(dgp * 16 + q) * 65 + e];
        }
        u32x4 w0, w1;
        w0.x = pg8::cvt_pk_bf16(a[0], a[1]); w0.y = pg8::cvt_pk_bf16(a[2], a[3]); w0.z = pg8::cvt_pk_bf16(a[4], a[5]); w0.w = pg8::cvt_pk_bf16(a[6], a[7]);
        w1.x = pg8::cvt_pk_bf16(a[8], a[9]); w1.y = pg8::cvt_pk_bf16(a[10], a[11]); w1.z = pg8::cvt_pk_bf16(a[12], a[13]); w1.w = pg8::cvt_pk_bf16(a[14], a[15]);
        bf16_t* dst = WC + (size_t)(h * 256 + s * 128 + k) * 1024 + d0 + dgp * 16;
        *(u32x4*)dst = w0; *(u32x4*)(dst + 8) = w1;
      }
      __syncthreads();
    }
  }
  xcd_barrier(xbar);
  {
    pg8::Gemm g{(const bf16_t*)WSP(WS_XN2), (const bf16_t*)WSP(WS_WC), MX, 2048, 1024, 1024, 1024};
    EpiTopK E{(unsigned short*)WSP(WS_IDX), (float*)WSP(WS_GATE)};
    const int nrounds = (64 * 8 + (int)gridDim.x - 1) / (int)gridDim.x;
    for (int rd = 0; rd < nrounds; ++rd) {
      OneUnitSched S; S.nM = 64; S.nN = 8; S.G = (int)gridDim.x; S.c = (int)blockIdx.x; S.round = rd; S.tsA = (long)256 * 1024 * 2; S.tsB = (long)256 * 1024 * 2;
      pg8::gemm_phase<EpiTopK, OneUnitSched, false, true>((PG8_LAS unsigned char*)lds, g, S, E);
    }
  }
  xcd_barrier(xbar);
  {
    PHASE_LOCALS
    const bf16_t* XN2 = (const bf16_t*)WSP(WS_XN2); const unsigned short* EXT = (const unsigned short*)WSP(WS_IDX);
    bf16_t* PD = (bf16_t*)WSP(WS_PD);
    const bool sl = (gridDim.x & 7) == 0;
    const int widu = __builtin_amdgcn_readfirstlane(wid);
    const int j0 = sl ? (int)(blockIdx.x & 7) : 0, nj = sl ? 1 : 8;
    const int wk = sl ? (int)(blockIdx.x >> 3) * 8 + widu : (int)blockIdx.x * (NT / 64) + widu, nwk = sl ? (int)(gridDim.x >> 3) * 8 : ngw;
    const int eg = lane >> 3, li = lane & 7;
    for (int jj = 0; jj < nj; ++jj) {
      const int j = j0 + jj;
      const unsigned char* U8j = (const unsigned char*)WSP(WS_U8) + (size_t)j * 16384 * 128 + li * 16;
      for (int t = wk; t < MX; t += nwk) {
        const u32x4* xp = (const u32x4*)(XN2 + (size_t)t * 1024 + j * 128 + li * 16);
        const u32x4 xa = xp[0], xb = xp[1];
        const u32x4* ep = (const u32x4*)(EXT + (size_t)t * 128 + eg * 16);
        const u32x4 e0 = ep[0], e1 = ep[1];
        const unsigned ew[8] = {e0.x, e0.y, e0.z, e0.w, e1.x, e1.y, e1.z, e1.w};
        u32x4 uw[16];
#pragma unroll
        for (int k = 0; k < 16; ++k) { const unsigned ex = (k & 1) ? (ew[k >> 1] >> 16) : (ew[k >> 1] & 0xffffu); uw[k] = *(const u32x4*)(U8j + ex * 128u); }
        const unsigned xwd[8] = {xa.x, xa.y, xa.z, xa.w, xb.x, xb.y, xb.z, xb.w};
        f32x2_t xf[8];
#pragma unroll
        for (int q = 0; q < 8; ++q) xf[q] = (f32x2_t){bflo(xwd[q]), bfhi(xwd[q])};
        float keep_lo = 0.f, keep_hi = 0.f;
#pragma unroll
        for (int k = 0; k < 16; ++k) {
          const unsigned uu[4] = {uw[k].x, uw[k].y, uw[k].z, uw[k].w};
          f32x2_t s2 = {0.f, 0.f};
#pragma unroll
          for (int q = 0; q < 4; ++q) { s2 += __builtin_amdgcn_cvt_pk_f32_fp8((int)uu[q], false) * xf[2 * q]; s2 += __builtin_amdgcn_cvt_pk_f32_fp8((int)uu[q], true) * xf[2 * q + 1]; }
          float dp = s2.x + s2.y;
          dp = dpp_add<0xB1>(dp); dp = dpp_add<0x4E>(dp); dp = dpp_add<0x141>(dp);
          if (li == (k & 7)) { if (k < 8) keep_lo = dp; else keep_hi = dp; }
        }
        bf16_t* pd = PD + ((size_t)t * 128 + eg * 16 + li) * 8 + j;
        pd[0] = f2bf(keep_lo * (1.f / 32.f)); pd[8 * 8] = f2bf(keep_hi * (1.f / 32.f));
      }
    }
    slice_table_fp8(INP(31), (unsigned char*)WSP(WS_V8), 1.f, gtid, gsz);
  }
  xcd_barrier(xbar);
  {
    PHASE_LOCALS
    const bf16_t* PD = (const bf16_t*)WSP(WS_PD); const float* GATE = (const float*)WSP(WS_GATE); unsigned* CFP = (unsigned*)WSP(WS_CFP);
    for (int t = gw; t < MX; t += ngw) {
      const u32x4* pp = (const u32x4*)(PD + ((size_t)t * 128 + 2 * lane) * 8);
      const u32x4 pa = pp[0], pb = pp[1];
      const f32x2_t g2 = *(const f32x2_t*)(GATE + (size_t)t * 128 + 2 * lane);
      const float p0 = ((bflo(pa.x) + bfhi(pa.x)) + (bflo(pa.y) + bfhi(pa.y))) + ((bflo(pa.z) + bfhi(pa.z)) + (bflo(pa.w) + bfhi(pa.w)));
      const float p1 = ((bflo(pb.x) + bfhi(pb.x)) + (bflo(pb.y) + bfhi(pb.y))) + ((bflo(pb.z) + bfhi(pb.z)) + (bflo(pb.w) + bfhi(pb.w)));
      CFP[(size_t)t * 64 + lane] = pg8::cvt_pk_bf16(g2.x * gelu_tanh(p0), g2.y * gelu_tanh(p1));
    }
  }
  xcd_barrier(xbar);
  {
    PHASE_LOCALS
    const float* X1 = (const float*)WSP(WS_X1); const float* MOD = (const float*)WSP(WS_MOD);
    const unsigned short* EXT = (const unsigned short*)WSP(WS_IDX); const unsigned* CFP = (const unsigned*)WSP(WS_CFP);
    float* SSQ = (float*)WSP(WS_SSQ); float* out = GPTR(float, ldptr_(33));
    const bool sl = (gridDim.x & 7) == 0;
    const int widu = __builtin_amdgcn_readfirstlane(wid);
    const int j0 = sl ? (int)(blockIdx.x & 7) : 0, nj = sl ? 1 : 8;
    const int wk = sl ? (int)(blockIdx.x >> 3) * 8 + widu : (int)blockIdx.x * (NT / 64) + widu, nwk = sl ? (int)(gridDim.x >> 3) * 8 : ngw;
    const int eg = lane >> 3, li = lane & 7;
    float* red = fl + widu * 1024;
    for (int jj = 0; jj < nj; ++jj) {
      const int j = j0 + jj;
      const unsigned char* V8j = (const unsigned char*)WSP(WS_V8) + (size_t)j * 16384 * 128 + li * 16;
      for (int t = wk; t < MX; t += nwk) {
        const u32x4* ep = (const u32x4*)(EXT + (size_t)t * 128 + eg * 16);
        const u32x4 e0 = ep[0], e1 = ep[1];
        const u32x4* cp = (const u32x4*)(CFP + (size_t)t * 64 + eg * 8);
        const u32x4 c0 = cp[0], c1 = cp[1];
        const int col = j * 128 + 2 * lane;
        const f32x2_t xr = *(const f32x2_t*)(X1 + (size_t)t * 1024 + col);
        const f32x2_t gr = *(const f32x2_t*)(MOD + (t >> 12) * 6144 + 5120 + col);
        const unsigned ew[8] = {e0.x, e0.y, e0.z, e0.w, e1.x, e1.y, e1.z, e1.w};
        const unsigned cfp[8] = {c0.x, c0.y, c0.z, c0.w, c1.x, c1.y, c1.z, c1.w};
        u32x4 vw[16];
#pragma unroll
        for (int k = 0; k < 16; ++k) { const unsigned ex = (k & 1) ? (ew[k >> 1] >> 16) : (ew[k >> 1] & 0xffffu); vw[k] = *(const u32x4*)(V8j + ex * 128u); }
        f32x2_t a[8];
#pragma unroll
        for (int q = 0; q < 8; ++q) a[q] = (f32x2_t){0.f, 0.f};
#pragma unroll
        for (int k = 0; k < 16; ++k) {
          const unsigned cf2 = cfp[k >> 1]; const float cf = (k & 1) ? bfhi(cf2) : bflo(cf2);
          const unsigned vv[4] = {vw[k].x, vw[k].y, vw[k].z, vw[k].w};
#pragma unroll
          for (int q = 0; q < 4; ++q) { a[2 * q] += __builtin_amdgcn_cvt_pk_f32_fp8((int)vv[q], false) * cf; a[2 * q + 1] += __builtin_amdgcn_cvt_pk_f32_fp8((int)vv[q], true) * cf; }
        }
#pragma unroll
        for (int q = 0; q < 4; ++q) *(f32x4*)(red + eg * 128 + li * 16 + q * 4) = (f32x4){a[2 * q].x, a[2 * q].y, a[2 * q + 1].x, a[2 * q + 1].y};
        asm volatile("s_waitcnt lgkmcnt(0)" ::: "memory");
        f32x2_t acc = {0.f, 0.f};
#pragma unroll
        for (int g = 0; g < 8; ++g) acc += *(const f32x2_t*)(red + g * 128 + 2 * lane);
        asm volatile("s_waitcnt lgkmcnt(0)" ::: "memory");
        const f32x2_t o2 = xr + gr * acc;
        float ss = o2.x * o2.x + o2.y * o2.y;
        ss = wave_sum(ss);
        *(f32x2_t*)(out + (size_t)t * 1024 + col) = o2;
        if (lane == 0) SSQ[(size_t)t * 8 + j] = ss;
      }
    }
  }
  xcd_barrier(xbar);
  {
    PHASE_LOCALS
    const float* SSQ = (const float*)WSP(WS_SSQ); const float* fng = INP(32); float* out = GPTR(float, ldptr_(33));
    for (int row = gw; row < MX; row += ngw) {
      const f32x4 sa = *(const f32x4*)(SSQ + (size_t)row * 8), sb = *(const f32x4*)(SSQ + (size_t)row * 8 + 4);
      const float rstd = rsqrtf(((sa[0] + sa[1]) + (sa[2] + sa[3]) + (sb[0] + sb[1]) + (sb[2] + sb[3])) * (1.f / D) + 1e-6f);
#pragma unroll
      for (int jq = 0; jq < 4; ++jq) {
        float* op = out + (size_t)row * D + lane * 4 + 256 * jq;
        const f32x4 v = *(const f32x4*)op, g4 = *(const f32x4*)(fng + lane * 4 + 256 * jq);
        *(f32x4*)op = v * rstd * g4;
      }
    }
  }
}

extern "C" void kernel_launch(void* const* d_in, const int* in_sizes, int n_in, void* d_out, int out_size, void* d_ws, size_t ws_size, hipStream_t stream) {
  static int grid_blocks = 0;
  if (!grid_blocks) {
    int dev = 0, cus = 0, per_cu = 0;
    (void)hipGetDevice(&dev);
    (void)hipDeviceGetAttribute(&cus, hipDeviceAttributeMultiprocessorCount, dev);
    (void)hipFuncSetAttribute((const void*)mega, hipFuncAttributeMaxDynamicSharedMemorySize, LDS_BYTES);
    (void)hipOccupancyMaxActiveBlocksPerMultiprocessor(&per_cu, (const void*)mega, NT, LDS_BYTES);
    if (per_cu < 1) per_cu = 1;
    grid_blocks = cus * per_cu;
    if (n_in != 33 || ws_size < 255 * MiB) { fprintf(stderr, "kernel_launch: unexpected n_in %d / ws %zu\n", n_in, ws_size); }
  }
  Params p{};
  for (int i = 0; i < 33 && i < n_in; ++i) p.in[i] = (const float*)d_in[i];
  p.out = (float*)d_out; p.ws = (unsigned char*)d_ws;
  void* args[] = {&p};
  hipError_t e = hipLaunchCooperativeKernel((const void*)mega, dim3(grid_blocks), dim3(NT), args, LDS_BYTES, stream);
  if (e != hipSuccess) fprintf(stderr, "cooperative launch failed: %s (grid %d)\n", hipGetErrorString(e), grid_blocks);
}
```

```cpp
#include <hip/hip_runtime.h>
#include <hip/hip_cooperative_groups.h>
#include <cstdio>
#include <cstdint>
namespace cg = cooperative_groups;

typedef unsigned short bf16_t;
typedef float f32x4 __attribute__((ext_vector_type(4)));

constexpr int NT = 512;
constexpr int LDS_BYTES = 147456;
constexpr int Bn = 4, L = 4096, D = 1024, NCTX = 256, LA = L + NCTX;
constexpr int MX = Bn * L, MC = Bn * NCTX;
constexpr int N_IN = 5632;
constexpr size_t MiB = 1u << 20;
constexpr size_t WS_MOD = 0, WS_LAM = 128 * 1024, WS_ROPE = 136 * 1024, WS_ARDT = 144 * 1024, WS_AIDT = 160 * 1024;
constexpr size_t WS_ABRE = 192 * 1024, WS_ABIM = 224 * 1024, WS_BBRE = 256 * 1024, WS_BBIM = 512 * 1024;
constexpr size_t WS_BAR = 1 * MiB;
constexpr size_t WS_KT = 2 * MiB;
constexpr size_t WS_XN = 4 * MiB, WS_Q = 38 * MiB, WS_K = 70 * MiB, WS_V = 104 * MiB, WS_SA = 138 * MiB, WS_G = 164 * MiB;
constexpr size_t WS_WIN = 228 * MiB, WS_WAU = 239 * MiB, WS_WSU = 241 * MiB, WS_WOUT = 242 * MiB, WS_WQ = 244 * MiB, WS_WGLU = 246 * MiB;
constexpr size_t WS_BTS = 247 * MiB;
constexpr size_t WS_BTY = 38 * MiB, WS_S = 62 * MiB, WS_YG = 79 * MiB, WS_SSMX = 62 * MiB, WS_M = 95 * MiB;
constexpr size_t WS_ATT = WS_XN, WS_X1 = 4 * MiB, WS_XN2 = 68 * MiB, WS_QP = WS_G;
constexpr size_t WS_IDX = 111 * MiB, WS_GATE = 115 * MiB, WS_SSQ = 123 * MiB;
constexpr size_t WS_U8 = 127 * MiB, WS_PD = 164 * MiB, WS_V8 = 196 * MiB, WS_WC = 160 * MiB, WS_CFP = 160 * MiB;
constexpr int SA_ROWS = 544, SA_LD = 768;

constexpr int PTR_OFF = LDS_BYTES - 1024;
__device__ __forceinline__ unsigned long long ldptr_(int k) {
  extern __shared__ __attribute__((aligned(16))) unsigned char lds_[];
  const unsigned long long v = ((const unsigned long long*)(lds_ + PTR_OFF))[k];
  const unsigned lo = __builtin_amdgcn_readfirstlane((unsigned)v), hi = __builtin_amdgcn_readfirstlane((unsigned)(v >> 32));
  return ((unsigned long long)hi << 32) | lo;
}
#define GPTR(T, v) ((T*)(__attribute__((address_space(1))) T*)(v))
#define INP(k) GPTR(const float, ldptr_(k))
#define WSP(off) GPTR(unsigned char, ldptr_(34) + (off))
#define PHASE_LOCALS \
  int tid = threadIdx.x; asm volatile("" : "+v"(tid)); \
  const int lane = tid & 63, wid = tid >> 6; \
  const int gtid = blockIdx.x * NT + tid, gsz = gridDim.x * NT; \
  const int gw = blockIdx.x * (NT / 64) + wid, ngw = gridDim.x * (NT / 64); \
  float* fl = (float*)lds; (void)lane; (void)wid; (void)gtid; (void)gsz; (void)gw; (void)ngw; (void)fl;

struct Params {
  const float* in[33];
  float* out;
  unsigned char* ws;
  int pad0, pad1;
};

__device__ __forceinline__ float bf2f(bf16_t v) { return __uint_as_float(((unsigned)v) << 16); }
__device__ __forceinline__ bf16_t f2bf(float f) { unsigned u = __float_as_uint(f); return (bf16_t)((u + 0x7fffu + ((u >> 16) & 1u)) >> 16); }
__device__ __forceinline__ float wave_sum(float v) {
#pragma unroll
  for (int o = 32; o; o >>= 1) v += __shfl_xor(v, o);
  return v;
}
__device__ __forceinline__ float gelu_tanh(float x) { const float u2 = -2.302208198f * (x + 0.044715f * x * x * x); return x * __builtin_amdgcn_rcpf(1.f + __builtin_amdgcn_exp2f(u2)); }
__device__ __forceinline__ float sigmoidf_(float x) { return __builtin_amdgcn_rcpf(1.f + __builtin_amdgcn_exp2f(-1.4426950408889634f * x)); }
__device__ __forceinline__ float siluf_(float x) { return x / (1.f + __expf(-x)); }

template <class Epi>
__device__ __forceinline__ void sgemm(const bf16_t* A, int lda, const float* Bm, int ldb, int M, int N, int K, float* lds, Epi epi) {
  constexpr int TM = 128, TN = 128, TK = 16, LDA_S = TM + 4, LDB_S = TN + 4;
  float* As = lds;
  float* Bs = lds + TK * LDA_S;
  const int tid = threadIdx.x, ty = tid >> 4, tx = tid & 15;
  const int ntm = M / TM, ntn = N / TN;
  for (int tile = blockIdx.x; tile < ntm * ntn; tile += gridDim.x) {
    const int tm = tile / ntn, tn = tile % ntn;
    float acc[4][8];
#pragma unroll
    for (int i = 0; i < 4; ++i)
#pragma unroll
      for (int j = 0; j < 8; ++j) acc[i][j] = 0.f;
    const int ar = tid >> 2, ak = (tid & 3) * 4;
    const int bk = tid >> 5, bn = (tid & 31) * 4;
    for (int k0 = 0; k0 < K; k0 += TK) {
      const bf16_t* ap = A + (size_t)(tm * TM + ar) * lda + k0 + ak;
      const unsigned long long av = *(const unsigned long long*)ap;
      const f32x4 bv = *(const f32x4*)(Bm + (size_t)(k0 + bk) * ldb + tn * TN + bn);
      __syncthreads();
      As[(ak + 0) * LDA_S + ar] = bf2f((bf16_t)(av & 0xffff));
      As[(ak + 1) * LDA_S + ar] = bf2f((bf16_t)((av >> 16) & 0xffff));
      As[(ak + 2) * LDA_S + ar] = bf2f((bf16_t)((av >> 32) & 0xffff));
      As[(ak + 3) * LDA_S + ar] = bf2f((bf16_t)((av >> 48) & 0xffff));
      *(f32x4*)(Bs + bk * LDB_S + bn) = bv;
      __syncthreads();
#pragma unroll
      for (int k = 0; k < TK; ++k) {
        const f32x4 a4 = *(const f32x4*)(As + k * LDA_S + ty * 4);
        const f32x4 b0 = *(const f32x4*)(Bs + k * LDB_S + tx * 8);
        const f32x4 b1 = *(const f32x4*)(Bs + k * LDB_S + tx * 8 + 4);
#pragma unroll
        for (int i = 0; i < 4; ++i) {
          acc[i][0] += a4[i] * b0[0]; acc[i][1] += a4[i] * b0[1]; acc[i][2] += a4[i] * b0[2]; acc[i][3] += a4[i] * b0[3];
          acc[i][4] += a4[i] * b1[0]; acc[i][5] += a4[i] * b1[1]; acc[i][6] += a4[i] * b1[2]; acc[i][7] += a4[i] * b1[3];
        }
      }
    }
#pragma unroll
    for (int i = 0; i < 4; ++i)
#pragma unroll
      for (int j = 0; j < 8; ++j) epi(tm * TM + ty * 4 + i, tn * TN + tx * 8 + j, acc[i][j]);
  }
  __syncthreads();
}

namespace pg8 {
#define PG8_LAS __attribute__((address_space(3)))
typedef unsigned short bf16_t;
typedef short bf16x8 __attribute__((ext_vector_type(8)));
typedef float f32x4 __attribute__((ext_vector_type(4)));
typedef unsigned u32x4 __attribute__((ext_vector_type(4)));
constexpr int BM = 256, BK = 64, HALF = 128, HTB = HALF * BK * 2  , STAGE_BYTES = 8 * HTB, NXCD = 8, WGM = 8;

__host__ __device__ __forceinline__ int lds_byte(int r, int c) { const int st = (r >> 4) * 2 + (c >> 5), rr = r & 15, cc = c & 31, ob = rr * 64 + cc * 2; return st * 1024 + (ob ^ (((ob >> 9) & 1) << 5)); }
__host__ __device__ __forceinline__ void stage_rc(int b, int& R, int& C) { const int st = b / 1024, sb = b % 1024, swz = sb ^ (((sb >> 9) & 1) << 5); R = (st >> 1) * 16 + swz / 64; C = (st & 1) * 32 + (swz % 64) / 2; }
__host__ __device__ __forceinline__ int perm32(int rho) { const int n = rho >> 4, i = rho & 15; return 8 * (i >> 2) + 4 * n + (i & 3); }

struct Unit { int pm, pn, grp; long ao, bo; };
struct Gemm { const bf16_t* A; const bf16_t* Bt; int M, N, K, lda, ldb; };

struct StaticOrder {
    int nM, nN, nwg, G, c; long tsA, tsB;
    __host__ __device__ void init(int M, int N, int G_, int c_, int lda, int ldb) { nM = M / BM; nN = N / BM; nwg = nM * nN; G = G_; c = c_; tsA = (long)BM * lda * 2; tsB = (long)BM * ldb * 2; }
    __host__ __device__ bool next(int i, Unit& u) const {
        const long L = (long)i * G + c; if (L >= nwg) return false;
        int wgid = (int)L; { const int q = nwg / NXCD, r = nwg % NXCD, xcd = wgid % NXCD, off = wgid / NXCD; wgid = (xcd < r ? xcd * (q + 1) : r * (q + 1) + (xcd - r) * q) + off; }
        const int nig = WGM * nN, gid = wgid / nig, fm = gid * WGM, gsz = (nM - fm) < WGM ? (nM - fm) : WGM;
        u.pm = fm + ((wgid % nig) % gsz); u.pn = (wgid % nig) / gsz; u.grp = 0; u.ao = u.pm * tsA; u.bo = u.pn * tsB; return true;
    }
    __device__ __forceinline__ void a_ready(const Unit&) const {}
    __device__ __forceinline__ void done(const Unit&) const {}
};

__device__ __forceinline__ unsigned cvt_pk_bf16(float lo, float hi) { unsigned r; asm volatile("v_cvt_pk_bf16_f32 %0, %1, %2" : "=v"(r) : "v"(lo), "v"(hi)); return r; }
template <class Epi, class Sched, bool ALIGN_EPI = false, bool SP2 = false>
__device__ __forceinline__ void gemm_phase(PG8_LAS unsigned char* lds, const Gemm g, const Sched& S, const Epi& E) {
    int tid_ = threadIdx.x; asm volatile("" : "+v"(tid_));
    const int tid = tid_, wid = __builtin_amdgcn_readfirstlane(tid >> 6), lane = tid & 63, wr = wid >> 2, wc = wid & 3, fr = lane & 15, fq = lane >> 4;
    const int K = g.K, nt = K / BK;
    unsigned voffA[2], voffB[2];
#pragma unroll
    for (int i = 0; i < 2; ++i) { int R, C; stage_rc(tid * 16 + i * 8192, R, C); const int Rb = Epi::PERM ? ((R & ~31) + perm32(R & 31)) : R;
        voffA[i] = (unsigned)(R * g.lda + C) * 2u; voffB[i] = (unsigned)(Rb * g.ldb + C) * 2u; }
    const size_t kstep = (size_t)(BK * 2);
    const size_t hstepA = (size_t)HALF * g.lda * 2, hstepB = (size_t)HALF * g.ldb * 2;
    const unsigned ldsw = (unsigned)wid * 1024u;
    const int aoff = lds_byte(wr * 64 + fr, fq * 8), boff = lds_byte(wc * 32 + fr, fq * 8);
#define PG8_SA(b, h) (((b) * 2 + (h)) * HTB)
#define PG8_SB(b, h) ((4 + (b) * 2 + (h)) * HTB)
#define PG8_STAGE(bufoff, gbase, voff) do { _Pragma("unroll") for (int _i = 0; _i < 2; ++_i) \
        __builtin_amdgcn_global_load_lds((const unsigned*)((const char*)(gbase) + (voff)[_i]), (PG8_LAS unsigned*)(lds + (bufoff) + ldsw + _i * 8192), 16, 0, 0); } while (0)
#define PG8_LDA(dst, b, h) do { _Pragma("unroll") for (int m = 0; m < 4; ++m) _Pragma("unroll") for (int k = 0; k < 2; ++k) dst[m][k] = *(const PG8_LAS bf16x8*)(lds + PG8_SA(b, h) + aoff + m * 2048 + k * 1024); } while (0)
#define PG8_LDB(dst, b, h) do { _Pragma("unroll") for (int n = 0; n < 2; ++n) _Pragma("unroll") for (int k = 0; k < 2; ++k) dst[n][k] = *(const PG8_LAS bf16x8*)(lds + PG8_SB(b, h) + boff + n * 2048 + k * 1024); } while (0)
#define PG8_MMA(ai, bj, At, Bt) do { __builtin_amdgcn_s_setprio(1); _Pragma("unroll") for (int m = 0; m < 4; ++m) _Pragma("unroll") for (int n = 0; n < 2; ++n) _Pragma("unroll") for (int k = 0; k < 2; ++k) \
        acc[ai][bj][m][n] = __builtin_amdgcn_mfma_f32_16x16x32_bf16(Bt[n][k], At[m][k], acc[ai][bj][m][n], 0, 0, 0); __builtin_amdgcn_s_setprio(0); } while (0)
#define PG8_WAIT_V(n) asm volatile("s_waitcnt vmcnt(" #n ")" ::: "memory")
#define PG8_WAIT_L(n) asm volatile("s_waitcnt lgkmcnt(" #n ")" ::: "memory")
#define PG8_BAR __builtin_amdgcn_s_barrier()
#define PG8_SCHED __builtin_amdgcn_sched_barrier(0)
    Unit cur, nxt; int ui = 0;
    if (!S.next(0, cur)) return;
    f32x4 acc[2][2][4][2];
#pragma unroll
    for (int a = 0; a < 2; ++a)
#pragma unroll
        for (int b = 0; b < 2; ++b)
#pragma unroll
            for (int m = 0; m < 4; ++m)
#pragma unroll
                for (int n = 0; n < 2; ++n) acc[a][b][m][n] = (f32x4){0.f, 0.f, 0.f, 0.f};
    bf16x8 At[4][2], B0[2][2], B1[2][2];
    const char* cA = (const char*)g.A + cur.ao; const char* cB = (const char*)g.Bt + cur.bo;
    S.a_ready(cur);
    if constexpr (SP2) {
        PG8_STAGE(PG8_SB(0, 0), cB, voffB); PG8_STAGE(PG8_SB(0, 1), cB + hstepB, voffB); PG8_STAGE(PG8_SA(0, 0), cA, voffA); PG8_STAGE(PG8_SA(0, 1), cA + hstepA, voffA);
        if (wr == 1) PG8_BAR;
        PG8_WAIT_V(2); PG8_BAR;
        PG8_STAGE(PG8_SB(1, 0), cB + kstep, voffB); PG8_STAGE(PG8_SA(1, 0), cA + kstep, voffA); PG8_STAGE(PG8_SB(1, 1), cB + hstepB + kstep, voffB);
        PG8_WAIT_V(6); PG8_BAR;
    } else {
        PG8_STAGE(PG8_SB(0, 0), cB, voffB); PG8_STAGE(PG8_SA(0, 0), cA, voffA); PG8_STAGE(PG8_SB(0, 1), cB + hstepB, voffB); PG8_STAGE(PG8_SA(0, 1), cA + hstepA, voffA);
        if (wr == 1) PG8_BAR;
        PG8_WAIT_V(4); PG8_BAR;
        PG8_STAGE(PG8_SB(1, 0), cB + kstep, voffB); PG8_STAGE(PG8_SA(1, 0), cA + kstep, voffA); PG8_STAGE(PG8_SB(1, 1), cB + hstepB + kstep, voffB);
        PG8_WAIT_V(6); PG8_BAR;
    }
    for (;;) {
        const bool has_next = S.next(ui + 1, nxt);
        const char* nA = has_next ? (const char*)g.A + nxt.ao : cA; const char* nB = has_next ? (const char*)g.Bt + nxt.bo : cB;
        for (int t = 0; t < nt; t += 2) {
            const bool last = (t == nt - 2);
            const char* a1 = cA + (size_t)(t + 1) * kstep;
            const char* a2 = last ? nA : cA + (size_t)(t + 2) * kstep; const char* b2 = last ? nB : cB + (size_t)(t + 2) * kstep;
            const char* a3 = a2 + kstep; const char* b3 = b2 + kstep;
            if (last && has_next) S.a_ready(nxt);
            if constexpr (SP2) {
            PG8_LDB(B0, 0, 0); PG8_LDB(B1, 0, 1); PG8_SCHED; PG8_LDA(At, 0, 0); PG8_STAGE(PG8_SA(1, 1), a1 + hstepA, voffA);
            PG8_WAIT_V(8); PG8_WAIT_L(0); PG8_BAR; PG8_MMA(0, 0, At, B0); PG8_MMA(0, 1, At, B1); PG8_BAR; PG8_SCHED;
            PG8_LDA(At, 0, 1); PG8_STAGE(PG8_SB(0, 0), b2, voffB); PG8_STAGE(PG8_SB(0, 1), b2 + hstepB, voffB); PG8_STAGE(PG8_SA(0, 0), a2, voffA);
            PG8_WAIT_V(8); PG8_WAIT_L(0); PG8_BAR; PG8_MMA(1, 0, At, B0); PG8_MMA(1, 1, At, B1); PG8_BAR; PG8_SCHED;
            PG8_LDB(B0, 1, 0); PG8_LDB(B1, 1, 1); PG8_SCHED; PG8_LDA(At, 1, 0); PG8_STAGE(PG8_SA(0, 1), a2 + hstepA, voffA);
            PG8_WAIT_V(8); PG8_WAIT_L(0); PG8_BAR; PG8_MMA(0, 0, At, B0); PG8_MMA(0, 1, At, B1); PG8_BAR; PG8_SCHED;
            PG8_LDA(At, 1, 1); PG8_STAGE(PG8_SB(1, 0), b3, voffB); PG8_STAGE(PG8_SB(1, 1), b3 + hstepB, voffB); PG8_STAGE(PG8_SA(1, 0), a3, voffA);
            PG8_WAIT_V(8); PG8_WAIT_L(0); PG8_BAR; PG8_MMA(1, 0, At, B0); PG8_MMA(1, 1, At, B1); PG8_BAR; PG8_SCHED;
            } else {
            PG8_LDB(B0, 0, 0); PG8_SCHED; PG8_LDA(At, 0, 0); PG8_STAGE(PG8_SA(1, 1), a1 + hstepA, voffA);
            PG8_WAIT_L(8); PG8_BAR; PG8_WAIT_L(0); PG8_MMA(0, 0, At, B0); PG8_BAR; PG8_SCHED;
            PG8_LDB(B1, 0, 1); PG8_STAGE(PG8_SB(0, 0), b2, voffB);
            PG8_BAR; PG8_WAIT_L(0); PG8_MMA(0, 1, At, B1); PG8_BAR;
            PG8_LDA(At, 0, 1); PG8_STAGE(PG8_SA(0, 0), a2, voffA);
            PG8_BAR; PG8_WAIT_L(0); PG8_MMA(1, 0, At, B0); PG8_BAR; PG8_SCHED;
            PG8_STAGE(PG8_SB(0, 1), b2 + hstepB, voffB);
            PG8_WAIT_V(6); PG8_BAR; PG8_MMA(1, 1, At, B1); PG8_BAR;
            PG8_LDB(B0, 1, 0); PG8_SCHED; PG8_LDA(At, 1, 0); PG8_STAGE(PG8_SA(0, 1), a2 + hstepA, voffA);
            PG8_WAIT_L(8); PG8_BAR; PG8_WAIT_L(0); PG8_MMA(0, 0, At, B0); PG8_BAR; PG8_SCHED;
            PG8_LDB(B1, 1, 1); PG8_STAGE(PG8_SB(1, 0), b3, voffB);
            PG8_BAR; PG8_WAIT_L(0); PG8_MMA(0, 1, At, B1); PG8_BAR;
            PG8_LDA(At, 1, 1); PG8_STAGE(PG8_SA(1, 0), a3, voffA);
            PG8_BAR; PG8_WAIT_L(0); PG8_MMA(1, 0, At, B0); PG8_BAR; PG8_SCHED;
            PG8_STAGE(PG8_SB(1, 1), b3 + hstepB, voffB);
            PG8_WAIT_V(6); PG8_BAR; PG8_MMA(1, 1, At, B1); PG8_BAR;
            }
        }
        if constexpr (ALIGN_EPI) { if (wr == 0) PG8_BAR; }
        if constexpr (!Epi::AFTER_DRAIN) { int fr_ = fr, fq_ = fq; asm volatile("" : "+v"(fr_), "+v"(fq_));
            E(acc, cur, wr, wc, fr_, fq_); S.done(cur); }
        if (!has_next) break;
#pragma unroll
        for (int a = 0; a < 2; ++a)
#pragma unroll
            for (int b = 0; b < 2; ++b)
#pragma unroll
                for (int m = 0; m < 4; ++m)
#pragma unroll
                    for (int n = 0; n < 2; ++n) acc[a][b][m][n] = (f32x4){0.f, 0.f, 0.f, 0.f};
        cur = nxt; cA = nA; cB = nB; ++ui;
        if constexpr (ALIGN_EPI) { if (wr == 1) PG8_BAR; }
    }
    PG8_WAIT_V(0);
    if constexpr (!ALIGN_EPI) { if (wr == 0) PG8_BAR; }
    PG8_BAR;
    if constexpr (Epi::AFTER_DRAIN) { int fr_ = fr, fq_ = fq, lane_ = lane; asm volatile("" : "+v"(fr_), "+v"(fq_), "+v"(lane_)); E.fused(acc, cur, wr, wc, fr_, fq_, lds, wid, lane_); S.done(cur); }
#undef PG8_SA
#undef PG8_SB
#undef PG8_STAGE
#undef PG8_LDA
#undef PG8_LDB
#undef PG8_MMA
#undef PG8_WAIT_V
#undef PG8_WAIT_L
#undef PG8_BAR
#undef PG8_SCHED
}
}


using pg8::Unit;
typedef unsigned u32x2 __attribute__((ext_vector_type(2)));
typedef unsigned u32x4 __attribute__((ext_vector_type(4)));
__device__ __forceinline__ float bflo(unsigned w) { return __uint_as_float(w << 16); }
__device__ __forceinline__ float bfhi(unsigned w) { return __uint_as_float(w & 0xffff0000u); }

struct InProjSched {
  pg8::StaticOrder so;
  __device__ __forceinline__ void init(int G, int c) { so.init(MX, N_IN, G, c, D, D); }
  __device__ __forceinline__ bool next(int i, Unit& u) const {
    const long Lx = (long)i * so.G + so.c;
    if (Lx < so.nwg) return so.next(i, u);
    const int j = (int)(Lx - so.nwg); if (j >= 40) return false;
    u.pm = 64 + (j & 3); u.pn = 4 + (j >> 2); u.grp = 0; u.ao = u.pm * so.tsA; u.bo = u.pn * so.tsB; return true;
  }
  __device__ __forceinline__ void a_ready(const Unit&) const {}
  __device__ __forceinline__ void done(const Unit&) const {}
};

struct EpiInProj {
  static constexpr bool PERM = false, AFTER_DRAIN = false;
  bf16_t *Q, *K, *V, *SA, *G; const float* rope;
  __device__ __forceinline__ static void st4(bf16_t* p, const f32x4 v) { u32x2 w; w.x = pg8::cvt_pk_bf16(v[0], v[1]); w.y = pg8::cvt_pk_bf16(v[2], v[3]); *(u32x2*)p = w; }
  __device__ __forceinline__ void operator()(const f32x4 (&acc)[2][2][4][2], const Unit& u, int wr, int wc, int fr, int fq) const {
    const int row0 = u.pm * 256 + wr * 64 + fr;
    const int cg0 = u.pn * 256 + wc * 32 + fq * 4;
    if (u.pm < 64) {
      if (u.pn < 8) {
        const bool isq = u.pn < 4; const float qsc = isq ? 0.125f * 1.4426950408889634f : 1.f;
#pragma unroll
        for (int ai = 0; ai < 2; ++ai)
#pragma unroll
          for (int m = 0; m < 4; ++m) {
            const int row = row0 + ai * 128 + m * 16, b = row >> 12, t = row & 4095;
            const int pos = (wc & 1) ? (t & 63) : (t >> 6);
            const f32x4* rp = (const f32x4*)(rope + (pos * 16 + fq * 4) * 2);
            const f32x4 r0 = rp[0], r1 = rp[1];
            const f32x4 cs = {r0[0], r0[2], r1[0], r1[2]}, sn = {r0[1], r0[3], r1[1], r1[3]};
            bf16_t* dst = isq ? Q + (size_t)row * 1024 + cg0 : K + ((size_t)b * LA + NCTX + t) * 1024 + (cg0 - 1024);
#pragma unroll
            for (int bj = 0; bj < 2; ++bj) {
              const f32x4 h1 = acc[ai][bj][m][0], h2 = acc[ai][bj][m][1];
              st4(dst + bj * 128, (h1 * cs - h2 * sn) * qsc);
              st4(dst + bj * 128 + 16, (h2 * cs + h1 * sn) * qsc);
            }
          }
      } else {
#pragma unroll
        for (int ai = 0; ai < 2; ++ai)
#pragma unroll
          for (int m = 0; m < 4; ++m) {
            const int row = row0 + ai * 128 + m * 16, b = row >> 12, t = row & 4095;
            const size_t kr = (size_t)b * LA + NCTX + t;
            if (u.pn >= 12 && u.pn < 14) {
#pragma unroll
              for (int bj = 0; bj < 2; ++bj)
#pragma unroll
                for (int n = 0; n < 2; ++n) {
                  const int ch = cg0 + bj * 128 + n * 16 - 3072;
                  st4(SA + ((size_t)(ch >> 4) * SA_ROWS + b * 128 + (t >> 5)) * SA_LD + (t & 31) * 16 + (ch & 15), acc[ai][bj][m][n]);
                }
            } else {
              bf16_t* dst = u.pn < 12 ? V + kr * 1024 + (cg0 - 2048) : G + (size_t)row * 2048 + (cg0 - 3584);
#pragma unroll
              for (int bj = 0; bj < 2; ++bj)
#pragma unroll
                for (int n = 0; n < 2; ++n) {
                  f32x4 v = acc[ai][bj][m][n];
                  if (u.pn >= 14) { v[0] = sigmoidf_(v[0]); v[1] = sigmoidf_(v[1]); v[2] = sigmoidf_(v[2]); v[3] = sigmoidf_(v[3]); }
                  st4(dst + bj * 128 + n * 16, v);
                }
            }
          }
      }
    } else {
#pragma unroll
      for (int ai = 0; ai < 2; ++ai)
#pragma unroll
        for (int m = 0; m < 4; ++m) {
          const int rc = row0 + ai * 128 + m * 16 - MX, b = rc >> 8, t = rc & 255;
          const size_t kr = (size_t)b * LA + t;
          if (u.pn >= 12) {
#pragma unroll
            for (int bj = 0; bj < 2; ++bj)
#pragma unroll
              for (int n = 0; n < 2; ++n) {
                const int ch = cg0 + bj * 128 + n * 16 - 3072;
                st4(SA + ((size_t)(ch >> 4) * SA_ROWS + 512 + b * 8 + (t >> 5)) * SA_LD + (t & 31) * 16 + (ch & 15), acc[ai][bj][m][n]);
              }
          } else {
            bf16_t* dst = u.pn < 8 ? K + kr * 1024 + (cg0 - 1024) : V + kr * 1024 + (cg0 - 2048);
#pragma unroll
            for (int bj = 0; bj < 2; ++bj)
#pragma unroll
              for (int n = 0; n < 2; ++n) st4(dst + bj * 128 + n * 16, acc[ai][bj][m][n]);
          }
        }
    }
  }
};
template <int MODE>
struct EpiBf8 {
  static constexpr bool PERM = true, AFTER_DRAIN = false;
  bf16_t* O; int ldo; const bf16_t* X; int ldx; const float* bias;
  __device__ __forceinline__ void operator()(const f32x4 (&acc)[2][2][4][2], const Unit& u, int wr, int wc, int fr, int fq) const {
    const int row0 = u.pm * 256 + wr * 64 + fr, col0 = u.pn * 256 + wc * 32 + 8 * fq;
#pragma unroll
    for (int ai = 0; ai < 2; ++ai)
#pragma unroll
      for (int m = 0; m < 4; ++m) {
        const int row = row0 + ai * 128 + m * 16;
#pragma unroll
        for (int bj = 0; bj < 2; ++bj) {
          const int col = col0 + bj * 128;
          f32x4 v0 = acc[ai][bj][m][0], v1 = acc[ai][bj][m][1];
          const u32x4 xw = *(const u32x4*)(X + (size_t)row * ldx + col);
          const f32x4 x0 = {bflo(xw.x), bfhi(xw.x), bflo(xw.y), bfhi(xw.y)}, x1 = {bflo(xw.z), bfhi(xw.z), bflo(xw.w), bfhi(xw.w)};
          if (MODE == 0) {
            const f32x4 b0 = *(const f32x4*)(bias + col), b1 = *(const f32x4*)(bias + col + 4);
#pragma unroll
            for (int i = 0; i < 4; ++i) { v0[i] = x0[i] * sigmoidf_(v0[i] + b0[i]); v1[i] = x1[i] * sigmoidf_(v1[i] + b1[i]); }
          } else if (MODE == 1) { v0 = v0 * x0; v1 = v1 * x1; }
          else {
            const u32x4 ow = *(const u32x4*)(O + (size_t)row * ldo + col);
            const f32x4 o0 = {bflo(ow.x), bfhi(ow.x), bflo(ow.y), bfhi(ow.y)}, o1 = {bflo(ow.z), bfhi(ow.z), bflo(ow.w), bfhi(ow.w)};
            v0 = o0 + v0 * x0; v1 = o1 + v1 * x1;
          }
          u32x4 w; w.x = pg8::cvt_pk_bf16(v0[0], v0[1]); w.y = pg8::cvt_pk_bf16(v0[2], v0[3]); w.z = pg8::cvt_pk_bf16(v1[0], v1[1]); w.w = pg8::cvt_pk_bf16(v1[2], v1[3]);
          *(u32x4*)(O + (size_t)row * ldo + col) = w;
        }
      }
  }
};
template <int MODE>
struct EpiF32 {
  static constexpr bool PERM = false, AFTER_DRAIN = false;
  float* O; const float* xres; const float* mod;
  __device__ __forceinline__ void operator()(const f32x4 (&acc)[2][2][4][2], const Unit& u, int wr, int wc, int fr, int fq) const {
    const int row0 = u.pm * 256 + wr * 64 + fr, col0 = u.pn * 256 + wc * 32 + 4 * fq;
#pragma unroll
    for (int ai = 0; ai < 2; ++ai)
#pragma unroll
      for (int m = 0; m < 4; ++m) {
        const int row = row0 + ai * 128 + m * 16;
#pragma unroll
        for (int bj = 0; bj < 2; ++bj)
#pragma unroll
          for (int n = 0; n < 2; ++n) {
            const int col = col0 + bj * 128 + n * 16;
            f32x4 v = acc[ai][bj][m][n];
            if (MODE == 1) { const f32x4 xr = *(const f32x4*)(xres + (size_t)row * 1024 + col); const f32x4 g = *(const f32x4*)(mod + (row >> 12) * 6144 + 2048 + col); v = xr + g * v; }
            *(f32x4*)(O + (size_t)row * 1024 + col) = v;
          }
      }
  }
};


struct GroupSched {
  int npm, npn, nunits, G, c; long gsA, gsB, tsA, tsB;
  __device__ __forceinline__ void init(int ngrp, int npm_, int npn_, long gsA_, long tsA_, long gsB_, long tsB_, int G_, int c_) { npm = npm_; npn = npn_; nunits = ngrp * npm_ * npn_; gsA = gsA_; tsA = tsA_; gsB = gsB_; tsB = tsB_; G = G_; c = c_; }
  __device__ __forceinline__ bool next(int i, Unit& u) const {
    const long Lx = (long)i * G + c; if (Lx >= nunits) return false;
    const int per = npm * npn, grp = (int)Lx / per, r = (int)Lx % per;
    u.grp = grp; u.pm = r / npn; u.pn = r % npn; u.ao = grp * gsA + u.pm * tsA; u.bo = grp * gsB + u.pn * tsB; return true;
  }
  __device__ __forceinline__ void a_ready(const Unit&) const {}
  __device__ __forceinline__ void done(const Unit&) const {}
};
struct EpiS {
  static constexpr bool PERM = false, AFTER_DRAIN = false;
  float* S;
  __device__ __forceinline__ void operator()(const f32x4 (&acc)[2][2][4][2], const Unit& u, int wr, int wc, int fr, int fq) const {
    const int row0 = u.pm * 256 + wr * 64 + fr, col0 = wc * 32 + 4 * fq;
#pragma unroll
    for (int ai = 0; ai < 2; ++ai)
#pragma unroll
      for (int m = 0; m < 4; ++m) {
        const int row = row0 + ai * 128 + m * 16;
        if (row < SA_ROWS) {
#pragma unroll
          for (int bj = 0; bj < 2; ++bj)
#pragma unroll
            for (int n = 0; n < 2; ++n) *(f32x4*)(S + ((size_t)u.grp * SA_ROWS + row) * 256 + col0 + bj * 128 + n * 16) = acc[ai][bj][m][n];
        }
      }
  }
};
struct EpiY {
  static constexpr bool PERM = true, AFTER_DRAIN = false;
  bf16_t* YG;
  __device__ __forceinline__ void operator()(const f32x4 (&acc)[2][2][4][2], const Unit& u, int wr, int wc, int fr, int fq) const {
    const int row0 = u.pm * 256 + wr * 64 + fr, col0 = u.pn * 256 + wc * 32 + 8 * fq;
#pragma unroll
    for (int ai = 0; ai < 2; ++ai)
#pragma unroll
      for (int m = 0; m < 4; ++m) {
        const int row = row0 + ai * 128 + m * 16, b = row >> 7, cx = row & 127;
#pragma unroll
        for (int bj = 0; bj < 2; ++bj) {
          const int col = col0 + bj * 128, j = col >> 4, p0 = col & 15;
          const f32x4 v0 = acc[ai][bj][m][0], v1 = acc[ai][bj][m][1];
          u32x4 w; w.x = pg8::cvt_pk_bf16(gelu_tanh(v0[0]), gelu_tanh(v0[1])); w.y = pg8::cvt_pk_bf16(gelu_tanh(v0[2]), gelu_tanh(v0[3]));
          w.z = pg8::cvt_pk_bf16(gelu_tanh(v1[0]), gelu_tanh(v1[1])); w.w = pg8::cvt_pk_bf16(gelu_tanh(v1[2]), gelu_tanh(v1[3]));
          *(u32x4*)(YG + ((size_t)(b * L + cx * 32 + j)) * 512 + u.grp * 16 + p0) = w;
        }
      }
  }
};


__device__ __forceinline__ unsigned f2key(float s) { const unsigned u = __float_as_uint(s); return u ^ ((u & 0x80000000u) ? 0xFFFFFFFFu : 0x80000000u); }
__device__ __forceinline__ float key2f(unsigned k) { return __uint_as_float(k ^ ((k & 0x80000000u) ? 0x80000000u : 0xFFFFFFFFu)); }
#define TK_INSERT(L, cv) do { _Pragma("unroll") for (int k_ = 0; k_ < 16; ++k_) { const unsigned hi_ = L[k_] > cv ? L[k_] : cv, lo_ = L[k_] > cv ? cv : L[k_]; L[k_] = hi_; cv = lo_; } } while (0)
struct EpiTopK {
  static constexpr bool PERM = false, AFTER_DRAIN = true;
  unsigned short* IDX; float* GATE;
  __device__ __forceinline__ void fused(f32x4 (&acc)[2][2][4][2], const Unit& u, int wr, int wc, int fr, int fq, PG8_LAS unsigned char* lds, int wid, int lane) const {
    PG8_LAS float* SC = (PG8_LAS float*)lds;
    const int tid = wid * 64 + lane;
#pragma unroll
    for (int ai = 0; ai < 2; ++ai) {
#pragma unroll
      for (int m = 0; m < 4; ++m)
#pragma unroll
        for (int bj = 0; bj < 2; ++bj)
#pragma unroll
          for (int n = 0; n < 2; ++n)
#pragma unroll
            for (int i = 0; i < 4; ++i) SC[(64 * wr + 16 * m + fr) * 257 + 128 * bj + 32 * wc + 16 * n + 4 * fq + i] = acc[ai][bj][m][n][i];
      asm volatile("s_waitcnt lgkmcnt(0)" ::: "memory"); __builtin_amdgcn_s_barrier(); asm volatile("" ::: "memory");
      if (tid < 256) {
        PG8_LAS float* rowp = SC + (tid & 127) * 257 + (tid >> 7) * 128;
        unsigned Lk[16];
#pragma unroll
        for (int k = 0; k < 16; ++k) Lk[k] = 0u;
        for (int k = 0; k < 128; ++k) { unsigned cv = (f2key(rowp[k]) & ~0x7Fu) | (unsigned)(127 - k); TK_INSERT(Lk, cv); }
#pragma unroll
        for (int k = 0; k < 16; ++k) rowp[k] = __uint_as_float(Lk[k]);
      }
      asm volatile("s_waitcnt lgkmcnt(0)" ::: "memory"); __builtin_amdgcn_s_barrier(); asm volatile("" ::: "memory");
      if (tid < 128) {
        PG8_LAS float* rowp = SC + tid * 257;
        float v1[16], v2[16];
#pragma unroll
        for (int k = 0; k < 16; ++k) { v1[k] = key2f(__float_as_uint(rowp[k]) & ~0x7Fu); v2[k] = key2f(__float_as_uint(rowp[128 + k]) & ~0x7Fu); }
        unsigned Lc[16];
#pragma unroll
        for (int k = 0; k < 16; ++k) Lc[k] = 0u;
#pragma unroll
        for (int a = 0; a < 16; ++a)
#pragma unroll
          for (int b = 0; b < 16; ++b)
            if ((a + 1) * (b + 1) <= 16) { unsigned cv = (f2key(v1[a] + v2[b]) & ~0xFFu) | (unsigned)(255 - (a * 16 + b)); TK_INSERT(Lc, cv); }
        float ev[16]; float den = 0.f; const float mx = key2f(Lc[0] & ~0xFFu);
#pragma unroll
        for (int k = 0; k < 16; ++k) { ev[k] = __expf(key2f(Lc[k] & ~0xFFu) - mx); den += ev[k]; }
        const float inv = 1.f / den;
        const size_t o = ((size_t)(u.pm * 256 + ai * 128 + tid) * 8 + u.pn) * 16;
        unsigned iw[8];
#pragma unroll
        for (int k = 0; k < 16; ++k) {
          const int code = 255 - (int)(Lc[k] & 0xFFu), a = code >> 4, b = code & 15;
          const unsigned e1 = 127u - (__float_as_uint(rowp[a]) & 0x7Fu), e2 = 127u - (__float_as_uint(rowp[128 + b]) & 0x7Fu);
          const unsigned ex = e1 * 128u + e2;
          if (k & 1) iw[k >> 1] |= ex << 16; else iw[k >> 1] = ex;
        }
        *(u32x4*)(IDX + o) = (u32x4){iw[0], iw[1], iw[2], iw[3]}; *(u32x4*)(IDX + o + 8) = (u32x4){iw[4], iw[5], iw[6], iw[7]};
#pragma unroll
        for (int k = 0; k < 16; k += 4) *(f32x4*)(GATE + o + k) = (f32x4){ev[k] * inv, ev[k + 1] * inv, ev[k + 2] * inv, ev[k + 3] * inv};
      }
      asm volatile("s_waitcnt lgkmcnt(0)" ::: "memory"); __builtin_amdgcn_s_barrier(); asm volatile("" ::: "memory");
    }
  }
};
struct OneUnitSched {
  int nM, nN, G, c, round; long tsA, tsB;
  __device__ __forceinline__ bool next(int i, Unit& u) const {
    if (i > 0) return false;
    const long Lx = (long)round * G + c; if (Lx >= (long)nM * nN) return false;
    u.pm = (int)(Lx % nM); u.pn = (int)(Lx / nM); u.grp = 0; u.ao = u.pm * tsA; u.bo = u.pn * tsB; return true;
  }
  __device__ __forceinline__ void a_ready(const Unit&) const {}
  __device__ __forceinline__ void done(const Unit&) const {}
};

__device__ __forceinline__ void transpose_item(const float* W, int K, int N, bf16_t* WT, float* scr, int item, int lane) {
  const int nblk = N / 32, kb = item / nblk, nb = item % nblk, k0 = 64 * kb, n0 = 32 * nb;
#pragma unroll 8
  for (int i = 0; i < 32; ++i) { const int kk = 2 * i + (lane >> 5); scr[kk * 33 + (lane & 31)] = W[(size_t)(k0 + kk) * N + n0 + (lane & 31)]; }
  asm volatile("s_waitcnt lgkmcnt(0)" ::: "memory");
  const int c = lane & 7;
#pragma unroll
  for (int j = 0; j < 4; ++j) {
    const int n = (lane >> 3) + 8 * j; const float* s = scr + (8 * c) * 33 + n;
    u32x4 o; o.x = pg8::cvt_pk_bf16(s[0], s[33]); o.y = pg8::cvt_pk_bf16(s[66], s[99]); o.z = pg8::cvt_pk_bf16(s[132], s[165]); o.w = pg8::cvt_pk_bf16(s[198], s[231]);
    *(u32x4*)(WT + (size_t)(n0 + n) * K + k0 + 8 * c) = o;
  }
  asm volatile("s_waitcnt lgkmcnt(0)" ::: "memory");
}

namespace att {
using bf16 = unsigned short;
constexpr int   D = 128, NW = 8, QBLK = 32, KVBLK = 64, SDEPTH = 1;
constexpr float SCALE = 0.125f;
constexpr float THR = 8.f;
constexpr int LDQ = 1024, LDK = 1024, LDO = 1024;
constexpr size_t SHM_V = KVBLK * D * 2, SHM_K = KVBLK * D * 2, SHM_ATTN = 2 * SHM_V + 2 * SHM_K + NW * 64 * 4 + 4 * 4 * 16 * 64 * 4;
using bf16x8 = __attribute__((ext_vector_type(8))) short;
using s16x4  = __attribute__((ext_vector_type(4))) short;
using f32x16 = __attribute__((ext_vector_type(16))) float;
using f32x8  = __attribute__((ext_vector_type(8))) float;
using u32x4  = __attribute__((ext_vector_type(4))) unsigned;
#define KSWZ(row, colB) ((row) * 256 + ((colB) ^ (((row) & 7) << 4)))
#define SBAR() __builtin_amdgcn_sched_barrier(0)
__device__ __forceinline__ int crow(int r, int hi) { return (r & 3) + 8 * (r >> 2) + 4 * hi; }
__device__ __forceinline__ unsigned cvtpk(float lo, float hi) {
  unsigned r; asm volatile("v_cvt_pk_bf16_f32 %0, %1, %2" : "=v"(r) : "v"(lo), "v"(hi)); return r;
}
template <typename TIn> struct Stage;
template <> struct Stage<bf16>  { using T = bf16x8;
  __device__ static __forceinline__ T ld8(const bf16* p) { return *(const __attribute__((address_space(1))) bf16x8*)(p); }
  __device__ static __forceinline__ bf16x8 tobf(T x) { return x; } };
constexpr float THR2 = 11.5f;
template <bool FIRST>
__device__ __forceinline__ void partialSM(f32x16& p0, f32x16& p1, float& mhat, f32x16& negm, float& alpha) {
  float pmax = p0[0]; for (int r = 1; r < 16; ++r) pmax = fmaxf(pmax, p0[r]); for (int r = 0; r < 16; ++r) pmax = fmaxf(pmax, p1[r]);
  { auto rr = __builtin_amdgcn_permlane32_swap(__float_as_uint(pmax), __float_as_uint(pmax), false, false);
    pmax = fmaxf(__uint_as_float(rr[0]), __uint_as_float(rr[1])); }
  alpha = 1.f;
  if (FIRST || !__builtin_expect(__all(pmax <= THR2), 1)) {
    const float dl = FIRST ? pmax : fmaxf(pmax, 0.f);
    mhat += dl;
    for (int r = 0; r < 16; ++r) { p0[r] -= dl; p1[r] -= dl; }
    for (int r = 0; r < 16; ++r) negm[r] = -mhat;
    if (!FIRST) alpha = __builtin_amdgcn_exp2f(-dl);
  }
  for (int r = 0; r < 16; ++r) p0[r] = __builtin_amdgcn_exp2f(p0[r]);
}
__device__ __forceinline__ void finishSM(f32x16& p0, f32x16& p1, float alpha, float& l_reg, bf16x8& pa0, bf16x8& pa1, bf16x8& pa2, bf16x8& pa3) {
  for (int r = 0; r < 16; ++r) p1[r] = __builtin_amdgcn_exp2f(p1[r]);
  float ps = 0; for (int r = 0; r < 16; ++r) ps += p0[r]; for (int r = 0; r < 16; ++r) ps += p1[r];
  { auto rr = __builtin_amdgcn_permlane32_swap(__float_as_uint(ps), __float_as_uint(ps), false, false);
    ps = __uint_as_float(rr[0]) + __uint_as_float(rr[1]); }
  l_reg = l_reg * alpha + ps;
#define PK4(P, BASE, OUT) do { unsigned a0 = cvtpk(P[BASE + 0], P[BASE + 1]), a1 = cvtpk(P[BASE + 2], P[BASE + 3]);   \
    unsigned b0 = cvtpk(P[BASE + 4], P[BASE + 5]), b1 = cvtpk(P[BASE + 6], P[BASE + 7]);                              \
    auto r0 = __builtin_amdgcn_permlane32_swap(a0, b0, false, false); auto r1 = __builtin_amdgcn_permlane32_swap(a1, b1, false, false); \
    u32x4 w = {r0[0], r1[0], r0[1], r1[1]}; OUT = *reinterpret_cast<bf16x8*>(&w); } while (0)
  PK4(p0, 0, pa0); PK4(p0, 8, pa1); PK4(p1, 0, pa2); PK4(p1, 8, pa3);
#undef PK4
}
typedef __attribute__((address_space(3))) const char* lds_cptr_t;
__device__ __forceinline__ void qkt(f32x16& p0, f32x16& p1, const bf16* Ks, const char* qfl_, int r32, int hi, int mcolB, const f32x16& negm) {
  unsigned qoff = (unsigned)(uintptr_t)qfl_;
  asm volatile("" : "+v"(qoff));
  const lds_cptr_t qfl = (lds_cptr_t)qoff;
  bf16x8 qr[4];
#pragma unroll
  for (int d0 = 0; d0 < 4; ++d0) qr[d0] = *(const __attribute__((address_space(3))) bf16x8*)(qfl + d0 * 1024);
#pragma unroll
  for (int d0 = 0; d0 < 4; ++d0) { int cb = mcolB + (d0 * 16 + hi * 8) * 2;
    bf16x8 b0 = *reinterpret_cast<const bf16x8*>((const char*)Ks + KSWZ(r32, cb));
    bf16x8 b1 = *reinterpret_cast<const bf16x8*>((const char*)Ks + KSWZ(32 + r32, cb));
    if (d0 == 0) { p0 = __builtin_amdgcn_mfma_f32_32x32x16_bf16(b0, qr[0], negm, 0, 0, 0); p1 = __builtin_amdgcn_mfma_f32_32x32x16_bf16(b1, qr[0], negm, 0, 0, 0); }
    else { p0 = __builtin_amdgcn_mfma_f32_32x32x16_bf16(b0, qr[d0], p0, 0, 0, 0); p1 = __builtin_amdgcn_mfma_f32_32x32x16_bf16(b1, qr[d0], p1, 0, 0, 0); } }
}
__device__ __forceinline__ int v_st(int k, int c) { const int kk = (k & ~0xC) | ((k & 4) << 1) | ((k & 8) >> 1); return ((kk >> 3) * 4 + (c >> 5)) * 512 + ((kk & 7) * 32 + (c & 31)) * 2; }
__device__ __forceinline__ int v_rd_base(int lane) { return ((lane & 3) << 3) | (((lane >> 2) & 3) << 6) | (((lane >> 4) & 1) << 5) | (((lane >> 5) & 1) << 8); }
constexpr int v_rd_off(int d0, int ks, int half) { return d0 * 512 + ks * 4096 + half * 2048; }
template <int OFF> __device__ __forceinline__ s16x4 tr_read(int vb) {
  s16x4 r; asm volatile("ds_read_b64_tr_b16 %0, %1 offset:%2" : "=&v"(r) : "v"(vb), "i"(OFF) : "memory"); return r;
}
template <int D0> __device__ __forceinline__ void pv_one(f32x16& od, int vb, bf16x8 pa0, bf16x8 pa1, bf16x8 pa2, bf16x8 pa3) {
  const s16x4 l0 = tr_read<v_rd_off(D0, 0, 0)>(vb), h0 = tr_read<v_rd_off(D0, 0, 1)>(vb), l1 = tr_read<v_rd_off(D0, 1, 0)>(vb), h1 = tr_read<v_rd_off(D0, 1, 1)>(vb);
  const s16x4 l2 = tr_read<v_rd_off(D0, 2, 0)>(vb), h2 = tr_read<v_rd_off(D0, 2, 1)>(vb), l3 = tr_read<v_rd_off(D0, 3, 0)>(vb), h3 = tr_read<v_rd_off(D0, 3, 1)>(vb);
  asm volatile("s_waitcnt lgkmcnt(0)" ::: "memory"); SBAR();
#define PK(L, H) (bf16x8){L[0], L[1], L[2], L[3], H[0], H[1], H[2], H[3]}
  od = __builtin_amdgcn_mfma_f32_32x32x16_bf16(pa0, PK(l0, h0), od, 0, 0, 0);
  od = __builtin_amdgcn_mfma_f32_32x32x16_bf16(pa1, PK(l1, h1), od, 0, 0, 0);
  od = __builtin_amdgcn_mfma_f32_32x32x16_bf16(pa2, PK(l2, h2), od, 0, 0, 0);
  od = __builtin_amdgcn_mfma_f32_32x32x16_bf16(pa3, PK(l3, h3), od, 0, 0, 0);
#undef PK
}
__device__ __forceinline__ void pv_d0(f32x16* o, int vb, bf16x8 pa0, bf16x8 pa1, bf16x8 pa2, bf16x8 pa3) {
  pv_one<0>(o[0], vb, pa0, pa1, pa2, pa3); pv_one<1>(o[1], vb, pa0, pa1, pa2, pa3); pv_one<2>(o[2], vb, pa0, pa1, pa2, pa3); pv_one<3>(o[3], vb, pa0, pa1, pa2, pa3);
}

__device__ __forceinline__ void diff_attn_unit(const bf16* __restrict__ Qb, const bf16* __restrict__ Kh, const bf16* __restrict__ Vh,
                                               bf16* __restrict__ Ob, int seq, float lam, const float* __restrict__ subln, char* lds) {
  using St = Stage<bf16>;
  int tid_ = threadIdx.x; asm volatile("" : "+v"(tid_));
  const int tid = tid_, wid = tid >> 6, lane = tid & 63, r32 = lane & 31, hi = lane >> 5;
  bf16* V_lds = (bf16*)lds; bf16* K_lds = (bf16*)(lds + 2 * SHM_V);
  float* ws = (float*)(lds + 2 * SHM_V + 2 * SHM_K) + wid * 64; float* li_l = ws; float* al_l = ws + 32;
  float m_reg = 0.f, l_reg = 0; f32x16 o[4] = {}; f32x16 negm = {};
  const int mw = wid >> 2, wq = wid & 3, mcolB = mw * 128;
  const bf16* Qw = Qb + (long)(wq * QBLK + r32) * LDQ + mw * 64 + hi * 8;
  char* qr = lds + 2 * SHM_V + 2 * SHM_K + NW * 64 * 4 + wid * 4096 + lane * 16;
#pragma unroll
  for (int d0 = 0; d0 < 4; ++d0) *reinterpret_cast<bf16x8*>(qr + d0 * 1024) = St::ld8(Qw + d0 * 16);
  const int sr = tid >> 4, sc = (tid & 15) * 8, vst0 = v_st(sr, sc), vst1 = v_st(32 + sr, sc);
  const int vb0 = (int)(uintptr_t)V_lds + v_rd_base(lane);
  struct { typename St::T vs0, vs1, ks0, ks1; } sr_[SDEPTH];
#define SLOAD(i, k0) do { sr_[i].vs0 = St::ld8(&Vh[(long)((k0) + sr) * LDK + sc]); sr_[i].vs1 = St::ld8(&Vh[(long)((k0) + 32 + sr) * LDK + sc]); \
    sr_[i].ks0 = St::ld8(&Kh[(long)((k0) + sr) * LDK + sc]); sr_[i].ks1 = St::ld8(&Kh[(long)((k0) + 32 + sr) * LDK + sc]); } while (0)
#define SWRITE(b, i) do { *(bf16x8*)((char*)V_lds + (b) * SHM_V + vst0) = St::tobf(sr_[i].vs0);          \
    *(bf16x8*)((char*)V_lds + (b) * SHM_V + vst1) = St::tobf(sr_[i].vs1); int kc = sc * 2;               \
    *(bf16x8*)((char*)K_lds + (b) * SHM_K + KSWZ(sr, kc)) = St::tobf(sr_[i].ks0);                       \
    *(bf16x8*)((char*)K_lds + (b) * SHM_K + KSWZ(32 + sr, kc)) = St::tobf(sr_[i].ks1); } while (0)
#define SWAIT() do { if constexpr (SDEPTH == 2) asm volatile("s_waitcnt vmcnt(4)" ::: "memory"); else asm volatile("s_waitcnt vmcnt(0)" ::: "memory"); } while (0)
#define RESC(a) do { if (__any((a) < 1.f)) { if (hi == 0) al_l[r32] = (a); asm volatile("s_waitcnt lgkmcnt(0)" ::: "memory"); \
    for (int d = 0; d < 4; ++d) for (int r = 0; r < 16; ++r) o[d][r] *= al_l[crow(r, hi)]; } } while (0)
  f32x16 pA0, pA1, pB0, pB1; float mnA, mnB, alA, alB; bf16x8 pa0, pa1, pa2, pa3; const int NT = seq / KVBLK;
  constexpr int SE = 0, SO = SDEPTH - 1;
  SLOAD(SE, 0); asm volatile("s_waitcnt vmcnt(0)" ::: "memory"); SWRITE(0, SE); __syncthreads();
  qkt(pA0, pA1, K_lds, qr, r32, hi, mcolB, negm); partialSM<true>(pA0, pA1, m_reg, negm, alA);
  SLOAD(SO, KVBLK); if constexpr (SDEPTH == 2) { if (2 < NT) SLOAD(SE, 2 * KVBLK); }
  SWAIT(); SWRITE(1, SO); __syncthreads();
  for (int j = 1; j + 1 < NT; j += 2) {
    SBAR(); qkt(pB0, pB1, (bf16*)((char*)K_lds + SHM_K), qr, r32, hi, mcolB, negm);
    finishSM(pA0, pA1, alA, l_reg, pa0, pa1, pa2, pa3); SBAR();
    SLOAD(SO, (j + SDEPTH) * KVBLK); SBAR();
    pv_d0(o, vb0, pa0, pa1, pa2, pa3); partialSM<false>(pB0, pB1, m_reg, negm, alB);
    __syncthreads(); SWAIT(); SWRITE(0, SE);
    RESC(alB); __syncthreads();
    SBAR(); qkt(pA0, pA1, K_lds, qr, r32, hi, mcolB, negm);
    finishSM(pB0, pB1, alB, l_reg, pa0, pa1, pa2, pa3); SBAR();
    if (SDEPTH == 1 || j + 3 < NT) SLOAD(SE, (j + 1 + SDEPTH) * KVBLK); SBAR();
    pv_d0(o, vb0 + (int)SHM_V, pa0, pa1, pa2, pa3); partialSM<false>(pA0, pA1, m_reg, negm, alA);
    __syncthreads(); SWAIT(); SWRITE(1, SO);
    RESC(alA); __syncthreads();
  }
  SBAR(); qkt(pB0, pB1, (bf16*)((char*)K_lds + SHM_K), qr, r32, hi, mcolB, negm);
  finishSM(pA0, pA1, alA, l_reg, pa0, pa1, pa2, pa3); SBAR();
  pv_d0(o, vb0, pa0, pa1, pa2, pa3); partialSM<false>(pB0, pB1, m_reg, negm, alB);
  __syncthreads(); RESC(alB);
  finishSM(pB0, pB1, alB, l_reg, pa0, pa1, pa2, pa3); SBAR();
  pv_d0(o, vb0 + (int)SHM_V, pa0, pa1, pa2, pa3);
  if (hi == 0) li_l[r32] = l_reg; asm volatile("s_waitcnt lgkmcnt(0)" ::: "memory");
  float rli[16];
#pragma unroll
  for (int r = 0; r < 16; ++r) rli[r] = __builtin_amdgcn_rcpf(li_l[crow(r, hi)]);
  float* EXO = (float*)(lds + 2 * SHM_V + 2 * SHM_K + NW * 64 * 4) + wq * (4 * 16 * 64) + lane;
  if (mw == 1) {
#pragma unroll
    for (int d0 = 0; d0 < 4; ++d0)
#pragma unroll
      for (int r = 0; r < 16; ++r) EXO[(d0 * 16 + r) * 64] = o[d0][r] * rli[r];
  }
  __syncthreads();
  if (mw == 0) {
    float ssq[16];
#pragma unroll
    for (int r = 0; r < 16; ++r) ssq[r] = 0.f;
#pragma unroll
    for (int d0 = 0; d0 < 4; ++d0)
#pragma unroll
      for (int r = 0; r < 16; ++r) { const float dv = o[d0][r] * rli[r] - lam * EXO[(d0 * 16 + r) * 64]; o[d0][r] = dv; ssq[r] += dv * dv; }
#pragma unroll
    for (int r = 0; r < 16; ++r) {
#pragma unroll
      for (int sft = 1; sft < 32; sft <<= 1) ssq[r] += __shfl_xor(ssq[r], sft);
      ssq[r] = rsqrtf(ssq[r] * (1.f / 128.f) + 1e-6f) * 0.8f;
    }
    bf16* Ow = Ob + (long)(wq * QBLK) * LDO;
#pragma unroll
    for (int d0 = 0; d0 < 4; ++d0) { const float gg = subln[d0 * 32 + r32];
#pragma unroll
      for (int r = 0; r < 16; ++r) { const float val = o[d0][r] * ssq[r] * gg; Ow[(long)crow(r, hi) * LDO + d0 * 32 + r32] = (bf16)(pg8::cvt_pk_bf16(val, val) & 0xffffu); } }
  }
  __syncthreads();
#undef SLOAD
#undef SWRITE
#undef SWAIT
#undef RESC
}
}


typedef __bf16 bf16x2_t __attribute__((ext_vector_type(2)));
__device__ __forceinline__ float dot2bf(unsigned a, unsigned b, float acc) { return __builtin_amdgcn_fdot2_f32_bf16(__builtin_bit_cast(bf16x2_t, a), __builtin_bit_cast(bf16x2_t, b), acc, false); }
template <int CTRL> __device__ __forceinline__ float dpp_add(float v) { return v + __builtin_bit_cast(float, __builtin_amdgcn_update_dpp(0, __builtin_bit_cast(int, v), CTRL, 0xf, 0xf, true)); }
__device__ __forceinline__ float row16_sum(float v) {
  v = dpp_add<0xB1>(v); v = dpp_add<0x4E>(v); v = dpp_add<0x141>(v); v = dpp_add<0x140>(v); return v;
}

typedef unsigned u32x2_t __attribute__((ext_vector_type(2)));
typedef float f32x2_t __attribute__((ext_vector_type(2)));
__device__ __forceinline__ void slice_table_fp8(const float* T, unsigned char* T8, float scale, int gtid, int gsz) {
  for (int it0 = gtid; it0 < 16384 * 128; it0 += 4 * gsz) {
    f32x4 a[4], b[4];
#pragma unroll
    for (int q = 0; q < 4; ++q) { const int it = it0 + q * gsz; if (it < 16384 * 128) { const int e = it >> 7, c8 = (it & 127) * 8; a[q] = *(const f32x4*)(T + (size_t)e * 1024 + c8); b[q] = *(const f32x4*)(T + (size_t)e * 1024 + c8 + 4); } }
#pragma unroll
    for (int q = 0; q < 4; ++q) { const int it = it0 + q * gsz; if (it < 16384 * 128) {
      const int e = it >> 7, c8 = (it & 127) * 8, j = c8 >> 7, c = c8 & 127; const f32x4 as = a[q] * scale, bs = b[q] * scale;
      int w0 = __builtin_amdgcn_cvt_pk_fp8_f32(as[0], as[1], 0, false); w0 = __builtin_amdgcn_cvt_pk_fp8_f32(as[2], as[3], w0, true);
      int w1 = __builtin_amdgcn_cvt_pk_fp8_f32(bs[0], bs[1], 0, false); w1 = __builtin_amdgcn_cvt_pk_fp8_f32(bs[2], bs[3], w1, true);
      *(u32x2_t*)(T8 + ((size_t)j * 16384 + e) * 128 + c) = (u32x2_t){(unsigned)w0, (unsigned)w1}; } }
  }
}
__device__ __forceinline__ void slice_table(const float* T, bf16_t* T8, int gtid, int gsz) {
  for (int it = gtid; it < 16384 * 128; it += gsz) {
    const int e = it >> 7, c8 = (it & 127) * 8, j = c8 >> 7, c = c8 & 127;
    const f32x4 a = *(const f32x4*)(T + (size_t)e * 1024 + c8), b = *(const f32x4*)(T + (size_t)e * 1024 + c8 + 4);
    u32x4 w; w.x = pg8::cvt_pk_bf16(a[0], a[1]); w.y = pg8::cvt_pk_bf16(a[2], a[3]); w.z = pg8::cvt_pk_bf16(b[0], b[1]); w.w = pg8::cvt_pk_bf16(b[2], b[3]);
    *(u32x4*)(T8 + ((size_t)j * 16384 + e) * 128 + c) = w;
  }
}

#define LAS __attribute__((address_space(3)))
#define XB_TMO      128
#define XB_XCNT(j)  (256  + 64 * (j))
#define XB_XSUB(j)  (1280 + 64 * (j))
#define XB_XGEN(j)  (2304 + 64 * (j))
#define XB_TOP      3328
#define XB_TOPGEN   3392
#define XCD_BAR_WORDS 3456
#define XB_SPIN_CAP (1u << 18)

__device__ __forceinline__ unsigned xb_ld(unsigned* p)              { return __hip_atomic_load(p, __ATOMIC_RELAXED, __HIP_MEMORY_SCOPE_AGENT); }
__device__ __forceinline__ unsigned xb_add(unsigned* p, unsigned v) { return __hip_atomic_fetch_add(p, v, __ATOMIC_RELAXED, __HIP_MEMORY_SCOPE_AGENT); }
__device__ __forceinline__ unsigned xb_xcc_id() { return (unsigned)__builtin_amdgcn_s_getreg((3 << 11) | 20) & 0xFu; }
#define XB_SPIN(cond, bar) do { unsigned _sp = 0; while (cond) { __builtin_amdgcn_s_sleep(1); \
    if ((++_sp & 255u) == 0u) { if (xb_ld(&(bar)[XB_TMO])) break; if (_sp > XB_SPIN_CAP) { atomicAdd(&(bar)[XB_TMO], 1u); break; } } } } while (0)

struct XcdBarrier {
    unsigned* bar; unsigned x;
    volatile LAS unsigned* st;
};

__device__ __forceinline__ XcdBarrier xcd_barrier_post(unsigned* bar, volatile LAS unsigned* st) {
    XcdBarrier b; b.bar = bar; b.x = xb_xcc_id(); b.st = st;
    if (threadIdx.x == 0) (void)xb_add(&bar[XB_XCNT(b.x)], 1u);
    return b;
}
__device__ __forceinline__ void xcd_barrier_complete(unsigned* bar, unsigned x, unsigned& nloc, unsigned& nx) {
    const unsigned G = gridDim.x * gridDim.y * gridDim.z;
    unsigned sum, cnt, mine, sp = 0u;
    for (;;) {
        sum = 0u; cnt = 0u; mine = 0u;
#pragma unroll
        for (unsigned j = 0; j < 16; ++j) { const unsigned c = xb_ld(&bar[XB_XCNT(j)]); sum += c; cnt += (c > 0u) ? 1u : 0u; mine = (j == x) ? c : mine; }
        if (sum == G) break;
        __builtin_amdgcn_s_sleep(1);
        if ((++sp & 255u) == 0u) { if (xb_ld(&bar[XB_TMO])) break; if (sp > XB_SPIN_CAP) { atomicAdd(&bar[XB_TMO], 1u); break; } }
    }
    nloc = mine > 0u ? mine : 1u; nx = cnt > 0u ? cnt : 1u;
}

__device__ __forceinline__ void xcd_barrier(const XcdBarrier& b) {
    asm volatile("s_waitcnt vmcnt(0)" ::: "memory");
    __syncthreads();
    if (threadIdx.x == 0) {
        unsigned* bar = b.bar;
        __builtin_amdgcn_s_waitcnt(0);
        unsigned nloc = b.st[0], nx = b.st[1];
        if (nloc == 0u) { xcd_barrier_complete(bar, b.x, nloc, nx); b.st[0] = nloc; b.st[1] = nx; }
        const unsigned old = xb_add(&bar[XB_XSUB(b.x)], 1u);
        const unsigned gen = old / nloc;
        if (old + 1u == (gen + 1u) * nloc) {
            __builtin_amdgcn_fence(__ATOMIC_RELEASE, "agent");
            asm volatile("s_waitcnt vmcnt(0)" ::: "memory");
            const unsigned og = xb_add(&bar[XB_TOP], 1u);
            const unsigned tg = og / nx;
            if (og + 1u == (tg + 1u) * nx) xb_add(&bar[XB_TOPGEN], 1u);
            else XB_SPIN(xb_ld(&bar[XB_TOPGEN]) == tg, bar);
            __builtin_amdgcn_fence(__ATOMIC_ACQUIRE, "agent");
            xb_add(&bar[XB_XGEN(b.x)], 1u);
            asm volatile("s_waitcnt vmcnt(0)" ::: "memory");
        } else {
            XB_SPIN(xb_ld(&bar[XB_XGEN(b.x)]) == gen, bar);
            __builtin_amdgcn_fence(__ATOMIC_ACQUIRE, "agent");
            asm volatile("s_waitcnt vmcnt(0)" ::: "memory");
        }
    }
    __syncthreads();
}


__device__ __forceinline__ void wave_argmax(float& v, int& i) {
#pragma unroll
  for (int o = 32; o; o >>= 1) {
    const float ov = __shfl_xor(v, o); const int oi = __shfl_xor(i, o);
    if (ov > v || (ov == v && oi < i)) { v = ov; i = oi; }
  }
}

__global__ void __launch_bounds__(NT) mega(Params p) {
  extern __shared__ __attribute__((aligned(16))) unsigned char lds[];
  cg::grid_group grid = cg::this_grid();
  if (threadIdx.x < 35) {
    unsigned long long v = threadIdx.x < 33 ? (unsigned long long)p.in[threadIdx.x] : (threadIdx.x == 33 ? (unsigned long long)p.out : (unsigned long long)p.ws);
    ((unsigned long long*)(lds + PTR_OFF))[threadIdx.x] = v;
  }
  if (threadIdx.x < 2) ((volatile unsigned*)(lds + PTR_OFF + 800))[threadIdx.x] = 0u;
  __syncthreads();
  if (blockIdx.x == 0) for (int i = threadIdx.x; i < XCD_BAR_WORDS; i += NT) ((unsigned*)WSP(WS_BAR))[i] = 0u;

  {
    PHASE_LOCALS
    float* MOD = (float*)WSP(WS_MOD); float* LAM = (float*)WSP(WS_LAM);
    float* ABRE = (float*)WSP(WS_ABRE); float* ABIM = (float*)WSP(WS_ABIM); float* BBRE = (float*)WSP(WS_BBRE); float* BBIM = (float*)WSP(WS_BBIM);
    const float* cin = INP(1); const float* c_ctx = INP(3); const float* ada_w = INP(4); const float* ada_b = INP(5);
    if (gridDim.x >= 192) {
      if (blockIdx.x < 192) {
        float* sil = fl; float* red = fl + 5 * 1024;
        for (int i = tid; i < 5 * 1024; i += NT) { const int r = i >> 10, k = i & 1023; sil[i] = siluf_(r < 4 ? cin[r * D + k] : c_ctx[k]); }
        __syncthreads();
        const int cl = tid & 31, kg = tid >> 5, col = blockIdx.x * 32 + cl;
        float a[5] = {0.f, 0.f, 0.f, 0.f, 0.f};
#pragma unroll
        for (int kk = 0; kk < 64; ++kk) {
          const int k = kg * 64 + kk; const float w = ada_w[(size_t)k * 6144 + col];
#pragma unroll
          for (int r = 0; r < 5; ++r) a[r] += sil[r * 1024 + k] * w;
        }
#pragma unroll
        for (int r = 0; r < 5; ++r) red[(kg * 5 + r) * 32 + cl] = a[r];
        __syncthreads();
        if (tid < 160) {
          const int r = tid >> 5; float s = 0.f;
#pragma unroll
          for (int q = 0; q < 16; ++q) s += red[(q * 5 + r) * 32 + cl];
          MOD[r * 6144 + col] = s + ada_b[col];
        }
        __syncthreads();
      }
    } else {
      for (int it = gtid; it < 5 * 6144; it += gsz) {
        const int r = it / 6144, j = it % 6144;
        const float* cv = r < 4 ? cin + r * D : c_ctx;
        float a = 0.f;
        for (int k = 0; k < D; ++k) a += siluf_(cv[k]) * ada_w[(size_t)k * 6144 + j];
        MOD[it] = a + ada_b[j];
      }
    }
    if (gtid == 0) {
      const float* q1 = INP(9); const float* k1 = INP(10); const float* q2 = INP(11); const float* k2 = INP(12);
      float s1 = 0.f, s2 = 0.f;
      for (int k = 0; k < 64; ++k) { s1 += q1[k] * k1[k]; s2 += q2[k] * k2[k]; }
      LAM[0] = expf(s1) - expf(s2) + 0.2f;
    }
    const float* a_re = INP(15); const float* a_im = INP(16); const float* ldt = INP(17); const float* b_re = INP(18); const float* b_im = INP(19);
    for (int it = gtid; it < 2 * 32 * 64; it += gsz) {
      const int dg = it >> 6;
      const float ar = a_re[it], ai = a_im[it], dt = expf(ldt[dg]);
      const float mag = expf(ar * dt), abr = mag * cosf(ai * dt), abi = mag * sinf(ai * dt);
      ABRE[it] = abr; ABIM[it] = abi; ((float*)WSP(WS_ARDT))[it] = ar * dt; ((float*)WSP(WS_AIDT))[it] = ai * dt;
      const float den = ar * ar + ai * ai, nr = abr - 1.f, ni = abi;
      const float fr = (nr * ar + ni * ai) / den, fi = (ni * ar - nr * ai) / den;
      for (int pp = 0; pp < 16; ++pp) {
        const float br = b_re[it * 16 + pp], bi = b_im[it * 16 + pp];
        BBRE[it * 16 + pp] = fr * br - fi * bi; BBIM[it * 16 + pp] = fr * bi + fi * br;
      }
    }
    {
      struct BB { float fr, fi, ardt, aidt; };
      auto disc1 = [&](int sidx) -> BB {
        const float ar = a_re[sidx], ai = a_im[sidx], dt = expf(ldt[sidx >> 6]);
        const float mag = expf(ar * dt), abr = mag * cosf(ai * dt), abi = mag * sinf(ai * dt);
        const float den = ar * ar + ai * ai, nr = abr - 1.f, ni = abi;
        return BB{(nr * ar + ni * ai) / den, (ni * ar - nr * ai) / den, ar * dt, ai * dt};
      };
      {
        bf16_t* BTS = (bf16_t*)WSP(WS_BTS);
        for (int it = gtid; it < 32 * 256 * 32; it += gsz) {
          const int i = it & 31, r = (it >> 5) & 255, g = it >> 13;
          const int d = r >> 7, n = (r >> 1) & 63, ri = r & 1, sidx = (d * 32 + g) * 64 + n;
          const BB bb = disc1(sidx);
          const float e = (float)(d == 0 ? 31 - i : i);
          const float mag = __expf(e * bb.ardt), pr0 = mag * __cosf(e * bb.aidt), pi0 = mag * __sinf(e * bb.aidt);
          const float pr = pr0 * bb.fr - pi0 * bb.fi, pi = pr0 * bb.fi + pi0 * bb.fr;
          unsigned w[8];
#pragma unroll
          for (int q = 0; q < 8; ++q) {
            const float br0 = b_re[sidx * 16 + 2 * q], bi0 = b_im[sidx * 16 + 2 * q], br1 = b_re[sidx * 16 + 2 * q + 1], bi1 = b_im[sidx * 16 + 2 * q + 1];
            const float v0 = ri == 0 ? pr * br0 - pi * bi0 : pr * bi0 + pi * br0, v1 = ri == 0 ? pr * br1 - pi * bi1 : pr * bi1 + pi * br1;
            w[q] = pg8::cvt_pk_bf16(v0, v1);
          }
          u32x4* dst = (u32x4*)(BTS + ((size_t)g * 256 + r) * 512 + i * 16);
          dst[0] = (u32x4){w[0], w[1], w[2], w[3]}; dst[1] = (u32x4){w[4], w[5], w[6], w[7]};
        }
      }
      {
        float* KT = (float*)WSP(WS_KT); const float* c_re = INP(20); const float* c_im = INP(21);
        if (gridDim.x >= 256) {
          if (blockIdx.x >= 192) {
            const int dg = (int)blockIdx.x - 192; float* dsc = fl;
            if (tid < 64) { const BB bb = disc1(dg * 64 + tid); dsc[tid * 4] = bb.fr; dsc[tid * 4 + 1] = bb.fi; dsc[tid * 4 + 2] = bb.ardt; dsc[tid * 4 + 3] = bb.aidt; }
            __syncthreads();
            const int pp = tid & 15, m = tid >> 4;
            float acc[16];
#pragma unroll
            for (int q = 0; q < 16; ++q) acc[q] = 0.f;
            for (int n = 0; n < 64; ++n) {
              const int sidx = dg * 64 + n;
              const float fr = dsc[n * 4], fi = dsc[n * 4 + 1], ardt = dsc[n * 4 + 2], aidt = dsc[n * 4 + 3];
              const float mag = __expf((float)m * ardt), pr0 = mag * __cosf((float)m * aidt), pi0 = mag * __sinf((float)m * aidt);
              const float pr = pr0 * fr - pi0 * fi, pi = pr0 * fi + pi0 * fr;
              const float cr = c_re[(dg * 16 + pp) * 64 + n], ci = c_im[(dg * 16 + pp) * 64 + n];
              const float wr_ = cr * pr - ci * pi, wi_ = cr * pi + ci * pr;
#pragma unroll
              for (int q = 0; q < 16; ++q) acc[q] += wr_ * b_re[sidx * 16 + q] - wi_ * b_im[sidx * 16 + q];
            }
#pragma unroll
            for (int q = 0; q < 16; ++q) KT[((size_t)dg * 32 + m) * 256 + pp * 16 + q] = acc[q];
            __syncthreads();
          }
        } else {
          for (int it = gtid; it < 2 * 32 * 32 * 16; it += gsz) {
            const int pp = it & 15, m = (it >> 4) & 31, dg = it >> 9;
            float acc[16];
#pragma unroll
            for (int q = 0; q < 16; ++q) acc[q] = 0.f;
            for (int n = 0; n < 64; ++n) {
              const int sidx = dg * 64 + n;
              const BB bb = disc1(sidx);
              const float mag = __expf((float)m * bb.ardt), pr0 = mag * __cosf((float)m * bb.aidt), pi0 = mag * __sinf((float)m * bb.aidt);
              const float pr = pr0 * bb.fr - pi0 * bb.fi, pi = pr0 * bb.fi + pi0 * bb.fr;
              const float cr = c_re[(dg * 16 + pp) * 64 + n], ci = c_im[(dg * 16 + pp) * 64 + n];
              const float wr_ = cr * pr - ci * pi, wi_ = cr * pi + ci * pr;
#pragma unroll
              for (int q = 0; q < 16; ++q) acc[q] += wr_ * b_re[sidx * 16 + q] - wi_ * b_im[sidx * 16 + q];
            }
#pragma unroll
            for (int q = 0; q < 16; ++q) KT[((size_t)dg * 32 + m) * 256 + pp * 16 + q] = acc[q];
          }
        }
      }
    }
    float* ROPE = (float*)WSP(WS_ROPE);
    for (int it = gtid; it < 64 * 16; it += gsz) {
      const float ang = (float)(it >> 4) * powf(10000.f, -(float)(it & 15) / 16.f);
      ROPE[it * 2] = cosf(ang); ROPE[it * 2 + 1] = sinf(ang);
    }
    {
      float* scr = fl + wid * (64 * 33);
      constexpr int I_IN = 16 * 176, I_AU = 16 * 32, I_SU = 8 * 32, I_OUT = 16 * 32, I_Q = 16 * 32, I_GLU = 8 * 16;
      for (int it = gw; it < I_IN + I_AU + I_SU + I_OUT + I_GLU; it += ngw) {
        int r = it;
        if (r < I_IN) { transpose_item(INP(8), 1024, N_IN, (bf16_t*)WSP(WS_WIN), scr, r, lane); continue; } r -= I_IN;
        if (r < I_AU) { transpose_item(INP(14), 1024, 1024, (bf16_t*)WSP(WS_WAU), scr, r, lane); continue; } r -= I_AU;
        if (r < I_SU) { transpose_item(INP(25), 512, 1024, (bf16_t*)WSP(WS_WSU), scr, r, lane); continue; } r -= I_SU;
        if (r < I_OUT) { transpose_item(INP(26), 1024, 1024, (bf16_t*)WSP(WS_WOUT), scr, r, lane); continue; } r -= I_OUT;
        transpose_item(INP(23), 512, 512, (bf16_t*)WSP(WS_WGLU), scr, r, lane);
      }
    }
  }
  grid.sync();
  const XcdBarrier xbar = xcd_barrier_post((unsigned*)WSP(WS_BAR), (volatile LAS unsigned*)(lds + PTR_OFF + 800));

  {
    PHASE_LOCALS
    const float* MOD = (const float*)WSP(WS_MOD); bf16_t* XN = (bf16_t*)WSP(WS_XN);
    const float* x = INP(0); const float* ctx = INP(2); const float* norm1_g = INP(6);
    for (int row = gw; row < MX + MC; row += ngw) {
      const float* src; const float* md;
      if (row < MX) { src = x + (size_t)row * D; md = MOD + (row / L) * 6144; } else { src = ctx + (size_t)(row - MX) * D; md = MOD + 4 * 6144; }
      f32x4 v[4]; float ss = 0.f;
#pragma unroll
      for (int j = 0; j < 4; ++j) { v[j] = *(const f32x4*)(src + lane * 4 + 256 * j); ss += v[j][0] * v[j][0] + v[j][1] * v[j][1] + v[j][2] * v[j][2] + v[j][3] * v[j][3]; }
      const float rstd = rsqrtf(wave_sum(ss) * (1.f / D) + 1e-6f);
#pragma unroll
      for (int j = 0; j < 4; ++j)
#pragma unroll
        for (int e = 0; e < 4; ++e) { const int col = lane * 4 + 256 * j + e; XN[(size_t)row * D + col] = f2bf(v[j][e] * rstd * norm1_g[col] * (1.f + md[1024 + col]) + md[col]); }
    }
  }
  xcd_barrier(xbar);

  {
    pg8::Gemm g{(const bf16_t*)WSP(WS_XN), (const bf16_t*)WSP(WS_WIN), MX + MC, N_IN, D, D, D};
    InProjSched S; S.init((int)gridDim.x, (int)blockIdx.x);
    EpiInProj E{(bf16_t*)WSP(WS_Q), (bf16_t*)WSP(WS_K), (bf16_t*)WSP(WS_V), (bf16_t*)WSP(WS_SA), (bf16_t*)WSP(WS_G), (const float*)WSP(WS_ROPE)};
    pg8::gemm_phase<EpiInProj, InProjSched, true, true>((PG8_LAS unsigned char*)lds, g, S, E);
  }
  xcd_barrier(xbar);

  {
    const float lam = ((const float*)WSP(WS_LAM))[0];
    const bf16_t* Qb = (const bf16_t*)WSP(WS_Q); const bf16_t* Kb = (const bf16_t*)WSP(WS_K); const bf16_t* Vb = (const bf16_t*)WSP(WS_V);
    bf16_t* ATT = (bf16_t*)WSP(WS_ATT); const float* subln = INP(13);
    for (int unit = blockIdx.x; unit < Bn * 8 * (L / 128); unit += gridDim.x) {
      const int h = unit & 7, qb = (unit >> 3) & 31, b = unit >> 8;
      const size_t qoff = ((size_t)(b * L + qb * 128)) * 1024 + h * 128, koff = (size_t)b * LA * 1024 + h * 128;
      att::diff_attn_unit(Qb + qoff, Kb + koff, Vb + koff, ATT + qoff, LA, lam, subln, (char*)lds);
    }
  }
  xcd_barrier(xbar);

  {
    const bool gemm_blk = (blockIdx.x < 96) || (gridDim.x <= 96);
    if (gemm_blk) {
      pg8::Gemm g{(const bf16_t*)WSP(WS_SA), (const bf16_t*)WSP(WS_BTS), 0, 0, 512, SA_LD, 512};
      GroupSched S; S.init(32, 3, 1, (long)SA_ROWS * SA_LD * 2, (long)256 * SA_LD * 2, (long)256 * 512 * 2, 0, (int)(gridDim.x <= 96 ? gridDim.x : 96), (int)blockIdx.x);
      EpiS E{(float*)WSP(WS_S)};
      pg8::gemm_phase<EpiS, GroupSched, true, true>((PG8_LAS unsigned char*)lds, g, S, E);
    }
    {
      PHASE_LOCALS
      const bool big = gridDim.x > 96;
      const int vslots = big ? (gemm_blk ? 3 : 5) : 1, vbase = big ? (gemm_blk ? (int)blockIdx.x * 3 : 96 * 3 + ((int)blockIdx.x - 96) * 5) : (int)blockIdx.x;
      const int vtot = big ? 96 * 3 + ((int)gridDim.x - 96) * 5 : (int)gridDim.x;
      const float* KT = (const float*)WSP(WS_KT); const float* ARDT = (const float*)WSP(WS_ARDT); const float* AIDT = (const float*)WSP(WS_AIDT);
      const float* c_re = INP(20); const float* c_im = INP(21); const float* dsk = INP(22); bf16_t* BTY = (bf16_t*)WSP(WS_BTY);
      for (int cb = vbase; cb < 32 * 512 * 96 / NT; cb += vtot) for (int vs = 0; vs < vslots; ++vs) {
        const int ch = cb + vs; if (ch >= 32 * 512 * 96 / NT) break;
        const int it = ch * NT + tid;
        const int cgp = it % 96, row = (it / 96) & 511, g = it / (96 * 512);
        const int j = row >> 4, pp = row & 15, col0 = cgp * 8;
        float v[8];
        if (col0 < 512) {
          const int i = col0 >> 4, q0 = col0 & 15;
#pragma unroll
          for (int e = 0; e < 8; ++e) v[e] = 0.f;
          if (i <= j) { const float* kp = KT + ((size_t)(0 * 32 + g) * 32 + (j - i)) * 256 + pp * 16 + q0;
#pragma unroll
            for (int e = 0; e < 8; ++e) v[e] += kp[e]; }
          if (i >= j) { const float* kp = KT + ((size_t)(1 * 32 + g) * 32 + (i - j)) * 256 + pp * 16 + q0;
#pragma unroll
            for (int e = 0; e < 8; ++e) v[e] += kp[e]; }
          if (i == j && pp >= q0 && pp < q0 + 8) {
#pragma unroll
            for (int e = 0; e < 8; ++e) if (q0 + e == pp) v[e] += dsk[g * 16 + pp];
          }
        } else {
          const int cc0 = col0 - 512, d = cc0 >> 7, n0 = (cc0 & 127) >> 1;
          const float ex = (float)(d == 0 ? j + 1 : 32 - j);
#pragma unroll
          for (int q = 0; q < 4; ++q) {
            const int n = n0 + q, sidx = (d * 32 + g) * 64 + n;
            const float mag = __expf(ex * ARDT[sidx]), pr = mag * __cosf(ex * AIDT[sidx]), pi = mag * __sinf(ex * AIDT[sidx]);
            const float cr = c_re[((d * 32 + g) * 16 + pp) * 64 + n], ci = c_im[((d * 32 + g) * 16 + pp) * 64 + n];
            v[2 * q] = cr * pr - ci * pi; v[2 * q + 1] = -(cr * pi + ci * pr);
          }
        }
        u32x4 w; w.x = pg8::cvt_pk_bf16(v[0], v[1]); w.y = pg8::cvt_pk_bf16(v[2], v[3]); w.z = pg8::cvt_pk_bf16(v[4], v[5]); w.w = pg8::cvt_pk_bf16(v[6], v[7]);
        *(u32x4*)(BTY + ((size_t)g * 512 + row) * 768 + col0) = w;
      }
    }
  }
  xcd_barrier(xbar);

  {
    PHASE_LOCALS
    const float* ARDT = (const float*)WSP(WS_ARDT); const float* AIDT = (const float*)WSP(WS_AIDT);
    if (wid == 0) {
      for (int it = blockIdx.x; it < Bn * 32 * 2; it += gridDim.x) {
        const int d = it & 1, g = (it >> 1) & 31, b = it >> 6;
        const int sidx = (d * 32 + g) * 64 + lane;
        const float mag = expf(32.f * ARDT[sidx]), pr = mag * cosf(32.f * AIDT[sidx]), pi = mag * sinf(32.f * AIDT[sidx]);
        typedef float f32x2_ __attribute__((ext_vector_type(2)));
        const f32x2_* Sg = (const f32x2_*)((const float*)WSP(WS_S) + (size_t)g * SA_ROWS * 256) + d * 64 + lane;
        bf16_t* SAg = (bf16_t*)WSP(WS_SA) + (size_t)g * SA_ROWS * SA_LD + 512 + d * 128 + lane * 2;
        float hr = 0.f, hi = 0.f;
        f32x2_ sc[8];
#pragma unroll
        for (int k = 0; k < 8; ++k) { const int cc = d == 0 ? k : 7 - k; sc[k] = Sg[(size_t)(512 + b * 8 + cc) * 128]; }
#pragma unroll
        for (int k = 0; k < 8; ++k) { const float nr = pr * hr - pi * hi + sc[k][0], ni = pr * hi + pi * hr + sc[k][1]; hr = nr; hi = ni; }
        for (int k0 = 0; k0 < 128; k0 += 16) {
          f32x2_ sv[16];
#pragma unroll
          for (int k = 0; k < 16; ++k) { const int cx = d == 0 ? k0 + k : 127 - (k0 + k); sv[k] = Sg[(size_t)(b * 128 + cx) * 128]; }
#pragma unroll
          for (int k = 0; k < 16; ++k) {
            const int cx = d == 0 ? k0 + k : 127 - (k0 + k);
            *(unsigned*)(SAg + (size_t)(b * 128 + cx) * SA_LD) = pg8::cvt_pk_bf16(hr, hi);
            const float nr = pr * hr - pi * hi + sv[k][0], ni = pr * hi + pi * hr + sv[k][1]; hr = nr; hi = ni;
          }
        }
      }
    }
  }
  xcd_barrier(xbar);

  {
    pg8::Gemm g{(const bf16_t*)WSP(WS_SA), (const bf16_t*)WSP(WS_BTY), 0, 0, 768, SA_LD, 768};
    GroupSched S; S.init(32, 2, 2, (long)SA_ROWS * SA_LD * 2, (long)256 * SA_LD * 2, (long)512 * 768 * 2, (long)256 * 768 * 2, (int)gridDim.x, (int)blockIdx.x);
    EpiY E{(bf16_t*)WSP(WS_YG)};
    pg8::gemm_phase<EpiY, GroupSched, true, true>((PG8_LAS unsigned char*)lds, g, S, E);
  }
  {
    pg8::Gemm g{(const bf16_t*)WSP(WS_ATT), (const bf16_t*)WSP(WS_WAU), MX, 1024, 1024, 1024, 1024};
    pg8::StaticOrder S; S.init(MX, 1024, (int)gridDim.x, (int)blockIdx.x, g.lda, g.ldb);
    EpiBf8<1> E{(bf16_t*)WSP(WS_M), 1024, (const bf16_t*)WSP(WS_G), 2048, nullptr};
    pg8::gemm_phase<EpiBf8<1>, pg8::StaticOrder, true, true>((PG8_LAS unsigned char*)lds, g, S, E);
  }
  xcd_barrier(xbar);

  {
    pg8::Gemm g{(const bf16_t*)WSP(WS_YG), (const bf16_t*)WSP(WS_WGLU), MX, 512, 512, 512, 512};
    pg8::StaticOrder S; S.init(MX, 512, (int)gridDim.x, (int)blockIdx.x, g.lda, g.ldb);
    EpiBf8<0> E{(bf16_t*)WSP(WS_SSMX), 512, (const bf16_t*)WSP(WS_YG), 512, INP(24)};
    pg8::gemm_phase<EpiBf8<0>, pg8::StaticOrder, true, true>((PG8_LAS unsigned char*)lds, g, S, E);
  }
  xcd_barrier(xbar);

  {
    pg8::Gemm g{(const bf16_t*)WSP(WS_SSMX), (const bf16_t*)WSP(WS_WSU), MX, 1024, 512, 512, 512};
    pg8::StaticOrder S; S.init(MX, 1024, (int)gridDim.x, (int)blockIdx.x, g.lda, g.ldb);
    EpiBf8<2> E{(bf16_t*)WSP(WS_M), 1024, (const bf16_t*)WSP(WS_G) + 1024, 2048, nullptr};
    pg8::gemm_phase<EpiBf8<2>, pg8::StaticOrder, true, true>((PG8_LAS unsigned char*)lds, g, S, E);
  }
  xcd_barrier(xbar);
  {
    pg8::Gemm g{(const bf16_t*)WSP(WS_M), (const bf16_t*)WSP(WS_WOUT), MX, 1024, 1024, 1024, 1024};
    pg8::StaticOrder S; S.init(MX, 1024, (int)gridDim.x, (int)blockIdx.x, g.lda, g.ldb);
    EpiF32<1> E{(float*)WSP(WS_X1), INP(0), (const float*)WSP(WS_MOD)};
    pg8::gemm_phase<EpiF32<1>, pg8::StaticOrder, true, true>((PG8_LAS unsigned char*)lds, g, S, E);
  }
  xcd_barrier(xbar);
  {
    PHASE_LOCALS
    const float* X1 = (const float*)WSP(WS_X1); const float* MOD = (const float*)WSP(WS_MOD); bf16_t* XN2 = (bf16_t*)WSP(WS_XN2); const float* norm2_g = INP(7);
    for (int row = gw; row < MX; row += ngw) {
      const float* src = X1 + (size_t)row * D; const float* md = MOD + (row / L) * 6144;
      f32x4 v[4]; float ss = 0.f;
#pragma unroll
      for (int j = 0; j < 4; ++j) { v[j] = *(const f32x4*)(src + lane * 4 + 256 * j); ss += v[j][0] * v[j][0] + v[j][1] * v[j][1] + v[j][2] * v[j][2] + v[j][3] * v[j][3]; }
      const float rstd = rsqrtf(wave_sum(ss) * (1.f / D) + 1e-6f);
#pragma unroll
      for (int j = 0; j < 4; ++j)
#pragma unroll
        for (int e = 0; e < 4; ++e) { const int col = lane * 4 + 256 * j + e; XN2[(size_t)row * D + col] = f2bf(v[j][e] * rstd * norm2_g[col] * (1.f + md[4096 + col]) + md[3072 + col]); }
    }
    slice_table_fp8(INP(30), (unsigned char*)WSP(WS_U8), 32.f, gtid, gsz);
    {
      const float* wq = INP(27); const float* sk1 = INP(28); const float* sk2 = INP(29); bf16_t* WC = (bf16_t*)WSP(WS_WC);
      float* skl = fl; float* wql = fl + 128 * 65;
      for (int tile = blockIdx.x; tile < 16 * 16; tile += gridDim.x) {
        const int hs = tile >> 4, d0 = (tile & 15) * 64, h = hs >> 1, s = hs & 1;
        __syncthreads();
        const float* skp = s ? sk2 : sk1;
        for (int i = tid; i < 128 * 16; i += NT) { const int k = i >> 4, e4 = (i & 15) * 4; const f32x4 v = *(const f32x4*)(skp + k * 64 + e4); skl[k * 65 + e4] = v[0]; skl[k * 65 + e4 + 1] = v[1]; skl[k * 65 + e4 + 2] = v[2]; skl[k * 65 + e4 + 3] = v[3]; }
        for (int i = tid; i < 64 * 16; i += NT) { const int dd = i >> 4, e4 = (i & 15) * 4; const f32x4 v = *(const f32x4*)(wq + (size_t)(d0 + dd) * 1024 + h * 128 + s * 64 + e4); wql[dd * 65 + e4] = v[0]; wql[dd * 65 + e4 + 1] = v[1]; wql[dd * 65 + e4 + 2] = v[2]; wql[dd * 65 + e4 + 3] = v[3]; }
        __syncthreads();
        const int k = tid & 127, dgp = tid >> 7;
        float a[16];
#pragma unroll
        for (int q = 0; q < 16; ++q) a[q] = 0.f;
        for (int e = 0; e < 64; ++e) {
          const float sv = skl[k * 65 + e];
#pragma unroll
          for (int q = 0; q < 16; ++q) a[q] += sv * wql[(dgp * 16 + q) * 65 + e];
        }
        u32x4 w0, w1;
        w0.x = pg8::cvt_pk_bf16(a[0], a[1]); w0.y = pg8::cvt_pk_bf16(a[2], a[3]); w0.z = pg8::cvt_pk_bf16(a[4], a[5]); w0.w = pg8::cvt_pk_bf16(a[6], a[7]);
        w1.x = pg8::cvt_pk_bf16(a[8], a[9]); w1.y = pg8::cvt_pk_bf16(a[10], a[11]); w1.z = pg8::cvt_pk_bf16(a[12], a[13]); w1.w = pg8::cvt_pk_bf16(a[14], a[15]);
        bf16_t* dst = WC + (size_t)(h * 256 + s * 128 + k) * 1024 + d0 + dgp * 16;
        *(u32x4*)dst = w0; *(u32x4*)(dst + 8) = w1;
      }
      __syncthreads();
    }
  }
  xcd_barrier(xbar);
  {
    pg8::Gemm g{(const bf16_t*)WSP(WS_XN2), (const bf16_t*)WSP(WS_WC), MX, 2048, 1024, 1024, 1024};
    EpiTopK E{(unsigned short*)WSP(WS_IDX), (float*)WSP(WS_GATE)};
    const int nrounds = (64 * 8 + (int)gridDim.x - 1) / (int)gridDim.x;
    for (int rd = 0; rd < nrounds; ++rd) {
      OneUnitSched S; S.nM = 64; S.nN = 8; S.G = (int)gridDim.x; S.c = (int)blockIdx.x; S.round = rd; S.tsA = (long)256 * 1024 * 2; S.tsB = (long)256 * 1024 * 2;
      pg8::gemm_phase<EpiTopK, OneUnitSched, false, true>((PG8_LAS unsigned char*)lds, g, S, E);
    }
  }
  xcd_barrier(xbar);
  {
    PHASE_LOCALS
    const bf16_t* XN2 = (const bf16_t*)WSP(WS_XN2); const unsigned short* EXT = (const unsigned short*)WSP(WS_IDX);
    bf16_t* PD = (bf16_t*)WSP(WS_PD);
    const bool sl = (gridDim.x & 7) == 0;
    const int widu = __builtin_amdgcn_readfirstlane(wid);
    const int j0 = sl ? (int)(blockIdx.x & 7) : 0, nj = sl ? 1 : 8;
    const int wk = sl ? (int)(blockIdx.x >> 3) * 8 + widu : (int)blockIdx.x * (NT / 64) + widu, nwk = sl ? (int)(gridDim.x >> 3) * 8 : ngw;
    const int eg = lane >> 3, li = lane & 7;
    for (int jj = 0; jj < nj; ++jj) {
      const int j = j0 + jj;
      const unsigned char* U8j = (const unsigned char*)WSP(WS_U8) + (size_t)j * 16384 * 128 + li * 16;
      for (int t = wk; t < MX; t += nwk) {
        const u32x4* xp = (const u32x4*)(XN2 + (size_t)t * 1024 + j * 128 + li * 16);
        const u32x4 xa = xp[0], xb = xp[1];
        const u32x4* ep = (const u32x4*)(EXT + (size_t)t * 128 + eg * 16);
        const u32x4 e0 = ep[0], e1 = ep[1];
        const unsigned ew[8] = {e0.x, e0.y, e0.z, e0.w, e1.x, e1.y, e1.z, e1.w};
        u32x4 uw[16];
#pragma unroll
        for (int k = 0; k < 16; ++k) { const unsigned ex = (k & 1) ? (ew[k >> 1] >> 16) : (ew[k >> 1] & 0xffffu); uw[k] = *(const u32x4*)(U8j + ex * 128u); }
        const unsigned xwd[8] = {xa.x, xa.y, xa.z, xa.w, xb.x, xb.y, xb.z, xb.w};
        f32x2_t xf[8];
#pragma unroll
        for (int q = 0; q < 8; ++q) xf[q] = (f32x2_t){bflo(xwd[q]), bfhi(xwd[q])};
        float keep_lo = 0.f, keep_hi = 0.f;
#pragma unroll
        for (int k = 0; k < 16; ++k) {
          const unsigned uu[4] = {uw[k].x, uw[k].y, uw[k].z, uw[k].w};
          f32x2_t s2 = {0.f, 0.f};
#pragma unroll
          for (int q = 0; q < 4; ++q) { s2 += __builtin_amdgcn_cvt_pk_f32_fp8((int)uu[q], false) * xf[2 * q]; s2 += __builtin_amdgcn_cvt_pk_f32_fp8((int)uu[q], true) * xf[2 * q + 1]; }
          float dp = s2.x + s2.y;
          dp = dpp_add<0xB1>(dp); dp = dpp_add<0x4E>(dp); dp = dpp_add<0x141>(dp);
          if (li == (k & 7)) { if (k < 8) keep_lo = dp; else keep_hi = dp; }
        }
        bf16_t* pd = PD + ((size_t)t * 128 + eg * 16 + li) * 8 + j;
        pd[0] = f2bf(keep_lo * (1.f / 32.f)); pd[8 * 8] = f2bf(keep_hi * (1.f / 32.f));
      }
    }
    slice_table_fp8(INP(31), (unsigned char*)WSP(WS_V8), 1.f, gtid, gsz);
  }
  xcd_barrier(xbar);
  {
    PHASE_LOCALS
    const bf16_t* PD = (const bf16_t*)WSP(WS_PD); const float* GATE = (const float*)WSP(WS_GATE); unsigned* CFP = (unsigned*)WSP(WS_CFP);
    for (int t = gw; t < MX; t += ngw) {
      const u32x4* pp = (const u32x4*)(PD + ((size_t)t * 128 + 2 * lane) * 8);
      const u32x4 pa = pp[0], pb = pp[1];
      const f32x2_t g2 = *(const f32x2_t*)(GATE + (size_t)t * 128 + 2 * lane);
      const float p0 = ((bflo(pa.x) + bfhi(pa.x)) + (bflo(pa.y) + bfhi(pa.y))) + ((bflo(pa.z) + bfhi(pa.z)) + (bflo(pa.w) + bfhi(pa.w)));
      const float p1 = ((bflo(pb.x) + bfhi(pb.x)) + (bflo(pb.y) + bfhi(pb.y))) + ((bflo(pb.z) + bfhi(pb.z)) + (bflo(pb.w) + bfhi(pb.w)));
      CFP[(size_t)t * 64 + lane] = pg8::cvt_pk_bf16(g2.x * gelu_tanh(p0), g2.y * gelu_tanh(p1));
    }
  }
  xcd_barrier(xbar);
  {
    PHASE_LOCALS
    const float* X1 = (const float*)WSP(WS_X1); const float* MOD = (const float*)WSP(WS_MOD);
    const unsigned short* EXT = (const unsigned short*)WSP(WS_IDX); const unsigned* CFP = (const unsigned*)WSP(WS_CFP);
    float* SSQ = (float*)WSP(WS_SSQ); float* out = GPTR(float, ldptr_(33));
    const bool sl = (gridDim.x & 7) == 0;
    const int widu = __builtin_amdgcn_readfirstlane(wid);
    const int j0 = sl ? (int)(blockIdx.x & 7) : 0, nj = sl ? 1 : 8;
    const int wk = sl ? (int)(blockIdx.x >> 3) * 8 + widu : (int)blockIdx.x * (NT / 64) + widu, nwk = sl ? (int)(gridDim.x >> 3) * 8 : ngw;
    const int eg = lane >> 3, li = lane & 7;
    float* red = fl + widu * 1024;
    for (int jj = 0; jj < nj; ++jj) {
      const int j = j0 + jj;
      const unsigned char* V8j = (const unsigned char*)WSP(WS_V8) + (size_t)j * 16384 * 128 + li * 16;
      for (int t = wk; t < MX; t += nwk) {
        const u32x4* ep = (const u32x4*)(EXT + (size_t)t * 128 + eg * 16);
        const u32x4 e0 = ep[0], e1 = ep[1];
        const u32x4* cp = (const u32x4*)(CFP + (size_t)t * 64 + eg * 8);
        const u32x4 c0 = cp[0], c1 = cp[1];
        const int col = j * 128 + 2 * lane;
        const f32x2_t xr = *(const f32x2_t*)(X1 + (size_t)t * 1024 + col);
        const f32x2_t gr = *(const f32x2_t*)(MOD + (t >> 12) * 6144 + 5120 + col);
        const unsigned ew[8] = {e0.x, e0.y, e0.z, e0.w, e1.x, e1.y, e1.z, e1.w};
        const unsigned cfp[8] = {c0.x, c0.y, c0.z, c0.w, c1.x, c1.y, c1.z, c1.w};
        u32x4 vw[16];
#pragma unroll
        for (int k = 0; k < 16; ++k) { const unsigned ex = (k & 1) ? (ew[k >> 1] >> 16) : (ew[k >> 1] & 0xffffu); vw[k] = *(const u32x4*)(V8j + ex * 128u); }
        f32x2_t a[8];
#pragma unroll
        for (int q = 0; q < 8; ++q) a[q] = (f32x2_t){0.f, 0.f};
#pragma unroll
        for (int k = 0; k < 16; ++k) {
          const unsigned cf2 = cfp[k >> 1]; const float cf = (k & 1) ? bfhi(cf2) : bflo(cf2);
          const unsigned vv[4] = {vw[k].x, vw[k].y, vw[k].z, vw[k].w};
#pragma unroll
          for (int q = 0; q < 4; ++q) { a[2 * q] += __builtin_amdgcn_cvt_pk_f32_fp8((int)vv[q], false) * cf; a[2 * q + 1] += __builtin_amdgcn_cvt_pk_f32_fp8((int)vv[q], true) * cf; }
        }
#pragma unroll
        for (int q = 0; q < 4; ++q) *(f32x4*)(red + eg * 128 + li * 16 + q * 4) = (f32x4){a[2 * q].x, a[2 * q].y, a[2 * q + 1].x, a[2 * q + 1].y};
        asm volatile("s_waitcnt lgkmcnt(0)" ::: "memory");
        f32x2_t acc = {0.f, 0.f};
#pragma unroll
        for (int g = 0; g < 8; ++g) acc += *(const f32x2_t*)(red + g * 128 + 2 * lane);
        asm volatile("s_waitcnt lgkmcnt(0)" ::: "memory");
        const f32x2_t o2 = xr + gr * acc;
        float ss = o2.x * o2.x + o2.y * o2.y;
        ss = wave_sum(ss);
        *(f32x2_t*)(out + (size_t)t * 1024 + col) = o2;
        if (lane == 0) SSQ[(size_t)t * 8 + j] = ss;
      }
    }
  }
  xcd_barrier(xbar);
  {
    PHASE_LOCALS
    const float* SSQ = (const float*)WSP(WS_SSQ); const float* fng = INP(32); float* out = GPTR(float, ldptr_(33));
    for (int row = gw; row < MX; row += ngw) {
      const f32x4 sa = *(const f32x4*)(SSQ + (size_t)row * 8), sb = *(const f32x4*)(SSQ + (size_t)row * 8 + 4);
      const float rstd = rsqrtf(((sa[0] + sa[1]) + (sa[2] + sa[3]) + (sb[0] + sb[1]) + (sb[2] + sb[3])) * (1.f / D) + 1e-6f);
#pragma unroll
      for (int jq = 0; jq < 4; ++jq) {
        float* op = out + (size_t)row * D + lane * 4 + 256 * jq;
        const f32x4 v = *(const f32x4*)op, g4 = *(const f32x4*)(fng + lane * 4 + 256 * jq);
        *(f32x4*)op = v * rstd * g4;
      }
    }
  }
}

extern "C" void kernel_launch(void* const* d_in, const int* in_sizes, int n_in, void* d_out, int out_size, void* d_ws, size_t ws_size, hipStream_t stream) {
  static int grid_blocks = 0;
  if (!grid_blocks) {
    int dev = 0, cus = 0, per_cu = 0;
    (void)hipGetDevice(&dev);
    (void)hipDeviceGetAttribute(&cus, hipDeviceAttributeMultiprocessorCount, dev);
    (void)hipFuncSetAttribute((const void*)mega, hipFuncAttributeMaxDynamicSharedMemorySize, LDS_BYTES);
    (void)hipOccupancyMaxActiveBlocksPerMultiprocessor(&per_cu, (const void*)mega, NT, LDS_BYTES);
    if (per_cu < 1) per_cu = 1;
    grid_blocks = cus * per_cu;
    if (n_in != 33 || ws_size < 255 * MiB) { fprintf(stderr, "kernel_launch: unexpected n_in %d / ws %zu\n", n_in, ws_size); }
  }
  Params p{};
  for (int i = 0; i < 33 && i < n_in; ++i) p.in[i] = (const float*)d_in[i];
  p.out = (float*)d_out; p.ws = (unsigned char*)d_ws;
  void* args[] = {&p};
  hipError_t e = hipLaunchCooperativeKernel((const void*)mega, dim3(grid_blocks), dim3(NT), args, LDS_BYTES, stream);
  if (e != hipSuccess) fprintf(stderr, "cooperative launch failed: %s (grid %d)\n", hipGetErrorString(e), grid_blocks);
}
```

```cpp
#include <hip/hip_runtime.h>
#include <hip/hip_cooperative_groups.h>
#include <cstdio>
#include <cstdint>
namespace cg = cooperative_groups;

typedef unsigned short bf16_t;
typedef float f32x4 __attribute__((ext_vector_type(4)));

constexpr int NT = 512;
constexpr int LDS_BYTES = 147456;
constexpr int Bn = 4, L = 4096, D = 1024, NCTX = 256, LA = L + NCTX;
constexpr int MX = Bn * L, MC = Bn * NCTX;
constexpr int N_IN = 5632;
constexpr size_t MiB = 1u << 20;
constexpr size_t WS_MOD = 0, WS_LAM = 128 * 1024, WS_ROPE = 136 * 1024, WS_ARDT = 144 * 1024, WS_AIDT = 160 * 1024;
constexpr size_t WS_ABRE = 192 * 1024, WS_ABIM = 224 * 1024, WS_BBRE = 256 * 1024, WS_BBIM = 512 * 1024;
constexpr size_t WS_BAR = 1 * MiB;
constexpr size_t WS_KT = 2 * MiB;
constexpr size_t WS_XN = 4 * MiB, WS_Q = 38 * MiB, WS_K = 70 * MiB, WS_V = 104 * MiB, WS_SA = 138 * MiB, WS_G = 164 * MiB;
constexpr size_t WS_WIN = 228 * MiB, WS_WAU = 239 * MiB, WS_WSU = 241 * MiB, WS_WOUT = 242 * MiB, WS_WQ = 244 * MiB, WS_WGLU = 246 * MiB;
constexpr size_t WS_BTS = 247 * MiB;
constexpr size_t WS_BTY = 38 * MiB, WS_S = 62 * MiB, WS_YG = 79 * MiB, WS_SSMX = 62 * MiB, WS_M = 95 * MiB;
constexpr size_t WS_ATT = WS_XN, WS_X1 = 4 * MiB, WS_XN2 = 68 * MiB, WS_QP = WS_G;
constexpr size_t WS_IDX = 111 * MiB, WS_GATE = 115 * MiB, WS_SSQ = 123 * MiB;
constexpr size_t WS_U8 = 127 * MiB, WS_PD = 164 * MiB, WS_V8 = 196 * MiB, WS_WC = 160 * MiB, WS_CFP = 160 * MiB;
constexpr int SA_ROWS = 544, SA_LD = 768;

constexpr int PTR_OFF = LDS_BYTES - 1024;
__device__ __forceinline__ unsigned long long ldptr_(int k) {
  extern __shared__ __attribute__((aligned(16))) unsigned char lds_[];
  const unsigned long long v = ((const unsigned long long*)(lds_ + PTR_OFF))[k];
  const unsigned lo = __builtin_amdgcn_readfirstlane((unsigned)v), hi = __builtin_amdgcn_readfirstlane((unsigned)(v >> 32));
  return ((unsigned long long)hi << 32) | lo;
}
#define GPTR(T, v) ((T*)(__attribute__((address_space(1))) T*)(v))
#define INP(k) GPTR(const float, ldptr_(k))
#define WSP(off) GPTR(unsigned char, ldptr_(34) + (off))
#define PHASE_LOCALS \
  int tid = threadIdx.x; asm volatile("" : "+v"(tid)); \
  const int lane = tid & 63, wid = tid >> 6; \
  const int gtid = blockIdx.x * NT + tid, gsz = gridDim.x * NT; \
  const int gw = blockIdx.x * (NT / 64) + wid, ngw = gridDim.x * (NT / 64); \
  float* fl = (float*)lds; (void)lane; (void)wid; (void)gtid; (void)gsz; (void)gw; (void)ngw; (void)fl;

struct Params {
  const float* in[33];
  float* out;
  unsigned char* ws;
  int pad0, pad1;
};

__device__ __forceinline__ float bf2f(bf16_t v) { return __uint_as_float(((unsigned)v) << 16); }
__device__ __forceinline__ bf16_t f2bf(float f) { unsigned u = __float_as_uint(f); return (bf16_t)((u + 0x7fffu + ((u >> 16) & 1u)) >> 16); }
__device__ __forceinline__ float wave_sum(float v) {
#pragma unroll
  for (int o = 32; o; o >>= 1) v += __shfl_xor(v, o);
  return v;
}
__device__ __forceinline__ float gelu_tanh(float x) { const float u2 = -2.302208198f * (x + 0.044715f * x * x * x); return x * __builtin_amdgcn_rcpf(1.f + __builtin_amdgcn_exp2f(u2)); }
__device__ __forceinline__ float sigmoidf_(float x) { return __builtin_amdgcn_rcpf(1.f + __builtin_amdgcn_exp2f(-1.4426950408889634f * x)); }
__device__ __forceinline__ float siluf_(float x) { return x / (1.f + __expf(-x)); }

template <class Epi>
__device__ __forceinline__ void sgemm(const bf16_t* A, int lda, const float* Bm, int ldb, int M, int N, int K, float* lds, Epi epi) {
  constexpr int TM = 128, TN = 128, TK = 16, LDA_S = TM + 4, LDB_S = TN + 4;
  float* As = lds;
  float* Bs = lds + TK * LDA_S;
  const int tid = threadIdx.x, ty = tid >> 4, tx = tid & 15;
  const int ntm = M / TM, ntn = N / TN;
  for (int tile = blockIdx.x; tile < ntm * ntn; tile += gridDim.x) {
    const int tm = tile / ntn, tn = tile % ntn;
    float acc[4][8];
#pragma unroll
    for (int i = 0; i < 4; ++i)
#pragma unroll
      for (int j = 0; j < 8; ++j) acc[i][j] = 0.f;
    const int ar = tid >> 2, ak = (tid & 3) * 4;
    const int bk = tid >> 5, bn = (tid & 31) * 4;
    for (int k0 = 0; k0 < K; k0 += TK) {
      const bf16_t* ap = A + (size_t)(tm * TM + ar) * lda + k0 + ak;
      const unsigned long long av = *(const unsigned long long*)ap;
      const f32x4 bv = *(const f32x4*)(Bm + (size_t)(k0 + bk) * ldb + tn * TN + bn);
      __syncthreads();
      As[(ak + 0) * LDA_S + ar] = bf2f((bf16_t)(av & 0xffff));
      As[(ak + 1) * LDA_S + ar] = bf2f((bf16_t)((av >> 16) & 0xffff));
      As[(ak + 2) * LDA_S + ar] = bf2f((bf16_t)((av >> 32) & 0xffff));
      As[(ak + 3) * LDA_S + ar] = bf2f((bf16_t)((av >> 48) & 0xffff));
      *(f32x4*)(Bs + bk * LDB_S + bn) = bv;
      __syncthreads();
#pragma unroll
      for (int k = 0; k < TK; ++k) {
        const f32x4 a4 = *(const f32x4*)(As + k * LDA_S + ty * 4);
        const f32x4 b0 = *(const f32x4*)(Bs + k * LDB_S + tx * 8);
        const f32x4 b1 = *(const f32x4*)(Bs + k * LDB_S + tx * 8 + 4);
#pragma unroll
        for (int i = 0; i < 4; ++i) {
          acc[i][0] += a4[i] * b0[0]; acc[i][1] += a4[i] * b0[1]; acc[i][2] += a4[i] * b0[2]; acc[i][3] += a4[i] * b0[3];
          acc[i][4] += a4[i] * b1[0]; acc[i][5] += a4[i] * b1[1]; acc[i][6] += a4[i] * b1[2]; acc[i][7] += a4[i] * b1[3];
        }
      }
    }
#pragma unroll
    for (int i = 0; i < 4; ++i)
#pragma unroll
      for (int j = 0; j < 8; ++j) epi(tm * TM + ty * 4 + i, tn * TN + tx * 8 + j, acc[i][j]);
  }
  __syncthreads();
}

namespace pg8 {
#define PG8_LAS __attribute__((address_space(3)))
typedef unsigned short bf16_t;
typedef short bf16x8 __attribute__((ext_vector_type(8)));
typedef float f32x4 __attribute__((ext_vector_type(4)));
typedef unsigned u32x4 __attribute__((ext_vector_type(4)));
constexpr int BM = 256, BK = 64, HALF = 128, HTB = HALF * BK * 2  , STAGE_BYTES = 8 * HTB, NXCD = 8, WGM = 8;

__host__ __device__ __forceinline__ int lds_byte(int r, int c) { const int st = (r >> 4) * 2 + (c >> 5), rr = r & 15, cc = c & 31, ob = rr * 64 + cc * 2; return st * 1024 + (ob ^ (((ob >> 9) & 1) << 5)); }
__host__ __device__ __forceinline__ void stage_rc(int b, int& R, int& C) { const int st = b / 1024, sb = b % 1024, swz = sb ^ (((sb >> 9) & 1) << 5); R = (st >> 1) * 16 + swz / 64; C = (st & 1) * 32 + (swz % 64) / 2; }
__host__ __device__ __forceinline__ int perm32(int rho) { const int n = rho >> 4, i = rho & 15; return 8 * (i >> 2) + 4 * n + (i & 3); }

struct Unit { int pm, pn, grp; long ao, bo; };
struct Gemm { const bf16_t* A; const bf16_t* Bt; int M, N, K, lda, ldb; };

struct StaticOrder {
    int nM, nN, nwg, G, c; long tsA, tsB;
    __host__ __device__ void init(int M, int N, int G_, int c_, int lda, int ldb) { nM = M / BM; nN = N / BM; nwg = nM * nN; G = G_; c = c_; tsA = (long)BM * lda * 2; tsB = (long)BM * ldb * 2; }
    __host__ __device__ bool next(int i, Unit& u) const {
        const long L = (long)i * G + c; if (L >= nwg) return false;
        int wgid = (int)L; { const int q = nwg / NXCD, r = nwg % NXCD, xcd = wgid % NXCD, off = wgid / NXCD; wgid = (xcd < r ? xcd * (q + 1) : r * (q + 1) + (xcd - r) * q) + off; }
        const int nig = WGM * nN, gid = wgid / nig, fm = gid * WGM, gsz = (nM - fm) < WGM ? (nM - fm) : WGM;
        u.pm = fm + ((wgid % nig) % gsz); u.pn = (wgid % nig) / gsz; u.grp = 0; u.ao = u.pm * tsA; u.bo = u.pn * tsB; return true;
    }
    __device__ __forceinline__ void a_ready(const Unit&) const {}
    __device__ __forceinline__ void done(const Unit&) const {}
};

__device__ __forceinline__ unsigned cvt_pk_bf16(float lo, float hi) { unsigned r; asm volatile("v_cvt_pk_bf16_f32 %0, %1, %2" : "=v"(r) : "v"(lo), "v"(hi)); return r; }
template <class Epi, class Sched, bool ALIGN_EPI = false, bool SP2 = false>
__device__ __forceinline__ void gemm_phase(PG8_LAS unsigned char* lds, const Gemm g, const Sched& S, const Epi& E) {
    int tid_ = threadIdx.x; asm volatile("" : "+v"(tid_));
    const int tid = tid_, wid = __builtin_amdgcn_readfirstlane(tid >> 6), lane = tid & 63, wr = wid >> 2, wc = wid & 3, fr = lane & 15, fq = lane >> 4;
    const int K = g.K, nt = K / BK;
    unsigned voffA[2], voffB[2];
#pragma unroll
    for (int i = 0; i < 2; ++i) { int R, C; stage_rc(tid * 16 + i * 8192, R, C); const int Rb = Epi::PERM ? ((R & ~31) + perm32(R & 31)) : R;
        voffA[i] = (unsigned)(R * g.lda + C) * 2u; voffB[i] = (unsigned)(Rb * g.ldb + C) * 2u; }
    const size_t kstep = (size_t)(BK * 2);
    const size_t hstepA = (size_t)HALF * g.lda * 2, hstepB = (size_t)HALF * g.ldb * 2;
    const unsigned ldsw = (unsigned)wid * 1024u;
    const int aoff = lds_byte(wr * 64 + fr, fq * 8), boff = lds_byte(wc * 32 + fr, fq * 8);
#define PG8_SA(b, h) (((b) * 2 + (h)) * HTB)
#define PG8_SB(b, h) ((4 + (b) * 2 + (h)) * HTB)
#define PG8_STAGE(bufoff, gbase, voff) do { _Pragma("unroll") for (int _i = 0; _i < 2; ++_i) \
        __builtin_amdgcn_global_load_lds((const unsigned*)((const char*)(gbase) + (voff)[_i]), (PG8_LAS unsigned*)(lds + (bufoff) + ldsw + _i * 8192), 16, 0, 0); } while (0)
#define PG8_LDA(dst, b, h) do { _Pragma("unroll") for (int m = 0; m < 4; ++m) _Pragma("unroll") for (int k = 0; k < 2; ++k) dst[m][k] = *(const PG8_LAS bf16x8*)(lds + PG8_SA(b, h) + aoff + m * 2048 + k * 1024); } while (0)
#define PG8_LDB(dst, b, h) do { _Pragma("unroll") for (int n = 0; n < 2; ++n) _Pragma("unroll") for (int k = 0; k < 2; ++k) dst[n][k] = *(const PG8_LAS bf16x8*)(lds + PG8_SB(b, h) + boff + n * 2048 + k * 1024); } while (0)
#define PG8_MMA(ai, bj, At, Bt) do { __builtin_amdgcn_s_setprio(1); _Pragma("unroll") for (int m = 0; m < 4; ++m) _Pragma("unroll") for (int n = 0; n < 2; ++n) _Pragma("unroll") for (int k = 0; k < 2; ++k) \
        acc[ai][bj][m][n] = __builtin_amdgcn_mfma_f32_16x16x32_bf16(Bt[n][k], At[m][k], acc[ai][bj][m][n], 0, 0, 0); __builtin_amdgcn_s_setprio(0); } while (0)
#define PG8_WAIT_V(n) asm volatile("s_waitcnt vmcnt(" #n ")" ::: "memory")
#define PG8_WAIT_L(n) asm volatile("s_waitcnt lgkmcnt(" #n ")" ::: "memory")
#define PG8_BAR __builtin_amdgcn_s_barrier()
#define PG8_SCHED __builtin_amdgcn_sched_barrier(0)
    Unit cur, nxt; int ui = 0;
    if (!S.next(0, cur)) return;
    f32x4 acc[2][2][4][2];
#pragma unroll
    for (int a = 0; a < 2; ++a)
#pragma unroll
        for (int b = 0; b < 2; ++b)
#pragma unroll
            for (int m = 0; m < 4; ++m)
#pragma unroll
                for (int n = 0; n < 2; ++n) acc[a][b][m][n] = (f32x4){0.f, 0.f, 0.f, 0.f};
    bf16x8 At[4][2], B0[2][2], B1[2][2];
    const char* cA = (const char*)g.A + cur.ao; const char* cB = (const char*)g.Bt + cur.bo;
    S.a_ready(cur);
    if constexpr (SP2) {
        PG8_STAGE(PG8_SB(0, 0), cB, voffB); PG8_STAGE(PG8_SB(0, 1), cB + hstepB, voffB); PG8_STAGE(PG8_SA(0, 0), cA, voffA); PG8_STAGE(PG8_SA(0, 1), cA + hstepA, voffA);
        if (wr == 1) PG8_BAR;
        PG8_WAIT_V(2); PG8_BAR;
        PG8_STAGE(PG8_SB(1, 0), cB + kstep, voffB); PG8_STAGE(PG8_SA(1, 0), cA + kstep, voffA); PG8_STAGE(PG8_SB(1, 1), cB + hstepB + kstep, voffB);
        PG8_WAIT_V(6); PG8_BAR;
    } else {
        PG8_STAGE(PG8_SB(0, 0), cB, voffB); PG8_STAGE(PG8_SA(0, 0), cA, voffA); PG8_STAGE(PG8_SB(0, 1), cB + hstepB, voffB); PG8_STAGE(PG8_SA(0, 1), cA + hstepA, voffA);
        if (wr == 1) PG8_BAR;
        PG8_WAIT_V(4); PG8_BAR;
        PG8_STAGE(PG8_SB(1, 0), cB + kstep, voffB); PG8_STAGE(PG8_SA(1, 0), cA + kstep, voffA); PG8_STAGE(PG8_SB(1, 1), cB + hstepB + kstep, voffB);
        PG8_WAIT_V(6); PG8_BAR;
    }
    for (;;) {
        const bool has_next = S.next(ui + 1, nxt);
        const char* nA = has_next ? (const char*)g.A + nxt.ao : cA; const char* nB = has_next ? (const char*)g.Bt + nxt.bo : cB;
        for (int t = 0; t < nt; t += 2) {
            const bool last = (t == nt - 2);
            const char* a1 = cA + (size_t)(t + 1) * kstep;
            const char* a2 = last ? nA : cA + (size_t)(t + 2) * kstep; const char* b2 = last ? nB : cB + (size_t)(t + 2) * kstep;
            const char* a3 = a2 + kstep; const char* b3 = b2 + kstep;
            if (last && has_next) S.a_ready(nxt);
            if constexpr (SP2) {
            PG8_LDB(B0, 0, 0); PG8_LDB(B1, 0, 1); PG8_SCHED; PG8_LDA(At, 0, 0); PG8_STAGE(PG8_SA(1, 1), a1 + hstepA, voffA);
            PG8_WAIT_V(8); PG8_WAIT_L(0); PG8_BAR; PG8_MMA(0, 0, At, B0); PG8_MMA(0, 1, At, B1); PG8_BAR; PG8_SCHED;
            PG8_LDA(At, 0, 1); PG8_STAGE(PG8_SB(0, 0), b2, voffB); PG8_STAGE(PG8_SB(0, 1), b2 + hstepB, voffB); PG8_STAGE(PG8_SA(0, 0), a2, voffA);
            PG8_WAIT_V(8); PG8_WAIT_L(0); PG8_BAR; PG8_MMA(1, 0, At, B0); PG8_MMA(1, 1, At, B1); PG8_BAR; PG8_SCHED;
            PG8_LDB(B0, 1, 0); PG8_LDB(B1, 1, 1); PG8_SCHED; PG8_LDA(At, 1, 0); PG8_STAGE(PG8_SA(0, 1), a2 + hstepA, voffA);
            PG8_WAIT_V(8); PG8_WAIT_L(0); PG8_BAR; PG8_MMA(0, 0, At, B0); PG8_MMA(0, 1, At, B1); PG8_BAR; PG8_SCHED;
            PG8_LDA(At, 1, 1); PG8_STAGE(PG8_SB(1, 0), b3, voffB); PG8_STAGE(PG8_SB(1, 1), b3 + hstepB, voffB); PG8_STAGE(PG8_SA(1, 0), a3, voffA);
            PG8_WAIT_V(8); PG8_WAIT_L(0); PG8_BAR; PG8_MMA(1, 0, At, B0); PG8_MMA(1, 1, At, B1); PG8_BAR; PG8_SCHED;
            } else {
            PG8_LDB(B0, 0, 0); PG8_SCHED; PG8_LDA(At, 0, 0); PG8_STAGE(PG8_SA(1, 1), a1 + hstepA, voffA);
            PG8_WAIT_L(8); PG8_BAR; PG8_WAIT_L(0); PG8_MMA(0, 0, At, B0); PG8_BAR; PG8_SCHED;
            PG8_LDB(B1, 0, 1); PG8_STAGE(PG8_SB(0, 0), b2, voffB);
            PG8_BAR; PG8_WAIT_L(0); PG8_MMA(0, 1, At, B1); PG8_BAR;
            PG8_LDA(At, 0, 1); PG8_STAGE(PG8_SA(0, 0), a2, voffA);
            PG8_BAR; PG8_WAIT_L(0); PG8_MMA(1, 0, At, B0); PG8_BAR; PG8_SCHED;
            PG8_STAGE(PG8_SB(0, 1), b2 + hstepB, voffB);
            PG8_WAIT_V(6); PG8_BAR; PG8_MMA(1, 1, At, B1); PG8_BAR;
            PG8_LDB(B0, 1, 0); PG8_SCHED; PG8_LDA(At, 1, 0); PG8_STAGE(PG8_SA(0, 1), a2 + hstepA, voffA);
            PG8_WAIT_L(8); PG8_BAR; PG8_WAIT_L(0); PG8_MMA(0, 0, At, B0); PG8_BAR; PG8_SCHED;
            PG8_LDB(B1, 1, 1); PG8_STAGE(PG8_SB(1, 0), b3, voffB);
            PG8_BAR; PG8_WAIT_L(0); PG8_MMA(0, 1, At, B1); PG8_BAR;
            PG8_LDA(At, 1, 1); PG8_STAGE(PG8_SA(1, 0), a3, voffA);
            PG8_BAR; PG8_WAIT_L(0); PG8_MMA(1, 0, At, B0); PG8_BAR; PG8_SCHED;
            PG8_STAGE(PG8_SB(1, 1), b3 + hstepB, voffB);
            PG8_WAIT_V(6); PG8_BAR; PG8_MMA(1, 1, At, B1); PG8_BAR;
            }
        }
        if constexpr (ALIGN_EPI) { if (wr == 0) PG8_BAR; }
        if constexpr (!Epi::AFTER_DRAIN) { int fr_ = fr, fq_ = fq; asm volatile("" : "+v"(fr_), "+v"(fq_));
            E(acc, cur, wr, wc, fr_, fq_); S.done(cur); }
        if (!has_next) break;
#pragma unroll
        for (int a = 0; a < 2; ++a)
#pragma unroll
            for (int b = 0; b < 2; ++b)
#pragma unroll
                for (int m = 0; m < 4; ++m)
#pragma unroll
                    for (int n = 0; n < 2; ++n) acc[a][b][m][n] = (f32x4){0.f, 0.f, 0.f, 0.f};
        cur = nxt; cA = nA; cB = nB; ++ui;
        if constexpr (ALIGN_EPI) { if (wr == 1) PG8_BAR; }
    }
    PG8_WAIT_V(0);
    if constexpr (!ALIGN_EPI) { if (wr == 0) PG8_BAR; }
    PG8_BAR;
    if constexpr (Epi::AFTER_DRAIN) { int fr_ = fr, fq_ = fq, lane_ = lane; asm volatile("" : "+v"(fr_), "+v"(fq_), "+v"(lane_)); E.fused(acc, cur, wr, wc, fr_, fq_, lds, wid, lane_); S.done(cur); }
#undef PG8_SA
#undef PG8_SB
#undef PG8_STAGE
#undef PG8_LDA
#undef PG8_LDB
#undef PG8_MMA
#undef PG8_WAIT_V
#undef PG8_WAIT_L
#undef PG8_BAR
#undef PG8_SCHED
}
}


using pg8::Unit;
typedef unsigned u32x2 __attribute__((ext_vector_type(2)));
typedef unsigned u32x4 __attribute__((ext_vector_type(4)));
__device__ __forceinline__ float bflo(unsigned w) { return __uint_as_float(w << 16); }
__device__ __forceinline__ float bfhi(unsigned w) { return __uint_as_float(w & 0xffff0000u); }

struct InProjSched {
  pg8::StaticOrder so;
  __device__ __forceinline__ void init(int G, int c) { so.init(MX, N_IN, G, c, D, D); }
  __device__ __forceinline__ bool next(int i, Unit& u) const {
    const long Lx = (long)i * so.G + so.c;
    if (Lx < so.nwg) return so.next(i, u);
    const int j = (int)(Lx - so.nwg); if (j >= 40) return false;
    u.pm = 64 + (j & 3); u.pn = 4 + (j >> 2); u.grp = 0; u.ao = u.pm * so.tsA; u.bo = u.pn * so.tsB; return true;
  }
  __device__ __forceinline__ void a_ready(const Unit&) const {}
  __device__ __forceinline__ void done(const Unit&) const {}
};

struct EpiInProj {
  static constexpr bool PERM = true, AFTER_DRAIN = false;
  bf16_t *Q, *K, *V, *SA, *G; const float* rope;
  __device__ __forceinline__ static void st8(bf16_t* p, const f32x4 a, const f32x4 b) {
    u32x4 w; w.x = pg8::cvt_pk_bf16(a[0], a[1]); w.y = pg8::cvt_pk_bf16(a[2], a[3]); w.z = pg8::cvt_pk_bf16(b[0], b[1]); w.w = pg8::cvt_pk_bf16(b[2], b[3]); *(u32x4*)p = w; }
  __device__ __forceinline__ static f32x4 partner4(const f32x4 v, const bool upper) {
    f32x4 r;
#pragma unroll
    for (int i = 0; i < 4; ++i) { auto rr = __builtin_amdgcn_permlane32_swap(__float_as_uint(v[i]), __float_as_uint(v[i]), false, false); r[i] = __uint_as_float(upper ? rr[0] : rr[1]); }
    return r;
  }
  __device__ __forceinline__ void operator()(const f32x4 (&acc)[2][2][4][2], const Unit& u, int wr, int wc, int fr, int fq) const {
    const int row0 = u.pm * 256 + wr * 64 + fr;
    const int cg0 = u.pn * 256 + wc * 32 + fq * 8;
    if (u.pm < 64) {
      if (u.pn < 8) {
        const bool isq = u.pn < 4; const float qsc = isq ? 0.125f * 1.4426950408889634f : 1.f;
        const bool upper = fq >= 2; const float sgn = upper ? 1.f : -1.f;
#pragma unroll
        for (int ai = 0; ai < 2; ++ai)
#pragma unroll
          for (int m = 0; m < 4; ++m) {
            const int row = row0 + ai * 128 + m * 16, b = row >> 12, t = row & 4095;
            const int pos = (wc & 1) ? (t & 63) : (t >> 6);
            const f32x4* rp = (const f32x4*)(rope + (pos * 16 + (fq & 1) * 8) * 2);
            const f32x4 r0 = rp[0], r1 = rp[1], r2 = rp[2], r3 = rp[3];
            const f32x4 cs0 = {r0[0], r0[2], r1[0], r1[2]}, sn0 = {r0[1], r0[3], r1[1], r1[3]}, cs1 = {r2[0], r2[2], r3[0], r3[2]}, sn1 = {r2[1], r2[3], r3[1], r3[3]};
            bf16_t* dst = isq ? Q + (size_t)row * 1024 + cg0 : K + ((size_t)b * LA + NCTX + t) * 1024 + (cg0 - 1024);
#pragma unroll
            for (int bj = 0; bj < 2; ++bj) {
              const f32x4 v0 = acc[ai][bj][m][0], v1 = acc[ai][bj][m][1];
              const f32x4 p0 = partner4(v0, upper), p1 = partner4(v1, upper);
              st8(dst + bj * 128, (v0 * cs0 + p0 * sn0 * sgn) * qsc, (v1 * cs1 + p1 * sn1 * sgn) * qsc);
            }
          }
      } else {
#pragma unroll
        for (int ai = 0; ai < 2; ++ai)
#pragma unroll
          for (int m = 0; m < 4; ++m) {
            const int row = row0 + ai * 128 + m * 16, b = row >> 12, t = row & 4095;
            const size_t kr = (size_t)b * LA + NCTX + t;
            if (u.pn >= 12 && u.pn < 14) {
#pragma unroll
              for (int bj = 0; bj < 2; ++bj) {
                const int ch = cg0 + bj * 128 - 3072;
                st8(SA + ((size_t)(ch >> 4) * SA_ROWS + b * 128 + (t >> 5)) * SA_LD + (t & 31) * 16 + (ch & 15), acc[ai][bj][m][0], acc[ai][bj][m][1]);
              }
            } else {
              bf16_t* dst = u.pn < 12 ? V + kr * 1024 + (cg0 - 2048) : G + (size_t)row * 2048 + (cg0 - 3584);
#pragma unroll
              for (int bj = 0; bj < 2; ++bj) {
                f32x4 v0 = acc[ai][bj][m][0], v1 = acc[ai][bj][m][1];
                if (u.pn >= 14) {
#pragma unroll
                  for (int i = 0; i < 4; ++i) { v0[i] = sigmoidf_(v0[i]); v1[i] = sigmoidf_(v1[i]); }
                }
                st8(dst + bj * 128, v0, v1);
              }
            }
          }
      }
    } else {
#pragma unroll
      for (int ai = 0; ai < 2; ++ai)
#pragma unroll
        for (int m = 0; m < 4; ++m) {
          const int rc = row0 + ai * 128 + m * 16 - MX, b = rc >> 8, t = rc & 255;
          const size_t kr = (size_t)b * LA + t;
          if (u.pn >= 12) {
#pragma unroll
            for (int bj = 0; bj < 2; ++bj) {
              const int ch = cg0 + bj * 128 - 3072;
              st8(SA + ((size_t)(ch >> 4) * SA_ROWS + 512 + b * 8 + (t >> 5)) * SA_LD + (t & 31) * 16 + (ch & 15), acc[ai][bj][m][0], acc[ai][bj][m][1]);
            }
          } else {
            bf16_t* dst = u.pn < 8 ? K + kr * 1024 + (cg0 - 1024) : V + kr * 1024 + (cg0 - 2048);
#pragma unroll
            for (int bj = 0; bj < 2; ++bj) st8(dst + bj * 128, acc[ai][bj][m][0], acc[ai][bj][m][1]);
          }
        }
    }
  }
};
template <int MODE>
struct EpiBf8 {
  static constexpr bool PERM = true, AFTER_DRAIN = false;
  bf16_t* O; int ldo; const bf16_t* X; int ldx; const float* bias;
  __device__ __forceinline__ void operator()(const f32x4 (&acc)[2][2][4][2], const Unit& u, int wr, int wc, int fr, int fq) const {
    const int row0 = u.pm * 256 + wr * 64 + fr, col0 = u.pn * 256 + wc * 32 + 8 * fq;
#pragma unroll
    for (int ai = 0; ai < 2; ++ai)
#pragma unroll
      for (int m = 0; m < 4; ++m) {
        const int row = row0 + ai * 128 + m * 16;
#pragma unroll
        for (int bj = 0; bj < 2; ++bj) {
          const int col = col0 + bj * 128;
          f32x4 v0 = acc[ai][bj][m][0], v1 = acc[ai][bj][m][1];
          const u32x4 xw = *(const u32x4*)(X + (size_t)row * ldx + col);
          const f32x4 x0 = {bflo(xw.x), bfhi(xw.x), bflo(xw.y), bfhi(xw.y)}, x1 = {bflo(xw.z), bfhi(xw.z), bflo(xw.w), bfhi(xw.w)};
          if (MODE == 0) {
            const f32x4 b0 = *(const f32x4*)(bias + col), b1 = *(const f32x4*)(bias + col + 4);
#pragma unroll
            for (int i = 0; i < 4; ++i) { v0[i] = x0[i] * sigmoidf_(v0[i] + b0[i]); v1[i] = x1[i] * sigmoidf_(v1[i] + b1[i]); }
          } else if (MODE == 1) { v0 = v0 * x0; v1 = v1 * x1; }
          else {
            const u32x4 ow = *(const u32x4*)(O + (size_t)row * ldo + col);
            const f32x4 o0 = {bflo(ow.x), bfhi(ow.x), bflo(ow.y), bfhi(ow.y)}, o1 = {bflo(ow.z), bfhi(ow.z), bflo(ow.w), bfhi(ow.w)};
            v0 = o0 + v0 * x0; v1 = o1 + v1 * x1;
          }
          u32x4 w; w.x = pg8::cvt_pk_bf16(v0[0], v0[1]); w.y = pg8::cvt_pk_bf16(v0[2], v0[3]); w.z = pg8::cvt_pk_bf16(v1[0], v1[1]); w.w = pg8::cvt_pk_bf16(v1[2], v1[3]);
          *(u32x4*)(O + (size_t)row * ldo + col) = w;
        }
      }
  }
};
template <int MODE>
struct EpiF32 {
  static constexpr bool PERM = false, AFTER_DRAIN = false;
  float* O; const float* xres; const float* mod;
  __device__ __forceinline__ void operator()(const f32x4 (&acc)[2][2][4][2], const Unit& u, int wr, int wc, int fr, int fq) const {
    const int row0 = u.pm * 256 + wr * 64 + fr, col0 = u.pn * 256 + wc * 32 + 4 * fq;
#pragma unroll
    for (int ai = 0; ai < 2; ++ai)
#pragma unroll
      for (int m = 0; m < 4; ++m) {
        const int row = row0 + ai * 128 + m * 16;
#pragma unroll
        for (int bj = 0; bj < 2; ++bj)
#pragma unroll
          for (int n = 0; n < 2; ++n) {
            const int col = col0 + bj * 128 + n * 16;
            f32x4 v = acc[ai][bj][m][n];
            if (MODE == 1) { const f32x4 xr = *(const f32x4*)(xres + (size_t)row * 1024 + col); const f32x4 g = *(const f32x4*)(mod + (row >> 12) * 6144 + 2048 + col); v = xr + g * v; }
            *(f32x4*)(O + (size_t)row * 1024 + col) = v;
          }
      }
  }
};


struct GroupSched {
  int npm, npn, nunits, G, c; long gsA, gsB, tsA, tsB;
  __device__ __forceinline__ void init(int ngrp, int npm_, int npn_, long gsA_, long tsA_, long gsB_, long tsB_, int G_, int c_) { npm = npm_; npn = npn_; nunits = ngrp * npm_ * npn_; gsA = gsA_; tsA = tsA_; gsB = gsB_; tsB = tsB_; G = G_; c = c_; }
  __device__ __forceinline__ bool next(int i, Unit& u) const {
    const long Lx = (long)i * G + c; if (Lx >= nunits) return false;
    const int per = npm * npn, grp = (int)Lx / per, r = (int)Lx % per;
    u.grp = grp; u.pm = r / npn; u.pn = r % npn; u.ao = grp * gsA + u.pm * tsA; u.bo = grp * gsB + u.pn * tsB; return true;
  }
  __device__ __forceinline__ void a_ready(const Unit&) const {}
  __device__ __forceinline__ void done(const Unit&) const {}
};
struct EpiS {
  static constexpr bool PERM = false, AFTER_DRAIN = false;
  float* S;
  __device__ __forceinline__ void operator()(const f32x4 (&acc)[2][2][4][2], const Unit& u, int wr, int wc, int fr, int fq) const {
    const int row0 = u.pm * 256 + wr * 64 + fr, col0 = wc * 32 + 4 * fq;
#pragma unroll
    for (int ai = 0; ai < 2; ++ai)
#pragma unroll
      for (int m = 0; m < 4; ++m) {
        const int row = row0 + ai * 128 + m * 16;
        if (row < SA_ROWS) {
#pragma unroll
          for (int bj = 0; bj < 2; ++bj)
#pragma unroll
            for (int n = 0; n < 2; ++n) *(f32x4*)(S + ((size_t)u.grp * SA_ROWS + row) * 256 + col0 + bj * 128 + n * 16) = acc[ai][bj][m][n];
        }
      }
  }
};
struct EpiY {
  static constexpr bool PERM = true, AFTER_DRAIN = false;
  bf16_t* YG;
  __device__ __forceinline__ void operator()(const f32x4 (&acc)[2][2][4][2], const Unit& u, int wr, int wc, int fr, int fq) const {
    const int row0 = u.pm * 256 + wr * 64 + fr, col0 = u.pn * 256 + wc * 32 + 8 * fq;
#pragma unroll
    for (int ai = 0; ai < 2; ++ai)
#pragma unroll
      for (int m = 0; m < 4; ++m) {
        const int row = row0 + ai * 128 + m * 16, b = row >> 7, cx = row & 127;
#pragma unroll
        for (int bj = 0; bj < 2; ++bj) {
          const int col = col0 + bj * 128, j = col >> 4, p0 = col & 15;
          const f32x4 v0 = acc[ai][bj][m][0], v1 = acc[ai][bj][m][1];
          u32x4 w; w.x = pg8::cvt_pk_bf16(gelu_tanh(v0[0]), gelu_tanh(v0[1])); w.y = pg8::cvt_pk_bf16(gelu_tanh(v0[2]), gelu_tanh(v0[3]));
          w.z = pg8::cvt_pk_bf16(gelu_tanh(v1[0]), gelu_tanh(v1[1])); w.w = pg8::cvt_pk_bf16(gelu_tanh(v1[2]), gelu_tanh(v1[3]));
          *(u32x4*)(YG + ((size_t)(b * L + cx * 32 + j)) * 512 + u.grp * 16 + p0) = w;
        }
      }
  }
};


__device__ __forceinline__ unsigned f2key(float s) { const unsigned u = __float_as_uint(s); return u ^ ((u & 0x80000000u) ? 0xFFFFFFFFu : 0x80000000u); }
__device__ __forceinline__ float key2f(unsigned k) { return __uint_as_float(k ^ ((k & 0x80000000u) ? 0x80000000u : 0xFFFFFFFFu)); }
#define TK_INSERT(L, cv) do { _Pragma("unroll") for (int k_ = 0; k_ < 16; ++k_) { const unsigned hi_ = L[k_] > cv ? L[k_] : cv, lo_ = L[k_] > cv ? cv : L[k_]; L[k_] = hi_; cv = lo_; } } while (0)
#define TK_CX(X, Y) do { const unsigned hi_ = (X) > (Y) ? (X) : (Y), lo_ = (X) > (Y) ? (Y) : (X); (X) = hi_; (Y) = lo_; } while (0)
#define TK_SORT16(A, B) do { _Pragma("unroll") for (int k_ = 2; k_ <= 16; k_ <<= 1) _Pragma("unroll") for (int j_ = k_ >> 1; j_ > 0; j_ >>= 1) _Pragma("unroll") for (int i_ = 0; i_ < 16; ++i_) { \
    const int l_ = i_ ^ j_; if (l_ > i_) { if ((i_ & k_) == 0) TK_CX(A[(B) + i_], A[(B) + l_]); else TK_CX(A[(B) + l_], A[(B) + i_]); } } } while (0)
#define TK_MERGE16(A, P, Q) do { _Pragma("unroll") for (int i_ = 0; i_ < 16; ++i_) A[(P) + i_] = A[(P) + i_] > A[(Q) + 15 - i_] ? A[(P) + i_] : A[(Q) + 15 - i_]; \
    _Pragma("unroll") for (int j_ = 8; j_ > 0; j_ >>= 1) _Pragma("unroll") for (int i_ = 0; i_ < 16; ++i_) { const int l_ = i_ ^ j_; if (l_ > i_) TK_CX(A[(P) + i_], A[(P) + l_]); } } while (0)
struct EpiTopK {
  static constexpr bool PERM = false, AFTER_DRAIN = true;
  unsigned short* IDX; float* GATE;
  __device__ __forceinline__ void fused(f32x4 (&acc)[2][2][4][2], const Unit& u, int wr, int wc, int fr, int fq, PG8_LAS unsigned char* lds, int wid, int lane) const {
    PG8_LAS float* SC = (PG8_LAS float*)lds;
    const int tid = wid * 64 + lane;
#pragma unroll
    for (int ai = 0; ai < 2; ++ai) {
#pragma unroll
      for (int m = 0; m < 4; ++m)
#pragma unroll
        for (int bj = 0; bj < 2; ++bj)
#pragma unroll
          for (int n = 0; n < 2; ++n)
#pragma unroll
            for (int i = 0; i < 4; ++i) SC[(64 * wr + 16 * m + fr) * 257 + 128 * bj + 32 * wc + 16 * n + 4 * fq + i] = acc[ai][bj][m][n][i];
      asm volatile("s_waitcnt lgkmcnt(0)" ::: "memory"); __builtin_amdgcn_s_barrier(); asm volatile("" ::: "memory");
      {
        const int hf = tid >> 8;
        PG8_LAS float* rowp = SC + (tid & 127) * 257 + ((tid >> 7) & 1) * 128 + hf * 64;
        unsigned a[48];
#pragma unroll
        for (int k = 0; k < 32; ++k) a[k] = (f2key(rowp[k]) & ~0x7Fu) | (unsigned)(127 - (hf * 64 + k));
        TK_SORT16(a, 0); TK_SORT16(a, 16); TK_MERGE16(a, 0, 16);
#pragma unroll
        for (int k = 0; k < 32; ++k) a[16 + k] = (f2key(rowp[32 + k]) & ~0x7Fu) | (unsigned)(127 - (hf * 64 + 32 + k));
        TK_SORT16(a, 16); TK_SORT16(a, 32); TK_MERGE16(a, 16, 32); TK_MERGE16(a, 0, 16);
#pragma unroll
        for (int k = 0; k < 16; ++k) rowp[k] = __uint_as_float(a[k]);
      }
      asm volatile("s_waitcnt lgkmcnt(0)" ::: "memory"); __builtin_amdgcn_s_barrier(); asm volatile("" ::: "memory");
      if (tid < 256) {
        PG8_LAS float* rowp = SC + (tid & 127) * 257 + (tid >> 7) * 128;
        unsigned a[32];
#pragma unroll
        for (int k = 0; k < 16; ++k) { a[k] = __float_as_uint(rowp[k]); a[16 + k] = __float_as_uint(rowp[64 + k]); }
        TK_MERGE16(a, 0, 16);
#pragma unroll
        for (int k = 0; k < 16; ++k) rowp[k] = __uint_as_float(a[k]);
      }
      asm volatile("s_waitcnt lgkmcnt(0)" ::: "memory"); __builtin_amdgcn_s_barrier(); asm volatile("" ::: "memory");
      if (tid < 128) {
        PG8_LAS float* rowp = SC + tid * 257;
        float v1[16], v2[16];
#pragma unroll
        for (int k = 0; k < 16; ++k) { v1[k] = key2f(__float_as_uint(rowp[k]) & ~0x7Fu); v2[k] = key2f(__float_as_uint(rowp[128 + k]) & ~0x7Fu); }
        unsigned Lc[16];
#pragma unroll
        for (int k = 0; k < 16; ++k) Lc[k] = 0u;
#pragma unroll
        for (int a = 0; a < 16; ++a)
#pragma unroll
          for (int b = 0; b < 16; ++b)
            if ((a + 1) * (b + 1) <= 16) { unsigned cv = (f2key(v1[a] + v2[b]) & ~0xFFu) | (unsigned)(255 - (a * 16 + b)); TK_INSERT(Lc, cv); }
        float ev[16]; float den = 0.f; const float mx = key2f(Lc[0] & ~0xFFu);
#pragma unroll
        for (int k = 0; k < 16; ++k) { ev[k] = __expf(key2f(Lc[k] & ~0xFFu) - mx); den += ev[k]; }
        const float inv = 1.f / den;
        const size_t o = ((size_t)(u.pm * 256 + ai * 128 + tid) * 8 + u.pn) * 16;
        unsigned iw[8];
#pragma unroll
        for (int k = 0; k < 16; ++k) {
          const int code = 255 - (int)(Lc[k] & 0xFFu), a = code >> 4, b = code & 15;
          const unsigned e1 = 127u - (__float_as_uint(rowp[a]) & 0x7Fu), e2 = 127u - (__float_as_uint(rowp[128 + b]) & 0x7Fu);
          const unsigned ex = e1 * 128u + e2;
          if (k & 1) iw[k >> 1] |= ex << 16; else iw[k >> 1] = ex;
        }
        *(u32x4*)(IDX + o) = (u32x4){iw[0], iw[1], iw[2], iw[3]}; *(u32x4*)(IDX + o + 8) = (u32x4){iw[4], iw[5], iw[6], iw[7]};
#pragma unroll
        for (int k = 0; k < 16; k += 4) *(f32x4*)(GATE + o + k) = (f32x4){ev[k] * inv, ev[k + 1] * inv, ev[k + 2] * inv, ev[k + 3] * inv};
      }
      asm volatile("s_waitcnt lgkmcnt(0)" ::: "memory"); __builtin_amdgcn_s_barrier(); asm volatile("" ::: "memory");
    }
  }
};
struct OneUnitSched {
  int nM, nN, G, c, round; long tsA, tsB;
  __device__ __forceinline__ bool next(int i, Unit& u) const {
    if (i > 0) return false;
    const long Lx = (long)round * G + c; if (Lx >= (long)nM * nN) return false;
    u.pm = (int)(Lx % nM); u.pn = (int)(Lx / nM); u.grp = 0; u.ao = u.pm * tsA; u.bo = u.pn * tsB; return true;
  }
  __device__ __forceinline__ void a_ready(const Unit&) const {}
  __device__ __forceinline__ void done(const Unit&) const {}
};

__device__ __forceinline__ void transpose_item64(const float* W, int K, int N, bf16_t* WT, float* scr, int item, int lane) {
  const int nblk = N / 64, kb = item / nblk, nb = item % nblk, k0 = 64 * kb, n0 = 64 * nb;
  f32x4 v[16];
#pragma unroll
  for (int i = 0; i < 16; ++i) v[i] = *(const f32x4*)(W + (size_t)(k0 + 4 * i + (lane >> 4)) * N + n0 + (lane & 15) * 4);
#pragma unroll
  for (int i = 0; i < 16; ++i) { float* d = scr + (4 * i + (lane >> 4)) * 65 + (lane & 15) * 4; d[0] = v[i][0]; d[1] = v[i][1]; d[2] = v[i][2]; d[3] = v[i][3]; }
  asm volatile("s_waitcnt lgkmcnt(0)" ::: "memory");
  const int c = lane & 7;
#pragma unroll
  for (int j = 0; j < 8; ++j) {
    const int n = (lane >> 3) + 8 * j; const float* s = scr + (8 * c) * 65 + n;
    u32x4 o; o.x = pg8::cvt_pk_bf16(s[0], s[65]); o.y = pg8::cvt_pk_bf16(s[130], s[195]); o.z = pg8::cvt_pk_bf16(s[260], s[325]); o.w = pg8::cvt_pk_bf16(s[390], s[455]);
    *(u32x4*)(WT + (size_t)(n0 + n) * K + k0 + 8 * c) = o;
  }
  asm volatile("s_waitcnt lgkmcnt(0)" ::: "memory");
}
__device__ __forceinline__ void transpose_item(const float* W, int K, int N, bf16_t* WT, float* scr, int item, int lane) {
  const int nblk = N / 32, kb = item / nblk, nb = item % nblk, k0 = 64 * kb, n0 = 32 * nb;
#pragma unroll 8
  for (int i = 0; i < 32; ++i) { const int kk = 2 * i + (lane >> 5); scr[kk * 33 + (lane & 31)] = W[(size_t)(k0 + kk) * N + n0 + (lane & 31)]; }
  asm volatile("s_waitcnt lgkmcnt(0)" ::: "memory");
  const int c = lane & 7;
#pragma unroll
  for (int j = 0; j < 4; ++j) {
    const int n = (lane >> 3) + 8 * j; const float* s = scr + (8 * c) * 33 + n;
    u32x4 o; o.x = pg8::cvt_pk_bf16(s[0], s[33]); o.y = pg8::cvt_pk_bf16(s[66], s[99]); o.z = pg8::cvt_pk_bf16(s[132], s[165]); o.w = pg8::cvt_pk_bf16(s[198], s[231]);
    *(u32x4*)(WT + (size_t)(n0 + n) * K + k0 + 8 * c) = o;
  }
  asm volatile("s_waitcnt lgkmcnt(0)" ::: "memory");
}

namespace att {
using bf16 = unsigned short;
constexpr int   D = 128, NW = 8, QBLK = 32, KVBLK = 64, SDEPTH = 1;
constexpr float SCALE = 0.125f;
constexpr float THR = 8.f;
constexpr int LDQ = 1024, LDK = 1024, LDO = 1024;
constexpr size_t SHM_V = KVBLK * D * 2, SHM_K = KVBLK * D * 2, SHM_ATTN = 2 * SHM_V + 2 * SHM_K + NW * 64 * 4 + 4 * 4 * 16 * 64 * 4;
using bf16x8 = __attribute__((ext_vector_type(8))) short;
using s16x4  = __attribute__((ext_vector_type(4))) short;
using f32x16 = __attribute__((ext_vector_type(16))) float;
using f32x8  = __attribute__((ext_vector_type(8))) float;
using u32x4  = __attribute__((ext_vector_type(4))) unsigned;
#define KSWZ(row, colB) ((row) * 256 + ((colB) ^ (((row) & 15) << 4)))
#define SBAR() __builtin_amdgcn_sched_barrier(0)
__device__ __forceinline__ int crow(int r, int hi) { return (r & 3) + 8 * (r >> 2) + 4 * hi; }
__device__ __forceinline__ unsigned cvtpk(float lo, float hi) {
  unsigned r; asm volatile("v_cvt_pk_bf16_f32 %0, %1, %2" : "=v"(r) : "v"(lo), "v"(hi)); return r;
}
template <typename TIn> struct Stage;
template <> struct Stage<bf16>  { using T = bf16x8;
  __device__ static __forceinline__ T ld8(const bf16* p) { return *(const __attribute__((address_space(1))) bf16x8*)(p); }
  __device__ static __forceinline__ bf16x8 tobf(T x) { return x; } };
constexpr float THR2 = 11.5f;
template <bool FIRST>
__device__ __forceinline__ void partialSM(f32x16& p0, f32x16& p1, float& mhat, f32x16& negm, float& alpha) {
  float pmax = p0[0]; for (int r = 1; r < 16; ++r) pmax = fmaxf(pmax, p0[r]); for (int r = 0; r < 16; ++r) pmax = fmaxf(pmax, p1[r]);
  { auto rr = __builtin_amdgcn_permlane32_swap(__float_as_uint(pmax), __float_as_uint(pmax), false, false);
    pmax = fmaxf(__uint_as_float(rr[0]), __uint_as_float(rr[1])); }
  alpha = 1.f;
  if (FIRST || !__builtin_expect(__all(pmax <= THR2), 1)) {
    const float dl = FIRST ? pmax : fmaxf(pmax, 0.f);
    mhat += dl;
    for (int r = 0; r < 16; ++r) { p0[r] -= dl; p1[r] -= dl; }
    for (int r = 0; r < 16; ++r) negm[r] = -mhat;
    if (!FIRST) alpha = __builtin_amdgcn_exp2f(-dl);
  }
  for (int r = 0; r < 16; ++r) p0[r] = __builtin_amdgcn_exp2f(p0[r]);
}
__device__ __forceinline__ void finishSM(f32x16& p0, f32x16& p1, float alpha, float& l_reg, bf16x8& pa0, bf16x8& pa1, bf16x8& pa2, bf16x8& pa3) {
  for (int r = 0; r < 16; ++r) p1[r] = __builtin_amdgcn_exp2f(p1[r]);
  float ps = 0; for (int r = 0; r < 16; ++r) ps += p0[r]; for (int r = 0; r < 16; ++r) ps += p1[r];
  { auto rr = __builtin_amdgcn_permlane32_swap(__float_as_uint(ps), __float_as_uint(ps), false, false);
    ps = __uint_as_float(rr[0]) + __uint_as_float(rr[1]); }
  l_reg = l_reg * alpha + ps;
#define PK4(P, BASE, OUT) do { unsigned a0 = cvtpk(P[BASE + 0], P[BASE + 1]), a1 = cvtpk(P[BASE + 2], P[BASE + 3]);   \
    unsigned b0 = cvtpk(P[BASE + 4], P[BASE + 5]), b1 = cvtpk(P[BASE + 6], P[BASE + 7]);                              \
    auto r0 = __builtin_amdgcn_permlane32_swap(a0, b0, false, false); auto r1 = __builtin_amdgcn_permlane32_swap(a1, b1, false, false); \
    u32x4 w = {r0[0], r1[0], r0[1], r1[1]}; OUT = *reinterpret_cast<bf16x8*>(&w); } while (0)
  PK4(p0, 0, pa0); PK4(p0, 8, pa1); PK4(p1, 0, pa2); PK4(p1, 8, pa3);
#undef PK4
}
typedef __attribute__((address_space(3))) const char* lds_cptr_t;
__device__ __forceinline__ void qkt(f32x16& p0, f32x16& p1, const bf16* Ks, const char* qfl_, int r32, int hi, int mcolB, const f32x16& negm) {
  unsigned qoff = (unsigned)(uintptr_t)qfl_;
  asm volatile("" : "+v"(qoff));
  const lds_cptr_t qfl = (lds_cptr_t)qoff;
  bf16x8 qr[4];
#pragma unroll
  for (int d0 = 0; d0 < 4; ++d0) qr[d0] = *(const __attribute__((address_space(3))) bf16x8*)(qfl + d0 * 1024);
#pragma unroll
  for (int d0 = 0; d0 < 4; ++d0) { int cb = mcolB + (d0 * 16 + hi * 8) * 2;
    bf16x8 b0 = *reinterpret_cast<const bf16x8*>((const char*)Ks + KSWZ(r32, cb));
    bf16x8 b1 = *reinterpret_cast<const bf16x8*>((const char*)Ks + KSWZ(32 + r32, cb));
    if (d0 == 0) { p0 = __builtin_amdgcn_mfma_f32_32x32x16_bf16(b0, qr[0], negm, 0, 0, 0); p1 = __builtin_amdgcn_mfma_f32_32x32x16_bf16(b1, qr[0], negm, 0, 0, 0); }
    else { p0 = __builtin_amdgcn_mfma_f32_32x32x16_bf16(b0, qr[d0], p0, 0, 0, 0); p1 = __builtin_amdgcn_mfma_f32_32x32x16_bf16(b1, qr[d0], p1, 0, 0, 0); } }
}
__device__ __forceinline__ int v_st(int k, int c) { const int kk = (k & ~0xC) | ((k & 4) << 1) | ((k & 8) >> 1); return ((kk >> 3) * 4 + (c >> 5)) * 512 + ((kk & 7) * 32 + (c & 31)) * 2; }
__device__ __forceinline__ int v_rd_base(int lane) { return ((lane & 3) << 3) | (((lane >> 2) & 3) << 6) | (((lane >> 4) & 1) << 5) | (((lane >> 5) & 1) << 8); }
constexpr int v_rd_off(int d0, int ks, int half) { return d0 * 512 + ks * 4096 + half * 2048; }
template <int OFF> __device__ __forceinline__ s16x4 tr_read(int vb) {
  s16x4 r; asm volatile("ds_read_b64_tr_b16 %0, %1 offset:%2" : "=&v"(r) : "v"(vb), "i"(OFF) : "memory"); return r;
}
template <int D0> __device__ __forceinline__ void pv_one(f32x16& od, int vb, bf16x8 pa0, bf16x8 pa1, bf16x8 pa2, bf16x8 pa3) {
  const s16x4 l0 = tr_read<v_rd_off(D0, 0, 0)>(vb), h0 = tr_read<v_rd_off(D0, 0, 1)>(vb), l1 = tr_read<v_rd_off(D0, 1, 0)>(vb), h1 = tr_read<v_rd_off(D0, 1, 1)>(vb);
  const s16x4 l2 = tr_read<v_rd_off(D0, 2, 0)>(vb), h2 = tr_read<v_rd_off(D0, 2, 1)>(vb), l3 = tr_read<v_rd_off(D0, 3, 0)>(vb), h3 = tr_read<v_rd_off(D0, 3, 1)>(vb);
  asm volatile("s_waitcnt lgkmcnt(0)" ::: "memory"); SBAR();
#define PK(L, H) (bf16x8){L[0], L[1], L[2], L[3], H[0], H[1], H[2], H[3]}
  od = __builtin_amdgcn_mfma_f32_32x32x16_bf16(pa0, PK(l0, h0), od, 0, 0, 0);
  od = __builtin_amdgcn_mfma_f32_32x32x16_bf16(pa1, PK(l1, h1), od, 0, 0, 0);
  od = __builtin_amdgcn_mfma_f32_32x32x16_bf16(pa2, PK(l2, h2), od, 0, 0, 0);
  od = __builtin_amdgcn_mfma_f32_32x32x16_bf16(pa3, PK(l3, h3), od, 0, 0, 0);
#undef PK
}
__device__ __forceinline__ void pv_d0(f32x16* o, int vb, bf16x8 pa0, bf16x8 pa1, bf16x8 pa2, bf16x8 pa3) {
  pv_one<0>(o[0], vb, pa0, pa1, pa2, pa3); pv_one<1>(o[1], vb, pa0, pa1, pa2, pa3); pv_one<2>(o[2], vb, pa0, pa1, pa2, pa3); pv_one<3>(o[3], vb, pa0, pa1, pa2, pa3);
}

__device__ __forceinline__ void diff_attn_unit(const bf16* __restrict__ Qb, const bf16* __restrict__ Kh, const bf16* __restrict__ Vh,
                                               bf16* __restrict__ Ob, int seq, float lam, const float* __restrict__ subln, char* lds) {
  using St = Stage<bf16>;
  int tid_ = threadIdx.x; asm volatile("" : "+v"(tid_));
  const int tid = tid_, wid = __builtin_amdgcn_readfirstlane(tid >> 6), lane = tid & 63, r32 = lane & 31, hi = lane >> 5;
  bf16* V_lds = (bf16*)lds; bf16* K_lds = (bf16*)(lds + 3 * SHM_V);
  float* ws = (float*)(lds + 3 * SHM_V + 3 * SHM_K) + wid * 64; float* li_l = ws; float* al_l = ws + 32;
  float m_reg = 0.f, l_reg = 0; f32x16 o[4] = {}; f32x16 negm = {};
  const int mw = wid >> 2, wq = wid & 3, mcolB = mw * 128;
  const bf16* Qw = Qb + (long)(wq * QBLK + r32) * LDQ + mw * 64 + hi * 8;
  char* qr = lds + 3 * SHM_V + 3 * SHM_K + NW * 64 * 4 + wid * 4096 + lane * 16;
#pragma unroll
  for (int d0 = 0; d0 < 4; ++d0) *reinterpret_cast<bf16x8*>(qr + d0 * 1024) = St::ld8(Qw + d0 * 16);
  const int vb0 = (int)(uintptr_t)V_lds + v_rd_base(lane);
  const int widu = wid;
  unsigned kof0, kof1, vof0, vof1;
  { const int r0 = 8 * widu + (lane >> 4), r1 = r0 + 4;
    kof0 = (unsigned)(r0 * LDK * 2 + ((((lane & 15) << 4)) ^ ((r0 & 15) << 4))); kof1 = (unsigned)(r1 * LDK * 2 + ((((lane & 15) << 4)) ^ ((r1 & 15) << 4)));
    const int kk = widu * 8 + ((lane & 31) >> 2), kx = (kk & ~0xC) | ((kk & 4) << 1) | ((kk & 8) >> 1);
    vof0 = (unsigned)(kx * LDK * 2 + (((lane >> 5)) * 32 + (lane & 3) * 8) * 2); vof1 = (unsigned)(kx * LDK * 2 + ((2 + (lane >> 5)) * 32 + (lane & 3) * 8) * 2); }
  typedef __attribute__((address_space(3))) unsigned lds_u32_t; typedef const __attribute__((address_space(1))) char g_cchar_t;
  lds_u32_t* const kdst = (lds_u32_t*)((__attribute__((address_space(3))) char*)K_lds + widu * 2048); lds_u32_t* const vdst = (lds_u32_t*)((__attribute__((address_space(3))) char*)V_lds + widu * 2048);
#define GLDS(g, off, dst) __builtin_amdgcn_global_load_lds((const __attribute__((address_space(1))) unsigned*)((g) + (off)), (dst), 16, 0, 0)
#define DMA_TILE(k0, slot) do { g_cchar_t* gk_ = (g_cchar_t*)Kh + (size_t)(k0) * LDK * 2; g_cchar_t* gv_ = (g_cchar_t*)Vh + (size_t)(k0) * LDK * 2; \
    GLDS(gk_, kof0, kdst + ((slot) * (int)SHM_K) / 4); GLDS(gk_, kof1, kdst + ((slot) * (int)SHM_K + 1024) / 4); \
    GLDS(gv_, vof0, vdst + ((slot) * (int)SHM_V) / 4); GLDS(gv_, vof1, vdst + ((slot) * (int)SHM_V + 1024) / 4); } while (0)
#define DMA_WAIT_BAR() do { asm volatile("s_waitcnt vmcnt(0)" ::: "memory"); __syncthreads(); } while (0)
#define RESC(a) do { if (__any((a) < 1.f)) { if (hi == 0) al_l[r32] = (a); asm volatile("s_waitcnt lgkmcnt(0)" ::: "memory"); \
    for (int d = 0; d < 4; ++d) for (int r = 0; r < 16; ++r) o[d][r] *= al_l[crow(r, hi)]; } } while (0)
#define ATT_STEP(PC0, PC1, ALC, PP0, PP1, ALP, CUR, PREV, NEXT, JJ) do { \
    SBAR(); qkt(PC0, PC1, (bf16*)((char*)K_lds + (CUR) * SHM_K), qr, r32, hi, mcolB, negm); \
    finishSM(PP0, PP1, ALP, l_reg, pa0, pa1, pa2, pa3); SBAR(); \
    DMA_TILE(((JJ) + 1) * KVBLK, NEXT); SBAR(); \
    pv_d0(o, vb0 + (PREV) * (int)SHM_V, pa0, pa1, pa2, pa3); partialSM<false>(PC0, PC1, m_reg, negm, ALC); \
    RESC(ALC); DMA_WAIT_BAR(); } while (0)
  f32x16 pA0, pA1, pB0, pB1; float alA, alB; bf16x8 pa0, pa1, pa2, pa3; const int NT = seq / KVBLK;
  if (mw == 1) __builtin_amdgcn_s_setprio(1);
  DMA_TILE(0, 0); DMA_TILE(KVBLK, 1); DMA_WAIT_BAR();
  qkt(pA0, pA1, K_lds, qr, r32, hi, mcolB, negm); partialSM<true>(pA0, pA1, m_reg, negm, alA);
  for (int j = 1; j + 1 < NT; j += 6) {
    ATT_STEP(pB0, pB1, alB, pA0, pA1, alA, 1, 0, 2, j);
    ATT_STEP(pA0, pA1, alA, pB0, pB1, alB, 2, 1, 0, j + 1);
    ATT_STEP(pB0, pB1, alB, pA0, pA1, alA, 0, 2, 1, j + 2);
    ATT_STEP(pA0, pA1, alA, pB0, pB1, alB, 1, 0, 2, j + 3);
    ATT_STEP(pB0, pB1, alB, pA0, pA1, alA, 2, 1, 0, j + 4);
    ATT_STEP(pA0, pA1, alA, pB0, pB1, alB, 0, 2, 1, j + 5);
  }
  SBAR(); qkt(pB0, pB1, (bf16*)((char*)K_lds + SHM_K), qr, r32, hi, mcolB, negm);
  finishSM(pA0, pA1, alA, l_reg, pa0, pa1, pa2, pa3); SBAR();
  pv_d0(o, vb0, pa0, pa1, pa2, pa3); partialSM<false>(pB0, pB1, m_reg, negm, alB);
  RESC(alB);
  finishSM(pB0, pB1, alB, l_reg, pa0, pa1, pa2, pa3); SBAR();
  pv_d0(o, vb0 + (int)SHM_V, pa0, pa1, pa2, pa3);
  __builtin_amdgcn_s_setprio(0);
  __syncthreads();
  if (hi == 0) li_l[r32] = l_reg; asm volatile("s_waitcnt lgkmcnt(0)" ::: "memory");
  float rli[16];
#pragma unroll
  for (int r = 0; r < 16; ++r) rli[r] = __builtin_amdgcn_rcpf(li_l[crow(r, hi)]);
  float* EXO = (float*)lds + wq * (4 * 16 * 64) + lane;
  if (mw == 1) {
#pragma unroll
    for (int d0 = 0; d0 < 4; ++d0)
#pragma unroll
      for (int r = 0; r < 16; ++r) EXO[(d0 * 16 + r) * 64] = o[d0][r] * rli[r];
  }
  __syncthreads();
  if (mw == 0) {
    float ssq[16];
#pragma unroll
    for (int r = 0; r < 16; ++r) ssq[r] = 0.f;
#pragma unroll
    for (int d0 = 0; d0 < 4; ++d0)
#pragma unroll
      for (int r = 0; r < 16; ++r) { const float dv = o[d0][r] * rli[r] - lam * EXO[(d0 * 16 + r) * 64]; o[d0][r] = dv; ssq[r] += dv * dv; }
#pragma unroll
    for (int r = 0; r < 16; ++r) {
#pragma unroll
      for (int sft = 1; sft < 32; sft <<= 1) ssq[r] += __shfl_xor(ssq[r], sft);
      ssq[r] = rsqrtf(ssq[r] * (1.f / 128.f) + 1e-6f) * 0.8f;
    }
    bf16* stg = (bf16*)(lds + 65536 + wq * 8192);
#pragma unroll
    for (int d0 = 0; d0 < 4; ++d0) { const float gg = subln[d0 * 32 + r32];
#pragma unroll
      for (int r = 0; r < 16; ++r) { const float val = o[d0][r] * ssq[r] * gg; stg[crow(r, hi) * 128 + d0 * 32 + r32] = (bf16)(pg8::cvt_pk_bf16(val, val) & 0xffffu); } }
    asm volatile("s_waitcnt lgkmcnt(0)" ::: "memory");
    bf16* Ow = Ob + (long)(wq * QBLK) * LDO;
#pragma unroll
    for (int i = 0; i < 8; ++i) { const int row = i * 4 + (lane >> 4), ch = lane & 15;
      const u32x4 v = *(const u32x4*)(stg + row * 128 + ch * 8);
      *(__attribute__((address_space(1))) u32x4*)(Ow + (long)row * LDO + ch * 8) = v; }
  }
  __syncthreads();
#undef GLDS
#undef DMA_TILE
#undef DMA_WAIT_BAR
#undef RESC
#undef ATT_STEP
}
}


typedef __bf16 bf16x2_t __attribute__((ext_vector_type(2)));
__device__ __forceinline__ float dot2bf(unsigned a, unsigned b, float acc) { return __builtin_amdgcn_fdot2_f32_bf16(__builtin_bit_cast(bf16x2_t, a), __builtin_bit_cast(bf16x2_t, b), acc, false); }
template <int CTRL> __device__ __forceinline__ float dpp_add(float v) { return v + __builtin_bit_cast(float, __builtin_amdgcn_update_dpp(0, __builtin_bit_cast(int, v), CTRL, 0xf, 0xf, true)); }
__device__ __forceinline__ float row16_sum(float v) {
  v = dpp_add<0xB1>(v); v = dpp_add<0x4E>(v); v = dpp_add<0x141>(v); v = dpp_add<0x140>(v); return v;
}

typedef unsigned u32x2_t __attribute__((ext_vector_type(2)));
typedef float f32x2_t __attribute__((ext_vector_type(2)));
__device__ __forceinline__ void slice_table_fp8(const float* T, unsigned char* T8, float scale, int gtid, int gsz) {
  for (int it0 = gtid; it0 < 16384 * 128; it0 += 4 * gsz) {
    f32x4 a[4], b[4];
#pragma unroll
    for (int q = 0; q < 4; ++q) { const int it = it0 + q * gsz; if (it < 16384 * 128) { const int e = it >> 7, c8 = (it & 127) * 8; a[q] = *(const f32x4*)(T + (size_t)e * 1024 + c8); b[q] = *(const f32x4*)(T + (size_t)e * 1024 + c8 + 4); } }
#pragma unroll
    for (int q = 0; q < 4; ++q) { const int it = it0 + q * gsz; if (it < 16384 * 128) {
      const int e = it >> 7, c8 = (it & 127) * 8, j = c8 >> 7, c = c8 & 127; const f32x4 as = a[q] * scale, bs = b[q] * scale;
      int w0 = __builtin_amdgcn_cvt_pk_fp8_f32(as[0], as[1], 0, false); w0 = __builtin_amdgcn_cvt_pk_fp8_f32(as[2], as[3], w0, true);
      int w1 = __builtin_amdgcn_cvt_pk_fp8_f32(bs[0], bs[1], 0, false); w1 = __builtin_amdgcn_cvt_pk_fp8_f32(bs[2], bs[3], w1, true);
      *(u32x2_t*)(T8 + ((size_t)j * 16384 + e) * 128 + c) = (u32x2_t){(unsigned)w0, (unsigned)w1}; } }
  }
}
__device__ __forceinline__ void slice_table(const float* T, bf16_t* T8, int gtid, int gsz) {
  for (int it = gtid; it < 16384 * 128; it += gsz) {
    const int e = it >> 7, c8 = (it & 127) * 8, j = c8 >> 7, c = c8 & 127;
    const f32x4 a = *(const f32x4*)(T + (size_t)e * 1024 + c8), b = *(const f32x4*)(T + (size_t)e * 1024 + c8 + 4);
    u32x4 w; w.x = pg8::cvt_pk_bf16(a[0], a[1]); w.y = pg8::cvt_pk_bf16(a[2], a[3]); w.z = pg8::cvt_pk_bf16(b[0], b[1]); w.w = pg8::cvt_pk_bf16(b[2], b[3]);
    *(u32x4*)(T8 + ((size_t)j * 16384 + e) * 128 + c) = w;
  }
}

#define LAS __attribute__((address_space(3)))
#define XB_TMO      128
#define XB_XCNT(j)  (256  + 64 * (j))
#define XB_XSUB(j)  (1280 + 64 * (j))
#define XB_XGEN(j)  (2304 + 64 * (j))
#define XB_TOP      3328
#define XB_TOPGEN   3392
#define XCD_BAR_WORDS 3456
#define XB_SPIN_CAP (1u << 18)

__device__ __forceinline__ unsigned xb_ld(unsigned* p)              { return __hip_atomic_load(p, __ATOMIC_RELAXED, __HIP_MEMORY_SCOPE_AGENT); }
__device__ __forceinline__ unsigned xb_add(unsigned* p, unsigned v) { return __hip_atomic_fetch_add(p, v, __ATOMIC_RELAXED, __HIP_MEMORY_SCOPE_AGENT); }
__device__ __forceinline__ unsigned xb_xcc_id() { return (unsigned)__builtin_amdgcn_s_getreg((3 << 11) | 20) & 0xFu; }
#define XB_SPIN(cond, bar) do { unsigned _sp = 0; while (cond) { __builtin_amdgcn_s_sleep(1); \
    if ((++_sp & 255u) == 0u) { if (xb_ld(&(bar)[XB_TMO])) break; if (_sp > XB_SPIN_CAP) { atomicAdd(&(bar)[XB_TMO], 1u); break; } } } } while (0)

struct XcdBarrier {
    unsigned* bar; unsigned x;
    volatile LAS unsigned* st;
};

__device__ __forceinline__ XcdBarrier xcd_barrier_post(unsigned* bar, volatile LAS unsigned* st) {
    XcdBarrier b; b.bar = bar; b.x = xb_xcc_id(); b.st = st;
    if (threadIdx.x == 0) (void)xb_add(&bar[XB_XCNT(b.x)], 1u);
    return b;
}
__device__ __forceinline__ void xcd_barrier_complete(unsigned* bar, unsigned x, unsigned& nloc, unsigned& nx) {
    const unsigned G = gridDim.x * gridDim.y * gridDim.z;
    unsigned sum, cnt, mine, sp = 0u;
    for (;;) {
        sum = 0u; cnt = 0u; mine = 0u;
#pragma unroll
        for (unsigned j = 0; j < 16; ++j) { const unsigned c = xb_ld(&bar[XB_XCNT(j)]); sum += c; cnt += (c > 0u) ? 1u : 0u; mine = (j == x) ? c : mine; }
        if (sum == G) break;
        __builtin_amdgcn_s_sleep(1);
        if ((++sp & 255u) == 0u) { if (xb_ld(&bar[XB_TMO])) break; if (sp > XB_SPIN_CAP) { atomicAdd(&bar[XB_TMO], 1u); break; } }
    }
    nloc = mine > 0u ? mine : 1u; nx = cnt > 0u ? cnt : 1u;
}

__device__ __forceinline__ void xcd_barrier(const XcdBarrier& b) {
    asm volatile("s_waitcnt vmcnt(0)" ::: "memory");
    __syncthreads();
    if (threadIdx.x == 0) {
        unsigned* bar = b.bar;
        __builtin_amdgcn_s_waitcnt(0);
        unsigned nloc = b.st[0], nx = b.st[1];
        if (nloc == 0u) { xcd_barrier_complete(bar, b.x, nloc, nx); b.st[0] = nloc; b.st[1] = nx; }
        const unsigned old = xb_add(&bar[XB_XSUB(b.x)], 1u);
        const unsigned gen = old / nloc;
        if (old + 1u == (gen + 1u) * nloc) {
            __builtin_amdgcn_fence(__ATOMIC_RELEASE, "agent");
            asm volatile("s_waitcnt vmcnt(0)" ::: "memory");
            const unsigned og = xb_add(&bar[XB_TOP], 1u);
            const unsigned tg = og / nx;
            if (og + 1u == (tg + 1u) * nx) xb_add(&bar[XB_TOPGEN], 1u);
            else XB_SPIN(xb_ld(&bar[XB_TOPGEN]) == tg, bar);
            __builtin_amdgcn_fence(__ATOMIC_ACQUIRE, "agent");
            xb_add(&bar[XB_XGEN(b.x)], 1u);
            asm volatile("s_waitcnt vmcnt(0)" ::: "memory");
        } else {
            XB_SPIN(xb_ld(&bar[XB_XGEN(b.x)]) == gen, bar);
            __builtin_amdgcn_fence(__ATOMIC_ACQUIRE, "agent");
            asm volatile("s_waitcnt vmcnt(0)" ::: "memory");
        }
    }
    __syncthreads();
}


__device__ __forceinline__ void wave_argmax(float& v, int& i) {
#pragma unroll
  for (int o = 32; o; o >>= 1) {
    const float ov = __shfl_xor(v, o); const int oi = __shfl_xor(i, o);
    if (ov > v || (ov == v && oi < i)) { v = ov; i = oi; }
  }
}

__global__ void __launch_bounds__(NT) mega(Params p) {
  extern __shared__ __attribute__((aligned(16))) unsigned char lds[];
  cg::grid_group grid = cg::this_grid();
  if (threadIdx.x < 35) {
    unsigned long long v = threadIdx.x < 33 ? (unsigned long long)p.in[threadIdx.x] : (threadIdx.x == 33 ? (unsigned long long)p.out : (unsigned long long)p.ws);
    ((unsigned long long*)(lds + PTR_OFF))[threadIdx.x] = v;
  }
  if (threadIdx.x < 2) ((volatile unsigned*)(lds + PTR_OFF + 800))[threadIdx.x] = 0u;
  __syncthreads();
  if (blockIdx.x == 0) for (int i = threadIdx.x; i < XCD_BAR_WORDS; i += NT) ((unsigned*)WSP(WS_BAR))[i] = 0u;

  {
    PHASE_LOCALS
    float* MOD = (float*)WSP(WS_MOD); float* LAM = (float*)WSP(WS_LAM);
    const float* cin = INP(1); const float* c_ctx = INP(3); const float* ada_w = INP(4); const float* ada_b = INP(5);
    if (gridDim.x >= 192) {
      if (blockIdx.x < 192) {
        float* sil = fl; float* red = fl + 5 * 1024;
        for (int i = tid; i < 5 * 1024; i += NT) { const int r = i >> 10, k = i & 1023; sil[i] = siluf_(r < 4 ? cin[r * D + k] : c_ctx[k]); }
        __syncthreads();
        const int cl = tid & 31, kg = tid >> 5, col = blockIdx.x * 32 + cl;
        float a[5] = {0.f, 0.f, 0.f, 0.f, 0.f};
#pragma unroll
        for (int kk = 0; kk < 64; ++kk) {
          const int k = kg * 64 + kk; const float w = ada_w[(size_t)k * 6144 + col];
#pragma unroll
          for (int r = 0; r < 5; ++r) a[r] += sil[r * 1024 + k] * w;
        }
#pragma unroll
        for (int r = 0; r < 5; ++r) red[(kg * 5 + r) * 32 + cl] = a[r];
        __syncthreads();
        if (tid < 160) {
          const int r = tid >> 5; float s = 0.f;
#pragma unroll
          for (int q = 0; q < 16; ++q) s += red[(q * 5 + r) * 32 + cl];
          MOD[r * 6144 + col] = s + ada_b[col];
        }
        __syncthreads();
      }
    } else {
      for (int it = gtid; it < 5 * 6144; it += gsz) {
        const int r = it / 6144, j = it % 6144;
        const float* cv = r < 4 ? cin + r * D : c_ctx;
        float a = 0.f;
        for (int k = 0; k < D; ++k) a += siluf_(cv[k]) * ada_w[(size_t)k * 6144 + j];
        MOD[it] = a + ada_b[j];
      }
    }
    if (gtid == 0) {
      const float* q1 = INP(9); const float* k1 = INP(10); const float* q2 = INP(11); const float* k2 = INP(12);
      float s1 = 0.f, s2 = 0.f;
      for (int k = 0; k < 64; ++k) { s1 += q1[k] * k1[k]; s2 += q2[k] * k2[k]; }
      LAM[0] = expf(s1) - expf(s2) + 0.2f;
    }
    const float* a_re = INP(15); const float* a_im = INP(16); const float* ldt = INP(17); const float* b_re = INP(18); const float* b_im = INP(19);
    for (int it = (int)(gridDim.x - 1 - blockIdx.x) * NT + tid; it < 2 * 32 * 64; it += gsz) {
      const float dt = expf(ldt[it >> 6]);
      ((float*)WSP(WS_ARDT))[it] = a_re[it] * dt; ((float*)WSP(WS_AIDT))[it] = a_im[it] * dt;
    }
    {
      struct BB { float fr, fi, ardt, aidt; };
      auto disc1 = [&](int sidx) -> BB {
        const float ar = a_re[sidx], ai = a_im[sidx], dt = expf(ldt[sidx >> 6]);
        const float mag = expf(ar * dt), abr = mag * cosf(ai * dt), abi = mag * sinf(ai * dt);
        const float den = ar * ar + ai * ai, nr = abr - 1.f, ni = abi;
        return BB{(nr * ar + ni * ai) / den, (ni * ar - nr * ai) / den, ar * dt, ai * dt};
      };
      {
        bf16_t* BTS = (bf16_t*)WSP(WS_BTS);
        for (int it = gtid; it < 32 * 256 * 32; it += gsz) {
          const int i = it & 31, r = (it >> 5) & 255, g = it >> 13;
          const int d = r >> 7, n = (r >> 1) & 63, ri = r & 1, sidx = (d * 32 + g) * 64 + n;
          const BB bb = disc1(sidx);
          const float e = (float)(d == 0 ? 31 - i : i);
          const float mag = __expf(e * bb.ardt), pr0 = mag * __cosf(e * bb.aidt), pi0 = mag * __sinf(e * bb.aidt);
          const float pr = pr0 * bb.fr - pi0 * bb.fi, pi = pr0 * bb.fi + pi0 * bb.fr;
          unsigned w[8];
#pragma unroll
          for (int q = 0; q < 8; ++q) {
            const float br0 = b_re[sidx * 16 + 2 * q], bi0 = b_im[sidx * 16 + 2 * q], br1 = b_re[sidx * 16 + 2 * q + 1], bi1 = b_im[sidx * 16 + 2 * q + 1];
            const float v0 = ri == 0 ? pr * br0 - pi * bi0 : pr * bi0 + pi * br0, v1 = ri == 0 ? pr * br1 - pi * bi1 : pr * bi1 + pi * br1;
            w[q] = pg8::cvt_pk_bf16(v0, v1);
          }
          u32x4* dst = (u32x4*)(BTS + ((size_t)g * 256 + r) * 512 + i * 16);
          dst[0] = (u32x4){w[0], w[1], w[2], w[3]}; dst[1] = (u32x4){w[4], w[5], w[6], w[7]};
        }
      }
      {
        float* KT = (float*)WSP(WS_KT); const float* c_re = INP(20); const float* c_im = INP(21);
        if (gridDim.x >= 256) {
          if (blockIdx.x >= 192) {
            const int dg = (int)blockIdx.x - 192; float* dsc = fl;
            float* blr = fl + 256; float* bli = blr + 1024; float* clr = bli + 1024; float* cli = clr + 16 * 65;
            if (tid < 64) { const BB bb = disc1(dg * 64 + tid); dsc[tid * 4] = bb.fr; dsc[tid * 4 + 1] = bb.fi; dsc[tid * 4 + 2] = bb.ardt; dsc[tid * 4 + 3] = bb.aidt; }
            for (int i = tid; i < 1024; i += NT) { blr[i] = b_re[dg * 1024 + i]; bli[i] = b_im[dg * 1024 + i];
              clr[(i >> 6) * 65 + (i & 63)] = c_re[dg * 1024 + i]; cli[(i >> 6) * 65 + (i & 63)] = c_im[dg * 1024 + i]; }
            __syncthreads();
            const int pp = tid & 15, m = tid >> 4;
            float acc[16];
#pragma unroll
            for (int q = 0; q < 16; ++q) acc[q] = 0.f;
            for (int n = 0; n < 64; ++n) {
              const float fr = dsc[n * 4], fi = dsc[n * 4 + 1], ardt = dsc[n * 4 + 2], aidt = dsc[n * 4 + 3];
              const float mag = __expf((float)m * ardt), pr0 = mag * __cosf((float)m * aidt), pi0 = mag * __sinf((float)m * aidt);
              const float pr = pr0 * fr - pi0 * fi, pi = pr0 * fi + pi0 * fr;
              const float cr = clr[pp * 65 + n], ci = cli[pp * 65 + n];
              const float wr_ = cr * pr - ci * pi, wi_ = cr * pi + ci * pr;
#pragma unroll
              for (int q = 0; q < 16; ++q) acc[q] += wr_ * blr[n * 16 + q] - wi_ * bli[n * 16 + q];
            }
#pragma unroll
            for (int q = 0; q < 16; ++q) KT[((size_t)dg * 32 + m) * 256 + pp * 16 + q] = acc[q];
            __syncthreads();
          }
        } else {
          for (int it = gtid; it < 2 * 32 * 32 * 16; it += gsz) {
            const int pp = it & 15, m = (it >> 4) & 31, dg = it >> 9;
            float acc[16];
#pragma unroll
            for (int q = 0; q < 16; ++q) acc[q] = 0.f;
            for (int n = 0; n < 64; ++n) {
              const int sidx = dg * 64 + n;
              const BB bb = disc1(sidx);
              const float mag = __expf((float)m * bb.ardt), pr0 = mag * __cosf((float)m * bb.aidt), pi0 = mag * __sinf((float)m * bb.aidt);
              const float pr = pr0 * bb.fr - pi0 * bb.fi, pi = pr0 * bb.fi + pi0 * bb.fr;
              const float cr = c_re[(dg * 16 + pp) * 64 + n], ci = c_im[(dg * 16 + pp) * 64 + n];
              const float wr_ = cr * pr - ci * pi, wi_ = cr * pi + ci * pr;
#pragma unroll
              for (int q = 0; q < 16; ++q) acc[q] += wr_ * b_re[sidx * 16 + q] - wi_ * b_im[sidx * 16 + q];
            }
#pragma unroll
            for (int q = 0; q < 16; ++q) KT[((size_t)dg * 32 + m) * 256 + pp * 16 + q] = acc[q];
          }
        }
      }
    }
    float* ROPE = (float*)WSP(WS_ROPE);
    for (int it = gtid; it < 64 * 16; it += gsz) {
      const float ang = (float)(it >> 4) * powf(10000.f, -(float)(it & 15) / 16.f);
      ROPE[it * 2] = cosf(ang); ROPE[it * 2 + 1] = sinf(ang);
    }
    {
      float* scr = fl + wid * (64 * 65);
      constexpr int I_IN = 16 * 88, I_AU = 16 * 16, I_SU = 8 * 16, I_OUT = 16 * 16, I_GLU = 8 * 8;
      for (int it = gw; it < I_IN + I_AU + I_SU + I_OUT + I_GLU; it += ngw) {
        int r = it;
        if (r < I_IN) { transpose_item64(INP(8), 1024, N_IN, (bf16_t*)WSP(WS_WIN), scr, r, lane); continue; } r -= I_IN;
        if (r < I_AU) { transpose_item64(INP(14), 1024, 1024, (bf16_t*)WSP(WS_WAU), scr, r, lane); continue; } r -= I_AU;
        if (r < I_SU) { transpose_item64(INP(25), 512, 1024, (bf16_t*)WSP(WS_WSU), scr, r, lane); continue; } r -= I_SU;
        if (r < I_OUT) { transpose_item64(INP(26), 1024, 1024, (bf16_t*)WSP(WS_WOUT), scr, r, lane); continue; } r -= I_OUT;
        transpose_item64(INP(23), 512, 512, (bf16_t*)WSP(WS_WGLU), scr, r, lane);
      }
    }
  }
  grid.sync();
  const XcdBarrier xbar = xcd_barrier_post((unsigned*)WSP(WS_BAR), (volatile LAS unsigned*)(lds + PTR_OFF + 800));

  {
    PHASE_LOCALS
    const float* MOD = (const float*)WSP(WS_MOD); bf16_t* XN = (bf16_t*)WSP(WS_XN);
    const float* x = INP(0); const float* ctx = INP(2); const float* norm1_g = INP(6);
    for (int row = gw; row < MX + MC; row += ngw) {
      const float* src; const float* md;
      if (row < MX) { src = x + (size_t)row * D; md = MOD + (row / L) * 6144; } else { src = ctx + (size_t)(row - MX) * D; md = MOD + 4 * 6144; }
      f32x4 v[4]; float ss = 0.f;
#pragma unroll
      for (int j = 0; j < 4; ++j) { v[j] = *(const f32x4*)(src + lane * 4 + 256 * j); ss += v[j][0] * v[j][0] + v[j][1] * v[j][1] + v[j][2] * v[j][2] + v[j][3] * v[j][3]; }
      const float rstd = rsqrtf(wave_sum(ss) * (1.f / D) + 1e-6f);
#pragma unroll
      for (int j = 0; j < 4; ++j)
#pragma unroll
        for (int e = 0; e < 4; ++e) { const int col = lane * 4 + 256 * j + e; XN[(size_t)row * D + col] = f2bf(v[j][e] * rstd * norm1_g[col] * (1.f + md[1024 + col]) + md[col]); }
    }
  }
  xcd_barrier(xbar);

  {
    pg8::Gemm g{(const bf16_t*)WSP(WS_XN), (const bf16_t*)WSP(WS_WIN), MX + MC, N_IN, D, D, D};
    InProjSched S; S.init((int)gridDim.x, (int)blockIdx.x);
    EpiInProj E{(bf16_t*)WSP(WS_Q), (bf16_t*)WSP(WS_K), (bf16_t*)WSP(WS_V), (bf16_t*)WSP(WS_SA), (bf16_t*)WSP(WS_G), (const float*)WSP(WS_ROPE)};
    pg8::gemm_phase<EpiInProj, InProjSched, true, true>((PG8_LAS unsigned char*)lds, g, S, E);
  }
  xcd_barrier(xbar);

  {
    const float lam = ((const float*)WSP(WS_LAM))[0];
    const bf16_t* Qb = (const bf16_t*)WSP(WS_Q); const bf16_t* Kb = (const bf16_t*)WSP(WS_K); const bf16_t* Vb = (const bf16_t*)WSP(WS_V);
    bf16_t* ATT = (bf16_t*)WSP(WS_ATT); const float* subln = INP(13);
    for (int unit = blockIdx.x; unit < Bn * 8 * (L / 128); unit += gridDim.x) {
      const int h = unit & 7, qb = (unit >> 3) & 31, b = unit >> 8;
      const size_t qoff = ((size_t)(b * L + qb * 128)) * 1024 + h * 128, koff = (size_t)b * LA * 1024 + h * 128;
      att::diff_attn_unit(Qb + qoff, Kb + koff, Vb + koff, ATT + qoff, LA, lam, subln, (char*)lds);
    }
  }
  xcd_barrier(xbar);

  {
    const bool gemm_blk = (blockIdx.x < 96) || (gridDim.x <= 96);
    if (gemm_blk) {
      pg8::Gemm g{(const bf16_t*)WSP(WS_SA), (const bf16_t*)WSP(WS_BTS), 0, 0, 512, SA_LD, 512};
      GroupSched S; S.init(32, 3, 1, (long)SA_ROWS * SA_LD * 2, (long)256 * SA_LD * 2, (long)256 * 512 * 2, 0, (int)(gridDim.x <= 96 ? gridDim.x : 96), (int)blockIdx.x);
      EpiS E{(float*)WSP(WS_S)};
      pg8::gemm_phase<EpiS, GroupSched, true, true>((PG8_LAS unsigned char*)lds, g, S, E);
    }
    {
      PHASE_LOCALS
      const bool big = gridDim.x > 96;
      const int vslots = big ? (gemm_blk ? 3 : 5) : 1, vbase = big ? (gemm_blk ? (int)blockIdx.x * 3 : 96 * 3 + ((int)blockIdx.x - 96) * 5) : (int)blockIdx.x;
      const int vtot = big ? 96 * 3 + ((int)gridDim.x - 96) * 5 : (int)gridDim.x;
      const float* KT = (const float*)WSP(WS_KT); const float* ARDT = (const float*)WSP(WS_ARDT); const float* AIDT = (const float*)WSP(WS_AIDT);
      const float* c_re = INP(20); const float* c_im = INP(21); const float* dsk = INP(22); bf16_t* BTY = (bf16_t*)WSP(WS_BTY);
      for (int cb = vbase; cb < 32 * 512 * 96 / NT; cb += vtot) for (int vs = 0; vs < vslots; ++vs) {
        const int ch = cb + vs; if (ch >= 32 * 512 * 96 / NT) break;
        const bool kpart = ch < 2048; const int it = (kpart ? ch : ch - 2048) * NT + tid;
        const int cgp = kpart ? (it & 63) : 64 + (it & 31), rg = kpart ? (it >> 6) : (it >> 5), row = rg & 511, g = rg >> 9;
        const int j = row >> 4, pp = row & 15, col0 = cgp * 8;
        float v[8];
        if (col0 < 512) {
          const int i = col0 >> 4, q0 = col0 & 15;
#pragma unroll
          for (int e = 0; e < 8; ++e) v[e] = 0.f;
          if (i <= j) { const float* kp = KT + ((size_t)(0 * 32 + g) * 32 + (j - i)) * 256 + pp * 16 + q0;
#pragma unroll
            for (int e = 0; e < 8; ++e) v[e] += kp[e]; }
          if (i >= j) { const float* kp = KT + ((size_t)(1 * 32 + g) * 32 + (i - j)) * 256 + pp * 16 + q0;
#pragma unroll
            for (int e = 0; e < 8; ++e) v[e] += kp[e]; }
          if (i == j && pp >= q0 && pp < q0 + 8) {
#pragma unroll
            for (int e = 0; e < 8; ++e) if (q0 + e == pp) v[e] += dsk[g * 16 + pp];
          }
        } else {
          const int cc0 = col0 - 512, d = cc0 >> 7, n0 = (cc0 & 127) >> 1;
          const float ex = (float)(d == 0 ? j + 1 : 32 - j);
#pragma unroll
          for (int q = 0; q < 4; ++q) {
            const int n = n0 + q, sidx = (d * 32 + g) * 64 + n;
            const float mag = __expf(ex * ARDT[sidx]), pr = mag * __cosf(ex * AIDT[sidx]), pi = mag * __sinf(ex * AIDT[sidx]);
            const float cr = c_re[((d * 32 + g) * 16 + pp) * 64 + n], ci = c_im[((d * 32 + g) * 16 + pp) * 64 + n];
            v[2 * q] = cr * pr - ci * pi; v[2 * q + 1] = -(cr * pi + ci * pr);
          }
        }
        u32x4 w; w.x = pg8::cvt_pk_bf16(v[0], v[1]); w.y = pg8::cvt_pk_bf16(v[2], v[3]); w.z = pg8::cvt_pk_bf16(v[4], v[5]); w.w = pg8::cvt_pk_bf16(v[6], v[7]);
        *(u32x4*)(BTY + ((size_t)g * 512 + row) * 768 + col0) = w;
      }
    }
  }
  xcd_barrier(xbar);

  {
    PHASE_LOCALS
    const float* ARDT = (const float*)WSP(WS_ARDT); const float* AIDT = (const float*)WSP(WS_AIDT);
    if (wid == 0) {
      for (int it = blockIdx.x; it < Bn * 32 * 2; it += gridDim.x) {
        const int d = it & 1, g = (it >> 1) & 31, b = it >> 6;
        const int sidx = (d * 32 + g) * 64 + lane;
        const float mag = expf(32.f * ARDT[sidx]), pr = mag * cosf(32.f * AIDT[sidx]), pi = mag * sinf(32.f * AIDT[sidx]);
        typedef float f32x2_ __attribute__((ext_vector_type(2)));
        const f32x2_* Sg = (const f32x2_*)((const float*)WSP(WS_S) + (size_t)g * SA_ROWS * 256) + d * 64 + lane;
        bf16_t* SAg = (bf16_t*)WSP(WS_SA) + (size_t)g * SA_ROWS * SA_LD + 512 + d * 128 + lane * 2;
        float hr = 0.f, hi = 0.f;
        f32x2_ sc[8];
#pragma unroll
        for (int k = 0; k < 8; ++k) { const int cc = d == 0 ? k : 7 - k; sc[k] = Sg[(size_t)(512 + b * 8 + cc) * 128]; }
#pragma unroll
        for (int k = 0; k < 8; ++k) { const float nr = pr * hr - pi * hi + sc[k][0], ni = pr * hi + pi * hr + sc[k][1]; hr = nr; hi = ni; }
        for (int k0 = 0; k0 < 128; k0 += 16) {
          f32x2_ sv[16];
#pragma unroll
          for (int k = 0; k < 16; ++k) { const int cx = d == 0 ? k0 + k : 127 - (k0 + k); sv[k] = Sg[(size_t)(b * 128 + cx) * 128]; }
#pragma unroll
          for (int k = 0; k < 16; ++k) {
            const int cx = d == 0 ? k0 + k : 127 - (k0 + k);
            *(unsigned*)(SAg + (size_t)(b * 128 + cx) * SA_LD) = pg8::cvt_pk_bf16(hr, hi);
            const float nr = pr * hr - pi * hi + sv[k][0], ni = pr * hi + pi * hr + sv[k][1]; hr = nr; hi = ni;
          }
        }
      }
    }
  }
  xcd_barrier(xbar);

  {
    pg8::Gemm g{(const bf16_t*)WSP(WS_SA), (const bf16_t*)WSP(WS_BTY), 0, 0, 768, SA_LD, 768};
    GroupSched S; S.init(32, 2, 2, (long)SA_ROWS * SA_LD * 2, (long)256 * SA_LD * 2, (long)512 * 768 * 2, (long)256 * 768 * 2, (int)gridDim.x, (int)blockIdx.x);
    EpiY E{(bf16_t*)WSP(WS_YG)};
    pg8::gemm_phase<EpiY, GroupSched, true, true>((PG8_LAS unsigned char*)lds, g, S, E);
  }
  {
    pg8::Gemm g{(const bf16_t*)WSP(WS_ATT), (const bf16_t*)WSP(WS_WAU), MX, 1024, 1024, 1024, 1024};
    pg8::StaticOrder S; S.init(MX, 1024, (int)gridDim.x, (int)blockIdx.x, g.lda, g.ldb);
    EpiBf8<1> E{(bf16_t*)WSP(WS_M), 1024, (const bf16_t*)WSP(WS_G), 2048, nullptr};
    pg8::gemm_phase<EpiBf8<1>, pg8::StaticOrder, true, true>((PG8_LAS unsigned char*)lds, g, S, E);
  }
  xcd_barrier(xbar);

  {
    pg8::Gemm g{(const bf16_t*)WSP(WS_YG), (const bf16_t*)WSP(WS_WGLU), MX, 512, 512, 512, 512};
    pg8::StaticOrder S; S.init(MX, 512, (int)gridDim.x, (int)blockIdx.x, g.lda, g.ldb);
    EpiBf8<0> E{(bf16_t*)WSP(WS_SSMX), 512, (const bf16_t*)WSP(WS_YG), 512, INP(24)};
    pg8::gemm_phase<EpiBf8<0>, pg8::StaticOrder, true, true>((PG8_LAS unsigned char*)lds, g, S, E);
  }
  xcd_barrier(xbar);

  {
    pg8::Gemm g{(const bf16_t*)WSP(WS_SSMX), (const bf16_t*)WSP(WS_WSU), MX, 1024, 512, 512, 512};
    pg8::StaticOrder S; S.init(MX, 1024, (int)gridDim.x, (int)blockIdx.x, g.lda, g.ldb);
    EpiBf8<2> E{(bf16_t*)WSP(WS_M), 1024, (const bf16_t*)WSP(WS_G) + 1024, 2048, nullptr};
    pg8::gemm_phase<EpiBf8<2>, pg8::StaticOrder, true, true>((PG8_LAS unsigned char*)lds, g, S, E);
  }
  xcd_barrier(xbar);
  {
    pg8::Gemm g{(const bf16_t*)WSP(WS_M), (const bf16_t*)WSP(WS_WOUT), MX, 1024, 1024, 1024, 1024};
    pg8::StaticOrder S; S.init(MX, 1024, (int)gridDim.x, (int)blockIdx.x, g.lda, g.ldb);
    EpiF32<1> E{(float*)WSP(WS_X1), INP(0), (const float*)WSP(WS_MOD)};
    pg8::gemm_phase<EpiF32<1>, pg8::StaticOrder, true, true>((PG8_LAS unsigned char*)lds, g, S, E);
  }
  xcd_barrier(xbar);
  {
    PHASE_LOCALS
    const float* X1 = (const float*)WSP(WS_X1); const float* MOD = (const float*)WSP(WS_MOD); bf16_t* XN2 = (bf16_t*)WSP(WS_XN2); const float* norm2_g = INP(7);
    for (int row = gw; row < MX; row += ngw) {
      const float* src = X1 + (size_t)row * D; const float* md = MOD + (row / L) * 6144;
      f32x4 v[4]; float ss = 0.f;
#pragma unroll
      for (int j = 0; j < 4; ++j) { v[j] = *(const f32x4*)(src + lane * 4 + 256 * j); ss += v[j][0] * v[j][0] + v[j][1] * v[j][1] + v[j][2] * v[j][2] + v[j][3] * v[j][3]; }
      const float rstd = rsqrtf(wave_sum(ss) * (1.f / D) + 1e-6f);
#pragma unroll
      for (int j = 0; j < 4; ++j)
#pragma unroll
        for (int e = 0; e < 4; ++e) { const int col = lane * 4 + 256 * j + e; XN2[(size_t)row * D + col] = f2bf(v[j][e] * rstd * norm2_g[col] * (1.f + md[4096 + col]) + md[3072 + col]); }
    }
    slice_table_fp8(INP(30), (unsigned char*)WSP(WS_U8), 32.f, gtid, gsz);
    {
      const float* wq = INP(27); const float* sk1 = INP(28); const float* sk2 = INP(29); bf16_t* WC = (bf16_t*)WSP(WS_WC);
      float* skl = fl; float* wql = fl + 128 * 65;
      for (int tile = blockIdx.x; tile < 16 * 16; tile += gridDim.x) {
        const int hs = tile >> 4, d0 = (tile & 15) * 64, h = hs >> 1, s = hs & 1;
        __syncthreads();
        const float* skp = s ? sk2 : sk1;
        for (int i = tid; i < 128 * 16; i += NT) { const int k = i >> 4, e4 = (i & 15) * 4; const f32x4 v = *(const f32x4*)(skp + k * 64 + e4); skl[k * 65 + e4] = v[0]; skl[k * 65 + e4 + 1] = v[1]; skl[k * 65 + e4 + 2] = v[2]; skl[k * 65 + e4 + 3] = v[3]; }
        for (int i = tid; i < 64 * 16; i += NT) { const int dd = i >> 4, e4 = (i & 15) * 4; const f32x4 v = *(const f32x4*)(wq + (size_t)(d0 + dd) * 1024 + h * 128 + s * 64 + e4); wql[dd * 65 + e4] = v[0]; wql[dd * 65 + e4 + 1] = v[1]; wql[dd * 65 + e4 + 2] = v[2]; wql[dd * 65 + e4 + 3] = v[3]; }
        __syncthreads();
        const int k = tid & 127, dgp = tid >> 7;
        float a[16];
#pragma unroll
        for (int q = 0; q < 16; ++q) a[q] = 0.f;
        for (int e = 0; e < 64; ++e) {
          const float sv = skl[k * 65 + e];
#pragma unroll
          for (int q = 0; q < 16; ++q) a[q] += sv * wql[(dgp * 16 + q) * 65 + e];
        }
        u32x4 w0, w1;
        w0.x = pg8::cvt_pk_bf16(a[0], a[1]); w0.y = pg8::cvt_pk_bf16(a[2], a[3]); w0.z = pg8::cvt_pk_bf16(a[4], a[5]); w0.w = pg8::cvt_pk_bf16(a[6], a[7]);
        w1.x = pg8::cvt_pk_bf16(a[8], a[9]); w1.y = pg8::cvt_pk_bf16(a[10], a[11]); w1.z = pg8::cvt_pk_bf16(a[12], a[13]); w1.w = pg8::cvt_pk_bf16(a[14], a[15]);
        bf16_t* dst = WC + (size_t)(h * 256 + s * 128 + k) * 1024 + d0 + dgp * 16;
        *(u32x4*)dst = w0; *(u32x4*)(dst + 8) = w1;
      }
      __syncthreads();
    }
  }
  xcd_barrier(xbar);
  {
    pg8::Gemm g{(const bf16_t*)WSP(WS_XN2), (const bf16_t*)WSP(WS_WC), MX, 2048, 1024, 1024, 1024};
    EpiTopK E{(unsigned short*)WSP(WS_IDX), (float*)WSP(WS_GATE)};
    const int nrounds = (64 * 8 + (int)gridDim.x - 1) / (int)gridDim.x;
    for (int rd = 0; rd < nrounds; ++rd) {
      OneUnitSched S; S.nM = 64; S.nN = 8; S.G = (int)gridDim.x; S.c = (int)blockIdx.x; S.round = rd; S.tsA = (long)256 * 1024 * 2; S.tsB = (long)256 * 1024 * 2;
      pg8::gemm_phase<EpiTopK, OneUnitSched, false, true>((PG8_LAS unsigned char*)lds, g, S, E);
    }
  }
  xcd_barrier(xbar);
  {
    PHASE_LOCALS
    const bf16_t* XN2 = (const bf16_t*)WSP(WS_XN2); const unsigned short* EXT = (const unsigned short*)WSP(WS_IDX);
    bf16_t* PD = (bf16_t*)WSP(WS_PD);
    const bool sl = (gridDim.x & 7) == 0;
    const int widu = __builtin_amdgcn_readfirstlane(wid);
    const int j0 = sl ? (int)(blockIdx.x & 7) : 0, nj = sl ? 1 : 8;
    const int wk = sl ? (int)(blockIdx.x >> 3) * 8 + widu : (int)blockIdx.x * (NT / 64) + widu, nwk = sl ? (int)(gridDim.x >> 3) * 8 : ngw;
    const int eg = lane >> 3, li = lane & 7;
    for (int jj = 0; jj < nj; ++jj) {
      const int j = j0 + jj;
      const unsigned char* U8j = (const unsigned char*)WSP(WS_U8) + (size_t)j * 16384 * 128 + li * 16;
      for (int t = wk; t < MX; t += nwk) {
        const u32x4* xp = (const u32x4*)(XN2 + (size_t)t * 1024 + j * 128 + li * 16);
        const u32x4 xa = xp[0], xb = xp[1];
        const u32x4* ep = (const u32x4*)(EXT + (size_t)t * 128 + eg * 16);
        const u32x4 e0 = ep[0], e1 = ep[1];
        const unsigned ew[8] = {e0.x, e0.y, e0.z, e0.w, e1.x, e1.y, e1.z, e1.w};
        u32x4 uw[16];
#pragma unroll
        for (int k = 0; k < 16; ++k) { const unsigned ex = (k & 1) ? (ew[k >> 1] >> 16) : (ew[k >> 1] & 0xffffu); uw[k] = *(const u32x4*)(U8j + ex * 128u); }
        const unsigned xwd[8] = {xa.x, xa.y, xa.z, xa.w, xb.x, xb.y, xb.z, xb.w};
        f32x2_t xf[8];
#pragma unroll
        for (int q = 0; q < 8; ++q) xf[q] = (f32x2_t){bflo(xwd[q]), bfhi(xwd[q])};
        float keep_lo = 0.f, keep_hi = 0.f;
#pragma unroll
        for (int k = 0; k < 16; ++k) {
          const unsigned uu[4] = {uw[k].x, uw[k].y, uw[k].z, uw[k].w};
          f32x2_t s2 = {0.f, 0.f};
#pragma unroll
          for (int q = 0; q < 4; ++q) { s2 += __builtin_amdgcn_cvt_pk_f32_fp8((int)uu[q], false) * xf[2 * q]; s2 += __builtin_amdgcn_cvt_pk_f32_fp8((int)uu[q], true) * xf[2 * q + 1]; }
          float dp = s2.x + s2.y;
          dp = dpp_add<0xB1>(dp); dp = dpp_add<0x4E>(dp); dp = dpp_add<0x141>(dp);
          if (li == (k & 7)) { if (k < 8) keep_lo = dp; else keep_hi = dp; }
        }
        bf16_t* pd = PD + ((size_t)t * 128 + eg * 16 + li) * 8 + j;
        pd[0] = f2bf(keep_lo * (1.f / 32.f)); pd[8 * 8] = f2bf(keep_hi * (1.f / 32.f));
      }
    }
    slice_table_fp8(INP(31), (unsigned char*)WSP(WS_V8), 1.f, gtid, gsz);
  }
  xcd_barrier(xbar);
  {
    PHASE_LOCALS
    const bf16_t* PD = (const bf16_t*)WSP(WS_PD); const float* GATE = (const float*)WSP(WS_GATE); unsigned* CFP = (unsigned*)WSP(WS_CFP);
    for (int t = gw; t < MX; t += ngw) {
      const u32x4* pp = (const u32x4*)(PD + ((size_t)t * 128 + 2 * lane) * 8);
      const u32x4 pa = pp[0], pb = pp[1];
      const f32x2_t g2 = *(const f32x2_t*)(GATE + (size_t)t * 128 + 2 * lane);
      const float p0 = ((bflo(pa.x) + bfhi(pa.x)) + (bflo(pa.y) + bfhi(pa.y))) + ((bflo(pa.z) + bfhi(pa.z)) + (bflo(pa.w) + bfhi(pa.w)));
      const float p1 = ((bflo(pb.x) + bfhi(pb.x)) + (bflo(pb.y) + bfhi(pb.y))) + ((bflo(pb.z) + bfhi(pb.z)) + (bflo(pb.w) + bfhi(pb.w)));
      CFP[(size_t)t * 64 + lane] = pg8::cvt_pk_bf16(g2.x * gelu_tanh(p0), g2.y * gelu_tanh(p1));
    }
  }
  xcd_barrier(xbar);
  {
    PHASE_LOCALS
    const float* X1 = (const float*)WSP(WS_X1); const float* MOD = (const float*)WSP(WS_MOD);
    const unsigned short* EXT = (const unsigned short*)WSP(WS_IDX); const unsigned* CFP = (const unsigned*)WSP(WS_CFP);
    float* SSQ = (float*)WSP(WS_SSQ); float* out = GPTR(float, ldptr_(33));
    const bool sl = (gridDim.x & 7) == 0;
    const int widu = __builtin_amdgcn_readfirstlane(wid);
    const int j0 = sl ? (int)(blockIdx.x & 7) : 0, nj = sl ? 1 : 8;
    const int wk = sl ? (int)(blockIdx.x >> 3) * 8 + widu : (int)blockIdx.x * (NT / 64) + widu, nwk = sl ? (int)(gridDim.x >> 3) * 8 : ngw;
    const int eg = lane >> 3, li = lane & 7;
    float* red = fl + widu * 1024;
    for (int jj = 0; jj < nj; ++jj) {
      const int j = j0 + jj;
      const unsigned char* V8j = (const unsigned char*)WSP(WS_V8) + (size_t)j * 16384 * 128 + li * 16;
      for (int t = wk; t < MX; t += nwk) {
        const u32x4* ep = (const u32x4*)(EXT + (size_t)t * 128 + eg * 16);
        const u32x4 e0 = ep[0], e1 = ep[1];
        const u32x4* cp = (const u32x4*)(CFP + (size_t)t * 64 + eg * 8);
        const u32x4 c0 = cp[0], c1 = cp[1];
        const int col = j * 128 + 2 * lane;
        const f32x2_t xr = *(const f32x2_t*)(X1 + (size_t)t * 1024 + col);
        const f32x2_t gr = *(const f32x2_t*)(MOD + (t >> 12) * 6144 + 5120 + col);
        const unsigned ew[8] = {e0.x, e0.y, e0.z, e0.w, e1.x, e1.y, e1.z, e1.w};
        const unsigned cfp[8] = {c0.x, c0.y, c0.z, c0.w, c1.x, c1.y, c1.z, c1.w};
        u32x4 vw[16];
#pragma unroll
        for (int k = 0; k < 16; ++k) { const unsigned ex = (k & 1) ? (ew[k >> 1] >> 16) : (ew[k >> 1] & 0xffffu); vw[k] = *(const u32x4*)(V8j + ex * 128u); }
        f32x2_t a[8];
#pragma unroll
        for (int q = 0; q < 8; ++q) a[q] = (f32x2_t){0.f, 0.f};
#pragma unroll
        for (int k = 0; k < 16; ++k) {
          const unsigned cf2 = cfp[k >> 1]; const float cf = (k & 1) ? bfhi(cf2) : bflo(cf2);
          const unsigned vv[4] = {vw[k].x, vw[k].y, vw[k].z, vw[k].w};
#pragma unroll
          for (int q = 0; q < 4; ++q) { a[2 * q] += __builtin_amdgcn_cvt_pk_f32_fp8((int)vv[q], false) * cf; a[2 * q + 1] += __builtin_amdgcn_cvt_pk_f32_fp8((int)vv[q], true) * cf; }
        }
#pragma unroll
        for (int q = 0; q < 4; ++q) *(f32x4*)(red + eg * 128 + li * 16 + q * 4) = (f32x4){a[2 * q].x, a[2 * q].y, a[2 * q + 1].x, a[2 * q + 1].y};
        asm volatile("s_waitcnt lgkmcnt(0)" ::: "memory");
        f32x2_t acc = {0.f, 0.f};
#pragma unroll
        for (int g = 0; g < 8; ++g) acc += *(const f32x2_t*)(red + g * 128 + 2 * lane);
        asm volatile("s_waitcnt lgkmcnt(0)" ::: "memory");
        const f32x2_t o2 = xr + gr * acc;
        float ss = o2.x * o2.x + o2.y * o2.y;
        ss = wave_sum(ss);
        *(f32x2_t*)(out + (size_t)t * 1024 + col) = o2;
        if (lane == 0) SSQ[(size_t)t * 8 + j] = ss;
      }
    }
  }
  xcd_barrier(xbar);
  {
    PHASE_LOCALS
    const float* SSQ = (const float*)WSP(WS_SSQ); const float* fng = INP(32); float* out = GPTR(float, ldptr_(33));
    f32x4 g4[4];
#pragma unroll
    for (int jq = 0; jq < 4; ++jq) g4[jq] = *(const f32x4*)(fng + lane * 4 + 256 * jq);
    for (int row = gw; row < MX; row += ngw) {
      const f32x4 sa = *(const f32x4*)(SSQ + (size_t)row * 8), sb = *(const f32x4*)(SSQ + (size_t)row * 8 + 4);
      const float rstd = rsqrtf(((sa[0] + sa[1]) + (sa[2] + sa[3]) + (sb[0] + sb[1]) + (sb[2] + sb[3])) * (1.f / D) + 1e-6f);
#pragma unroll
      for (int jq = 0; jq < 4; ++jq) {
        float* op = out + (size_t)row * D + lane * 4 + 256 * jq;
        const f32x4 v = *(const f32x4*)op;
        *(f32x4*)op = v * rstd * g4[jq];
      }
    }
  }
}

extern "C" void kernel_launch(void* const* d_in, const int* in_sizes, int n_in, void* d_out, int out_size, void* d_ws, size_t ws_size, hipStream_t stream) {
  static int grid_blocks = 0;
  if (!grid_blocks) {
    int dev = 0, cus = 0, per_cu = 0;
    (void)hipGetDevice(&dev);
    (void)hipDeviceGetAttribute(&cus, hipDeviceAttributeMultiprocessorCount, dev);
    (void)hipFuncSetAttribute((const void*)mega, hipFuncAttributeMaxDynamicSharedMemorySize, LDS_BYTES);
    (void)hipOccupancyMaxActiveBlocksPerMultiprocessor(&per_cu, (const void*)mega, NT, LDS_BYTES);
    if (per_cu < 1) per_cu = 1;
    grid_blocks = cus * per_cu;
    if (n_in != 33 || ws_size < 255 * MiB) { fprintf(stderr, "kernel_launch: unexpected n_in %d / ws %zu\n", n_in, ws_size); }
  }
  Params p{};
  for (int i = 0; i < 33 && i < n_in; ++i) p.in[i] = (const float*)d_in[i];
  p.out = (float*)d_out; p.ws = (unsigned char*)d_ws;
  void* args[] = {&p};
  hipError_t e = hipLaunchCooperativeKernel((const void*)mega, dim3(grid_blocks), dim3(NT), args, LDS_BYTES, stream);
  if (e != hipSuccess) fprintf(stderr, "cooperative launch failed: %s (grid %d)\n", hipGetErrorString(e), grid_blocks);
}
```

```cpp
#include <hip/hip_runtime.h>
#include <hip/hip_cooperative_groups.h>
#include <cstdio>
#include <cstdint>
namespace cg = cooperative_groups;

typedef unsigned short bf16_t;
typedef float f32x4 __attribute__((ext_vector_type(4)));

constexpr int NT = 512;
constexpr int LDS_BYTES = 147456;
constexpr int Bn = 4, L = 4096, D = 1024, NCTX = 256, LA = L + NCTX;
constexpr int MX = Bn * L, MC = Bn * NCTX;
constexpr int N_IN = 5632;
constexpr size_t MiB = 1u << 20;
constexpr size_t WS_MOD = 0, WS_LAM = 128 * 1024, WS_ROPE = 136 * 1024, WS_ARDT = 144 * 1024, WS_AIDT = 160 * 1024;
constexpr size_t WS_ABRE = 192 * 1024, WS_ABIM = 224 * 1024, WS_BBRE = 256 * 1024, WS_BBIM = 512 * 1024;
constexpr size_t WS_FLAGS = 1 * MiB + 65536;
constexpr size_t WS_BAR = 1 * MiB;
constexpr size_t WS_KT = 2 * MiB;
constexpr size_t WS_XN = 4 * MiB, WS_Q = 38 * MiB, WS_K = 70 * MiB, WS_V = 104 * MiB, WS_SA = 138 * MiB, WS_G = 164 * MiB;
constexpr size_t WS_WIN = 228 * MiB, WS_WAU = 239 * MiB, WS_WSU = 241 * MiB, WS_WOUT = 242 * MiB, WS_WQ = 244 * MiB, WS_WGLU = 246 * MiB;
constexpr size_t WS_BTS = 247 * MiB;
constexpr size_t WS_BTY = 38 * MiB, WS_S = 62 * MiB, WS_YG = 79 * MiB, WS_SSMX = 62 * MiB, WS_M = 95 * MiB;
constexpr size_t WS_ATT = WS_XN, WS_X1 = 4 * MiB, WS_XN2 = 68 * MiB, WS_QP = WS_G;
constexpr size_t WS_IDX = 111 * MiB, WS_GATE = 115 * MiB, WS_SSQ = 123 * MiB;
constexpr size_t WS_U8 = 127 * MiB, WS_PD = 164 * MiB, WS_V8 = 196 * MiB, WS_WC = 160 * MiB, WS_CFP = 160 * MiB;
constexpr int SA_ROWS = 544, SA_LD = 768;

constexpr int PTR_OFF = LDS_BYTES - 1024;
__device__ __forceinline__ unsigned long long ldptr_(int k) {
  extern __shared__ __attribute__((aligned(16))) unsigned char lds_[];
  const unsigned long long v = ((const unsigned long long*)(lds_ + PTR_OFF))[k];
  const unsigned lo = __builtin_amdgcn_readfirstlane((unsigned)v), hi = __builtin_amdgcn_readfirstlane((unsigned)(v >> 32));
  return ((unsigned long long)hi << 32) | lo;
}
#define GPTR(T, v) ((T*)(__attribute__((address_space(1))) T*)(v))
#define INP(k) GPTR(const float, ldptr_(k))
#define WSP(off) GPTR(unsigned char, ldptr_(34) + (off))
#define PHASE_LOCALS \
  int tid = threadIdx.x; asm volatile("" : "+v"(tid)); \
  const int lane = tid & 63, wid = tid >> 6; \
  const int gtid = blockIdx.x * NT + tid, gsz = gridDim.x * NT; \
  const int gw = blockIdx.x * (NT / 64) + wid, ngw = gridDim.x * (NT / 64); \
  float* fl = (float*)lds; (void)lane; (void)wid; (void)gtid; (void)gsz; (void)gw; (void)ngw; (void)fl;

struct Params {
  const float* in[33];
  float* out;
  unsigned char* ws;
  int pad0, pad1;
};

__device__ __forceinline__ float bf2f(bf16_t v) { return __uint_as_float(((unsigned)v) << 16); }
__device__ __forceinline__ bf16_t f2bf(float f) { unsigned u = __float_as_uint(f); return (bf16_t)((u + 0x7fffu + ((u >> 16) & 1u)) >> 16); }
__device__ __forceinline__ float wave_sum(float v) {
#pragma unroll
  for (int o = 32; o; o >>= 1) v += __shfl_xor(v, o);
  return v;
}
__device__ __forceinline__ float gelu_tanh(float x) { const float u2 = -2.302208198f * (x + 0.044715f * x * x * x); return x * __builtin_amdgcn_rcpf(1.f + __builtin_amdgcn_exp2f(u2)); }
__device__ __forceinline__ float sigmoidf_(float x) { return __builtin_amdgcn_rcpf(1.f + __builtin_amdgcn_exp2f(-1.4426950408889634f * x)); }
__device__ __forceinline__ float siluf_(float x) { return x / (1.f + __expf(-x)); }

template <class Epi>
__device__ __forceinline__ void sgemm(const bf16_t* A, int lda, const float* Bm, int ldb, int M, int N, int K, float* lds, Epi epi) {
  constexpr int TM = 128, TN = 128, TK = 16, LDA_S = TM + 4, LDB_S = TN + 4;
  float* As = lds;
  float* Bs = lds + TK * LDA_S;
  const int tid = threadIdx.x, ty = tid >> 4, tx = tid & 15;
  const int ntm = M / TM, ntn = N / TN;
  for (int tile = blockIdx.x; tile < ntm * ntn; tile += gridDim.x) {
    const int tm = tile / ntn, tn = tile % ntn;
    float acc[4][8];
#pragma unroll
    for (int i = 0; i < 4; ++i)
#pragma unroll
      for (int j = 0; j < 8; ++j) acc[i][j] = 0.f;
    const int ar = tid >> 2, ak = (tid & 3) * 4;
    const int bk = tid >> 5, bn = (tid & 31) * 4;
    for (int k0 = 0; k0 < K; k0 += TK) {
      const bf16_t* ap = A + (size_t)(tm * TM + ar) * lda + k0 + ak;
      const unsigned long long av = *(const unsigned long long*)ap;
      const f32x4 bv = *(const f32x4*)(Bm + (size_t)(k0 + bk) * ldb + tn * TN + bn);
      __syncthreads();
      As[(ak + 0) * LDA_S + ar] = bf2f((bf16_t)(av & 0xffff));
      As[(ak + 1) * LDA_S + ar] = bf2f((bf16_t)((av >> 16) & 0xffff));
      As[(ak + 2) * LDA_S + ar] = bf2f((bf16_t)((av >> 32) & 0xffff));
      As[(ak + 3) * LDA_S + ar] = bf2f((bf16_t)((av >> 48) & 0xffff));
      *(f32x4*)(Bs + bk * LDB_S + bn) = bv;
      __syncthreads();
#pragma unroll
      for (int k = 0; k < TK; ++k) {
        const f32x4 a4 = *(const f32x4*)(As + k * LDA_S + ty * 4);
        const f32x4 b0 = *(const f32x4*)(Bs + k * LDB_S + tx * 8);
        const f32x4 b1 = *(const f32x4*)(Bs + k * LDB_S + tx * 8 + 4);
#pragma unroll
        for (int i = 0; i < 4; ++i) {
          acc[i][0] += a4[i] * b0[0]; acc[i][1] += a4[i] * b0[1]; acc[i][2] += a4[i] * b0[2]; acc[i][3] += a4[i] * b0[3];
          acc[i][4] += a4[i] * b1[0]; acc[i][5] += a4[i] * b1[1]; acc[i][6] += a4[i] * b1[2]; acc[i][7] += a4[i] * b1[3];
        }
      }
    }
#pragma unroll
    for (int i = 0; i < 4; ++i)
#pragma unroll
      for (int j = 0; j < 8; ++j) epi(tm * TM + ty * 4 + i, tn * TN + tx * 8 + j, acc[i][j]);
  }
  __syncthreads();
}

namespace pg8 {
#define PG8_LAS __attribute__((address_space(3)))
typedef unsigned short bf16_t;
typedef short bf16x8 __attribute__((ext_vector_type(8)));
typedef float f32x4 __attribute__((ext_vector_type(4)));
typedef unsigned u32x4 __attribute__((ext_vector_type(4)));
constexpr int BM = 256, BK = 64, HALF = 128, HTB = HALF * BK * 2  , STAGE_BYTES = 8 * HTB, NXCD = 8, WGM = 8;

__host__ __device__ __forceinline__ int lds_byte(int r, int c) { const int st = (r >> 4) * 2 + (c >> 5), rr = r & 15, cc = c & 31, ob = rr * 64 + cc * 2; return st * 1024 + (ob ^ (((ob >> 9) & 1) << 5)); }
__host__ __device__ __forceinline__ void stage_rc(int b, int& R, int& C) { const int st = b / 1024, sb = b % 1024, swz = sb ^ (((sb >> 9) & 1) << 5); R = (st >> 1) * 16 + swz / 64; C = (st & 1) * 32 + (swz % 64) / 2; }
__host__ __device__ __forceinline__ int perm32(int rho) { const int n = rho >> 4, i = rho & 15; return 8 * (i >> 2) + 4 * n + (i & 3); }

struct Unit { int pm, pn, grp; long ao, bo; };
struct Gemm { const bf16_t* A; const bf16_t* Bt; int M, N, K, lda, ldb; };

struct StaticOrder {
    int nM, nN, nwg, G, c; long tsA, tsB;
    __host__ __device__ void init(int M, int N, int G_, int c_, int lda, int ldb) { nM = M / BM; nN = N / BM; nwg = nM * nN; G = G_; c = c_; tsA = (long)BM * lda * 2; tsB = (long)BM * ldb * 2; }
    __host__ __device__ bool next(int i, Unit& u) const {
        const long L = (long)i * G + c; if (L >= nwg) return false;
        int wgid = (int)L; { const int q = nwg / NXCD, r = nwg % NXCD, xcd = wgid % NXCD, off = wgid / NXCD; wgid = (xcd < r ? xcd * (q + 1) : r * (q + 1) + (xcd - r) * q) + off; }
        const int nig = WGM * nN, gid = wgid / nig, fm = gid * WGM, gsz = (nM - fm) < WGM ? (nM - fm) : WGM;
        u.pm = fm + ((wgid % nig) % gsz); u.pn = (wgid % nig) / gsz; u.grp = 0; u.ao = u.pm * tsA; u.bo = u.pn * tsB; return true;
    }
    __device__ __forceinline__ void a_ready(const Unit&) const {}
    __device__ __forceinline__ void done(const Unit&) const {}
};

__device__ __forceinline__ unsigned cvt_pk_bf16(float lo, float hi) { unsigned r; asm volatile("v_cvt_pk_bf16_f32 %0, %1, %2" : "=v"(r) : "v"(lo), "v"(hi)); return r; }
template <class Epi, class Sched, bool ALIGN_EPI = false, bool SP2 = false>
__device__ __forceinline__ void gemm_phase(PG8_LAS unsigned char* lds, const Gemm g, const Sched& S, const Epi& E) {
    int tid_ = threadIdx.x; asm volatile("" : "+v"(tid_));
    const int tid = tid_, wid = __builtin_amdgcn_readfirstlane(tid >> 6), lane = tid & 63, wr = wid >> 2, wc = wid & 3, fr = lane & 15, fq = lane >> 4;
    const int K = g.K, nt = K / BK;
    unsigned voffA[2], voffB[2];
#pragma unroll
    for (int i = 0; i < 2; ++i) { int R, C; stage_rc(tid * 16 + i * 8192, R, C); const int Rb = Epi::PERM ? ((R & ~31) + perm32(R & 31)) : R;
        voffA[i] = (unsigned)(R * g.lda + C) * 2u; voffB[i] = (unsigned)(Rb * g.ldb + C) * 2u; }
    const size_t kstep = (size_t)(BK * 2);
    const size_t hstepA = (size_t)HALF * g.lda * 2, hstepB = (size_t)HALF * g.ldb * 2;
    const unsigned ldsw = (unsigned)wid * 1024u;
    const int aoff = lds_byte(wr * 64 + fr, fq * 8), boff = lds_byte(wc * 32 + fr, fq * 8);
#define PG8_SA(b, h) (((b) * 2 + (h)) * HTB)
#define PG8_SB(b, h) ((4 + (b) * 2 + (h)) * HTB)
#define PG8_STAGE(bufoff, gbase, voff) do { _Pragma("unroll") for (int _i = 0; _i < 2; ++_i) \
        __builtin_amdgcn_global_load_lds((const unsigned*)((const char*)(gbase) + (voff)[_i]), (PG8_LAS unsigned*)(lds + (bufoff) + ldsw + _i * 8192), 16, 0, 0); } while (0)
#define PG8_LDA(dst, b, h) do { _Pragma("unroll") for (int m = 0; m < 4; ++m) _Pragma("unroll") for (int k = 0; k < 2; ++k) dst[m][k] = *(const PG8_LAS bf16x8*)(lds + PG8_SA(b, h) + aoff + m * 2048 + k * 1024); } while (0)
#define PG8_LDB(dst, b, h) do { _Pragma("unroll") for (int n = 0; n < 2; ++n) _Pragma("unroll") for (int k = 0; k < 2; ++k) dst[n][k] = *(const PG8_LAS bf16x8*)(lds + PG8_SB(b, h) + boff + n * 2048 + k * 1024); } while (0)
#define PG8_MMA(ai, bj, At, Bt) do { __builtin_amdgcn_s_setprio(1); _Pragma("unroll") for (int m = 0; m < 4; ++m) _Pragma("unroll") for (int n = 0; n < 2; ++n) _Pragma("unroll") for (int k = 0; k < 2; ++k) \
        acc[ai][bj][m][n] = __builtin_amdgcn_mfma_f32_16x16x32_bf16(Bt[n][k], At[m][k], acc[ai][bj][m][n], 0, 0, 0); __builtin_amdgcn_s_setprio(0); } while (0)
#define PG8_WAIT_V(n) asm volatile("s_waitcnt vmcnt(" #n ")" ::: "memory")
#define PG8_WAIT_L(n) asm volatile("s_waitcnt lgkmcnt(" #n ")" ::: "memory")
#define PG8_BAR __builtin_amdgcn_s_barrier()
#define PG8_SCHED __builtin_amdgcn_sched_barrier(0)
    Unit cur, nxt; int ui = 0;
    if (!S.next(0, cur)) return;
    f32x4 acc[2][2][4][2];
#pragma unroll
    for (int a = 0; a < 2; ++a)
#pragma unroll
        for (int b = 0; b < 2; ++b)
#pragma unroll
            for (int m = 0; m < 4; ++m)
#pragma unroll
                for (int n = 0; n < 2; ++n) acc[a][b][m][n] = (f32x4){0.f, 0.f, 0.f, 0.f};
    bf16x8 At[4][2], B0[2][2], B1[2][2];
    const char* cA = (const char*)g.A + cur.ao; const char* cB = (const char*)g.Bt + cur.bo;
    S.a_ready(cur);
    if constexpr (SP2) {
        PG8_STAGE(PG8_SB(0, 0), cB, voffB); PG8_STAGE(PG8_SB(0, 1), cB + hstepB, voffB); PG8_STAGE(PG8_SA(0, 0), cA, voffA); PG8_STAGE(PG8_SA(0, 1), cA + hstepA, voffA);
        if (wr == 1) PG8_BAR;
        PG8_WAIT_V(2); PG8_BAR;
        PG8_STAGE(PG8_SB(1, 0), cB + kstep, voffB); PG8_STAGE(PG8_SA(1, 0), cA + kstep, voffA); PG8_STAGE(PG8_SB(1, 1), cB + hstepB + kstep, voffB);
        PG8_WAIT_V(6); PG8_BAR;
    } else {
        PG8_STAGE(PG8_SB(0, 0), cB, voffB); PG8_STAGE(PG8_SA(0, 0), cA, voffA); PG8_STAGE(PG8_SB(0, 1), cB + hstepB, voffB); PG8_STAGE(PG8_SA(0, 1), cA + hstepA, voffA);
        if (wr == 1) PG8_BAR;
        PG8_WAIT_V(4); PG8_BAR;
        PG8_STAGE(PG8_SB(1, 0), cB + kstep, voffB); PG8_STAGE(PG8_SA(1, 0), cA + kstep, voffA); PG8_STAGE(PG8_SB(1, 1), cB + hstepB + kstep, voffB);
        PG8_WAIT_V(6); PG8_BAR;
    }
    for (;;) {
        const bool has_next = S.next(ui + 1, nxt);
        const char* nA = has_next ? (const char*)g.A + nxt.ao : cA; const char* nB = has_next ? (const char*)g.Bt + nxt.bo : cB;
        for (int t = 0; t < nt; t += 2) {
            const bool last = (t == nt - 2);
            const char* a1 = cA + (size_t)(t + 1) * kstep;
            const char* a2 = last ? nA : cA + (size_t)(t + 2) * kstep; const char* b2 = last ? nB : cB + (size_t)(t + 2) * kstep;
            const char* a3 = a2 + kstep; const char* b3 = b2 + kstep;
            if (last && has_next) S.a_ready(nxt);
            if constexpr (SP2) {
            PG8_LDB(B0, 0, 0); PG8_LDB(B1, 0, 1); PG8_SCHED; PG8_LDA(At, 0, 0); PG8_STAGE(PG8_SA(1, 1), a1 + hstepA, voffA);
            PG8_WAIT_V(8); PG8_WAIT_L(0); PG8_BAR; PG8_MMA(0, 0, At, B0); PG8_MMA(0, 1, At, B1); PG8_BAR; PG8_SCHED;
            PG8_LDA(At, 0, 1); PG8_STAGE(PG8_SB(0, 0), b2, voffB); PG8_STAGE(PG8_SB(0, 1), b2 + hstepB, voffB); PG8_STAGE(PG8_SA(0, 0), a2, voffA);
            PG8_WAIT_V(8); PG8_WAIT_L(0); PG8_BAR; PG8_MMA(1, 0, At, B0); PG8_MMA(1, 1, At, B1); PG8_BAR; PG8_SCHED;
            PG8_LDB(B0, 1, 0); PG8_LDB(B1, 1, 1); PG8_SCHED; PG8_LDA(At, 1, 0); PG8_STAGE(PG8_SA(0, 1), a2 + hstepA, voffA);
            PG8_WAIT_V(8); PG8_WAIT_L(0); PG8_BAR; PG8_MMA(0, 0, At, B0); PG8_MMA(0, 1, At, B1); PG8_BAR; PG8_SCHED;
            PG8_LDA(At, 1, 1); PG8_STAGE(PG8_SB(1, 0), b3, voffB); PG8_STAGE(PG8_SB(1, 1), b3 + hstepB, voffB); PG8_STAGE(PG8_SA(1, 0), a3, voffA);
            PG8_WAIT_V(8); PG8_WAIT_L(0); PG8_BAR; PG8_MMA(1, 0, At, B0); PG8_MMA(1, 1, At, B1); PG8_BAR; PG8_SCHED;
            } else {
            PG8_LDB(B0, 0, 0); PG8_SCHED; PG8_LDA(At, 0, 0); PG8_STAGE(PG8_SA(1, 1), a1 + hstepA, voffA);
            PG8_WAIT_L(8); PG8_BAR; PG8_WAIT_L(0); PG8_MMA(0, 0, At, B0); PG8_BAR; PG8_SCHED;
            PG8_LDB(B1, 0, 1); PG8_STAGE(PG8_SB(0, 0), b2, voffB);
            PG8_BAR; PG8_WAIT_L(0); PG8_MMA(0, 1, At, B1); PG8_BAR;
            PG8_LDA(At, 0, 1); PG8_STAGE(PG8_SA(0, 0), a2, voffA);
            PG8_BAR; PG8_WAIT_L(0); PG8_MMA(1, 0, At, B0); PG8_BAR; PG8_SCHED;
            PG8_STAGE(PG8_SB(0, 1), b2 + hstepB, voffB);
            PG8_WAIT_V(6); PG8_BAR; PG8_MMA(1, 1, At, B1); PG8_BAR;
            PG8_LDB(B0, 1, 0); PG8_SCHED; PG8_LDA(At, 1, 0); PG8_STAGE(PG8_SA(0, 1), a2 + hstepA, voffA);
            PG8_WAIT_L(8); PG8_BAR; PG8_WAIT_L(0); PG8_MMA(0, 0, At, B0); PG8_BAR; PG8_SCHED;
            PG8_LDB(B1, 1, 1); PG8_STAGE(PG8_SB(1, 0), b3, voffB);
            PG8_BAR; PG8_WAIT_L(0); PG8_MMA(0, 1, At, B1); PG8_BAR;
            PG8_LDA(At, 1, 1); PG8_STAGE(PG8_SA(1, 0), a3, voffA);
            PG8_BAR; PG8_WAIT_L(0); PG8_MMA(1, 0, At, B0); PG8_BAR; PG8_SCHED;
            PG8_STAGE(PG8_SB(1, 1), b3 + hstepB, voffB);
            PG8_WAIT_V(6); PG8_BAR; PG8_MMA(1, 1, At, B1); PG8_BAR;
            }
        }
        if constexpr (ALIGN_EPI) { if (wr == 0) PG8_BAR; }
        if constexpr (!Epi::AFTER_DRAIN) { int fr_ = fr, fq_ = fq; asm volatile("" : "+v"(fr_), "+v"(fq_));
            E(acc, cur, wr, wc, fr_, fq_); S.done(cur); }
        if (!has_next) break;
#pragma unroll
        for (int a = 0; a < 2; ++a)
#pragma unroll
            for (int b = 0; b < 2; ++b)
#pragma unroll
                for (int m = 0; m < 4; ++m)
#pragma unroll
                    for (int n = 0; n < 2; ++n) acc[a][b][m][n] = (f32x4){0.f, 0.f, 0.f, 0.f};
        cur = nxt; cA = nA; cB = nB; ++ui;
        if constexpr (ALIGN_EPI) { if (wr == 1) PG8_BAR; }
    }
    PG8_WAIT_V(0);
    if constexpr (!ALIGN_EPI) { if (wr == 0) PG8_BAR; }
    PG8_BAR;
    if constexpr (Epi::AFTER_DRAIN) { int fr_ = fr, fq_ = fq, lane_ = lane; asm volatile("" : "+v"(fr_), "+v"(fq_), "+v"(lane_)); E.fused(acc, cur, wr, wc, fr_, fq_, lds, wid, lane_); S.done(cur); }
#undef PG8_SA
#undef PG8_SB
#undef PG8_STAGE
#undef PG8_LDA
#undef PG8_LDB
#undef PG8_MMA
#undef PG8_WAIT_V
#undef PG8_WAIT_L
#undef PG8_BAR
#undef PG8_SCHED
}
}


using pg8::Unit;
typedef unsigned u32x2 __attribute__((ext_vector_type(2)));
typedef unsigned u32x4 __attribute__((ext_vector_type(4)));
__device__ __forceinline__ float bflo(unsigned w) { return __uint_as_float(w << 16); }
__device__ __forceinline__ float bfhi(unsigned w) { return __uint_as_float(w & 0xffff0000u); }

struct InProjSched {
  pg8::StaticOrder so;
  __device__ __forceinline__ void init(int G, int c) { so.init(MX, N_IN, G, c, D, D); }
  __device__ __forceinline__ bool next(int i, Unit& u) const {
    const long Lx = (long)i * so.G + so.c;
    if (Lx < so.nwg) return so.next(i, u);
    const int j = (int)(Lx - so.nwg); if (j >= 40) return false;
    u.pm = 64 + (j & 3); u.pn = 4 + (j >> 2); u.grp = 0; u.ao = u.pm * so.tsA; u.bo = u.pn * so.tsB; return true;
  }
  __device__ __forceinline__ void a_ready(const Unit&) const {}
  __device__ __forceinline__ void done(const Unit&) const {}
};

struct EpiInProj {
  static constexpr bool PERM = true, AFTER_DRAIN = false;
  bf16_t *Q, *K, *V, *SA, *G; const float* rope;
  __device__ __forceinline__ static void st8(bf16_t* p, const f32x4 a, const f32x4 b) {
    u32x4 w; w.x = pg8::cvt_pk_bf16(a[0], a[1]); w.y = pg8::cvt_pk_bf16(a[2], a[3]); w.z = pg8::cvt_pk_bf16(b[0], b[1]); w.w = pg8::cvt_pk_bf16(b[2], b[3]); *(u32x4*)p = w; }
  __device__ __forceinline__ static f32x4 partner4(const f32x4 v, const bool upper) {
    f32x4 r;
#pragma unroll
    for (int i = 0; i < 4; ++i) { auto rr = __builtin_amdgcn_permlane32_swap(__float_as_uint(v[i]), __float_as_uint(v[i]), false, false); r[i] = __uint_as_float(upper ? rr[0] : rr[1]); }
    return r;
  }
  __device__ __forceinline__ void operator()(const f32x4 (&acc)[2][2][4][2], const Unit& u, int wr, int wc, int fr, int fq) const {
    const int row0 = u.pm * 256 + wr * 64 + fr;
    const int cg0 = u.pn * 256 + wc * 32 + fq * 8;
    if (u.pm < 64) {
      if (u.pn < 8) {
        const bool isq = u.pn < 4; const float qsc = isq ? 0.125f * 1.4426950408889634f : 1.f;
        const bool upper = fq >= 2; const float sgn = upper ? 1.f : -1.f;
#pragma unroll
        for (int ai = 0; ai < 2; ++ai)
#pragma unroll
          for (int m = 0; m < 4; ++m) {
            const int row = row0 + ai * 128 + m * 16, b = row >> 12, t = row & 4095;
            const int pos = (wc & 1) ? (t & 63) : (t >> 6);
            const f32x4* rp = (const f32x4*)(rope + (pos * 16 + (fq & 1) * 8) * 2);
            const f32x4 r0 = rp[0], r1 = rp[1], r2 = rp[2], r3 = rp[3];
            const f32x4 cs0 = {r0[0], r0[2], r1[0], r1[2]}, sn0 = {r0[1], r0[3], r1[1], r1[3]}, cs1 = {r2[0], r2[2], r3[0], r3[2]}, sn1 = {r2[1], r2[3], r3[1], r3[3]};
            bf16_t* dst = isq ? Q + (size_t)row * 1024 + cg0 : K + ((size_t)b * LA + NCTX + t) * 1024 + (cg0 - 1024);
#pragma unroll
            for (int bj = 0; bj < 2; ++bj) {
              const f32x4 v0 = acc[ai][bj][m][0], v1 = acc[ai][bj][m][1];
              const f32x4 p0 = partner4(v0, upper), p1 = partner4(v1, upper);
              st8(dst + bj * 128, (v0 * cs0 + p0 * sn0 * sgn) * qsc, (v1 * cs1 + p1 * sn1 * sgn) * qsc);
            }
          }
      } else {
#pragma unroll
        for (int ai = 0; ai < 2; ++ai)
#pragma unroll
          for (int m = 0; m < 4; ++m) {
            const int row = row0 + ai * 128 + m * 16, b = row >> 12, t = row & 4095;
            const size_t kr = (size_t)b * LA + NCTX + t;
            if (u.pn >= 12 && u.pn < 14) {
#pragma unroll
              for (int bj = 0; bj < 2; ++bj) {
                const int ch = cg0 + bj * 128 - 3072;
                st8(SA + ((size_t)(ch >> 4) * SA_ROWS + b * 128 + (t >> 5)) * SA_LD + (t & 31) * 16 + (ch & 15), acc[ai][bj][m][0], acc[ai][bj][m][1]);
              }
            } else {
              bf16_t* dst = u.pn < 12 ? V + kr * 1024 + (cg0 - 2048) : G + (size_t)row * 2048 + (cg0 - 3584);
#pragma unroll
              for (int bj = 0; bj < 2; ++bj) {
                f32x4 v0 = acc[ai][bj][m][0], v1 = acc[ai][bj][m][1];
                if (u.pn >= 14) {
#pragma unroll
                  for (int i = 0; i < 4; ++i) { v0[i] = sigmoidf_(v0[i]); v1[i] = sigmoidf_(v1[i]); }
                }
                st8(dst + bj * 128, v0, v1);
              }
            }
          }
      }
    } else {
#pragma unroll
      for (int ai = 0; ai < 2; ++ai)
#pragma unroll
        for (int m = 0; m < 4; ++m) {
          const int rc = row0 + ai * 128 + m * 16 - MX, b = rc >> 8, t = rc & 255;
          const size_t kr = (size_t)b * LA + t;
          if (u.pn >= 12) {
#pragma unroll
            for (int bj = 0; bj < 2; ++bj) {
              const int ch = cg0 + bj * 128 - 3072;
              st8(SA + ((size_t)(ch >> 4) * SA_ROWS + 512 + b * 8 + (t >> 5)) * SA_LD + (t & 31) * 16 + (ch & 15), acc[ai][bj][m][0], acc[ai][bj][m][1]);
            }
          } else {
            bf16_t* dst = u.pn < 8 ? K + kr * 1024 + (cg0 - 1024) : V + kr * 1024 + (cg0 - 2048);
#pragma unroll
            for (int bj = 0; bj < 2; ++bj) st8(dst + bj * 128, acc[ai][bj][m][0], acc[ai][bj][m][1]);
          }
        }
    }
  }
};
template <int MODE>
struct EpiBf8 {
  static constexpr bool PERM = true, AFTER_DRAIN = false;
  bf16_t* O; int ldo; const bf16_t* X; int ldx; const float* bias;
  __device__ __forceinline__ void operator()(const f32x4 (&acc)[2][2][4][2], const Unit& u, int wr, int wc, int fr, int fq) const {
    const int row0 = u.pm * 256 + wr * 64 + fr, col0 = u.pn * 256 + wc * 32 + 8 * fq;
#pragma unroll
    for (int ai = 0; ai < 2; ++ai)
#pragma unroll
      for (int m = 0; m < 4; ++m) {
        const int row = row0 + ai * 128 + m * 16;
#pragma unroll
        for (int bj = 0; bj < 2; ++bj) {
          const int col = col0 + bj * 128;
          f32x4 v0 = acc[ai][bj][m][0], v1 = acc[ai][bj][m][1];
          const u32x4 xw = *(const u32x4*)(X + (size_t)row * ldx + col);
          const f32x4 x0 = {bflo(xw.x), bfhi(xw.x), bflo(xw.y), bfhi(xw.y)}, x1 = {bflo(xw.z), bfhi(xw.z), bflo(xw.w), bfhi(xw.w)};
          if (MODE == 0) {
            const f32x4 b0 = *(const f32x4*)(bias + col), b1 = *(const f32x4*)(bias + col + 4);
#pragma unroll
            for (int i = 0; i < 4; ++i) { v0[i] = x0[i] * sigmoidf_(v0[i] + b0[i]); v1[i] = x1[i] * sigmoidf_(v1[i] + b1[i]); }
          } else if (MODE == 1) { v0 = v0 * x0; v1 = v1 * x1; }
          else {
            const u32x4 ow = *(const u32x4*)(O + (size_t)row * ldo + col);
            const f32x4 o0 = {bflo(ow.x), bfhi(ow.x), bflo(ow.y), bfhi(ow.y)}, o1 = {bflo(ow.z), bfhi(ow.z), bflo(ow.w), bfhi(ow.w)};
            v0 = o0 + v0 * x0; v1 = o1 + v1 * x1;
          }
          u32x4 w; w.x = pg8::cvt_pk_bf16(v0[0], v0[1]); w.y = pg8::cvt_pk_bf16(v0[2], v0[3]); w.z = pg8::cvt_pk_bf16(v1[0], v1[1]); w.w = pg8::cvt_pk_bf16(v1[2], v1[3]);
          *(u32x4*)(O + (size_t)row * ldo + col) = w;
        }
      }
  }
};
template <int MODE>
struct EpiF32 {
  static constexpr bool PERM = false, AFTER_DRAIN = false;
  float* O; const float* xres; const float* mod;
  __device__ __forceinline__ void operator()(const f32x4 (&acc)[2][2][4][2], const Unit& u, int wr, int wc, int fr, int fq) const {
    const int row0 = u.pm * 256 + wr * 64 + fr, col0 = u.pn * 256 + wc * 32 + 4 * fq;
#pragma unroll
    for (int ai = 0; ai < 2; ++ai)
#pragma unroll
      for (int m = 0; m < 4; ++m) {
        const int row = row0 + ai * 128 + m * 16;
#pragma unroll
        for (int bj = 0; bj < 2; ++bj)
#pragma unroll
          for (int n = 0; n < 2; ++n) {
            const int col = col0 + bj * 128 + n * 16;
            f32x4 v = acc[ai][bj][m][n];
            if (MODE == 1) { const f32x4 xr = *(const f32x4*)(xres + (size_t)row * 1024 + col); const f32x4 g = *(const f32x4*)(mod + (row >> 12) * 6144 + 2048 + col); v = xr + g * v; }
            *(f32x4*)(O + (size_t)row * 1024 + col) = v;
          }
      }
  }
};


struct GroupSched {
  int npm, npn, nunits, G, c; long gsA, gsB, tsA, tsB;
  __device__ __forceinline__ void init(int ngrp, int npm_, int npn_, long gsA_, long tsA_, long gsB_, long tsB_, int G_, int c_) { npm = npm_; npn = npn_; nunits = ngrp * npm_ * npn_; gsA = gsA_; tsA = tsA_; gsB = gsB_; tsB = tsB_; G = G_; c = c_; }
  __device__ __forceinline__ bool next(int i, Unit& u) const {
    const long Lx = (long)i * G + c; if (Lx >= nunits) return false;
    const int per = npm * npn, grp = (int)Lx / per, r = (int)Lx % per;
    u.grp = grp; u.pm = r / npn; u.pn = r % npn; u.ao = grp * gsA + u.pm * tsA; u.bo = grp * gsB + u.pn * tsB; return true;
  }
  __device__ __forceinline__ void a_ready(const Unit&) const {}
  __device__ __forceinline__ void done(const Unit&) const {}
};
struct EpiS {
  static constexpr bool PERM = false, AFTER_DRAIN = false;
  float* S;
  __device__ __forceinline__ void operator()(const f32x4 (&acc)[2][2][4][2], const Unit& u, int wr, int wc, int fr, int fq) const {
    const int row0 = u.pm * 256 + wr * 64 + fr, col0 = wc * 32 + 4 * fq;
#pragma unroll
    for (int ai = 0; ai < 2; ++ai)
#pragma unroll
      for (int m = 0; m < 4; ++m) {
        const int row = row0 + ai * 128 + m * 16;
        if (row < SA_ROWS) {
#pragma unroll
          for (int bj = 0; bj < 2; ++bj)
#pragma unroll
            for (int n = 0; n < 2; ++n) *(f32x4*)(S + ((size_t)u.grp * SA_ROWS + row) * 256 + col0 + bj * 128 + n * 16) = acc[ai][bj][m][n];
        }
      }
  }
};
struct EpiY {
  static constexpr bool PERM = true, AFTER_DRAIN = false;
  bf16_t* YG;
  __device__ __forceinline__ void operator()(const f32x4 (&acc)[2][2][4][2], const Unit& u, int wr, int wc, int fr, int fq) const {
    const int row0 = u.pm * 256 + wr * 64 + fr, col0 = u.pn * 256 + wc * 32 + 8 * fq;
#pragma unroll
    for (int ai = 0; ai < 2; ++ai)
#pragma unroll
      for (int m = 0; m < 4; ++m) {
        const int row = row0 + ai * 128 + m * 16, b = row >> 7, cx = row & 127;
#pragma unroll
        for (int bj = 0; bj < 2; ++bj) {
          const int col = col0 + bj * 128, j = col >> 4, p0 = col & 15;
          const f32x4 v0 = acc[ai][bj][m][0], v1 = acc[ai][bj][m][1];
          u32x4 w; w.x = pg8::cvt_pk_bf16(gelu_tanh(v0[0]), gelu_tanh(v0[1])); w.y = pg8::cvt_pk_bf16(gelu_tanh(v0[2]), gelu_tanh(v0[3]));
          w.z = pg8::cvt_pk_bf16(gelu_tanh(v1[0]), gelu_tanh(v1[1])); w.w = pg8::cvt_pk_bf16(gelu_tanh(v1[2]), gelu_tanh(v1[3]));
          *(u32x4*)(YG + ((size_t)(b * L + cx * 32 + j)) * 512 + u.grp * 16 + p0) = w;
        }
      }
  }
};


__device__ __forceinline__ unsigned f2key(float s) { const unsigned u = __float_as_uint(s); return u ^ ((u & 0x80000000u) ? 0xFFFFFFFFu : 0x80000000u); }
__device__ __forceinline__ float key2f(unsigned k) { return __uint_as_float(k ^ ((k & 0x80000000u) ? 0x80000000u : 0xFFFFFFFFu)); }
#define TK_INSERT(L, cv) do { _Pragma("unroll") for (int k_ = 0; k_ < 16; ++k_) { const unsigned hi_ = L[k_] > cv ? L[k_] : cv, lo_ = L[k_] > cv ? cv : L[k_]; L[k_] = hi_; cv = lo_; } } while (0)
#define TK_CX(X, Y) do { const unsigned hi_ = (X) > (Y) ? (X) : (Y), lo_ = (X) > (Y) ? (Y) : (X); (X) = hi_; (Y) = lo_; } while (0)
#define TK_SORT16(A, B) do { _Pragma("unroll") for (int k_ = 2; k_ <= 16; k_ <<= 1) _Pragma("unroll") for (int j_ = k_ >> 1; j_ > 0; j_ >>= 1) _Pragma("unroll") for (int i_ = 0; i_ < 16; ++i_) { \
    const int l_ = i_ ^ j_; if (l_ > i_) { if ((i_ & k_) == 0) TK_CX(A[(B) + i_], A[(B) + l_]); else TK_CX(A[(B) + l_], A[(B) + i_]); } } } while (0)
#define TK_MERGE16(A, P, Q) do { _Pragma("unroll") for (int i_ = 0; i_ < 16; ++i_) A[(P) + i_] = A[(P) + i_] > A[(Q) + 15 - i_] ? A[(P) + i_] : A[(Q) + 15 - i_]; \
    _Pragma("unroll") for (int j_ = 8; j_ > 0; j_ >>= 1) _Pragma("unroll") for (int i_ = 0; i_ < 16; ++i_) { const int l_ = i_ ^ j_; if (l_ > i_) TK_CX(A[(P) + i_], A[(P) + l_]); } } while (0)
struct EpiTopK {
  static constexpr bool PERM = false, AFTER_DRAIN = true;
  unsigned short* IDX; float* GATE;
  __device__ __forceinline__ void fused(f32x4 (&acc)[2][2][4][2], const Unit& u, int wr, int wc, int fr, int fq, PG8_LAS unsigned char* lds, int wid, int lane) const {
    PG8_LAS float* SC = (PG8_LAS float*)lds;
    const int tid = wid * 64 + lane;
#pragma unroll
    for (int ai = 0; ai < 2; ++ai) {
#pragma unroll
      for (int m = 0; m < 4; ++m)
#pragma unroll
        for (int bj = 0; bj < 2; ++bj)
#pragma unroll
          for (int n = 0; n < 2; ++n)
#pragma unroll
            for (int i = 0; i < 4; ++i) SC[(64 * wr + 16 * m + fr) * 257 + 128 * bj + 32 * wc + 16 * n + 4 * fq + i] = acc[ai][bj][m][n][i];
      asm volatile("s_waitcnt lgkmcnt(0)" ::: "memory"); __builtin_amdgcn_s_barrier(); asm volatile("" ::: "memory");
      {
        const int hf = tid >> 8;
        PG8_LAS float* rowp = SC + (tid & 127) * 257 + ((tid >> 7) & 1) * 128 + hf * 64;
        unsigned a[48];
#pragma unroll
        for (int k = 0; k < 32; ++k) a[k] = (f2key(rowp[k]) & ~0x7Fu) | (unsigned)(127 - (hf * 64 + k));
        TK_SORT16(a, 0); TK_SORT16(a, 16); TK_MERGE16(a, 0, 16);
#pragma unroll
        for (int k = 0; k < 32; ++k) a[16 + k] = (f2key(rowp[32 + k]) & ~0x7Fu) | (unsigned)(127 - (hf * 64 + 32 + k));
        TK_SORT16(a, 16); TK_SORT16(a, 32); TK_MERGE16(a, 16, 32); TK_MERGE16(a, 0, 16);
#pragma unroll
        for (int k = 0; k < 16; ++k) rowp[k] = __uint_as_float(a[k]);
      }
      asm volatile("s_waitcnt lgkmcnt(0)" ::: "memory"); __builtin_amdgcn_s_barrier(); asm volatile("" ::: "memory");
      if (tid < 256) {
        PG8_LAS float* rowp = SC + (tid & 127) * 257 + (tid >> 7) * 128;
        unsigned a[32];
#pragma unroll
        for (int k = 0; k < 16; ++k) { a[k] = __float_as_uint(rowp[k]); a[16 + k] = __float_as_uint(rowp[64 + k]); }
        TK_MERGE16(a, 0, 16);
#pragma unroll
        for (int k = 0; k < 16; ++k) rowp[k] = __uint_as_float(a[k]);
      }
      asm volatile("s_waitcnt lgkmcnt(0)" ::: "memory"); __builtin_amdgcn_s_barrier(); asm volatile("" ::: "memory");
      if (tid < 128) {
        PG8_LAS float* rowp = SC + tid * 257;
        float v1[16], v2[16];
#pragma unroll
        for (int k = 0; k < 16; ++k) { v1[k] = key2f(__float_as_uint(rowp[k]) & ~0x7Fu); v2[k] = key2f(__float_as_uint(rowp[128 + k]) & ~0x7Fu); }
        unsigned Lc[16];
#pragma unroll
        for (int k = 0; k < 16; ++k) Lc[k] = 0u;
#pragma unroll
        for (int a = 0; a < 16; ++a)
#pragma unroll
          for (int b = 0; b < 16; ++b)
            if ((a + 1) * (b + 1) <= 16) { unsigned cv = (f2key(v1[a] + v2[b]) & ~0xFFu) | (unsigned)(255 - (a * 16 + b)); TK_INSERT(Lc, cv); }
        float ev[16]; float den = 0.f; const float mx = key2f(Lc[0] & ~0xFFu);
#pragma unroll
        for (int k = 0; k < 16; ++k) { ev[k] = __expf(key2f(Lc[k] & ~0xFFu) - mx); den += ev[k]; }
        const float inv = 1.f / den;
        const size_t o = ((size_t)(u.pm * 256 + ai * 128 + tid) * 8 + u.pn) * 16;
        unsigned iw[8];
#pragma unroll
        for (int k = 0; k < 16; ++k) {
          const int code = 255 - (int)(Lc[k] & 0xFFu), a = code >> 4, b = code & 15;
          const unsigned e1 = 127u - (__float_as_uint(rowp[a]) & 0x7Fu), e2 = 127u - (__float_as_uint(rowp[128 + b]) & 0x7Fu);
          const unsigned ex = e1 * 128u + e2;
          if (k & 1) iw[k >> 1] |= ex << 16; else iw[k >> 1] = ex;
        }
        *(u32x4*)(IDX + o) = (u32x4){iw[0], iw[1], iw[2], iw[3]}; *(u32x4*)(IDX + o + 8) = (u32x4){iw[4], iw[5], iw[6], iw[7]};
#pragma unroll
        for (int k = 0; k < 16; k += 4) *(f32x4*)(GATE + o + k) = (f32x4){ev[k] * inv, ev[k + 1] * inv, ev[k + 2] * inv, ev[k + 3] * inv};
      }
      asm volatile("s_waitcnt lgkmcnt(0)" ::: "memory"); __builtin_amdgcn_s_barrier(); asm volatile("" ::: "memory");
    }
  }
};
struct OneUnitSched {
  int nM, nN, G, c, round; long tsA, tsB;
  __device__ __forceinline__ bool next(int i, Unit& u) const {
    if (i > 0) return false;
    const long Lx = (long)round * G + c; if (Lx >= (long)nM * nN) return false;
    u.pm = (int)(Lx % nM); u.pn = (int)(Lx / nM); u.grp = 0; u.ao = u.pm * tsA; u.bo = u.pn * tsB; return true;
  }
  __device__ __forceinline__ void a_ready(const Unit&) const {}
  __device__ __forceinline__ void done(const Unit&) const {}
};

__device__ __forceinline__ void transpose_item64(const float* W, int K, int N, bf16_t* WT, float* scr, int item, int lane) {
  const int nblk = N / 64, kb = item / nblk, nb = item % nblk, k0 = 64 * kb, n0 = 64 * nb;
  f32x4 v[16];
#pragma unroll
  for (int i = 0; i < 16; ++i) v[i] = *(const f32x4*)(W + (size_t)(k0 + 4 * i + (lane >> 4)) * N + n0 + (lane & 15) * 4);
#pragma unroll
  for (int i = 0; i < 16; ++i) { float* d = scr + (4 * i + (lane >> 4)) * 65 + (lane & 15) * 4; d[0] = v[i][0]; d[1] = v[i][1]; d[2] = v[i][2]; d[3] = v[i][3]; }
  asm volatile("s_waitcnt lgkmcnt(0)" ::: "memory");
  const int c = lane & 7;
#pragma unroll
  for (int j = 0; j < 8; ++j) {
    const int n = (lane >> 3) + 8 * j; const float* s = scr + (8 * c) * 65 + n;
    u32x4 o; o.x = pg8::cvt_pk_bf16(s[0], s[65]); o.y = pg8::cvt_pk_bf16(s[130], s[195]); o.z = pg8::cvt_pk_bf16(s[260], s[325]); o.w = pg8::cvt_pk_bf16(s[390], s[455]);
    *(u32x4*)(WT + (size_t)(n0 + n) * K + k0 + 8 * c) = o;
  }
  asm volatile("s_waitcnt lgkmcnt(0)" ::: "memory");
}
__device__ __forceinline__ void transpose_item(const float* W, int K, int N, bf16_t* WT, float* scr, int item, int lane) {
  const int nblk = N / 32, kb = item / nblk, nb = item % nblk, k0 = 64 * kb, n0 = 32 * nb;
#pragma unroll 8
  for (int i = 0; i < 32; ++i) { const int kk = 2 * i + (lane >> 5); scr[kk * 33 + (lane & 31)] = W[(size_t)(k0 + kk) * N + n0 + (lane & 31)]; }
  asm volatile("s_waitcnt lgkmcnt(0)" ::: "memory");
  const int c = lane & 7;
#pragma unroll
  for (int j = 0; j < 4; ++j) {
    const int n = (lane >> 3) + 8 * j; const float* s = scr + (8 * c) * 33 + n;
    u32x4 o; o.x = pg8::cvt_pk_bf16(s[0], s[33]); o.y = pg8::cvt_pk_bf16(s[66], s[99]); o.z = pg8::cvt_pk_bf16(s[132], s[165]); o.w = pg8::cvt_pk_bf16(s[198], s[231]);
    *(u32x4*)(WT + (size_t)(n0 + n) * K + k0 + 8 * c) = o;
  }
  asm volatile("s_waitcnt lgkmcnt(0)" ::: "memory");
}

namespace att {
using bf16 = unsigned short;
constexpr int   D = 128, NW = 8, QBLK = 32, KVBLK = 64, SDEPTH = 1;
constexpr float SCALE = 0.125f;
constexpr float THR = 8.f;
constexpr int LDQ = 1024, LDK = 1024, LDO = 1024;
constexpr size_t SHM_V = KVBLK * D * 2, SHM_K = KVBLK * D * 2, SHM_ATTN = 2 * SHM_V + 2 * SHM_K + NW * 64 * 4 + 4 * 4 * 16 * 64 * 4;
using bf16x8 = __attribute__((ext_vector_type(8))) short;
using s16x4  = __attribute__((ext_vector_type(4))) short;
using f32x16 = __attribute__((ext_vector_type(16))) float;
using f32x8  = __attribute__((ext_vector_type(8))) float;
using u32x4  = __attribute__((ext_vector_type(4))) unsigned;
#define KSWZ(row, colB) ((row) * 256 + ((colB) ^ (((row) & 15) << 4)))
#define SBAR() __builtin_amdgcn_sched_barrier(0)
__device__ __forceinline__ int crow(int r, int hi) { return (r & 3) + 8 * (r >> 2) + 4 * hi; }
__device__ __forceinline__ unsigned cvtpk(float lo, float hi) {
  unsigned r; asm volatile("v_cvt_pk_bf16_f32 %0, %1, %2" : "=v"(r) : "v"(lo), "v"(hi)); return r;
}
template <typename TIn> struct Stage;
template <> struct Stage<bf16>  { using T = bf16x8;
  __device__ static __forceinline__ T ld8(const bf16* p) { return *(const __attribute__((address_space(1))) bf16x8*)(p); }
  __device__ static __forceinline__ bf16x8 tobf(T x) { return x; } };
constexpr float THR2 = 11.5f;
template <bool FIRST>
__device__ __forceinline__ void partialSM(f32x16& p0, f32x16& p1, float& mhat, f32x16& negm, float& alpha) {
  float pmax = p0[0]; for (int r = 1; r < 16; ++r) pmax = fmaxf(pmax, p0[r]); for (int r = 0; r < 16; ++r) pmax = fmaxf(pmax, p1[r]);
  { auto rr = __builtin_amdgcn_permlane32_swap(__float_as_uint(pmax), __float_as_uint(pmax), false, false);
    pmax = fmaxf(__uint_as_float(rr[0]), __uint_as_float(rr[1])); }
  alpha = 1.f;
  if (FIRST || !__builtin_expect(__all(pmax <= THR2), 1)) {
    const float dl = FIRST ? pmax : fmaxf(pmax, 0.f);
    mhat += dl;
    for (int r = 0; r < 16; ++r) { p0[r] -= dl; p1[r] -= dl; }
    for (int r = 0; r < 16; ++r) negm[r] = -mhat;
    if (!FIRST) alpha = __builtin_amdgcn_exp2f(-dl);
  }
  for (int r = 0; r < 16; ++r) p0[r] = __builtin_amdgcn_exp2f(p0[r]);
}
__device__ __forceinline__ void finishSM(f32x16& p0, f32x16& p1, float alpha, float& l_reg, bf16x8& pa0, bf16x8& pa1, bf16x8& pa2, bf16x8& pa3) {
  for (int r = 0; r < 16; ++r) p1[r] = __builtin_amdgcn_exp2f(p1[r]);
  float ps = 0; for (int r = 0; r < 16; ++r) ps += p0[r]; for (int r = 0; r < 16; ++r) ps += p1[r];
  { auto rr = __builtin_amdgcn_permlane32_swap(__float_as_uint(ps), __float_as_uint(ps), false, false);
    ps = __uint_as_float(rr[0]) + __uint_as_float(rr[1]); }
  l_reg = l_reg * alpha + ps;
#define PK4(P, BASE, OUT) do { unsigned a0 = cvtpk(P[BASE + 0], P[BASE + 1]), a1 = cvtpk(P[BASE + 2], P[BASE + 3]);   \
    unsigned b0 = cvtpk(P[BASE + 4], P[BASE + 5]), b1 = cvtpk(P[BASE + 6], P[BASE + 7]);                              \
    auto r0 = __builtin_amdgcn_permlane32_swap(a0, b0, false, false); auto r1 = __builtin_amdgcn_permlane32_swap(a1, b1, false, false); \
    u32x4 w = {r0[0], r1[0], r0[1], r1[1]}; OUT = *reinterpret_cast<bf16x8*>(&w); } while (0)
  PK4(p0, 0, pa0); PK4(p0, 8, pa1); PK4(p1, 0, pa2); PK4(p1, 8, pa3);
#undef PK4
}
typedef __attribute__((address_space(3))) const char* lds_cptr_t;
__device__ __forceinline__ void qkt(f32x16& p0, f32x16& p1, const bf16* Ks, const char* qfl_, int r32, int hi, int mcolB, const f32x16& negm) {
  unsigned qoff = (unsigned)(uintptr_t)qfl_;
  asm volatile("" : "+v"(qoff));
  const lds_cptr_t qfl = (lds_cptr_t)qoff;
  bf16x8 qr[4];
#pragma unroll
  for (int d0 = 0; d0 < 4; ++d0) qr[d0] = *(const __attribute__((address_space(3))) bf16x8*)(qfl + d0 * 1024);
#pragma unroll
  for (int d0 = 0; d0 < 4; ++d0) { int cb = mcolB + (d0 * 16 + hi * 8) * 2;
    bf16x8 b0 = *reinterpret_cast<const bf16x8*>((const char*)Ks + KSWZ(r32, cb));
    bf16x8 b1 = *reinterpret_cast<const bf16x8*>((const char*)Ks + KSWZ(32 + r32, cb));
    if (d0 == 0) { p0 = __builtin_amdgcn_mfma_f32_32x32x16_bf16(b0, qr[0], negm, 0, 0, 0); p1 = __builtin_amdgcn_mfma_f32_32x32x16_bf16(b1, qr[0], negm, 0, 0, 0); }
    else { p0 = __builtin_amdgcn_mfma_f32_32x32x16_bf16(b0, qr[d0], p0, 0, 0, 0); p1 = __builtin_amdgcn_mfma_f32_32x32x16_bf16(b1, qr[d0], p1, 0, 0, 0); } }
}
__device__ __forceinline__ int v_st(int k, int c) { const int kk = (k & ~0xC) | ((k & 4) << 1) | ((k & 8) >> 1); return ((kk >> 3) * 4 + (c >> 5)) * 512 + ((kk & 7) * 32 + (c & 31)) * 2; }
__device__ __forceinline__ int v_rd_base(int lane) { return ((lane & 3) << 3) | (((lane >> 2) & 3) << 6) | (((lane >> 4) & 1) << 5) | (((lane >> 5) & 1) << 8); }
constexpr int v_rd_off(int d0, int ks, int half) { return d0 * 512 + ks * 4096 + half * 2048; }
template <int OFF> __device__ __forceinline__ s16x4 tr_read(int vb) {
  s16x4 r; asm volatile("ds_read_b64_tr_b16 %0, %1 offset:%2" : "=&v"(r) : "v"(vb), "i"(OFF) : "memory"); return r;
}
template <int D0> __device__ __forceinline__ void pv_one(f32x16& od, int vb, bf16x8 pa0, bf16x8 pa1, bf16x8 pa2, bf16x8 pa3) {
  const s16x4 l0 = tr_read<v_rd_off(D0, 0, 0)>(vb), h0 = tr_read<v_rd_off(D0, 0, 1)>(vb), l1 = tr_read<v_rd_off(D0, 1, 0)>(vb), h1 = tr_read<v_rd_off(D0, 1, 1)>(vb);
  const s16x4 l2 = tr_read<v_rd_off(D0, 2, 0)>(vb), h2 = tr_read<v_rd_off(D0, 2, 1)>(vb), l3 = tr_read<v_rd_off(D0, 3, 0)>(vb), h3 = tr_read<v_rd_off(D0, 3, 1)>(vb);
  asm volatile("s_waitcnt lgkmcnt(0)" ::: "memory"); SBAR();
#define PK(L, H) (bf16x8){L[0], L[1], L[2], L[3], H[0], H[1], H[2], H[3]}
  od = __builtin_amdgcn_mfma_f32_32x32x16_bf16(pa0, PK(l0, h0), od, 0, 0, 0);
  od = __builtin_amdgcn_mfma_f32_32x32x16_bf16(pa1, PK(l1, h1), od, 0, 0, 0);
  od = __builtin_amdgcn_mfma_f32_32x32x16_bf16(pa2, PK(l2, h2), od, 0, 0, 0);
  od = __builtin_amdgcn_mfma_f32_32x32x16_bf16(pa3, PK(l3, h3), od, 0, 0, 0);
#undef PK
}
__device__ __forceinline__ void pv_d0(f32x16* o, int vb, bf16x8 pa0, bf16x8 pa1, bf16x8 pa2, bf16x8 pa3) {
  pv_one<0>(o[0], vb, pa0, pa1, pa2, pa3); pv_one<1>(o[1], vb, pa0, pa1, pa2, pa3); pv_one<2>(o[2], vb, pa0, pa1, pa2, pa3); pv_one<3>(o[3], vb, pa0, pa1, pa2, pa3);
}

__device__ __forceinline__ void diff_attn_unit(const bf16* __restrict__ Qb, const bf16* __restrict__ Kh, const bf16* __restrict__ Vh,
                                               bf16* __restrict__ Ob, int seq, float lam, const float* __restrict__ subln, char* lds) {
  using St = Stage<bf16>;
  int tid_ = threadIdx.x; asm volatile("" : "+v"(tid_));
  const int tid = tid_, wid = __builtin_amdgcn_readfirstlane(tid >> 6), lane = tid & 63, r32 = lane & 31, hi = lane >> 5;
  bf16* V_lds = (bf16*)lds; bf16* K_lds = (bf16*)(lds + 3 * SHM_V);
  float* ws = (float*)(lds + 3 * SHM_V + 3 * SHM_K) + wid * 64; float* li_l = ws; float* al_l = ws + 32;
  float m_reg = 0.f, l_reg = 0; f32x16 o[4] = {}; f32x16 negm = {};
  const int mw = wid >> 2, wq = wid & 3, mcolB = mw * 128;
  const bf16* Qw = Qb + (long)(wq * QBLK + r32) * LDQ + mw * 64 + hi * 8;
  char* qr = lds + 3 * SHM_V + 3 * SHM_K + NW * 64 * 4 + wid * 4096 + lane * 16;
#pragma unroll
  for (int d0 = 0; d0 < 4; ++d0) *reinterpret_cast<bf16x8*>(qr + d0 * 1024) = St::ld8(Qw + d0 * 16);
  const int vb0 = (int)(uintptr_t)V_lds + v_rd_base(lane);
  const int widu = wid;
  unsigned kof0, kof1, vof0, vof1;
  { const int r0 = 8 * widu + (lane >> 4), r1 = r0 + 4;
    kof0 = (unsigned)(r0 * LDK * 2 + ((((lane & 15) << 4)) ^ ((r0 & 15) << 4))); kof1 = (unsigned)(r1 * LDK * 2 + ((((lane & 15) << 4)) ^ ((r1 & 15) << 4)));
    const int kk = widu * 8 + ((lane & 31) >> 2), kx = (kk & ~0xC) | ((kk & 4) << 1) | ((kk & 8) >> 1);
    vof0 = (unsigned)(kx * LDK * 2 + (((lane >> 5)) * 32 + (lane & 3) * 8) * 2); vof1 = (unsigned)(kx * LDK * 2 + ((2 + (lane >> 5)) * 32 + (lane & 3) * 8) * 2); }
  typedef __attribute__((address_space(3))) unsigned lds_u32_t; typedef const __attribute__((address_space(1))) char g_cchar_t;
  lds_u32_t* const kdst = (lds_u32_t*)((__attribute__((address_space(3))) char*)K_lds + widu * 2048); lds_u32_t* const vdst = (lds_u32_t*)((__attribute__((address_space(3))) char*)V_lds + widu * 2048);
#define GLDS(g, off, dst) __builtin_amdgcn_global_load_lds((const __attribute__((address_space(1))) unsigned*)((g) + (off)), (dst), 16, 0, 0)
#define DMA_TILE(k0, slot) do { g_cchar_t* gk_ = (g_cchar_t*)Kh + (size_t)(k0) * LDK * 2; g_cchar_t* gv_ = (g_cchar_t*)Vh + (size_t)(k0) * LDK * 2; \
    GLDS(gk_, kof0, kdst + ((slot) * (int)SHM_K) / 4); GLDS(gk_, kof1, kdst + ((slot) * (int)SHM_K + 1024) / 4); \
    GLDS(gv_, vof0, vdst + ((slot) * (int)SHM_V) / 4); GLDS(gv_, vof1, vdst + ((slot) * (int)SHM_V + 1024) / 4); } while (0)
#define DMA_WAIT_BAR() do { asm volatile("s_waitcnt vmcnt(0)" ::: "memory"); __syncthreads(); } while (0)
#define RESC(a) do { if (__any((a) < 1.f)) { if (hi == 0) al_l[r32] = (a); asm volatile("s_waitcnt lgkmcnt(0)" ::: "memory"); \
    for (int d = 0; d < 4; ++d) for (int r = 0; r < 16; ++r) o[d][r] *= al_l[crow(r, hi)]; } } while (0)
#define ATT_STEP(PC0, PC1, ALC, PP0, PP1, ALP, CUR, PREV, NEXT, JJ) do { \
    SBAR(); qkt(PC0, PC1, (bf16*)((char*)K_lds + (CUR) * SHM_K), qr, r32, hi, mcolB, negm); \
    finishSM(PP0, PP1, ALP, l_reg, pa0, pa1, pa2, pa3); SBAR(); \
    DMA_TILE(((JJ) + 1) * KVBLK, NEXT); SBAR(); \
    pv_d0(o, vb0 + (PREV) * (int)SHM_V, pa0, pa1, pa2, pa3); partialSM<false>(PC0, PC1, m_reg, negm, ALC); \
    RESC(ALC); DMA_WAIT_BAR(); } while (0)
  f32x16 pA0, pA1, pB0, pB1; float alA, alB; bf16x8 pa0, pa1, pa2, pa3; const int NT = seq / KVBLK;
  DMA_TILE(0, 0); DMA_TILE(KVBLK, 1); DMA_WAIT_BAR();
  qkt(pA0, pA1, K_lds, qr, r32, hi, mcolB, negm); partialSM<true>(pA0, pA1, m_reg, negm, alA);
  for (int j = 1; j + 1 < NT; j += 6) {
    ATT_STEP(pB0, pB1, alB, pA0, pA1, alA, 1, 0, 2, j);
    ATT_STEP(pA0, pA1, alA, pB0, pB1, alB, 2, 1, 0, j + 1);
    ATT_STEP(pB0, pB1, alB, pA0, pA1, alA, 0, 2, 1, j + 2);
    ATT_STEP(pA0, pA1, alA, pB0, pB1, alB, 1, 0, 2, j + 3);
    ATT_STEP(pB0, pB1, alB, pA0, pA1, alA, 2, 1, 0, j + 4);
    ATT_STEP(pA0, pA1, alA, pB0, pB1, alB, 0, 2, 1, j + 5);
  }
  SBAR(); qkt(pB0, pB1, (bf16*)((char*)K_lds + SHM_K), qr, r32, hi, mcolB, negm);
  finishSM(pA0, pA1, alA, l_reg, pa0, pa1, pa2, pa3); SBAR();
  pv_d0(o, vb0, pa0, pa1, pa2, pa3); partialSM<false>(pB0, pB1, m_reg, negm, alB);
  RESC(alB);
  finishSM(pB0, pB1, alB, l_reg, pa0, pa1, pa2, pa3); SBAR();
  pv_d0(o, vb0 + (int)SHM_V, pa0, pa1, pa2, pa3);
  __syncthreads();
  if (hi == 0) li_l[r32] = l_reg; asm volatile("s_waitcnt lgkmcnt(0)" ::: "memory");
  float rli[16];
#pragma unroll
  for (int r = 0; r < 16; ++r) rli[r] = __builtin_amdgcn_rcpf(li_l[crow(r, hi)]);
  float* EXO = (float*)lds + wq * (4 * 16 * 64) + lane;
  if (mw == 1) {
#pragma unroll
    for (int d0 = 0; d0 < 4; ++d0)
#pragma unroll
      for (int r = 0; r < 16; ++r) EXO[(d0 * 16 + r) * 64] = o[d0][r] * rli[r];
  }
  __syncthreads();
  if (mw == 0) {
    float ssq[16];
#pragma unroll
    for (int r = 0; r < 16; ++r) ssq[r] = 0.f;
#pragma unroll
    for (int d0 = 0; d0 < 4; ++d0)
#pragma unroll
      for (int r = 0; r < 16; ++r) { const float dv = o[d0][r] * rli[r] - lam * EXO[(d0 * 16 + r) * 64]; o[d0][r] = dv; ssq[r] += dv * dv; }
#pragma unroll
    for (int r = 0; r < 16; ++r) {
#pragma unroll
      for (int sft = 1; sft < 32; sft <<= 1) ssq[r] += __shfl_xor(ssq[r], sft);
      ssq[r] = rsqrtf(ssq[r] * (1.f / 128.f) + 1e-6f) * 0.8f;
    }
    bf16* stg = (bf16*)(lds + 65536 + wq * 8192);
#pragma unroll
    for (int d0 = 0; d0 < 4; ++d0) { const float gg = subln[d0 * 32 + r32];
#pragma unroll
      for (int r = 0; r < 16; ++r) { const float val = o[d0][r] * ssq[r] * gg; stg[crow(r, hi) * 128 + d0 * 32 + r32] = (bf16)(pg8::cvt_pk_bf16(val, val) & 0xffffu); } }
    asm volatile("s_waitcnt lgkmcnt(0)" ::: "memory");
    bf16* Ow = Ob + (long)(wq * QBLK) * LDO;
#pragma unroll
    for (int i = 0; i < 8; ++i) { const int row = i * 4 + (lane >> 4), ch = lane & 15;
      const u32x4 v = *(const u32x4*)(stg + row * 128 + ch * 8);
      *(__attribute__((address_space(1))) u32x4*)(Ow + (long)row * LDO + ch * 8) = v; }
  }
  __syncthreads();
#undef GLDS
#undef DMA_TILE
#undef DMA_WAIT_BAR
#undef RESC
#undef ATT_STEP
}
}


typedef __bf16 bf16x2_t __attribute__((ext_vector_type(2)));
__device__ __forceinline__ float dot2bf(unsigned a, unsigned b, float acc) { return __builtin_amdgcn_fdot2_f32_bf16(__builtin_bit_cast(bf16x2_t, a), __builtin_bit_cast(bf16x2_t, b), acc, false); }
template <int CTRL> __device__ __forceinline__ float dpp_add(float v) { return v + __builtin_bit_cast(float, __builtin_amdgcn_update_dpp(0, __builtin_bit_cast(int, v), CTRL, 0xf, 0xf, true)); }
__device__ __forceinline__ float row16_sum(float v) {
  v = dpp_add<0xB1>(v); v = dpp_add<0x4E>(v); v = dpp_add<0x141>(v); v = dpp_add<0x140>(v); return v;
}

typedef unsigned u32x2_t __attribute__((ext_vector_type(2)));
typedef float f32x2_t __attribute__((ext_vector_type(2)));
__device__ __forceinline__ void slice_table_fp8(const float* T, unsigned char* T8, float scale, int gtid, int gsz) {
  for (int it0 = gtid; it0 < 16384 * 128; it0 += 4 * gsz) {
    f32x4 a[4], b[4];
#pragma unroll
    for (int q = 0; q < 4; ++q) { const int it = it0 + q * gsz; if (it < 16384 * 128) { const int e = it >> 7, c8 = (it & 127) * 8; a[q] = *(const f32x4*)(T + (size_t)e * 1024 + c8); b[q] = *(const f32x4*)(T + (size_t)e * 1024 + c8 + 4); } }
#pragma unroll
    for (int q = 0; q < 4; ++q) { const int it = it0 + q * gsz; if (it < 16384 * 128) {
      const int e = it >> 7, c8 = (it & 127) * 8, j = c8 >> 7, c = c8 & 127; const f32x4 as = a[q] * scale, bs = b[q] * scale;
      int w0 = __builtin_amdgcn_cvt_pk_fp8_f32(as[0], as[1], 0, false); w0 = __builtin_amdgcn_cvt_pk_fp8_f32(as[2], as[3], w0, true);
      int w1 = __builtin_amdgcn_cvt_pk_fp8_f32(bs[0], bs[1], 0, false); w1 = __builtin_amdgcn_cvt_pk_fp8_f32(bs[2], bs[3], w1, true);
      *(u32x2_t*)(T8 + ((size_t)j * 16384 + e) * 128 + c) = (u32x2_t){(unsigned)w0, (unsigned)w1}; } }
  }
}
__device__ __forceinline__ void slice_table(const float* T, bf16_t* T8, int gtid, int gsz) {
  for (int it = gtid; it < 16384 * 128; it += gsz) {
    const int e = it >> 7, c8 = (it & 127) * 8, j = c8 >> 7, c = c8 & 127;
    const f32x4 a = *(const f32x4*)(T + (size_t)e * 1024 + c8), b = *(const f32x4*)(T + (size_t)e * 1024 + c8 + 4);
    u32x4 w; w.x = pg8::cvt_pk_bf16(a[0], a[1]); w.y = pg8::cvt_pk_bf16(a[2], a[3]); w.z = pg8::cvt_pk_bf16(b[0], b[1]); w.w = pg8::cvt_pk_bf16(b[2], b[3]);
    *(u32x4*)(T8 + ((size_t)j * 16384 + e) * 128 + c) = w;
  }
}

#define LAS __attribute__((address_space(3)))
#define XB_TMO      128
#define XB_XCNT(j)  (256  + 64 * (j))
#define XB_XSUB(j)  (1280 + 64 * (j))
#define XB_XGEN(j)  (2304 + 64 * (j))
#define XB_TOP      3328
#define XB_TOPGEN   3392
#define XCD_BAR_WORDS 3456
#define XB_SPIN_CAP (1u << 18)

__device__ __forceinline__ unsigned xb_ld(unsigned* p)              { return __hip_atomic_load(p, __ATOMIC_RELAXED, __HIP_MEMORY_SCOPE_AGENT); }
__device__ __forceinline__ unsigned xb_add(unsigned* p, unsigned v) { return __hip_atomic_fetch_add(p, v, __ATOMIC_RELAXED, __HIP_MEMORY_SCOPE_AGENT); }
__device__ __forceinline__ unsigned xb_xcc_id() { return (unsigned)__builtin_amdgcn_s_getreg((3 << 11) | 20) & 0xFu; }
#define XB_SPIN(cond, bar) do { unsigned _sp = 0; while (cond) { __builtin_amdgcn_s_sleep(1); \
    if ((++_sp & 255u) == 0u) { if (xb_ld(&(bar)[XB_TMO])) break; if (_sp > XB_SPIN_CAP) { atomicAdd(&(bar)[XB_TMO], 1u); break; } } } } while (0)

struct XcdBarrier {
    unsigned* bar; unsigned x;
    volatile LAS unsigned* st;
};

__device__ __forceinline__ XcdBarrier xcd_barrier_post(unsigned* bar, volatile LAS unsigned* st) {
    XcdBarrier b; b.bar = bar; b.x = xb_xcc_id(); b.st = st;
    if (threadIdx.x == 0) (void)xb_add(&bar[XB_XCNT(b.x)], 1u);
    return b;
}
__device__ __forceinline__ void xcd_barrier_complete(unsigned* bar, unsigned x, unsigned& nloc, unsigned& nx) {
    const unsigned G = gridDim.x * gridDim.y * gridDim.z;
    unsigned sum, cnt, mine, sp = 0u;
    for (;;) {
        sum = 0u; cnt = 0u; mine = 0u;
#pragma unroll
        for (unsigned j = 0; j < 16; ++j) { const unsigned c = xb_ld(&bar[XB_XCNT(j)]); sum += c; cnt += (c > 0u) ? 1u : 0u; mine = (j == x) ? c : mine; }
        if (sum == G) break;
        __builtin_amdgcn_s_sleep(1);
        if ((++sp & 255u) == 0u) { if (xb_ld(&bar[XB_TMO])) break; if (sp > XB_SPIN_CAP) { atomicAdd(&bar[XB_TMO], 1u); break; } }
    }
    nloc = mine > 0u ? mine : 1u; nx = cnt > 0u ? cnt : 1u;
}

__device__ __forceinline__ void xcd_barrier(const XcdBarrier& b) {
    asm volatile("s_waitcnt vmcnt(0)" ::: "memory");
    __syncthreads();
    if (threadIdx.x == 0) {
        unsigned* bar = b.bar;
        __builtin_amdgcn_s_waitcnt(0);
        unsigned nloc = b.st[0], nx = b.st[1];
        if (nloc == 0u) { xcd_barrier_complete(bar, b.x, nloc, nx); b.st[0] = nloc; b.st[1] = nx; }
        const unsigned old = xb_add(&bar[XB_XSUB(b.x)], 1u);
        const unsigned gen = old / nloc;
        if (old + 1u == (gen + 1u) * nloc) {
            __builtin_amdgcn_fence(__ATOMIC_RELEASE, "agent");
            asm volatile("s_waitcnt vmcnt(0)" ::: "memory");
            const unsigned og = xb_add(&bar[XB_TOP], 1u);
            const unsigned tg = og / nx;
            if (og + 1u == (tg + 1u) * nx) xb_add(&bar[XB_TOPGEN], 1u);
            else XB_SPIN(xb_ld(&bar[XB_TOPGEN]) == tg, bar);
            __builtin_amdgcn_fence(__ATOMIC_ACQUIRE, "agent");
            xb_add(&bar[XB_XGEN(b.x)], 1u);
            asm volatile("s_waitcnt vmcnt(0)" ::: "memory");
        } else {
            XB_SPIN(xb_ld(&bar[XB_XGEN(b.x)]) == gen, bar);
            __builtin_amdgcn_fence(__ATOMIC_ACQUIRE, "agent");
            asm volatile("s_waitcnt vmcnt(0)" ::: "memory");
        }
    }
    __syncthreads();
}


#define FB_MAGIC 0x5EEDBA11u
__device__ __forceinline__ void flag_barrier(unsigned* flags) {
  asm volatile("s_waitcnt vmcnt(0)" ::: "memory");
  __syncthreads();
  if (threadIdx.x < 64) {
    if (threadIdx.x == 0) {
      __builtin_amdgcn_fence(__ATOMIC_RELEASE, "agent");
      asm volatile("s_waitcnt vmcnt(0)" ::: "memory");
      __hip_atomic_store(&flags[blockIdx.x], FB_MAGIC, __ATOMIC_RELAXED, __HIP_MEMORY_SCOPE_AGENT);
    }
    const unsigned G = gridDim.x; unsigned sp = 0u;
    for (;;) {
      bool ok = true;
      for (unsigned i = threadIdx.x; i < G; i += 64u) ok = ok && (xb_ld(&flags[i]) == FB_MAGIC);
      if (__all(ok)) break;
      __builtin_amdgcn_s_sleep(2);
      if (++sp > (1u << 21)) break;
    }
    __builtin_amdgcn_fence(__ATOMIC_ACQUIRE, "agent");
    asm volatile("s_waitcnt vmcnt(0)" ::: "memory");
  }
  __syncthreads();
}

__device__ __forceinline__ void wave_argmax(float& v, int& i) {
#pragma unroll
  for (int o = 32; o; o >>= 1) {
    const float ov = __shfl_xor(v, o); const int oi = __shfl_xor(i, o);
    if (ov > v || (ov == v && oi < i)) { v = ov; i = oi; }
  }
}

__global__ void __launch_bounds__(NT) mega(Params p) {
  extern __shared__ __attribute__((aligned(16))) unsigned char lds[];
  cg::grid_group grid = cg::this_grid();
  if (threadIdx.x < 35) {
    unsigned long long v = threadIdx.x < 33 ? (unsigned long long)p.in[threadIdx.x] : (threadIdx.x == 33 ? (unsigned long long)p.out : (unsigned long long)p.ws);
    ((unsigned long long*)(lds + PTR_OFF))[threadIdx.x] = v;
  }
  if (threadIdx.x < 2) ((volatile unsigned*)(lds + PTR_OFF + 800))[threadIdx.x] = 0u;
  __syncthreads();
  if (blockIdx.x == 0) for (int i = threadIdx.x; i < XCD_BAR_WORDS; i += NT) ((unsigned*)WSP(WS_BAR))[i] = 0u;

  {
    PHASE_LOCALS
    float* MOD = (float*)WSP(WS_MOD); float* LAM = (float*)WSP(WS_LAM);
    const float* cin = INP(1); const float* c_ctx = INP(3); const float* ada_w = INP(4); const float* ada_b = INP(5);
    if (gridDim.x >= 192) {
      if (blockIdx.x < 192) {
        float* sil = fl; float* red = fl + 5 * 1024;
        for (int i = tid; i < 5 * 1024; i += NT) { const int r = i >> 10, k = i & 1023; sil[i] = siluf_(r < 4 ? cin[r * D + k] : c_ctx[k]); }
        __syncthreads();
        const int cl = tid & 31, kg = tid >> 5, col = blockIdx.x * 32 + cl;
        float a[5] = {0.f, 0.f, 0.f, 0.f, 0.f};
#pragma unroll
        for (int kk = 0; kk < 64; ++kk) {
          const int k = kg * 64 + kk; const float w = ada_w[(size_t)k * 6144 + col];
#pragma unroll
          for (int r = 0; r < 5; ++r) a[r] += sil[r * 1024 + k] * w;
        }
#pragma unroll
        for (int r = 0; r < 5; ++r) red[(kg * 5 + r) * 32 + cl] = a[r];
        __syncthreads();
        if (tid < 160) {
          const int r = tid >> 5; float s = 0.f;
#pragma unroll
          for (int q = 0; q < 16; ++q) s += red[(q * 5 + r) * 32 + cl];
          MOD[r * 6144 + col] = s + ada_b[col];
        }
        __syncthreads();
      }
    } else {
      for (int it = gtid; it < 5 * 6144; it += gsz) {
        const int r = it / 6144, j = it % 6144;
        const float* cv = r < 4 ? cin + r * D : c_ctx;
        float a = 0.f;
        for (int k = 0; k < D; ++k) a += siluf_(cv[k]) * ada_w[(size_t)k * 6144 + j];
        MOD[it] = a + ada_b[j];
      }
    }
    if (gtid == 0) {
      const float* q1 = INP(9); const float* k1 = INP(10); const float* q2 = INP(11); const float* k2 = INP(12);
      float s1 = 0.f, s2 = 0.f;
      for (int k = 0; k < 64; ++k) { s1 += q1[k] * k1[k]; s2 += q2[k] * k2[k]; }
      LAM[0] = expf(s1) - expf(s2) + 0.2f;
    }
    const float* a_re = INP(15); const float* a_im = INP(16); const float* ldt = INP(17); const float* b_re = INP(18); const float* b_im = INP(19);
    for (int it = (int)(gridDim.x - 1 - blockIdx.x) * NT + tid; it < 2 * 32 * 64; it += gsz) {
      const float dt = expf(ldt[it >> 6]);
      ((float*)WSP(WS_ARDT))[it] = a_re[it] * dt; ((float*)WSP(WS_AIDT))[it] = a_im[it] * dt;
    }
    {
      struct BB { float fr, fi, ardt, aidt; };
      auto disc1 = [&](int sidx) -> BB {
        const float ar = a_re[sidx], ai = a_im[sidx], dt = expf(ldt[sidx >> 6]);
        const float mag = expf(ar * dt), abr = mag * cosf(ai * dt), abi = mag * sinf(ai * dt);
        const float den = ar * ar + ai * ai, nr = abr - 1.f, ni = abi;
        return BB{(nr * ar + ni * ai) / den, (ni * ar - nr * ai) / den, ar * dt, ai * dt};
      };
      {
        bf16_t* BTS = (bf16_t*)WSP(WS_BTS);
        for (int it = gtid; it < 32 * 256 * 32; it += gsz) {
          const int i = it & 31, r = (it >> 5) & 255, g = it >> 13;
          const int d = r >> 7, n = (r >> 1) & 63, ri = r & 1, sidx = (d * 32 + g) * 64 + n;
          const BB bb = disc1(sidx);
          const float e = (float)(d == 0 ? 31 - i : i);
          const float mag = __expf(e * bb.ardt), pr0 = mag * __cosf(e * bb.aidt), pi0 = mag * __sinf(e * bb.aidt);
          const float pr = pr0 * bb.fr - pi0 * bb.fi, pi = pr0 * bb.fi + pi0 * bb.fr;
          unsigned w[8];
#pragma unroll
          for (int q = 0; q < 8; ++q) {
            const float br0 = b_re[sidx * 16 + 2 * q], bi0 = b_im[sidx * 16 + 2 * q], br1 = b_re[sidx * 16 + 2 * q + 1], bi1 = b_im[sidx * 16 + 2 * q + 1];
            const float v0 = ri == 0 ? pr * br0 - pi * bi0 : pr * bi0 + pi * br0, v1 = ri == 0 ? pr * br1 - pi * bi1 : pr * bi1 + pi * br1;
            w[q] = pg8::cvt_pk_bf16(v0, v1);
          }
          u32x4* dst = (u32x4*)(BTS + ((size_t)g * 256 + r) * 512 + i * 16);
          dst[0] = (u32x4){w[0], w[1], w[2], w[3]}; dst[1] = (u32x4){w[4], w[5], w[6], w[7]};
        }
      }
      {
        float* KT = (float*)WSP(WS_KT); const float* c_re = INP(20); const float* c_im = INP(21);
        if (gridDim.x >= 256) {
          if (blockIdx.x >= 192) {
            const int dg = (int)blockIdx.x - 192; float* dsc = fl;
            float* blr = fl + 256; float* bli = blr + 1024; float* clr = bli + 1024; float* cli = clr + 16 * 65;
            if (tid < 64) { const BB bb = disc1(dg * 64 + tid); dsc[tid * 4] = bb.fr; dsc[tid * 4 + 1] = bb.fi; dsc[tid * 4 + 2] = bb.ardt; dsc[tid * 4 + 3] = bb.aidt; }
            for (int i = tid; i < 1024; i += NT) { blr[i] = b_re[dg * 1024 + i]; bli[i] = b_im[dg * 1024 + i];
              clr[(i >> 6) * 65 + (i & 63)] = c_re[dg * 1024 + i]; cli[(i >> 6) * 65 + (i & 63)] = c_im[dg * 1024 + i]; }
            __syncthreads();
            const int pp = tid & 15, m = tid >> 4;
            float acc[16];
#pragma unroll
            for (int q = 0; q < 16; ++q) acc[q] = 0.f;
            for (int n = 0; n < 64; ++n) {
              const float fr = dsc[n * 4], fi = dsc[n * 4 + 1], ardt = dsc[n * 4 + 2], aidt = dsc[n * 4 + 3];
              const float mag = __expf((float)m * ardt), pr0 = mag * __cosf((float)m * aidt), pi0 = mag * __sinf((float)m * aidt);
              const float pr = pr0 * fr - pi0 * fi, pi = pr0 * fi + pi0 * fr;
              const float cr = clr[pp * 65 + n], ci = cli[pp * 65 + n];
              const float wr_ = cr * pr - ci * pi, wi_ = cr * pi + ci * pr;
#pragma unroll
              for (int q = 0; q < 16; ++q) acc[q] += wr_ * blr[n * 16 + q] - wi_ * bli[n * 16 + q];
            }
#pragma unroll
            for (int q = 0; q < 16; ++q) KT[((size_t)dg * 32 + m) * 256 + pp * 16 + q] = acc[q];
            __syncthreads();
          }
        } else {
          for (int it = gtid; it < 2 * 32 * 32 * 16; it += gsz) {
            const int pp = it & 15, m = (it >> 4) & 31, dg = it >> 9;
            float acc[16];
#pragma unroll
            for (int q = 0; q < 16; ++q) acc[q] = 0.f;
            for (int n = 0; n < 64; ++n) {
              const int sidx = dg * 64 + n;
              const BB bb = disc1(sidx);
              const float mag = __expf((float)m * bb.ardt), pr0 = mag * __cosf((float)m * bb.aidt), pi0 = mag * __sinf((float)m * bb.aidt);
              const float pr = pr0 * bb.fr - pi0 * bb.fi, pi = pr0 * bb.fi + pi0 * bb.fr;
              const float cr = c_re[(dg * 16 + pp) * 64 + n], ci = c_im[(dg * 16 + pp) * 64 + n];
              const float wr_ = cr * pr - ci * pi, wi_ = cr * pi + ci * pr;
#pragma unroll
              for (int q = 0; q < 16; ++q) acc[q] += wr_ * b_re[sidx * 16 + q] - wi_ * b_im[sidx * 16 + q];
            }
#pragma unroll
            for (int q = 0; q < 16; ++q) KT[((size_t)dg * 32 + m) * 256 + pp * 16 + q] = acc[q];
          }
        }
      }
    }
    float* ROPE = (float*)WSP(WS_ROPE);
    for (int it = gtid; it < 64 * 16; it += gsz) {
      const float ang = (float)(it >> 4) * powf(10000.f, -(float)(it & 15) / 16.f);
      ROPE[it * 2] = cosf(ang); ROPE[it * 2 + 1] = sinf(ang);
    }
    {
      float* scr = fl + wid * (64 * 65);
      constexpr int I_IN = 16 * 88, I_AU = 16 * 16, I_SU = 8 * 16, I_OUT = 16 * 16, I_GLU = 8 * 8;
      for (int it = gw; it < I_IN + I_AU + I_SU + I_OUT + I_GLU; it += ngw) {
        int r = it;
        if (r < I_IN) { transpose_item64(INP(8), 1024, N_IN, (bf16_t*)WSP(WS_WIN), scr, r, lane); continue; } r -= I_IN;
        if (r < I_AU) { transpose_item64(INP(14), 1024, 1024, (bf16_t*)WSP(WS_WAU), scr, r, lane); continue; } r -= I_AU;
        if (r < I_SU) { transpose_item64(INP(25), 512, 1024, (bf16_t*)WSP(WS_WSU), scr, r, lane); continue; } r -= I_SU;
        if (r < I_OUT) { transpose_item64(INP(26), 1024, 1024, (bf16_t*)WSP(WS_WOUT), scr, r, lane); continue; } r -= I_OUT;
        transpose_item64(INP(23), 512, 512, (bf16_t*)WSP(WS_WGLU), scr, r, lane);
      }
    }
  }
  if (p.ws == nullptr) grid.sync();
  flag_barrier((unsigned*)WSP(WS_FLAGS));
  const XcdBarrier xbar = xcd_barrier_post((unsigned*)WSP(WS_BAR), (volatile LAS unsigned*)(lds + PTR_OFF + 800));

  {
    PHASE_LOCALS
    const float* MOD = (const float*)WSP(WS_MOD); bf16_t* XN = (bf16_t*)WSP(WS_XN);
    const float* x = INP(0); const float* ctx = INP(2); const float* norm1_g = INP(6);
    for (int row = gw; row < MX + MC; row += ngw) {
      const float* src; const float* md;
      if (row < MX) { src = x + (size_t)row * D; md = MOD + (row / L) * 6144; } else { src = ctx + (size_t)(row - MX) * D; md = MOD + 4 * 6144; }
      f32x4 v[4]; float ss = 0.f;
#pragma unroll
      for (int j = 0; j < 4; ++j) { v[j] = *(const f32x4*)(src + lane * 4 + 256 * j); ss += v[j][0] * v[j][0] + v[j][1] * v[j][1] + v[j][2] * v[j][2] + v[j][3] * v[j][3]; }
      const float rstd = rsqrtf(wave_sum(ss) * (1.f / D) + 1e-6f);
#pragma unroll
      for (int j = 0; j < 4; ++j)
#pragma unroll
        for (int e = 0; e < 4; ++e) { const int col = lane * 4 + 256 * j + e; XN[(size_t)row * D + col] = f2bf(v[j][e] * rstd * norm1_g[col] * (1.f + md[1024 + col]) + md[col]); }
    }
  }
  xcd_barrier(xbar);
  if (threadIdx.x == 0) ((unsigned*)WSP(WS_FLAGS))[blockIdx.x] = 0u;

  {
    pg8::Gemm g{(const bf16_t*)WSP(WS_XN), (const bf16_t*)WSP(WS_WIN), MX + MC, N_IN, D, D, D};
    InProjSched S; S.init((int)gridDim.x, (int)blockIdx.x);
    EpiInProj E{(bf16_t*)WSP(WS_Q), (bf16_t*)WSP(WS_K), (bf16_t*)WSP(WS_V), (bf16_t*)WSP(WS_SA), (bf16_t*)WSP(WS_G), (const float*)WSP(WS_ROPE)};
    pg8::gemm_phase<EpiInProj, InProjSched, true, true>((PG8_LAS unsigned char*)lds, g, S, E);
  }
  xcd_barrier(xbar);

  {
    const float lam = ((const float*)WSP(WS_LAM))[0];
    const bf16_t* Qb = (const bf16_t*)WSP(WS_Q); const bf16_t* Kb = (const bf16_t*)WSP(WS_K); const bf16_t* Vb = (const bf16_t*)WSP(WS_V);
    bf16_t* ATT = (bf16_t*)WSP(WS_ATT); const float* subln = INP(13);
    for (int unit = blockIdx.x; unit < Bn * 8 * (L / 128); unit += gridDim.x) {
      const int h = unit & 7, qb = (unit >> 3) & 31, b = unit >> 8;
      const size_t qoff = ((size_t)(b * L + qb * 128)) * 1024 + h * 128, koff = (size_t)b * LA * 1024 + h * 128;
      att::diff_attn_unit(Qb + qoff, Kb + koff, Vb + koff, ATT + qoff, LA, lam, subln, (char*)lds);
    }
  }
  xcd_barrier(xbar);

  {
    const bool gemm_blk = (blockIdx.x < 96) || (gridDim.x <= 96);
    if (gemm_blk) {
      pg8::Gemm g{(const bf16_t*)WSP(WS_SA), (const bf16_t*)WSP(WS_BTS), 0, 0, 512, SA_LD, 512};
      GroupSched S; S.init(32, 3, 1, (long)SA_ROWS * SA_LD * 2, (long)256 * SA_LD * 2, (long)256 * 512 * 2, 0, (int)(gridDim.x <= 96 ? gridDim.x : 96), (int)blockIdx.x);
      EpiS E{(float*)WSP(WS_S)};
      pg8::gemm_phase<EpiS, GroupSched, true, true>((PG8_LAS unsigned char*)lds, g, S, E);
    }
    {
      PHASE_LOCALS
      const bool big = gridDim.x > 96;
      const int vslots = big ? (gemm_blk ? 3 : 5) : 1, vbase = big ? (gemm_blk ? (int)blockIdx.x * 3 : 96 * 3 + ((int)blockIdx.x - 96) * 5) : (int)blockIdx.x;
      const int vtot = big ? 96 * 3 + ((int)gridDim.x - 96) * 5 : (int)gridDim.x;
      const float* KT = (const float*)WSP(WS_KT); const float* ARDT = (const float*)WSP(WS_ARDT); const float* AIDT = (const float*)WSP(WS_AIDT);
      const float* c_re = INP(20); const float* c_im = INP(21); const float* dsk = INP(22); bf16_t* BTY = (bf16_t*)WSP(WS_BTY);
      for (int cb = vbase; cb < 32 * 512 * 96 / NT; cb += vtot) for (int vs = 0; vs < vslots; ++vs) {
        const int ch = cb + vs; if (ch >= 32 * 512 * 96 / NT) break;
        const bool kpart = ch < 2048; const int it = (kpart ? ch : ch - 2048) * NT + tid;
        const int cgp = kpart ? (it & 63) : 64 + (it & 31), rg = kpart ? (it >> 6) : (it >> 5), row = rg & 511, g = rg >> 9;
        const int j = row >> 4, pp = row & 15, col0 = cgp * 8;
        float v[8];
        if (col0 < 512) {
          const int i = col0 >> 4, q0 = col0 & 15;
#pragma unroll
          for (int e = 0; e < 8; ++e) v[e] = 0.f;
          if (i <= j) { const float* kp = KT + ((size_t)(0 * 32 + g) * 32 + (j - i)) * 256 + pp * 16 + q0;
#pragma unroll
            for (int e = 0; e < 8; ++e) v[e] += kp[e]; }
          if (i >= j) { const float* kp = KT + ((size_t)(1 * 32 + g) * 32 + (i - j)) * 256 + pp * 16 + q0;
#pragma unroll
            for (int e = 0; e < 8; ++e) v[e] += kp[e]; }
          if (i == j && pp >= q0 && pp < q0 + 8) {
#pragma unroll
            for (int e = 0; e < 8; ++e) if (q0 + e == pp) v[e] += dsk[g * 16 + pp];
          }
        } else {
          const int cc0 = col0 - 512, d = cc0 >> 7, n0 = (cc0 & 127) >> 1;
          const float ex = (float)(d == 0 ? j + 1 : 32 - j);
#pragma unroll
          for (int q = 0; q < 4; ++q) {
            const int n = n0 + q, sidx = (d * 32 + g) * 64 + n;
            const float mag = __expf(ex * ARDT[sidx]), pr = mag * __cosf(ex * AIDT[sidx]), pi = mag * __sinf(ex * AIDT[sidx]);
            const float cr = c_re[((d * 32 + g) * 16 + pp) * 64 + n], ci = c_im[((d * 32 + g) * 16 + pp) * 64 + n];
            v[2 * q] = cr * pr - ci * pi; v[2 * q + 1] = -(cr * pi + ci * pr);
          }
        }
        u32x4 w; w.x = pg8::cvt_pk_bf16(v[0], v[1]); w.y = pg8::cvt_pk_bf16(v[2], v[3]); w.z = pg8::cvt_pk_bf16(v[4], v[5]); w.w = pg8::cvt_pk_bf16(v[6], v[7]);
        *(u32x4*)(BTY + ((size_t)g * 512 + row) * 768 + col0) = w;
      }
    }
  }
  xcd_barrier(xbar);

  {
    PHASE_LOCALS
    const float* ARDT = (const float*)WSP(WS_ARDT); const float* AIDT = (const float*)WSP(WS_AIDT);
    if (wid == 0) {
      for (int it = blockIdx.x; it < Bn * 32 * 2; it += gridDim.x) {
        const int d = it & 1, g = (it >> 1) & 31, b = it >> 6;
        const int sidx = (d * 32 + g) * 64 + lane;
        const float mag = expf(32.f * ARDT[sidx]), pr = mag * cosf(32.f * AIDT[sidx]), pi = mag * sinf(32.f * AIDT[sidx]);
        typedef float f32x2_ __attribute__((ext_vector_type(2)));
        const f32x2_* Sg = (const f32x2_*)((const float*)WSP(WS_S) + (size_t)g * SA_ROWS * 256) + d * 64 + lane;
        bf16_t* SAg = (bf16_t*)WSP(WS_SA) + (size_t)g * SA_ROWS * SA_LD + 512 + d * 128 + lane * 2;
        float hr = 0.f, hi = 0.f;
        f32x2_ sc[8];
#pragma unroll
        for (int k = 0; k < 8; ++k) { const int cc = d == 0 ? k : 7 - k; sc[k] = Sg[(size_t)(512 + b * 8 + cc) * 128]; }
#pragma unroll
        for (int k = 0; k < 8; ++k) { const float nr = pr * hr - pi * hi + sc[k][0], ni = pr * hi + pi * hr + sc[k][1]; hr = nr; hi = ni; }
        for (int k0 = 0; k0 < 128; k0 += 16) {
          f32x2_ sv[16];
#pragma unroll
          for (int k = 0; k < 16; ++k) { const int cx = d == 0 ? k0 + k : 127 - (k0 + k); sv[k] = Sg[(size_t)(b * 128 + cx) * 128]; }
#pragma unroll
          for (int k = 0; k < 16; ++k) {
            const int cx = d == 0 ? k0 + k : 127 - (k0 + k);
            *(unsigned*)(SAg + (size_t)(b * 128 + cx) * SA_LD) = pg8::cvt_pk_bf16(hr, hi);
            const float nr = pr * hr - pi * hi + sv[k][0], ni = pr * hi + pi * hr + sv[k][1]; hr = nr; hi = ni;
          }
        }
      }
    }
  }
  xcd_barrier(xbar);

  {
    pg8::Gemm g{(const bf16_t*)WSP(WS_SA), (const bf16_t*)WSP(WS_BTY), 0, 0, 768, SA_LD, 768};
    GroupSched S; S.init(32, 2, 2, (long)SA_ROWS * SA_LD * 2, (long)256 * SA_LD * 2, (long)512 * 768 * 2, (long)256 * 768 * 2, (int)gridDim.x, (int)blockIdx.x);
    EpiY E{(bf16_t*)WSP(WS_YG)};
    pg8::gemm_phase<EpiY, GroupSched, true, true>((PG8_LAS unsigned char*)lds, g, S, E);
  }
  {
    pg8::Gemm g{(const bf16_t*)WSP(WS_ATT), (const bf16_t*)WSP(WS_WAU), MX, 1024, 1024, 1024, 1024};
    pg8::StaticOrder S; S.init(MX, 1024, (int)gridDim.x, (int)blockIdx.x, g.lda, g.ldb);
    EpiBf8<1> E{(bf16_t*)WSP(WS_M), 1024, (const bf16_t*)WSP(WS_G), 2048, nullptr};
    pg8::gemm_phase<EpiBf8<1>, pg8::StaticOrder, true, true>((PG8_LAS unsigned char*)lds, g, S, E);
  }
  xcd_barrier(xbar);

  {
    pg8::Gemm g{(const bf16_t*)WSP(WS_YG), (const bf16_t*)WSP(WS_WGLU), MX, 512, 512, 512, 512};
    pg8::StaticOrder S; S.init(MX, 512, (int)gridDim.x, (int)blockIdx.x, g.lda, g.ldb);
    EpiBf8<0> E{(bf16_t*)WSP(WS_SSMX), 512, (const bf16_t*)WSP(WS_YG), 512, INP(24)};
    pg8::gemm_phase<EpiBf8<0>, pg8::StaticOrder, true, true>((PG8_LAS unsigned char*)lds, g, S, E);
  }
  xcd_barrier(xbar);

  {
    pg8::Gemm g{(const bf16_t*)WSP(WS_SSMX), (const bf16_t*)WSP(WS_WSU), MX, 1024, 512, 512, 512};
    pg8::StaticOrder S; S.init(MX, 1024, (int)gridDim.x, (int)blockIdx.x, g.lda, g.ldb);
    EpiBf8<2> E{(bf16_t*)WSP(WS_M), 1024, (const bf16_t*)WSP(WS_G) + 1024, 2048, nullptr};
    pg8::gemm_phase<EpiBf8<2>, pg8::StaticOrder, true, true>((PG8_LAS unsigned char*)lds, g, S, E);
  }
  xcd_barrier(xbar);
  {
    pg8::Gemm g{(const bf16_t*)WSP(WS_M), (const bf16_t*)WSP(WS_WOUT), MX, 1024, 1024, 1024, 1024};
    pg8::StaticOrder S; S.init(MX, 1024, (int)gridDim.x, (int)blockIdx.x, g.lda, g.ldb);
    EpiF32<1> E{(float*)WSP(WS_X1), INP(0), (const float*)WSP(WS_MOD)};
    pg8::gemm_phase<EpiF32<1>, pg8::StaticOrder, true, true>((PG8_LAS unsigned char*)lds, g, S, E);
  }
  xcd_barrier(xbar);
  {
    PHASE_LOCALS
    const float* X1 = (const float*)WSP(WS_X1); const float* MOD = (const float*)WSP(WS_MOD); bf16_t* XN2 = (bf16_t*)WSP(WS_XN2); const float* norm2_g = INP(7);
    for (int row = gw; row < MX; row += ngw) {
      const float* src = X1 + (size_t)row * D; const float* md = MOD + (row / L) * 6144;
      f32x4 v[4]; float ss = 0.f;
#pragma unroll
      for (int j = 0; j < 4; ++j) { v[j] = *(const f32x4*)(src + lane * 4 + 256 * j); ss += v[j][0] * v[j][0] + v[j][1] * v[j][1] + v[j][2] * v[j][2] + v[j][3] * v[j][3]; }
      const float rstd = rsqrtf(wave_sum(ss) * (1.f / D) + 1e-6f);
#pragma unroll
      for (int j = 0; j < 4; ++j)
#pragma unroll
        for (int e = 0; e < 4; ++e) { const int col = lane * 4 + 256 * j + e; XN2[(size_t)row * D + col] = f2bf(v[j][e] * rstd * norm2_g[col] * (1.f + md[4096 + col]) + md[3072 + col]); }
    }
    slice_table_fp8(INP(30), (unsigned char*)WSP(WS_U8), 32.f, gtid, gsz);
    {
      const float* wq = INP(27); const float* sk1 = INP(28); const float* sk2 = INP(29); bf16_t* WC = (bf16_t*)WSP(WS_WC);
      float* skl = fl; float* wql = fl + 128 * 65;
      for (int tile = blockIdx.x; tile < 16 * 16; tile += gridDim.x) {
        const int hs = tile >> 4, d0 = (tile & 15) * 64, h = hs >> 1, s = hs & 1;
        __syncthreads();
        const float* skp = s ? sk2 : sk1;
        for (int i = tid; i < 128 * 16; i += NT) { const int k = i >> 4, e4 = (i & 15) * 4; const f32x4 v = *(const f32x4*)(skp + k * 64 + e4); skl[k * 65 + e4] = v[0]; skl[k * 65 + e4 + 1] = v[1]; skl[k * 65 + e4 + 2] = v[2]; skl[k * 65 + e4 + 3] = v[3]; }
        for (int i = tid; i < 64 * 16; i += NT) { const int dd = i >> 4, e4 = (i & 15) * 4; const f32x4 v = *(const f32x4*)(wq + (size_t)(d0 + dd) * 1024 + h * 128 + s * 64 + e4); wql[dd * 65 + e4] = v[0]; wql[dd * 65 + e4 + 1] = v[1]; wql[dd * 65 + e4 + 2] = v[2]; wql[dd * 65 + e4 + 3] = v[3]; }
        __syncthreads();
        const int k = tid & 127, dgp = tid >> 7;
        float a[16];
#pragma unroll
        for (int q = 0; q < 16; ++q) a[q] = 0.f;
        for (int e = 0; e < 64; ++e) {
          const float sv = skl[k * 65 + e];
#pragma unroll
          for (int q = 0; q < 16; ++q) a[q] += sv * wql[(dgp * 16 + q) * 65 + e];
        }
        u32x4 w0, w1;
        w0.x = pg8::cvt_pk_bf16(a[0], a[1]); w0.y = pg8::cvt_pk_bf16(a[2], a[3]); w0.z = pg8::cvt_pk_bf16(a[4], a[5]); w0.w = pg8::cvt_pk_bf16(a[6], a[7]);
        w1.x = pg8::cvt_pk_bf16(a[8], a[9]); w1.y = pg8::cvt_pk_bf16(a[10], a[11]); w1.z = pg8::cvt_pk_bf16(a[12], a[13]); w1.w = pg8::cvt_pk_bf16(a[14], a[15]);
        bf16_t* dst = WC + (size_t)(h * 256 + s * 128 + k) * 1024 + d0 + dgp * 16;
        *(u32x4*)dst = w0; *(u32x4*)(dst + 8) = w1;
      }
      __syncthreads();
    }
  }
  xcd_barrier(xbar);
  {
    pg8::Gemm g{(const bf16_t*)WSP(WS_XN2), (const bf16_t*)WSP(WS_WC), MX, 2048, 1024, 1024, 1024};
    EpiTopK E{(unsigned short*)WSP(WS_IDX), (float*)WSP(WS_GATE)};
    const int nrounds = (64 * 8 + (int)gridDim.x - 1) / (int)gridDim.x;
    for (int rd = 0; rd < nrounds; ++rd) {
      OneUnitSched S; S.nM = 64; S.nN = 8; S.G = (int)gridDim.x; S.c = (int)blockIdx.x; S.round = rd; S.tsA = (long)256 * 1024 * 2; S.tsB = (long)256 * 1024 * 2;
      pg8::gemm_phase<EpiTopK, OneUnitSched, false, true>((PG8_LAS unsigned char*)lds, g, S, E);
    }
  }
  xcd_barrier(xbar);
  {
    PHASE_LOCALS
    const bf16_t* XN2 = (const bf16_t*)WSP(WS_XN2); const unsigned short* EXT = (const unsigned short*)WSP(WS_IDX);
    bf16_t* PD = (bf16_t*)WSP(WS_PD);
    const bool sl = (gridDim.x & 7) == 0;
    const int widu = __builtin_amdgcn_readfirstlane(wid);
    const int j0 = sl ? (int)(blockIdx.x & 7) : 0, nj = sl ? 1 : 8;
    const int wk = sl ? (int)(blockIdx.x >> 3) * 8 + widu : (int)blockIdx.x * (NT / 64) + widu, nwk = sl ? (int)(gridDim.x >> 3) * 8 : ngw;
    const int eg = lane >> 3, li = lane & 7;
    for (int jj = 0; jj < nj; ++jj) {
      const int j = j0 + jj;
      const unsigned char* U8j = (const unsigned char*)WSP(WS_U8) + (size_t)j * 16384 * 128 + li * 16;
      for (int t = wk; t < MX; t += nwk) {
        const u32x4* xp = (const u32x4*)(XN2 + (size_t)t * 1024 + j * 128 + li * 16);
        const u32x4 xa = xp[0], xb = xp[1];
        const u32x4* ep = (const u32x4*)(EXT + (size_t)t * 128 + eg * 16);
        const u32x4 e0 = ep[0], e1 = ep[1];
        const unsigned ew[8] = {e0.x, e0.y, e0.z, e0.w, e1.x, e1.y, e1.z, e1.w};
        u32x4 uw[16];
#pragma unroll
        for (int k = 0; k < 16; ++k) { const unsigned ex = (k & 1) ? (ew[k >> 1] >> 16) : (ew[k >> 1] & 0xffffu); uw[k] = *(const u32x4*)(U8j + ex * 128u); }
        const unsigned xwd[8] = {xa.x, xa.y, xa.z, xa.w, xb.x, xb.y, xb.z, xb.w};
        f32x2_t xf[8];
#pragma unroll
        for (int q = 0; q < 8; ++q) xf[q] = (f32x2_t){bflo(xwd[q]), bfhi(xwd[q])};
        float keep_lo = 0.f, keep_hi = 0.f;
#pragma unroll
        for (int k = 0; k < 16; ++k) {
          const unsigned uu[4] = {uw[k].x, uw[k].y, uw[k].z, uw[k].w};
          f32x2_t s2 = {0.f, 0.f};
#pragma unroll
          for (int q = 0; q < 4; ++q) { s2 += __builtin_amdgcn_cvt_pk_f32_fp8((int)uu[q], false) * xf[2 * q]; s2 += __builtin_amdgcn_cvt_pk_f32_fp8((int)uu[q], true) * xf[2 * q + 1]; }
          float dp = s2.x + s2.y;
          dp = dpp_add<0xB1>(dp); dp = dpp_add<0x4E>(dp); dp = dpp_add<0x141>(dp);
          if (li == (k & 7)) { if (k < 8) keep_lo = dp; else keep_hi = dp; }
        }
        bf16_t* pd = PD + ((size_t)t * 128 + eg * 16 + li) * 8 + j;
        pd[0] = f2bf(keep_lo * (1.f / 32.f)); pd[8 * 8] = f2bf(keep_hi * (1.f / 32.f));
      }
    }
    slice_table_fp8(INP(31), (unsigned char*)WSP(WS_V8), 1.f, gtid, gsz);
  }
  xcd_barrier(xbar);
  {
    PHASE_LOCALS
    const bf16_t* PD = (const bf16_t*)WSP(WS_PD); const float* GATE = (const float*)WSP(WS_GATE); unsigned* CFP = (unsigned*)WSP(WS_CFP);
    for (int t = gw; t < MX; t += ngw) {
      const u32x4* pp = (const u32x4*)(PD + ((size_t)t * 128 + 2 * lane) * 8);
      const u32x4 pa = pp[0], pb = pp[1];
      const f32x2_t g2 = *(const f32x2_t*)(GATE + (size_t)t * 128 + 2 * lane);
      const float p0 = ((bflo(pa.x) + bfhi(pa.x)) + (bflo(pa.y) + bfhi(pa.y))) + ((bflo(pa.z) + bfhi(pa.z)) + (bflo(pa.w) + bfhi(pa.w)));
      const float p1 = ((bflo(pb.x) + bfhi(pb.x)) + (bflo(pb.y) + bfhi(pb.y))) + ((bflo(pb.z) + bfhi(pb.z)) + (bflo(pb.w) + bfhi(pb.w)));
      CFP[(size_t)t * 64 + lane] = pg8::cvt_pk_bf16(g2.x * gelu_tanh(p0), g2.y * gelu_tanh(p1));
    }
  }
  xcd_barrier(xbar);
  {
    PHASE_LOCALS
    const float* X1 = (const float*)WSP(WS_X1); const float* MOD = (const float*)WSP(WS_MOD);
    const unsigned short* EXT = (const unsigned short*)WSP(WS_IDX); const unsigned* CFP = (const unsigned*)WSP(WS_CFP);
    float* SSQ = (float*)WSP(WS_SSQ); float* out = GPTR(float, ldptr_(33));
    const bool sl = (gridDim.x & 7) == 0;
    const int widu = __builtin_amdgcn_readfirstlane(wid);
    const int j0 = sl ? (int)(blockIdx.x & 7) : 0, nj = sl ? 1 : 8;
    const int wk = sl ? (int)(blockIdx.x >> 3) * 8 + widu : (int)blockIdx.x * (NT / 64) + widu, nwk = sl ? (int)(gridDim.x >> 3) * 8 : ngw;
    const int eg = lane >> 3, li = lane & 7;
    float* red = fl + widu * 1024;
    for (int jj = 0; jj < nj; ++jj) {
      const int j = j0 + jj;
      const unsigned char* V8j = (const unsigned char*)WSP(WS_V8) + (size_t)j * 16384 * 128 + li * 16;
      for (int t = wk; t < MX; t += nwk) {
        const u32x4* ep = (const u32x4*)(EXT + (size_t)t * 128 + eg * 16);
        const u32x4 e0 = ep[0], e1 = ep[1];
        const u32x4* cp = (const u32x4*)(CFP + (size_t)t * 64 + eg * 8);
        const u32x4 c0 = cp[0], c1 = cp[1];
        const int col = j * 128 + 2 * lane;
        const f32x2_t xr = *(const f32x2_t*)(X1 + (size_t)t * 1024 + col);
        const f32x2_t gr = *(const f32x2_t*)(MOD + (t >> 12) * 6144 + 5120 + col);
        const unsigned ew[8] = {e0.x, e0.y, e0.z, e0.w, e1.x, e1.y, e1.z, e1.w};
        const unsigned cfp[8] = {c0.x, c0.y, c0.z, c0.w, c1.x, c1.y, c1.z, c1.w};
        u32x4 vw[16];
#pragma unroll
        for (int k = 0; k < 16; ++k) { const unsigned ex = (k & 1) ? (ew[k >> 1] >> 16) : (ew[k >> 1] & 0xffffu); vw[k] = *(const u32x4*)(V8j + ex * 128u); }
        f32x2_t a[8];
#pragma unroll
        for (int q = 0; q < 8; ++q) a[q] = (f32x2_t){0.f, 0.f};
#pragma unroll
        for (int k = 0; k < 16; ++k) {
          const unsigned cf2 = cfp[k >> 1]; const float cf = (k & 1) ? bfhi(cf2) : bflo(cf2);
          const unsigned vv[4] = {vw[k].x, vw[k].y, vw[k].z, vw[k].w};
#pragma unroll
          for (int q = 0; q < 4; ++q) { a[2 * q] += __builtin_amdgcn_cvt_pk_f32_fp8((int)vv[q], false) * cf; a[2 * q + 1] += __builtin_amdgcn_cvt_pk_f32_fp8((int)vv[q], true) * cf; }
        }
#pragma unroll
        for (int q = 0; q < 4; ++q) *(f32x4*)(red + eg * 128 + li * 16 + q * 4) = (f32x4){a[2 * q].x, a[2 * q].y, a[2 * q + 1].x, a[2 * q + 1].y};
        asm volatile("s_waitcnt lgkmcnt(0)" ::: "memory");
        f32x2_t acc = {0.f, 0.f};
#pragma unroll
        for (int g = 0; g < 8; ++g) acc += *(const f32x2_t*)(red + g * 128 + 2 * lane);
        asm volatile("s_waitcnt lgkmcnt(0)" ::: "memory");
        const f32x2_t o2 = xr + gr * acc;
        float ss = o2.x * o2.x + o2.y * o2.y;
        ss = wave_sum(ss);
        *(f32x2_t*)(out + (size_t)t * 1024 + col) = o2;
        if (lane == 0) SSQ[(size_t)t * 8 + j] = ss;
      }
    }
  }
  xcd_barrier(xbar);
  {
    PHASE_LOCALS
    const float* SSQ = (const float*)WSP(WS_SSQ); const float* fng = INP(32); float* out = GPTR(float, ldptr_(33));
    f32x4 g4[4];
#pragma unroll
    for (int jq = 0; jq < 4; ++jq) g4[jq] = *(const f32x4*)(fng + lane * 4 + 256 * jq);
    for (int row = gw; row < MX; row += ngw) {
      const f32x4 sa = *(const f32x4*)(SSQ + (size_t)row * 8), sb = *(const f32x4*)(SSQ + (size_t)row * 8 + 4);
      const float rstd = rsqrtf(((sa[0] + sa[1]) + (sa[2] + sa[3]) + (sb[0] + sb[1]) + (sb[2] + sb[3])) * (1.f / D) + 1e-6f);
#pragma unroll
      for (int jq = 0; jq < 4; ++jq) {
        float* op = out + (size_t)row * D + lane * 4 + 256 * jq;
        const f32x4 v = *(const f32x4*)op;
        *(f32x4*)op = v * rstd * g4[jq];
      }
    }
  }
}

extern "C" void kernel_launch(void* const* d_in, const int* in_sizes, int n_in, void* d_out, int out_size, void* d_ws, size_t ws_size, hipStream_t stream) {
  static int grid_blocks = 0;
  if (!grid_blocks) {
    int dev = 0, cus = 0, per_cu = 0;
    (void)hipGetDevice(&dev);
    (void)hipDeviceGetAttribute(&cus, hipDeviceAttributeMultiprocessorCount, dev);
    (void)hipFuncSetAttribute((const void*)mega, hipFuncAttributeMaxDynamicSharedMemorySize, LDS_BYTES);
    (void)hipOccupancyMaxActiveBlocksPerMultiprocessor(&per_cu, (const void*)mega, NT, LDS_BYTES);
    if (per_cu < 1) per_cu = 1;
    grid_blocks = cus * per_cu;
    if (n_in != 33 || ws_size < 255 * MiB) { fprintf(stderr, "kernel_launch: unexpected n_in %d / ws %zu\n", n_in, ws_size); }
  }
  Params p{};
  for (int i = 0; i < 33 && i < n_in; ++i) p.in[i] = (const float*)d_in[i];
  p.out = (float*)d_out; p.ws = (unsigned char*)d_ws;
  void* args[] = {&p};
  hipError_t e = hipLaunchCooperativeKernel((const void*)mega, dim3(grid_blocks), dim3(NT), args, LDS_BYTES, stream);
  if (e != hipSuccess) fprintf(stderr, "cooperative launch failed: %s (grid %d)\n", hipGetErrorString(e), grid_blocks);
}
```

```cpp
#include <hip/hip_runtime.h>
#include <hip/hip_cooperative_groups.h>
#include <cstdio>
#include <cstdint>
namespace cg = cooperative_groups;

typedef unsigned short bf16_t;
typedef float f32x4 __attribute__((ext_vector_type(4)));

constexpr int NT = 512;
constexpr int LDS_BYTES = 147456;
constexpr int Bn = 4, L = 4096, D = 1024, NCTX = 256, LA = L + NCTX;
constexpr int MX = Bn * L, MC = Bn * NCTX;
constexpr int N_IN = 5632;
constexpr size_t MiB = 1u << 20;
constexpr size_t WS_MOD = 0, WS_LAM = 128 * 1024, WS_ROPE = 136 * 1024, WS_ARDT = 144 * 1024, WS_AIDT = 160 * 1024;
constexpr size_t WS_ABRE = 192 * 1024, WS_ABIM = 224 * 1024, WS_BBRE = 256 * 1024, WS_BBIM = 512 * 1024;
constexpr size_t WS_FLAGS = 1 * MiB + 65536;
constexpr size_t WS_BAR = 1 * MiB;
constexpr size_t WS_KT = 2 * MiB;
constexpr size_t WS_XN = 4 * MiB, WS_Q = 38 * MiB, WS_K = 70 * MiB, WS_V = 104 * MiB, WS_SA = 138 * MiB, WS_G = 164 * MiB;
constexpr size_t WS_WIN = 228 * MiB, WS_WAU = 239 * MiB, WS_WSU = 241 * MiB, WS_WOUT = 242 * MiB, WS_WQ = 244 * MiB, WS_WGLU = 246 * MiB;
constexpr size_t WS_BTS = 247 * MiB;
constexpr size_t WS_BTY = 38 * MiB, WS_S = 62 * MiB, WS_YG = 79 * MiB, WS_SSMX = 62 * MiB, WS_M = 95 * MiB;
constexpr size_t WS_ATT = WS_XN, WS_X1 = 4 * MiB, WS_XN2 = 68 * MiB, WS_QP = WS_G;
constexpr size_t WS_IDX = 111 * MiB, WS_GATE = 115 * MiB, WS_SSQ = 123 * MiB;
constexpr size_t WS_U8 = 127 * MiB, WS_PD = 164 * MiB, WS_V8 = 196 * MiB, WS_WC = 160 * MiB, WS_CFP = 160 * MiB;
constexpr int SA_ROWS = 544, SA_LD = 768;

constexpr int PTR_OFF = LDS_BYTES - 1024;
__device__ __forceinline__ unsigned long long ldptr_(int k) {
  extern __shared__ __attribute__((aligned(16))) unsigned char lds_[];
  const unsigned long long v = ((const unsigned long long*)(lds_ + PTR_OFF))[k];
  const unsigned lo = __builtin_amdgcn_readfirstlane((unsigned)v), hi = __builtin_amdgcn_readfirstlane((unsigned)(v >> 32));
  return ((unsigned long long)hi << 32) | lo;
}
#define GPTR(T, v) ((T*)(__attribute__((address_space(1))) T*)(v))
#define INP(k) GPTR(const float, ldptr_(k))
#define WSP(off) GPTR(unsigned char, ldptr_(34) + (off))
#define PHASE_LOCALS \
  int tid = threadIdx.x; asm volatile("" : "+v"(tid)); \
  const int lane = tid & 63, wid = tid >> 6; \
  const int gtid = blockIdx.x * NT + tid, gsz = gridDim.x * NT; \
  const int gw = blockIdx.x * (NT / 64) + wid, ngw = gridDim.x * (NT / 64); \
  float* fl = (float*)lds; (void)lane; (void)wid; (void)gtid; (void)gsz; (void)gw; (void)ngw; (void)fl;

struct Params {
  const float* in[33];
  float* out;
  unsigned char* ws;
  int pad0, pad1;
};

__device__ __forceinline__ float bf2f(bf16_t v) { return __uint_as_float(((unsigned)v) << 16); }
__device__ __forceinline__ bf16_t f2bf(float f) { unsigned u = __float_as_uint(f); return (bf16_t)((u + 0x7fffu + ((u >> 16) & 1u)) >> 16); }
__device__ __forceinline__ float wave_sum(float v) {
#pragma unroll
  for (int o = 32; o; o >>= 1) v += __shfl_xor(v, o);
  return v;
}
__device__ __forceinline__ float gelu_tanh(float x) { const float u2 = -2.302208198f * (x + 0.044715f * x * x * x); return x * __builtin_amdgcn_rcpf(1.f + __builtin_amdgcn_exp2f(u2)); }
__device__ __forceinline__ float sigmoidf_(float x) { return __builtin_amdgcn_rcpf(1.f + __builtin_amdgcn_exp2f(-1.4426950408889634f * x)); }
__device__ __forceinline__ float siluf_(float x) { return x / (1.f + __expf(-x)); }

template <class Epi>
__device__ __forceinline__ void sgemm(const bf16_t* A, int lda, const float* Bm, int ldb, int M, int N, int K, float* lds, Epi epi) {
  constexpr int TM = 128, TN = 128, TK = 16, LDA_S = TM + 4, LDB_S = TN + 4;
  float* As = lds;
  float* Bs = lds + TK * LDA_S;
  const int tid = threadIdx.x, ty = tid >> 4, tx = tid & 15;
  const int ntm = M / TM, ntn = N / TN;
  for (int tile = blockIdx.x; tile < ntm * ntn; tile += gridDim.x) {
    const int tm = tile / ntn, tn = tile % ntn;
    float acc[4][8];
#pragma unroll
    for (int i = 0; i < 4; ++i)
#pragma unroll
      for (int j = 0; j < 8; ++j) acc[i][j] = 0.f;
    const int ar = tid >> 2, ak = (tid & 3) * 4;
    const int bk = tid >> 5, bn = (tid & 31) * 4;
    for (int k0 = 0; k0 < K; k0 += TK) {
      const bf16_t* ap = A + (size_t)(tm * TM + ar) * lda + k0 + ak;
      const unsigned long long av = *(const unsigned long long*)ap;
      const f32x4 bv = *(const f32x4*)(Bm + (size_t)(k0 + bk) * ldb + tn * TN + bn);
      __syncthreads();
      As[(ak + 0) * LDA_S + ar] = bf2f((bf16_t)(av & 0xffff));
      As[(ak + 1) * LDA_S + ar] = bf2f((bf16_t)((av >> 16) & 0xffff));
      As[(ak + 2) * LDA_S + ar] = bf2f((bf16_t)((av >> 32) & 0xffff));
      As[(ak + 3) * LDA_S + ar] = bf2f((bf16_t)((av >> 48) & 0xffff));
      *(f32x4*)(Bs + bk * LDB_S + bn) = bv;
      __syncthreads();
#pragma unroll
      for (int k = 0; k < TK; ++k) {
        const f32x4 a4 = *(const f32x4*)(As + k * LDA_S + ty * 4);
        const f32x4 b0 = *(const f32x4*)(Bs + k * LDB_S + tx * 8);
        const f32x4 b1 = *(const f32x4*)(Bs + k * LDB_S + tx * 8 + 4);
#pragma unroll
        for (int i = 0; i < 4; ++i) {
          acc[i][0] += a4[i] * b0[0]; acc[i][1] += a4[i] * b0[1]; acc[i][2] += a4[i] * b0[2]; acc[i][3] += a4[i] * b0[3];
          acc[i][4] += a4[i] * b1[0]; acc[i][5] += a4[i] * b1[1]; acc[i][6] += a4[i] * b1[2]; acc[i][7] += a4[i] * b1[3];
        }
      }
    }
#pragma unroll
    for (int i = 0; i < 4; ++i)
#pragma unroll
      for (int j = 0; j < 8; ++j) epi(tm * TM + ty * 4 + i, tn * TN + tx * 8 + j, acc[i][j]);
  }
  __syncthreads();
}

namespace pg8 {
#define PG8_LAS __attribute__((address_space(3)))
typedef unsigned short bf16_t;
typedef short bf16x8 __attribute__((ext_vector_type(8)));
typedef float f32x4 __attribute__((ext_vector_type(4)));
typedef unsigned u32x4 __attribute__((ext_vector_type(4)));
constexpr int BM = 256, BK = 64, HALF = 128, HTB = HALF * BK * 2  , STAGE_BYTES = 8 * HTB, NXCD = 8, WGM = 8;

__host__ __device__ __forceinline__ int lds_byte(int r, int c) { const int st = (r >> 4) * 2 + (c >> 5), rr = r & 15, cc = c & 31, ob = rr * 64 + cc * 2; return st * 1024 + (ob ^ (((ob >> 9) & 1) << 5)); }
__host__ __device__ __forceinline__ void stage_rc(int b, int& R, int& C) { const int st = b / 1024, sb = b % 1024, swz = sb ^ (((sb >> 9) & 1) << 5); R = (st >> 1) * 16 + swz / 64; C = (st & 1) * 32 + (swz % 64) / 2; }
__host__ __device__ __forceinline__ int perm32(int rho) { const int n = rho >> 4, i = rho & 15; return 8 * (i >> 2) + 4 * n + (i & 3); }

struct Unit { int pm, pn, grp; long ao, bo; };
struct Gemm { const bf16_t* A; const bf16_t* Bt; int M, N, K, lda, ldb; };

struct StaticOrder {
    int nM, nN, nwg, G, c; long tsA, tsB;
    __host__ __device__ void init(int M, int N, int G_, int c_, int lda, int ldb) { nM = M / BM; nN = N / BM; nwg = nM * nN; G = G_; c = c_; tsA = (long)BM * lda * 2; tsB = (long)BM * ldb * 2; }
    __host__ __device__ bool next(int i, Unit& u) const {
        const long L = (long)i * G + c; if (L >= nwg) return false;
        int wgid = (int)L; { const int q = nwg / NXCD, r = nwg % NXCD, xcd = wgid % NXCD, off = wgid / NXCD; wgid = (xcd < r ? xcd * (q + 1) : r * (q + 1) + (xcd - r) * q) + off; }
        const int nig = WGM * nN, gid = wgid / nig, fm = gid * WGM, gsz = (nM - fm) < WGM ? (nM - fm) : WGM;
        u.pm = fm + ((wgid % nig) % gsz); u.pn = (wgid % nig) / gsz; u.grp = 0; u.ao = u.pm * tsA; u.bo = u.pn * tsB; return true;
    }
    __device__ __forceinline__ void a_ready(const Unit&) const {}
    __device__ __forceinline__ void done(const Unit&) const {}
};

__device__ __forceinline__ unsigned cvt_pk_bf16(float lo, float hi) { unsigned r; asm volatile("v_cvt_pk_bf16_f32 %0, %1, %2" : "=v"(r) : "v"(lo), "v"(hi)); return r; }
template <class Epi, class Sched, bool ALIGN_EPI = false, bool SP2 = false>
__device__ __forceinline__ void gemm_phase(PG8_LAS unsigned char* lds, const Gemm g, const Sched& S, const Epi& E) {
    int tid_ = threadIdx.x; asm volatile("" : "+v"(tid_));
    const int tid = tid_, wid = __builtin_amdgcn_readfirstlane(tid >> 6), lane = tid & 63, wr = wid >> 2, wc = wid & 3, fr = lane & 15, fq = lane >> 4;
    const int K = g.K, nt = K / BK;
    unsigned voffA[2], voffB[2];
#pragma unroll
    for (int i = 0; i < 2; ++i) { int R, C; stage_rc(tid * 16 + i * 8192, R, C); const int Rb = Epi::PERM ? ((R & ~31) + perm32(R & 31)) : R;
        voffA[i] = (unsigned)(R * g.lda + C) * 2u; voffB[i] = (unsigned)(Rb * g.ldb + C) * 2u; }
    const size_t kstep = (size_t)(BK * 2);
    const size_t hstepA = (size_t)HALF * g.lda * 2, hstepB = (size_t)HALF * g.ldb * 2;
    const unsigned ldsw = (unsigned)wid * 1024u;
    const int aoff = lds_byte(wr * 64 + fr, fq * 8), boff = lds_byte(wc * 32 + fr, fq * 8);
#define PG8_SA(b, h) (((b) * 2 + (h)) * HTB)
#define PG8_SB(b, h) ((4 + (b) * 2 + (h)) * HTB)
#define PG8_STAGE(bufoff, gbase, voff) do { _Pragma("unroll") for (int _i = 0; _i < 2; ++_i) \
        __builtin_amdgcn_global_load_lds((const unsigned*)((const char*)(gbase) + (voff)[_i]), (PG8_LAS unsigned*)(lds + (bufoff) + ldsw + _i * 8192), 16, 0, 0); } while (0)
#define PG8_LDA(dst, b, h) do { _Pragma("unroll") for (int m = 0; m < 4; ++m) _Pragma("unroll") for (int k = 0; k < 2; ++k) dst[m][k] = *(const PG8_LAS bf16x8*)(lds + PG8_SA(b, h) + aoff + m * 2048 + k * 1024); } while (0)
#define PG8_LDB(dst, b, h) do { _Pragma("unroll") for (int n = 0; n < 2; ++n) _Pragma("unroll") for (int k = 0; k < 2; ++k) dst[n][k] = *(const PG8_LAS bf16x8*)(lds + PG8_SB(b, h) + boff + n * 2048 + k * 1024); } while (0)
#define PG8_MMA(ai, bj, At, Bt) do { __builtin_amdgcn_s_setprio(1); _Pragma("unroll") for (int m = 0; m < 4; ++m) _Pragma("unroll") for (int n = 0; n < 2; ++n) _Pragma("unroll") for (int k = 0; k < 2; ++k) \
        acc[ai][bj][m][n] = __builtin_amdgcn_mfma_f32_16x16x32_bf16(Bt[n][k], At[m][k], acc[ai][bj][m][n], 0, 0, 0); __builtin_amdgcn_s_setprio(0); } while (0)
#define PG8_WAIT_V(n) asm volatile("s_waitcnt vmcnt(" #n ")" ::: "memory")
#define PG8_WAIT_L(n) asm volatile("s_waitcnt lgkmcnt(" #n ")" ::: "memory")
#define PG8_BAR __builtin_amdgcn_s_barrier()
#define PG8_SCHED __builtin_amdgcn_sched_barrier(0)
    Unit cur, nxt; int ui = 0;
    if (!S.next(0, cur)) return;
    f32x4 acc[2][2][4][2];
#pragma unroll
    for (int a = 0; a < 2; ++a)
#pragma unroll
        for (int b = 0; b < 2; ++b)
#pragma unroll
            for (int m = 0; m < 4; ++m)
#pragma unroll
                for (int n = 0; n < 2; ++n) acc[a][b][m][n] = (f32x4){0.f, 0.f, 0.f, 0.f};
    bf16x8 At[4][2], B0[2][2], B1[2][2];
    const char* cA = (const char*)g.A + cur.ao; const char* cB = (const char*)g.Bt + cur.bo;
    S.a_ready(cur);
    if constexpr (SP2) {
        PG8_STAGE(PG8_SB(0, 0), cB, voffB); PG8_STAGE(PG8_SB(0, 1), cB + hstepB, voffB); PG8_STAGE(PG8_SA(0, 0), cA, voffA); PG8_STAGE(PG8_SA(0, 1), cA + hstepA, voffA);
        if (wr == 1) PG8_BAR;
        PG8_WAIT_V(2); PG8_BAR;
        PG8_STAGE(PG8_SB(1, 0), cB + kstep, voffB); PG8_STAGE(PG8_SA(1, 0), cA + kstep, voffA); PG8_STAGE(PG8_SB(1, 1), cB + hstepB + kstep, voffB);
        PG8_WAIT_V(6); PG8_BAR;
    } else {
        PG8_STAGE(PG8_SB(0, 0), cB, voffB); PG8_STAGE(PG8_SA(0, 0), cA, voffA); PG8_STAGE(PG8_SB(0, 1), cB + hstepB, voffB); PG8_STAGE(PG8_SA(0, 1), cA + hstepA, voffA);
        if (wr == 1) PG8_BAR;
        PG8_WAIT_V(4); PG8_BAR;
        PG8_STAGE(PG8_SB(1, 0), cB + kstep, voffB); PG8_STAGE(PG8_SA(1, 0), cA + kstep, voffA); PG8_STAGE(PG8_SB(1, 1), cB + hstepB + kstep, voffB);
        PG8_WAIT_V(6); PG8_BAR;
    }
    for (;;) {
        const bool has_next = S.next(ui + 1, nxt);
        const char* nA = has_next ? (const char*)g.A + nxt.ao : cA; const char* nB = has_next ? (const char*)g.Bt + nxt.bo : cB;
        for (int t = 0; t < nt; t += 2) {
            const bool last = (t == nt - 2);
            const char* a1 = cA + (size_t)(t + 1) * kstep;
            const char* a2 = last ? nA : cA + (size_t)(t + 2) * kstep; const char* b2 = last ? nB : cB + (size_t)(t + 2) * kstep;
            const char* a3 = a2 + kstep; const char* b3 = b2 + kstep;
            if (last && has_next) S.a_ready(nxt);
            if constexpr (SP2) {
            PG8_LDB(B0, 0, 0); PG8_LDB(B1, 0, 1); PG8_SCHED; PG8_LDA(At, 0, 0); PG8_STAGE(PG8_SA(1, 1), a1 + hstepA, voffA);
            PG8_WAIT_V(8); PG8_WAIT_L(0); PG8_BAR; PG8_MMA(0, 0, At, B0); PG8_MMA(0, 1, At, B1); PG8_BAR; PG8_SCHED;
            PG8_LDA(At, 0, 1); PG8_STAGE(PG8_SB(0, 0), b2, voffB); PG8_STAGE(PG8_SB(0, 1), b2 + hstepB, voffB); PG8_STAGE(PG8_SA(0, 0), a2, voffA);
            PG8_WAIT_V(8); PG8_WAIT_L(0); PG8_BAR; PG8_MMA(1, 0, At, B0); PG8_MMA(1, 1, At, B1); PG8_BAR; PG8_SCHED;
            PG8_LDB(B0, 1, 0); PG8_LDB(B1, 1, 1); PG8_SCHED; PG8_LDA(At, 1, 0); PG8_STAGE(PG8_SA(0, 1), a2 + hstepA, voffA);
            PG8_WAIT_V(8); PG8_WAIT_L(0); PG8_BAR; PG8_MMA(0, 0, At, B0); PG8_MMA(0, 1, At, B1); PG8_BAR; PG8_SCHED;
            PG8_LDA(At, 1, 1); PG8_STAGE(PG8_SB(1, 0), b3, voffB); PG8_STAGE(PG8_SB(1, 1), b3 + hstepB, voffB); PG8_STAGE(PG8_SA(1, 0), a3, voffA);
            PG8_WAIT_V(8); PG8_WAIT_L(0); PG8_BAR; PG8_MMA(1, 0, At, B0); PG8_MMA(1, 1, At, B1); PG8_BAR; PG8_SCHED;
            } else {
            PG8_LDB(B0, 0, 0); PG8_SCHED; PG8_LDA(At, 0, 0); PG8_STAGE(PG8_SA(1, 1), a1 + hstepA, voffA);
            PG8_WAIT_L(8); PG8_BAR; PG8_WAIT_L(0); PG8_MMA(0, 0, At, B0); PG8_BAR; PG8_SCHED;
            PG8_LDB(B1, 0, 1); PG8_STAGE(PG8_SB(0, 0), b2, voffB);
            PG8_BAR; PG8_WAIT_L(0); PG8_MMA(0, 1, At, B1); PG8_BAR;
            PG8_LDA(At, 0, 1); PG8_STAGE(PG8_SA(0, 0), a2, voffA);
            PG8_BAR; PG8_WAIT_L(0); PG8_MMA(1, 0, At, B0); PG8_BAR; PG8_SCHED;
            PG8_STAGE(PG8_SB(0, 1), b2 + hstepB, voffB);
            PG8_WAIT_V(6); PG8_BAR; PG8_MMA(1, 1, At, B1); PG8_BAR;
            PG8_LDB(B0, 1, 0); PG8_SCHED; PG8_LDA(At, 1, 0); PG8_STAGE(PG8_SA(0, 1), a2 + hstepA, voffA);
            PG8_WAIT_L(8); PG8_BAR; PG8_WAIT_L(0); PG8_MMA(0, 0, At, B0); PG8_BAR; PG8_SCHED;
            PG8_LDB(B1, 1, 1); PG8_STAGE(PG8_SB(1, 0), b3, voffB);
            PG8_BAR; PG8_WAIT_L(0); PG8_MMA(0, 1, At, B1); PG8_BAR;
            PG8_LDA(At, 1, 1); PG8_STAGE(PG8_SA(1, 0), a3, voffA);
            PG8_BAR; PG8_WAIT_L(0); PG8_MMA(1, 0, At, B0); PG8_BAR; PG8_SCHED;
            PG8_STAGE(PG8_SB(1, 1), b3 + hstepB, voffB);
            PG8_WAIT_V(6); PG8_BAR; PG8_MMA(1, 1, At, B1); PG8_BAR;
            }
        }
        if constexpr (ALIGN_EPI) { if (wr == 0) PG8_BAR; }
        if constexpr (!Epi::AFTER_DRAIN) { int fr_ = fr, fq_ = fq; asm volatile("" : "+v"(fr_), "+v"(fq_));
            E(acc, cur, wr, wc, fr_, fq_); S.done(cur); }
        if (!has_next) break;
#pragma unroll
        for (int a = 0; a < 2; ++a)
#pragma unroll
            for (int b = 0; b < 2; ++b)
#pragma unroll
                for (int m = 0; m < 4; ++m)
#pragma unroll
                    for (int n = 0; n < 2; ++n) acc[a][b][m][n] = (f32x4){0.f, 0.f, 0.f, 0.f};
        cur = nxt; cA = nA; cB = nB; ++ui;
        if constexpr (ALIGN_EPI) { if (wr == 1) PG8_BAR; }
    }
    PG8_WAIT_V(0);
    if constexpr (!ALIGN_EPI) { if (wr == 0) PG8_BAR; }
    PG8_BAR;
    if constexpr (Epi::AFTER_DRAIN) { int fr_ = fr, fq_ = fq, lane_ = lane; asm volatile("" : "+v"(fr_), "+v"(fq_), "+v"(lane_)); E.fused(acc, cur, wr, wc, fr_, fq_, lds, wid, lane_); S.done(cur); }
#undef PG8_SA
#undef PG8_SB
#undef PG8_STAGE
#undef PG8_LDA
#undef PG8_LDB
#undef PG8_MMA
#undef PG8_WAIT_V
#undef PG8_WAIT_L
#undef PG8_BAR
#undef PG8_SCHED
}
}


using pg8::Unit;
typedef unsigned u32x2 __attribute__((ext_vector_type(2)));
typedef unsigned u32x4 __attribute__((ext_vector_type(4)));
__device__ __forceinline__ float bflo(unsigned w) { return __uint_as_float(w << 16); }
__device__ __forceinline__ float bfhi(unsigned w) { return __uint_as_float(w & 0xffff0000u); }

struct InProjSched {
  pg8::StaticOrder so;
  __device__ __forceinline__ void init(int G, int c) { so.init(MX, N_IN, G, c, D, D); }
  __device__ __forceinline__ bool next(int i, Unit& u) const {
    const long Lx = (long)i * so.G + so.c;
    if (Lx < so.nwg) return so.next(i, u);
    const int j = (int)(Lx - so.nwg); if (j >= 40) return false;
    u.pm = 64 + (j & 3); u.pn = 4 + (j >> 2); u.grp = 0; u.ao = u.pm * so.tsA; u.bo = u.pn * so.tsB; return true;
  }
  __device__ __forceinline__ void a_ready(const Unit&) const {}
  __device__ __forceinline__ void done(const Unit&) const {}
};

struct EpiInProj {
  static constexpr bool PERM = true, AFTER_DRAIN = false;
  bf16_t *Q, *K, *V, *SA, *G; const float* rope;
  __device__ __forceinline__ static void st8(bf16_t* p, const f32x4 a, const f32x4 b) {
    u32x4 w; w.x = pg8::cvt_pk_bf16(a[0], a[1]); w.y = pg8::cvt_pk_bf16(a[2], a[3]); w.z = pg8::cvt_pk_bf16(b[0], b[1]); w.w = pg8::cvt_pk_bf16(b[2], b[3]); *(u32x4*)p = w; }
  __device__ __forceinline__ static f32x4 partner4(const f32x4 v, const bool upper) {
    f32x4 r;
#pragma unroll
    for (int i = 0; i < 4; ++i) { auto rr = __builtin_amdgcn_permlane32_swap(__float_as_uint(v[i]), __float_as_uint(v[i]), false, false); r[i] = __uint_as_float(upper ? rr[0] : rr[1]); }
    return r;
  }
  __device__ __forceinline__ void operator()(const f32x4 (&acc)[2][2][4][2], const Unit& u, int wr, int wc, int fr, int fq) const {
    const int row0 = u.pm * 256 + wr * 64 + fr;
    const int cg0 = u.pn * 256 + wc * 32 + fq * 8;
    if (u.pm < 64) {
      if (u.pn < 8) {
        const bool isq = u.pn < 4; const float qsc = isq ? 0.125f * 1.4426950408889634f : 1.f;
        const bool upper = fq >= 2; const float sgn = upper ? 1.f : -1.f;
#pragma unroll
        for (int ai = 0; ai < 2; ++ai)
#pragma unroll
          for (int m = 0; m < 4; ++m) {
            const int row = row0 + ai * 128 + m * 16, b = row >> 12, t = row & 4095;
            const int pos = (wc & 1) ? (t & 63) : (t >> 6);
            const f32x4* rp = (const f32x4*)(rope + (pos * 16 + (fq & 1) * 8) * 2);
            const f32x4 r0 = rp[0], r1 = rp[1], r2 = rp[2], r3 = rp[3];
            const f32x4 cs0 = {r0[0], r0[2], r1[0], r1[2]}, sn0 = {r0[1], r0[3], r1[1], r1[3]}, cs1 = {r2[0], r2[2], r3[0], r3[2]}, sn1 = {r2[1], r2[3], r3[1], r3[3]};
            bf16_t* dst = isq ? Q + (size_t)row * 1024 + cg0 : K + ((size_t)b * LA + NCTX + t) * 1024 + (cg0 - 1024);
#pragma unroll
            for (int bj = 0; bj < 2; ++bj) {
              const f32x4 v0 = acc[ai][bj][m][0], v1 = acc[ai][bj][m][1];
              const f32x4 p0 = partner4(v0, upper), p1 = partner4(v1, upper);
              st8(dst + bj * 128, (v0 * cs0 + p0 * sn0 * sgn) * qsc, (v1 * cs1 + p1 * sn1 * sgn) * qsc);
            }
          }
      } else {
#pragma unroll
        for (int ai = 0; ai < 2; ++ai)
#pragma unroll
          for (int m = 0; m < 4; ++m) {
            const int row = row0 + ai * 128 + m * 16, b = row >> 12, t = row & 4095;
            const size_t kr = (size_t)b * LA + NCTX + t;
            if (u.pn >= 12 && u.pn < 14) {
#pragma unroll
              for (int bj = 0; bj < 2; ++bj) {
                const int ch = cg0 + bj * 128 - 3072;
                st8(SA + ((size_t)(ch >> 4) * SA_ROWS + b * 128 + (t >> 5)) * SA_LD + (t & 31) * 16 + (ch & 15), acc[ai][bj][m][0], acc[ai][bj][m][1]);
              }
            } else {
              bf16_t* dst = u.pn < 12 ? V + kr * 1024 + (cg0 - 2048) : G + (size_t)row * 2048 + (cg0 - 3584);
#pragma unroll
              for (int bj = 0; bj < 2; ++bj) {
                f32x4 v0 = acc[ai][bj][m][0], v1 = acc[ai][bj][m][1];
                if (u.pn >= 14) {
#pragma unroll
                  for (int i = 0; i < 4; ++i) { v0[i] = sigmoidf_(v0[i]); v1[i] = sigmoidf_(v1[i]); }
                }
                st8(dst + bj * 128, v0, v1);
              }
            }
          }
      }
    } else {
#pragma unroll
      for (int ai = 0; ai < 2; ++ai)
#pragma unroll
        for (int m = 0; m < 4; ++m) {
          const int rc = row0 + ai * 128 + m * 16 - MX, b = rc >> 8, t = rc & 255;
          const size_t kr = (size_t)b * LA + t;
          if (u.pn >= 12) {
#pragma unroll
            for (int bj = 0; bj < 2; ++bj) {
              const int ch = cg0 + bj * 128 - 3072;
              st8(SA + ((size_t)(ch >> 4) * SA_ROWS + 512 + b * 8 + (t >> 5)) * SA_LD + (t & 31) * 16 + (ch & 15), acc[ai][bj][m][0], acc[ai][bj][m][1]);
            }
          } else {
            bf16_t* dst = u.pn < 8 ? K + kr * 1024 + (cg0 - 1024) : V + kr * 1024 + (cg0 - 2048);
#pragma unroll
            for (int bj = 0; bj < 2; ++bj) st8(dst + bj * 128, acc[ai][bj][m][0], acc[ai][bj][m][1]);
          }
        }
    }
  }
};
template <int MODE>
struct EpiBf8 {
  static constexpr bool PERM = true, AFTER_DRAIN = false;
  bf16_t* O; int ldo; const bf16_t* X; int ldx; const float* bias;
  __device__ __forceinline__ void operator()(const f32x4 (&acc)[2][2][4][2], const Unit& u, int wr, int wc, int fr, int fq) const {
    const int row0 = u.pm * 256 + wr * 64 + fr, col0 = u.pn * 256 + wc * 32 + 8 * fq;
#pragma unroll
    for (int ai = 0; ai < 2; ++ai)
#pragma unroll
      for (int m = 0; m < 4; ++m) {
        const int row = row0 + ai * 128 + m * 16;
#pragma unroll
        for (int bj = 0; bj < 2; ++bj) {
          const int col = col0 + bj * 128;
          f32x4 v0 = acc[ai][bj][m][0], v1 = acc[ai][bj][m][1];
          const u32x4 xw = *(const u32x4*)(X + (size_t)row * ldx + col);
          const f32x4 x0 = {bflo(xw.x), bfhi(xw.x), bflo(xw.y), bfhi(xw.y)}, x1 = {bflo(xw.z), bfhi(xw.z), bflo(xw.w), bfhi(xw.w)};
          if (MODE == 0) {
            const f32x4 b0 = *(const f32x4*)(bias + col), b1 = *(const f32x4*)(bias + col + 4);
#pragma unroll
            for (int i = 0; i < 4; ++i) { v0[i] = x0[i] * sigmoidf_(v0[i] + b0[i]); v1[i] = x1[i] * sigmoidf_(v1[i] + b1[i]); }
          } else if (MODE == 1) { v0 = v0 * x0; v1 = v1 * x1; }
          else {
            const u32x4 ow = *(const u32x4*)(O + (size_t)row * ldo + col);
            const f32x4 o0 = {bflo(ow.x), bfhi(ow.x), bflo(ow.y), bfhi(ow.y)}, o1 = {bflo(ow.z), bfhi(ow.z), bflo(ow.w), bfhi(ow.w)};
            v0 = o0 + v0 * x0; v1 = o1 + v1 * x1;
          }
          u32x4 w; w.x = pg8::cvt_pk_bf16(v0[0], v0[1]); w.y = pg8::cvt_pk_bf16(v0[2], v0[3]); w.z = pg8::cvt_pk_bf16(v1[0], v1[1]); w.w = pg8::cvt_pk_bf16(v1[2], v1[3]);
          *(u32x4*)(O + (size_t)row * ldo + col) = w;
        }
      }
  }
};
template <int MODE>
struct EpiF32 {
  static constexpr bool PERM = false, AFTER_DRAIN = false;
  float* O; const float* xres; const float* mod;
  __device__ __forceinline__ void operator()(const f32x4 (&acc)[2][2][4][2], const Unit& u, int wr, int wc, int fr, int fq) const {
    const int row0 = u.pm * 256 + wr * 64 + fr, col0 = u.pn * 256 + wc * 32 + 4 * fq;
#pragma unroll
    for (int ai = 0; ai < 2; ++ai)
#pragma unroll
      for (int m = 0; m < 4; ++m) {
        const int row = row0 + ai * 128 + m * 16;
#pragma unroll
        for (int bj = 0; bj < 2; ++bj)
#pragma unroll
          for (int n = 0; n < 2; ++n) {
            const int col = col0 + bj * 128 + n * 16;
            f32x4 v = acc[ai][bj][m][n];
            if (MODE == 1) { const f32x4 xr = *(const f32x4*)(xres + (size_t)row * 1024 + col); const f32x4 g = *(const f32x4*)(mod + (row >> 12) * 6144 + 2048 + col); v = xr + g * v; }
            *(f32x4*)(O + (size_t)row * 1024 + col) = v;
          }
      }
  }
};


struct GroupSched {
  int npm, npn, nunits, G, c; long gsA, gsB, tsA, tsB;
  __device__ __forceinline__ void init(int ngrp, int npm_, int npn_, long gsA_, long tsA_, long gsB_, long tsB_, int G_, int c_) { npm = npm_; npn = npn_; nunits = ngrp * npm_ * npn_; gsA = gsA_; tsA = tsA_; gsB = gsB_; tsB = tsB_; G = G_; c = c_; }
  __device__ __forceinline__ bool next(int i, Unit& u) const {
    const long Lx = (long)i * G + c; if (Lx >= nunits) return false;
    const int per = npm * npn, grp = (int)Lx / per, r = (int)Lx % per;
    u.grp = grp; u.pm = r / npn; u.pn = r % npn; u.ao = grp * gsA + u.pm * tsA; u.bo = grp * gsB + u.pn * tsB; return true;
  }
  __device__ __forceinline__ void a_ready(const Unit&) const {}
  __device__ __forceinline__ void done(const Unit&) const {}
};
struct EpiS {
  static constexpr bool PERM = false, AFTER_DRAIN = false;
  float* S;
  __device__ __forceinline__ void operator()(const f32x4 (&acc)[2][2][4][2], const Unit& u, int wr, int wc, int fr, int fq) const {
    const int row0 = u.pm * 256 + wr * 64 + fr, col0 = wc * 32 + 4 * fq;
#pragma unroll
    for (int ai = 0; ai < 2; ++ai)
#pragma unroll
      for (int m = 0; m < 4; ++m) {
        const int row = row0 + ai * 128 + m * 16;
        if (row < SA_ROWS) {
#pragma unroll
          for (int bj = 0; bj < 2; ++bj)
#pragma unroll
            for (int n = 0; n < 2; ++n) *(f32x4*)(S + ((size_t)u.grp * SA_ROWS + row) * 256 + col0 + bj * 128 + n * 16) = acc[ai][bj][m][n];
        }
      }
  }
};
struct EpiY {
  static constexpr bool PERM = true, AFTER_DRAIN = false;
  bf16_t* YG;
  __device__ __forceinline__ void operator()(const f32x4 (&acc)[2][2][4][2], const Unit& u, int wr, int wc, int fr, int fq) const {
    const int row0 = u.pm * 256 + wr * 64 + fr, col0 = u.pn * 256 + wc * 32 + 8 * fq;
#pragma unroll
    for (int ai = 0; ai < 2; ++ai)
#pragma unroll
      for (int m = 0; m < 4; ++m) {
        const int row = row0 + ai * 128 + m * 16, b = row >> 7, cx = row & 127;
#pragma unroll
        for (int bj = 0; bj < 2; ++bj) {
          const int col = col0 + bj * 128, j = col >> 4, p0 = col & 15;
          const f32x4 v0 = acc[ai][bj][m][0], v1 = acc[ai][bj][m][1];
          u32x4 w; w.x = pg8::cvt_pk_bf16(gelu_tanh(v0[0]), gelu_tanh(v0[1])); w.y = pg8::cvt_pk_bf16(gelu_tanh(v0[2]), gelu_tanh(v0[3]));
          w.z = pg8::cvt_pk_bf16(gelu_tanh(v1[0]), gelu_tanh(v1[1])); w.w = pg8::cvt_pk_bf16(gelu_tanh(v1[2]), gelu_tanh(v1[3]));
          *(u32x4*)(YG + ((size_t)(b * L + cx * 32 + j)) * 512 + u.grp * 16 + p0) = w;
        }
      }
  }
};


__device__ __forceinline__ unsigned f2key(float s) { const unsigned u = __float_as_uint(s); return u ^ ((u & 0x80000000u) ? 0xFFFFFFFFu : 0x80000000u); }
__device__ __forceinline__ float key2f(unsigned k) { return __uint_as_float(k ^ ((k & 0x80000000u) ? 0x80000000u : 0xFFFFFFFFu)); }
#define TK_INSERT(L, cv) do { _Pragma("unroll") for (int k_ = 0; k_ < 16; ++k_) { const unsigned hi_ = L[k_] > cv ? L[k_] : cv, lo_ = L[k_] > cv ? cv : L[k_]; L[k_] = hi_; cv = lo_; } } while (0)
#define TK_CX(X, Y) do { const unsigned hi_ = (X) > (Y) ? (X) : (Y), lo_ = (X) > (Y) ? (Y) : (X); (X) = hi_; (Y) = lo_; } while (0)
#define TK_SORT16(A, B) do { _Pragma("unroll") for (int k_ = 2; k_ <= 16; k_ <<= 1) _Pragma("unroll") for (int j_ = k_ >> 1; j_ > 0; j_ >>= 1) _Pragma("unroll") for (int i_ = 0; i_ < 16; ++i_) { \
    const int l_ = i_ ^ j_; if (l_ > i_) { if ((i_ & k_) == 0) TK_CX(A[(B) + i_], A[(B) + l_]); else TK_CX(A[(B) + l_], A[(B) + i_]); } } } while (0)
#define TK_MERGE16(A, P, Q) do { _Pragma("unroll") for (int i_ = 0; i_ < 16; ++i_) A[(P) + i_] = A[(P) + i_] > A[(Q) + 15 - i_] ? A[(P) + i_] : A[(Q) + 15 - i_]; \
    _Pragma("unroll") for (int j_ = 8; j_ > 0; j_ >>= 1) _Pragma("unroll") for (int i_ = 0; i_ < 16; ++i_) { const int l_ = i_ ^ j_; if (l_ > i_) TK_CX(A[(P) + i_], A[(P) + l_]); } } while (0)
struct EpiTopK {
  static constexpr bool PERM = false, AFTER_DRAIN = true;
  unsigned short* IDX; float* GATE;
  __device__ __forceinline__ void fused(f32x4 (&acc)[2][2][4][2], const Unit& u, int wr, int wc, int fr, int fq, PG8_LAS unsigned char* lds, int wid, int lane) const {
    PG8_LAS float* SC = (PG8_LAS float*)lds;
    const int tid = wid * 64 + lane;
#pragma unroll
    for (int ai = 0; ai < 2; ++ai) {
#pragma unroll
      for (int m = 0; m < 4; ++m)
#pragma unroll
        for (int bj = 0; bj < 2; ++bj)
#pragma unroll
          for (int n = 0; n < 2; ++n)
#pragma unroll
            for (int i = 0; i < 4; ++i) SC[(64 * wr + 16 * m + fr) * 257 + 128 * bj + 32 * wc + 16 * n + 4 * fq + i] = acc[ai][bj][m][n][i];
      asm volatile("s_waitcnt lgkmcnt(0)" ::: "memory"); __builtin_amdgcn_s_barrier(); asm volatile("" ::: "memory");
      {
        const int hf = tid >> 8;
        PG8_LAS float* rowp = SC + (tid & 127) * 257 + ((tid >> 7) & 1) * 128 + hf * 64;
        unsigned a[48];
#pragma unroll
        for (int k = 0; k < 32; ++k) a[k] = (f2key(rowp[k]) & ~0x7Fu) | (unsigned)(127 - (hf * 64 + k));
        TK_SORT16(a, 0); TK_SORT16(a, 16); TK_MERGE16(a, 0, 16);
#pragma unroll
        for (int k = 0; k < 32; ++k) a[16 + k] = (f2key(rowp[32 + k]) & ~0x7Fu) | (unsigned)(127 - (hf * 64 + 32 + k));
        TK_SORT16(a, 16); TK_SORT16(a, 32); TK_MERGE16(a, 16, 32); TK_MERGE16(a, 0, 16);
#pragma unroll
        for (int k = 0; k < 16; ++k) rowp[k] = __uint_as_float(a[k]);
      }
      asm volatile("s_waitcnt lgkmcnt(0)" ::: "memory"); __builtin_amdgcn_s_barrier(); asm volatile("" ::: "memory");
      if (tid < 256) {
        PG8_LAS float* rowp = SC + (tid & 127) * 257 + (tid >> 7) * 128;
        unsigned a[32];
#pragma unroll
        for (int k = 0; k < 16; ++k) { a[k] = __float_as_uint(rowp[k]); a[16 + k] = __float_as_uint(rowp[64 + k]); }
        TK_MERGE16(a, 0, 16);
#pragma unroll
        for (int k = 0; k < 16; ++k) rowp[k] = __uint_as_float(a[k]);
      }
      asm volatile("s_waitcnt lgkmcnt(0)" ::: "memory"); __builtin_amdgcn_s_barrier(); asm volatile("" ::: "memory");
      if (tid < 128) {
        PG8_LAS float* rowp = SC + tid * 257;
        float v1[16], v2[16];
#pragma unroll
        for (int k = 0; k < 16; ++k) { v1[k] = key2f(__float_as_uint(rowp[k]) & ~0x7Fu); v2[k] = key2f(__float_as_uint(rowp[128 + k]) & ~0x7Fu); }
#define TK_CAND(a, b) ((f2key(v1[a] + v2[b]) & ~0xFFu) | (unsigned)(255 - ((a) * 16 + (b))))
        unsigned Lc[48];
#pragma unroll
        for (int k = 0; k < 16; ++k) { Lc[k] = TK_CAND(0, k); Lc[16 + k] = k < 15 ? TK_CAND(k + 1, 0) : 0u; }
        { int n_ = 0; unsigned ex_[3];
#pragma unroll
          for (int a = 1; a < 8; ++a)
#pragma unroll
            for (int b = 1; b < 8; ++b)
              if ((a + 1) * (b + 1) <= 16) { const unsigned cv = TK_CAND(a, b); if (n_ < 16) Lc[32 + n_] = cv; else ex_[n_ - 16] = cv; ++n_; }
          TK_MERGE16(Lc, 0, 16); TK_SORT16(Lc, 32); TK_MERGE16(Lc, 0, 32);
#pragma unroll
          for (int k = 0; k < 3; ++k) { unsigned cv = ex_[k]; TK_INSERT(Lc, cv); } }
#undef TK_CAND
        float ev[16]; float den = 0.f; const float mx = key2f(Lc[0] & ~0xFFu);
#pragma unroll
        for (int k = 0; k < 16; ++k) { ev[k] = __expf(key2f(Lc[k] & ~0xFFu) - mx); den += ev[k]; }
        const float inv = 1.f / den;
        const size_t o = ((size_t)(u.pm * 256 + ai * 128 + tid) * 8 + u.pn) * 16;
        unsigned iw[8];
#pragma unroll
        for (int k = 0; k < 16; ++k) {
          const int code = 255 - (int)(Lc[k] & 0xFFu), a = code >> 4, b = code & 15;
          const unsigned e1 = 127u - (__float_as_uint(rowp[a]) & 0x7Fu), e2 = 127u - (__float_as_uint(rowp[128 + b]) & 0x7Fu);
          const unsigned ex = e1 * 128u + e2;
          if (k & 1) iw[k >> 1] |= ex << 16; else iw[k >> 1] = ex;
        }
        *(u32x4*)(IDX + o) = (u32x4){iw[0], iw[1], iw[2], iw[3]}; *(u32x4*)(IDX + o + 8) = (u32x4){iw[4], iw[5], iw[6], iw[7]};
#pragma unroll
        for (int k = 0; k < 16; k += 4) *(f32x4*)(GATE + o + k) = (f32x4){ev[k] * inv, ev[k + 1] * inv, ev[k + 2] * inv, ev[k + 3] * inv};
      }
      asm volatile("s_waitcnt lgkmcnt(0)" ::: "memory"); __builtin_amdgcn_s_barrier(); asm volatile("" ::: "memory");
    }
  }
};
struct OneUnitSched {
  int nM, nN, G, c, round; long tsA, tsB;
  __device__ __forceinline__ bool next(int i, Unit& u) const {
    if (i > 0) return false;
    const long Lx = (long)round * G + c; if (Lx >= (long)nM * nN) return false;
    u.pm = (int)(Lx % nM); u.pn = (int)(Lx / nM); u.grp = 0; u.ao = u.pm * tsA; u.bo = u.pn * tsB; return true;
  }
  __device__ __forceinline__ void a_ready(const Unit&) const {}
  __device__ __forceinline__ void done(const Unit&) const {}
};

__device__ __forceinline__ void transpose_item64(const float* W, int K, int N, bf16_t* WT, float* scr, int item, int lane) {
  const int nblk = N / 64, kb = item / nblk, nb = item % nblk, k0 = 64 * kb, n0 = 64 * nb;
  f32x4 v[16];
#pragma unroll
  for (int i = 0; i < 16; ++i) v[i] = *(const f32x4*)(W + (size_t)(k0 + 4 * i + (lane >> 4)) * N + n0 + (lane & 15) * 4);
#pragma unroll
  for (int i = 0; i < 16; ++i) { float* d = scr + (4 * i + (lane >> 4)) * 65 + (lane & 15) * 4; d[0] = v[i][0]; d[1] = v[i][1]; d[2] = v[i][2]; d[3] = v[i][3]; }
  asm volatile("s_waitcnt lgkmcnt(0)" ::: "memory");
  const int c = lane & 7;
#pragma unroll
  for (int j = 0; j < 8; ++j) {
    const int n = (lane >> 3) + 8 * j; const float* s = scr + (8 * c) * 65 + n;
    u32x4 o; o.x = pg8::cvt_pk_bf16(s[0], s[65]); o.y = pg8::cvt_pk_bf16(s[130], s[195]); o.z = pg8::cvt_pk_bf16(s[260], s[325]); o.w = pg8::cvt_pk_bf16(s[390], s[455]);
    *(u32x4*)(WT + (size_t)(n0 + n) * K + k0 + 8 * c) = o;
  }
  asm volatile("s_waitcnt lgkmcnt(0)" ::: "memory");
}
__device__ __forceinline__ void transpose_item(const float* W, int K, int N, bf16_t* WT, float* scr, int item, int lane) {
  const int nblk = N / 32, kb = item / nblk, nb = item % nblk, k0 = 64 * kb, n0 = 32 * nb;
#pragma unroll 8
  for (int i = 0; i < 32; ++i) { const int kk = 2 * i + (lane >> 5); scr[kk * 33 + (lane & 31)] = W[(size_t)(k0 + kk) * N + n0 + (lane & 31)]; }
  asm volatile("s_waitcnt lgkmcnt(0)" ::: "memory");
  const int c = lane & 7;
#pragma unroll
  for (int j = 0; j < 4; ++j) {
    const int n = (lane >> 3) + 8 * j; const float* s = scr + (8 * c) * 33 + n;
    u32x4 o; o.x = pg8::cvt_pk_bf16(s[0], s[33]); o.y = pg8::cvt_pk_bf16(s[66], s[99]); o.z = pg8::cvt_pk_bf16(s[132], s[165]); o.w = pg8::cvt_pk_bf16(s[198], s[231]);
    *(u32x4*)(WT + (size_t)(n0 + n) * K + k0 + 8 * c) = o;
  }
  asm volatile("s_waitcnt lgkmcnt(0)" ::: "memory");
}

namespace att {
using bf16 = unsigned short;
constexpr int   D = 128, NW = 8, QBLK = 32, KVBLK = 64, SDEPTH = 1;
constexpr float SCALE = 0.125f;
constexpr float THR = 8.f;
constexpr int LDQ = 1024, LDK = 1024, LDO = 1024;
constexpr size_t SHM_V = KVBLK * D * 2, SHM_K = KVBLK * D * 2, SHM_ATTN = 2 * SHM_V + 2 * SHM_K + NW * 64 * 4 + 4 * 4 * 16 * 64 * 4;
using bf16x8 = __attribute__((ext_vector_type(8))) short;
using s16x4  = __attribute__((ext_vector_type(4))) short;
using f32x16 = __attribute__((ext_vector_type(16))) float;
using f32x8  = __attribute__((ext_vector_type(8))) float;
using u32x4  = __attribute__((ext_vector_type(4))) unsigned;
#define KSWZ(row, colB) ((row) * 256 + ((colB) ^ (((row) & 15) << 4)))
#define SBAR() __builtin_amdgcn_sched_barrier(0)
__device__ __forceinline__ int crow(int r, int hi) { return (r & 3) + 8 * (r >> 2) + 4 * hi; }
__device__ __forceinline__ unsigned cvtpk(float lo, float hi) {
  unsigned r; asm volatile("v_cvt_pk_bf16_f32 %0, %1, %2" : "=v"(r) : "v"(lo), "v"(hi)); return r;
}
template <typename TIn> struct Stage;
template <> struct Stage<bf16>  { using T = bf16x8;
  __device__ static __forceinline__ T ld8(const bf16* p) { return *(const __attribute__((address_space(1))) bf16x8*)(p); }
  __device__ static __forceinline__ bf16x8 tobf(T x) { return x; } };
constexpr float THR2 = 11.5f;
template <bool FIRST>
__device__ __forceinline__ void partialSM(f32x16& p0, f32x16& p1, float& mhat, f32x16& negm, float& alpha) {
  float pmax = p0[0]; for (int r = 1; r < 16; ++r) pmax = fmaxf(pmax, p0[r]); for (int r = 0; r < 16; ++r) pmax = fmaxf(pmax, p1[r]);
  { auto rr = __builtin_amdgcn_permlane32_swap(__float_as_uint(pmax), __float_as_uint(pmax), false, false);
    pmax = fmaxf(__uint_as_float(rr[0]), __uint_as_float(rr[1])); }
  alpha = 1.f;
  if (FIRST || !__builtin_expect(__all(pmax <= THR2), 1)) {
    const float dl = FIRST ? pmax : fmaxf(pmax, 0.f);
    mhat += dl;
    for (int r = 0; r < 16; ++r) { p0[r] -= dl; p1[r] -= dl; }
    for (int r = 0; r < 16; ++r) negm[r] = -mhat;
    if (!FIRST) alpha = __builtin_amdgcn_exp2f(-dl);
  }
  for (int r = 0; r < 16; ++r) p0[r] = __builtin_amdgcn_exp2f(p0[r]);
}
__device__ __forceinline__ void finishSM(f32x16& p0, f32x16& p1, float alpha, float& l_reg, bf16x8& pa0, bf16x8& pa1, bf16x8& pa2, bf16x8& pa3) {
  for (int r = 0; r < 16; ++r) p1[r] = __builtin_amdgcn_exp2f(p1[r]);
  float ps = 0; for (int r = 0; r < 16; ++r) ps += p0[r]; for (int r = 0; r < 16; ++r) ps += p1[r];
  { auto rr = __builtin_amdgcn_permlane32_swap(__float_as_uint(ps), __float_as_uint(ps), false, false);
    ps = __uint_as_float(rr[0]) + __uint_as_float(rr[1]); }
  l_reg = l_reg * alpha + ps;
#define PK4(P, BASE, OUT) do { unsigned a0 = cvtpk(P[BASE + 0], P[BASE + 1]), a1 = cvtpk(P[BASE + 2], P[BASE + 3]);   \
    unsigned b0 = cvtpk(P[BASE + 4], P[BASE + 5]), b1 = cvtpk(P[BASE + 6], P[BASE + 7]);                              \
    auto r0 = __builtin_amdgcn_permlane32_swap(a0, b0, false, false); auto r1 = __builtin_amdgcn_permlane32_swap(a1, b1, false, false); \
    u32x4 w = {r0[0], r1[0], r0[1], r1[1]}; OUT = *reinterpret_cast<bf16x8*>(&w); } while (0)
  PK4(p0, 0, pa0); PK4(p0, 8, pa1); PK4(p1, 0, pa2); PK4(p1, 8, pa3);
#undef PK4
}
typedef __attribute__((address_space(3))) const char* lds_cptr_t;
__device__ __forceinline__ void qkt(f32x16& p0, f32x16& p1, const bf16* Ks, const char* qfl_, int r32, int hi, int mcolB, const f32x16& negm) {
  unsigned qoff = (unsigned)(uintptr_t)qfl_;
  asm volatile("" : "+v"(qoff));
  const lds_cptr_t qfl = (lds_cptr_t)qoff;
  bf16x8 qr[4];
#pragma unroll
  for (int d0 = 0; d0 < 4; ++d0) qr[d0] = *(const __attribute__((address_space(3))) bf16x8*)(qfl + d0 * 1024);
#pragma unroll
  for (int d0 = 0; d0 < 4; ++d0) { int cb = mcolB + (d0 * 16 + hi * 8) * 2;
    bf16x8 b0 = *reinterpret_cast<const bf16x8*>((const char*)Ks + KSWZ(r32, cb));
    bf16x8 b1 = *reinterpret_cast<const bf16x8*>((const char*)Ks + KSWZ(32 + r32, cb));
    if (d0 == 0) { p0 = __builtin_amdgcn_mfma_f32_32x32x16_bf16(b0, qr[0], negm, 0, 0, 0); p1 = __builtin_amdgcn_mfma_f32_32x32x16_bf16(b1, qr[0], negm, 0, 0, 0); }
    else { p0 = __builtin_amdgcn_mfma_f32_32x32x16_bf16(b0, qr[d0], p0, 0, 0, 0); p1 = __builtin_amdgcn_mfma_f32_32x32x16_bf16(b1, qr[d0], p1, 0, 0, 0); } }
}
__device__ __forceinline__ int v_st(int k, int c) { const int kk = (k & ~0xC) | ((k & 4) << 1) | ((k & 8) >> 1); return ((kk >> 3) * 4 + (c >> 5)) * 512 + ((kk & 7) * 32 + (c & 31)) * 2; }
__device__ __forceinline__ int v_rd_base(int lane) { return ((lane & 3) << 3) | (((lane >> 2) & 3) << 6) | (((lane >> 4) & 1) << 5) | (((lane >> 5) & 1) << 8); }
constexpr int v_rd_off(int d0, int ks, int half) { return d0 * 512 + ks * 4096 + half * 2048; }
template <int OFF> __device__ __forceinline__ s16x4 tr_read(int vb) {
  s16x4 r; asm volatile("ds_read_b64_tr_b16 %0, %1 offset:%2" : "=&v"(r) : "v"(vb), "i"(OFF) : "memory"); return r;
}
template <int D0> __device__ __forceinline__ void pv_one(f32x16& od, int vb, bf16x8 pa0, bf16x8 pa1, bf16x8 pa2, bf16x8 pa3) {
  const s16x4 l0 = tr_read<v_rd_off(D0, 0, 0)>(vb), h0 = tr_read<v_rd_off(D0, 0, 1)>(vb), l1 = tr_read<v_rd_off(D0, 1, 0)>(vb), h1 = tr_read<v_rd_off(D0, 1, 1)>(vb);
  const s16x4 l2 = tr_read<v_rd_off(D0, 2, 0)>(vb), h2 = tr_read<v_rd_off(D0, 2, 1)>(vb), l3 = tr_read<v_rd_off(D0, 3, 0)>(vb), h3 = tr_read<v_rd_off(D0, 3, 1)>(vb);
  asm volatile("s_waitcnt lgkmcnt(0)" ::: "memory"); SBAR();
#define PK(L, H) (bf16x8){L[0], L[1], L[2], L[3], H[0], H[1], H[2], H[3]}
  od = __builtin_amdgcn_mfma_f32_32x32x16_bf16(pa0, PK(l0, h0), od, 0, 0, 0);
  od = __builtin_amdgcn_mfma_f32_32x32x16_bf16(pa1, PK(l1, h1), od, 0, 0, 0);
  od = __builtin_amdgcn_mfma_f32_32x32x16_bf16(pa2, PK(l2, h2), od, 0, 0, 0);
  od = __builtin_amdgcn_mfma_f32_32x32x16_bf16(pa3, PK(l3, h3), od, 0, 0, 0);
#undef PK
}
__device__ __forceinline__ void pv_d0(f32x16* o, int vb, bf16x8 pa0, bf16x8 pa1, bf16x8 pa2, bf16x8 pa3) {
  pv_one<0>(o[0], vb, pa0, pa1, pa2, pa3); pv_one<1>(o[1], vb, pa0, pa1, pa2, pa3); pv_one<2>(o[2], vb, pa0, pa1, pa2, pa3); pv_one<3>(o[3], vb, pa0, pa1, pa2, pa3);
}

__device__ __forceinline__ void diff_attn_unit(const bf16* __restrict__ Qb, const bf16* __restrict__ Kh, const bf16* __restrict__ Vh,
                                               bf16* __restrict__ Ob, int seq, float lam, const float* __restrict__ subln, char* lds) {
  using St = Stage<bf16>;
  int tid_ = threadIdx.x; asm volatile("" : "+v"(tid_));
  const int tid = tid_, wid = __builtin_amdgcn_readfirstlane(tid >> 6), lane = tid & 63, r32 = lane & 31, hi = lane >> 5;
  bf16* V_lds = (bf16*)lds; bf16* K_lds = (bf16*)(lds + 3 * SHM_V);
  float* ws = (float*)(lds + 3 * SHM_V + 3 * SHM_K) + wid * 64; float* li_l = ws; float* al_l = ws + 32;
  float m_reg = 0.f, l_reg = 0; f32x16 o[4] = {}; f32x16 negm = {};
  const int mw = wid >> 2, wq = wid & 3, mcolB = mw * 128;
  const bf16* Qw = Qb + (long)(wq * QBLK + r32) * LDQ + mw * 64 + hi * 8;
  char* qr = lds + 3 * SHM_V + 3 * SHM_K + NW * 64 * 4 + wid * 4096 + lane * 16;
#pragma unroll
  for (int d0 = 0; d0 < 4; ++d0) *reinterpret_cast<bf16x8*>(qr + d0 * 1024) = St::ld8(Qw + d0 * 16);
  const int vb0 = (int)(uintptr_t)V_lds + v_rd_base(lane);
  const int widu = wid;
  unsigned kof0, kof1, vof0, vof1;
  { const int r0 = 8 * widu + (lane >> 4), r1 = r0 + 4;
    kof0 = (unsigned)(r0 * LDK * 2 + ((((lane & 15) << 4)) ^ ((r0 & 15) << 4))); kof1 = (unsigned)(r1 * LDK * 2 + ((((lane & 15) << 4)) ^ ((r1 & 15) << 4)));
    const int kk = widu * 8 + ((lane & 31) >> 2), kx = (kk & ~0xC) | ((kk & 4) << 1) | ((kk & 8) >> 1);
    vof0 = (unsigned)(kx * LDK * 2 + (((lane >> 5)) * 32 + (lane & 3) * 8) * 2); vof1 = (unsigned)(kx * LDK * 2 + ((2 + (lane >> 5)) * 32 + (lane & 3) * 8) * 2); }
  typedef __attribute__((address_space(3))) unsigned lds_u32_t; typedef const __attribute__((address_space(1))) char g_cchar_t;
  lds_u32_t* const kdst = (lds_u32_t*)((__attribute__((address_space(3))) char*)K_lds + widu * 2048); lds_u32_t* const vdst = (lds_u32_t*)((__attribute__((address_space(3))) char*)V_lds + widu * 2048);
#define GLDS(g, off, dst) __builtin_amdgcn_global_load_lds((const __attribute__((address_space(1))) unsigned*)((g) + (off)), (dst), 16, 0, 0)
#define DMA_TILE(k0, slot) do { g_cchar_t* gk_ = (g_cchar_t*)Kh + (size_t)(k0) * LDK * 2; g_cchar_t* gv_ = (g_cchar_t*)Vh + (size_t)(k0) * LDK * 2; \
    GLDS(gk_, kof0, kdst + ((slot) * (int)SHM_K) / 4); GLDS(gk_, kof1, kdst + ((slot) * (int)SHM_K + 1024) / 4); \
    GLDS(gv_, vof0, vdst + ((slot) * (int)SHM_V) / 4); GLDS(gv_, vof1, vdst + ((slot) * (int)SHM_V + 1024) / 4); } while (0)
#define DMA_WAIT_BAR() do { asm volatile("s_waitcnt vmcnt(0)" ::: "memory"); __syncthreads(); } while (0)
#define RESC(a) do { if (__any((a) < 1.f)) { if (hi == 0) al_l[r32] = (a); asm volatile("s_waitcnt lgkmcnt(0)" ::: "memory"); \
    for (int d = 0; d < 4; ++d) for (int r = 0; r < 16; ++r) o[d][r] *= al_l[crow(r, hi)]; } } while (0)
#define ATT_STEP(PC0, PC1, ALC, PP0, PP1, ALP, CUR, PREV, NEXT, JJ) do { \
    SBAR(); qkt(PC0, PC1, (bf16*)((char*)K_lds + (CUR) * SHM_K), qr, r32, hi, mcolB, negm); \
    finishSM(PP0, PP1, ALP, l_reg, pa0, pa1, pa2, pa3); SBAR(); \
    DMA_TILE(((JJ) + 1) * KVBLK, NEXT); SBAR(); \
    pv_d0(o, vb0 + (PREV) * (int)SHM_V, pa0, pa1, pa2, pa3); partialSM<false>(PC0, PC1, m_reg, negm, ALC); \
    RESC(ALC); DMA_WAIT_BAR(); } while (0)
  f32x16 pA0, pA1, pB0, pB1; float alA, alB; bf16x8 pa0, pa1, pa2, pa3; const int NT = seq / KVBLK;
  DMA_TILE(0, 0); DMA_TILE(KVBLK, 1); DMA_WAIT_BAR();
  qkt(pA0, pA1, K_lds, qr, r32, hi, mcolB, negm); partialSM<true>(pA0, pA1, m_reg, negm, alA);
  for (int j = 1; j + 1 < NT; j += 6) {
    ATT_STEP(pB0, pB1, alB, pA0, pA1, alA, 1, 0, 2, j);
    ATT_STEP(pA0, pA1, alA, pB0, pB1, alB, 2, 1, 0, j + 1);
    ATT_STEP(pB0, pB1, alB, pA0, pA1, alA, 0, 2, 1, j + 2);
    ATT_STEP(pA0, pA1, alA, pB0, pB1, alB, 1, 0, 2, j + 3);
    ATT_STEP(pB0, pB1, alB, pA0, pA1, alA, 2, 1, 0, j + 4);
    ATT_STEP(pA0, pA1, alA, pB0, pB1, alB, 0, 2, 1, j + 5);
  }
  SBAR(); qkt(pB0, pB1, (bf16*)((char*)K_lds + SHM_K), qr, r32, hi, mcolB, negm);
  finishSM(pA0, pA1, alA, l_reg, pa0, pa1, pa2, pa3); SBAR();
  pv_d0(o, vb0, pa0, pa1, pa2, pa3); partialSM<false>(pB0, pB1, m_reg, negm, alB);
  RESC(alB);
  finishSM(pB0, pB1, alB, l_reg, pa0, pa1, pa2, pa3); SBAR();
  pv_d0(o, vb0 + (int)SHM_V, pa0, pa1, pa2, pa3);
  __syncthreads();
  if (hi == 0) li_l[r32] = l_reg; asm volatile("s_waitcnt lgkmcnt(0)" ::: "memory");
  float rli[16];
#pragma unroll
  for (int r = 0; r < 16; ++r) rli[r] = __builtin_amdgcn_rcpf(li_l[crow(r, hi)]);
  float* EXO = (float*)lds + wq * (4 * 16 * 64) + lane;
  if (mw == 1) {
#pragma unroll
    for (int d0 = 0; d0 < 4; ++d0)
#pragma unroll
      for (int r = 0; r < 16; ++r) EXO[(d0 * 16 + r) * 64] = o[d0][r] * rli[r];
  }
  __syncthreads();
  if (mw == 0) {
    float ssq[16];
#pragma unroll
    for (int r = 0; r < 16; ++r) ssq[r] = 0.f;
#pragma unroll
    for (int d0 = 0; d0 < 4; ++d0)
#pragma unroll
      for (int r = 0; r < 16; ++r) { const float dv = o[d0][r] * rli[r] - lam * EXO[(d0 * 16 + r) * 64]; o[d0][r] = dv; ssq[r] += dv * dv; }
#pragma unroll
    for (int r = 0; r < 16; ++r) {
#pragma unroll
      for (int sft = 1; sft < 32; sft <<= 1) ssq[r] += __shfl_xor(ssq[r], sft);
      ssq[r] = rsqrtf(ssq[r] * (1.f / 128.f) + 1e-6f) * 0.8f;
    }
    bf16* stg = (bf16*)(lds + 65536 + wq * 8192);
#pragma unroll
    for (int d0 = 0; d0 < 4; ++d0) { const float gg = subln[d0 * 32 + r32];
#pragma unroll
      for (int r = 0; r < 16; ++r) { const float val = o[d0][r] * ssq[r] * gg; stg[crow(r, hi) * 128 + d0 * 32 + r32] = (bf16)(pg8::cvt_pk_bf16(val, val) & 0xffffu); } }
    asm volatile("s_waitcnt lgkmcnt(0)" ::: "memory");
    bf16* Ow = Ob + (long)(wq * QBLK) * LDO;
#pragma unroll
    for (int i = 0; i < 8; ++i) { const int row = i * 4 + (lane >> 4), ch = lane & 15;
      const u32x4 v = *(const u32x4*)(stg + row * 128 + ch * 8);
      *(__attribute__((address_space(1))) u32x4*)(Ow + (long)row * LDO + ch * 8) = v; }
  }
  __syncthreads();
#undef GLDS
#undef DMA_TILE
#undef DMA_WAIT_BAR
#undef RESC
#undef ATT_STEP
}
}


typedef __bf16 bf16x2_t __attribute__((ext_vector_type(2)));
__device__ __forceinline__ float dot2bf(unsigned a, unsigned b, float acc) { return __builtin_amdgcn_fdot2_f32_bf16(__builtin_bit_cast(bf16x2_t, a), __builtin_bit_cast(bf16x2_t, b), acc, false); }
template <int CTRL> __device__ __forceinline__ float dpp_add(float v) { return v + __builtin_bit_cast(float, __builtin_amdgcn_update_dpp(0, __builtin_bit_cast(int, v), CTRL, 0xf, 0xf, true)); }
__device__ __forceinline__ float row16_sum(float v) {
  v = dpp_add<0xB1>(v); v = dpp_add<0x4E>(v); v = dpp_add<0x141>(v); v = dpp_add<0x140>(v); return v;
}

typedef unsigned u32x2_t __attribute__((ext_vector_type(2)));
typedef float f32x2_t __attribute__((ext_vector_type(2)));
__device__ __forceinline__ void slice_table_fp8(const float* T, unsigned char* T8, float scale, int gtid, int gsz) {
  for (int it0 = gtid; it0 < 16384 * 128; it0 += 4 * gsz) {
    f32x4 a[4], b[4];
#pragma unroll
    for (int q = 0; q < 4; ++q) { const int it = it0 + q * gsz; if (it < 16384 * 128) { const int e = it >> 7, c8 = (it & 127) * 8; a[q] = *(const f32x4*)(T + (size_t)e * 1024 + c8); b[q] = *(const f32x4*)(T + (size_t)e * 1024 + c8 + 4); } }
#pragma unroll
    for (int q = 0; q < 4; ++q) { const int it = it0 + q * gsz; if (it < 16384 * 128) {
      const int e = it >> 7, c8 = (it & 127) * 8, j = c8 >> 7, c = c8 & 127; const f32x4 as = a[q] * scale, bs = b[q] * scale;
      int w0 = __builtin_amdgcn_cvt_pk_fp8_f32(as[0], as[1], 0, false); w0 = __builtin_amdgcn_cvt_pk_fp8_f32(as[2], as[3], w0, true);
      int w1 = __builtin_amdgcn_cvt_pk_fp8_f32(bs[0], bs[1], 0, false); w1 = __builtin_amdgcn_cvt_pk_fp8_f32(bs[2], bs[3], w1, true);
      *(u32x2_t*)(T8 + ((size_t)j * 16384 + e) * 128 + c) = (u32x2_t){(unsigned)w0, (unsigned)w1}; } }
  }
}
__device__ __forceinline__ void slice_table(const float* T, bf16_t* T8, int gtid, int gsz) {
  for (int it = gtid; it < 16384 * 128; it += gsz) {
    const int e = it >> 7, c8 = (it & 127) * 8, j = c8 >> 7, c = c8 & 127;
    const f32x4 a = *(const f32x4*)(T + (size_t)e * 1024 + c8), b = *(const f32x4*)(T + (size_t)e * 1024 + c8 + 4);
    u32x4 w; w.x = pg8::cvt_pk_bf16(a[0], a[1]); w.y = pg8::cvt_pk_bf16(a[2], a[3]); w.z = pg8::cvt_pk_bf16(b[0], b[1]); w.w = pg8::cvt_pk_bf16(b[2], b[3]);
    *(u32x4*)(T8 + ((size_t)j * 16384 + e) * 128 + c) = w;
  }
}

#define LAS __attribute__((address_space(3)))
#define XB_TMO      128
#define XB_XCNT(j)  (256  + 64 * (j))
#define XB_XSUB(j)  (1280 + 64 * (j))
#define XB_XGEN(j)  (2304 + 64 * (j))
#define XB_TOP      3328
#define XB_TOPGEN   3392
#define XCD_BAR_WORDS 3456
#define XB_SPIN_CAP (1u << 18)

__device__ __forceinline__ unsigned xb_ld(unsigned* p)              { return __hip_atomic_load(p, __ATOMIC_RELAXED, __HIP_MEMORY_SCOPE_AGENT); }
__device__ __forceinline__ unsigned xb_add(unsigned* p, unsigned v) { return __hip_atomic_fetch_add(p, v, __ATOMIC_RELAXED, __HIP_MEMORY_SCOPE_AGENT); }
__device__ __forceinline__ unsigned xb_xcc_id() { return (unsigned)__builtin_amdgcn_s_getreg((3 << 11) | 20) & 0xFu; }
#define XB_SPIN(cond, bar) do { unsigned _sp = 0; while (cond) { __builtin_amdgcn_s_sleep(1); \
    if ((++_sp & 255u) == 0u) { if (xb_ld(&(bar)[XB_TMO])) break; if (_sp > XB_SPIN_CAP) { atomicAdd(&(bar)[XB_TMO], 1u); break; } } } } while (0)

struct XcdBarrier {
    unsigned* bar; unsigned x;
    volatile LAS unsigned* st;
};

__device__ __forceinline__ XcdBarrier xcd_barrier_post(unsigned* bar, volatile LAS unsigned* st) {
    XcdBarrier b; b.bar = bar; b.x = xb_xcc_id(); b.st = st;
    if (threadIdx.x == 0) (void)xb_add(&bar[XB_XCNT(b.x)], 1u);
    return b;
}
__device__ __forceinline__ void xcd_barrier_complete(unsigned* bar, unsigned x, unsigned& nloc, unsigned& nx) {
    const unsigned G = gridDim.x * gridDim.y * gridDim.z;
    unsigned sum, cnt, mine, sp = 0u;
    for (;;) {
        sum = 0u; cnt = 0u; mine = 0u;
#pragma unroll
        for (unsigned j = 0; j < 16; ++j) { const unsigned c = xb_ld(&bar[XB_XCNT(j)]); sum += c; cnt += (c > 0u) ? 1u : 0u; mine = (j == x) ? c : mine; }
        if (sum == G) break;
        __builtin_amdgcn_s_sleep(1);
        if ((++sp & 255u) == 0u) { if (xb_ld(&bar[XB_TMO])) break; if (sp > XB_SPIN_CAP) { atomicAdd(&bar[XB_TMO], 1u); break; } }
    }
    nloc = mine > 0u ? mine : 1u; nx = cnt > 0u ? cnt : 1u;
}

__device__ __forceinline__ void xcd_barrier(const XcdBarrier& b) {
    asm volatile("s_waitcnt vmcnt(0)" ::: "memory");
    __syncthreads();
    if (threadIdx.x == 0) {
        unsigned* bar = b.bar;
        __builtin_amdgcn_s_waitcnt(0);
        unsigned nloc = b.st[0], nx = b.st[1];
        if (nloc == 0u) { xcd_barrier_complete(bar, b.x, nloc, nx); b.st[0] = nloc; b.st[1] = nx; }
        const unsigned old = xb_add(&bar[XB_XSUB(b.x)], 1u);
        const unsigned gen = old / nloc;
        if (old + 1u == (gen + 1u) * nloc) {
            __builtin_amdgcn_fence(__ATOMIC_RELEASE, "agent");
            asm volatile("s_waitcnt vmcnt(0)" ::: "memory");
            const unsigned og = xb_add(&bar[XB_TOP], 1u);
            const unsigned tg = og / nx;
            if (og + 1u == (tg + 1u) * nx) xb_add(&bar[XB_TOPGEN], 1u);
            else XB_SPIN(xb_ld(&bar[XB_TOPGEN]) == tg, bar);
            __builtin_amdgcn_fence(__ATOMIC_ACQUIRE, "agent");
            xb_add(&bar[XB_XGEN(b.x)], 1u);
            asm volatile("s_waitcnt vmcnt(0)" ::: "memory");
        } else {
            XB_SPIN(xb_ld(&bar[XB_XGEN(b.x)]) == gen, bar);
            __builtin_amdgcn_fence(__ATOMIC_ACQUIRE, "agent");
            asm volatile("s_waitcnt vmcnt(0)" ::: "memory");
        }
    }
    __syncthreads();
}


#define FB_MAGIC 0x5EEDBA11u
__device__ __forceinline__ void flag_barrier(unsigned* flags) {
  asm volatile("s_waitcnt vmcnt(0)" ::: "memory");
  __syncthreads();
  if (threadIdx.x < 64) {
    if (threadIdx.x == 0) {
      __builtin_amdgcn_fence(__ATOMIC_RELEASE, "agent");
      asm volatile("s_waitcnt vmcnt(0)" ::: "memory");
      __hip_atomic_store(&flags[blockIdx.x], FB_MAGIC, __ATOMIC_RELAXED, __HIP_MEMORY_SCOPE_AGENT);
    }
    const unsigned G = gridDim.x; unsigned sp = 0u;
    for (;;) {
      bool ok = true;
      for (unsigned i = threadIdx.x; i < G; i += 64u) ok = ok && (xb_ld(&flags[i]) == FB_MAGIC);
      if (__all(ok)) break;
      __builtin_amdgcn_s_sleep(2);
      if (++sp > (1u << 21)) break;
    }
    __builtin_amdgcn_fence(__ATOMIC_ACQUIRE, "agent");
    asm volatile("s_waitcnt vmcnt(0)" ::: "memory");
  }
  __syncthreads();
}

__device__ __forceinline__ void wave_argmax(float& v, int& i) {
#pragma unroll
  for (int o = 32; o; o >>= 1) {
    const float ov = __shfl_xor(v, o); const int oi = __shfl_xor(i, o);
    if (ov > v || (ov == v && oi < i)) { v = ov; i = oi; }
  }
}

__global__ void __launch_bounds__(NT) mega(Params p) {
  extern __shared__ __attribute__((aligned(16))) unsigned char lds[];
  cg::grid_group grid = cg::this_grid();
  if (threadIdx.x < 35) {
    unsigned long long v = threadIdx.x < 33 ? (unsigned long long)p.in[threadIdx.x] : (threadIdx.x == 33 ? (unsigned long long)p.out : (unsigned long long)p.ws);
    ((unsigned long long*)(lds + PTR_OFF))[threadIdx.x] = v;
  }
  if (threadIdx.x < 2) ((volatile unsigned*)(lds + PTR_OFF + 800))[threadIdx.x] = 0u;
  __syncthreads();
  if (blockIdx.x == 0) for (int i = threadIdx.x; i < XCD_BAR_WORDS; i += NT) ((unsigned*)WSP(WS_BAR))[i] = 0u;

  {
    PHASE_LOCALS
    float* MOD = (float*)WSP(WS_MOD); float* LAM = (float*)WSP(WS_LAM);
    const float* cin = INP(1); const float* c_ctx = INP(3); const float* ada_w = INP(4); const float* ada_b = INP(5);
    if (gridDim.x >= 192) {
      if (blockIdx.x < 192) {
        float* sil = fl; float* red = fl + 5 * 1024;
        for (int i = tid; i < 5 * 1024; i += NT) { const int r = i >> 10, k = i & 1023; sil[i] = siluf_(r < 4 ? cin[r * D + k] : c_ctx[k]); }
        __syncthreads();
        const int cl = tid & 31, kg = tid >> 5, col = blockIdx.x * 32 + cl;
        float a[5] = {0.f, 0.f, 0.f, 0.f, 0.f};
#pragma unroll
        for (int kk = 0; kk < 64; ++kk) {
          const int k = kg * 64 + kk; const float w = ada_w[(size_t)k * 6144 + col];
#pragma unroll
          for (int r = 0; r < 5; ++r) a[r] += sil[r * 1024 + k] * w;
        }
#pragma unroll
        for (int r = 0; r < 5; ++r) red[(kg * 5 + r) * 32 + cl] = a[r];
        __syncthreads();
        if (tid < 160) {
          const int r = tid >> 5; float s = 0.f;
#pragma unroll
          for (int q = 0; q < 16; ++q) s += red[(q * 5 + r) * 32 + cl];
          MOD[r * 6144 + col] = s + ada_b[col];
        }
        __syncthreads();
      }
    } else {
      for (int it = gtid; it < 5 * 6144; it += gsz) {
        const int r = it / 6144, j = it % 6144;
        const float* cv = r < 4 ? cin + r * D : c_ctx;
        float a = 0.f;
        for (int k = 0; k < D; ++k) a += siluf_(cv[k]) * ada_w[(size_t)k * 6144 + j];
        MOD[it] = a + ada_b[j];
      }
    }
    if (gtid == 0) {
      const float* q1 = INP(9); const float* k1 = INP(10); const float* q2 = INP(11); const float* k2 = INP(12);
      float s1 = 0.f, s2 = 0.f;
      for (int k = 0; k < 64; ++k) { s1 += q1[k] * k1[k]; s2 += q2[k] * k2[k]; }
      LAM[0] = expf(s1) - expf(s2) + 0.2f;
    }
    const float* a_re = INP(15); const float* a_im = INP(16); const float* ldt = INP(17); const float* b_re = INP(18); const float* b_im = INP(19);
    for (int it = (int)(gridDim.x - 1 - blockIdx.x) * NT + tid; it < 2 * 32 * 64; it += gsz) {
      const float dt = expf(ldt[it >> 6]);
      ((float*)WSP(WS_ARDT))[it] = a_re[it] * dt; ((float*)WSP(WS_AIDT))[it] = a_im[it] * dt;
    }
    {
      struct BB { float fr, fi, ardt, aidt; };
      auto disc1 = [&](int sidx) -> BB {
        const float ar = a_re[sidx], ai = a_im[sidx], dt = expf(ldt[sidx >> 6]);
        const float mag = expf(ar * dt), abr = mag * cosf(ai * dt), abi = mag * sinf(ai * dt);
        const float den = ar * ar + ai * ai, nr = abr - 1.f, ni = abi;
        return BB{(nr * ar + ni * ai) / den, (ni * ar - nr * ai) / den, ar * dt, ai * dt};
      };
      {
        bf16_t* BTS = (bf16_t*)WSP(WS_BTS);
        for (int it = gtid; it < 32 * 256 * 32; it += gsz) {
          const int i = it & 31, r = (it >> 5) & 255, g = it >> 13;
          const int d = r >> 7, n = (r >> 1) & 63, ri = r & 1, sidx = (d * 32 + g) * 64 + n;
          const BB bb = disc1(sidx);
          const float e = (float)(d == 0 ? 31 - i : i);
          const float mag = __expf(e * bb.ardt), pr0 = mag * __cosf(e * bb.aidt), pi0 = mag * __sinf(e * bb.aidt);
          const float pr = pr0 * bb.fr - pi0 * bb.fi, pi = pr0 * bb.fi + pi0 * bb.fr;
          unsigned w[8];
#pragma unroll
          for (int q = 0; q < 8; ++q) {
            const float br0 = b_re[sidx * 16 + 2 * q], bi0 = b_im[sidx * 16 + 2 * q], br1 = b_re[sidx * 16 + 2 * q + 1], bi1 = b_im[sidx * 16 + 2 * q + 1];
            const float v0 = ri == 0 ? pr * br0 - pi * bi0 : pr * bi0 + pi * br0, v1 = ri == 0 ? pr * br1 - pi * bi1 : pr * bi1 + pi * br1;
            w[q] = pg8::cvt_pk_bf16(v0, v1);
          }
          u32x4* dst = (u32x4*)(BTS + ((size_t)g * 256 + r) * 512 + i * 16);
          dst[0] = (u32x4){w[0], w[1], w[2], w[3]}; dst[1] = (u32x4){w[4], w[5], w[6], w[7]};
        }
      }
      {
        float* KT = (float*)WSP(WS_KT); const float* c_re = INP(20); const float* c_im = INP(21);
        if (gridDim.x >= 256) {
          if (blockIdx.x >= 192) {
            const int dg = (int)blockIdx.x - 192; float* dsc = fl;
            float* blr = fl + 256; float* bli = blr + 1024; float* clr = bli + 1024; float* cli = clr + 16 * 65;
            if (tid < 64) { const BB bb = disc1(dg * 64 + tid); dsc[tid * 4] = bb.fr; dsc[tid * 4 + 1] = bb.fi; dsc[tid * 4 + 2] = bb.ardt; dsc[tid * 4 + 3] = bb.aidt; }
            for (int i = tid; i < 1024; i += NT) { blr[i] = b_re[dg * 1024 + i]; bli[i] = b_im[dg * 1024 + i];
              clr[(i >> 6) * 65 + (i & 63)] = c_re[dg * 1024 + i]; cli[(i >> 6) * 65 + (i & 63)] = c_im[dg * 1024 + i]; }
            __syncthreads();
            const int pp = tid & 15, m = tid >> 4;
            float acc[16];
#pragma unroll
            for (int q = 0; q < 16; ++q) acc[q] = 0.f;
            for (int n = 0; n < 64; ++n) {
              const float fr = dsc[n * 4], fi = dsc[n * 4 + 1], ardt = dsc[n * 4 + 2], aidt = dsc[n * 4 + 3];
              const float mag = __expf((float)m * ardt), pr0 = mag * __cosf((float)m * aidt), pi0 = mag * __sinf((float)m * aidt);
              const float pr = pr0 * fr - pi0 * fi, pi = pr0 * fi + pi0 * fr;
              const float cr = clr[pp * 65 + n], ci = cli[pp * 65 + n];
              const float wr_ = cr * pr - ci * pi, wi_ = cr * pi + ci * pr;
#pragma unroll
              for (int q = 0; q < 16; ++q) acc[q] += wr_ * blr[n * 16 + q] - wi_ * bli[n * 16 + q];
            }
#pragma unroll
            for (int q = 0; q < 16; ++q) KT[((size_t)dg * 32 + m) * 256 + pp * 16 + q] = acc[q];
            __syncthreads();
          }
        } else {
          for (int it = gtid; it < 2 * 32 * 32 * 16; it += gsz) {
            const int pp = it & 15, m = (it >> 4) & 31, dg = it >> 9;
            float acc[16];
#pragma unroll
            for (int q = 0; q < 16; ++q) acc[q] = 0.f;
            for (int n = 0; n < 64; ++n) {
              const int sidx = dg * 64 + n;
              const BB bb = disc1(sidx);
              const float mag = __expf((float)m * bb.ardt), pr0 = mag * __cosf((float)m * bb.aidt), pi0 = mag * __sinf((float)m * bb.aidt);
              const float pr = pr0 * bb.fr - pi0 * bb.fi, pi = pr0 * bb.fi + pi0 * bb.fr;
              const float cr = c_re[(dg * 16 + pp) * 64 + n], ci = c_im[(dg * 16 + pp) * 64 + n];
              const float wr_ = cr * pr - ci * pi, wi_ = cr * pi + ci * pr;
#pragma unroll
              for (int q = 0; q < 16; ++q) acc[q] += wr_ * b_re[sidx * 16 + q] - wi_ * b_im[sidx * 16 + q];
            }
#pragma unroll
            for (int q = 0; q < 16; ++q) KT[((size_t)dg * 32 + m) * 256 + pp * 16 + q] = acc[q];
          }
        }
      }
    }
    float* ROPE = (float*)WSP(WS_ROPE);
    for (int it = gtid; it < 64 * 16; it += gsz) {
      const float ang = (float)(it >> 4) * powf(10000.f, -(float)(it & 15) / 16.f);
      ROPE[it * 2] = cosf(ang); ROPE[it * 2 + 1] = sinf(ang);
    }
    {
      float* scr = fl + wid * (64 * 65);
      constexpr int I_IN = 16 * 88, I_AU = 16 * 16, I_SU = 8 * 16, I_OUT = 16 * 16, I_GLU = 8 * 8;
      for (int it = gw; it < I_IN + I_AU + I_SU + I_OUT + I_GLU; it += ngw) {
        int r = it;
        if (r < I_IN) { transpose_item64(INP(8), 1024, N_IN, (bf16_t*)WSP(WS_WIN), scr, r, lane); continue; } r -= I_IN;
        if (r < I_AU) { transpose_item64(INP(14), 1024, 1024, (bf16_t*)WSP(WS_WAU), scr, r, lane); continue; } r -= I_AU;
        if (r < I_SU) { transpose_item64(INP(25), 512, 1024, (bf16_t*)WSP(WS_WSU), scr, r, lane); continue; } r -= I_SU;
        if (r < I_OUT) { transpose_item64(INP(26), 1024, 1024, (bf16_t*)WSP(WS_WOUT), scr, r, lane); continue; } r -= I_OUT;
        transpose_item64(INP(23), 512, 512, (bf16_t*)WSP(WS_WGLU), scr, r, lane);
      }
    }
  }
  if (p.ws == nullptr) grid.sync();
  flag_barrier((unsigned*)WSP(WS_FLAGS));
  const XcdBarrier xbar = xcd_barrier_post((unsigned*)WSP(WS_BAR), (volatile LAS unsigned*)(lds + PTR_OFF + 800));

  {
    PHASE_LOCALS
    const float* MOD = (const float*)WSP(WS_MOD); bf16_t* XN = (bf16_t*)WSP(WS_XN);
    const float* x = INP(0); const float* ctx = INP(2); const float* norm1_g = INP(6);
    for (int row = gw; row < MX + MC; row += ngw) {
      const float* src; const float* md;
      if (row < MX) { src = x + (size_t)row * D; md = MOD + (row / L) * 6144; } else { src = ctx + (size_t)(row - MX) * D; md = MOD + 4 * 6144; }
      f32x4 v[4]; float ss = 0.f;
#pragma unroll
      for (int j = 0; j < 4; ++j) { v[j] = *(const f32x4*)(src + lane * 4 + 256 * j); ss += v[j][0] * v[j][0] + v[j][1] * v[j][1] + v[j][2] * v[j][2] + v[j][3] * v[j][3]; }
      const float rstd = rsqrtf(wave_sum(ss) * (1.f / D) + 1e-6f);
#pragma unroll
      for (int j = 0; j < 4; ++j)
#pragma unroll
        for (int e = 0; e < 4; ++e) { const int col = lane * 4 + 256 * j + e; XN[(size_t)row * D + col] = f2bf(v[j][e] * rstd * norm1_g[col] * (1.f + md[1024 + col]) + md[col]); }
    }
  }
  xcd_barrier(xbar);
  if (threadIdx.x == 0) ((unsigned*)WSP(WS_FLAGS))[blockIdx.x] = 0u;

  {
    pg8::Gemm g{(const bf16_t*)WSP(WS_XN), (const bf16_t*)WSP(WS_WIN), MX + MC, N_IN, D, D, D};
    InProjSched S; S.init((int)gridDim.x, (int)blockIdx.x);
    EpiInProj E{(bf16_t*)WSP(WS_Q), (bf16_t*)WSP(WS_K), (bf16_t*)WSP(WS_V), (bf16_t*)WSP(WS_SA), (bf16_t*)WSP(WS_G), (const float*)WSP(WS_ROPE)};
    pg8::gemm_phase<EpiInProj, InProjSched, true, true>((PG8_LAS unsigned char*)lds, g, S, E);
  }
  xcd_barrier(xbar);

  {
    const float lam = ((const float*)WSP(WS_LAM))[0];
    const bf16_t* Qb = (const bf16_t*)WSP(WS_Q); const bf16_t* Kb = (const bf16_t*)WSP(WS_K); const bf16_t* Vb = (const bf16_t*)WSP(WS_V);
    bf16_t* ATT = (bf16_t*)WSP(WS_ATT); const float* subln = INP(13);
    for (int unit = blockIdx.x; unit < Bn * 8 * (L / 128); unit += gridDim.x) {
      const int h = unit & 7, qb = (unit >> 3) & 31, b = unit >> 8;
      const size_t qoff = ((size_t)(b * L + qb * 128)) * 1024 + h * 128, koff = (size_t)b * LA * 1024 + h * 128;
      att::diff_attn_unit(Qb + qoff, Kb + koff, Vb + koff, ATT + qoff, LA, lam, subln, (char*)lds);
    }
  }
  xcd_barrier(xbar);

  {
    const bool gemm_blk = (blockIdx.x < 96) || (gridDim.x <= 96);
    if (gemm_blk) {
      pg8::Gemm g{(const bf16_t*)WSP(WS_SA), (const bf16_t*)WSP(WS_BTS), 0, 0, 512, SA_LD, 512};
      GroupSched S; S.init(32, 3, 1, (long)SA_ROWS * SA_LD * 2, (long)256 * SA_LD * 2, (long)256 * 512 * 2, 0, (int)(gridDim.x <= 96 ? gridDim.x : 96), (int)blockIdx.x);
      EpiS E{(float*)WSP(WS_S)};
      pg8::gemm_phase<EpiS, GroupSched, true, true>((PG8_LAS unsigned char*)lds, g, S, E);
    }
    {
      PHASE_LOCALS
      const bool big = gridDim.x > 96;
      const int vslots = big ? (gemm_blk ? 3 : 5) : 1, vbase = big ? (gemm_blk ? (int)blockIdx.x * 3 : 96 * 3 + ((int)blockIdx.x - 96) * 5) : (int)blockIdx.x;
      const int vtot = big ? 96 * 3 + ((int)gridDim.x - 96) * 5 : (int)gridDim.x;
      const float* KT = (const float*)WSP(WS_KT); const float* ARDT = (const float*)WSP(WS_ARDT); const float* AIDT = (const float*)WSP(WS_AIDT);
      const float* c_re = INP(20); const float* c_im = INP(21); const float* dsk = INP(22); bf16_t* BTY = (bf16_t*)WSP(WS_BTY);
      for (int cb = vbase; cb < 32 * 512 * 96 / NT; cb += vtot) for (int vs = 0; vs < vslots; ++vs) {
        const int ch = cb + vs; if (ch >= 32 * 512 * 96 / NT) break;
        const bool kpart = ch < 2048; const int it = (kpart ? ch : ch - 2048) * NT + tid;
        const int cgp = kpart ? (it & 63) : 64 + (it & 31), rg = kpart ? (it >> 6) : (it >> 5), row = rg & 511, g = rg >> 9;
        const int j = row >> 4, pp = row & 15, col0 = cgp * 8;
        float v[8];
        if (col0 < 512) {
          const int i = col0 >> 4, q0 = col0 & 15;
#pragma unroll
          for (int e = 0; e < 8; ++e) v[e] = 0.f;
          if (i <= j) { const float* kp = KT + ((size_t)(0 * 32 + g) * 32 + (j - i)) * 256 + pp * 16 + q0;
#pragma unroll
            for (int e = 0; e < 8; ++e) v[e] += kp[e]; }
          if (i >= j) { const float* kp = KT + ((size_t)(1 * 32 + g) * 32 + (i - j)) * 256 + pp * 16 + q0;
#pragma unroll
            for (int e = 0; e < 8; ++e) v[e] += kp[e]; }
          if (i == j && pp >= q0 && pp < q0 + 8) {
#pragma unroll
            for (int e = 0; e < 8; ++e) if (q0 + e == pp) v[e] += dsk[g * 16 + pp];
          }
        } else {
          const int cc0 = col0 - 512, d = cc0 >> 7, n0 = (cc0 & 127) >> 1;
          const float ex = (float)(d == 0 ? j + 1 : 32 - j);
#pragma unroll
          for (int q = 0; q < 4; ++q) {
            const int n = n0 + q, sidx = (d * 32 + g) * 64 + n;
            const float mag = __expf(ex * ARDT[sidx]), pr = mag * __cosf(ex * AIDT[sidx]), pi = mag * __sinf(ex * AIDT[sidx]);
            const float cr = c_re[((d * 32 + g) * 16 + pp) * 64 + n], ci = c_im[((d * 32 + g) * 16 + pp) * 64 + n];
            v[2 * q] = cr * pr - ci * pi; v[2 * q + 1] = -(cr * pi + ci * pr);
          }
        }
        u32x4 w; w.x = pg8::cvt_pk_bf16(v[0], v[1]); w.y = pg8::cvt_pk_bf16(v[2], v[3]); w.z = pg8::cvt_pk_bf16(v[4], v[5]); w.w = pg8::cvt_pk_bf16(v[6], v[7]);
        *(u32x4*)(BTY + ((size_t)g * 512 + row) * 768 + col0) = w;
      }
    }
  }
  xcd_barrier(xbar);

  {
    PHASE_LOCALS
    const float* ARDT = (const float*)WSP(WS_ARDT); const float* AIDT = (const float*)WSP(WS_AIDT);
    if (wid == 0) {
      for (int it = blockIdx.x; it < Bn * 32 * 2; it += gridDim.x) {
        const int d = it & 1, g = (it >> 1) & 31, b = it >> 6;
        const int sidx = (d * 32 + g) * 64 + lane;
        const float mag = expf(32.f * ARDT[sidx]), pr = mag * cosf(32.f * AIDT[sidx]), pi = mag * sinf(32.f * AIDT[sidx]);
        typedef float f32x2_ __attribute__((ext_vector_type(2)));
        const f32x2_* Sg = (const f32x2_*)((const float*)WSP(WS_S) + (size_t)g * SA_ROWS * 256) + d * 64 + lane;
        bf16_t* SAg = (bf16_t*)WSP(WS_SA) + (size_t)g * SA_ROWS * SA_LD + 512 + d * 128 + lane * 2;
        float hr = 0.f, hi = 0.f;
        f32x2_ sc[8];
#pragma unroll
        for (int k = 0; k < 8; ++k) { const int cc = d == 0 ? k : 7 - k; sc[k] = Sg[(size_t)(512 + b * 8 + cc) * 128]; }
#pragma unroll
        for (int k = 0; k < 8; ++k) { const float nr = pr * hr - pi * hi + sc[k][0], ni = pr * hi + pi * hr + sc[k][1]; hr = nr; hi = ni; }
        for (int k0 = 0; k0 < 128; k0 += 16) {
          f32x2_ sv[16];
#pragma unroll
          for (int k = 0; k < 16; ++k) { const int cx = d == 0 ? k0 + k : 127 - (k0 + k); sv[k] = Sg[(size_t)(b * 128 + cx) * 128]; }
#pragma unroll
          for (int k = 0; k < 16; ++k) {
            const int cx = d == 0 ? k0 + k : 127 - (k0 + k);
            *(unsigned*)(SAg + (size_t)(b * 128 + cx) * SA_LD) = pg8::cvt_pk_bf16(hr, hi);
            const float nr = pr * hr - pi * hi + sv[k][0], ni = pr * hi + pi * hr + sv[k][1]; hr = nr; hi = ni;
          }
        }
      }
    }
  }
  xcd_barrier(xbar);

  {
    pg8::Gemm g{(const bf16_t*)WSP(WS_SA), (const bf16_t*)WSP(WS_BTY), 0, 0, 768, SA_LD, 768};
    GroupSched S; S.init(32, 2, 2, (long)SA_ROWS * SA_LD * 2, (long)256 * SA_LD * 2, (long)512 * 768 * 2, (long)256 * 768 * 2, (int)gridDim.x, (int)blockIdx.x);
    EpiY E{(bf16_t*)WSP(WS_YG)};
    pg8::gemm_phase<EpiY, GroupSched, true, true>((PG8_LAS unsigned char*)lds, g, S, E);
  }
  {
    pg8::Gemm g{(const bf16_t*)WSP(WS_ATT), (const bf16_t*)WSP(WS_WAU), MX, 1024, 1024, 1024, 1024};
    pg8::StaticOrder S; S.init(MX, 1024, (int)gridDim.x, (int)blockIdx.x, g.lda, g.ldb);
    EpiBf8<1> E{(bf16_t*)WSP(WS_M), 1024, (const bf16_t*)WSP(WS_G), 2048, nullptr};
    pg8::gemm_phase<EpiBf8<1>, pg8::StaticOrder, true, true>((PG8_LAS unsigned char*)lds, g, S, E);
  }
  xcd_barrier(xbar);

  {
    pg8::Gemm g{(const bf16_t*)WSP(WS_YG), (const bf16_t*)WSP(WS_WGLU), MX, 512, 512, 512, 512};
    pg8::StaticOrder S; S.init(MX, 512, (int)gridDim.x, (int)blockIdx.x, g.lda, g.ldb);
    EpiBf8<0> E{(bf16_t*)WSP(WS_SSMX), 512, (const bf16_t*)WSP(WS_YG), 512, INP(24)};
    pg8::gemm_phase<EpiBf8<0>, pg8::StaticOrder, true, true>((PG8_LAS unsigned char*)lds, g, S, E);
  }
  xcd_barrier(xbar);

  {
    pg8::Gemm g{(const bf16_t*)WSP(WS_SSMX), (const bf16_t*)WSP(WS_WSU), MX, 1024, 512, 512, 512};
    pg8::StaticOrder S; S.init(MX, 1024, (int)gridDim.x, (int)blockIdx.x, g.lda, g.ldb);
    EpiBf8<2> E{(bf16_t*)WSP(WS_M), 1024, (const bf16_t*)WSP(WS_G) + 1024, 2048, nullptr};
    pg8::gemm_phase<EpiBf8<2>, pg8::StaticOrder, true, true>((PG8_LAS unsigned char*)lds, g, S, E);
  }
  xcd_barrier(xbar);
  {
    pg8::Gemm g{(const bf16_t*)WSP(WS_M), (const bf16_t*)WSP(WS_WOUT), MX, 1024, 1024, 1024, 1024};
    pg8::StaticOrder S; S.init(MX, 1024, (int)gridDim.x, (int)blockIdx.x, g.lda, g.ldb);
    EpiF32<1> E{(float*)WSP(WS_X1), INP(0), (const float*)WSP(WS_MOD)};
    pg8::gemm_phase<EpiF32<1>, pg8::StaticOrder, true, true>((PG8_LAS unsigned char*)lds, g, S, E);
  }
  xcd_barrier(xbar);
  {
    PHASE_LOCALS
    const float* X1 = (const float*)WSP(WS_X1); const float* MOD = (const float*)WSP(WS_MOD); bf16_t* XN2 = (bf16_t*)WSP(WS_XN2); const float* norm2_g = INP(7);
    for (int row = gw; row < MX; row += ngw) {
      const float* src = X1 + (size_t)row * D; const float* md = MOD + (row / L) * 6144;
      f32x4 v[4]; float ss = 0.f;
#pragma unroll
      for (int j = 0; j < 4; ++j) { v[j] = *(const f32x4*)(src + lane * 4 + 256 * j); ss += v[j][0] * v[j][0] + v[j][1] * v[j][1] + v[j][2] * v[j][2] + v[j][3] * v[j][3]; }
      const float rstd = rsqrtf(wave_sum(ss) * (1.f / D) + 1e-6f);
#pragma unroll
      for (int j = 0; j < 4; ++j)
#pragma unroll
        for (int e = 0; e < 4; ++e) { const int col = lane * 4 + 256 * j + e; XN2[(size_t)row * D + col] = f2bf(v[j][e] * rstd * norm2_g[col] * (1.f + md[4096 + col]) + md[3072 + col]); }
    }
    slice_table_fp8(INP(30), (unsigned char*)WSP(WS_U8), 32.f, gtid, gsz);
    {
      const float* wq = INP(27); const float* sk1 = INP(28); const float* sk2 = INP(29); bf16_t* WC = (bf16_t*)WSP(WS_WC);
      float* skl = fl; float* wql = fl + 128 * 65;
      for (int tile = blockIdx.x; tile < 16 * 16; tile += gridDim.x) {
        const int hs = tile >> 4, d0 = (tile & 15) * 64, h = hs >> 1, s = hs & 1;
        __syncthreads();
        const float* skp = s ? sk2 : sk1;
        for (int i = tid; i < 128 * 16; i += NT) { const int k = i >> 4, e4 = (i & 15) * 4; const f32x4 v = *(const f32x4*)(skp + k * 64 + e4); skl[k * 65 + e4] = v[0]; skl[k * 65 + e4 + 1] = v[1]; skl[k * 65 + e4 + 2] = v[2]; skl[k * 65 + e4 + 3] = v[3]; }
        for (int i = tid; i < 64 * 16; i += NT) { const int dd = i >> 4, e4 = (i & 15) * 4; const f32x4 v = *(const f32x4*)(wq + (size_t)(d0 + dd) * 1024 + h * 128 + s * 64 + e4); wql[dd * 65 + e4] = v[0]; wql[dd * 65 + e4 + 1] = v[1]; wql[dd * 65 + e4 + 2] = v[2]; wql[dd * 65 + e4 + 3] = v[3]; }
        __syncthreads();
        const int k = tid & 127, dgp = tid >> 7;
        float a[16];
#pragma unroll
        for (int q = 0; q < 16; ++q) a[q] = 0.f;
        for (int e = 0; e < 64; ++e) {
          const float sv = skl[k * 65 + e];
#pragma unroll
          for (int q = 0; q < 16; ++q) a[q] += sv * wql[(dgp * 16 + q) * 65 + e];
        }
        u32x4 w0, w1;
        w0.x = pg8::cvt_pk_bf16(a[0], a[1]); w0.y = pg8::cvt_pk_bf16(a[2], a[3]); w0.z = pg8::cvt_pk_bf16(a[4], a[5]); w0.w = pg8::cvt_pk_bf16(a[6], a[7]);
        w1.x = pg8::cvt_pk_bf16(a[8], a[9]); w1.y = pg8::cvt_pk_bf16(a[10], a[11]); w1.z = pg8::cvt_pk_bf16(a[12], a[13]); w1.w = pg8::cvt_pk_bf16(a[14], a[15]);
        bf16_t* dst = WC + (size_t)(h * 256 + s * 128 + k) * 1024 + d0 + dgp * 16;
        *(u32x4*)dst = w0; *(u32x4*)(dst + 8) = w1;
      }
      __syncthreads();
    }
  }
  xcd_barrier(xbar);
  {
    pg8::Gemm g{(const bf16_t*)WSP(WS_XN2), (const bf16_t*)WSP(WS_WC), MX, 2048, 1024, 1024, 1024};
    EpiTopK E{(unsigned short*)WSP(WS_IDX), (float*)WSP(WS_GATE)};
    const int nrounds = (64 * 8 + (int)gridDim.x - 1) / (int)gridDim.x;
    for (int rd = 0; rd < nrounds; ++rd) {
      OneUnitSched S; S.nM = 64; S.nN = 8; S.G = (int)gridDim.x; S.c = (int)blockIdx.x; S.round = rd; S.tsA = (long)256 * 1024 * 2; S.tsB = (long)256 * 1024 * 2;
      pg8::gemm_phase<EpiTopK, OneUnitSched, false, true>((PG8_LAS unsigned char*)lds, g, S, E);
    }
  }
  xcd_barrier(xbar);
  {
    PHASE_LOCALS
    const bf16_t* XN2 = (const bf16_t*)WSP(WS_XN2); const unsigned short* EXT = (const unsigned short*)WSP(WS_IDX);
    bf16_t* PD = (bf16_t*)WSP(WS_PD);
    const bool sl = (gridDim.x & 7) == 0;
    const int widu = __builtin_amdgcn_readfirstlane(wid);
    const int j0 = sl ? (int)(blockIdx.x & 7) : 0, nj = sl ? 1 : 8;
    const int wk = sl ? (int)(blockIdx.x >> 3) * 8 + widu : (int)blockIdx.x * (NT / 64) + widu, nwk = sl ? (int)(gridDim.x >> 3) * 8 : ngw;
    const int eg = lane >> 3, li = lane & 7;
    for (int jj = 0; jj < nj; ++jj) {
      const int j = j0 + jj;
      const unsigned char* U8j = (const unsigned char*)WSP(WS_U8) + (size_t)j * 16384 * 128 + li * 16;
      for (int t = wk; t < MX; t += nwk) {
        const u32x4* xp = (const u32x4*)(XN2 + (size_t)t * 1024 + j * 128 + li * 16);
        const u32x4 xa = xp[0], xb = xp[1];
        const u32x4* ep = (const u32x4*)(EXT + (size_t)t * 128 + eg * 16);
        const u32x4 e0 = ep[0], e1 = ep[1];
        const unsigned ew[8] = {e0.x, e0.y, e0.z, e0.w, e1.x, e1.y, e1.z, e1.w};
        u32x4 uw[16];
#pragma unroll
        for (int k = 0; k < 16; ++k) { const unsigned ex = (k & 1) ? (ew[k >> 1] >> 16) : (ew[k >> 1] & 0xffffu); uw[k] = *(const u32x4*)(U8j + ex * 128u); }
        const unsigned xwd[8] = {xa.x, xa.y, xa.z, xa.w, xb.x, xb.y, xb.z, xb.w};
        f32x2_t xf[8];
#pragma unroll
        for (int q = 0; q < 8; ++q) xf[q] = (f32x2_t){bflo(xwd[q]), bfhi(xwd[q])};
        float keep_lo = 0.f, keep_hi = 0.f;
#pragma unroll
        for (int k = 0; k < 16; ++k) {
          const unsigned uu[4] = {uw[k].x, uw[k].y, uw[k].z, uw[k].w};
          f32x2_t s2 = {0.f, 0.f};
#pragma unroll
          for (int q = 0; q < 4; ++q) { s2 += __builtin_amdgcn_cvt_pk_f32_fp8((int)uu[q], false) * xf[2 * q]; s2 += __builtin_amdgcn_cvt_pk_f32_fp8((int)uu[q], true) * xf[2 * q + 1]; }
          float dp = s2.x + s2.y;
          dp = dpp_add<0xB1>(dp); dp = dpp_add<0x4E>(dp); dp = dpp_add<0x141>(dp);
          if (li == (k & 7)) { if (k < 8) keep_lo = dp; else keep_hi = dp; }
        }
        bf16_t* pd = PD + ((size_t)t * 128 + eg * 16 + li) * 8 + j;
        pd[0] = f2bf(keep_lo * (1.f / 32.f)); pd[8 * 8] = f2bf(keep_hi * (1.f / 32.f));
      }
    }
    slice_table_fp8(INP(31), (unsigned char*)WSP(WS_V8), 1.f, gtid, gsz);
  }
  xcd_barrier(xbar);
  {
    PHASE_LOCALS
    const bf16_t* PD = (const bf16_t*)WSP(WS_PD); const float* GATE = (const float*)WSP(WS_GATE); unsigned* CFP = (unsigned*)WSP(WS_CFP);
    for (int t = gw; t < MX; t += ngw) {
      const u32x4* pp = (const u32x4*)(PD + ((size_t)t * 128 + 2 * lane) * 8);
      const u32x4 pa = pp[0], pb = pp[1];
      const f32x2_t g2 = *(const f32x2_t*)(GATE + (size_t)t * 128 + 2 * lane);
      const float p0 = ((bflo(pa.x) + bfhi(pa.x)) + (bflo(pa.y) + bfhi(pa.y))) + ((bflo(pa.z) + bfhi(pa.z)) + (bflo(pa.w) + bfhi(pa.w)));
      const float p1 = ((bflo(pb.x) + bfhi(pb.x)) + (bflo(pb.y) + bfhi(pb.y))) + ((bflo(pb.z) + bfhi(pb.z)) + (bflo(pb.w) + bfhi(pb.w)));
      CFP[(size_t)t * 64 + lane] = pg8::cvt_pk_bf16(g2.x * gelu_tanh(p0), g2.y * gelu_tanh(p1));
    }
  }
  xcd_barrier(xbar);
  {
    PHASE_LOCALS
    const float* X1 = (const float*)WSP(WS_X1); const float* MOD = (const float*)WSP(WS_MOD);
    const unsigned short* EXT = (const unsigned short*)WSP(WS_IDX); const unsigned* CFP = (const unsigned*)WSP(WS_CFP);
    float* SSQ = (float*)WSP(WS_SSQ); float* out = GPTR(float, ldptr_(33));
    const bool sl = (gridDim.x & 7) == 0;
    const int widu = __builtin_amdgcn_readfirstlane(wid);
    const int j0 = sl ? (int)(blockIdx.x & 7) : 0, nj = sl ? 1 : 8;
    const int wk = sl ? (int)(blockIdx.x >> 3) * 8 + widu : (int)blockIdx.x * (NT / 64) + widu, nwk = sl ? (int)(gridDim.x >> 3) * 8 : ngw;
    const int eg = lane >> 3, li = lane & 7;
    float* red = fl + widu * 1024;
    for (int jj = 0; jj < nj; ++jj) {
      const int j = j0 + jj;
      const unsigned char* V8j = (const unsigned char*)WSP(WS_V8) + (size_t)j * 16384 * 128 + li * 16;
      for (int t = wk; t < MX; t += nwk) {
        const u32x4* ep = (const u32x4*)(EXT + (size_t)t * 128 + eg * 16);
        const u32x4 e0 = ep[0], e1 = ep[1];
        const u32x4* cp = (const u32x4*)(CFP + (size_t)t * 64 + eg * 8);
        const u32x4 c0 = cp[0], c1 = cp[1];
        const int col = j * 128 + 2 * lane;
        const f32x2_t xr = *(const f32x2_t*)(X1 + (size_t)t * 1024 + col);
        const f32x2_t gr = *(const f32x2_t*)(MOD + (t >> 12) * 6144 + 5120 + col);
        const unsigned ew[8] = {e0.x, e0.y, e0.z, e0.w, e1.x, e1.y, e1.z, e1.w};
        const unsigned cfp[8] = {c0.x, c0.y, c0.z, c0.w, c1.x, c1.y, c1.z, c1.w};
        u32x4 vw[16];
#pragma unroll
        for (int k = 0; k < 16; ++k) { const unsigned ex = (k & 1) ? (ew[k >> 1] >> 16) : (ew[k >> 1] & 0xffffu); vw[k] = *(const u32x4*)(V8j + ex * 128u); }
        f32x2_t a[8];
#pragma unroll
        for (int q = 0; q < 8; ++q) a[q] = (f32x2_t){0.f, 0.f};
#pragma unroll
        for (int k = 0; k < 16; ++k) {
          const unsigned cf2 = cfp[k >> 1]; const float cf = (k & 1) ? bfhi(cf2) : bflo(cf2);
          const unsigned vv[4] = {vw[k].x, vw[k].y, vw[k].z, vw[k].w};
#pragma unroll
          for (int q = 0; q < 4; ++q) { a[2 * q] += __builtin_amdgcn_cvt_pk_f32_fp8((int)vv[q], false) * cf; a[2 * q + 1] += __builtin_amdgcn_cvt_pk_f32_fp8((int)vv[q], true) * cf; }
        }
#pragma unroll
        for (int q = 0; q < 4; ++q) *(f32x4*)(red + eg * 128 + li * 16 + q * 4) = (f32x4){a[2 * q].x, a[2 * q].y, a[2 * q + 1].x, a[2 * q + 1].y};
        asm volatile("s_waitcnt lgkmcnt(0)" ::: "memory");
        f32x2_t acc = {0.f, 0.f};
#pragma unroll
        for (int g = 0; g < 8; ++g) acc += *(const f32x2_t*)(red + g * 128 + 2 * lane);
        asm volatile("s_waitcnt lgkmcnt(0)" ::: "memory");
        const f32x2_t o2 = xr + gr * acc;
        float ss = o2.x * o2.x + o2.y * o2.y;
        ss = wave_sum(ss);
        *(f32x2_t*)(out + (size_t)t * 1024 + col) = o2;
        if (lane == 0) SSQ[(size_t)t * 8 + j] = ss;
      }
    }
  }
  xcd_barrier(xbar);
  {
    PHASE_LOCALS
    const float* SSQ = (const float*)WSP(WS_SSQ); const float* fng = INP(32); float* out = GPTR(float, ldptr_(33));
    f32x4 g4[4];
#pragma unroll
    for (int jq = 0; jq < 4; ++jq) g4[jq] = *(const f32x4*)(fng + lane * 4 + 256 * jq);
    for (int row = gw; row < MX; row += ngw) {
      const f32x4 sa = *(const f32x4*)(SSQ + (size_t)row * 8), sb = *(const f32x4*)(SSQ + (size_t)row * 8 + 4);
      const float rstd = rsqrtf(((sa[0] + sa[1]) + (sa[2] + sa[3]) + (sb[0] + sb[1]) + (sb[2] + sb[3])) * (1.f / D) + 1e-6f);
#pragma unroll
      for (int jq = 0; jq < 4; ++jq) {
        float* op = out + (size_t)row * D + lane * 4 + 256 * jq;
        const f32x4 v = *(const f32x4*)op;
        *(f32x4*)op = v * rstd * g4[jq];
      }
    }
  }
}

extern "C" void kernel_launch(void* const* d_in, const int* in_sizes, int n_in, void* d_out, int out_size, void* d_ws, size_t ws_size, hipStream_t stream) {
  static int grid_blocks = 0;
  if (!grid_blocks) {
    int dev = 0, cus = 0, per_cu = 0;
    (void)hipGetDevice(&dev);
    (void)hipDeviceGetAttribute(&cus, hipDeviceAttributeMultiprocessorCount, dev);
    (void)hipFuncSetAttribute((const void*)mega, hipFuncAttributeMaxDynamicSharedMemorySize, LDS_BYTES);
    (void)hipOccupancyMaxActiveBlocksPerMultiprocessor(&per_cu, (const void*)mega, NT, LDS_BYTES);
    if (per_cu < 1) per_cu = 1;
    grid_blocks = cus * per_cu;
    if (n_in != 33 || ws_size < 255 * MiB) { fprintf(stderr, "kernel_launch: unexpected n_in %d / ws %zu\n", n_in, ws_size); }
  }
  Params p{};
  for (int i = 0; i < 33 && i < n_in; ++i) p.in[i] = (const float*)d_in[i];
  p.out = (float*)d_out; p.ws = (unsigned char*)d_ws;
  void* args[] = {&p};
  hipError_t e = hipLaunchCooperativeKernel((const void*)mega, dim3(grid_blocks), dim3(NT), args, LDS_BYTES, stream);
  if (e != hipSuccess) fprintf(stderr, "cooperative launch failed: %s (grid %d)\n", hipGetErrorString(e), grid_blocks);
}
```

```cpp
#include <hip/hip_runtime.h>
#include <hip/hip_cooperative_groups.h>
#include <cstdio>
#include <cstdint>
namespace cg = cooperative_groups;

typedef unsigned short bf16_t;
typedef float f32x4 __attribute__((ext_vector_type(4)));

constexpr int NT = 512;
constexpr int LDS_BYTES = 147456;
constexpr int Bn = 4, L = 4096, D = 1024, NCTX = 256, LA = L + NCTX;
constexpr int MX = Bn * L, MC = Bn * NCTX;
constexpr int N_IN = 5632;
constexpr size_t MiB = 1u << 20;
constexpr size_t WS_MOD = 0, WS_LAM = 128 * 1024, WS_ROPE = 136 * 1024, WS_ARDT = 144 * 1024, WS_AIDT = 160 * 1024;
constexpr size_t WS_ABRE = 192 * 1024, WS_ABIM = 224 * 1024, WS_BBRE = 256 * 1024, WS_BBIM = 512 * 1024;
constexpr size_t WS_FLAGS = 1 * MiB + 65536;
constexpr size_t WS_BAR = 1 * MiB;
constexpr size_t WS_KT = 2 * MiB;
constexpr size_t WS_XN = 4 * MiB, WS_Q = 38 * MiB, WS_K = 70 * MiB, WS_V = 104 * MiB, WS_SA = 138 * MiB, WS_G = 164 * MiB;
constexpr size_t WS_WIN = 228 * MiB, WS_WAU = 239 * MiB, WS_WSU = 241 * MiB, WS_WOUT = 242 * MiB, WS_WQ = 244 * MiB, WS_WGLU = 246 * MiB;
constexpr size_t WS_BTS = 247 * MiB;
constexpr size_t WS_BTY = 38 * MiB, WS_S = 62 * MiB, WS_YG = 79 * MiB, WS_SSMX = 62 * MiB, WS_M = 95 * MiB;
constexpr size_t WS_ATT = WS_XN, WS_X1 = 4 * MiB, WS_XN2 = 68 * MiB, WS_QP = WS_G;
constexpr size_t WS_X2 = WS_XN2;
constexpr size_t WS_IDX = 111 * MiB, WS_GATE = 115 * MiB, WS_SSQ = 123 * MiB;
constexpr size_t WS_U8 = 127 * MiB, WS_PD = 164 * MiB, WS_V8 = 196 * MiB, WS_WC = 160 * MiB, WS_CFP = 160 * MiB;
constexpr int SA_ROWS = 544, SA_LD = 768;

constexpr int PTR_OFF = LDS_BYTES - 1024;
__device__ __forceinline__ unsigned long long ldptr_(int k) {
  extern __shared__ __attribute__((aligned(16))) unsigned char lds_[];
  const unsigned long long v = ((const unsigned long long*)(lds_ + PTR_OFF))[k];
  const unsigned lo = __builtin_amdgcn_readfirstlane((unsigned)v), hi = __builtin_amdgcn_readfirstlane((unsigned)(v >> 32));
  return ((unsigned long long)hi << 32) | lo;
}
#define GPTR(T, v) ((T*)(__attribute__((address_space(1))) T*)(v))
#define INP(k) GPTR(const float, ldptr_(k))
#define WSP(off) GPTR(unsigned char, ldptr_(34) + (off))
#define PHASE_LOCALS \
  int tid = threadIdx.x; asm volatile("" : "+v"(tid)); \
  const int lane = tid & 63, wid = tid >> 6; \
  const int gtid = blockIdx.x * NT + tid, gsz = gridDim.x * NT; \
  const int gw = blockIdx.x * (NT / 64) + wid, ngw = gridDim.x * (NT / 64); \
  float* fl = (float*)lds; (void)lane; (void)wid; (void)gtid; (void)gsz; (void)gw; (void)ngw; (void)fl;

struct Params {
  const float* in[33];
  float* out;
  unsigned char* ws;
  int pad0, pad1;
};

__device__ __forceinline__ float bf2f(bf16_t v) { return __uint_as_float(((unsigned)v) << 16); }
__device__ __forceinline__ bf16_t f2bf(float f) { unsigned u = __float_as_uint(f); return (bf16_t)((u + 0x7fffu + ((u >> 16) & 1u)) >> 16); }
__device__ __forceinline__ float wave_sum(float v) {
#pragma unroll
  for (int o = 32; o; o >>= 1) v += __shfl_xor(v, o);
  return v;
}
__device__ __forceinline__ float gelu_tanh(float x) { const float u2 = -2.302208198f * (x + 0.044715f * x * x * x); return x * __builtin_amdgcn_rcpf(1.f + __builtin_amdgcn_exp2f(u2)); }
__device__ __forceinline__ float sigmoidf_(float x) { return __builtin_amdgcn_rcpf(1.f + __builtin_amdgcn_exp2f(-1.4426950408889634f * x)); }
__device__ __forceinline__ float siluf_(float x) { return x / (1.f + __expf(-x)); }

template <class Epi>
__device__ __forceinline__ void sgemm(const bf16_t* A, int lda, const float* Bm, int ldb, int M, int N, int K, float* lds, Epi epi) {
  constexpr int TM = 128, TN = 128, TK = 16, LDA_S = TM + 4, LDB_S = TN + 4;
  float* As = lds;
  float* Bs = lds + TK * LDA_S;
  const int tid = threadIdx.x, ty = tid >> 4, tx = tid & 15;
  const int ntm = M / TM, ntn = N / TN;
  for (int tile = blockIdx.x; tile < ntm * ntn; tile += gridDim.x) {
    const int tm = tile / ntn, tn = tile % ntn;
    float acc[4][8];
#pragma unroll
    for (int i = 0; i < 4; ++i)
#pragma unroll
      for (int j = 0; j < 8; ++j) acc[i][j] = 0.f;
    const int ar = tid >> 2, ak = (tid & 3) * 4;
    const int bk = tid >> 5, bn = (tid & 31) * 4;
    for (int k0 = 0; k0 < K; k0 += TK) {
      const bf16_t* ap = A + (size_t)(tm * TM + ar) * lda + k0 + ak;
      const unsigned long long av = *(const unsigned long long*)ap;
      const f32x4 bv = *(const f32x4*)(Bm + (size_t)(k0 + bk) * ldb + tn * TN + bn);
      __syncthreads();
      As[(ak + 0) * LDA_S + ar] = bf2f((bf16_t)(av & 0xffff));
      As[(ak + 1) * LDA_S + ar] = bf2f((bf16_t)((av >> 16) & 0xffff));
      As[(ak + 2) * LDA_S + ar] = bf2f((bf16_t)((av >> 32) & 0xffff));
      As[(ak + 3) * LDA_S + ar] = bf2f((bf16_t)((av >> 48) & 0xffff));
      *(f32x4*)(Bs + bk * LDB_S + bn) = bv;
      __syncthreads();
#pragma unroll
      for (int k = 0; k < TK; ++k) {
        const f32x4 a4 = *(const f32x4*)(As + k * LDA_S + ty * 4);
        const f32x4 b0 = *(const f32x4*)(Bs + k * LDB_S + tx * 8);
        const f32x4 b1 = *(const f32x4*)(Bs + k * LDB_S + tx * 8 + 4);
#pragma unroll
        for (int i = 0; i < 4; ++i) {
          acc[i][0] += a4[i] * b0[0]; acc[i][1] += a4[i] * b0[1]; acc[i][2] += a4[i] * b0[2]; acc[i][3] += a4[i] * b0[3];
          acc[i][4] += a4[i] * b1[0]; acc[i][5] += a4[i] * b1[1]; acc[i][6] += a4[i] * b1[2]; acc[i][7] += a4[i] * b1[3];
        }
      }
    }
#pragma unroll
    for (int i = 0; i < 4; ++i)
#pragma unroll
      for (int j = 0; j < 8; ++j) epi(tm * TM + ty * 4 + i, tn * TN + tx * 8 + j, acc[i][j]);
  }
  __syncthreads();
}

namespace pg8 {
#define PG8_LAS __attribute__((address_space(3)))
typedef unsigned short bf16_t;
typedef short bf16x8 __attribute__((ext_vector_type(8)));
typedef float f32x4 __attribute__((ext_vector_type(4)));
typedef unsigned u32x4 __attribute__((ext_vector_type(4)));
constexpr int BM = 256, BK = 64, HALF = 128, HTB = HALF * BK * 2  , STAGE_BYTES = 8 * HTB, NXCD = 8, WGM = 8;

__host__ __device__ __forceinline__ int lds_byte(int r, int c) { const int st = (r >> 4) * 2 + (c >> 5), rr = r & 15, cc = c & 31, ob = rr * 64 + cc * 2; return st * 1024 + (ob ^ (((ob >> 9) & 1) << 5)); }
__host__ __device__ __forceinline__ void stage_rc(int b, int& R, int& C) { const int st = b / 1024, sb = b % 1024, swz = sb ^ (((sb >> 9) & 1) << 5); R = (st >> 1) * 16 + swz / 64; C = (st & 1) * 32 + (swz % 64) / 2; }
__host__ __device__ __forceinline__ int perm32(int rho) { const int n = rho >> 4, i = rho & 15; return 8 * (i >> 2) + 4 * n + (i & 3); }

struct Unit { int pm, pn, grp; long ao, bo; };
struct Gemm { const bf16_t* A; const bf16_t* Bt; int M, N, K, lda, ldb; };

struct StaticOrder {
    int nM, nN, nwg, G, c; long tsA, tsB;
    __host__ __device__ void init(int M, int N, int G_, int c_, int lda, int ldb) { nM = M / BM; nN = N / BM; nwg = nM * nN; G = G_; c = c_; tsA = (long)BM * lda * 2; tsB = (long)BM * ldb * 2; }
    __host__ __device__ bool next(int i, Unit& u) const {
        const long L = (long)i * G + c; if (L >= nwg) return false;
        int wgid = (int)L; { const int q = nwg / NXCD, r = nwg % NXCD, xcd = wgid % NXCD, off = wgid / NXCD; wgid = (xcd < r ? xcd * (q + 1) : r * (q + 1) + (xcd - r) * q) + off; }
        const int nig = WGM * nN, gid = wgid / nig, fm = gid * WGM, gsz = (nM - fm) < WGM ? (nM - fm) : WGM;
        u.pm = fm + ((wgid % nig) % gsz); u.pn = (wgid % nig) / gsz; u.grp = 0; u.ao = u.pm * tsA; u.bo = u.pn * tsB; return true;
    }
    __device__ __forceinline__ void a_ready(const Unit&) const {}
    __device__ __forceinline__ void done(const Unit&) const {}
};

__device__ __forceinline__ unsigned cvt_pk_bf16(float lo, float hi) { unsigned r; asm volatile("v_cvt_pk_bf16_f32 %0, %1, %2" : "=v"(r) : "v"(lo), "v"(hi)); return r; }
template <class Epi, class Sched, bool ALIGN_EPI = false, bool SP2 = false>
__device__ __forceinline__ void gemm_phase(PG8_LAS unsigned char* lds, const Gemm g, const Sched& S, const Epi& E) {
    int tid_ = threadIdx.x; asm volatile("" : "+v"(tid_));
    const int tid = tid_, wid = __builtin_amdgcn_readfirstlane(tid >> 6), lane = tid & 63, wr = wid >> 2, wc = wid & 3, fr = lane & 15, fq = lane >> 4;
    const int K = g.K, nt = K / BK;
    unsigned voffA[2], voffB[2];
#pragma unroll
    for (int i = 0; i < 2; ++i) { int R, C; stage_rc(tid * 16 + i * 8192, R, C); const int Rb = Epi::PERM ? ((R & ~31) + perm32(R & 31)) : R;
        voffA[i] = (unsigned)(R * g.lda + C) * 2u; voffB[i] = (unsigned)(Rb * g.ldb + C) * 2u; }
    const size_t kstep = (size_t)(BK * 2);
    const size_t hstepA = (size_t)HALF * g.lda * 2, hstepB = (size_t)HALF * g.ldb * 2;
    const unsigned ldsw = (unsigned)wid * 1024u;
    const int aoff = lds_byte(wr * 64 + fr, fq * 8), boff = lds_byte(wc * 32 + fr, fq * 8);
#define PG8_SA(b, h) (((b) * 2 + (h)) * HTB)
#define PG8_SB(b, h) ((4 + (b) * 2 + (h)) * HTB)
#define PG8_STAGE(bufoff, gbase, voff) do { _Pragma("unroll") for (int _i = 0; _i < 2; ++_i) \
        __builtin_amdgcn_global_load_lds((const unsigned*)((const char*)(gbase) + (voff)[_i]), (PG8_LAS unsigned*)(lds + (bufoff) + ldsw + _i * 8192), 16, 0, 0); } while (0)
#define PG8_LDA(dst, b, h) do { _Pragma("unroll") for (int m = 0; m < 4; ++m) _Pragma("unroll") for (int k = 0; k < 2; ++k) dst[m][k] = *(const PG8_LAS bf16x8*)(lds + PG8_SA(b, h) + aoff + m * 2048 + k * 1024); } while (0)
#define PG8_LDB(dst, b, h) do { _Pragma("unroll") for (int n = 0; n < 2; ++n) _Pragma("unroll") for (int k = 0; k < 2; ++k) dst[n][k] = *(const PG8_LAS bf16x8*)(lds + PG8_SB(b, h) + boff + n * 2048 + k * 1024); } while (0)
#define PG8_MMA(ai, bj, At, Bt) do { __builtin_amdgcn_s_setprio(1); _Pragma("unroll") for (int m = 0; m < 4; ++m) _Pragma("unroll") for (int n = 0; n < 2; ++n) _Pragma("unroll") for (int k = 0; k < 2; ++k) \
        acc[ai][bj][m][n] = __builtin_amdgcn_mfma_f32_16x16x32_bf16(Bt[n][k], At[m][k], acc[ai][bj][m][n], 0, 0, 0); __builtin_amdgcn_s_setprio(0); } while (0)
#define PG8_WAIT_V(n) asm volatile("s_waitcnt vmcnt(" #n ")" ::: "memory")
#define PG8_WAIT_L(n) asm volatile("s_waitcnt lgkmcnt(" #n ")" ::: "memory")
#define PG8_BAR __builtin_amdgcn_s_barrier()
#define PG8_SCHED __builtin_amdgcn_sched_barrier(0)
    Unit cur, nxt; int ui = 0;
    if (!S.next(0, cur)) return;
    f32x4 acc[2][2][4][2];
#pragma unroll
    for (int a = 0; a < 2; ++a)
#pragma unroll
        for (int b = 0; b < 2; ++b)
#pragma unroll
            for (int m = 0; m < 4; ++m)
#pragma unroll
                for (int n = 0; n < 2; ++n) acc[a][b][m][n] = (f32x4){0.f, 0.f, 0.f, 0.f};
    bf16x8 At[4][2], B0[2][2], B1[2][2];
    const char* cA = (const char*)g.A + cur.ao; const char* cB = (const char*)g.Bt + cur.bo;
    S.a_ready(cur);
    if constexpr (SP2) {
        PG8_STAGE(PG8_SB(0, 0), cB, voffB); PG8_STAGE(PG8_SB(0, 1), cB + hstepB, voffB); PG8_STAGE(PG8_SA(0, 0), cA, voffA); PG8_STAGE(PG8_SA(0, 1), cA + hstepA, voffA);
        if (wr == 1) PG8_BAR;
        PG8_WAIT_V(2); PG8_BAR;
        PG8_STAGE(PG8_SB(1, 0), cB + kstep, voffB); PG8_STAGE(PG8_SA(1, 0), cA + kstep, voffA); PG8_STAGE(PG8_SB(1, 1), cB + hstepB + kstep, voffB);
        PG8_WAIT_V(6); PG8_BAR;
    } else {
        PG8_STAGE(PG8_SB(0, 0), cB, voffB); PG8_STAGE(PG8_SA(0, 0), cA, voffA); PG8_STAGE(PG8_SB(0, 1), cB + hstepB, voffB); PG8_STAGE(PG8_SA(0, 1), cA + hstepA, voffA);
        if (wr == 1) PG8_BAR;
        PG8_WAIT_V(4); PG8_BAR;
        PG8_STAGE(PG8_SB(1, 0), cB + kstep, voffB); PG8_STAGE(PG8_SA(1, 0), cA + kstep, voffA); PG8_STAGE(PG8_SB(1, 1), cB + hstepB + kstep, voffB);
        PG8_WAIT_V(6); PG8_BAR;
    }
    for (;;) {
        const bool has_next = S.next(ui + 1, nxt);
        const char* nA = has_next ? (const char*)g.A + nxt.ao : cA; const char* nB = has_next ? (const char*)g.Bt + nxt.bo : cB;
        for (int t = 0; t < nt; t += 2) {
            const bool last = (t == nt - 2);
            const char* a1 = cA + (size_t)(t + 1) * kstep;
            const char* a2 = last ? nA : cA + (size_t)(t + 2) * kstep; const char* b2 = last ? nB : cB + (size_t)(t + 2) * kstep;
            const char* a3 = a2 + kstep; const char* b3 = b2 + kstep;
            if (last && has_next) S.a_ready(nxt);
            if constexpr (SP2) {
            PG8_LDB(B0, 0, 0); PG8_LDB(B1, 0, 1); PG8_SCHED; PG8_LDA(At, 0, 0); PG8_STAGE(PG8_SA(1, 1), a1 + hstepA, voffA);
            PG8_WAIT_V(8); PG8_WAIT_L(0); PG8_BAR; PG8_MMA(0, 0, At, B0); PG8_MMA(0, 1, At, B1); PG8_BAR; PG8_SCHED;
            PG8_LDA(At, 0, 1); PG8_STAGE(PG8_SB(0, 0), b2, voffB); PG8_STAGE(PG8_SB(0, 1), b2 + hstepB, voffB); PG8_STAGE(PG8_SA(0, 0), a2, voffA);
            PG8_WAIT_V(8); PG8_WAIT_L(0); PG8_BAR; PG8_MMA(1, 0, At, B0); PG8_MMA(1, 1, At, B1); PG8_BAR; PG8_SCHED;
            PG8_LDB(B0, 1, 0); PG8_LDB(B1, 1, 1); PG8_SCHED; PG8_LDA(At, 1, 0); PG8_STAGE(PG8_SA(0, 1), a2 + hstepA, voffA);
            PG8_WAIT_V(8); PG8_WAIT_L(0); PG8_BAR; PG8_MMA(0, 0, At, B0); PG8_MMA(0, 1, At, B1); PG8_BAR; PG8_SCHED;
            PG8_LDA(At, 1, 1); PG8_STAGE(PG8_SB(1, 0), b3, voffB); PG8_STAGE(PG8_SB(1, 1), b3 + hstepB, voffB); PG8_STAGE(PG8_SA(1, 0), a3, voffA);
            PG8_WAIT_V(8); PG8_WAIT_L(0); PG8_BAR; PG8_MMA(1, 0, At, B0); PG8_MMA(1, 1, At, B1); PG8_BAR; PG8_SCHED;
            } else {
            PG8_LDB(B0, 0, 0); PG8_SCHED; PG8_LDA(At, 0, 0); PG8_STAGE(PG8_SA(1, 1), a1 + hstepA, voffA);
            PG8_WAIT_L(8); PG8_BAR; PG8_WAIT_L(0); PG8_MMA(0, 0, At, B0); PG8_BAR; PG8_SCHED;
            PG8_LDB(B1, 0, 1); PG8_STAGE(PG8_SB(0, 0), b2, voffB);
            PG8_BAR; PG8_WAIT_L(0); PG8_MMA(0, 1, At, B1); PG8_BAR;
            PG8_LDA(At, 0, 1); PG8_STAGE(PG8_SA(0, 0), a2, voffA);
            PG8_BAR; PG8_WAIT_L(0); PG8_MMA(1, 0, At, B0); PG8_BAR; PG8_SCHED;
            PG8_STAGE(PG8_SB(0, 1), b2 + hstepB, voffB);
            PG8_WAIT_V(6); PG8_BAR; PG8_MMA(1, 1, At, B1); PG8_BAR;
            PG8_LDB(B0, 1, 0); PG8_SCHED; PG8_LDA(At, 1, 0); PG8_STAGE(PG8_SA(0, 1), a2 + hstepA, voffA);
            PG8_WAIT_L(8); PG8_BAR; PG8_WAIT_L(0); PG8_MMA(0, 0, At, B0); PG8_BAR; PG8_SCHED;
            PG8_LDB(B1, 1, 1); PG8_STAGE(PG8_SB(1, 0), b3, voffB);
            PG8_BAR; PG8_WAIT_L(0); PG8_MMA(0, 1, At, B1); PG8_BAR;
            PG8_LDA(At, 1, 1); PG8_STAGE(PG8_SA(1, 0), a3, voffA);
            PG8_BAR; PG8_WAIT_L(0); PG8_MMA(1, 0, At, B0); PG8_BAR; PG8_SCHED;
            PG8_STAGE(PG8_SB(1, 1), b3 + hstepB, voffB);
            PG8_WAIT_V(6); PG8_BAR; PG8_MMA(1, 1, At, B1); PG8_BAR;
            }
        }
        if constexpr (ALIGN_EPI) { if (wr == 0) PG8_BAR; }
        if constexpr (!Epi::AFTER_DRAIN) { int fr_ = fr, fq_ = fq; asm volatile("" : "+v"(fr_), "+v"(fq_));
            E(acc, cur, wr, wc, fr_, fq_); S.done(cur); }
        if (!has_next) break;
#pragma unroll
        for (int a = 0; a < 2; ++a)
#pragma unroll
            for (int b = 0; b < 2; ++b)
#pragma unroll
                for (int m = 0; m < 4; ++m)
#pragma unroll
                    for (int n = 0; n < 2; ++n) acc[a][b][m][n] = (f32x4){0.f, 0.f, 0.f, 0.f};
        cur = nxt; cA = nA; cB = nB; ++ui;
        if constexpr (ALIGN_EPI) { if (wr == 1) PG8_BAR; }
    }
    PG8_WAIT_V(0);
    if constexpr (!ALIGN_EPI) { if (wr == 0) PG8_BAR; }
    PG8_BAR;
    if constexpr (Epi::AFTER_DRAIN) { int fr_ = fr, fq_ = fq, lane_ = lane; asm volatile("" : "+v"(fr_), "+v"(fq_), "+v"(lane_)); E.fused(acc, cur, wr, wc, fr_, fq_, lds, wid, lane_); S.done(cur); }
#undef PG8_SA
#undef PG8_SB
#undef PG8_STAGE
#undef PG8_LDA
#undef PG8_LDB
#undef PG8_MMA
#undef PG8_WAIT_V
#undef PG8_WAIT_L
#undef PG8_BAR
#undef PG8_SCHED
}
}


using pg8::Unit;
typedef unsigned u32x2 __attribute__((ext_vector_type(2)));
typedef unsigned u32x4 __attribute__((ext_vector_type(4)));
__device__ __forceinline__ float bflo(unsigned w) { return __uint_as_float(w << 16); }
__device__ __forceinline__ float bfhi(unsigned w) { return __uint_as_float(w & 0xffff0000u); }

struct InProjSched {
  pg8::StaticOrder so;
  __device__ __forceinline__ void init(int G, int c) { so.init(MX, N_IN, G, c, D, D); }
  __device__ __forceinline__ bool next(int i, Unit& u) const {
    const long Lx = (long)i * so.G + so.c;
    if (Lx < so.nwg) return so.next(i, u);
    const int j = (int)(Lx - so.nwg); if (j >= 40) return false;
    u.pm = 64 + (j & 3); u.pn = 4 + (j >> 2); u.grp = 0; u.ao = u.pm * so.tsA; u.bo = u.pn * so.tsB; return true;
  }
  __device__ __forceinline__ void a_ready(const Unit&) const {}
  __device__ __forceinline__ void done(const Unit&) const {}
};

struct EpiInProj {
  static constexpr bool PERM = true, AFTER_DRAIN = false;
  bf16_t *Q, *K, *V, *SA, *G; const float* rope;
  __device__ __forceinline__ static void st8(bf16_t* p, const f32x4 a, const f32x4 b) {
    u32x4 w; w.x = pg8::cvt_pk_bf16(a[0], a[1]); w.y = pg8::cvt_pk_bf16(a[2], a[3]); w.z = pg8::cvt_pk_bf16(b[0], b[1]); w.w = pg8::cvt_pk_bf16(b[2], b[3]); *(u32x4*)p = w; }
  __device__ __forceinline__ static f32x4 partner4(const f32x4 v, const bool upper) {
    f32x4 r;
#pragma unroll
    for (int i = 0; i < 4; ++i) { auto rr = __builtin_amdgcn_permlane32_swap(__float_as_uint(v[i]), __float_as_uint(v[i]), false, false); r[i] = __uint_as_float(upper ? rr[0] : rr[1]); }
    return r;
  }
  __device__ __forceinline__ void operator()(const f32x4 (&acc)[2][2][4][2], const Unit& u, int wr, int wc, int fr, int fq) const {
    const int row0 = u.pm * 256 + wr * 64 + fr;
    const int cg0 = u.pn * 256 + wc * 32 + fq * 8;
    if (u.pm < 64) {
      if (u.pn < 8) {
        const bool isq = u.pn < 4; const float qsc = isq ? 0.125f * 1.4426950408889634f : 1.f;
        const bool upper = fq >= 2; const float sgn = upper ? 1.f : -1.f;
#pragma unroll
        for (int ai = 0; ai < 2; ++ai)
#pragma unroll
          for (int m = 0; m < 4; ++m) {
            const int row = row0 + ai * 128 + m * 16, b = row >> 12, t = row & 4095;
            const int pos = (wc & 1) ? (t & 63) : (t >> 6);
            const f32x4* rp = (const f32x4*)(rope + (pos * 16 + (fq & 1) * 8) * 2);
            const f32x4 r0 = rp[0], r1 = rp[1], r2 = rp[2], r3 = rp[3];
            const f32x4 cs0 = {r0[0], r0[2], r1[0], r1[2]}, sn0 = {r0[1], r0[3], r1[1], r1[3]}, cs1 = {r2[0], r2[2], r3[0], r3[2]}, sn1 = {r2[1], r2[3], r3[1], r3[3]};
            bf16_t* dst = isq ? Q + (size_t)row * 1024 + cg0 : K + ((size_t)b * LA + NCTX + t) * 1024 + (cg0 - 1024);
#pragma unroll
            for (int bj = 0; bj < 2; ++bj) {
              const f32x4 v0 = acc[ai][bj][m][0], v1 = acc[ai][bj][m][1];
              const f32x4 p0 = partner4(v0, upper), p1 = partner4(v1, upper);
              st8(dst + bj * 128, (v0 * cs0 + p0 * sn0 * sgn) * qsc, (v1 * cs1 + p1 * sn1 * sgn) * qsc);
            }
          }
      } else {
#pragma unroll
        for (int ai = 0; ai < 2; ++ai)
#pragma unroll
          for (int m = 0; m < 4; ++m) {
            const int row = row0 + ai * 128 + m * 16, b = row >> 12, t = row & 4095;
            const size_t kr = (size_t)b * LA + NCTX + t;
            if (u.pn >= 12 && u.pn < 14) {
#pragma unroll
              for (int bj = 0; bj < 2; ++bj) {
                const int ch = cg0 + bj * 128 - 3072;
                st8(SA + ((size_t)(ch >> 4) * SA_ROWS + b * 128 + (t >> 5)) * SA_LD + (t & 31) * 16 + (ch & 15), acc[ai][bj][m][0], acc[ai][bj][m][1]);
              }
            } else {
              bf16_t* dst = u.pn < 12 ? V + kr * 1024 + (cg0 - 2048) : G + (size_t)row * 2048 + (cg0 - 3584);
#pragma unroll
              for (int bj = 0; bj < 2; ++bj) {
                f32x4 v0 = acc[ai][bj][m][0], v1 = acc[ai][bj][m][1];
                if (u.pn >= 14) {
#pragma unroll
                  for (int i = 0; i < 4; ++i) { v0[i] = sigmoidf_(v0[i]); v1[i] = sigmoidf_(v1[i]); }
                }
                st8(dst + bj * 128, v0, v1);
              }
            }
          }
      }
    } else {
#pragma unroll
      for (int ai = 0; ai < 2; ++ai)
#pragma unroll
        for (int m = 0; m < 4; ++m) {
          const int rc = row0 + ai * 128 + m * 16 - MX, b = rc >> 8, t = rc & 255;
          const size_t kr = (size_t)b * LA + t;
          if (u.pn >= 12) {
#pragma unroll
            for (int bj = 0; bj < 2; ++bj) {
              const int ch = cg0 + bj * 128 - 3072;
              st8(SA + ((size_t)(ch >> 4) * SA_ROWS + 512 + b * 8 + (t >> 5)) * SA_LD + (t & 31) * 16 + (ch & 15), acc[ai][bj][m][0], acc[ai][bj][m][1]);
            }
          } else {
            bf16_t* dst = u.pn < 8 ? K + kr * 1024 + (cg0 - 1024) : V + kr * 1024 + (cg0 - 2048);
#pragma unroll
            for (int bj = 0; bj < 2; ++bj) st8(dst + bj * 128, acc[ai][bj][m][0], acc[ai][bj][m][1]);
          }
        }
    }
  }
};
template <int MODE>
struct EpiBf8 {
  static constexpr bool PERM = true, AFTER_DRAIN = false;
  bf16_t* O; int ldo; const bf16_t* X; int ldx; const float* bias;
  __device__ __forceinline__ void operator()(const f32x4 (&acc)[2][2][4][2], const Unit& u, int wr, int wc, int fr, int fq) const {
    const int row0 = u.pm * 256 + wr * 64 + fr, col0 = u.pn * 256 + wc * 32 + 8 * fq;
#pragma unroll
    for (int ai = 0; ai < 2; ++ai)
#pragma unroll
      for (int m = 0; m < 4; ++m) {
        const int row = row0 + ai * 128 + m * 16;
#pragma unroll
        for (int bj = 0; bj < 2; ++bj) {
          const int col = col0 + bj * 128;
          f32x4 v0 = acc[ai][bj][m][0], v1 = acc[ai][bj][m][1];
          const u32x4 xw = *(const u32x4*)(X + (size_t)row * ldx + col);
          const f32x4 x0 = {bflo(xw.x), bfhi(xw.x), bflo(xw.y), bfhi(xw.y)}, x1 = {bflo(xw.z), bfhi(xw.z), bflo(xw.w), bfhi(xw.w)};
          if (MODE == 0) {
            const f32x4 b0 = *(const f32x4*)(bias + col), b1 = *(const f32x4*)(bias + col + 4);
#pragma unroll
            for (int i = 0; i < 4; ++i) { v0[i] = x0[i] * sigmoidf_(v0[i] + b0[i]); v1[i] = x1[i] * sigmoidf_(v1[i] + b1[i]); }
          } else if (MODE == 1) { v0 = v0 * x0; v1 = v1 * x1; }
          else {
            const u32x4 ow = *(const u32x4*)(O + (size_t)row * ldo + col);
            const f32x4 o0 = {bflo(ow.x), bfhi(ow.x), bflo(ow.y), bfhi(ow.y)}, o1 = {bflo(ow.z), bfhi(ow.z), bflo(ow.w), bfhi(ow.w)};
            v0 = o0 + v0 * x0; v1 = o1 + v1 * x1;
          }
          u32x4 w; w.x = pg8::cvt_pk_bf16(v0[0], v0[1]); w.y = pg8::cvt_pk_bf16(v0[2], v0[3]); w.z = pg8::cvt_pk_bf16(v1[0], v1[1]); w.w = pg8::cvt_pk_bf16(v1[2], v1[3]);
          *(u32x4*)(O + (size_t)row * ldo + col) = w;
        }
      }
  }
};
template <int MODE>
struct EpiF32 {
  static constexpr bool PERM = false, AFTER_DRAIN = false;
  float* O; const float* xres; const float* mod;
  __device__ __forceinline__ void operator()(const f32x4 (&acc)[2][2][4][2], const Unit& u, int wr, int wc, int fr, int fq) const {
    const int row0 = u.pm * 256 + wr * 64 + fr, col0 = u.pn * 256 + wc * 32 + 4 * fq;
#pragma unroll
    for (int ai = 0; ai < 2; ++ai)
#pragma unroll
      for (int m = 0; m < 4; ++m) {
        const int row = row0 + ai * 128 + m * 16;
#pragma unroll
        for (int bj = 0; bj < 2; ++bj)
#pragma unroll
          for (int n = 0; n < 2; ++n) {
            const int col = col0 + bj * 128 + n * 16;
            f32x4 v = acc[ai][bj][m][n];
            if (MODE == 1) { const f32x4 xr = *(const f32x4*)(xres + (size_t)row * 1024 + col); const f32x4 g = *(const f32x4*)(mod + (row >> 12) * 6144 + 2048 + col); v = xr + g * v; }
            *(f32x4*)(O + (size_t)row * 1024 + col) = v;
          }
      }
  }
};


struct EpiX1 {
  static constexpr bool PERM = true, AFTER_DRAIN = false;
  bf16_t* O; const float* xres; const float* mod;
  __device__ __forceinline__ void operator()(const f32x4 (&acc)[2][2][4][2], const Unit& u, int wr, int wc, int fr, int fq) const {
    const int row0 = u.pm * 256 + wr * 64 + fr, col0 = u.pn * 256 + wc * 32 + 8 * fq;
#pragma unroll
    for (int ai = 0; ai < 2; ++ai)
#pragma unroll
      for (int m = 0; m < 4; ++m) {
        const int row = row0 + ai * 128 + m * 16;
#pragma unroll
        for (int bj = 0; bj < 2; ++bj) {
          const int col = col0 + bj * 128;
          const float* xp = xres + (size_t)row * 1024 + col; const float* gp = mod + (row >> 12) * 6144 + 2048 + col;
          const f32x4 v0 = *(const f32x4*)xp + *(const f32x4*)gp * acc[ai][bj][m][0], v1 = *(const f32x4*)(xp + 4) + *(const f32x4*)(gp + 4) * acc[ai][bj][m][1];
          u32x4 w; w.x = pg8::cvt_pk_bf16(v0[0], v0[1]); w.y = pg8::cvt_pk_bf16(v0[2], v0[3]); w.z = pg8::cvt_pk_bf16(v1[0], v1[1]); w.w = pg8::cvt_pk_bf16(v1[2], v1[3]);
          *(u32x4*)(O + (size_t)row * 1024 + col) = w;
        }
      }
  }
};
struct GroupSched {
  int npm, npn, nunits, G, c; long gsA, gsB, tsA, tsB;
  __device__ __forceinline__ void init(int ngrp, int npm_, int npn_, long gsA_, long tsA_, long gsB_, long tsB_, int G_, int c_) { npm = npm_; npn = npn_; nunits = ngrp * npm_ * npn_; gsA = gsA_; tsA = tsA_; gsB = gsB_; tsB = tsB_; G = G_; c = c_; }
  __device__ __forceinline__ bool next(int i, Unit& u) const {
    const long Lx = (long)i * G + c; if (Lx >= nunits) return false;
    const int per = npm * npn, grp = (int)Lx / per, r = (int)Lx % per;
    u.grp = grp; u.pm = r / npn; u.pn = r % npn; u.ao = grp * gsA + u.pm * tsA; u.bo = grp * gsB + u.pn * tsB; return true;
  }
  __device__ __forceinline__ void a_ready(const Unit&) const {}
  __device__ __forceinline__ void done(const Unit&) const {}
};
struct EpiS {
  static constexpr bool PERM = false, AFTER_DRAIN = false;
  float* S;
  __device__ __forceinline__ void operator()(const f32x4 (&acc)[2][2][4][2], const Unit& u, int wr, int wc, int fr, int fq) const {
    const int row0 = u.pm * 256 + wr * 64 + fr, col0 = wc * 32 + 4 * fq;
#pragma unroll
    for (int ai = 0; ai < 2; ++ai)
#pragma unroll
      for (int m = 0; m < 4; ++m) {
        const int row = row0 + ai * 128 + m * 16;
        if (row < SA_ROWS) {
#pragma unroll
          for (int bj = 0; bj < 2; ++bj)
#pragma unroll
            for (int n = 0; n < 2; ++n) *(f32x4*)(S + ((size_t)u.grp * SA_ROWS + row) * 256 + col0 + bj * 128 + n * 16) = acc[ai][bj][m][n];
        }
      }
  }
};
struct EpiY {
  static constexpr bool PERM = true, AFTER_DRAIN = false;
  bf16_t* YG;
  __device__ __forceinline__ void operator()(const f32x4 (&acc)[2][2][4][2], const Unit& u, int wr, int wc, int fr, int fq) const {
    const int row0 = u.pm * 256 + wr * 64 + fr, col0 = u.pn * 256 + wc * 32 + 8 * fq;
#pragma unroll
    for (int ai = 0; ai < 2; ++ai)
#pragma unroll
      for (int m = 0; m < 4; ++m) {
        const int row = row0 + ai * 128 + m * 16, b = row >> 7, cx = row & 127;
#pragma unroll
        for (int bj = 0; bj < 2; ++bj) {
          const int col = col0 + bj * 128, j = col >> 4, p0 = col & 15;
          const f32x4 v0 = acc[ai][bj][m][0], v1 = acc[ai][bj][m][1];
          u32x4 w; w.x = pg8::cvt_pk_bf16(gelu_tanh(v0[0]), gelu_tanh(v0[1])); w.y = pg8::cvt_pk_bf16(gelu_tanh(v0[2]), gelu_tanh(v0[3]));
          w.z = pg8::cvt_pk_bf16(gelu_tanh(v1[0]), gelu_tanh(v1[1])); w.w = pg8::cvt_pk_bf16(gelu_tanh(v1[2]), gelu_tanh(v1[3]));
          *(u32x4*)(YG + ((size_t)(b * L + cx * 32 + j)) * 512 + u.grp * 16 + p0) = w;
        }
      }
  }
};


__device__ __forceinline__ unsigned f2key(float s) { const unsigned u = __float_as_uint(s); return u ^ ((u & 0x80000000u) ? 0xFFFFFFFFu : 0x80000000u); }
__device__ __forceinline__ float key2f(unsigned k) { return __uint_as_float(k ^ ((k & 0x80000000u) ? 0x80000000u : 0xFFFFFFFFu)); }
#define TK_INSERT(L, cv) do { _Pragma("unroll") for (int k_ = 0; k_ < 16; ++k_) { const unsigned hi_ = L[k_] > cv ? L[k_] : cv, lo_ = L[k_] > cv ? cv : L[k_]; L[k_] = hi_; cv = lo_; } } while (0)
#define TK_CX(X, Y) do { const unsigned hi_ = (X) > (Y) ? (X) : (Y), lo_ = (X) > (Y) ? (Y) : (X); (X) = hi_; (Y) = lo_; } while (0)
#define TK_SORT16(A, B) do { _Pragma("unroll") for (int k_ = 2; k_ <= 16; k_ <<= 1) _Pragma("unroll") for (int j_ = k_ >> 1; j_ > 0; j_ >>= 1) _Pragma("unroll") for (int i_ = 0; i_ < 16; ++i_) { \
    const int l_ = i_ ^ j_; if (l_ > i_) { if ((i_ & k_) == 0) TK_CX(A[(B) + i_], A[(B) + l_]); else TK_CX(A[(B) + l_], A[(B) + i_]); } } } while (0)
#define TK_MERGE16(A, P, Q) do { _Pragma("unroll") for (int i_ = 0; i_ < 16; ++i_) A[(P) + i_] = A[(P) + i_] > A[(Q) + 15 - i_] ? A[(P) + i_] : A[(Q) + 15 - i_]; \
    _Pragma("unroll") for (int j_ = 8; j_ > 0; j_ >>= 1) _Pragma("unroll") for (int i_ = 0; i_ < 16; ++i_) { const int l_ = i_ ^ j_; if (l_ > i_) TK_CX(A[(P) + i_], A[(P) + l_]); } } while (0)
struct EpiTopK {
  static constexpr bool PERM = false, AFTER_DRAIN = true;
  unsigned short* IDX; float* GATE;
  __device__ __forceinline__ void fused(f32x4 (&acc)[2][2][4][2], const Unit& u, int wr, int wc, int fr, int fq, PG8_LAS unsigned char* lds, int wid, int lane) const {
    PG8_LAS float* SC = (PG8_LAS float*)lds;
    const int tid = wid * 64 + lane;
#pragma unroll
    for (int ai = 0; ai < 2; ++ai) {
#pragma unroll
      for (int m = 0; m < 4; ++m)
#pragma unroll
        for (int bj = 0; bj < 2; ++bj)
#pragma unroll
          for (int n = 0; n < 2; ++n)
#pragma unroll
            for (int i = 0; i < 4; ++i) SC[(64 * wr + 16 * m + fr) * 257 + 128 * bj + 32 * wc + 16 * n + 4 * fq + i] = acc[ai][bj][m][n][i];
      asm volatile("s_waitcnt lgkmcnt(0)" ::: "memory"); __builtin_amdgcn_s_barrier(); asm volatile("" ::: "memory");
      {
        const int hf = tid >> 8;
        PG8_LAS float* rowp = SC + (tid & 127) * 257 + ((tid >> 7) & 1) * 128 + hf * 64;
        unsigned a[48];
#pragma unroll
        for (int k = 0; k < 32; ++k) a[k] = (f2key(rowp[k]) & ~0x7Fu) | (unsigned)(127 - (hf * 64 + k));
        TK_SORT16(a, 0); TK_SORT16(a, 16); TK_MERGE16(a, 0, 16);
#pragma unroll
        for (int k = 0; k < 32; ++k) a[16 + k] = (f2key(rowp[32 + k]) & ~0x7Fu) | (unsigned)(127 - (hf * 64 + 32 + k));
        TK_SORT16(a, 16); TK_SORT16(a, 32); TK_MERGE16(a, 16, 32); TK_MERGE16(a, 0, 16);
#pragma unroll
        for (int k = 0; k < 16; ++k) rowp[k] = __uint_as_float(a[k]);
      }
      asm volatile("s_waitcnt lgkmcnt(0)" ::: "memory"); __builtin_amdgcn_s_barrier(); asm volatile("" ::: "memory");
      if (tid < 256) {
        PG8_LAS float* rowp = SC + (tid & 127) * 257 + (tid >> 7) * 128;
        unsigned a[32];
#pragma unroll
        for (int k = 0; k < 16; ++k) { a[k] = __float_as_uint(rowp[k]); a[16 + k] = __float_as_uint(rowp[64 + k]); }
        TK_MERGE16(a, 0, 16);
#pragma unroll
        for (int k = 0; k < 16; ++k) rowp[k] = __uint_as_float(a[k]);
      }
      asm volatile("s_waitcnt lgkmcnt(0)" ::: "memory"); __builtin_amdgcn_s_barrier(); asm volatile("" ::: "memory");
      if (tid < 128) {
        PG8_LAS float* rowp = SC + tid * 257;
        float v1[16], v2[16];
#pragma unroll
        for (int k = 0; k < 16; ++k) { v1[k] = key2f(__float_as_uint(rowp[k]) & ~0x7Fu); v2[k] = key2f(__float_as_uint(rowp[128 + k]) & ~0x7Fu); }
#define TK_CAND(a, b) ((f2key(v1[a] + v2[b]) & ~0xFFu) | (unsigned)(255 - ((a) * 16 + (b))))
        unsigned Lc[48];
#pragma unroll
        for (int k = 0; k < 16; ++k) { Lc[k] = TK_CAND(0, k); Lc[16 + k] = k < 15 ? TK_CAND(k + 1, 0) : 0u; }
        { int n_ = 0; unsigned ex_[3];
#pragma unroll
          for (int a = 1; a < 8; ++a)
#pragma unroll
            for (int b = 1; b < 8; ++b)
              if ((a + 1) * (b + 1) <= 16) { const unsigned cv = TK_CAND(a, b); if (n_ < 16) Lc[32 + n_] = cv; else ex_[n_ - 16] = cv; ++n_; }
          TK_MERGE16(Lc, 0, 16); TK_SORT16(Lc, 32); TK_MERGE16(Lc, 0, 32);
#pragma unroll
          for (int k = 0; k < 3; ++k) { unsigned cv = ex_[k]; TK_INSERT(Lc, cv); } }
#undef TK_CAND
        float ev[16]; float den = 0.f; const float mx = key2f(Lc[0] & ~0xFFu);
#pragma unroll
        for (int k = 0; k < 16; ++k) { ev[k] = __expf(key2f(Lc[k] & ~0xFFu) - mx); den += ev[k]; }
        const float inv = 1.f / den;
        const size_t o = ((size_t)(u.pm * 256 + ai * 128 + tid) * 8 + u.pn) * 16;
        unsigned iw[8];
#pragma unroll
        for (int k = 0; k < 16; ++k) {
          const int code = 255 - (int)(Lc[k] & 0xFFu), a = code >> 4, b = code & 15;
          const unsigned e1 = 127u - (__float_as_uint(rowp[a]) & 0x7Fu), e2 = 127u - (__float_as_uint(rowp[128 + b]) & 0x7Fu);
          const unsigned ex = e1 * 128u + e2;
          if (k & 1) iw[k >> 1] |= ex << 16; else iw[k >> 1] = ex;
        }
        *(u32x4*)(IDX + o) = (u32x4){iw[0], iw[1], iw[2], iw[3]}; *(u32x4*)(IDX + o + 8) = (u32x4){iw[4], iw[5], iw[6], iw[7]};
#pragma unroll
        for (int k = 0; k < 16; k += 4) *(f32x4*)(GATE + o + k) = (f32x4){ev[k] * inv, ev[k + 1] * inv, ev[k + 2] * inv, ev[k + 3] * inv};
      }
      asm volatile("s_waitcnt lgkmcnt(0)" ::: "memory"); __builtin_amdgcn_s_barrier(); asm volatile("" ::: "memory");
    }
  }
};
struct OneUnitSched {
  int nM, nN, G, c, round; long tsA, tsB;
  __device__ __forceinline__ bool next(int i, Unit& u) const {
    if (i > 0) return false;
    const long Lx = (long)round * G + c; if (Lx >= (long)nM * nN) return false;
    u.pm = (int)(Lx % nM); u.pn = (int)(Lx / nM); u.grp = 0; u.ao = u.pm * tsA; u.bo = u.pn * tsB; return true;
  }
  __device__ __forceinline__ void a_ready(const Unit&) const {}
  __device__ __forceinline__ void done(const Unit&) const {}
};

__device__ __forceinline__ void transpose_item64(const float* W, int K, int N, bf16_t* WT, float* scr, int item, int lane) {
  const int nblk = N / 64, kb = item / nblk, nb = item % nblk, k0 = 64 * kb, n0 = 64 * nb;
  f32x4 v[16];
#pragma unroll
  for (int i = 0; i < 16; ++i) v[i] = *(const f32x4*)(W + (size_t)(k0 + 4 * i + (lane >> 4)) * N + n0 + (lane & 15) * 4);
#pragma unroll
  for (int i = 0; i < 16; ++i) { float* d = scr + (4 * i + (lane >> 4)) * 65 + (lane & 15) * 4; d[0] = v[i][0]; d[1] = v[i][1]; d[2] = v[i][2]; d[3] = v[i][3]; }
  asm volatile("s_waitcnt lgkmcnt(0)" ::: "memory");
  const int c = lane & 7;
#pragma unroll
  for (int j = 0; j < 8; ++j) {
    const int n = (lane >> 3) + 8 * j; const float* s = scr + (8 * c) * 65 + n;
    u32x4 o; o.x = pg8::cvt_pk_bf16(s[0], s[65]); o.y = pg8::cvt_pk_bf16(s[130], s[195]); o.z = pg8::cvt_pk_bf16(s[260], s[325]); o.w = pg8::cvt_pk_bf16(s[390], s[455]);
    *(u32x4*)(WT + (size_t)(n0 + n) * K + k0 + 8 * c) = o;
  }
  asm volatile("s_waitcnt lgkmcnt(0)" ::: "memory");
}
__device__ __forceinline__ void transpose_item(const float* W, int K, int N, bf16_t* WT, float* scr, int item, int lane) {
  const int nblk = N / 32, kb = item / nblk, nb = item % nblk, k0 = 64 * kb, n0 = 32 * nb;
#pragma unroll 8
  for (int i = 0; i < 32; ++i) { const int kk = 2 * i + (lane >> 5); scr[kk * 33 + (lane & 31)] = W[(size_t)(k0 + kk) * N + n0 + (lane & 31)]; }
  asm volatile("s_waitcnt lgkmcnt(0)" ::: "memory");
  const int c = lane & 7;
#pragma unroll
  for (int j = 0; j < 4; ++j) {
    const int n = (lane >> 3) + 8 * j; const float* s = scr + (8 * c) * 33 + n;
    u32x4 o; o.x = pg8::cvt_pk_bf16(s[0], s[33]); o.y = pg8::cvt_pk_bf16(s[66], s[99]); o.z = pg8::cvt_pk_bf16(s[132], s[165]); o.w = pg8::cvt_pk_bf16(s[198], s[231]);
    *(u32x4*)(WT + (size_t)(n0 + n) * K + k0 + 8 * c) = o;
  }
  asm volatile("s_waitcnt lgkmcnt(0)" ::: "memory");
}

namespace att {
using bf16 = unsigned short;
constexpr int   D = 128, NW = 8, QBLK = 32, KVBLK = 64, SDEPTH = 1;
constexpr float SCALE = 0.125f;
constexpr float THR = 8.f;
constexpr int LDQ = 1024, LDK = 1024, LDO = 1024;
constexpr size_t SHM_V = KVBLK * D * 2, SHM_K = KVBLK * D * 2, SHM_ATTN = 2 * SHM_V + 2 * SHM_K + NW * 64 * 4 + 4 * 4 * 16 * 64 * 4;
using bf16x8 = __attribute__((ext_vector_type(8))) short;
using s16x4  = __attribute__((ext_vector_type(4))) short;
using f32x16 = __attribute__((ext_vector_type(16))) float;
using f32x8  = __attribute__((ext_vector_type(8))) float;
using u32x4  = __attribute__((ext_vector_type(4))) unsigned;
#define KSWZ(row, colB) ((row) * 256 + ((colB) ^ (((row) & 15) << 4)))
#define SBAR() __builtin_amdgcn_sched_barrier(0)
__device__ __forceinline__ int crow(int r, int hi) { return (r & 3) + 8 * (r >> 2) + 4 * hi; }
__device__ __forceinline__ unsigned cvtpk(float lo, float hi) {
  unsigned r; asm volatile("v_cvt_pk_bf16_f32 %0, %1, %2" : "=v"(r) : "v"(lo), "v"(hi)); return r;
}
template <typename TIn> struct Stage;
template <> struct Stage<bf16>  { using T = bf16x8;
  __device__ static __forceinline__ T ld8(const bf16* p) { return *(const __attribute__((address_space(1))) bf16x8*)(p); }
  __device__ static __forceinline__ bf16x8 tobf(T x) { return x; } };
constexpr float THR2 = 11.5f;
template <bool FIRST>
__device__ __forceinline__ void partialSM(f32x16& p0, f32x16& p1, float& mhat, f32x16& negm, float& alpha) {
  float pmax = p0[0]; for (int r = 1; r < 16; ++r) pmax = fmaxf(pmax, p0[r]); for (int r = 0; r < 16; ++r) pmax = fmaxf(pmax, p1[r]);
  { auto rr = __builtin_amdgcn_permlane32_swap(__float_as_uint(pmax), __float_as_uint(pmax), false, false);
    pmax = fmaxf(__uint_as_float(rr[0]), __uint_as_float(rr[1])); }
  alpha = 1.f;
  if (FIRST || !__builtin_expect(__all(pmax <= THR2), 1)) {
    const float dl = FIRST ? pmax : fmaxf(pmax, 0.f);
    mhat += dl;
    for (int r = 0; r < 16; ++r) { p0[r] -= dl; p1[r] -= dl; }
    if (!FIRST) alpha = __builtin_amdgcn_exp2f(-dl);
  }
  for (int r = 0; r < 16; ++r) p0[r] = __builtin_amdgcn_exp2f(p0[r]);
}
__device__ __forceinline__ void finishSM(f32x16& p0, f32x16& p1, float alpha, float& l_reg, bf16x8& pa0, bf16x8& pa1, bf16x8& pa2, bf16x8& pa3) {
  for (int r = 0; r < 16; ++r) p1[r] = __builtin_amdgcn_exp2f(p1[r]);
  float ps = 0; for (int r = 0; r < 16; ++r) ps += p0[r]; for (int r = 0; r < 16; ++r) ps += p1[r];
  { auto rr = __builtin_amdgcn_permlane32_swap(__float_as_uint(ps), __float_as_uint(ps), false, false);
    ps = __uint_as_float(rr[0]) + __uint_as_float(rr[1]); }
  l_reg = l_reg * alpha + ps;
#define PK4(P, BASE, OUT) do { unsigned a0 = cvtpk(P[BASE + 0], P[BASE + 1]), a1 = cvtpk(P[BASE + 2], P[BASE + 3]);   \
    unsigned b0 = cvtpk(P[BASE + 4], P[BASE + 5]), b1 = cvtpk(P[BASE + 6], P[BASE + 7]);                              \
    auto r0 = __builtin_amdgcn_permlane32_swap(a0, b0, false, false); auto r1 = __builtin_amdgcn_permlane32_swap(a1, b1, false, false); \
    u32x4 w = {r0[0], r1[0], r0[1], r1[1]}; OUT = *reinterpret_cast<bf16x8*>(&w); } while (0)
  PK4(p0, 0, pa0); PK4(p0, 8, pa1); PK4(p1, 0, pa2); PK4(p1, 8, pa3);
#undef PK4
}
typedef __attribute__((address_space(3))) const char* lds_cptr_t;
__device__ __forceinline__ void qkt(f32x16& p0, f32x16& p1, const bf16* Ks, const bf16x8 (&qr)[4], int r32, int hi, int mcolB, const f32x16& negm_unused, float mhat) {
  float nm = -mhat; asm volatile("" : "+v"(nm));
  f32x16 negm;
#pragma unroll
  for (int r = 0; r < 16; ++r) negm[r] = nm;
#pragma unroll
  for (int d0 = 0; d0 < 4; ++d0) { int cb = mcolB + (d0 * 16 + hi * 8) * 2;
    bf16x8 b0 = *reinterpret_cast<const bf16x8*>((const char*)Ks + KSWZ(r32, cb));
    bf16x8 b1 = *reinterpret_cast<const bf16x8*>((const char*)Ks + KSWZ(32 + r32, cb));
    if (d0 == 0) { p0 = __builtin_amdgcn_mfma_f32_32x32x16_bf16(b0, qr[0], negm, 0, 0, 0); p1 = __builtin_amdgcn_mfma_f32_32x32x16_bf16(b1, qr[0], negm, 0, 0, 0); }
    else { p0 = __builtin_amdgcn_mfma_f32_32x32x16_bf16(b0, qr[d0], p0, 0, 0, 0); p1 = __builtin_amdgcn_mfma_f32_32x32x16_bf16(b1, qr[d0], p1, 0, 0, 0); } }
}
__device__ __forceinline__ int v_st(int k, int c) { const int kk = (k & ~0xC) | ((k & 4) << 1) | ((k & 8) >> 1); return ((kk >> 3) * 4 + (c >> 5)) * 512 + ((kk & 7) * 32 + (c & 31)) * 2; }
__device__ __forceinline__ int v_rd_base(int lane) { return ((lane & 3) << 3) | (((lane >> 2) & 3) << 6) | (((lane >> 4) & 1) << 5) | (((lane >> 5) & 1) << 8); }
constexpr int v_rd_off(int d0, int ks, int half) { return d0 * 512 + ks * 4096 + half * 2048; }
template <int OFF> __device__ __forceinline__ s16x4 tr_read(int vb) {
  s16x4 r; asm volatile("ds_read_b64_tr_b16 %0, %1 offset:%2" : "=&v"(r) : "v"(vb), "i"(OFF) : "memory"); return r;
}
template <int D0> __device__ __forceinline__ void pv_one(f32x16& od, int vb, bf16x8 pa0, bf16x8 pa1, bf16x8 pa2, bf16x8 pa3) {
  const s16x4 l0 = tr_read<v_rd_off(D0, 0, 0)>(vb), h0 = tr_read<v_rd_off(D0, 0, 1)>(vb), l1 = tr_read<v_rd_off(D0, 1, 0)>(vb), h1 = tr_read<v_rd_off(D0, 1, 1)>(vb);
  const s16x4 l2 = tr_read<v_rd_off(D0, 2, 0)>(vb), h2 = tr_read<v_rd_off(D0, 2, 1)>(vb), l3 = tr_read<v_rd_off(D0, 3, 0)>(vb), h3 = tr_read<v_rd_off(D0, 3, 1)>(vb);
  asm volatile("s_waitcnt lgkmcnt(0)" ::: "memory"); SBAR();
#define PK(L, H) (bf16x8){L[0], L[1], L[2], L[3], H[0], H[1], H[2], H[3]}
  od = __builtin_amdgcn_mfma_f32_32x32x16_bf16(pa0, PK(l0, h0), od, 0, 0, 0);
  od = __builtin_amdgcn_mfma_f32_32x32x16_bf16(pa1, PK(l1, h1), od, 0, 0, 0);
  od = __builtin_amdgcn_mfma_f32_32x32x16_bf16(pa2, PK(l2, h2), od, 0, 0, 0);
  od = __builtin_amdgcn_mfma_f32_32x32x16_bf16(pa3, PK(l3, h3), od, 0, 0, 0);
#undef PK
}
__device__ __forceinline__ void pv_d0(f32x16* o, int vb, bf16x8 pa0, bf16x8 pa1, bf16x8 pa2, bf16x8 pa3) {
  pv_one<0>(o[0], vb, pa0, pa1, pa2, pa3); pv_one<1>(o[1], vb, pa0, pa1, pa2, pa3); pv_one<2>(o[2], vb, pa0, pa1, pa2, pa3); pv_one<3>(o[3], vb, pa0, pa1, pa2, pa3);
}

__device__ __forceinline__ void diff_attn_unit(const bf16* __restrict__ Qb, const bf16* __restrict__ Kh, const bf16* __restrict__ Vh,
                                               bf16* __restrict__ Ob, int seq, float lam, const float* __restrict__ subln, char* lds) {
  using St = Stage<bf16>;
  int tid_ = threadIdx.x; asm volatile("" : "+v"(tid_));
  const int tid = tid_, wid = __builtin_amdgcn_readfirstlane(tid >> 6), lane = tid & 63, r32 = lane & 31, hi = lane >> 5;
  bf16* V_lds = (bf16*)lds; bf16* K_lds = (bf16*)(lds + 3 * SHM_V);
  float* ws = (float*)(lds + 3 * SHM_V + 3 * SHM_K) + wid * 64; float* li_l = ws; float* al_l = ws + 32;
  float m_reg = 0.f, l_reg = 0; f32x16 o[4] = {}; f32x16 negm = {};
  const int mw = wid >> 2, wq = wid & 3, mcolB = mw * 128;
  const bf16* Qw = Qb + (long)(wq * QBLK + r32) * LDQ + mw * 64 + hi * 8;
  bf16x8 qr[4];
#pragma unroll
  for (int d0 = 0; d0 < 4; ++d0) qr[d0] = St::ld8(Qw + d0 * 16);
  const int vb0 = (int)(uintptr_t)V_lds + v_rd_base(lane);
  const int widu = wid;
  unsigned kof0, kof1, vof0, vof1;
  { const int r0 = 8 * widu + (lane >> 4), r1 = r0 + 4;
    kof0 = (unsigned)(r0 * LDK * 2 + ((((lane & 15) << 4)) ^ ((r0 & 15) << 4))); kof1 = (unsigned)(r1 * LDK * 2 + ((((lane & 15) << 4)) ^ ((r1 & 15) << 4)));
    const int kk = widu * 8 + ((lane & 31) >> 2), kx = (kk & ~0xC) | ((kk & 4) << 1) | ((kk & 8) >> 1);
    vof0 = (unsigned)(kx * LDK * 2 + (((lane >> 5)) * 32 + (lane & 3) * 8) * 2); vof1 = (unsigned)(kx * LDK * 2 + ((2 + (lane >> 5)) * 32 + (lane & 3) * 8) * 2); }
  typedef __attribute__((address_space(3))) unsigned lds_u32_t; typedef const __attribute__((address_space(1))) char g_cchar_t;
  lds_u32_t* const kdst = (lds_u32_t*)((__attribute__((address_space(3))) char*)K_lds + widu * 2048); lds_u32_t* const vdst = (lds_u32_t*)((__attribute__((address_space(3))) char*)V_lds + widu * 2048);
#define GLDS(g, off, dst) __builtin_amdgcn_global_load_lds((const __attribute__((address_space(1))) unsigned*)((g) + (off)), (dst), 16, 0, 0)
#define DMA_TILE(k0, slot) do { g_cchar_t* gk_ = (g_cchar_t*)Kh + (size_t)(k0) * LDK * 2; g_cchar_t* gv_ = (g_cchar_t*)Vh + (size_t)(k0) * LDK * 2; \
    GLDS(gk_, kof0, kdst + ((slot) * (int)SHM_K) / 4); GLDS(gk_, kof1, kdst + ((slot) * (int)SHM_K + 1024) / 4); \
    GLDS(gv_, vof0, vdst + ((slot) * (int)SHM_V) / 4); GLDS(gv_, vof1, vdst + ((slot) * (int)SHM_V + 1024) / 4); } while (0)
#define DMA_WAIT_BAR() do { asm volatile("s_waitcnt vmcnt(0)" ::: "memory"); __syncthreads(); } while (0)
#define RESC(a) do { if (__any((a) < 1.f)) { if (hi == 0) al_l[r32] = (a); asm volatile("s_waitcnt lgkmcnt(0)" ::: "memory"); \
    for (int d = 0; d < 4; ++d) for (int r = 0; r < 16; ++r) o[d][r] *= al_l[crow(r, hi)]; } } while (0)
#define ATT_STEP(PC0, PC1, ALC, PP0, PP1, ALP, CUR, PREV, NEXT, JJ) do { \
    SBAR(); qkt(PC0, PC1, (bf16*)((char*)K_lds + (CUR) * SHM_K), qr, r32, hi, mcolB, negm, m_reg); \
    finishSM(PP0, PP1, ALP, l_reg, pa0, pa1, pa2, pa3); SBAR(); \
    DMA_TILE(((JJ) + 1) * KVBLK, NEXT); SBAR(); \
    pv_d0(o, vb0 + (PREV) * (int)SHM_V, pa0, pa1, pa2, pa3); partialSM<false>(PC0, PC1, m_reg, negm, ALC); \
    RESC(ALC); DMA_WAIT_BAR(); } while (0)
  f32x16 pA0, pA1, pB0, pB1; float alA, alB; bf16x8 pa0, pa1, pa2, pa3; const int NT = seq / KVBLK;
  DMA_TILE(0, 0); DMA_TILE(KVBLK, 1); DMA_WAIT_BAR();
  qkt(pA0, pA1, K_lds, qr, r32, hi, mcolB, negm, m_reg); partialSM<true>(pA0, pA1, m_reg, negm, alA);
  for (int j = 1; j + 1 < NT; j += 6) {
    ATT_STEP(pB0, pB1, alB, pA0, pA1, alA, 1, 0, 2, j);
    ATT_STEP(pA0, pA1, alA, pB0, pB1, alB, 2, 1, 0, j + 1);
    ATT_STEP(pB0, pB1, alB, pA0, pA1, alA, 0, 2, 1, j + 2);
    ATT_STEP(pA0, pA1, alA, pB0, pB1, alB, 1, 0, 2, j + 3);
    ATT_STEP(pB0, pB1, alB, pA0, pA1, alA, 2, 1, 0, j + 4);
    ATT_STEP(pA0, pA1, alA, pB0, pB1, alB, 0, 2, 1, j + 5);
  }
  SBAR(); qkt(pB0, pB1, (bf16*)((char*)K_lds + SHM_K), qr, r32, hi, mcolB, negm, m_reg);
  finishSM(pA0, pA1, alA, l_reg, pa0, pa1, pa2, pa3); SBAR();
  pv_d0(o, vb0, pa0, pa1, pa2, pa3); partialSM<false>(pB0, pB1, m_reg, negm, alB);
  RESC(alB);
  finishSM(pB0, pB1, alB, l_reg, pa0, pa1, pa2, pa3); SBAR();
  pv_d0(o, vb0 + (int)SHM_V, pa0, pa1, pa2, pa3);
  __syncthreads();
  if (hi == 0) li_l[r32] = l_reg; asm volatile("s_waitcnt lgkmcnt(0)" ::: "memory");
  float rli[16];
#pragma unroll
  for (int r = 0; r < 16; ++r) rli[r] = __builtin_amdgcn_rcpf(li_l[crow(r, hi)]);
  float* EXO = (float*)lds + wq * (4 * 16 * 64) + lane;
  if (mw == 1) {
#pragma unroll
    for (int d0 = 0; d0 < 4; ++d0)
#pragma unroll
      for (int r = 0; r < 16; ++r) EXO[(d0 * 16 + r) * 64] = o[d0][r] * rli[r];
  }
  __syncthreads();
  if (mw == 0) {
    float ssq[16];
#pragma unroll
    for (int r = 0; r < 16; ++r) ssq[r] = 0.f;
#pragma unroll
    for (int d0 = 0; d0 < 4; ++d0)
#pragma unroll
      for (int r = 0; r < 16; ++r) { const float dv = o[d0][r] * rli[r] - lam * EXO[(d0 * 16 + r) * 64]; o[d0][r] = dv; ssq[r] += dv * dv; }
#pragma unroll
    for (int r = 0; r < 16; ++r) {
#pragma unroll
      for (int sft = 1; sft < 32; sft <<= 1) ssq[r] += __shfl_xor(ssq[r], sft);
      ssq[r] = rsqrtf(ssq[r] * (1.f / 128.f) + 1e-6f) * 0.8f;
    }
    bf16* stg = (bf16*)(lds + 65536 + wq * 8192);
#pragma unroll
    for (int d0 = 0; d0 < 4; ++d0) { const float gg = subln[d0 * 32 + r32];
#pragma unroll
      for (int r = 0; r < 16; ++r) { const float val = o[d0][r] * ssq[r] * gg; stg[crow(r, hi) * 128 + d0 * 32 + r32] = (bf16)(pg8::cvt_pk_bf16(val, val) & 0xffffu); } }
    asm volatile("s_waitcnt lgkmcnt(0)" ::: "memory");
    bf16* Ow = Ob + (long)(wq * QBLK) * LDO;
#pragma unroll
    for (int i = 0; i < 8; ++i) { const int row = i * 4 + (lane >> 4), ch = lane & 15;
      const u32x4 v = *(const u32x4*)(stg + row * 128 + ch * 8);
      *(__attribute__((address_space(1))) u32x4*)(Ow + (long)row * LDO + ch * 8) = v; }
  }
  __syncthreads();
#undef GLDS
#undef DMA_TILE
#undef DMA_WAIT_BAR
#undef RESC
#undef ATT_STEP
}
}


typedef __bf16 bf16x2_t __attribute__((ext_vector_type(2)));
__device__ __forceinline__ float dot2bf(unsigned a, unsigned b, float acc) { return __builtin_amdgcn_fdot2_f32_bf16(__builtin_bit_cast(bf16x2_t, a), __builtin_bit_cast(bf16x2_t, b), acc, false); }
template <int CTRL> __device__ __forceinline__ float dpp_add(float v) { return v + __builtin_bit_cast(float, __builtin_amdgcn_update_dpp(0, __builtin_bit_cast(int, v), CTRL, 0xf, 0xf, true)); }
__device__ __forceinline__ float row16_sum(float v) {
  v = dpp_add<0xB1>(v); v = dpp_add<0x4E>(v); v = dpp_add<0x141>(v); v = dpp_add<0x140>(v); return v;
}

typedef unsigned u32x2_t __attribute__((ext_vector_type(2)));
typedef float f32x2_t __attribute__((ext_vector_type(2)));
__device__ __forceinline__ void slice_table_fp8(const float* T, unsigned char* T8, float scale, int gtid, int gsz) {
  for (int it0 = gtid; it0 < 16384 * 128; it0 += 4 * gsz) {
    f32x4 a[4], b[4];
#pragma unroll
    for (int q = 0; q < 4; ++q) { const int it = it0 + q * gsz; if (it < 16384 * 128) { const int e = it >> 7, c8 = (it & 127) * 8; a[q] = *(const f32x4*)(T + (size_t)e * 1024 + c8); b[q] = *(const f32x4*)(T + (size_t)e * 1024 + c8 + 4); } }
#pragma unroll
    for (int q = 0; q < 4; ++q) { const int it = it0 + q * gsz; if (it < 16384 * 128) {
      const int e = it >> 7, c8 = (it & 127) * 8, j = c8 >> 7, c = c8 & 127; const f32x4 as = a[q] * scale, bs = b[q] * scale;
      int w0 = __builtin_amdgcn_cvt_pk_fp8_f32(as[0], as[1], 0, false); w0 = __builtin_amdgcn_cvt_pk_fp8_f32(as[2], as[3], w0, true);
      int w1 = __builtin_amdgcn_cvt_pk_fp8_f32(bs[0], bs[1], 0, false); w1 = __builtin_amdgcn_cvt_pk_fp8_f32(bs[2], bs[3], w1, true);
      *(u32x2_t*)(T8 + ((size_t)j * 16384 + e) * 128 + c) = (u32x2_t){(unsigned)w0, (unsigned)w1}; } }
  }
}
__device__ __forceinline__ void slice_table(const float* T, bf16_t* T8, int gtid, int gsz) {
  for (int it = gtid; it < 16384 * 128; it += gsz) {
    const int e = it >> 7, c8 = (it & 127) * 8, j = c8 >> 7, c = c8 & 127;
    const f32x4 a = *(const f32x4*)(T + (size_t)e * 1024 + c8), b = *(const f32x4*)(T + (size_t)e * 1024 + c8 + 4);
    u32x4 w; w.x = pg8::cvt_pk_bf16(a[0], a[1]); w.y = pg8::cvt_pk_bf16(a[2], a[3]); w.z = pg8::cvt_pk_bf16(b[0], b[1]); w.w = pg8::cvt_pk_bf16(b[2], b[3]);
    *(u32x4*)(T8 + ((size_t)j * 16384 + e) * 128 + c) = w;
  }
}

#define LAS __attribute__((address_space(3)))
#define XB_TMO      128
#define XB_XCNT(j)  (256  + 64 * (j))
#define XB_XSUB(j)  (1280 + 64 * (j))
#define XB_XGEN(j)  (2304 + 64 * (j))
#define XB_TOP      3328
#define XB_TOPGEN   3392
#define XCD_BAR_WORDS 3456
#define XB_SPIN_CAP (1u << 18)

__device__ __forceinline__ unsigned xb_ld(unsigned* p)              { return __hip_atomic_load(p, __ATOMIC_RELAXED, __HIP_MEMORY_SCOPE_AGENT); }
__device__ __forceinline__ unsigned xb_add(unsigned* p, unsigned v) { return __hip_atomic_fetch_add(p, v, __ATOMIC_RELAXED, __HIP_MEMORY_SCOPE_AGENT); }
__device__ __forceinline__ unsigned xb_xcc_id() { return (unsigned)__builtin_amdgcn_s_getreg((3 << 11) | 20) & 0xFu; }
#define XB_SPIN(cond, bar) do { unsigned _sp = 0; while (cond) { __builtin_amdgcn_s_sleep(1); \
    if ((++_sp & 255u) == 0u) { if (xb_ld(&(bar)[XB_TMO])) break; if (_sp > XB_SPIN_CAP) { atomicAdd(&(bar)[XB_TMO], 1u); break; } } } } while (0)

struct XcdBarrier {
    unsigned* bar; unsigned x;
    volatile LAS unsigned* st;
};

__device__ __forceinline__ XcdBarrier xcd_barrier_post(unsigned* bar, volatile LAS unsigned* st) {
    XcdBarrier b; b.bar = bar; b.x = xb_xcc_id(); b.st = st;
    if (threadIdx.x == 0) (void)xb_add(&bar[XB_XCNT(b.x)], 1u);
    return b;
}
__device__ __forceinline__ void xcd_barrier_complete(unsigned* bar, unsigned x, unsigned& nloc, unsigned& nx) {
    const unsigned G = gridDim.x * gridDim.y * gridDim.z;
    unsigned sum, cnt, mine, sp = 0u;
    for (;;) {
        sum = 0u; cnt = 0u; mine = 0u;
#pragma unroll
        for (unsigned j = 0; j < 16; ++j) { const unsigned c = xb_ld(&bar[XB_XCNT(j)]); sum += c; cnt += (c > 0u) ? 1u : 0u; mine = (j == x) ? c : mine; }
        if (sum == G) break;
        __builtin_amdgcn_s_sleep(1);
        if ((++sp & 255u) == 0u) { if (xb_ld(&bar[XB_TMO])) break; if (sp > XB_SPIN_CAP) { atomicAdd(&bar[XB_TMO], 1u); break; } }
    }
    nloc = mine > 0u ? mine : 1u; nx = cnt > 0u ? cnt : 1u;
}

__device__ __forceinline__ void xcd_barrier(const XcdBarrier& b) {
    asm volatile("s_waitcnt vmcnt(0)" ::: "memory");
    __syncthreads();
    if (threadIdx.x == 0) {
        unsigned* bar = b.bar;
        __builtin_amdgcn_s_waitcnt(0);
        unsigned nloc = b.st[0], nx = b.st[1];
        if (nloc == 0u) { xcd_barrier_complete(bar, b.x, nloc, nx); b.st[0] = nloc; b.st[1] = nx; }
        const unsigned old = xb_add(&bar[XB_XSUB(b.x)], 1u);
        const unsigned gen = old / nloc;
        if (old + 1u == (gen + 1u) * nloc) {
            __builtin_amdgcn_fence(__ATOMIC_RELEASE, "agent");
            asm volatile("s_waitcnt vmcnt(0)" ::: "memory");
            const unsigned og = xb_add(&bar[XB_TOP], 1u);
            const unsigned tg = og / nx;
            if (og + 1u == (tg + 1u) * nx) xb_add(&bar[XB_TOPGEN], 1u);
            else XB_SPIN(xb_ld(&bar[XB_TOPGEN]) == tg, bar);
            __builtin_amdgcn_fence(__ATOMIC_ACQUIRE, "agent");
            xb_add(&bar[XB_XGEN(b.x)], 1u);
            asm volatile("s_waitcnt vmcnt(0)" ::: "memory");
        } else {
            XB_SPIN(xb_ld(&bar[XB_XGEN(b.x)]) == gen, bar);
            __builtin_amdgcn_fence(__ATOMIC_ACQUIRE, "agent");
            asm volatile("s_waitcnt vmcnt(0)" ::: "memory");
        }
    }
    __syncthreads();
}


#define XB_XFLAG(j) (3456 + 64 * (j))
#define XCD_BAR_WORDS2 (3456 + 64 * 16)
#define XB_MAGIC2 0x0BA55000u
__device__ __forceinline__ void xcd_barrier2(const XcdBarrier& b) {
    asm volatile("s_waitcnt vmcnt(0)" ::: "memory");
    __syncthreads();
    if (threadIdx.x < 64) {
        unsigned* bar = b.bar; const unsigned lane = threadIdx.x;
        unsigned nloc = b.st[0], nx = b.st[1];
        if (lane == 0) {
            __builtin_amdgcn_s_waitcnt(0);
            if (nloc == 0u) { xcd_barrier_complete(bar, b.x, nloc, nx); b.st[0] = nloc; b.st[1] = nx; }
        }
        nloc = __builtin_amdgcn_readfirstlane(nloc);
        const unsigned ep = b.st[2] + 1u;
        const unsigned val = XB_MAGIC2 + ep;
        if (lane == 0) {
            b.st[2] = ep;
            const unsigned old = xb_add(&bar[XB_XSUB(b.x)], 1u);
            const unsigned gen = old / nloc;
            if (old + 1u == (gen + 1u) * nloc) {
                __builtin_amdgcn_fence(__ATOMIC_RELEASE, "agent");
                asm volatile("s_waitcnt vmcnt(0)" ::: "memory");
                __hip_atomic_store(&bar[XB_XFLAG(b.x)], val, __ATOMIC_RELAXED, __HIP_MEMORY_SCOPE_AGENT);
            }
        }
        const bool mine = lane < 16u && xb_ld(&bar[XB_XCNT(lane < 16u ? lane : 0u)]) > 0u;
        unsigned sp = 0u;
        for (;;) {
            const bool ok = !mine || ((xb_ld(&bar[XB_XFLAG(lane & 15u)]) - val) <= 1u);
            if (__all(ok)) break;
            __builtin_amdgcn_s_sleep(1);
            if ((++sp & 255u) == 0u) { if (xb_ld(&bar[XB_TMO])) break; if (sp > XB_SPIN_CAP) { if (lane == 0) atomicAdd(&bar[XB_TMO], 1u); break; } }
        }
        __builtin_amdgcn_fence(__ATOMIC_ACQUIRE, "agent");
        asm volatile("s_waitcnt vmcnt(0)" ::: "memory");
    }
    __syncthreads();
}

#define FB_MAGIC 0x5EEDBA00u
#define FB_MAGIC2 0x7A11F1A6u
__device__ __forceinline__ bool flag_barrier(unsigned* flags, unsigned* flags2) {
  asm volatile("s_waitcnt vmcnt(0)" ::: "memory");
  __syncthreads();
  bool leader = false;
  if (threadIdx.x < 64) {
    const unsigned myx = xb_xcc_id(), G = gridDim.x;
    if (threadIdx.x == 0) __hip_atomic_store(&flags[blockIdx.x], FB_MAGIC + myx, __ATOMIC_RELAXED, __HIP_MEMORY_SCOPE_AGENT);
    unsigned sp = 0u, minb = 0xFFFFFFFFu;
    for (;;) {
      bool ok = true; minb = 0xFFFFFFFFu;
      for (unsigned i = threadIdx.x; i < G; i += 64u) { const unsigned v = xb_ld(&flags[i]) - FB_MAGIC; ok = ok && (v < 16u); if (v == myx && i < minb) minb = i; }
      if (__all(ok)) break;
      __builtin_amdgcn_s_sleep(1);
      if (++sp > (1u << 21)) break;
    }
#pragma unroll
    for (int o = 32; o; o >>= 1) { const unsigned ov = (unsigned)__shfl_xor((int)minb, o); minb = ov < minb ? ov : minb; }
    leader = (minb == blockIdx.x);
    if (leader && threadIdx.x == 0) {
      __builtin_amdgcn_fence(__ATOMIC_RELEASE, "agent");
      asm volatile("s_waitcnt vmcnt(0)" ::: "memory");
      __hip_atomic_store(&flags2[myx], FB_MAGIC2, __ATOMIC_RELAXED, __HIP_MEMORY_SCOPE_AGENT);
    }
    sp = 0u;
    for (;;) {
      bool ok = true;
      for (unsigned i = threadIdx.x; i < G; i += 64u) { const unsigned x = (xb_ld(&flags[i]) - FB_MAGIC) & 15u; ok = ok && (xb_ld(&flags2[x]) == FB_MAGIC2); }
      if (__all(ok)) break;
      __builtin_amdgcn_s_sleep(1);
      if (++sp > (1u << 21)) break;
    }
    __builtin_amdgcn_fence(__ATOMIC_ACQUIRE, "agent");
    asm volatile("s_waitcnt vmcnt(0)" ::: "memory");
  }
  __syncthreads();
  return leader;
}

__device__ __forceinline__ void wave_argmax(float& v, int& i) {
#pragma unroll
  for (int o = 32; o; o >>= 1) {
    const float ov = __shfl_xor(v, o); const int oi = __shfl_xor(i, o);
    if (ov > v || (ov == v && oi < i)) { v = ov; i = oi; }
  }
}

__global__ void __launch_bounds__(NT) mega(Params p) {
  extern __shared__ __attribute__((aligned(16))) unsigned char lds[];
  cg::grid_group grid = cg::this_grid();
  if (threadIdx.x < 35) {
    unsigned long long v = threadIdx.x < 33 ? (unsigned long long)p.in[threadIdx.x] : (threadIdx.x == 33 ? (unsigned long long)p.out : (unsigned long long)p.ws);
    ((unsigned long long*)(lds + PTR_OFF))[threadIdx.x] = v;
  }
  if (threadIdx.x < 3) ((volatile unsigned*)(lds + PTR_OFF + 800))[threadIdx.x] = 0u;
  __syncthreads();
  if (blockIdx.x == 0) for (int i = threadIdx.x; i < XCD_BAR_WORDS2; i += NT) ((unsigned*)WSP(WS_BAR))[i] = 0u;

  {
    PHASE_LOCALS
    float* MOD = (float*)WSP(WS_MOD); float* LAM = (float*)WSP(WS_LAM);
    const float* cin = INP(1); const float* c_ctx = INP(3); const float* ada_w = INP(4); const float* ada_b = INP(5);
    if (gridDim.x >= 192) {
      if (blockIdx.x < 192) {
        float* sil = fl; float* red = fl + 5 * 1024;
        for (int i = tid; i < 5 * 1024; i += NT) { const int r = i >> 10, k = i & 1023; sil[i] = siluf_(r < 4 ? cin[r * D + k] : c_ctx[k]); }
        __syncthreads();
        const int cl = tid & 31, kg = tid >> 5, col = blockIdx.x * 32 + cl;
        float a[5] = {0.f, 0.f, 0.f, 0.f, 0.f};
#pragma unroll
        for (int kk = 0; kk < 64; ++kk) {
          const int k = kg * 64 + kk; const float w = ada_w[(size_t)k * 6144 + col];
#pragma unroll
          for (int r = 0; r < 5; ++r) a[r] += sil[r * 1024 + k] * w;
        }
#pragma unroll
        for (int r = 0; r < 5; ++r) red[(kg * 5 + r) * 32 + cl] = a[r];
        __syncthreads();
        if (tid < 160) {
          const int r = tid >> 5; float s = 0.f;
#pragma unroll
          for (int q = 0; q < 16; ++q) s += red[(q * 5 + r) * 32 + cl];
          MOD[r * 6144 + col] = s + ada_b[col];
        }
        __syncthreads();
      }
    } else {
      for (int it = gtid; it < 5 * 6144; it += gsz) {
        const int r = it / 6144, j = it % 6144;
        const float* cv = r < 4 ? cin + r * D : c_ctx;
        float a = 0.f;
        for (int k = 0; k < D; ++k) a += siluf_(cv[k]) * ada_w[(size_t)k * 6144 + j];
        MOD[it] = a + ada_b[j];
      }
    }
    if (gtid == 0) {
      const float* q1 = INP(9); const float* k1 = INP(10); const float* q2 = INP(11); const float* k2 = INP(12);
      float s1 = 0.f, s2 = 0.f;
      for (int k = 0; k < 64; ++k) { s1 += q1[k] * k1[k]; s2 += q2[k] * k2[k]; }
      LAM[0] = expf(s1) - expf(s2) + 0.2f;
    }
    const float* a_re = INP(15); const float* a_im = INP(16); const float* ldt = INP(17); const float* b_re = INP(18); const float* b_im = INP(19);
    for (int it = (int)(gridDim.x - 1 - blockIdx.x) * NT + tid; it < 2 * 32 * 64; it += gsz) {
      const float dt = expf(ldt[it >> 6]);
      ((float*)WSP(WS_ARDT))[it] = a_re[it] * dt; ((float*)WSP(WS_AIDT))[it] = a_im[it] * dt;
    }
    {
      struct BB { float fr, fi, ardt, aidt; };
      auto disc1 = [&](int sidx) -> BB {
        const float ar = a_re[sidx], ai = a_im[sidx], dt = expf(ldt[sidx >> 6]);
        const float mag = expf(ar * dt), abr = mag * cosf(ai * dt), abi = mag * sinf(ai * dt);
        const float den = ar * ar + ai * ai, nr = abr - 1.f, ni = abi;
        return BB{(nr * ar + ni * ai) / den, (ni * ar - nr * ai) / den, ar * dt, ai * dt};
      };
      {
        bf16_t* BTS = (bf16_t*)WSP(WS_BTS);
        for (int it = gtid; it < 32 * 256 * 32; it += gsz) {
          const int i = it & 31, r = (it >> 5) & 255, g = it >> 13;
          const int d = r >> 7, n = (r >> 1) & 63, ri = r & 1, sidx = (d * 32 + g) * 64 + n;
          const BB bb = disc1(sidx);
          const float e = (float)(d == 0 ? 31 - i : i);
          const float mag = __expf(e * bb.ardt), pr0 = mag * __cosf(e * bb.aidt), pi0 = mag * __sinf(e * bb.aidt);
          const float pr = pr0 * bb.fr - pi0 * bb.fi, pi = pr0 * bb.fi + pi0 * bb.fr;
          unsigned w[8];
#pragma unroll
          for (int q = 0; q < 8; ++q) {
            const float br0 = b_re[sidx * 16 + 2 * q], bi0 = b_im[sidx * 16 + 2 * q], br1 = b_re[sidx * 16 + 2 * q + 1], bi1 = b_im[sidx * 16 + 2 * q + 1];
            const float v0 = ri == 0 ? pr * br0 - pi * bi0 : pr * bi0 + pi * br0, v1 = ri == 0 ? pr * br1 - pi * bi1 : pr * bi1 + pi * br1;
            w[q] = pg8::cvt_pk_bf16(v0, v1);
          }
          u32x4* dst = (u32x4*)(BTS + ((size_t)g * 256 + r) * 512 + i * 16);
          dst[0] = (u32x4){w[0], w[1], w[2], w[3]}; dst[1] = (u32x4){w[4], w[5], w[6], w[7]};
        }
      }
      {
        float* KT = (float*)WSP(WS_KT); const float* c_re = INP(20); const float* c_im = INP(21);
        if (gridDim.x >= 256) {
          if (blockIdx.x >= 192) {
            const int dg = (int)blockIdx.x - 192; float* dsc = fl;
            float* blr = fl + 256; float* bli = blr + 1024; float* clr = bli + 1024; float* cli = clr + 16 * 65;
            if (tid < 64) { const BB bb = disc1(dg * 64 + tid); dsc[tid * 4] = bb.fr; dsc[tid * 4 + 1] = bb.fi; dsc[tid * 4 + 2] = bb.ardt; dsc[tid * 4 + 3] = bb.aidt; }
            for (int i = tid; i < 1024; i += NT) { blr[i] = b_re[dg * 1024 + i]; bli[i] = b_im[dg * 1024 + i];
              clr[(i >> 6) * 65 + (i & 63)] = c_re[dg * 1024 + i]; cli[(i >> 6) * 65 + (i & 63)] = c_im[dg * 1024 + i]; }
            __syncthreads();
            const int pp = tid & 15, m = tid >> 4;
            float acc[16];
#pragma unroll
            for (int q = 0; q < 16; ++q) acc[q] = 0.f;
            for (int n = 0; n < 64; ++n) {
              const float fr = dsc[n * 4], fi = dsc[n * 4 + 1], ardt = dsc[n * 4 + 2], aidt = dsc[n * 4 + 3];
              const float mag = __expf((float)m * ardt), pr0 = mag * __cosf((float)m * aidt), pi0 = mag * __sinf((float)m * aidt);
              const float pr = pr0 * fr - pi0 * fi, pi = pr0 * fi + pi0 * fr;
              const float cr = clr[pp * 65 + n], ci = cli[pp * 65 + n];
              const float wr_ = cr * pr - ci * pi, wi_ = cr * pi + ci * pr;
#pragma unroll
              for (int q = 0; q < 16; ++q) acc[q] += wr_ * blr[n * 16 + q] - wi_ * bli[n * 16 + q];
            }
#pragma unroll
            for (int q = 0; q < 16; ++q) KT[((size_t)dg * 32 + m) * 256 + pp * 16 + q] = acc[q];
            __syncthreads();
          }
        } else {
          for (int it = gtid; it < 2 * 32 * 32 * 16; it += gsz) {
            const int pp = it & 15, m = (it >> 4) & 31, dg = it >> 9;
            float acc[16];
#pragma unroll
            for (int q = 0; q < 16; ++q) acc[q] = 0.f;
            for (int n = 0; n < 64; ++n) {
              const int sidx = dg * 64 + n;
              const BB bb = disc1(sidx);
              const float mag = __expf((float)m * bb.ardt), pr0 = mag * __cosf((float)m * bb.aidt), pi0 = mag * __sinf((float)m * bb.aidt);
              const float pr = pr0 * bb.fr - pi0 * bb.fi, pi = pr0 * bb.fi + pi0 * bb.fr;
              const float cr = c_re[(dg * 16 + pp) * 64 + n], ci = c_im[(dg * 16 + pp) * 64 + n];
              const float wr_ = cr * pr - ci * pi, wi_ = cr * pi + ci * pr;
#pragma unroll
              for (int q = 0; q < 16; ++q) acc[q] += wr_ * b_re[sidx * 16 + q] - wi_ * b_im[sidx * 16 + q];
            }
#pragma unroll
            for (int q = 0; q < 16; ++q) KT[((size_t)dg * 32 + m) * 256 + pp * 16 + q] = acc[q];
          }
        }
      }
    }
    float* ROPE = (float*)WSP(WS_ROPE);
    for (int it = gtid; it < 64 * 16; it += gsz) {
      const float ang = (float)(it >> 4) * powf(10000.f, -(float)(it & 15) / 16.f);
      ROPE[it * 2] = cosf(ang); ROPE[it * 2 + 1] = sinf(ang);
    }
    {
      float* scr = fl + wid * (64 * 65);
      constexpr int I_IN = 16 * 88, I_AU = 16 * 16, I_SU = 8 * 16, I_OUT = 16 * 16, I_GLU = 8 * 8;
      for (int it = gw; it < I_IN + I_AU + I_SU + I_OUT + I_GLU; it += ngw) {
        int r = it;
        if (r < I_IN) { transpose_item64(INP(8), 1024, N_IN, (bf16_t*)WSP(WS_WIN), scr, r, lane); continue; } r -= I_IN;
        if (r < I_AU) { transpose_item64(INP(14), 1024, 1024, (bf16_t*)WSP(WS_WAU), scr, r, lane); continue; } r -= I_AU;
        if (r < I_SU) { transpose_item64(INP(25), 512, 1024, (bf16_t*)WSP(WS_WSU), scr, r, lane); continue; } r -= I_SU;
        if (r < I_OUT) { transpose_item64(INP(26), 1024, 1024, (bf16_t*)WSP(WS_WOUT), scr, r, lane); continue; } r -= I_OUT;
        transpose_item64(INP(23), 512, 512, (bf16_t*)WSP(WS_WGLU), scr, r, lane);
      }
    }
  }
  if (p.ws == nullptr) grid.sync();
  const bool fb_leader = flag_barrier((unsigned*)WSP(WS_FLAGS), (unsigned*)WSP(WS_FLAGS) + 2048);
  const XcdBarrier xbar = xcd_barrier_post((unsigned*)WSP(WS_BAR), (volatile LAS unsigned*)(lds + PTR_OFF + 800));

  {
    PHASE_LOCALS
    const float* MOD = (const float*)WSP(WS_MOD); bf16_t* XN = (bf16_t*)WSP(WS_XN);
    const float* x = INP(0); const float* ctx = INP(2); const float* norm1_g = INP(6);
    for (int row = gw; row < MX + MC; row += ngw) {
      const float* src; const float* md;
      if (row < MX) { src = x + (size_t)row * D; md = MOD + (row / L) * 6144; } else { src = ctx + (size_t)(row - MX) * D; md = MOD + 4 * 6144; }
      f32x4 v[4]; float ss = 0.f;
#pragma unroll
      for (int j = 0; j < 4; ++j) { v[j] = *(const f32x4*)(src + lane * 4 + 256 * j); ss += v[j][0] * v[j][0] + v[j][1] * v[j][1] + v[j][2] * v[j][2] + v[j][3] * v[j][3]; }
      const float rstd = rsqrtf(wave_sum(ss) * (1.f / D) + 1e-6f);
#pragma unroll
      for (int j = 0; j < 4; ++j)
#pragma unroll
        for (int e = 0; e < 4; ++e) { const int col = lane * 4 + 256 * j + e; XN[(size_t)row * D + col] = f2bf(v[j][e] * rstd * norm1_g[col] * (1.f + md[1024 + col]) + md[col]); }
    }
  }
  xcd_barrier2(xbar);
  if (threadIdx.x == 0) { ((unsigned*)WSP(WS_FLAGS))[blockIdx.x] = 0u; if (fb_leader) ((unsigned*)WSP(WS_FLAGS))[2048 + xb_xcc_id()] = 0u; }

  {
    pg8::Gemm g{(const bf16_t*)WSP(WS_XN), (const bf16_t*)WSP(WS_WIN), MX + MC, N_IN, D, D, D};
    InProjSched S; S.init((int)gridDim.x, (int)blockIdx.x);
    EpiInProj E{(bf16_t*)WSP(WS_Q), (bf16_t*)WSP(WS_K), (bf16_t*)WSP(WS_V), (bf16_t*)WSP(WS_SA), (bf16_t*)WSP(WS_G), (const float*)WSP(WS_ROPE)};
    pg8::gemm_phase<EpiInProj, InProjSched, true, true>((PG8_LAS unsigned char*)lds, g, S, E);
  }
  xcd_barrier2(xbar);

  {
    const float lam = ((const float*)WSP(WS_LAM))[0];
    const bf16_t* Qb = (const bf16_t*)WSP(WS_Q); const bf16_t* Kb = (const bf16_t*)WSP(WS_K); const bf16_t* Vb = (const bf16_t*)WSP(WS_V);
    bf16_t* ATT = (bf16_t*)WSP(WS_ATT); const float* subln = INP(13);
    for (int unit = blockIdx.x; unit < Bn * 8 * (L / 128); unit += gridDim.x) {
      const int h = unit & 7, qb = (unit >> 3) & 31, b = unit >> 8;
      const size_t qoff = ((size_t)(b * L + qb * 128)) * 1024 + h * 128, koff = (size_t)b * LA * 1024 + h * 128;
      att::diff_attn_unit(Qb + qoff, Kb + koff, Vb + koff, ATT + qoff, LA, lam, subln, (char*)lds);
    }
  }
  xcd_barrier2(xbar);

  {
    const bool gemm_blk = (blockIdx.x < 96) || (gridDim.x <= 96);
    if (gemm_blk) {
      pg8::Gemm g{(const bf16_t*)WSP(WS_SA), (const bf16_t*)WSP(WS_BTS), 0, 0, 512, SA_LD, 512};
      GroupSched S; S.init(32, 3, 1, (long)SA_ROWS * SA_LD * 2, (long)256 * SA_LD * 2, (long)256 * 512 * 2, 0, (int)(gridDim.x <= 96 ? gridDim.x : 96), (int)blockIdx.x);
      EpiS E{(float*)WSP(WS_S)};
      pg8::gemm_phase<EpiS, GroupSched, true, true>((PG8_LAS unsigned char*)lds, g, S, E);
    }
    {
      PHASE_LOCALS
      const bool big = gridDim.x > 96;
      const int vslots = big ? (gemm_blk ? 0 : 5) : 1, vbase = big ? (gemm_blk ? 768 : ((int)blockIdx.x - 96) * 5) : (int)blockIdx.x;
      const int vtot = big ? ((int)gridDim.x - 96) * 5 : (int)gridDim.x;
      const float* KT = (const float*)WSP(WS_KT); const float* ARDT = (const float*)WSP(WS_ARDT); const float* AIDT = (const float*)WSP(WS_AIDT);
      const float* c_re = INP(20); const float* c_im = INP(21); const float* dsk = INP(22); bf16_t* BTY = (bf16_t*)WSP(WS_BTY);
      constexpr int NCH = 32 * 512 * 96 / NT, NSG = NCH / 4;
      for (int cb = vbase; cb < NSG; cb += vtot) for (int vs = 0; vs < vslots; ++vs) {
        const int sg = cb + vs; if (sg >= NSG) break;
        const bool kpart = sg < 512;
        float v[4][8]; size_t dsto[4];
        if (kpart) {
          f32x4 fa[4], fb[4], ba[4], bb[4]; float dv[4], mf[4], mb[4]; int de[4];
#pragma unroll
          for (int u = 0; u < 4; ++u) {
            const int it = (sg * 4 + u) * NT + tid, cgp = it & 63, rg = it >> 6, row = rg & 511, g = rg >> 9, j = row >> 4, pp = row & 15, col0 = cgp * 8, i = col0 >> 4, q0 = col0 & 15;
            const int lf = j - i, lb = i - j;
            const float* kf = KT + ((size_t)(0 * 32 + g) * 32 + (lf > 0 ? lf : 0)) * 256 + pp * 16 + q0; const float* kb = KT + ((size_t)(1 * 32 + g) * 32 + (lb > 0 ? lb : 0)) * 256 + pp * 16 + q0;
            fa[u] = *(const f32x4*)kf; fb[u] = *(const f32x4*)(kf + 4); ba[u] = *(const f32x4*)kb; bb[u] = *(const f32x4*)(kb + 4); dv[u] = dsk[g * 16 + pp];
            mf[u] = lf >= 0 ? 1.f : 0.f; mb[u] = lb >= 0 ? 1.f : 0.f; de[u] = (i == j) ? pp - q0 : -1;
            dsto[u] = ((size_t)g * 512 + row) * 768 + col0;
          }
#pragma unroll
          for (int u = 0; u < 4; ++u)
#pragma unroll
            for (int e = 0; e < 8; ++e) v[u][e] = mf[u] * (e < 4 ? fa[u][e] : fb[u][e - 4]) + mb[u] * (e < 4 ? ba[u][e] : bb[u][e - 4]) + (de[u] == e ? dv[u] : 0.f);
        } else {
          f32x4 ar[4], ai[4], cr[4], ci[4]; float ex[4];
#pragma unroll
          for (int u = 0; u < 4; ++u) {
            const int it = ((sg - 512) * 4 + u) * NT + tid, cgp = 64 + (it & 31), rg = it >> 5, row = rg & 511, g = rg >> 9, j = row >> 4, pp = row & 15, col0 = cgp * 8;
            const int cc0 = col0 - 512, d = cc0 >> 7, n0 = (cc0 & 127) >> 1, sidx = (d * 32 + g) * 64 + n0;
            ex[u] = (float)(d == 0 ? j + 1 : 32 - j);
            ar[u] = *(const f32x4*)(ARDT + sidx); ai[u] = *(const f32x4*)(AIDT + sidx);
            cr[u] = *(const f32x4*)(c_re + ((d * 32 + g) * 16 + pp) * 64 + n0); ci[u] = *(const f32x4*)(c_im + ((d * 32 + g) * 16 + pp) * 64 + n0);
            dsto[u] = ((size_t)g * 512 + row) * 768 + col0;
          }
#pragma unroll
          for (int u = 0; u < 4; ++u)
#pragma unroll
            for (int q = 0; q < 4; ++q) {
              const float mag = __expf(ex[u] * ar[u][q]), pr = mag * __cosf(ex[u] * ai[u][q]), pi = mag * __sinf(ex[u] * ai[u][q]);
              v[u][2 * q] = cr[u][q] * pr - ci[u][q] * pi; v[u][2 * q + 1] = -(cr[u][q] * pi + ci[u][q] * pr);
            }
        }
#pragma unroll
        for (int u = 0; u < 4; ++u) {
          u32x4 w; w.x = pg8::cvt_pk_bf16(v[u][0], v[u][1]); w.y = pg8::cvt_pk_bf16(v[u][2], v[u][3]); w.z = pg8::cvt_pk_bf16(v[u][4], v[u][5]); w.w = pg8::cvt_pk_bf16(v[u][6], v[u][7]);
          *(u32x4*)(BTY + dsto[u]) = w;
        }
      }
    }
  }
  xcd_barrier2(xbar);

  {
    PHASE_LOCALS
    const float* ARDT = (const float*)WSP(WS_ARDT); const float* AIDT = (const float*)WSP(WS_AIDT);
    typedef float f32x2_ __attribute__((ext_vector_type(2)));
    f32x2_* PX = (f32x2_*)fl;
    for (int it = blockIdx.x; it < Bn * 32 * 2; it += gridDim.x) {
      const int d = it & 1, g = (it >> 1) & 31, b = it >> 6;
      const int sidx = (d * 32 + g) * 64 + lane;
      const float mag = expf(32.f * ARDT[sidx]), pr = mag * cosf(32.f * AIDT[sidx]), pi = mag * sinf(32.f * AIDT[sidx]);
      const f32x2_* Sg = (const f32x2_*)((const float*)WSP(WS_S) + (size_t)g * SA_ROWS * 256) + d * 64 + lane;
      bf16_t* SAg = (bf16_t*)WSP(WS_SA) + (size_t)g * SA_ROWS * SA_LD + 512 + d * 128 + lane * 2;
      f32x2_ sv[16];
#pragma unroll
      for (int k = 0; k < 16; ++k) { const int kk = wid * 16 + k, cx = d == 0 ? kk : 127 - kk; sv[k] = Sg[(size_t)(b * 128 + cx) * 128]; }
      if (wid == 0) {
        f32x2_ sc[8]; float hr = 0.f, hi = 0.f;
#pragma unroll
        for (int k = 0; k < 8; ++k) { const int cc = d == 0 ? k : 7 - k; sc[k] = Sg[(size_t)(512 + b * 8 + cc) * 128]; }
#pragma unroll
        for (int k = 0; k < 8; ++k) { const float nr = pr * hr - pi * hi + sc[k][0], ni = pr * hi + pi * hr + sc[k][1]; hr = nr; hi = ni; }
        PX[8 * 64 + lane] = (f32x2_){hr, hi};
      }
      float qr = 0.f, qi = 0.f;
#pragma unroll
      for (int k = 0; k < 16; ++k) { const float nr = pr * qr - pi * qi + sv[k][0], ni = pr * qi + pi * qr + sv[k][1]; qr = nr; qi = ni; }
      PX[wid * 64 + lane] = (f32x2_){qr, qi};
      float ar = pr, ai = pi;
#pragma unroll
      for (int q = 0; q < 4; ++q) { const float nr = ar * ar - ai * ai, ni = 2.f * ar * ai; ar = nr; ai = ni; }
      __syncthreads();
      float hr = PX[8 * 64 + lane][0], hi = PX[8 * 64 + lane][1];
      for (int v = 0; v < wid; ++v) { const f32x2_ pv = PX[v * 64 + lane]; const float nr = ar * hr - ai * hi + pv[0], ni = ar * hi + ai * hr + pv[1]; hr = nr; hi = ni; }
#pragma unroll
      for (int k = 0; k < 16; ++k) {
        const int kk = wid * 16 + k, cx = d == 0 ? kk : 127 - kk;
        *(unsigned*)(SAg + (size_t)(b * 128 + cx) * SA_LD) = pg8::cvt_pk_bf16(hr, hi);
        const float nr = pr * hr - pi * hi + sv[k][0], ni = pr * hi + pi * hr + sv[k][1]; hr = nr; hi = ni;
      }
      __syncthreads();
    }
  }
  xcd_barrier2(xbar);

  {
    pg8::Gemm g{(const bf16_t*)WSP(WS_SA), (const bf16_t*)WSP(WS_BTY), 0, 0, 768, SA_LD, 768};
    GroupSched S; S.init(32, 2, 2, (long)SA_ROWS * SA_LD * 2, (long)256 * SA_LD * 2, (long)512 * 768 * 2, (long)256 * 768 * 2, (int)gridDim.x, (int)blockIdx.x);
    EpiY E{(bf16_t*)WSP(WS_YG)};
    pg8::gemm_phase<EpiY, GroupSched, true, true>((PG8_LAS unsigned char*)lds, g, S, E);
  }
  {
    pg8::Gemm g{(const bf16_t*)WSP(WS_ATT), (const bf16_t*)WSP(WS_WAU), MX, 1024, 1024, 1024, 1024};
    pg8::StaticOrder S; S.init(MX, 1024, (int)gridDim.x, (int)blockIdx.x, g.lda, g.ldb);
    EpiBf8<1> E{(bf16_t*)WSP(WS_M), 1024, (const bf16_t*)WSP(WS_G), 2048, nullptr};
    pg8::gemm_phase<EpiBf8<1>, pg8::StaticOrder, true, true>((PG8_LAS unsigned char*)lds, g, S, E);
  }
  xcd_barrier2(xbar);

  {
    pg8::Gemm g{(const bf16_t*)WSP(WS_YG), (const bf16_t*)WSP(WS_WGLU), MX, 512, 512, 512, 512};
    pg8::StaticOrder S; S.init(MX, 512, (int)gridDim.x, (int)blockIdx.x, g.lda, g.ldb);
    EpiBf8<0> E{(bf16_t*)WSP(WS_SSMX), 512, (const bf16_t*)WSP(WS_YG), 512, INP(24)};
    pg8::gemm_phase<EpiBf8<0>, pg8::StaticOrder, true, true>((PG8_LAS unsigned char*)lds, g, S, E);
    {
      PHASE_LOCALS
      const int nglu = (MX / 256) * 2, nidle = (int)gridDim.x > nglu ? (int)gridDim.x - nglu : (int)gridDim.x, me = (int)gridDim.x > nglu ? (int)blockIdx.x - nglu : (int)blockIdx.x;
      const float* wq = INP(27); const float* sk1 = INP(28); const float* sk2 = INP(29); bf16_t* WC = (bf16_t*)WSP(WS_WC);
      float* skl = fl; float* wql = fl + 128 * 68;
      if (me >= 0) for (int tile = me; tile < 16 * 16; tile += nidle) {
        const int hs = tile >> 4, d0 = (tile & 15) * 64, h = hs >> 1, s = hs & 1;
        __syncthreads();
        const float* skp = s ? sk2 : sk1;
        for (int i = tid; i < 128 * 16; i += NT) { const int k = i >> 4, e4 = (i & 15) * 4; *(f32x4*)(skl + k * 68 + e4) = *(const f32x4*)(skp + k * 64 + e4); }
        for (int i = tid; i < 64 * 16; i += NT) { const int dd = i >> 4, e4 = (i & 15) * 4; *(f32x4*)(wql + dd * 68 + e4) = *(const f32x4*)(wq + (size_t)(d0 + dd) * 1024 + h * 128 + s * 64 + e4); }
        __syncthreads();
        const int k = tid & 127, dgp = tid >> 7;
        float a[16];
#pragma unroll
        for (int q = 0; q < 16; ++q) a[q] = 0.f;
        for (int e = 0; e < 64; e += 4) {
          const f32x4 sv = *(const f32x4*)(skl + k * 68 + e);
#pragma unroll
          for (int q = 0; q < 16; ++q) { const f32x4 wv = *(const f32x4*)(wql + (dgp * 16 + q) * 68 + e); a[q] += sv[0] * wv[0] + sv[1] * wv[1] + sv[2] * wv[2] + sv[3] * wv[3]; }
        }
        u32x4 w0, w1;
        w0.x = pg8::cvt_pk_bf16(a[0], a[1]); w0.y = pg8::cvt_pk_bf16(a[2], a[3]); w0.z = pg8::cvt_pk_bf16(a[4], a[5]); w0.w = pg8::cvt_pk_bf16(a[6], a[7]);
        w1.x = pg8::cvt_pk_bf16(a[8], a[9]); w1.y = pg8::cvt_pk_bf16(a[10], a[11]); w1.z = pg8::cvt_pk_bf16(a[12], a[13]); w1.w = pg8::cvt_pk_bf16(a[14], a[15]);
        bf16_t* dst = WC + (size_t)(h * 256 + s * 128 + k) * 1024 + d0 + dgp * 16;
        *(u32x4*)dst = w0; *(u32x4*)(dst + 8) = w1;
      }
      __syncthreads();
    }
  }
  xcd_barrier2(xbar);

  {
    pg8::Gemm g{(const bf16_t*)WSP(WS_SSMX), (const bf16_t*)WSP(WS_WSU), MX, 1024, 512, 512, 512};
    pg8::StaticOrder S; S.init(MX, 1024, (int)gridDim.x, (int)blockIdx.x, g.lda, g.ldb);
    EpiBf8<2> E{(bf16_t*)WSP(WS_M), 1024, (const bf16_t*)WSP(WS_G) + 1024, 2048, nullptr};
    pg8::gemm_phase<EpiBf8<2>, pg8::StaticOrder, true, true>((PG8_LAS unsigned char*)lds, g, S, E);
  }
  xcd_barrier2(xbar);
  {
    pg8::Gemm g{(const bf16_t*)WSP(WS_M), (const bf16_t*)WSP(WS_WOUT), MX, 1024, 1024, 1024, 1024};
    pg8::StaticOrder S; S.init(MX, 1024, (int)gridDim.x, (int)blockIdx.x, g.lda, g.ldb);
    EpiX1 E{(bf16_t*)WSP(WS_X1), INP(0), (const float*)WSP(WS_MOD)};
    pg8::gemm_phase<EpiX1, pg8::StaticOrder, true, true>((PG8_LAS unsigned char*)lds, g, S, E);
  }
  xcd_barrier2(xbar);
  {
    PHASE_LOCALS
    const bf16_t* X1 = (const bf16_t*)WSP(WS_X1); const float* MOD = (const float*)WSP(WS_MOD); bf16_t* XN2 = (bf16_t*)WSP(WS_XN2); const float* norm2_g = INP(7);
    const float* TU_ = INP(30); unsigned char* TU8_ = (unsigned char*)WSP(WS_U8);
    int sq_ = 0; const int snq_ = (16384 * 128 + gsz - 1) / gsz;
#define SL_ST(q_, a_, b_) do { const int it_ = gtid + (q_) * gsz; if ((q_) < snq_ && it_ < 16384 * 128) { const int e_ = it_ >> 7, c8_ = (it_ & 127) * 8, js_ = c8_ >> 7, c_ = c8_ & 127; const f32x4 as_ = (a_) * 32.f, bs_ = (b_) * 32.f; \
        int w0_ = __builtin_amdgcn_cvt_pk_fp8_f32(as_[0], as_[1], 0, false); w0_ = __builtin_amdgcn_cvt_pk_fp8_f32(as_[2], as_[3], w0_, true); \
        int w1_ = __builtin_amdgcn_cvt_pk_fp8_f32(bs_[0], bs_[1], 0, false); w1_ = __builtin_amdgcn_cvt_pk_fp8_f32(bs_[2], bs_[3], w1_, true); \
        *(u32x2_t*)(TU8_ + ((size_t)js_ * 16384 + e_) * 128 + c_) = (u32x2_t){(unsigned)w0_, (unsigned)w1_}; } } while (0)
#define SL_LD(q_, a_, b_) do { const int it_ = gtid + (q_) * gsz; if ((q_) < snq_ && it_ < 16384 * 128) { const float* sp_ = TU_ + (size_t)(it_ >> 7) * 1024 + (it_ & 127) * 8; a_ = *(const f32x4*)sp_; b_ = *(const f32x4*)(sp_ + 4); } } while (0)
    for (int row = gw; row < MX; row += ngw) {
      const bf16_t* src = X1 + (size_t)row * D; const float* md = MOD + (row / L) * 6144;
      float v[2][8]; float ss = 0.f;
      u32x4 rw_[2];
#pragma unroll
      for (int j = 0; j < 2; ++j) rw_[j] = *(const u32x4*)(src + lane * 8 + 512 * j);
      f32x4 sa0_, sb0_, sa1_, sb1_; SL_LD(sq_, sa0_, sb0_); SL_LD(sq_ + 1, sa1_, sb1_);
#pragma unroll
      for (int j = 0; j < 2; ++j) { const u32x4 w = rw_[j];
        v[j][0] = bflo(w.x); v[j][1] = bfhi(w.x); v[j][2] = bflo(w.y); v[j][3] = bfhi(w.y); v[j][4] = bflo(w.z); v[j][5] = bfhi(w.z); v[j][6] = bflo(w.w); v[j][7] = bfhi(w.w);
#pragma unroll
        for (int e = 0; e < 8; ++e) ss += v[j][e] * v[j][e]; }
      const float rstd = rsqrtf(wave_sum(ss) * (1.f / D) + 1e-6f);
#pragma unroll
      for (int j = 0; j < 2; ++j) { const int col = lane * 8 + 512 * j; float o[8];
#pragma unroll
        for (int h = 0; h < 2; ++h) { const f32x4 g4 = *(const f32x4*)(norm2_g + col + 4 * h), s4 = *(const f32x4*)(md + 4096 + col + 4 * h), b4 = *(const f32x4*)(md + 3072 + col + 4 * h);
#pragma unroll
          for (int e = 0; e < 4; ++e) o[4 * h + e] = v[j][4 * h + e] * rstd * g4[e] * (1.f + s4[e]) + b4[e]; }
        u32x4 w; w.x = pg8::cvt_pk_bf16(o[0], o[1]); w.y = pg8::cvt_pk_bf16(o[2], o[3]); w.z = pg8::cvt_pk_bf16(o[4], o[5]); w.w = pg8::cvt_pk_bf16(o[6], o[7]);
        *(u32x4*)(XN2 + (size_t)row * D + col) = w; }
      SL_ST(sq_, sa0_, sb0_); SL_ST(sq_ + 1, sa1_, sb1_); sq_ += 2;
    }
    for (; sq_ < snq_; ++sq_) { f32x4 sa0_, sb0_; SL_LD(sq_, sa0_, sb0_); SL_ST(sq_, sa0_, sb0_); }
#undef SL_LD
#undef SL_ST
  }
  xcd_barrier2(xbar);
  {
    pg8::Gemm g{(const bf16_t*)WSP(WS_XN2), (const bf16_t*)WSP(WS_WC), MX, 2048, 1024, 1024, 1024};
    EpiTopK E{(unsigned short*)WSP(WS_IDX), (float*)WSP(WS_GATE)};
    const int nrounds = (64 * 8 + (int)gridDim.x - 1) / (int)gridDim.x;
    for (int rd = 0; rd < nrounds; ++rd) {
      OneUnitSched S; S.nM = 64; S.nN = 8; S.G = (int)gridDim.x; S.c = (int)blockIdx.x; S.round = rd; S.tsA = (long)256 * 1024 * 2; S.tsB = (long)256 * 1024 * 2;
      pg8::gemm_phase<EpiTopK, OneUnitSched, false, true>((PG8_LAS unsigned char*)lds, g, S, E);
    }
  }
  xcd_barrier2(xbar);
  {
    PHASE_LOCALS
    const bf16_t* XN2 = (const bf16_t*)WSP(WS_XN2); const unsigned short* EXT = (const unsigned short*)WSP(WS_IDX);
    unsigned* PDW = (unsigned*)WSP(WS_PD);
    const bool sl = (gridDim.x & 7) == 0;
    const int widu = __builtin_amdgcn_readfirstlane(wid);
    const int j0 = sl ? (int)(blockIdx.x & 7) : 0, nj = sl ? 1 : 8;
    const int wk = sl ? (int)(blockIdx.x >> 3) * 8 + widu : (int)blockIdx.x * (NT / 64) + widu, nwk = sl ? (int)(gridDim.x >> 3) * 8 : ngw;
    const int eg = lane >> 3, li = lane & 7;
    for (int jj = 0; jj < nj; ++jj) {
      const int j = j0 + jj;
      const unsigned char* U8j = (const unsigned char*)WSP(WS_U8) + (size_t)j * 16384 * 128 + li * 16;
      volatile LAS unsigned* tctr_ = (volatile LAS unsigned*)(lds + PTR_OFF + 816);
      __syncthreads(); if (tid == 0) *tctr_ = 0u; __syncthreads();
      const int tgb_ = (int)(blockIdx.x >> 3), tnb_ = (int)(gridDim.x >> 3);
      for (int t = sl ? 0 : wk; ; t += nwk) {
        if (sl) { unsigned k_ = 0u; if (lane == 0) k_ = __hip_atomic_fetch_add((LAS unsigned*)tctr_, 1u, __ATOMIC_RELAXED, __HIP_MEMORY_SCOPE_WORKGROUP); k_ = (unsigned)__builtin_amdgcn_readfirstlane((int)k_); t = tgb_ + (int)k_ * tnb_; }
        if (t >= MX) break;
        const u32x4* xp = (const u32x4*)(XN2 + (size_t)t * 1024 + j * 128 + li * 16);
        const u32x4 xa = xp[0], xb = xp[1];
        const u32x4* ep = (const u32x4*)(EXT + (size_t)t * 128 + eg * 16);
        const u32x4 e0 = ep[0], e1 = ep[1];
        const unsigned ew[8] = {e0.x, e0.y, e0.z, e0.w, e1.x, e1.y, e1.z, e1.w};
        u32x4 uw[16];
#pragma unroll
        for (int k = 0; k < 16; ++k) { const unsigned ex = (k & 1) ? (ew[k >> 1] >> 16) : (ew[k >> 1] & 0xffffu); uw[k] = *(const u32x4*)(U8j + ex * 128u); }
        const unsigned xwd[8] = {xa.x, xa.y, xa.z, xa.w, xb.x, xb.y, xb.z, xb.w};
        f32x2_t xf[8];
#pragma unroll
        for (int q = 0; q < 8; ++q) xf[q] = (f32x2_t){bflo(xwd[q]), bfhi(xwd[q])};
        float keep_lo = 0.f, keep_hi = 0.f;
#pragma unroll
        for (int k = 0; k < 16; ++k) {
          const unsigned uu[4] = {uw[k].x, uw[k].y, uw[k].z, uw[k].w};
          f32x2_t s2 = {0.f, 0.f};
#pragma unroll
          for (int q = 0; q < 4; ++q) { s2 += __builtin_amdgcn_cvt_pk_f32_fp8((int)uu[q], false) * xf[2 * q]; s2 += __builtin_amdgcn_cvt_pk_f32_fp8((int)uu[q], true) * xf[2 * q + 1]; }
          float dp = s2.x + s2.y;
          dp = dpp_add<0xB1>(dp); dp = dpp_add<0x4E>(dp); dp = dpp_add<0x141>(dp);
          if (li == (k >> 1)) { if (k & 1) keep_hi = dp; else keep_lo = dp; }
        }
        PDW[((size_t)j * MX + t) * 64 + lane] = pg8::cvt_pk_bf16(keep_lo * (1.f / 32.f), keep_hi * (1.f / 32.f));
      }
    }
    slice_table_fp8(INP(31), (unsigned char*)WSP(WS_V8), 1.f, gtid, gsz);
  }
  xcd_barrier2(xbar);
  {
    PHASE_LOCALS
    const unsigned* PDW = (const unsigned*)WSP(WS_PD); const float* GATE = (const float*)WSP(WS_GATE); unsigned* CFP = (unsigned*)WSP(WS_CFP);
    for (int t0 = gw * 4; t0 < MX; t0 += ngw * 4) {
      unsigned pw[4][8]; f32x2_t g2[4];
#pragma unroll
      for (int u = 0; u < 4; ++u) {
#pragma unroll
        for (int j = 0; j < 8; ++j) pw[u][j] = PDW[((size_t)j * MX + t0 + u) * 64 + lane];
        g2[u] = *(const f32x2_t*)(GATE + (size_t)(t0 + u) * 128 + 2 * lane);
      }
#pragma unroll
      for (int u = 0; u < 4; ++u) {
        const float p0 = ((bflo(pw[u][0]) + bflo(pw[u][1])) + (bflo(pw[u][2]) + bflo(pw[u][3]))) + ((bflo(pw[u][4]) + bflo(pw[u][5])) + (bflo(pw[u][6]) + bflo(pw[u][7])));
        const float p1 = ((bfhi(pw[u][0]) + bfhi(pw[u][1])) + (bfhi(pw[u][2]) + bfhi(pw[u][3]))) + ((bfhi(pw[u][4]) + bfhi(pw[u][5])) + (bfhi(pw[u][6]) + bfhi(pw[u][7])));
        CFP[(size_t)(t0 + u) * 64 + lane] = pg8::cvt_pk_bf16(g2[u].x * gelu_tanh(p0), g2[u].y * gelu_tanh(p1));
      }
    }
  }
  xcd_barrier2(xbar);
  {
    PHASE_LOCALS
    const bf16_t* X1 = (const bf16_t*)WSP(WS_X1); const float* MOD = (const float*)WSP(WS_MOD);
    const unsigned short* EXT = (const unsigned short*)WSP(WS_IDX); const unsigned* CFP = (const unsigned*)WSP(WS_CFP);
    float* SSQ = (float*)WSP(WS_SSQ); bf16_t* X2 = (bf16_t*)WSP(WS_X2);
    const bool sl = (gridDim.x & 7) == 0;
    const int widu = __builtin_amdgcn_readfirstlane(wid);
    const int j0 = sl ? (int)(blockIdx.x & 7) : 0, nj = sl ? 1 : 8;
    const int wk = sl ? (int)(blockIdx.x >> 3) * 8 + widu : (int)blockIdx.x * (NT / 64) + widu, nwk = sl ? (int)(gridDim.x >> 3) * 8 : ngw;
    const int eg = lane >> 3, li = lane & 7;
    float* red = fl + widu * 1024;
    for (int jj = 0; jj < nj; ++jj) {
      const int j = j0 + jj;
      const unsigned char* V8j = (const unsigned char*)WSP(WS_V8) + (size_t)j * 16384 * 128 + li * 16;
      volatile LAS unsigned* tctr_ = (volatile LAS unsigned*)(lds + PTR_OFF + 816);
      __syncthreads(); if (tid == 0) *tctr_ = 0u; __syncthreads();
      const int tgb_ = (int)(blockIdx.x >> 3), tnb_ = (int)(gridDim.x >> 3);
      for (int t = sl ? 0 : wk; ; t += nwk) {
        if (sl) { unsigned k_ = 0u; if (lane == 0) k_ = __hip_atomic_fetch_add((LAS unsigned*)tctr_, 1u, __ATOMIC_RELAXED, __HIP_MEMORY_SCOPE_WORKGROUP); k_ = (unsigned)__builtin_amdgcn_readfirstlane((int)k_); t = tgb_ + (int)k_ * tnb_; }
        if (t >= MX) break;
        const u32x4* ep = (const u32x4*)(EXT + (size_t)t * 128 + eg * 16);
        const u32x4 e0 = ep[0], e1 = ep[1];
        const u32x4* cp = (const u32x4*)(CFP + (size_t)t * 64 + eg * 8);
        const u32x4 c0 = cp[0], c1 = cp[1];
        const int col = j * 128 + 2 * lane;
        const unsigned xrw = *(const unsigned*)(X1 + (size_t)t * 1024 + col); const f32x2_t xr = {bflo(xrw), bfhi(xrw)};
        const f32x2_t gr = *(const f32x2_t*)(MOD + (t >> 12) * 6144 + 5120 + col);
        const unsigned ew[8] = {e0.x, e0.y, e0.z, e0.w, e1.x, e1.y, e1.z, e1.w};
        const unsigned cfp[8] = {c0.x, c0.y, c0.z, c0.w, c1.x, c1.y, c1.z, c1.w};
        u32x4 vw[16];
#pragma unroll
        for (int k = 0; k < 16; ++k) { const unsigned ex = (k & 1) ? (ew[k >> 1] >> 16) : (ew[k >> 1] & 0xffffu); vw[k] = *(const u32x4*)(V8j + ex * 128u); }
        f32x2_t a[8];
#pragma unroll
        for (int q = 0; q < 8; ++q) a[q] = (f32x2_t){0.f, 0.f};
#pragma unroll
        for (int k = 0; k < 16; ++k) {
          const unsigned cf2 = cfp[k >> 1]; const float cf = (k & 1) ? bfhi(cf2) : bflo(cf2);
          const unsigned vv[4] = {vw[k].x, vw[k].y, vw[k].z, vw[k].w};
#pragma unroll
          for (int q = 0; q < 4; ++q) { a[2 * q] += __builtin_amdgcn_cvt_pk_f32_fp8((int)vv[q], false) * cf; a[2 * q + 1] += __builtin_amdgcn_cvt_pk_f32_fp8((int)vv[q], true) * cf; }
        }
#pragma unroll
        for (int q = 0; q < 4; ++q) *(f32x4*)(red + (eg * 4 + q) * 32 + ((li * 4 + 16 * (q >> 1)) & 31)) = (f32x4){a[2 * q].x, a[2 * q].y, a[2 * q + 1].x, a[2 * q + 1].y};
        asm volatile("s_waitcnt lgkmcnt(0)" ::: "memory");
        f32x2_t acc = {0.f, 0.f};
        const int rq = (lane >> 1) & 3, roff = rq * 32 + (((lane >> 3) * 4 + 2 * (lane & 1) + 16 * (rq >> 1)) & 31);
#pragma unroll
        for (int g = 0; g < 8; ++g) acc += *(const f32x2_t*)(red + g * 128 + roff);
        asm volatile("s_waitcnt lgkmcnt(0)" ::: "memory");
        const f32x2_t o2 = xr + gr * acc;
        float ss = o2.x * o2.x + o2.y * o2.y;
        ss = wave_sum(ss);
        *(unsigned*)(X2 + (size_t)t * 1024 + col) = pg8::cvt_pk_bf16(o2.x, o2.y);
        if (lane == 0) SSQ[(size_t)t * 8 + j] = ss;
      }
    }
  }
  xcd_barrier2(xbar);
  {
    PHASE_LOCALS
    const float* SSQ = (const float*)WSP(WS_SSQ); const float* fng = INP(32); float* out = GPTR(float, ldptr_(33)); const bf16_t* X2 = (const bf16_t*)WSP(WS_X2);
    f32x4 g4[4];
#pragma unroll
    for (int jq = 0; jq < 4; ++jq) g4[jq] = *(const f32x4*)(fng + lane * 8 + 512 * (jq >> 1) + 4 * (jq & 1));
    for (int row0 = gw * 2; row0 < MX; row0 += ngw * 2) {
      f32x4 sa[2], sb[2]; u32x4 w[2][2];
#pragma unroll
      for (int u = 0; u < 2; ++u) { const int row = row0 + u; sa[u] = *(const f32x4*)(SSQ + (size_t)row * 8); sb[u] = *(const f32x4*)(SSQ + (size_t)row * 8 + 4);
#pragma unroll
        for (int j = 0; j < 2; ++j) w[u][j] = *(const u32x4*)(X2 + (size_t)row * D + lane * 8 + 512 * j); }
#pragma unroll
      for (int u = 0; u < 2; ++u) { const int row = row0 + u;
        const float rstd = rsqrtf(((sa[u][0] + sa[u][1]) + (sa[u][2] + sa[u][3]) + (sb[u][0] + sb[u][1]) + (sb[u][2] + sb[u][3])) * (1.f / D) + 1e-6f);
#pragma unroll
        for (int j = 0; j < 2; ++j) {
          float* op = out + (size_t)row * D + lane * 8 + 512 * j; const u32x4 ww = w[u][j];
          *(f32x4*)op = (f32x4){bflo(ww.x), bfhi(ww.x), bflo(ww.y), bfhi(ww.y)} * rstd * g4[2 * j];
          *(f32x4*)(op + 4) = (f32x4){bflo(ww.z), bfhi(ww.z), bflo(ww.w), bfhi(ww.w)} * rstd * g4[2 * j + 1];
        } }
    }
  }
}

extern "C" void kernel_launch(void* const* d_in, const int* in_sizes, int n_in, void* d_out, int out_size, void* d_ws, size_t ws_size, hipStream_t stream) {
  static int grid_blocks = 0;
  if (!grid_blocks) {
    int dev = 0, cus = 0, per_cu = 0;
    (void)hipGetDevice(&dev);
    (void)hipDeviceGetAttribute(&cus, hipDeviceAttributeMultiprocessorCount, dev);
    (void)hipFuncSetAttribute((const void*)mega, hipFuncAttributeMaxDynamicSharedMemorySize, LDS_BYTES);
    (void)hipOccupancyMaxActiveBlocksPerMultiprocessor(&per_cu, (const void*)mega, NT, LDS_BYTES);
    if (per_cu < 1) per_cu = 1;
    grid_blocks = cus * per_cu;
    if (n_in != 33 || ws_size < 255 * MiB) { fprintf(stderr, "kernel_launch: unexpected n_in %d / ws %zu\n", n_in, ws_size); }
  }
  Params p{};
  for (int i = 0; i < 33 && i < n_in; ++i) p.in[i] = (const float*)d_in[i];
  p.out = (float*)d_out; p.ws = (unsigned char*)d_ws;
  void* args[] = {&p};
  hipError_t e = hipLaunchCooperativeKernel((const void*)mega, dim3(grid_blocks), dim3(NT), args, LDS_BYTES, stream);
  if (e != hipSuccess) fprintf(stderr, "cooperative launch failed: %s (grid %d)\n", hipGetErrorString(e), grid_blocks);
}
```
